# Optimizing an MI355X kernel written in HIP

```python
import math
import jax, jax.numpy as jnp
from jax import lax
import numpy as np

D_MODEL = 2048
BATCH = 8
SEQ = 4096
DEPTH = 4

F32 = jnp.float32
LN_EPS = 1e-5
NORM_EPS = 1e-6

N_BRANCH = 3
BRANCH_WIDTH = D_MODEL // 2

M_HEADS = 4
M_DV = BRANCH_WIDTH // M_HEADS
M_DQK = M_DV // 2
M_CHUNK = 64

S_DINNER = BRANCH_WIDTH
S_HEADDIM = 64
S_HEADS = S_DINNER // S_HEADDIM
S_GROUPS = 2
S_HPG = S_HEADS // S_GROUPS
S_DSTATE = 128
S_CONV = 4
S_CHUNK = 128
S_CONV_CH = S_DINNER + 2 * S_GROUPS * S_DSTATE

A_HEADDIM = 64
A_QHEADS = BRANCH_WIDTH // A_HEADDIM
A_KVHEADS = 4
A_REP = A_QHEADS // A_KVHEADS
A_WINDOW = 128
A_BLOCK = 128
ROPE_THETA = 10000.0

P_HEADS = 8
P_NKEYS = 128
P_EXPERTS = P_NKEYS * P_NKEYS
P_DKEY = 256
P_TOPK = 16
P_CHUNK = 128

M_COLS = 2 * M_HEADS * M_DQK + 2 * M_HEADS * M_DV + 2 * M_HEADS
S_COLS = S_DINNER + S_CONV_CH + S_HEADS
A_COLS = A_QHEADS * A_HEADDIM + 2 * A_KVHEADS * A_HEADDIM
G_COLS = N_BRANCH * D_MODEL
IN_COLS = M_COLS + S_COLS + A_COLS + G_COLS

kernel_name = "hybrid_mlstm_ssd_swa_peer_deepnorm"


def _in_split_points():
    sizes = [M_HEADS * M_DQK, M_HEADS * M_DQK, M_HEADS * M_DV, M_HEADS * M_DV, M_HEADS, M_HEADS,
             S_DINNER, S_CONV_CH, S_HEADS,
             A_QHEADS * A_HEADDIM, A_KVHEADS * A_HEADDIM, A_KVHEADS * A_HEADDIM,
             G_COLS]
    return [int(v) for v in np.cumsum(sizes)[:-1]]


def layer_norm(x, g, b):
    xf = x.astype(F32)
    mu = jnp.mean(xf, -1, keepdims=True)
    var = jnp.mean(jnp.square(xf - mu), -1, keepdims=True)
    return ((xf - mu) * lax.rsqrt(var + LN_EPS) * g.astype(F32) + b.astype(F32)).astype(x.dtype)


def mlstm_mixer(q, k, v, o_pre, i_pre, f_pre, norm_w):
    B_, S_ = q.shape[:2]
    nc = S_ // M_CHUNK

    def to_chunks(t):
        t = t.reshape((B_, nc, M_CHUNK) + t.shape[2:])
        return jnp.moveaxis(jnp.moveaxis(t, 3, 2), 1, 0)

    qc = to_chunks(q.astype(F32))
    kc = to_chunks(k.astype(F32) * (M_DQK ** -0.5))
    vc = to_chunks(v.astype(F32))
    li = to_chunks(i_pre.astype(F32))
    lf = to_chunks(jax.nn.log_sigmoid(f_pre.astype(F32)))
    causal = jnp.tril(jnp.ones((M_CHUNK, M_CHUNK), dtype=bool))

    def step(carry, inp):
        C, n, m = carry
        qb, kb, vb, lib, lfb = inp
        b = jnp.cumsum(lfb, axis=-1)
        g = b[..., -1]
        log_d = jnp.where(causal, b[..., :, None] - b[..., None, :] + lib[..., None, :], -jnp.inf)
        log_inter = b + m[..., None]
        m_t = jnp.maximum(jnp.max(log_d, -1), log_inter)
        w_intra = jnp.exp(log_d - m_t[..., None])
        w_inter = jnp.exp(log_inter - m_t)
        s = jnp.einsum('bhtd,bhsd->bhts', qb, kb) * w_intra
        num = jnp.einsum('bhts,bhsv->bhtv', s, vb) + w_inter[..., None] * jnp.einsum('bhtd,bhdv->bhtv', qb, C)
        den = jnp.sum(s, -1) + w_inter * jnp.einsum('bhtd,bhd->bht', qb, n)
        h = num / jnp.maximum(jnp.abs(den), jnp.exp(-m_t))[..., None]
        log_ws = g[..., None] - b + lib
        m_new = jnp.maximum(g + m, jnp.max(log_ws, -1))
        a_prev = jnp.exp(g + m - m_new)
        ws = jnp.exp(log_ws - m_new[..., None])
        C_new = a_prev[..., None, None] * C + jnp.einsum('bhsd,bhsv->bhdv', kb * ws[..., None], vb)
        n_new = a_prev[..., None] * n + jnp.einsum('bhs,bhsd->bhd', ws, kb)
        return (C_new, n_new, m_new), h

    init = (jnp.zeros((B_, M_HEADS, M_DQK, M_DV), F32),
            jnp.zeros((B_, M_HEADS, M_DQK), F32),
            jnp.zeros((B_, M_HEADS), F32))
    _, hs = lax.scan(step, init, (qc, kc, vc, li, lf))
    h = jnp.swapaxes(jnp.moveaxis(hs, 0, 1), 2, 3).reshape(B_, S_, M_HEADS, M_DV)
    mu = jnp.mean(h, -1, keepdims=True)
    var = jnp.mean(jnp.square(h - mu), -1, keepdims=True)
    h = ((h - mu) * lax.rsqrt(var + NORM_EPS)).reshape(B_, S_, M_HEADS * M_DV) * norm_w.astype(F32)
    return (jax.nn.sigmoid(o_pre.astype(F32)) * h).astype(q.dtype)


def causal_depthwise_conv(u, w, b):
    out = lax.conv_general_dilated(u, w.astype(u.dtype), window_strides=(1,), padding=[(S_CONV - 1, 0)],
                                   dimension_numbers=('NWC', 'WIO', 'NWC'),
                                   feature_group_count=u.shape[-1])
    return out + b.astype(u.dtype)


def ssd_mixer(z, xbc, dt_raw, conv_w, conv_b, dt_bias, a_log, d_skip, norm_w):
    B_, S_ = z.shape[:2]
    xbc = jax.nn.silu(causal_depthwise_conv(xbc, conv_w, conv_b)).astype(F32)
    xs, bm, cm = jnp.split(xbc, [S_DINNER, S_DINNER + S_GROUPS * S_DSTATE], axis=-1)
    xs = xs.reshape(B_, S_, S_GROUPS, S_HPG, S_HEADDIM)
    dt = jax.nn.softplus(dt_raw.astype(F32) + dt_bias.astype(F32)).reshape(B_, S_, S_GROUPS, S_HPG)
    a = -jnp.exp(a_log.astype(F32)).reshape(S_GROUPS, S_HPG)
    nc = S_ // S_CHUNK
    xc = (xs * dt[..., None]).reshape(B_, nc, S_CHUNK, S_GROUPS, S_HPG, S_HEADDIM)
    bc = bm.reshape(B_, nc, S_CHUNK, S_GROUPS, S_DSTATE)
    cc = cm.reshape(B_, nc, S_CHUNK, S_GROUPS, S_DSTATE)
    acum = jnp.cumsum((dt * a).reshape(B_, nc, S_CHUNK, S_GROUPS, S_HPG), axis=2)
    causal = jnp.tril(jnp.ones((S_CHUNK, S_CHUNK), dtype=bool))[None, None, :, :, None, None]
    decay = jnp.exp(jnp.where(causal, acum[:, :, :, None] - acum[:, :, None, :], -jnp.inf))
    cb = jnp.einsum('bclgn,bcsgn->bclsg', cc, bc)
    y_diag = jnp.einsum('bclsgh,bcsghp->bclghp', cb[..., None] * decay, xc)
    decay_states = jnp.exp(acum[:, :, -1:] - acum)
    states = jnp.einsum('bclgn,bclghp->bcghpn', bc, decay_states[..., None] * xc)
    chunk_decay = jnp.exp(acum[:, :, -1])

    def step(hstate, inp):
        st, dec = inp
        return dec[..., None, None] * hstate + st, hstate

    h0 = jnp.zeros((B_, S_GROUPS, S_HPG, S_HEADDIM, S_DSTATE), F32)
    _, prev = lax.scan(step, h0, (jnp.moveaxis(states, 1, 0), jnp.moveaxis(chunk_decay, 1, 0)))
    prev = jnp.moveaxis(prev, 0, 1)
    y_off = jnp.einsum('bclgn,bcghpn->bclghp', cc, prev) * jnp.exp(acum)[..., None]
    y = (y_diag + y_off).reshape(B_, S_, S_GROUPS, S_HPG, S_HEADDIM) \
        + d_skip.astype(F32).reshape(S_GROUPS, S_HPG)[..., None] * xs
    y = y.reshape(B_, S_, S_DINNER) * jax.nn.silu(z.astype(F32))
    yg = y.reshape(B_, S_, S_GROUPS, S_DINNER // S_GROUPS)
    yg = yg * lax.rsqrt(jnp.mean(jnp.square(yg), -1, keepdims=True) + NORM_EPS)
    return (yg.reshape(B_, S_, S_DINNER) * norm_w.astype(F32)).astype(z.dtype)


def rope(x, pos):
    half = x.shape[-1] // 2
    freqs = ROPE_THETA ** (-jnp.arange(half, dtype=F32) / half)
    ang = pos.astype(F32)[:, None] * freqs[None, :]
    cos = jnp.cos(ang)[None, :, None, :]
    sin = jnp.sin(ang)[None, :, None, :]
    x1, x2 = x[..., :half], x[..., half:]
    return jnp.concatenate([x1 * cos - x2 * sin, x2 * cos + x1 * sin], axis=-1)


def swa_mixer(q, k, v, sinks):
    B_, S_ = q.shape[:2]
    pos = jnp.arange(S_)
    q = rope(q.astype(F32), pos)
    k = rope(k.astype(F32), pos)
    v = v.astype(F32)
    nb = S_ // A_BLOCK
    qb = q.reshape(B_, nb, A_BLOCK, A_KVHEADS, A_REP, A_HEADDIM)

    def with_prev(t):
        t = t.reshape(B_, nb, A_BLOCK, A_KVHEADS, A_HEADDIM)
        prev = jnp.pad(t[:, :-1], ((0, 0), (1, 0), (0, 0), (0, 0), (0, 0)))
        return jnp.concatenate([prev, t], axis=2)

    kk, vv = with_prev(k), with_prev(v)
    s = jnp.einsum('bnqgrd,bnkgd->bngrqk', qb, kk) * (A_HEADDIM ** -0.5)
    qi = jnp.arange(A_BLOCK)[:, None] + A_BLOCK
    ki = jnp.arange(2 * A_BLOCK)[None, :]
    rel = qi - ki
    band = (rel >= 0) & (rel < A_WINDOW)
    valid = band[None] & ((jnp.arange(nb)[:, None, None] > 0) | (ki >= A_BLOCK)[None])
    s = jnp.where(valid[None, :, None, None], s, -jnp.inf)
    sink = sinks.astype(F32).reshape(A_KVHEADS, A_REP)[None, None, :, :, None]
    m = jnp.maximum(jnp.max(s, -1), sink)
    p = jnp.exp(s - m[..., None])
    den = jnp.sum(p, -1) + jnp.exp(sink - m)
    o = jnp.einsum('bngrqk,bnkgd->bnqgrd', p, vv) / jnp.transpose(den, (0, 1, 4, 2, 3))[..., None]
    return o.reshape(B_, S_, A_QHEADS * A_HEADDIM)


def peer_ffn(x, wq, subkeys, u_tab, v_tab):
    B_, S_, D = x.shape
    T = B_ * S_
    xt = x.reshape(T, D)
    q = (xt @ wq).astype(F32).reshape(T, P_HEADS, 2, P_DKEY // 2)
    s = jnp.einsum('thcd,hckd->thck', q, subkeys.astype(F32))
    top_v, top_i = lax.top_k(s, P_TOPK)
    cand_v = top_v[:, :, 0, :, None] + top_v[:, :, 1, None, :]
    cand_i = top_i[:, :, 0, :, None] * P_NKEYS + top_i[:, :, 1, None, :]
    best_v, best_j = lax.top_k(cand_v.reshape(T, P_HEADS, P_TOPK * P_TOPK), P_TOPK)
    ids = jnp.take_along_axis(cand_i.reshape(T, P_HEADS, P_TOPK * P_TOPK), best_j, axis=-1)
    gates = jax.nn.softmax(best_v, axis=-1)
    nchunk = T // P_CHUNK

    def expert_block(args):
        xc, idc, gc = args
        u = jnp.take(u_tab, idc, axis=0)
        act = jax.nn.gelu(jnp.einsum('td,ted->te', xc, u).astype(F32), approximate=False)
        vsel = jnp.take(v_tab, idc, axis=0)
        return jnp.einsum('te,ted->td', (gc * act).astype(vsel.dtype), vsel)

    out = lax.map(expert_block, (xt.reshape(nchunk, P_CHUNK, D),
                                 ids.reshape(nchunk, P_CHUNK, P_HEADS * P_TOPK),
                                 gates.reshape(nchunk, P_CHUNK, P_HEADS * P_TOPK)))
    return out.reshape(B_, S_, D).astype(x.dtype)


def setup_inputs(seed: int = 0) -> dict:
    key = jax.random.key(seed)
    ks = jax.random.split(key, 26)
    L, D = DEPTH, D_MODEL
    beta = (8.0 * DEPTH) ** -0.25
    nrm = lambda k, shape, scale: jax.random.normal(k, shape, F32) * scale
    dt0 = jnp.exp(jax.random.uniform(ks[7], (L, S_HEADS), F32, math.log(1e-3), math.log(1e-1)))
    return {
        "x": nrm(ks[0], (BATCH, SEQ, D), 1.0),
        "w_in": nrm(ks[1], (L, D, IN_COLS), D ** -0.5),
        "mlstm_gate_b": jnp.stack([nrm(ks[2], (L, M_HEADS), 0.1),
                                   3.0 + 3.0 * jax.random.uniform(ks[3], (L, M_HEADS), F32)], axis=1),
        "mlstm_norm_w": 1.0 + nrm(ks[4], (L, M_HEADS * M_DV), 0.02),
        "ssm_conv_w": nrm(ks[5], (L, S_CONV, 1, S_CONV_CH), S_CONV ** -0.5),
        "ssm_conv_b": nrm(ks[6], (L, S_CONV_CH), 0.02),
        "ssm_dt_bias": dt0 + jnp.log(-jnp.expm1(-dt0)),
        "ssm_a_log": jnp.log(jax.random.uniform(ks[8], (L, S_HEADS), F32, 1.0, 16.0)),
        "ssm_d": 1.0 + nrm(ks[9], (L, S_HEADS), 0.02),
        "ssm_norm_w": 1.0 + nrm(ks[10], (L, S_DINNER), 0.02),
        "swa_sinks": nrm(ks[11], (L, A_QHEADS), 1.0),
        "merge_gate_b": nrm(ks[12], (L, N_BRANCH, D), 0.02),
        "w_branch": nrm(ks[13], (L, N_BRANCH, BRANCH_WIDTH, D), beta * BRANCH_WIDTH ** -0.5),
        "w_out": nrm(ks[14], (L, D, D), beta * D ** -0.5),
        "ln1_g": 1.0 + nrm(ks[15], (L, D), 0.02),
        "ln1_b": nrm(ks[16], (L, D), 0.02),
        "peer_wq": nrm(ks[17], (L, D, P_HEADS * P_DKEY), D ** -0.5),
        "peer_subkeys": nrm(ks[18], (L, P_HEADS, 2, P_NKEYS, P_DKEY // 2), (P_DKEY // 2) ** -0.5),
        "peer_u": nrm(ks[19], (L, P_EXPERTS, D), D ** -0.5),
        "peer_v": nrm(ks[20], (L, P_EXPERTS, D), beta * P_HEADS ** -0.5),
        "ln2_g": 1.0 + nrm(ks[21], (L, D), 0.02),
        "ln2_b": nrm(ks[22], (L, D), 0.02),
    }


def reference(x, w_in, mlstm_gate_b, mlstm_norm_w, ssm_conv_w, ssm_conv_b, ssm_dt_bias, ssm_a_log,
              ssm_d, ssm_norm_w, swa_sinks, merge_gate_b, w_branch, w_out, ln1_g, ln1_b,
              peer_wq, peer_subkeys, peer_u, peer_v, ln2_g, ln2_b):
    alpha = (2.0 * DEPTH) ** 0.25
    B_, S_, D = x.shape
    split_points = _in_split_points()
    for l in range(DEPTH):
        proj = x @ w_in[l]
        (mq, mk, mv, mo, mi, mf, sz, sxbc, sdt, aq, ak, av, gpre) = jnp.split(proj, split_points, axis=-1)
        y_m = mlstm_mixer(mq.reshape(B_, S_, M_HEADS, M_DQK), mk.reshape(B_, S_, M_HEADS, M_DQK),
                          mv.reshape(B_, S_, M_HEADS, M_DV), mo,
                          mi + mlstm_gate_b[l, 0], mf + mlstm_gate_b[l, 1], mlstm_norm_w[l])
        y_s = ssd_mixer(sz, sxbc, sdt, ssm_conv_w[l], ssm_conv_b[l], ssm_dt_bias[l], ssm_a_log[l],
                        ssm_d[l], ssm_norm_w[l])
        y_a = swa_mixer(aq.reshape(B_, S_, A_QHEADS, A_HEADDIM), ak.reshape(B_, S_, A_KVHEADS, A_HEADDIM),
                        av.reshape(B_, S_, A_KVHEADS, A_HEADDIM), swa_sinks[l]).astype(x.dtype)
        gates = jax.nn.sigmoid(gpre.reshape(B_, S_, N_BRANCH, D) + merge_gate_b[l])
        mix = (gates[:, :, 0] * (y_m @ w_branch[l, 0])
               + gates[:, :, 1] * (y_s @ w_branch[l, 1])
               + gates[:, :, 2] * (y_a @ w_branch[l, 2]))
        x = layer_norm(alpha * x + mix @ w_out[l], ln1_g[l], ln1_b[l])
        x = layer_norm(alpha * x + peer_ffn(x, peer_wq[l], peer_subkeys[l], peer_u[l], peer_v[l]),
                       ln2_g[l], ln2_b[l])
    return x
```

```cpp
#include <hip/hip_runtime.h>
#include <cstdio>
#include <cstdint>
#include <cstring>

namespace pg8 {
#define PG8_LAS __attribute__((address_space(3)))
typedef unsigned short bf16_t;
typedef short bf16x8 __attribute__((ext_vector_type(8)));
typedef float f32x4 __attribute__((ext_vector_type(4)));
typedef unsigned u32x4 __attribute__((ext_vector_type(4)));
constexpr int BM = 256, BK = 64, HALF = 128, HTB = HALF * BK * 2  , STAGE_BYTES = 8 * HTB, NXCD = 8, WGM = 8;

__host__ __device__ __forceinline__ int lds_byte(int r, int c) { const int st = (r >> 4) * 2 + (c >> 5), rr = r & 15, cc = c & 31, ob = rr * 64 + cc * 2; return st * 1024 + (ob ^ (((ob >> 9) & 1) << 5)); }
__host__ __device__ __forceinline__ void stage_rc(int b, int& R, int& C) { const int st = b / 1024, sb = b % 1024, swz = sb ^ (((sb >> 9) & 1) << 5); R = (st >> 1) * 16 + swz / 64; C = (st & 1) * 32 + (swz % 64) / 2; }
__host__ __device__ __forceinline__ int perm32(int rho) { const int n = rho >> 4, i = rho & 15; return 8 * (i >> 2) + 4 * n + (i & 3); }

struct Unit { int pm, pn; };
struct Gemm { const bf16_t* A; const bf16_t* Bt; int M, N, K; };

struct StaticOrder {
    int nM, nN, nwg, G, c;
    __host__ __device__ void init(int M, int N, int G_, int c_) { nM = M / BM; nN = N / BM; nwg = nM * nN; G = G_; c = c_; }
    __host__ __device__ bool next(int i, Unit& u) const {
        const long L = (long)i * G + c; if (L >= nwg) return false;
        int wgid = (int)L; { const int q = nwg / NXCD, r = nwg % NXCD, xcd = wgid % NXCD, off = wgid / NXCD; wgid = (xcd < r ? xcd * (q + 1) : r * (q + 1) + (xcd - r) * q) + off; }
        const int nig = WGM * nN, gid = wgid / nig, fm = gid * WGM, gsz = (nM - fm) < WGM ? (nM - fm) : WGM;
        u.pm = fm + ((wgid % nig) % gsz); u.pn = (wgid % nig) / gsz; return true;
    }
    __device__ __forceinline__ void a_ready(const Unit&) const {}
    __device__ __forceinline__ void done(const Unit&) const {}
};

__device__ __forceinline__ unsigned cvt_pk_bf16(float lo, float hi) { unsigned r; asm volatile("v_cvt_pk_bf16_f32 %0, %1, %2" : "=v"(r) : "v"(lo), "v"(hi)); return r; }
typedef float f32x2 __attribute__((ext_vector_type(2)));
__device__ __forceinline__ float bf_lo(unsigned w) { return __uint_as_float(w << 16); }
__device__ __forceinline__ float bf_hi(unsigned w) { return __uint_as_float(w & 0xffff0000u); }
__device__ __forceinline__ float sigmoidf_(float x) { return 1.0f / (1.0f + __expf(-x)); }

struct EpiF32 {
    static constexpr bool PERM = false, AFTER_DRAIN = false;
    float* C; int ldc; int pad;
    __device__ __forceinline__ void operator()(const f32x4 (&acc)[2][2][4][2], const Unit& u, int wr, int wc, int fr, int fq) const {
        const int row0 = u.pm * BM + wr * 64 + fr, col0 = u.pn * BM + wc * 32 + 4 * fq;
#pragma unroll
        for (int ai = 0; ai < 2; ++ai)
#pragma unroll
            for (int m = 0; m < 4; ++m) { float* rowp = C + (size_t)(row0 + ai * HALF + m * 16) * ldc + col0;
#pragma unroll
                for (int bj = 0; bj < 2; ++bj)
#pragma unroll
                    for (int n = 0; n < 2; ++n) *(f32x4*)(rowp + bj * HALF + n * 16) = acc[ai][bj][m][n]; }
    }
};
struct EpiResid {
    static constexpr bool PERM = false, AFTER_DRAIN = false;
    float* C; const float* X; int ldc; float alpha;
    __device__ __forceinline__ void operator()(const f32x4 (&acc)[2][2][4][2], const Unit& u, int wr, int wc, int fr, int fq) const {
        const int row0 = u.pm * BM + wr * 64 + fr, col0 = u.pn * BM + wc * 32 + 4 * fq;
#pragma unroll
        for (int ai = 0; ai < 2; ++ai)
#pragma unroll
            for (int m = 0; m < 4; ++m) { const size_t off = (size_t)(row0 + ai * HALF + m * 16) * ldc + col0;
#pragma unroll
                for (int bj = 0; bj < 2; ++bj)
#pragma unroll
                    for (int n = 0; n < 2; ++n) { const f32x4 xv = *(const f32x4*)(X + off + bj * HALF + n * 16);
                        *(f32x4*)(C + off + bj * HALF + n * 16) = acc[ai][bj][m][n] + xv * alpha; } }
    }
};
struct EpiProj {
    static constexpr bool PERM = true, AFTER_DRAIN = false;
    bf16_t* O; const float* bias; float* small; int ldc; int gate_lo; int small_tile; int pad;
    __device__ __forceinline__ void operator()(const f32x4 (&acc)[2][2][4][2], const Unit& u, int wr, int wc, int fr, int fq) const {
        const int row0 = u.pm * BM + wr * 64 + fr, col0 = u.pn * BM + wc * 32 + 8 * fq;
        if (u.pn == small_tile) {
            if (wc == 0) {
#pragma unroll
                for (int ai = 0; ai < 2; ++ai)
#pragma unroll
                    for (int m = 0; m < 4; ++m) { float* p = small + (size_t)(row0 + ai * HALF + m * 16) * 32 + 8 * fq;
                        *(f32x4*)p = acc[ai][0][m][0]; *(f32x4*)(p + 4) = acc[ai][0][m][1]; }
            }
            return;
        }
        const bool gate = u.pn >= gate_lo;
        f32x4 bv[2][2];
#pragma unroll
        for (int bj = 0; bj < 2; ++bj)
#pragma unroll
            for (int n = 0; n < 2; ++n) bv[bj][n] = gate ? *(const f32x4*)(bias + col0 + bj * HALF + 4 * n) : (f32x4){0.f, 0.f, 0.f, 0.f};
#pragma unroll
        for (int ai = 0; ai < 2; ++ai)
#pragma unroll
            for (int m = 0; m < 4; ++m) { bf16_t* rowp = O + (size_t)(row0 + ai * HALF + m * 16) * ldc + col0;
#pragma unroll
                for (int bj = 0; bj < 2; ++bj) { f32x4 v0 = acc[ai][bj][m][0] + bv[bj][0], v1 = acc[ai][bj][m][1] + bv[bj][1];
                    if (gate) {
#pragma unroll
                        for (int j = 0; j < 4; ++j) { v0[j] = sigmoidf_(v0[j]); v1[j] = sigmoidf_(v1[j]); } }
                    u32x4 w; w.x = cvt_pk_bf16(v0[0], v0[1]); w.y = cvt_pk_bf16(v0[2], v0[3]); w.z = cvt_pk_bf16(v1[0], v1[1]); w.w = cvt_pk_bf16(v1[2], v1[3]);
                    *(u32x4*)(rowp + bj * HALF) = w; } }
    }
};
template <int FIRST> struct EpiMix {
    static constexpr bool PERM = true, AFTER_DRAIN = false;
    bf16_t* O; const bf16_t* G; int ldc; int ldg;
    __device__ __forceinline__ void operator()(const f32x4 (&acc)[2][2][4][2], const Unit& u, int wr, int wc, int fr, int fq) const {
        const int row0 = u.pm * BM + wr * 64 + fr, col0 = u.pn * BM + wc * 32 + 8 * fq;
#pragma unroll
        for (int ai = 0; ai < 2; ++ai)
#pragma unroll
            for (int m = 0; m < 4; ++m) { const int row = row0 + ai * HALF + m * 16; bf16_t* rowp = O + (size_t)row * ldc + col0; const bf16_t* gp = G + (size_t)row * ldg + col0;
#pragma unroll
                for (int bj = 0; bj < 2; ++bj) { const u32x4 gw = *(const u32x4*)(gp + bj * HALF); u32x4 ow = (u32x4){0u, 0u, 0u, 0u}; if (!FIRST) ow = *(const u32x4*)(rowp + bj * HALF);
                    const f32x4 a0 = acc[ai][bj][m][0], a1 = acc[ai][bj][m][1];
                    float r0 = bf_lo(ow.x) + bf_lo(gw.x) * a0[0], r1 = bf_hi(ow.x) + bf_hi(gw.x) * a0[1], r2 = bf_lo(ow.y) + bf_lo(gw.y) * a0[2], r3 = bf_hi(ow.y) + bf_hi(gw.y) * a0[3];
                    float r4 = bf_lo(ow.z) + bf_lo(gw.z) * a1[0], r5 = bf_hi(ow.z) + bf_hi(gw.z) * a1[1], r6 = bf_lo(ow.w) + bf_lo(gw.w) * a1[2], r7 = bf_hi(ow.w) + bf_hi(gw.w) * a1[3];
                    u32x4 w; w.x = cvt_pk_bf16(r0, r1); w.y = cvt_pk_bf16(r2, r3); w.z = cvt_pk_bf16(r4, r5); w.w = cvt_pk_bf16(r6, r7);
                    *(u32x4*)(rowp + bj * HALF) = w; } }
    }
};

template <class Epi, class Sched, bool ALIGN_EPI = false, bool SP2 = false>
__device__ __forceinline__ void gemm_phase(PG8_LAS unsigned char* lds, const Gemm g, const Sched& S, const Epi& E) {
    const int tid = threadIdx.x, wid = __builtin_amdgcn_readfirstlane(tid >> 6), lane = tid & 63, wr = wid >> 2, wc = wid & 3, fr = lane & 15, fq = lane >> 4;
    const int K = g.K, nt = K / BK;
    unsigned voffA[2], voffB[2];
#pragma unroll
    for (int i = 0; i < 2; ++i) { int R, C; stage_rc(tid * 16 + i * 8192, R, C); const int Rb = Epi::PERM ? ((R & ~31) + perm32(R & 31)) : R;
        voffA[i] = (unsigned)(R * K + C) * 2u; voffB[i] = (unsigned)(Rb * K + C) * 2u; }
    const size_t kstep = (size_t)(BK * 2);
    const size_t hstep = (size_t)HALF * K * 2;
    const size_t tstep = 2 * hstep;
    const unsigned ldsw = (unsigned)wid * 1024u;
    const int aoff = lds_byte(wr * 64 + fr, fq * 8), boff = lds_byte(wc * 32 + fr, fq * 8);
#define PG8_SA(b, h) (((b) * 2 + (h)) * HTB)
#define PG8_SB(b, h) ((4 + (b) * 2 + (h)) * HTB)
#define PG8_STAGE(bufoff, gbase, voff) do { _Pragma("unroll") for (int _i = 0; _i < 2; ++_i) \
        __builtin_amdgcn_global_load_lds((const unsigned*)((const char*)(gbase) + (voff)[_i]), (PG8_LAS unsigned*)(lds + (bufoff) + ldsw + _i * 8192), 16, 0, 0); } while (0)
#define PG8_LDA(dst, b, h) do { _Pragma("unroll") for (int m = 0; m < 4; ++m) _Pragma("unroll") for (int k = 0; k < 2; ++k) dst[m][k] = *(const PG8_LAS bf16x8*)(lds + PG8_SA(b, h) + aoff + m * 2048 + k * 1024); } while (0)
#define PG8_LDB(dst, b, h) do { _Pragma("unroll") for (int n = 0; n < 2; ++n) _Pragma("unroll") for (int k = 0; k < 2; ++k) dst[n][k] = *(const PG8_LAS bf16x8*)(lds + PG8_SB(b, h) + boff + n * 2048 + k * 1024); } while (0)
#define PG8_MMA(ai, bj, At, Bt) do { __builtin_amdgcn_s_setprio(1); _Pragma("unroll") for (int m = 0; m < 4; ++m) _Pragma("unroll") for (int n = 0; n < 2; ++n) _Pragma("unroll") for (int k = 0; k < 2; ++k) \
        acc[ai][bj][m][n] = __builtin_amdgcn_mfma_f32_16x16x32_bf16(Bt[n][k], At[m][k], acc[ai][bj][m][n], 0, 0, 0); __builtin_amdgcn_s_setprio(0); } while (0)
#define PG8_WAIT_V(n) asm volatile("s_waitcnt vmcnt(" #n ")" ::: "memory")
#define PG8_WAIT_L(n) asm volatile("s_waitcnt lgkmcnt(" #n ")" ::: "memory")
#define PG8_BAR __builtin_amdgcn_s_barrier()
#define PG8_SCHED __builtin_amdgcn_sched_barrier(0)
    Unit cur, nxt; int ui = 0;
    if (!S.next(0, cur)) return;
    f32x4 acc[2][2][4][2];
#pragma unroll
    for (int a = 0; a < 2; ++a)
#pragma unroll
        for (int b = 0; b < 2; ++b)
#pragma unroll
            for (int m = 0; m < 4; ++m)
#pragma unroll
                for (int n = 0; n < 2; ++n) acc[a][b][m][n] = (f32x4){0.f, 0.f, 0.f, 0.f};
    bf16x8 At[4][2], B0[2][2], B1[2][2];
    const char* cA = (const char*)g.A + (size_t)cur.pm * tstep; const char* cB = (const char*)g.Bt + (size_t)cur.pn * tstep;
    S.a_ready(cur);
    if constexpr (SP2) {
        PG8_STAGE(PG8_SB(0, 0), cB, voffB); PG8_STAGE(PG8_SB(0, 1), cB + hstep, voffB); PG8_STAGE(PG8_SA(0, 0), cA, voffA); PG8_STAGE(PG8_SA(0, 1), cA + hstep, voffA);
        if (wr == 1) PG8_BAR;
        PG8_WAIT_V(2); PG8_BAR;
        PG8_STAGE(PG8_SB(1, 0), cB + kstep, voffB); PG8_STAGE(PG8_SA(1, 0), cA + kstep, voffA); PG8_STAGE(PG8_SB(1, 1), cB + hstep + kstep, voffB);
        PG8_WAIT_V(6); PG8_BAR;
    } else {
        PG8_STAGE(PG8_SB(0, 0), cB, voffB); PG8_STAGE(PG8_SA(0, 0), cA, voffA); PG8_STAGE(PG8_SB(0, 1), cB + hstep, voffB); PG8_STAGE(PG8_SA(0, 1), cA + hstep, voffA);
        if (wr == 1) PG8_BAR;
        PG8_WAIT_V(4); PG8_BAR;
        PG8_STAGE(PG8_SB(1, 0), cB + kstep, voffB); PG8_STAGE(PG8_SA(1, 0), cA + kstep, voffA); PG8_STAGE(PG8_SB(1, 1), cB + hstep + kstep, voffB);
        PG8_WAIT_V(6); PG8_BAR;
    }
    for (;;) {
        const bool has_next = S.next(ui + 1, nxt);
        const char* nA = has_next ? (const char*)g.A + (size_t)nxt.pm * tstep : cA; const char* nB = has_next ? (const char*)g.Bt + (size_t)nxt.pn * tstep : cB;
        for (int t = 0; t < nt; t += 2) {
            const bool last = (t == nt - 2);
            const char* a1 = cA + (size_t)(t + 1) * kstep;
            const char* a2 = last ? nA : cA + (size_t)(t + 2) * kstep; const char* b2 = last ? nB : cB + (size_t)(t + 2) * kstep;
            const char* a3 = a2 + kstep; const char* b3 = b2 + kstep;
            if (last && has_next) S.a_ready(nxt);
            if constexpr (SP2) {
            PG8_LDB(B0, 0, 0); PG8_LDB(B1, 0, 1); PG8_SCHED; PG8_LDA(At, 0, 0); PG8_STAGE(PG8_SA(1, 1), a1 + hstep, voffA);
            PG8_WAIT_V(8); PG8_WAIT_L(0); PG8_BAR; PG8_MMA(0, 0, At, B0); PG8_MMA(0, 1, At, B1); PG8_BAR; PG8_SCHED;
            PG8_LDA(At, 0, 1); PG8_STAGE(PG8_SB(0, 0), b2, voffB); PG8_STAGE(PG8_SB(0, 1), b2 + hstep, voffB); PG8_STAGE(PG8_SA(0, 0), a2, voffA);
            PG8_WAIT_V(8); PG8_WAIT_L(0); PG8_BAR; PG8_MMA(1, 0, At, B0); PG8_MMA(1, 1, At, B1); PG8_BAR; PG8_SCHED;
            PG8_LDB(B0, 1, 0); PG8_LDB(B1, 1, 1); PG8_SCHED; PG8_LDA(At, 1, 0); PG8_STAGE(PG8_SA(0, 1), a2 + hstep, voffA);
            PG8_WAIT_V(8); PG8_WAIT_L(0); PG8_BAR; PG8_MMA(0, 0, At, B0); PG8_MMA(0, 1, At, B1); PG8_BAR; PG8_SCHED;
            PG8_LDA(At, 1, 1); PG8_STAGE(PG8_SB(1, 0), b3, voffB); PG8_STAGE(PG8_SB(1, 1), b3 + hstep, voffB); PG8_STAGE(PG8_SA(1, 0), a3, voffA);
            PG8_WAIT_V(8); PG8_WAIT_L(0); PG8_BAR; PG8_MMA(1, 0, At, B0); PG8_MMA(1, 1, At, B1); PG8_BAR; PG8_SCHED;
            } else {
            PG8_LDB(B0, 0, 0); PG8_SCHED; PG8_LDA(At, 0, 0); PG8_STAGE(PG8_SA(1, 1), a1 + hstep, voffA);
            PG8_WAIT_L(8); PG8_BAR; PG8_WAIT_L(0); PG8_MMA(0, 0, At, B0); PG8_BAR; PG8_SCHED;
            PG8_LDB(B1, 0, 1); PG8_STAGE(PG8_SB(0, 0), b2, voffB);
            PG8_BAR; PG8_WAIT_L(0); PG8_MMA(0, 1, At, B1); PG8_BAR;
            PG8_LDA(At, 0, 1); PG8_STAGE(PG8_SA(0, 0), a2, voffA);
            PG8_BAR; PG8_WAIT_L(0); PG8_MMA(1, 0, At, B0); PG8_BAR; PG8_SCHED;
            PG8_STAGE(PG8_SB(0, 1), b2 + hstep, voffB);
            PG8_WAIT_V(6); PG8_BAR; PG8_MMA(1, 1, At, B1); PG8_BAR;
            PG8_LDB(B0, 1, 0); PG8_SCHED; PG8_LDA(At, 1, 0); PG8_STAGE(PG8_SA(0, 1), a2 + hstep, voffA);
            PG8_WAIT_L(8); PG8_BAR; PG8_WAIT_L(0); PG8_MMA(0, 0, At, B0); PG8_BAR; PG8_SCHED;
            PG8_LDB(B1, 1, 1); PG8_STAGE(PG8_SB(1, 0), b3, voffB);
            PG8_BAR; PG8_WAIT_L(0); PG8_MMA(0, 1, At, B1); PG8_BAR;
            PG8_LDA(At, 1, 1); PG8_STAGE(PG8_SA(1, 0), a3, voffA);
            PG8_BAR; PG8_WAIT_L(0); PG8_MMA(1, 0, At, B0); PG8_BAR; PG8_SCHED;
            PG8_STAGE(PG8_SB(1, 1), b3 + hstep, voffB);
            PG8_WAIT_V(6); PG8_BAR; PG8_MMA(1, 1, At, B1); PG8_BAR;
            }
        }
        if constexpr (ALIGN_EPI) { if (wr == 0) PG8_BAR; }
        if constexpr (!Epi::AFTER_DRAIN) { E(acc, cur, wr, wc, fr, fq); S.done(cur); }
        if (!has_next) break;
#pragma unroll
        for (int a = 0; a < 2; ++a)
#pragma unroll
            for (int b = 0; b < 2; ++b)
#pragma unroll
                for (int m = 0; m < 4; ++m)
#pragma unroll
                    for (int n = 0; n < 2; ++n) acc[a][b][m][n] = (f32x4){0.f, 0.f, 0.f, 0.f};
        cur = nxt; cA = nA; cB = nB; ++ui;
        if constexpr (ALIGN_EPI) { if (wr == 1) PG8_BAR; }
    }
    PG8_WAIT_V(0);
    if constexpr (!ALIGN_EPI) { if (wr == 0) PG8_BAR; }
    PG8_BAR;
    if constexpr (Epi::AFTER_DRAIN) { E.fused(acc, cur, wr, wc, fr, fq, lds, wid, lane); S.done(cur); }
#undef PG8_SA
#undef PG8_SB
#undef PG8_STAGE
#undef PG8_LDA
#undef PG8_LDB
#undef PG8_MMA
#undef PG8_WAIT_V
#undef PG8_WAIT_L
#undef PG8_BAR
#undef PG8_SCHED
}
}
typedef unsigned short bf16;
constexpr int T_TOK = 32768, DM = 2048, SEQ = 4096, NBATCH = 8, DEPTH = 4;
constexpr int IN_COLS = 13336, NP = 13568;
constexpr int C_MQ = 0, C_MK = 512, C_MV = 1024, C_MO = 2048, C_SZ = 3072, C_SXBC = 4096, C_AQ = 5632, C_AK = 6656, C_AV = 6912, C_G = 7168, C_SMALL = 13312;
constexpr int GATE_TILE_LO = C_G / 256, SMALL_TILE = C_SMALL / 256;
constexpr float ALPHA = 1.681792830507429f;
constexpr int P_EXPERTS = 16384;

constexpr size_t MiB = 1u << 20;
constexpr size_t WS_CTL = 0, WS_WIN = 1 * MiB, WS_WB = 54 * MiB, WS_WO = 66 * MiB, WS_WQ = 74 * MiB, WS_BIAS = 82 * MiB, WS_SMALL = 83 * MiB,
                 WS_XB = 88 * MiB, WS_BUFB = 216 * MiB, WS_PROJ = 472 * MiB, WS_R1 = 1320 * MiB, WS_Y = 1480 * MiB, WS_R2 = 1672 * MiB, WS_END = 1864 * MiB;
constexpr size_t WS_QF = WS_PROJ, WS_IDS = WS_PROJ + 256 * MiB, WS_GATES = WS_PROJ + 272 * MiB;

__device__ __forceinline__ unsigned f2bf(float f) { unsigned u = __float_as_uint(f); return (u + 0x7fffu + ((u >> 16) & 1u)) >> 16; }
__device__ __forceinline__ float bf2f(bf16 b) { return __uint_as_float(((unsigned)b) << 16); }
__device__ __forceinline__ float sigm(float x) { return 1.0f / (1.0f + expf(-x)); }
__device__ __forceinline__ float wave_sum(float v) {
#pragma unroll
    for (int o = 1; o < 64; o <<= 1) v += __shfl_xor(v, o);
    return v;
}
__device__ __forceinline__ int src_col(int n) {
    if (n < 3072) return n;
    if (n < 5632) return n + 8;
    if (n < 13312) return n + 24;
    if (n < 13320) return 3072 + (n - 13312);
    if (n < 13336) return 5640 + (n - 13320);
    return -1;
}

__global__ __launch_bounds__(256) void k_transpose(const float* __restrict__ W, int ldw, int K, int ndst, int mode, bf16* __restrict__ WT) {
    __shared__ float tile[64][65];
    const int nb = ndst / 64, kb = blockIdx.x / nb, nbi = blockIdx.x % nb, k0 = kb * 64, n0 = nbi * 64, tid = threadIdx.x;
#pragma unroll
    for (int i = 0; i < 16; ++i) { const int kk = i * 4 + (tid >> 6), nn = tid & 63, n = n0 + nn; const int sc = mode ? src_col(n) : n;
        tile[kk][nn] = sc >= 0 ? W[(size_t)(k0 + kk) * ldw + sc] : 0.f; }
    __syncthreads();
    const int n = tid >> 2, kq = (tid & 3) * 16;
    unsigned w[8];
#pragma unroll
    for (int j = 0; j < 8; ++j) w[j] = f2bf(tile[kq + 2 * j][n]) | (f2bf(tile[kq + 2 * j + 1][n]) << 16);
    uint4* dst = (uint4*)(WT + (size_t)(n0 + n) * K + k0 + kq);
    dst[0] = make_uint4(w[0], w[1], w[2], w[3]); dst[1] = make_uint4(w[4], w[5], w[6], w[7]);
}
__global__ void k_bias(const float* __restrict__ mgb, float* __restrict__ bias) {
    const int n = blockIdx.x * 256 + threadIdx.x; if (n < NP) bias[n] = (n >= C_G && n < C_SMALL) ? mgb[n - C_G] : 0.f;
}
__global__ void k_f2bf(const float* __restrict__ in, bf16* __restrict__ out, size_t n4) {
    for (size_t i = (size_t)blockIdx.x * 256 + threadIdx.x; i < n4; i += (size_t)gridDim.x * 256) { const float4 v = ((const float4*)in)[i];
        ((uint2*)out)[i] = make_uint2(f2bf(v.x) | (f2bf(v.y) << 16), f2bf(v.z) | (f2bf(v.w) << 16)); }
}

struct GemmArgs { const bf16* A; const bf16* Bt; int M, N, K, pad; };
template <class Epi> __global__ __launch_bounds__(512, 2) void k_gemm(GemmArgs ga, Epi E) {
    extern __shared__ __attribute__((aligned(16))) unsigned char shm[];
    pg8::Gemm g{ga.A, ga.Bt, ga.M, ga.N, ga.K};
    pg8::StaticOrder S; S.init(ga.M, ga.N, (int)gridDim.x, (int)blockIdx.x);
    pg8::gemm_phase<Epi, pg8::StaticOrder, true, true>((PG8_LAS unsigned char*)shm, g, S, E);
}

__global__ __launch_bounds__(256) void k_rope(const bf16* __restrict__ proj, float* __restrict__ qr, float* __restrict__ kr) {
    const size_t gid = (size_t)blockIdx.x * 256 + threadIdx.x;
    const int i = (int)(gid & 31), hh = (int)((gid >> 5) % 20), t = (int)(gid / 640);
    if (t >= T_TOK) return;
    const int pos = t % SEQ;
    const float freq = powf(10000.0f, -(float)i / 32.0f), ang = (float)pos * freq, c = cosf(ang), s = sinf(ang);
    const bf16* src; float* dst;
    if (hh < 16) { src = proj + (size_t)t * NP + C_AQ + hh * 64; dst = qr + (size_t)t * 1024 + hh * 64; }
    else { src = proj + (size_t)t * NP + C_AK + (hh - 16) * 64; dst = kr + (size_t)t * 256 + (hh - 16) * 64; }
    const float x1 = bf2f(src[i]), x2 = bf2f(src[32 + i]);
    dst[i] = x1 * c - x2 * s; dst[32 + i] = x2 * c + x1 * s;
}
__global__ __launch_bounds__(256) void k_swa(const float* __restrict__ qr, const float* __restrict__ kr, const bf16* __restrict__ proj, const float* __restrict__ sinks, bf16* __restrict__ ya) {
    const int gid = blockIdx.x * 256 + threadIdx.x;
    const int hq = gid & 15, t = gid >> 4, b = t / SEQ, pos = t % SEQ, g = hq >> 2;
    float q[64], o[64];
#pragma unroll
    for (int d = 0; d < 64; ++d) { q[d] = qr[(size_t)t * 1024 + hq * 64 + d] * 0.125f; o[d] = 0.f; }
    float m = sinks[hq], l = 1.0f;
    const int j0 = pos >= 127 ? pos - 127 : 0;
    for (int j = j0; j <= pos; ++j) {
        const int tk = b * SEQ + j;
        const float* kp = kr + (size_t)tk * 256 + g * 64; const bf16* vp = proj + (size_t)tk * NP + C_AV + g * 64;
        float s = 0.f;
#pragma unroll
        for (int d = 0; d < 64; ++d) s += q[d] * kp[d];
        const float mn = fmaxf(m, s), sc = expf(m - mn), p = expf(s - mn);
        l = l * sc + p; m = mn;
#pragma unroll
        for (int d = 0; d < 64; ++d) o[d] = o[d] * sc + p * bf2f(vp[d]);
    }
    const float inv = 1.0f / l;
    bf16* op = ya + (size_t)t * 1024 + hq * 64;
#pragma unroll
    for (int d = 0; d < 64; ++d) op[d] = (bf16)f2bf(o[d] * inv);
}

__global__ __launch_bounds__(256) void k_mlstm(const bf16* __restrict__ proj, const float* __restrict__ small, const float* __restrict__ gate_b, float* __restrict__ hm) {
    const int gid = blockIdx.x * 256 + threadIdx.x;
    const int dq = gid & 3, v = (gid >> 2) & 255, h = (gid >> 10) & 3, b = gid >> 12;
    float C[32], n[32];
#pragma unroll
    for (int d = 0; d < 32; ++d) { C[d] = 0.f; n[d] = 0.f; }
    const float bi = gate_b[h], bfg = gate_b[4 + h];
    for (int pos = 0; pos < SEQ; ++pos) {
        const size_t t = (size_t)b * SEQ + pos;
        const float ip = small[t * 32 + h] + bi, fp = small[t * 32 + 4 + h] + bfg;
        const float f = sigm(fp), ig = expf(ip);
        const float vv = bf2f(proj[t * NP + C_MV + h * 256 + v]);
        const bf16* qp = proj + t * NP + C_MQ + h * 128 + dq * 32; const bf16* kp = proj + t * NP + C_MK + h * 128 + dq * 32;
        float num = 0.f, den = 0.f;
#pragma unroll
        for (int d = 0; d < 32; ++d) { const float kd = bf2f(kp[d]) * 0.08838834764831845f, qd = bf2f(qp[d]);
            C[d] = f * C[d] + (ig * kd) * vv; n[d] = f * n[d] + ig * kd; num += qd * C[d]; den += qd * n[d]; }
        num += __shfl_xor(num, 1); num += __shfl_xor(num, 2); den += __shfl_xor(den, 1); den += __shfl_xor(den, 2);
        if (dq == 0) hm[t * 1024 + h * 256 + v] = num / fmaxf(fabsf(den), 1.0f);
    }
}
__global__ __launch_bounds__(256) void k_mlstm_post(const float* __restrict__ hm, const bf16* __restrict__ proj, const float* __restrict__ norm_w, bf16* __restrict__ ym) {
    const int w = (blockIdx.x * 256 + threadIdx.x) >> 6, lane = threadIdx.x & 63;
    const int h = w & 3, t = w >> 2;
    const float4 x = *(const float4*)(hm + (size_t)t * 1024 + h * 256 + lane * 4);
    const float mu = wave_sum((x.x + x.y) + (x.z + x.w)) * (1.0f / 256.0f);
    const float d0 = x.x - mu, d1 = x.y - mu, d2 = x.z - mu, d3 = x.w - mu;
    const float var = wave_sum((d0 * d0 + d1 * d1) + (d2 * d2 + d3 * d3)) * (1.0f / 256.0f);
    const float rs = rsqrtf(var + 1e-6f);
    const int c = h * 256 + lane * 4;
    const float4 nw = *(const float4*)(norm_w + c);
    const bf16* op = proj + (size_t)t * NP + C_MO + c;
    const float y0 = d0 * rs * nw.x * sigm(bf2f(op[0])), y1 = d1 * rs * nw.y * sigm(bf2f(op[1])), y2 = d2 * rs * nw.z * sigm(bf2f(op[2])), y3 = d3 * rs * nw.w * sigm(bf2f(op[3]));
    *(uint2*)(ym + (size_t)t * 1024 + c) = make_uint2(f2bf(y0) | (f2bf(y1) << 16), f2bf(y2) | (f2bf(y3) << 16));
}

__global__ __launch_bounds__(256) void k_ssd_conv(const bf16* __restrict__ proj, const float* __restrict__ cw, const float* __restrict__ cb, float* __restrict__ xc) {
    const size_t gid = (size_t)blockIdx.x * 256 + threadIdx.x;
    const int c = (int)(gid % 1536); const int t = (int)(gid / 1536); const int pos = t % SEQ;
    float acc = cb[c];
#pragma unroll
    for (int j = 0; j < 4; ++j) { const int pp = pos - 3 + j; if (pp >= 0) acc += cw[j * 1536 + c] * bf2f(proj[(size_t)(t - 3 + j) * NP + C_SXBC + c]); }
    xc[gid] = acc * sigm(acc);
}
__global__ __launch_bounds__(256) void k_ssd_scan(const float* __restrict__ xc, const float* __restrict__ small, const float* __restrict__ dt_bias, const float* __restrict__ a_log, const float* __restrict__ dsk, float* __restrict__ yraw) {
    const int gid = blockIdx.x * 256 + threadIdx.x;
    const int nq = gid & 3, p = (gid >> 2) & 63, hh = (gid >> 8) & 15, b = gid >> 12, g = hh >> 3;
    const float a = -expf(a_log[hh]), dtb = dt_bias[hh], Dk = dsk[hh];
    float hs[32];
#pragma unroll
    for (int n = 0; n < 32; ++n) hs[n] = 0.f;
    for (int pos = 0; pos < SEQ; ++pos) {
        const size_t t = (size_t)b * SEQ + pos;
        const float dtr = small[t * 32 + 8 + hh] + dtb; const float dt = dtr > 20.f ? dtr : log1pf(expf(dtr));
        const float dA = expf(dt * a), xv = xc[t * 1536 + hh * 64 + p], dx = dt * xv;
        const float* Bp = xc + t * 1536 + 1024 + g * 128 + nq * 32; const float* Cp = Bp + 256;
        float y = 0.f;
#pragma unroll
        for (int n = 0; n < 32; ++n) { hs[n] = dA * hs[n] + dx * Bp[n]; y += Cp[n] * hs[n]; }
        y += __shfl_xor(y, 1); y += __shfl_xor(y, 2);
        if (nq == 0) yraw[t * 1024 + hh * 64 + p] = y + Dk * xv;
    }
}
__global__ __launch_bounds__(256) void k_ssd_post(const float* __restrict__ yraw, const bf16* __restrict__ proj, const float* __restrict__ norm_w, bf16* __restrict__ ys) {
    const int w = (blockIdx.x * 256 + threadIdx.x) >> 6, lane = threadIdx.x & 63;
    const int g = w & 1, t = w >> 1, c = g * 512 + lane * 8;
    float y[8]; float ss = 0.f;
#pragma unroll
    for (int i = 0; i < 8; ++i) { const float z = bf2f(proj[(size_t)t * NP + C_SZ + c + i]); y[i] = yraw[(size_t)t * 1024 + c + i] * (z * sigm(z)); ss += y[i] * y[i]; }
    const float rs = rsqrtf(wave_sum(ss) * (1.0f / 512.0f) + 1e-6f);
    unsigned o[4];
#pragma unroll
    for (int i = 0; i < 4; ++i) o[i] = f2bf(y[2 * i] * rs * norm_w[c + 2 * i]) | (f2bf(y[2 * i + 1] * rs * norm_w[c + 2 * i + 1]) << 16);
    *(uint4*)(ys + (size_t)t * 1024 + c) = make_uint4(o[0], o[1], o[2], o[3]);
}

__global__ __launch_bounds__(256) void k_ln(const float* in, const float* __restrict__ g, const float* __restrict__ bta, float* outf, bf16* __restrict__ outb) {
    const int t = (blockIdx.x * 256 + threadIdx.x) >> 6, lane = threadIdx.x & 63;
    float4 v[8]; float s = 0.f;
#pragma unroll
    for (int j = 0; j < 8; ++j) { v[j] = *(const float4*)(in + (size_t)t * DM + j * 256 + lane * 4); s += (v[j].x + v[j].y) + (v[j].z + v[j].w); }
    const float mu = wave_sum(s) * (1.0f / DM); float q = 0.f;
#pragma unroll
    for (int j = 0; j < 8; ++j) { v[j].x -= mu; v[j].y -= mu; v[j].z -= mu; v[j].w -= mu; q += (v[j].x * v[j].x + v[j].y * v[j].y) + (v[j].z * v[j].z + v[j].w * v[j].w); }
    const float rs = rsqrtf(wave_sum(q) * (1.0f / DM) + 1e-5f);
#pragma unroll
    for (int j = 0; j < 8; ++j) { const int c = j * 256 + lane * 4; const float4 gg = *(const float4*)(g + c), bb = *(const float4*)(bta + c);
        float4 y; y.x = v[j].x * rs * gg.x + bb.x; y.y = v[j].y * rs * gg.y + bb.y; y.z = v[j].z * rs * gg.z + bb.z; y.w = v[j].w * rs * gg.w + bb.w;
        *(float4*)(outf + (size_t)t * DM + c) = y; *(uint2*)(outb + (size_t)t * DM + c) = make_uint2(f2bf(y.x) | (f2bf(y.y) << 16), f2bf(y.z) | (f2bf(y.w) << 16)); }
}

#define TOPK_INSERT(tv, ti, val, idx) do { _Pragma("unroll") for (int _j = 15; _j >= 1; --_j) { const bool _c1 = (val) > tv[_j - 1], _c0 = (val) > tv[_j]; \
        ti[_j] = _c1 ? ti[_j - 1] : (_c0 ? (idx) : ti[_j]); tv[_j] = _c1 ? tv[_j - 1] : (_c0 ? (val) : tv[_j]); } \
        { const bool _c0 = (val) > tv[0]; ti[0] = _c0 ? (idx) : ti[0]; tv[0] = _c0 ? (val) : tv[0]; } } while (0)
__global__ __launch_bounds__(256) void k_peer_select(const float* __restrict__ q, const float* __restrict__ subkeys, int* __restrict__ ids, float* __restrict__ gates) {
    const int h = blockIdx.x >> 7, t = (blockIdx.x & 127) * 256 + threadIdx.x;
    float tv0[16], tv1[16]; int ti0[16], ti1[16];
#pragma unroll
    for (int j = 0; j < 16; ++j) { tv0[j] = -INFINITY; ti0[j] = 0; tv1[j] = -INFINITY; ti1[j] = 0; }
    {
        float qv[128];
        const float* qp = q + (size_t)t * DM + h * 256;
#pragma unroll
        for (int d = 0; d < 128; d += 4) { const float4 x = *(const float4*)(qp + d); qv[d] = x.x; qv[d + 1] = x.y; qv[d + 2] = x.z; qv[d + 3] = x.w; }
        const float* sk = subkeys + (size_t)(h * 2 + 0) * 128 * 128;
        for (int k = 0; k < 128; ++k) {
            float s = 0.f;
#pragma unroll
            for (int d = 0; d < 128; ++d) s += qv[d] * sk[k * 128 + d];
            TOPK_INSERT(tv0, ti0, s, k);
        }
    }
    {
        float qv[128];
        const float* qp = q + (size_t)t * DM + h * 256 + 128;
#pragma unroll
        for (int d = 0; d < 128; d += 4) { const float4 x = *(const float4*)(qp + d); qv[d] = x.x; qv[d + 1] = x.y; qv[d + 2] = x.z; qv[d + 3] = x.w; }
        const float* sk = subkeys + (size_t)(h * 2 + 1) * 128 * 128;
        for (int k = 0; k < 128; ++k) {
            float s = 0.f;
#pragma unroll
            for (int d = 0; d < 128; ++d) s += qv[d] * sk[k * 128 + d];
            TOPK_INSERT(tv1, ti1, s, k);
        }
    }
    float bv[16]; int bi[16];
#pragma unroll
    for (int j = 0; j < 16; ++j) { bv[j] = -INFINITY; bi[j] = 0; }
#pragma unroll
    for (int a = 0; a < 16; ++a)
#pragma unroll
        for (int b = 0; b < 16; ++b) if ((a + 1) * (b + 1) <= 16) { const float cv = tv0[a] + tv1[b]; const int ci = ti0[a] * 128 + ti1[b]; TOPK_INSERT(bv, bi, cv, ci); }
    float den = 0.f, e[16];
#pragma unroll
    for (int j = 0; j < 16; ++j) { e[j] = expf(bv[j] - bv[0]); den += e[j]; }
    const float inv = 1.0f / den;
#pragma unroll
    for (int j = 0; j < 16; ++j) { ids[(size_t)t * 128 + h * 16 + j] = bi[j]; gates[(size_t)t * 128 + h * 16 + j] = e[j] * inv; }
}
__global__ __launch_bounds__(256) void k_peer_expert(const float* __restrict__ x1, const int* __restrict__ ids, const float* __restrict__ gates, const float* __restrict__ U, const float* __restrict__ V,
                                                     const float* __restrict__ g, const float* __restrict__ bta, float* __restrict__ outf, bf16* __restrict__ outb) {
    const int t = (blockIdx.x * 256 + threadIdx.x) >> 6, lane = threadIdx.x & 63;
    float4 xv[8], acc[8];
#pragma unroll
    for (int j = 0; j < 8; ++j) { xv[j] = *(const float4*)(x1 + (size_t)t * DM + j * 256 + lane * 4); acc[j] = make_float4(0.f, 0.f, 0.f, 0.f); }
    for (int e = 0; e < 128; ++e) {
        const int id = __builtin_amdgcn_readfirstlane(ids[(size_t)t * 128 + e]); const float gt = gates[(size_t)t * 128 + e];
        const float* up = U + (size_t)id * DM + lane * 4; const float* vp = V + (size_t)id * DM + lane * 4;
        float s = 0.f;
#pragma unroll
        for (int j = 0; j < 8; ++j) { const float4 u = *(const float4*)(up + j * 256); s += (xv[j].x * u.x + xv[j].y * u.y) + (xv[j].z * u.z + xv[j].w * u.w); }
        s = wave_sum(s);
        const float c = gt * 0.5f * s * (1.0f + erff(s * 0.7071067811865476f));
#pragma unroll
        for (int j = 0; j < 8; ++j) { const float4 vv = *(const float4*)(vp + j * 256); acc[j].x += c * vv.x; acc[j].y += c * vv.y; acc[j].z += c * vv.z; acc[j].w += c * vv.w; }
    }
    float s = 0.f;
#pragma unroll
    for (int j = 0; j < 8; ++j) { acc[j].x += ALPHA * xv[j].x; acc[j].y += ALPHA * xv[j].y; acc[j].z += ALPHA * xv[j].z; acc[j].w += ALPHA * xv[j].w; s += (acc[j].x + acc[j].y) + (acc[j].z + acc[j].w); }
    const float mu = wave_sum(s) * (1.0f / DM); float q = 0.f;
#pragma unroll
    for (int j = 0; j < 8; ++j) { acc[j].x -= mu; acc[j].y -= mu; acc[j].z -= mu; acc[j].w -= mu; q += (acc[j].x * acc[j].x + acc[j].y * acc[j].y) + (acc[j].z * acc[j].z + acc[j].w * acc[j].w); }
    const float rs = rsqrtf(wave_sum(q) * (1.0f / DM) + 1e-5f);
#pragma unroll
    for (int j = 0; j < 8; ++j) { const int c = j * 256 + lane * 4; const float4 gg = *(const float4*)(g + c), bb = *(const float4*)(bta + c);
        float4 y; y.x = acc[j].x * rs * gg.x + bb.x; y.y = acc[j].y * rs * gg.y + bb.y; y.z = acc[j].z * rs * gg.z + bb.z; y.w = acc[j].w * rs * gg.w + bb.w;
        *(float4*)(outf + (size_t)t * DM + c) = y; *(uint2*)(outb + (size_t)t * DM + c) = make_uint2(f2bf(y.x) | (f2bf(y.y) << 16), f2bf(y.z) | (f2bf(y.w) << 16)); }
}

template <class Epi> static void launch_gemm(const bf16* A, const bf16* Bt, int M, int N, int K, const Epi& E, int grid, hipStream_t stream) {
    static bool attr_set = false;
    if (!attr_set) { (void)hipFuncSetAttribute((const void*)k_gemm<Epi>, hipFuncAttributeMaxDynamicSharedMemorySize, pg8::STAGE_BYTES); attr_set = true; }
    GemmArgs ga; memset(&ga, 0, sizeof(ga)); ga.A = A; ga.Bt = Bt; ga.M = M; ga.N = N; ga.K = K;
    hipLaunchKernelGGL(k_gemm<Epi>, dim3(grid), dim3(512), pg8::STAGE_BYTES, stream, ga, E);
}

extern "C" void kernel_launch(void* const* d_in, const int* in_sizes, int n_in, void* d_out, int out_size, void* d_ws, size_t ws_size, hipStream_t stream) {
    static int grid = 0;
    if (grid == 0) {
        if (n_in != 22 || out_size != T_TOK * DM || ws_size < WS_END) { fprintf(stderr, "kernel_launch: unexpected shapes (n_in %d, out %d, ws %zu)\n", n_in, out_size, ws_size); grid = -1; return; }
        int dev = 0, cus = 0; if (hipGetDevice(&dev) != hipSuccess || hipDeviceGetAttribute(&cus, hipDeviceAttributeMultiprocessorCount, dev) != hipSuccess) { grid = -1; return; }
        grid = cus;
    }
    if (grid < 0) return;
    const float* x = (const float*)d_in[0]; const float* w_in = (const float*)d_in[1]; const float* mlstm_gate_b = (const float*)d_in[2]; const float* mlstm_norm_w = (const float*)d_in[3];
    const float* ssm_conv_w = (const float*)d_in[4]; const float* ssm_conv_b = (const float*)d_in[5]; const float* ssm_dt_bias = (const float*)d_in[6]; const float* ssm_a_log = (const float*)d_in[7];
    const float* ssm_d = (const float*)d_in[8]; const float* ssm_norm_w = (const float*)d_in[9]; const float* swa_sinks = (const float*)d_in[10]; const float* merge_gate_b = (const float*)d_in[11];
    const float* w_branch = (const float*)d_in[12]; const float* w_out = (const float*)d_in[13]; const float* ln1_g = (const float*)d_in[14]; const float* ln1_b = (const float*)d_in[15];
    const float* peer_wq = (const float*)d_in[16]; const float* peer_subkeys = (const float*)d_in[17]; const float* peer_u = (const float*)d_in[18]; const float* peer_v = (const float*)d_in[19];
    const float* ln2_g = (const float*)d_in[20]; const float* ln2_b = (const float*)d_in[21];
    unsigned char* ws = (unsigned char*)d_ws; float* out = (float*)d_out;
    bf16* WinT = (bf16*)(ws + WS_WIN); bf16* WbT = (bf16*)(ws + WS_WB); bf16* WoT = (bf16*)(ws + WS_WO); bf16* WqT = (bf16*)(ws + WS_WQ); float* bias = (float*)(ws + WS_BIAS);
    float* small = (float*)(ws + WS_SMALL); bf16* xb = (bf16*)(ws + WS_XB); float* bufB = (float*)(ws + WS_BUFB); bf16* proj = (bf16*)(ws + WS_PROJ);
    float* qr = (float*)(ws + WS_R1); float* kr = (float*)(ws + WS_R1 + 128 * MiB); float* hm = (float*)(ws + WS_R1); float* yraw = (float*)(ws + WS_R1); bf16* mix = (bf16*)(ws + WS_R1);
    bf16* ym = (bf16*)(ws + WS_Y); bf16* ys = (bf16*)(ws + WS_Y + 64 * MiB); bf16* ya = (bf16*)(ws + WS_Y + 128 * MiB); float* xc = (float*)(ws + WS_R2);
    float* qf = (float*)(ws + WS_QF); int* ids = (int*)(ws + WS_IDS); float* gates = (float*)(ws + WS_GATES);

    hipLaunchKernelGGL(k_f2bf, dim3(4096), dim3(256), 0, stream, x, xb, (size_t)T_TOK * DM / 4);
    for (int l = 0; l < DEPTH; ++l) {
        hipLaunchKernelGGL(k_transpose, dim3((DM / 64) * (NP / 64)), dim3(256), 0, stream, w_in + (size_t)l * DM * IN_COLS, IN_COLS, DM, NP, 1, WinT);
        for (int k = 0; k < 3; ++k)
            hipLaunchKernelGGL(k_transpose, dim3((1024 / 64) * (DM / 64)), dim3(256), 0, stream, w_branch + ((size_t)l * 3 + k) * 1024 * DM, DM, 1024, DM, 0, WbT + (size_t)k * DM * 1024);
        hipLaunchKernelGGL(k_transpose, dim3((DM / 64) * (DM / 64)), dim3(256), 0, stream, w_out + (size_t)l * DM * DM, DM, DM, DM, 0, WoT);
        hipLaunchKernelGGL(k_transpose, dim3((DM / 64) * (DM / 64)), dim3(256), 0, stream, peer_wq + (size_t)l * DM * DM, DM, DM, DM, 0, WqT);
        hipLaunchKernelGGL(k_bias, dim3((NP + 255) / 256), dim3(256), 0, stream, merge_gate_b + (size_t)l * 3 * DM, bias);
        const float* xin = l == 0 ? x : out;
        { pg8::EpiProj E; memset(&E, 0, sizeof(E)); E.O = proj; E.bias = bias; E.small = small; E.ldc = NP; E.gate_lo = GATE_TILE_LO; E.small_tile = SMALL_TILE;
          launch_gemm(xb, WinT, T_TOK, NP, DM, E, grid, stream); }
        hipLaunchKernelGGL(k_rope, dim3(T_TOK * 640 / 256), dim3(256), 0, stream, proj, qr, kr);
        hipLaunchKernelGGL(k_swa, dim3(T_TOK * 16 / 256), dim3(256), 0, stream, qr, kr, proj, swa_sinks + l * 16, ya);
        hipLaunchKernelGGL(k_mlstm, dim3(NBATCH * 4 * 256 * 4 / 256), dim3(256), 0, stream, proj, small, mlstm_gate_b + l * 8, hm);
        hipLaunchKernelGGL(k_mlstm_post, dim3(T_TOK * 4 / 4), dim3(256), 0, stream, hm, proj, mlstm_norm_w + l * 1024, ym);
        hipLaunchKernelGGL(k_ssd_conv, dim3(T_TOK * 1536 / 256), dim3(256), 0, stream, proj, ssm_conv_w + (size_t)l * 4 * 1536, ssm_conv_b + l * 1536, xc);
        hipLaunchKernelGGL(k_ssd_scan, dim3(NBATCH * 16 * 64 * 4 / 256), dim3(256), 0, stream, xc, small, ssm_dt_bias + l * 16, ssm_a_log + l * 16, ssm_d + l * 16, yraw);
        hipLaunchKernelGGL(k_ssd_post, dim3(T_TOK * 2 / 4), dim3(256), 0, stream, yraw, proj, ssm_norm_w + l * 1024, ys);
        { pg8::EpiMix<1> E; memset(&E, 0, sizeof(E)); E.O = mix; E.G = proj + C_G; E.ldc = DM; E.ldg = NP; launch_gemm(ym, WbT, T_TOK, DM, 1024, E, grid, stream); }
        { pg8::EpiMix<0> E; memset(&E, 0, sizeof(E)); E.O = mix; E.G = proj + C_G + DM; E.ldc = DM; E.ldg = NP; launch_gemm(ys, WbT + (size_t)DM * 1024, T_TOK, DM, 1024, E, grid, stream); }
        { pg8::EpiMix<0> E; memset(&E, 0, sizeof(E)); E.O = mix; E.G = proj + C_G + 2 * DM; E.ldc = DM; E.ldg = NP; launch_gemm(ya, WbT + (size_t)2 * DM * 1024, T_TOK, DM, 1024, E, grid, stream); }
        { pg8::EpiResid E; memset(&E, 0, sizeof(E)); E.C = bufB; E.X = xin; E.ldc = DM; E.alpha = ALPHA; launch_gemm(mix, WoT, T_TOK, DM, DM, E, grid, stream); }
        hipLaunchKernelGGL(k_ln, dim3(T_TOK / 4), dim3(256), 0, stream, bufB, ln1_g + l * DM, ln1_b + l * DM, bufB, xb);
        { pg8::EpiF32 E; memset(&E, 0, sizeof(E)); E.C = qf; E.ldc = DM; launch_gemm(xb, WqT, T_TOK, DM, DM, E, grid, stream); }
        hipLaunchKernelGGL(k_peer_select, dim3(8 * 128), dim3(256), 0, stream, qf, peer_subkeys + (size_t)l * 8 * 2 * 128 * 128, ids, gates);
        hipLaunchKernelGGL(k_peer_expert, dim3(T_TOK / 4), dim3(256), 0, stream, bufB, ids, gates, peer_u + (size_t)l * P_EXPERTS * DM, peer_v + (size_t)l * P_EXPERTS * DM,
                           ln2_g + l * DM, ln2_b + l * DM, out, xb);
    }
}
```

```cpp
#include <hip/hip_runtime.h>
#include <cstdio>
#include <cstdint>
#include <cstring>

namespace pg8 {
#define PG8_LAS __attribute__((address_space(3)))
typedef unsigned short bf16_t;
typedef short bf16x8 __attribute__((ext_vector_type(8)));
typedef float f32x4 __attribute__((ext_vector_type(4)));
typedef unsigned u32x4 __attribute__((ext_vector_type(4)));
constexpr int BM = 256, BK = 64, HALF = 128, HTB = HALF * BK * 2  , STAGE_BYTES = 8 * HTB, NXCD = 8, WGM = 8;

__host__ __device__ __forceinline__ int lds_byte(int r, int c) { const int st = (r >> 4) * 2 + (c >> 5), rr = r & 15, cc = c & 31, ob = rr * 64 + cc * 2; return st * 1024 + (ob ^ (((ob >> 9) & 1) << 5)); }
__host__ __device__ __forceinline__ void stage_rc(int b, int& R, int& C) { const int st = b / 1024, sb = b % 1024, swz = sb ^ (((sb >> 9) & 1) << 5); R = (st >> 1) * 16 + swz / 64; C = (st & 1) * 32 + (swz % 64) / 2; }
__host__ __device__ __forceinline__ int perm32(int rho) { const int n = rho >> 4, i = rho & 15; return 8 * (i >> 2) + 4 * n + (i & 3); }

struct Unit { int pm, pn; };
struct Gemm { const bf16_t* A; const bf16_t* Bt; int M, N, K; };

struct StaticOrder {
    int nM, nN, nwg, G, c;
    __host__ __device__ void init(int M, int N, int G_, int c_) { nM = M / BM; nN = N / BM; nwg = nM * nN; G = G_; c = c_; }
    __host__ __device__ bool next(int i, Unit& u) const {
        const long L = (long)i * G + c; if (L >= nwg) return false;
        int wgid = (int)L; { const int q = nwg / NXCD, r = nwg % NXCD, xcd = wgid % NXCD, off = wgid / NXCD; wgid = (xcd < r ? xcd * (q + 1) : r * (q + 1) + (xcd - r) * q) + off; }
        const int nig = WGM * nN, gid = wgid / nig, fm = gid * WGM, gsz = (nM - fm) < WGM ? (nM - fm) : WGM;
        u.pm = fm + ((wgid % nig) % gsz); u.pn = (wgid % nig) / gsz; return true;
    }
    __device__ __forceinline__ void a_ready(const Unit&) const {}
    __device__ __forceinline__ void done(const Unit&) const {}
};

__device__ __forceinline__ unsigned cvt_pk_bf16(float lo, float hi) { unsigned r; asm volatile("v_cvt_pk_bf16_f32 %0, %1, %2" : "=v"(r) : "v"(lo), "v"(hi)); return r; }
typedef float f32x2 __attribute__((ext_vector_type(2)));
__device__ __forceinline__ float bf_lo(unsigned w) { return __uint_as_float(w << 16); }
__device__ __forceinline__ float bf_hi(unsigned w) { return __uint_as_float(w & 0xffff0000u); }
__device__ __forceinline__ float sigmoidf_(float x) { return 1.0f / (1.0f + __expf(-x)); }

struct EpiF32 {
    static constexpr bool PERM = false, AFTER_DRAIN = false;
    float* C; int ldc; int pad;
    __device__ __forceinline__ void operator()(const f32x4 (&acc)[2][2][4][2], const Unit& u, int wr, int wc, int fr, int fq) const {
        const int row0 = u.pm * BM + wr * 64 + fr, col0 = u.pn * BM + wc * 32 + 4 * fq;
#pragma unroll
        for (int ai = 0; ai < 2; ++ai)
#pragma unroll
            for (int m = 0; m < 4; ++m) { float* rowp = C + (size_t)(row0 + ai * HALF + m * 16) * ldc + col0;
#pragma unroll
                for (int bj = 0; bj < 2; ++bj)
#pragma unroll
                    for (int n = 0; n < 2; ++n) *(f32x4*)(rowp + bj * HALF + n * 16) = acc[ai][bj][m][n]; }
    }
};
struct EpiResid {
    static constexpr bool PERM = false, AFTER_DRAIN = false;
    float* C; const float* X; int ldc; float alpha;
    __device__ __forceinline__ void operator()(const f32x4 (&acc)[2][2][4][2], const Unit& u, int wr, int wc, int fr, int fq) const {
        const int row0 = u.pm * BM + wr * 64 + fr, col0 = u.pn * BM + wc * 32 + 4 * fq;
#pragma unroll
        for (int ai = 0; ai < 2; ++ai)
#pragma unroll
            for (int m = 0; m < 4; ++m) { const size_t off = (size_t)(row0 + ai * HALF + m * 16) * ldc + col0;
#pragma unroll
                for (int bj = 0; bj < 2; ++bj)
#pragma unroll
                    for (int n = 0; n < 2; ++n) { const f32x4 xv = *(const f32x4*)(X + off + bj * HALF + n * 16);
                        *(f32x4*)(C + off + bj * HALF + n * 16) = acc[ai][bj][m][n] + xv * alpha; } }
    }
};
struct EpiProj {
    static constexpr bool PERM = true, AFTER_DRAIN = false;
    bf16_t* O; const float* bias; float* small; int ldc; int gate_lo; int small_tile; int pad;
    __device__ __forceinline__ void operator()(const f32x4 (&acc)[2][2][4][2], const Unit& u, int wr, int wc, int fr, int fq) const {
        const int row0 = u.pm * BM + wr * 64 + fr, col0 = u.pn * BM + wc * 32 + 8 * fq;
        if (u.pn == small_tile) {
            if (wc == 0) {
#pragma unroll
                for (int ai = 0; ai < 2; ++ai)
#pragma unroll
                    for (int m = 0; m < 4; ++m) { float* p = small + (size_t)(row0 + ai * HALF + m * 16) * 32 + 8 * fq;
                        *(f32x4*)p = acc[ai][0][m][0]; *(f32x4*)(p + 4) = acc[ai][0][m][1]; }
            }
            return;
        }
        const bool gate = u.pn >= gate_lo;
        f32x4 bv[2][2];
#pragma unroll
        for (int bj = 0; bj < 2; ++bj)
#pragma unroll
            for (int n = 0; n < 2; ++n) bv[bj][n] = gate ? *(const f32x4*)(bias + col0 + bj * HALF + 4 * n) : (f32x4){0.f, 0.f, 0.f, 0.f};
#pragma unroll
        for (int ai = 0; ai < 2; ++ai)
#pragma unroll
            for (int m = 0; m < 4; ++m) { bf16_t* rowp = O + (size_t)(row0 + ai * HALF + m * 16) * ldc + col0;
#pragma unroll
                for (int bj = 0; bj < 2; ++bj) { f32x4 v0 = acc[ai][bj][m][0] + bv[bj][0], v1 = acc[ai][bj][m][1] + bv[bj][1];
                    if (gate) {
#pragma unroll
                        for (int j = 0; j < 4; ++j) { v0[j] = sigmoidf_(v0[j]); v1[j] = sigmoidf_(v1[j]); } }
                    u32x4 w; w.x = cvt_pk_bf16(v0[0], v0[1]); w.y = cvt_pk_bf16(v0[2], v0[3]); w.z = cvt_pk_bf16(v1[0], v1[1]); w.w = cvt_pk_bf16(v1[2], v1[3]);
                    *(u32x4*)(rowp + bj * HALF) = w; } }
    }
};
template <int FIRST> struct EpiMix {
    static constexpr bool PERM = true, AFTER_DRAIN = false;
    bf16_t* O; const bf16_t* G; int ldc; int ldg;
    __device__ __forceinline__ void operator()(const f32x4 (&acc)[2][2][4][2], const Unit& u, int wr, int wc, int fr, int fq) const {
        const int row0 = u.pm * BM + wr * 64 + fr, col0 = u.pn * BM + wc * 32 + 8 * fq;
#pragma unroll
        for (int ai = 0; ai < 2; ++ai)
#pragma unroll
            for (int m = 0; m < 4; ++m) { const int row = row0 + ai * HALF + m * 16; bf16_t* rowp = O + (size_t)row * ldc + col0; const bf16_t* gp = G + (size_t)row * ldg + col0;
#pragma unroll
                for (int bj = 0; bj < 2; ++bj) { const u32x4 gw = *(const u32x4*)(gp + bj * HALF); u32x4 ow = (u32x4){0u, 0u, 0u, 0u}; if (!FIRST) ow = *(const u32x4*)(rowp + bj * HALF);
                    const f32x4 a0 = acc[ai][bj][m][0], a1 = acc[ai][bj][m][1];
                    float r0 = bf_lo(ow.x) + bf_lo(gw.x) * a0[0], r1 = bf_hi(ow.x) + bf_hi(gw.x) * a0[1], r2 = bf_lo(ow.y) + bf_lo(gw.y) * a0[2], r3 = bf_hi(ow.y) + bf_hi(gw.y) * a0[3];
                    float r4 = bf_lo(ow.z) + bf_lo(gw.z) * a1[0], r5 = bf_hi(ow.z) + bf_hi(gw.z) * a1[1], r6 = bf_lo(ow.w) + bf_lo(gw.w) * a1[2], r7 = bf_hi(ow.w) + bf_hi(gw.w) * a1[3];
                    u32x4 w; w.x = cvt_pk_bf16(r0, r1); w.y = cvt_pk_bf16(r2, r3); w.z = cvt_pk_bf16(r4, r5); w.w = cvt_pk_bf16(r6, r7);
                    *(u32x4*)(rowp + bj * HALF) = w; } }
    }
};

template <class Epi, class Sched, bool ALIGN_EPI = false, bool SP2 = false>
__device__ __forceinline__ void gemm_phase(PG8_LAS unsigned char* lds, const Gemm g, const Sched& S, const Epi& E) {
    int tid_ = threadIdx.x; asm volatile("" : "+v"(tid_));
    const int tid = tid_, wid = __builtin_amdgcn_readfirstlane(tid >> 6), lane = tid & 63, wr = wid >> 2, wc = wid & 3, fr = lane & 15, fq = lane >> 4;
    const int K = g.K, nt = K / BK;
    unsigned voffA[2], voffB[2];
#pragma unroll
    for (int i = 0; i < 2; ++i) { int R, C; stage_rc(tid * 16 + i * 8192, R, C); const int Rb = Epi::PERM ? ((R & ~31) + perm32(R & 31)) : R;
        voffA[i] = (unsigned)(R * K + C) * 2u; voffB[i] = (unsigned)(Rb * K + C) * 2u; }
    const size_t kstep = (size_t)(BK * 2);
    const size_t hstep = (size_t)HALF * K * 2;
    const size_t tstep = 2 * hstep;
    const unsigned ldsw = (unsigned)wid * 1024u;
    const int aoff = lds_byte(wr * 64 + fr, fq * 8), boff = lds_byte(wc * 32 + fr, fq * 8);
#define PG8_SA(b, h) (((b) * 2 + (h)) * HTB)
#define PG8_SB(b, h) ((4 + (b) * 2 + (h)) * HTB)
#define PG8_STAGE(bufoff, gbase, voff) do { _Pragma("unroll") for (int _i = 0; _i < 2; ++_i) \
        __builtin_amdgcn_global_load_lds((const unsigned*)((const char*)(gbase) + (voff)[_i]), (PG8_LAS unsigned*)(lds + (bufoff) + ldsw + _i * 8192), 16, 0, 0); } while (0)
#define PG8_LDA(dst, b, h) do { _Pragma("unroll") for (int m = 0; m < 4; ++m) _Pragma("unroll") for (int k = 0; k < 2; ++k) dst[m][k] = *(const PG8_LAS bf16x8*)(lds + PG8_SA(b, h) + aoff + m * 2048 + k * 1024); } while (0)
#define PG8_LDB(dst, b, h) do { _Pragma("unroll") for (int n = 0; n < 2; ++n) _Pragma("unroll") for (int k = 0; k < 2; ++k) dst[n][k] = *(const PG8_LAS bf16x8*)(lds + PG8_SB(b, h) + boff + n * 2048 + k * 1024); } while (0)
#define PG8_MMA(ai, bj, At, Bt) do { __builtin_amdgcn_s_setprio(1); _Pragma("unroll") for (int m = 0; m < 4; ++m) _Pragma("unroll") for (int n = 0; n < 2; ++n) _Pragma("unroll") for (int k = 0; k < 2; ++k) \
        acc[ai][bj][m][n] = __builtin_amdgcn_mfma_f32_16x16x32_bf16(Bt[n][k], At[m][k], acc[ai][bj][m][n], 0, 0, 0); __builtin_amdgcn_s_setprio(0); } while (0)
#define PG8_WAIT_V(n) asm volatile("s_waitcnt vmcnt(" #n ")" ::: "memory")
#define PG8_WAIT_L(n) asm volatile("s_waitcnt lgkmcnt(" #n ")" ::: "memory")
#define PG8_BAR __builtin_amdgcn_s_barrier()
#define PG8_SCHED __builtin_amdgcn_sched_barrier(0)
    Unit cur, nxt; int ui = 0;
    if (!S.next(0, cur)) return;
    f32x4 acc[2][2][4][2];
#pragma unroll
    for (int a = 0; a < 2; ++a)
#pragma unroll
        for (int b = 0; b < 2; ++b)
#pragma unroll
            for (int m = 0; m < 4; ++m)
#pragma unroll
                for (int n = 0; n < 2; ++n) acc[a][b][m][n] = (f32x4){0.f, 0.f, 0.f, 0.f};
    bf16x8 At[4][2], B0[2][2], B1[2][2];
    const char* cA = (const char*)g.A + (size_t)cur.pm * tstep; const char* cB = (const char*)g.Bt + (size_t)cur.pn * tstep;
    S.a_ready(cur);
    if constexpr (SP2) {
        PG8_STAGE(PG8_SB(0, 0), cB, voffB); PG8_STAGE(PG8_SB(0, 1), cB + hstep, voffB); PG8_STAGE(PG8_SA(0, 0), cA, voffA); PG8_STAGE(PG8_SA(0, 1), cA + hstep, voffA);
        if (wr == 1) PG8_BAR;
        PG8_WAIT_V(2); PG8_BAR;
        PG8_STAGE(PG8_SB(1, 0), cB + kstep, voffB); PG8_STAGE(PG8_SA(1, 0), cA + kstep, voffA); PG8_STAGE(PG8_SB(1, 1), cB + hstep + kstep, voffB);
        PG8_WAIT_V(6); PG8_BAR;
    } else {
        PG8_STAGE(PG8_SB(0, 0), cB, voffB); PG8_STAGE(PG8_SA(0, 0), cA, voffA); PG8_STAGE(PG8_SB(0, 1), cB + hstep, voffB); PG8_STAGE(PG8_SA(0, 1), cA + hstep, voffA);
        if (wr == 1) PG8_BAR;
        PG8_WAIT_V(4); PG8_BAR;
        PG8_STAGE(PG8_SB(1, 0), cB + kstep, voffB); PG8_STAGE(PG8_SA(1, 0), cA + kstep, voffA); PG8_STAGE(PG8_SB(1, 1), cB + hstep + kstep, voffB);
        PG8_WAIT_V(6); PG8_BAR;
    }
    for (;;) {
        const bool has_next = S.next(ui + 1, nxt);
        const char* nA = has_next ? (const char*)g.A + (size_t)nxt.pm * tstep : cA; const char* nB = has_next ? (const char*)g.Bt + (size_t)nxt.pn * tstep : cB;
        for (int t = 0; t < nt; t += 2) {
            const bool last = (t == nt - 2);
            const char* a1 = cA + (size_t)(t + 1) * kstep;
            const char* a2 = last ? nA : cA + (size_t)(t + 2) * kstep; const char* b2 = last ? nB : cB + (size_t)(t + 2) * kstep;
            const char* a3 = a2 + kstep; const char* b3 = b2 + kstep;
            if (last && has_next) S.a_ready(nxt);
            if constexpr (SP2) {
            PG8_LDB(B0, 0, 0); PG8_LDB(B1, 0, 1); PG8_SCHED; PG8_LDA(At, 0, 0); PG8_STAGE(PG8_SA(1, 1), a1 + hstep, voffA);
            PG8_WAIT_V(8); PG8_WAIT_L(0); PG8_BAR; PG8_MMA(0, 0, At, B0); PG8_MMA(0, 1, At, B1); PG8_BAR; PG8_SCHED;
            PG8_LDA(At, 0, 1); PG8_STAGE(PG8_SB(0, 0), b2, voffB); PG8_STAGE(PG8_SB(0, 1), b2 + hstep, voffB); PG8_STAGE(PG8_SA(0, 0), a2, voffA);
            PG8_WAIT_V(8); PG8_WAIT_L(0); PG8_BAR; PG8_MMA(1, 0, At, B0); PG8_MMA(1, 1, At, B1); PG8_BAR; PG8_SCHED;
            PG8_LDB(B0, 1, 0); PG8_LDB(B1, 1, 1); PG8_SCHED; PG8_LDA(At, 1, 0); PG8_STAGE(PG8_SA(0, 1), a2 + hstep, voffA);
            PG8_WAIT_V(8); PG8_WAIT_L(0); PG8_BAR; PG8_MMA(0, 0, At, B0); PG8_MMA(0, 1, At, B1); PG8_BAR; PG8_SCHED;
            PG8_LDA(At, 1, 1); PG8_STAGE(PG8_SB(1, 0), b3, voffB); PG8_STAGE(PG8_SB(1, 1), b3 + hstep, voffB); PG8_STAGE(PG8_SA(1, 0), a3, voffA);
            PG8_WAIT_V(8); PG8_WAIT_L(0); PG8_BAR; PG8_MMA(1, 0, At, B0); PG8_MMA(1, 1, At, B1); PG8_BAR; PG8_SCHED;
            } else {
            PG8_LDB(B0, 0, 0); PG8_SCHED; PG8_LDA(At, 0, 0); PG8_STAGE(PG8_SA(1, 1), a1 + hstep, voffA);
            PG8_WAIT_L(8); PG8_BAR; PG8_WAIT_L(0); PG8_MMA(0, 0, At, B0); PG8_BAR; PG8_SCHED;
            PG8_LDB(B1, 0, 1); PG8_STAGE(PG8_SB(0, 0), b2, voffB);
            PG8_BAR; PG8_WAIT_L(0); PG8_MMA(0, 1, At, B1); PG8_BAR;
            PG8_LDA(At, 0, 1); PG8_STAGE(PG8_SA(0, 0), a2, voffA);
            PG8_BAR; PG8_WAIT_L(0); PG8_MMA(1, 0, At, B0); PG8_BAR; PG8_SCHED;
            PG8_STAGE(PG8_SB(0, 1), b2 + hstep, voffB);
            PG8_WAIT_V(6); PG8_BAR; PG8_MMA(1, 1, At, B1); PG8_BAR;
            PG8_LDB(B0, 1, 0); PG8_SCHED; PG8_LDA(At, 1, 0); PG8_STAGE(PG8_SA(0, 1), a2 + hstep, voffA);
            PG8_WAIT_L(8); PG8_BAR; PG8_WAIT_L(0); PG8_MMA(0, 0, At, B0); PG8_BAR; PG8_SCHED;
            PG8_LDB(B1, 1, 1); PG8_STAGE(PG8_SB(1, 0), b3, voffB);
            PG8_BAR; PG8_WAIT_L(0); PG8_MMA(0, 1, At, B1); PG8_BAR;
            PG8_LDA(At, 1, 1); PG8_STAGE(PG8_SA(1, 0), a3, voffA);
            PG8_BAR; PG8_WAIT_L(0); PG8_MMA(1, 0, At, B0); PG8_BAR; PG8_SCHED;
            PG8_STAGE(PG8_SB(1, 1), b3 + hstep, voffB);
            PG8_WAIT_V(6); PG8_BAR; PG8_MMA(1, 1, At, B1); PG8_BAR;
            }
        }
        if constexpr (ALIGN_EPI) { if (wr == 0) PG8_BAR; }
        if constexpr (!Epi::AFTER_DRAIN) { E(acc, cur, wr, wc, fr, fq); S.done(cur); }
        if (!has_next) break;
#pragma unroll
        for (int a = 0; a < 2; ++a)
#pragma unroll
            for (int b = 0; b < 2; ++b)
#pragma unroll
                for (int m = 0; m < 4; ++m)
#pragma unroll
                    for (int n = 0; n < 2; ++n) acc[a][b][m][n] = (f32x4){0.f, 0.f, 0.f, 0.f};
        cur = nxt; cA = nA; cB = nB; ++ui;
        if constexpr (ALIGN_EPI) { if (wr == 1) PG8_BAR; }
    }
    PG8_WAIT_V(0);
    if constexpr (!ALIGN_EPI) { if (wr == 0) PG8_BAR; }
    PG8_BAR;
    if constexpr (Epi::AFTER_DRAIN) { E.fused(acc, cur, wr, wc, fr, fq, lds, wid, lane); S.done(cur); }
#undef PG8_SA
#undef PG8_SB
#undef PG8_STAGE
#undef PG8_LDA
#undef PG8_LDB
#undef PG8_MMA
#undef PG8_WAIT_V
#undef PG8_WAIT_L
#undef PG8_BAR
#undef PG8_SCHED
}
}
typedef unsigned short bf16;
#define LAS __attribute__((address_space(3)))
constexpr int T_TOK = 32768, DM = 2048, SEQ = 4096, NBATCH = 8, DEPTH = 4;
constexpr int IN_COLS = 13336, NP = 13568;
constexpr int C_MQ = 0, C_MK = 512, C_MV = 1024, C_MO = 2048, C_SZ = 3072, C_SXBC = 4096, C_AQ = 5632, C_AK = 6656, C_AV = 6912, C_G = 7168, C_SMALL = 13312;
constexpr int GATE_TILE_LO = C_G / 256, SMALL_TILE = C_SMALL / 256;
constexpr float ALPHA = 1.681792830507429f;
constexpr int P_EXPERTS = 16384;

constexpr size_t MiB = 1u << 20;
constexpr size_t WS_CTL = 0, CTL_ZERO_BYTES = 64 * 1024, WS_WIN = 1 * MiB, WS_WB = 54 * MiB, WS_WO = 66 * MiB, WS_WQ = 74 * MiB, WS_BIAS = 82 * MiB, WS_SMALL = 83 * MiB,
                 WS_XB = 88 * MiB, WS_BUFB = 216 * MiB, WS_PROJ = 472 * MiB, WS_R1 = 1320 * MiB, WS_Y = 1480 * MiB, WS_R2 = 1672 * MiB, WS_HM = 1864 * MiB, WS_END = 1992 * MiB;
constexpr size_t WS_QF = WS_PROJ, WS_IDS = WS_PROJ + 256 * MiB, WS_GATES = WS_PROJ + 272 * MiB;
constexpr int CW_BAR = 4096;
constexpr int RING_BYTES = 131072, MISC_OFF = RING_BYTES + 320, LDS_BYTES = 147456;

__device__ __forceinline__ unsigned f2bf(float f) { unsigned u = __float_as_uint(f); return (u + 0x7fffu + ((u >> 16) & 1u)) >> 16; }
__device__ __forceinline__ unsigned pk2(float lo, float hi) { return f2bf(lo) | (f2bf(hi) << 16); }
__device__ __forceinline__ float bf2f(bf16 b) { return __uint_as_float(((unsigned)b) << 16); }
__device__ __forceinline__ float sigm(float x) { return 1.0f / (1.0f + expf(-x)); }
__device__ __forceinline__ float wave_sum(float v) {
#pragma unroll
    for (int o = 1; o < 64; o <<= 1) v += __shfl_xor(v, o);
    return v;
}
__device__ __forceinline__ int src_col(int n) {
    if (n < 3072) return n;
    if (n < 5632) return n + 8;
    if (n < 13312) return n + 24;
    if (n < 13320) return 3072 + (n - 13312);
    if (n < 13336) return 5640 + (n - 13320);
    return -1;
}

#define XB_TMO      128
#define XB_XCNT(j)  (256  + 64 * (j))
#define XB_XSUB(j)  (1280 + 64 * (j))
#define XB_XGEN(j)  (2304 + 64 * (j))
#define XB_TOP      3328
#define XB_TOPGEN   3392
#define XCD_BAR_WORDS 3456
#define XB_SPIN_CAP (1u << 18)

__device__ __forceinline__ unsigned xb_ld(unsigned* p)              { return __hip_atomic_load(p, __ATOMIC_RELAXED, __HIP_MEMORY_SCOPE_AGENT); }
__device__ __forceinline__ unsigned xb_add(unsigned* p, unsigned v) { return __hip_atomic_fetch_add(p, v, __ATOMIC_RELAXED, __HIP_MEMORY_SCOPE_AGENT); }
__device__ __forceinline__ unsigned xb_xcc_id() { return (unsigned)__builtin_amdgcn_s_getreg((3 << 11) | 20) & 0xFu; }
#define XB_SPIN(cond, bar) do { unsigned _sp = 0; while (cond) { __builtin_amdgcn_s_sleep(1); \
    if ((++_sp & 255u) == 0u) { if (xb_ld(&(bar)[XB_TMO])) break; if (_sp > XB_SPIN_CAP) { atomicAdd(&(bar)[XB_TMO], 1u); break; } } } } while (0)

struct XcdBarrier {
    unsigned* bar; unsigned x;
    volatile LAS unsigned* st;
};

__device__ __forceinline__ XcdBarrier xcd_barrier_post(unsigned* bar, volatile LAS unsigned* st) {
    XcdBarrier b; b.bar = bar; b.x = xb_xcc_id(); b.st = st;
    if (threadIdx.x == 0) (void)xb_add(&bar[XB_XCNT(b.x)], 1u);
    return b;
}
__device__ __forceinline__ void xcd_barrier_complete(unsigned* bar, unsigned x, unsigned& nloc, unsigned& nx) {
    const unsigned G = gridDim.x * gridDim.y * gridDim.z;
    unsigned sum, cnt, mine, sp = 0u;
    for (;;) {
        sum = 0u; cnt = 0u; mine = 0u;
#pragma unroll
        for (unsigned j = 0; j < 16; ++j) { const unsigned c = xb_ld(&bar[XB_XCNT(j)]); sum += c; cnt += (c > 0u) ? 1u : 0u; mine = (j == x) ? c : mine; }
        if (sum == G) break;
        __builtin_amdgcn_s_sleep(1);
        if ((++sp & 255u) == 0u) { if (xb_ld(&bar[XB_TMO])) break; if (sp > XB_SPIN_CAP) { atomicAdd(&bar[XB_TMO], 1u); break; } }
    }
    nloc = mine > 0u ? mine : 1u; nx = cnt > 0u ? cnt : 1u;
}

__device__ __forceinline__ void xcd_barrier(const XcdBarrier& b) {
    asm volatile("s_waitcnt vmcnt(0)" ::: "memory");
    __syncthreads();
    if (threadIdx.x == 0) {
        unsigned* bar = b.bar;
        __builtin_amdgcn_s_waitcnt(0);
        unsigned nloc = b.st[0], nx = b.st[1];
        if (nloc == 0u) { xcd_barrier_complete(bar, b.x, nloc, nx); b.st[0] = nloc; b.st[1] = nx; }
        const unsigned old = xb_add(&bar[XB_XSUB(b.x)], 1u);
        const unsigned gen = old / nloc;
        if (old + 1u == (gen + 1u) * nloc) {
            __builtin_amdgcn_fence(__ATOMIC_RELEASE, "agent");
            asm volatile("s_waitcnt vmcnt(0)" ::: "memory");
            const unsigned og = xb_add(&bar[XB_TOP], 1u);
            const unsigned tg = og / nx;
            if (og + 1u == (tg + 1u) * nx) xb_add(&bar[XB_TOPGEN], 1u);
            else XB_SPIN(xb_ld(&bar[XB_TOPGEN]) == tg, bar);
            __builtin_amdgcn_fence(__ATOMIC_ACQUIRE, "agent");
            xb_add(&bar[XB_XGEN(b.x)], 1u);
            asm volatile("s_waitcnt vmcnt(0)" ::: "memory");
        } else {
            XB_SPIN(xb_ld(&bar[XB_XGEN(b.x)]) == gen, bar);
            __builtin_amdgcn_fence(__ATOMIC_ACQUIRE, "agent");
            asm volatile("s_waitcnt vmcnt(0)" ::: "memory");
        }
    }
    __syncthreads();
}

__device__ __forceinline__ int fresh_tid() { int t = threadIdx.x; asm volatile("" : "+v"(t)); return t; }
#define PHASE_IDS const int tid = fresh_tid(), lane = tid & 63, wave = __builtin_amdgcn_readfirstlane(tid >> 6); const int gw = bx * 8 + wave; const size_t gt = (size_t)bx * 512 + tid; (void)lane; (void)gw; (void)gt;

template <int MODE> __device__ __forceinline__ void transpose_item(const float* __restrict__ W, int K, int ldw, int ndst, bf16* __restrict__ WT, LAS float* scr, int item, int lane) {
    const int nblk = ndst / 32, kb = item / nblk, nb = item % nblk, k0 = 64 * kb, n0 = 32 * nb;
    const int n_l = n0 + (lane & 31); const int sc = MODE ? src_col(n_l) : n_l;
#pragma unroll 8
    for (int i = 0; i < 32; ++i) { const int kk = 2 * i + (lane >> 5); scr[kk * 33 + (lane & 31)] = sc >= 0 ? W[(size_t)(k0 + kk) * ldw + sc] : 0.f; }
    asm volatile("s_waitcnt lgkmcnt(0)" ::: "memory");
    const int c = lane & 7;
#pragma unroll
    for (int j = 0; j < 4; ++j) { const int n = (lane >> 3) + 8 * j; const LAS float* s = scr + (8 * c) * 33 + n;
        uint4 o; o.x = pk2(s[0 * 33], s[1 * 33]); o.y = pk2(s[2 * 33], s[3 * 33]); o.z = pk2(s[4 * 33], s[5 * 33]); o.w = pk2(s[6 * 33], s[7 * 33]);
        *(uint4*)(WT + (size_t)(n0 + n) * K + k0 + 8 * c) = o; }
    asm volatile("s_waitcnt lgkmcnt(0)" ::: "memory");
}

__device__ __forceinline__ void rope_body(size_t gid, const bf16* __restrict__ proj, float* __restrict__ qr, float* __restrict__ kr) {
    const int i = (int)(gid & 31), hh = (int)((gid >> 5) % 20), t = (int)(gid / 640);
    const int pos = t % SEQ;
    const float freq = powf(10000.0f, -(float)i / 32.0f), ang = (float)pos * freq, c = cosf(ang), s = sinf(ang);
    const bf16* src; float* dst;
    if (hh < 16) { src = proj + (size_t)t * NP + C_AQ + hh * 64; dst = qr + (size_t)t * 1024 + hh * 64; }
    else { src = proj + (size_t)t * NP + C_AK + (hh - 16) * 64; dst = kr + (size_t)t * 256 + (hh - 16) * 64; }
    const float x1 = bf2f(src[i]), x2 = bf2f(src[32 + i]);
    dst[i] = x1 * c - x2 * s; dst[32 + i] = x2 * c + x1 * s;
}
__device__ __forceinline__ void swa_body(int gid, const float* __restrict__ qr, const float* __restrict__ kr, const bf16* __restrict__ proj, const float* __restrict__ sinks, bf16* __restrict__ ya) {
    const int hq = gid & 15, t = gid >> 4, b = t / SEQ, pos = t % SEQ, g = hq >> 2;
    float q[64], o[64];
#pragma unroll
    for (int d = 0; d < 64; ++d) { q[d] = qr[(size_t)t * 1024 + hq * 64 + d] * 0.125f; o[d] = 0.f; }
    float m = sinks[hq], l = 1.0f;
    const int j0 = pos >= 127 ? pos - 127 : 0;
    for (int j = j0; j <= pos; ++j) {
        const int tk = b * SEQ + j;
        const float* kp = kr + (size_t)tk * 256 + g * 64; const bf16* vp = proj + (size_t)tk * NP + C_AV + g * 64;
        float s = 0.f;
#pragma unroll
        for (int d = 0; d < 64; ++d) s += q[d] * kp[d];
        const float mn = fmaxf(m, s), sc = expf(m - mn), p = expf(s - mn);
        l = l * sc + p; m = mn;
#pragma unroll
        for (int d = 0; d < 64; ++d) o[d] = o[d] * sc + p * bf2f(vp[d]);
    }
    const float inv = 1.0f / l;
    bf16* op = ya + (size_t)t * 1024 + hq * 64;
#pragma unroll
    for (int d = 0; d < 64; d += 2) *(unsigned*)(op + d) = pk2(o[d] * inv, o[d + 1] * inv);
}

__device__ __forceinline__ void mlstm_body(int gid, const bf16* __restrict__ proj, const float* __restrict__ small, const float* __restrict__ gate_b, float* __restrict__ hm) {
    const int dq = gid & 3, v = (gid >> 2) & 255, h = (gid >> 10) & 3, b = gid >> 12;
    float C[32], n[32];
#pragma unroll
    for (int d = 0; d < 32; ++d) { C[d] = 0.f; n[d] = 0.f; }
    const float bi = gate_b[h], bfg = gate_b[4 + h];
    for (int pos = 0; pos < SEQ; ++pos) {
        const size_t t = (size_t)b * SEQ + pos;
        const float ip = small[t * 32 + h] + bi, fp = small[t * 32 + 4 + h] + bfg;
        const float f = sigm(fp), ig = expf(ip);
        const float vv = bf2f(proj[t * NP + C_MV + h * 256 + v]);
        const bf16* qp = proj + t * NP + C_MQ + h * 128 + dq * 32; const bf16* kp = proj + t * NP + C_MK + h * 128 + dq * 32;
        float num = 0.f, den = 0.f;
#pragma unroll
        for (int d = 0; d < 32; ++d) { const float kd = bf2f(kp[d]) * 0.08838834764831845f, qd = bf2f(qp[d]);
            C[d] = f * C[d] + (ig * kd) * vv; n[d] = f * n[d] + ig * kd; num += qd * C[d]; den += qd * n[d]; }
        num += __shfl_xor(num, 1); num += __shfl_xor(num, 2); den += __shfl_xor(den, 1); den += __shfl_xor(den, 2);
        if (dq == 0) hm[t * 1024 + h * 256 + v] = num / fmaxf(fabsf(den), 1.0f);
    }
}
__device__ __forceinline__ void mlstm_post_body(int w, int lane, const float* __restrict__ hm, const bf16* __restrict__ proj, const float* __restrict__ norm_w, bf16* __restrict__ ym) {
    const int h = w & 3, t = w >> 2;
    const float4 x = *(const float4*)(hm + (size_t)t * 1024 + h * 256 + lane * 4);
    const float mu = wave_sum((x.x + x.y) + (x.z + x.w)) * (1.0f / 256.0f);
    const float d0 = x.x - mu, d1 = x.y - mu, d2 = x.z - mu, d3 = x.w - mu;
    const float var = wave_sum((d0 * d0 + d1 * d1) + (d2 * d2 + d3 * d3)) * (1.0f / 256.0f);
    const float rs = rsqrtf(var + 1e-6f);
    const int c = h * 256 + lane * 4;
    const float4 nw = *(const float4*)(norm_w + c);
    const bf16* op = proj + (size_t)t * NP + C_MO + c;
    const float y0 = d0 * rs * nw.x * sigm(bf2f(op[0])), y1 = d1 * rs * nw.y * sigm(bf2f(op[1])), y2 = d2 * rs * nw.z * sigm(bf2f(op[2])), y3 = d3 * rs * nw.w * sigm(bf2f(op[3]));
    *(uint2*)(ym + (size_t)t * 1024 + c) = make_uint2(pk2(y0, y1), pk2(y2, y3));
}

__device__ __forceinline__ void ssd_conv_body(size_t gid, const bf16* __restrict__ proj, const float* __restrict__ cw, const float* __restrict__ cb, float* __restrict__ xc) {
    const int c = (int)(gid % 1536); const int t = (int)(gid / 1536); const int pos = t % SEQ;
    float acc = cb[c];
#pragma unroll
    for (int j = 0; j < 4; ++j) { const int pp = pos - 3 + j; if (pp >= 0) acc += cw[j * 1536 + c] * bf2f(proj[(size_t)(t - 3 + j) * NP + C_SXBC + c]); }
    xc[gid] = acc * sigm(acc);
}
__device__ __forceinline__ void ssd_scan_body(int gid, const float* xc, const float* __restrict__ small, const float* __restrict__ dt_bias, const float* __restrict__ a_log, const float* __restrict__ dsk, float* yraw) {
    const int nq = gid & 3, p = (gid >> 2) & 63, hh = (gid >> 8) & 15, b = gid >> 12, g = hh >> 3;
    const float a = -expf(a_log[hh]), dtb = dt_bias[hh], Dk = dsk[hh];
    float hs[32];
#pragma unroll
    for (int n = 0; n < 32; ++n) hs[n] = 0.f;
    for (int pos = 0; pos < SEQ; ++pos) {
        const size_t t = (size_t)b * SEQ + pos;
        const float dtr = small[t * 32 + 8 + hh] + dtb; const float dt = dtr > 20.f ? dtr : log1pf(expf(dtr));
        const float dA = expf(dt * a), xv = xc[t * 1536 + hh * 64 + p], dx = dt * xv;
        const float* Bp = xc + t * 1536 + 1024 + g * 128 + nq * 32; const float* Cp = Bp + 256;
        float y = 0.f;
#pragma unroll
        for (int n = 0; n < 32; ++n) { hs[n] = dA * hs[n] + dx * Bp[n]; y += Cp[n] * hs[n]; }
        y += __shfl_xor(y, 1); y += __shfl_xor(y, 2);
        if (nq == 0) yraw[t * 1536 + hh * 64 + p] = y + Dk * xv;
    }
}
__device__ __forceinline__ void ssd_post_body(int w, int lane, const float* __restrict__ yraw, const bf16* __restrict__ proj, const float* __restrict__ norm_w, bf16* __restrict__ ys) {
    const int g = w & 1, t = w >> 1, c = g * 512 + lane * 8;
    float y[8]; float ss = 0.f;
#pragma unroll
    for (int i = 0; i < 8; ++i) { const float z = bf2f(proj[(size_t)t * NP + C_SZ + c + i]); y[i] = yraw[(size_t)t * 1536 + c + i] * (z * sigm(z)); ss += y[i] * y[i]; }
    const float rs = rsqrtf(wave_sum(ss) * (1.0f / 512.0f) + 1e-6f);
    unsigned o[4];
#pragma unroll
    for (int i = 0; i < 4; ++i) o[i] = pk2(y[2 * i] * rs * norm_w[c + 2 * i], y[2 * i + 1] * rs * norm_w[c + 2 * i + 1]);
    *(uint4*)(ys + (size_t)t * 1024 + c) = make_uint4(o[0], o[1], o[2], o[3]);
}

__device__ __forceinline__ void ln_body(int t, int lane, const float* in, const float* __restrict__ g, const float* __restrict__ bta, float* outf, bf16* __restrict__ outb) {
    float4 v[8]; float s = 0.f;
#pragma unroll
    for (int j = 0; j < 8; ++j) { v[j] = *(const float4*)(in + (size_t)t * DM + j * 256 + lane * 4); s += (v[j].x + v[j].y) + (v[j].z + v[j].w); }
    const float mu = wave_sum(s) * (1.0f / DM); float q = 0.f;
#pragma unroll
    for (int j = 0; j < 8; ++j) { v[j].x -= mu; v[j].y -= mu; v[j].z -= mu; v[j].w -= mu; q += (v[j].x * v[j].x + v[j].y * v[j].y) + (v[j].z * v[j].z + v[j].w * v[j].w); }
    const float rs = rsqrtf(wave_sum(q) * (1.0f / DM) + 1e-5f);
#pragma unroll
    for (int j = 0; j < 8; ++j) { const int c = j * 256 + lane * 4; const float4 gg = *(const float4*)(g + c), bb = *(const float4*)(bta + c);
        float4 y; y.x = v[j].x * rs * gg.x + bb.x; y.y = v[j].y * rs * gg.y + bb.y; y.z = v[j].z * rs * gg.z + bb.z; y.w = v[j].w * rs * gg.w + bb.w;
        *(float4*)(outf + (size_t)t * DM + c) = y; *(uint2*)(outb + (size_t)t * DM + c) = make_uint2(pk2(y.x, y.y), pk2(y.z, y.w)); }
}

#define TOPK_INSERT(tv, ti, val, idx) do { _Pragma("unroll") for (int _j = 15; _j >= 1; --_j) { const bool _c1 = (val) > tv[_j - 1], _c0 = (val) > tv[_j]; \
        ti[_j] = _c1 ? ti[_j - 1] : (_c0 ? (idx) : ti[_j]); tv[_j] = _c1 ? tv[_j - 1] : (_c0 ? (val) : tv[_j]); } \
        { const bool _c0 = (val) > tv[0]; ti[0] = _c0 ? (idx) : ti[0]; tv[0] = _c0 ? (val) : tv[0]; } } while (0)
__device__ __forceinline__ void peer_select_body(int h, int t, const float* __restrict__ q, const float* __restrict__ subkeys, int* __restrict__ ids, float* __restrict__ gates) {
    float tv0[16], tv1[16]; int ti0[16], ti1[16];
#pragma unroll
    for (int j = 0; j < 16; ++j) { tv0[j] = -INFINITY; ti0[j] = 0; tv1[j] = -INFINITY; ti1[j] = 0; }
    {
        float qv[128];
        const float* qp = q + (size_t)t * DM + h * 256;
#pragma unroll
        for (int d = 0; d < 128; d += 4) { const float4 x = *(const float4*)(qp + d); qv[d] = x.x; qv[d + 1] = x.y; qv[d + 2] = x.z; qv[d + 3] = x.w; }
        const float* sk = subkeys + (size_t)(h * 2 + 0) * 128 * 128;
        for (int k = 0; k < 128; ++k) {
            float s = 0.f;
#pragma unroll
            for (int d = 0; d < 128; ++d) s += qv[d] * sk[k * 128 + d];
            TOPK_INSERT(tv0, ti0, s, k);
        }
    }
    {
        float qv[128];
        const float* qp = q + (size_t)t * DM + h * 256 + 128;
#pragma unroll
        for (int d = 0; d < 128; d += 4) { const float4 x = *(const float4*)(qp + d); qv[d] = x.x; qv[d + 1] = x.y; qv[d + 2] = x.z; qv[d + 3] = x.w; }
        const float* sk = subkeys + (size_t)(h * 2 + 1) * 128 * 128;
        for (int k = 0; k < 128; ++k) {
            float s = 0.f;
#pragma unroll
            for (int d = 0; d < 128; ++d) s += qv[d] * sk[k * 128 + d];
            TOPK_INSERT(tv1, ti1, s, k);
        }
    }
    float bv[16]; int bi[16];
#pragma unroll
    for (int j = 0; j < 16; ++j) { bv[j] = -INFINITY; bi[j] = 0; }
#pragma unroll
    for (int a = 0; a < 16; ++a)
#pragma unroll
        for (int b = 0; b < 16; ++b) if ((a + 1) * (b + 1) <= 16) { const float cv = tv0[a] + tv1[b]; const int ci = ti0[a] * 128 + ti1[b]; TOPK_INSERT(bv, bi, cv, ci); }
    float den = 0.f, e[16];
#pragma unroll
    for (int j = 0; j < 16; ++j) { e[j] = expf(bv[j] - bv[0]); den += e[j]; }
    const float inv = 1.0f / den;
#pragma unroll
    for (int j = 0; j < 16; ++j) { ids[(size_t)t * 128 + h * 16 + j] = bi[j]; gates[(size_t)t * 128 + h * 16 + j] = e[j] * inv; }
}
__device__ __forceinline__ void peer_expert_body(int t, int lane, const float* __restrict__ x1, const int* __restrict__ ids, const float* __restrict__ gates, const float* __restrict__ U, const float* __restrict__ V,
                                                 const float* __restrict__ g, const float* __restrict__ bta, float* __restrict__ outf, bf16* __restrict__ outb) {
    float4 xv[8], acc[8];
#pragma unroll
    for (int j = 0; j < 8; ++j) { xv[j] = *(const float4*)(x1 + (size_t)t * DM + j * 256 + lane * 4); acc[j] = make_float4(0.f, 0.f, 0.f, 0.f); }
    for (int e = 0; e < 128; ++e) {
        const int id = __builtin_amdgcn_readfirstlane(ids[(size_t)t * 128 + e]); const float gt = gates[(size_t)t * 128 + e];
        const float* up = U + (size_t)id * DM + lane * 4; const float* vp = V + (size_t)id * DM + lane * 4;
        float s = 0.f;
#pragma unroll
        for (int j = 0; j < 8; ++j) { const float4 u = *(const float4*)(up + j * 256); s += (xv[j].x * u.x + xv[j].y * u.y) + (xv[j].z * u.z + xv[j].w * u.w); }
        s = wave_sum(s);
        const float c = gt * 0.5f * s * (1.0f + erff(s * 0.7071067811865476f));
#pragma unroll
        for (int j = 0; j < 8; ++j) { const float4 vv = *(const float4*)(vp + j * 256); acc[j].x += c * vv.x; acc[j].y += c * vv.y; acc[j].z += c * vv.z; acc[j].w += c * vv.w; }
    }
    float s = 0.f;
#pragma unroll
    for (int j = 0; j < 8; ++j) { acc[j].x += ALPHA * xv[j].x; acc[j].y += ALPHA * xv[j].y; acc[j].z += ALPHA * xv[j].z; acc[j].w += ALPHA * xv[j].w; s += (acc[j].x + acc[j].y) + (acc[j].z + acc[j].w); }
    const float mu = wave_sum(s) * (1.0f / DM); float q = 0.f;
#pragma unroll
    for (int j = 0; j < 8; ++j) { acc[j].x -= mu; acc[j].y -= mu; acc[j].z -= mu; acc[j].w -= mu; q += (acc[j].x * acc[j].x + acc[j].y * acc[j].y) + (acc[j].z * acc[j].z + acc[j].w * acc[j].w); }
    const float rs = rsqrtf(wave_sum(q) * (1.0f / DM) + 1e-5f);
#pragma unroll
    for (int j = 0; j < 8; ++j) { const int c = j * 256 + lane * 4; const float4 gg = *(const float4*)(g + c), bb = *(const float4*)(bta + c);
        float4 y; y.x = acc[j].x * rs * gg.x + bb.x; y.y = acc[j].y * rs * gg.y + bb.y; y.z = acc[j].z * rs * gg.z + bb.z; y.w = acc[j].w * rs * gg.w + bb.w;
        *(float4*)(outf + (size_t)t * DM + c) = y; *(uint2*)(outb + (size_t)t * DM + c) = make_uint2(pk2(y.x, y.y), pk2(y.z, y.w)); }
}

struct MegaArgs { const float* in[22]; float* out; unsigned char* ws; };
__global__ void __launch_bounds__(512, 2) mega_fwd(MegaArgs a) {
    extern __shared__ __attribute__((aligned(16))) unsigned char lds_raw[];
    LAS unsigned char* lds = (LAS unsigned char*)lds_raw;
    const int G = gridDim.x, bx = blockIdx.x;
    const int NGW = G * 8; const size_t NGT = (size_t)G * 512;
    volatile LAS unsigned* MISC = (volatile LAS unsigned*)(lds + MISC_OFF);
    { PHASE_IDS for (int u = tid; u < (LDS_BYTES - RING_BYTES) / 4; u += 512) ((LAS unsigned*)(lds + RING_BYTES))[u] = 0u; }
    __syncthreads();
    unsigned char* ws = a.ws;
    XcdBarrier bar = xcd_barrier_post((unsigned*)(ws + WS_CTL) + CW_BAR, MISC + 8);
#define GRID_BAR() xcd_barrier(bar)

    const float* x = a.in[0]; const float* w_in = a.in[1]; const float* mlstm_gate_b = a.in[2]; const float* mlstm_norm_w = a.in[3];
    const float* ssm_conv_w = a.in[4]; const float* ssm_conv_b = a.in[5]; const float* ssm_dt_bias = a.in[6]; const float* ssm_a_log = a.in[7];
    const float* ssm_d = a.in[8]; const float* ssm_norm_w = a.in[9]; const float* swa_sinks = a.in[10]; const float* merge_gate_b = a.in[11];
    const float* w_branch = a.in[12]; const float* w_out = a.in[13]; const float* ln1_g = a.in[14]; const float* ln1_b = a.in[15];
    const float* peer_wq = a.in[16]; const float* peer_subkeys = a.in[17]; const float* peer_u = a.in[18]; const float* peer_v = a.in[19];
    const float* ln2_g = a.in[20]; const float* ln2_b = a.in[21];
    float* out = a.out;
    bf16* WinT = (bf16*)(ws + WS_WIN); bf16* WbT = (bf16*)(ws + WS_WB); bf16* WoT = (bf16*)(ws + WS_WO); bf16* WqT = (bf16*)(ws + WS_WQ); float* bias = (float*)(ws + WS_BIAS);
    float* small = (float*)(ws + WS_SMALL); bf16* xb = (bf16*)(ws + WS_XB); float* bufB = (float*)(ws + WS_BUFB); bf16* proj = (bf16*)(ws + WS_PROJ);
    float* qr = (float*)(ws + WS_R1); float* kr = (float*)(ws + WS_R1 + 128 * MiB); float* hm = (float*)(ws + WS_HM); bf16* mix = (bf16*)(ws + WS_R1);
    bf16* ym = (bf16*)(ws + WS_Y); bf16* ys = (bf16*)(ws + WS_Y + 64 * MiB); bf16* ya = (bf16*)(ws + WS_Y + 128 * MiB); float* xc = (float*)(ws + WS_R2);
    float* qf = (float*)(ws + WS_QF); int* ids = (int*)(ws + WS_IDS); float* gates = (float*)(ws + WS_GATES);

    { PHASE_IDS for (size_t i = gt; i < (size_t)T_TOK * DM / 4; i += NGT) { const float4 v = ((const float4*)x)[i]; ((uint2*)xb)[i] = make_uint2(pk2(v.x, v.y), pk2(v.z, v.w)); } }

    for (int l = 0; l < DEPTH; ++l) {
        { PHASE_IDS
            LAS float* scr = (LAS float*)(lds + wave * 16384);
            constexpr int I_IN = (DM / 64) * (NP / 32), I_B = (1024 / 64) * (DM / 32), I_O = (DM / 64) * (DM / 32);
            constexpr int NITEMS = I_IN + 3 * I_B + 2 * I_O;
            for (int it = gw; it < NITEMS; it += NGW) {
                int r = it;
                if (r < I_IN) { transpose_item<1>(w_in + (size_t)l * DM * IN_COLS, DM, IN_COLS, NP, WinT, scr, r, lane); continue; } r -= I_IN;
                if (r < 3 * I_B) { const int k = r / I_B; transpose_item<0>(w_branch + ((size_t)l * 3 + k) * 1024 * DM, 1024, DM, DM, WbT + (size_t)k * DM * 1024, scr, r - k * I_B, lane); continue; } r -= 3 * I_B;
                if (r < I_O) { transpose_item<0>(w_out + (size_t)l * DM * DM, DM, DM, DM, WoT, scr, r, lane); continue; } r -= I_O;
                transpose_item<0>(peer_wq + (size_t)l * DM * DM, DM, DM, DM, WqT, scr, r, lane);
            }
            for (size_t n = gt; n < NP; n += NGT) bias[n] = (n >= C_G && n < C_SMALL) ? merge_gate_b[(size_t)l * 3 * DM + (n - C_G)] : 0.f;
        }
        GRID_BAR();
        const float* xin = l == 0 ? x : out;
        { pg8::Gemm g{xb, WinT, T_TOK, NP, DM}; pg8::StaticOrder S; S.init(T_TOK, NP, G, bx);
          pg8::EpiProj E{proj, bias, small, NP, GATE_TILE_LO, SMALL_TILE, 0};
          pg8::gemm_phase<pg8::EpiProj, pg8::StaticOrder, true, true>(lds, g, S, E); }
        GRID_BAR();
        { PHASE_IDS for (size_t i = gt; i < (size_t)T_TOK * 640; i += NGT) rope_body(i, proj, qr, kr); }
        { PHASE_IDS for (size_t i = gt; i < (size_t)T_TOK * 1536; i += NGT) ssd_conv_body(i, proj, ssm_conv_w + (size_t)l * 4 * 1536, ssm_conv_b + l * 1536, xc); }
        GRID_BAR();
        { PHASE_IDS
        if (wave < 2) { for (int i = bx * 128 + tid; i < NBATCH * 4 * 256 * 4; i += G * 128) mlstm_body(i, proj, small, mlstm_gate_b + l * 8, hm); }
        else if (wave < 4) { for (int i = bx * 128 + (tid - 128); i < NBATCH * 16 * 64 * 4; i += G * 128) ssd_scan_body(i, xc, small, ssm_dt_bias + l * 16, ssm_a_log + l * 16, ssm_d + l * 16, xc); }
        else { for (int i = bx * 256 + (tid - 256); i < T_TOK * 16; i += G * 256) swa_body(i, qr, kr, proj, swa_sinks + l * 16, ya); } }
        GRID_BAR();
        { PHASE_IDS for (int w = gw; w < T_TOK * 4; w += NGW) mlstm_post_body(w, lane, hm, proj, mlstm_norm_w + l * 1024, ym); }
        { PHASE_IDS for (int w = gw; w < T_TOK * 2; w += NGW) ssd_post_body(w, lane, xc, proj, ssm_norm_w + l * 1024, ys); }
        GRID_BAR();
        { pg8::Gemm g{ym, WbT, T_TOK, DM, 1024}; pg8::StaticOrder S; S.init(T_TOK, DM, G, bx); pg8::EpiMix<1> E{mix, proj + C_G, DM, NP};
          pg8::gemm_phase<pg8::EpiMix<1>, pg8::StaticOrder, true, true>(lds, g, S, E); }
        __syncthreads();
        { pg8::Gemm g{ys, WbT + (size_t)DM * 1024, T_TOK, DM, 1024}; pg8::StaticOrder S; S.init(T_TOK, DM, G, bx); pg8::EpiMix<0> E{mix, proj + C_G + DM, DM, NP};
          pg8::gemm_phase<pg8::EpiMix<0>, pg8::StaticOrder, true, true>(lds, g, S, E); }
        __syncthreads();
        { pg8::Gemm g{ya, WbT + (size_t)2 * DM * 1024, T_TOK, DM, 1024}; pg8::StaticOrder S; S.init(T_TOK, DM, G, bx); pg8::EpiMix<0> E{mix, proj + C_G + 2 * DM, DM, NP};
          pg8::gemm_phase<pg8::EpiMix<0>, pg8::StaticOrder, true, true>(lds, g, S, E); }
        GRID_BAR();
        { pg8::Gemm g{mix, WoT, T_TOK, DM, DM}; pg8::StaticOrder S; S.init(T_TOK, DM, G, bx); pg8::EpiResid E{bufB, xin, DM, ALPHA};
          pg8::gemm_phase<pg8::EpiResid, pg8::StaticOrder, true, true>(lds, g, S, E); }
        GRID_BAR();
        { PHASE_IDS for (int t = gw; t < T_TOK; t += NGW) ln_body(t, lane, bufB, ln1_g + l * DM, ln1_b + l * DM, bufB, xb); }
        GRID_BAR();
        { pg8::Gemm g{xb, WqT, T_TOK, DM, DM}; pg8::StaticOrder S; S.init(T_TOK, DM, G, bx); pg8::EpiF32 E{qf, DM, 0};
          pg8::gemm_phase<pg8::EpiF32, pg8::StaticOrder, true, true>(lds, g, S, E); }
        GRID_BAR();
        { PHASE_IDS for (int wi = gw; wi < 8 * (T_TOK / 64); wi += NGW) { const int h = wi / (T_TOK / 64), t = (wi % (T_TOK / 64)) * 64 + lane; peer_select_body(h, t, qf, peer_subkeys + (size_t)l * 8 * 2 * 128 * 128, ids, gates); } }
        GRID_BAR();
        { PHASE_IDS for (int t = gw; t < T_TOK; t += NGW) peer_expert_body(t, lane, bufB, ids, gates, peer_u + (size_t)l * P_EXPERTS * DM, peer_v + (size_t)l * P_EXPERTS * DM, ln2_g + l * DM, ln2_b + l * DM, out, xb); }
        GRID_BAR();
    }
#undef GRID_BAR
}

extern "C" void kernel_launch(void* const* d_in, const int* in_sizes, int n_in, void* d_out, int out_size, void* d_ws, size_t ws_size, hipStream_t stream) {
    static int grid = 0;
    if (grid == 0) {
        if (n_in != 22 || out_size != T_TOK * DM || ws_size < WS_END) { fprintf(stderr, "kernel_launch: unexpected shapes (n_in %d, out %d, ws %zu)\n", n_in, out_size, ws_size); grid = -1; return; }
        int dev = 0, cus = 0, per_cu = 0;
        if (hipGetDevice(&dev) != hipSuccess || hipDeviceGetAttribute(&cus, hipDeviceAttributeMultiprocessorCount, dev) != hipSuccess) { grid = -1; return; }
        if (hipFuncSetAttribute((const void*)mega_fwd, hipFuncAttributeMaxDynamicSharedMemorySize, LDS_BYTES) != hipSuccess) { fprintf(stderr, "kernel_launch: hipFuncSetAttribute failed\n"); grid = -1; return; }
        if (hipOccupancyMaxActiveBlocksPerMultiprocessor(&per_cu, (const void*)mega_fwd, 512, LDS_BYTES) != hipSuccess || per_cu < 1) { fprintf(stderr, "kernel_launch: occupancy query says %d blocks per CU\n", per_cu); (void)hipGetLastError(); grid = -1; return; }
        grid = cus;
    }
    if (grid < 0) return;
    (void)hipMemsetAsync((char*)d_ws + WS_CTL, 0, CTL_ZERO_BYTES, stream);
    MegaArgs a; memset(&a, 0, sizeof(a));
    for (int i = 0; i < 22; ++i) a.in[i] = (const float*)d_in[i];
    a.out = (float*)d_out; a.ws = (unsigned char*)d_ws;
    hipLaunchKernelGGL(mega_fwd, dim3(grid), dim3(512), LDS_BYTES, stream, a);
}
```

```cpp
#include <hip/hip_runtime.h>
#include <cstdio>
#include <cstdint>
#include <cstring>

namespace pg8 {
#define PG8_LAS __attribute__((address_space(3)))
typedef unsigned short bf16_t;
typedef short bf16x8 __attribute__((ext_vector_type(8)));
typedef float f32x4 __attribute__((ext_vector_type(4)));
typedef unsigned u32x4 __attribute__((ext_vector_type(4)));
constexpr int BM = 256, BK = 64, HALF = 128, HTB = HALF * BK * 2  , STAGE_BYTES = 8 * HTB, NXCD = 8, WGM = 8;

__host__ __device__ __forceinline__ int lds_byte(int r, int c) { const int st = (r >> 4) * 2 + (c >> 5), rr = r & 15, cc = c & 31, ob = rr * 64 + cc * 2; return st * 1024 + (ob ^ (((ob >> 9) & 1) << 5)); }
__host__ __device__ __forceinline__ void stage_rc(int b, int& R, int& C) { const int st = b / 1024, sb = b % 1024, swz = sb ^ (((sb >> 9) & 1) << 5); R = (st >> 1) * 16 + swz / 64; C = (st & 1) * 32 + (swz % 64) / 2; }
__host__ __device__ __forceinline__ int perm32(int rho) { const int n = rho >> 4, i = rho & 15; return 8 * (i >> 2) + 4 * n + (i & 3); }

struct Unit { int pm, pn; };
struct Gemm { const bf16_t* A; const bf16_t* Bt; int M, N, K; };

struct StaticOrder {
    int nM, nN, nwg, G, c;
    __host__ __device__ void init(int M, int N, int G_, int c_) { nM = M / BM; nN = N / BM; nwg = nM * nN; G = G_; c = c_; }
    __host__ __device__ bool next(int i, Unit& u) const {
        const long L = (long)i * G + c; if (L >= nwg) return false;
        int wgid = (int)L; { const int q = nwg / NXCD, r = nwg % NXCD, xcd = wgid % NXCD, off = wgid / NXCD; wgid = (xcd < r ? xcd * (q + 1) : r * (q + 1) + (xcd - r) * q) + off; }
        const int nig = WGM * nN, gid = wgid / nig, fm = gid * WGM, gsz = (nM - fm) < WGM ? (nM - fm) : WGM;
        u.pm = fm + ((wgid % nig) % gsz); u.pn = (wgid % nig) / gsz; return true;
    }
    __device__ __forceinline__ void a_ready(const Unit&) const {}
    __device__ __forceinline__ void done(const Unit&) const {}
};

__device__ __forceinline__ unsigned cvt_pk_bf16(float lo, float hi) { unsigned r; asm volatile("v_cvt_pk_bf16_f32 %0, %1, %2" : "=v"(r) : "v"(lo), "v"(hi)); return r; }
typedef float f32x2 __attribute__((ext_vector_type(2)));
__device__ __forceinline__ float bf_lo(unsigned w) { return __uint_as_float(w << 16); }
__device__ __forceinline__ float bf_hi(unsigned w) { return __uint_as_float(w & 0xffff0000u); }
__device__ __forceinline__ float sigmoidf_(float x) { return 1.0f / (1.0f + __expf(-x)); }

struct EpiF32 {
    static constexpr bool PERM = false, AFTER_DRAIN = false;
    float* C; int ldc; int pad;
    __device__ __forceinline__ void operator()(const f32x4 (&acc)[2][2][4][2], const Unit& u, int wr, int wc, int fr, int fq) const {
        const int row0 = u.pm * BM + wr * 64 + fr, col0 = u.pn * BM + wc * 32 + 4 * fq;
#pragma unroll
        for (int ai = 0; ai < 2; ++ai)
#pragma unroll
            for (int m = 0; m < 4; ++m) { float* rowp = C + (size_t)(row0 + ai * HALF + m * 16) * ldc + col0;
#pragma unroll
                for (int bj = 0; bj < 2; ++bj)
#pragma unroll
                    for (int n = 0; n < 2; ++n) *(f32x4*)(rowp + bj * HALF + n * 16) = acc[ai][bj][m][n]; }
    }
};
struct EpiResid {
    static constexpr bool PERM = false, AFTER_DRAIN = false;
    float* C; const float* X; int ldc; float alpha;
    __device__ __forceinline__ void operator()(const f32x4 (&acc)[2][2][4][2], const Unit& u, int wr, int wc, int fr, int fq) const {
        const int row0 = u.pm * BM + wr * 64 + fr, col0 = u.pn * BM + wc * 32 + 4 * fq;
#pragma unroll
        for (int ai = 0; ai < 2; ++ai)
#pragma unroll
            for (int m = 0; m < 4; ++m) { const size_t off = (size_t)(row0 + ai * HALF + m * 16) * ldc + col0;
#pragma unroll
                for (int bj = 0; bj < 2; ++bj)
#pragma unroll
                    for (int n = 0; n < 2; ++n) { const f32x4 xv = *(const f32x4*)(X + off + bj * HALF + n * 16);
                        *(f32x4*)(C + off + bj * HALF + n * 16) = acc[ai][bj][m][n] + xv * alpha; } }
    }
};
struct EpiProj {
    static constexpr bool PERM = true, AFTER_DRAIN = false;
    bf16_t* O; const float* bias; float* small; int ldc; int gate_lo; int small_tile; int pad;
    __device__ __forceinline__ void operator()(const f32x4 (&acc)[2][2][4][2], const Unit& u, int wr, int wc, int fr, int fq) const {
        const int row0 = u.pm * BM + wr * 64 + fr, col0 = u.pn * BM + wc * 32 + 8 * fq;
        if (u.pn == small_tile) {
            if (wc == 0) {
#pragma unroll
                for (int ai = 0; ai < 2; ++ai)
#pragma unroll
                    for (int m = 0; m < 4; ++m) { float* p = small + (size_t)(row0 + ai * HALF + m * 16) * 32 + 8 * fq;
                        *(f32x4*)p = acc[ai][0][m][0]; *(f32x4*)(p + 4) = acc[ai][0][m][1]; }
            }
            return;
        }
        const bool gate = u.pn >= gate_lo;
        f32x4 bv[2][2];
#pragma unroll
        for (int bj = 0; bj < 2; ++bj)
#pragma unroll
            for (int n = 0; n < 2; ++n) bv[bj][n] = gate ? *(const f32x4*)(bias + col0 + bj * HALF + 4 * n) : (f32x4){0.f, 0.f, 0.f, 0.f};
#pragma unroll
        for (int ai = 0; ai < 2; ++ai)
#pragma unroll
            for (int m = 0; m < 4; ++m) { bf16_t* rowp = O + (size_t)(row0 + ai * HALF + m * 16) * ldc + col0;
#pragma unroll
                for (int bj = 0; bj < 2; ++bj) { f32x4 v0 = acc[ai][bj][m][0] + bv[bj][0], v1 = acc[ai][bj][m][1] + bv[bj][1];
                    if (gate) {
#pragma unroll
                        for (int j = 0; j < 4; ++j) { v0[j] = sigmoidf_(v0[j]); v1[j] = sigmoidf_(v1[j]); } }
                    u32x4 w; w.x = cvt_pk_bf16(v0[0], v0[1]); w.y = cvt_pk_bf16(v0[2], v0[3]); w.z = cvt_pk_bf16(v1[0], v1[1]); w.w = cvt_pk_bf16(v1[2], v1[3]);
                    *(u32x4*)(rowp + bj * HALF) = w; } }
    }
};
template <int FIRST> struct EpiMix {
    static constexpr bool PERM = true, AFTER_DRAIN = false;
    bf16_t* O; const bf16_t* G; int ldc; int ldg;
    __device__ __forceinline__ void operator()(const f32x4 (&acc)[2][2][4][2], const Unit& u, int wr, int wc, int fr, int fq) const {
        const int row0 = u.pm * BM + wr * 64 + fr, col0 = u.pn * BM + wc * 32 + 8 * fq;
#pragma unroll
        for (int ai = 0; ai < 2; ++ai)
#pragma unroll
            for (int m = 0; m < 4; ++m) { const int row = row0 + ai * HALF + m * 16; bf16_t* rowp = O + (size_t)row * ldc + col0; const bf16_t* gp = G + (size_t)row * ldg + col0;
#pragma unroll
                for (int bj = 0; bj < 2; ++bj) { const u32x4 gw = *(const u32x4*)(gp + bj * HALF); u32x4 ow = (u32x4){0u, 0u, 0u, 0u}; if (!FIRST) ow = *(const u32x4*)(rowp + bj * HALF);
                    const f32x4 a0 = acc[ai][bj][m][0], a1 = acc[ai][bj][m][1];
                    float r0 = bf_lo(ow.x) + bf_lo(gw.x) * a0[0], r1 = bf_hi(ow.x) + bf_hi(gw.x) * a0[1], r2 = bf_lo(ow.y) + bf_lo(gw.y) * a0[2], r3 = bf_hi(ow.y) + bf_hi(gw.y) * a0[3];
                    float r4 = bf_lo(ow.z) + bf_lo(gw.z) * a1[0], r5 = bf_hi(ow.z) + bf_hi(gw.z) * a1[1], r6 = bf_lo(ow.w) + bf_lo(gw.w) * a1[2], r7 = bf_hi(ow.w) + bf_hi(gw.w) * a1[3];
                    u32x4 w; w.x = cvt_pk_bf16(r0, r1); w.y = cvt_pk_bf16(r2, r3); w.z = cvt_pk_bf16(r4, r5); w.w = cvt_pk_bf16(r6, r7);
                    *(u32x4*)(rowp + bj * HALF) = w; } }
    }
};

template <class Epi, class Sched, bool ALIGN_EPI = false, bool SP2 = false>
__device__ __forceinline__ void gemm_phase(PG8_LAS unsigned char* lds, const Gemm g, const Sched& S, const Epi& E, int tid_) {
    asm volatile("" : "+v"(tid_));
    const int tid = tid_, wid = __builtin_amdgcn_readfirstlane(tid >> 6), lane = tid & 63, wr = wid >> 2, wc = wid & 3, fr = lane & 15, fq = lane >> 4;
    const int K = g.K, nt = K / BK;
    unsigned voffA[2], voffB[2];
#pragma unroll
    for (int i = 0; i < 2; ++i) { int R, C; stage_rc(tid * 16 + i * 8192, R, C); const int Rb = Epi::PERM ? ((R & ~31) + perm32(R & 31)) : R;
        voffA[i] = (unsigned)(R * K + C) * 2u; voffB[i] = (unsigned)(Rb * K + C) * 2u; }
    const size_t kstep = (size_t)(BK * 2);
    const size_t hstep = (size_t)HALF * K * 2;
    const size_t tstep = 2 * hstep;
    const unsigned ldsw = (unsigned)wid * 1024u;
    const int aoff = lds_byte(wr * 64 + fr, fq * 8), boff = lds_byte(wc * 32 + fr, fq * 8);
#define PG8_SA(b, h) (((b) * 2 + (h)) * HTB)
#define PG8_SB(b, h) ((4 + (b) * 2 + (h)) * HTB)
#define PG8_STAGE(bufoff, gbase, voff) do { _Pragma("unroll") for (int _i = 0; _i < 2; ++_i) \
        __builtin_amdgcn_global_load_lds((const unsigned*)((const char*)(gbase) + (voff)[_i]), (PG8_LAS unsigned*)(lds + (bufoff) + ldsw + _i * 8192), 16, 0, 0); } while (0)
#define PG8_LDA(dst, b, h) do { _Pragma("unroll") for (int m = 0; m < 4; ++m) _Pragma("unroll") for (int k = 0; k < 2; ++k) dst[m][k] = *(const PG8_LAS bf16x8*)(lds + PG8_SA(b, h) + aoff + m * 2048 + k * 1024); } while (0)
#define PG8_LDB(dst, b, h) do { _Pragma("unroll") for (int n = 0; n < 2; ++n) _Pragma("unroll") for (int k = 0; k < 2; ++k) dst[n][k] = *(const PG8_LAS bf16x8*)(lds + PG8_SB(b, h) + boff + n * 2048 + k * 1024); } while (0)
#define PG8_MMA(ai, bj, At, Bt) do { __builtin_amdgcn_s_setprio(1); _Pragma("unroll") for (int m = 0; m < 4; ++m) _Pragma("unroll") for (int n = 0; n < 2; ++n) _Pragma("unroll") for (int k = 0; k < 2; ++k) \
        acc[ai][bj][m][n] = __builtin_amdgcn_mfma_f32_16x16x32_bf16(Bt[n][k], At[m][k], acc[ai][bj][m][n], 0, 0, 0); __builtin_amdgcn_s_setprio(0); } while (0)
#define PG8_WAIT_V(n) asm volatile("s_waitcnt vmcnt(" #n ")" ::: "memory")
#define PG8_WAIT_L(n) asm volatile("s_waitcnt lgkmcnt(" #n ")" ::: "memory")
#define PG8_BAR __builtin_amdgcn_s_barrier()
#define PG8_SCHED __builtin_amdgcn_sched_barrier(0)
    Unit cur, nxt; int ui = 0;
    if (!S.next(0, cur)) return;
    f32x4 acc[2][2][4][2];
#pragma unroll
    for (int a = 0; a < 2; ++a)
#pragma unroll
        for (int b = 0; b < 2; ++b)
#pragma unroll
            for (int m = 0; m < 4; ++m)
#pragma unroll
                for (int n = 0; n < 2; ++n) acc[a][b][m][n] = (f32x4){0.f, 0.f, 0.f, 0.f};
    bf16x8 At[4][2], B0[2][2], B1[2][2];
    const char* cA = (const char*)g.A + (size_t)cur.pm * tstep; const char* cB = (const char*)g.Bt + (size_t)cur.pn * tstep;
    S.a_ready(cur);
    if constexpr (SP2) {
        PG8_STAGE(PG8_SB(0, 0), cB, voffB); PG8_STAGE(PG8_SB(0, 1), cB + hstep, voffB); PG8_STAGE(PG8_SA(0, 0), cA, voffA); PG8_STAGE(PG8_SA(0, 1), cA + hstep, voffA);
        if (wr == 1) PG8_BAR;
        PG8_WAIT_V(2); PG8_BAR;
        PG8_STAGE(PG8_SB(1, 0), cB + kstep, voffB); PG8_STAGE(PG8_SA(1, 0), cA + kstep, voffA); PG8_STAGE(PG8_SB(1, 1), cB + hstep + kstep, voffB);
        PG8_WAIT_V(6); PG8_BAR;
    } else {
        PG8_STAGE(PG8_SB(0, 0), cB, voffB); PG8_STAGE(PG8_SA(0, 0), cA, voffA); PG8_STAGE(PG8_SB(0, 1), cB + hstep, voffB); PG8_STAGE(PG8_SA(0, 1), cA + hstep, voffA);
        if (wr == 1) PG8_BAR;
        PG8_WAIT_V(4); PG8_BAR;
        PG8_STAGE(PG8_SB(1, 0), cB + kstep, voffB); PG8_STAGE(PG8_SA(1, 0), cA + kstep, voffA); PG8_STAGE(PG8_SB(1, 1), cB + hstep + kstep, voffB);
        PG8_WAIT_V(6); PG8_BAR;
    }
    for (;;) {
        const bool has_next = S.next(ui + 1, nxt);
        const char* nA = has_next ? (const char*)g.A + (size_t)nxt.pm * tstep : cA; const char* nB = has_next ? (const char*)g.Bt + (size_t)nxt.pn * tstep : cB;
        for (int t = 0; t < nt; t += 2) {
            const bool last = (t == nt - 2);
            const char* a1 = cA + (size_t)(t + 1) * kstep;
            const char* a2 = last ? nA : cA + (size_t)(t + 2) * kstep; const char* b2 = last ? nB : cB + (size_t)(t + 2) * kstep;
            const char* a3 = a2 + kstep; const char* b3 = b2 + kstep;
            if (last && has_next) S.a_ready(nxt);
            if constexpr (SP2) {
            PG8_LDB(B0, 0, 0); PG8_LDB(B1, 0, 1); PG8_SCHED; PG8_LDA(At, 0, 0); PG8_STAGE(PG8_SA(1, 1), a1 + hstep, voffA);
            PG8_WAIT_V(8); PG8_WAIT_L(0); PG8_BAR; PG8_MMA(0, 0, At, B0); PG8_MMA(0, 1, At, B1); PG8_BAR; PG8_SCHED;
            PG8_LDA(At, 0, 1); PG8_STAGE(PG8_SB(0, 0), b2, voffB); PG8_STAGE(PG8_SB(0, 1), b2 + hstep, voffB); PG8_STAGE(PG8_SA(0, 0), a2, voffA);
            PG8_WAIT_V(8); PG8_WAIT_L(0); PG8_BAR; PG8_MMA(1, 0, At, B0); PG8_MMA(1, 1, At, B1); PG8_BAR; PG8_SCHED;
            PG8_LDB(B0, 1, 0); PG8_LDB(B1, 1, 1); PG8_SCHED; PG8_LDA(At, 1, 0); PG8_STAGE(PG8_SA(0, 1), a2 + hstep, voffA);
            PG8_WAIT_V(8); PG8_WAIT_L(0); PG8_BAR; PG8_MMA(0, 0, At, B0); PG8_MMA(0, 1, At, B1); PG8_BAR; PG8_SCHED;
            PG8_LDA(At, 1, 1); PG8_STAGE(PG8_SB(1, 0), b3, voffB); PG8_STAGE(PG8_SB(1, 1), b3 + hstep, voffB); PG8_STAGE(PG8_SA(1, 0), a3, voffA);
            PG8_WAIT_V(8); PG8_WAIT_L(0); PG8_BAR; PG8_MMA(1, 0, At, B0); PG8_MMA(1, 1, At, B1); PG8_BAR; PG8_SCHED;
            } else {
            PG8_LDB(B0, 0, 0); PG8_SCHED; PG8_LDA(At, 0, 0); PG8_STAGE(PG8_SA(1, 1), a1 + hstep, voffA);
            PG8_WAIT_L(8); PG8_BAR; PG8_WAIT_L(0); PG8_MMA(0, 0, At, B0); PG8_BAR; PG8_SCHED;
            PG8_LDB(B1, 0, 1); PG8_STAGE(PG8_SB(0, 0), b2, voffB);
            PG8_BAR; PG8_WAIT_L(0); PG8_MMA(0, 1, At, B1); PG8_BAR;
            PG8_LDA(At, 0, 1); PG8_STAGE(PG8_SA(0, 0), a2, voffA);
            PG8_BAR; PG8_WAIT_L(0); PG8_MMA(1, 0, At, B0); PG8_BAR; PG8_SCHED;
            PG8_STAGE(PG8_SB(0, 1), b2 + hstep, voffB);
            PG8_WAIT_V(6); PG8_BAR; PG8_MMA(1, 1, At, B1); PG8_BAR;
            PG8_LDB(B0, 1, 0); PG8_SCHED; PG8_LDA(At, 1, 0); PG8_STAGE(PG8_SA(0, 1), a2 + hstep, voffA);
            PG8_WAIT_L(8); PG8_BAR; PG8_WAIT_L(0); PG8_MMA(0, 0, At, B0); PG8_BAR; PG8_SCHED;
            PG8_LDB(B1, 1, 1); PG8_STAGE(PG8_SB(1, 0), b3, voffB);
            PG8_BAR; PG8_WAIT_L(0); PG8_MMA(0, 1, At, B1); PG8_BAR;
            PG8_LDA(At, 1, 1); PG8_STAGE(PG8_SA(1, 0), a3, voffA);
            PG8_BAR; PG8_WAIT_L(0); PG8_MMA(1, 0, At, B0); PG8_BAR; PG8_SCHED;
            PG8_STAGE(PG8_SB(1, 1), b3 + hstep, voffB);
            PG8_WAIT_V(6); PG8_BAR; PG8_MMA(1, 1, At, B1); PG8_BAR;
            }
        }
        if constexpr (ALIGN_EPI) { if (wr == 0) PG8_BAR; }
        if constexpr (!Epi::AFTER_DRAIN) { E(acc, cur, wr, wc, fr, fq); S.done(cur); }
        if (!has_next) break;
#pragma unroll
        for (int a = 0; a < 2; ++a)
#pragma unroll
            for (int b = 0; b < 2; ++b)
#pragma unroll
                for (int m = 0; m < 4; ++m)
#pragma unroll
                    for (int n = 0; n < 2; ++n) acc[a][b][m][n] = (f32x4){0.f, 0.f, 0.f, 0.f};
        cur = nxt; cA = nA; cB = nB; ++ui;
        if constexpr (ALIGN_EPI) { if (wr == 1) PG8_BAR; }
    }
    PG8_WAIT_V(0);
    if constexpr (!ALIGN_EPI) { if (wr == 0) PG8_BAR; }
    PG8_BAR;
    if constexpr (Epi::AFTER_DRAIN) { E.fused(acc, cur, wr, wc, fr, fq, lds, wid, lane); S.done(cur); }
#undef PG8_SA
#undef PG8_SB
#undef PG8_STAGE
#undef PG8_LDA
#undef PG8_LDB
#undef PG8_MMA
#undef PG8_WAIT_V
#undef PG8_WAIT_L
#undef PG8_BAR
#undef PG8_SCHED
}
}
typedef unsigned short bf16;
#define LAS __attribute__((address_space(3)))
constexpr int T_TOK = 32768, DM = 2048, SEQ = 4096, NBATCH = 8, DEPTH = 4;
constexpr int IN_COLS = 13336, NP = 13568;
constexpr int C_MQ = 0, C_MK = 512, C_MV = 1024, C_MO = 2048, C_SZ = 3072, C_SXBC = 4096, C_AQ = 5632, C_AK = 6656, C_AV = 6912, C_G = 7168, C_SMALL = 13312;
constexpr int GATE_TILE_LO = C_G / 256, SMALL_TILE = C_SMALL / 256;
constexpr float ALPHA = 1.681792830507429f;
constexpr int P_EXPERTS = 16384;

constexpr size_t MiB = 1u << 20;
constexpr size_t WS_CTL = 0, CTL_ZERO_BYTES = 64 * 1024, WS_WIN = 1 * MiB, WS_WB = 54 * MiB, WS_WO = 66 * MiB, WS_WQ = 74 * MiB, WS_BIAS = 82 * MiB, WS_SMALL = 83 * MiB,
                 WS_XB = 88 * MiB, WS_BUFB = 216 * MiB, WS_PROJ = 472 * MiB, WS_R1 = 1320 * MiB, WS_Y = 1480 * MiB, WS_R2 = 1672 * MiB, WS_HM = 1864 * MiB, WS_END = 1992 * MiB;
constexpr size_t WS_QF = WS_PROJ, WS_IDS = WS_PROJ + 256 * MiB, WS_GATES = WS_PROJ + 272 * MiB;
constexpr int CW_BAR = 4096;
constexpr int RING_BYTES = 131072, MISC_OFF = RING_BYTES + 320, LDS_BYTES = 147456;

__device__ __forceinline__ unsigned f2bf(float f) { unsigned u = __float_as_uint(f); return (u + 0x7fffu + ((u >> 16) & 1u)) >> 16; }
__device__ __forceinline__ unsigned pk2(float lo, float hi) { return f2bf(lo) | (f2bf(hi) << 16); }
__device__ __forceinline__ float bf2f(bf16 b) { return __uint_as_float(((unsigned)b) << 16); }
__device__ __forceinline__ float sigm(float x) { return 1.0f / (1.0f + expf(-x)); }
template <int CTRL> __device__ __forceinline__ float dpp_f(float v) { return __builtin_bit_cast(float, __builtin_amdgcn_update_dpp(0, __builtin_bit_cast(int, v), CTRL, 0xF, 0xF, true)); }
__device__ __forceinline__ float quad_sum(float v) { v += dpp_f<0xB1>(v); v += dpp_f<0x4E>(v); return v; }
__device__ __forceinline__ float wave_sum(float v) {
    v = quad_sum(v); v += dpp_f<0x141>(v); v += dpp_f<0x140>(v);
    v += __builtin_bit_cast(float, __builtin_amdgcn_ds_swizzle(__builtin_bit_cast(int, v), 0x401F));
    return __builtin_bit_cast(float, __builtin_amdgcn_readlane(__builtin_bit_cast(int, v), 0)) + __builtin_bit_cast(float, __builtin_amdgcn_readlane(__builtin_bit_cast(int, v), 32));
}
__device__ __forceinline__ int src_col(int n) {
    if (n < 3072) return n;
    if (n < 5632) return n + 8;
    if (n < 13312) return n + 24;
    if (n < 13320) return 3072 + (n - 13312);
    if (n < 13336) return 5640 + (n - 13320);
    return -1;
}

#define XB_TMO      128
#define XB_XCNT(j)  (256  + 64 * (j))
#define XB_XSUB(j)  (1280 + 64 * (j))
#define XB_XGEN(j)  (2304 + 64 * (j))
#define XB_TOP      3328
#define XB_TOPGEN   3392
#define XCD_BAR_WORDS 3456
#define XB_SPIN_CAP (1u << 18)

__device__ __forceinline__ unsigned xb_ld(unsigned* p)              { return __hip_atomic_load(p, __ATOMIC_RELAXED, __HIP_MEMORY_SCOPE_AGENT); }
__device__ __forceinline__ unsigned xb_add(unsigned* p, unsigned v) { return __hip_atomic_fetch_add(p, v, __ATOMIC_RELAXED, __HIP_MEMORY_SCOPE_AGENT); }
__device__ __forceinline__ unsigned xb_xcc_id() { return (unsigned)__builtin_amdgcn_s_getreg((3 << 11) | 20) & 0xFu; }
#define XB_SPIN(cond, bar) do { unsigned _sp = 0; while (cond) { __builtin_amdgcn_s_sleep(1); \
    if ((++_sp & 255u) == 0u) { if (xb_ld(&(bar)[XB_TMO])) break; if (_sp > XB_SPIN_CAP) { atomicAdd(&(bar)[XB_TMO], 1u); break; } } } } while (0)

struct XcdBarrier {
    unsigned* bar; unsigned x;
    volatile LAS unsigned* st;
};

__device__ __forceinline__ XcdBarrier xcd_barrier_post(unsigned* bar, volatile LAS unsigned* st) {
    XcdBarrier b; b.bar = bar; b.x = xb_xcc_id(); b.st = st;
    if (threadIdx.x == 0) (void)xb_add(&bar[XB_XCNT(b.x)], 1u);
    return b;
}
__device__ __forceinline__ void xcd_barrier_complete(unsigned* bar, unsigned x, unsigned& nloc, unsigned& nx) {
    const unsigned G = gridDim.x * gridDim.y * gridDim.z;
    unsigned sum, cnt, mine, sp = 0u;
    for (;;) {
        sum = 0u; cnt = 0u; mine = 0u;
#pragma unroll
        for (unsigned j = 0; j < 16; ++j) { const unsigned c = xb_ld(&bar[XB_XCNT(j)]); sum += c; cnt += (c > 0u) ? 1u : 0u; mine = (j == x) ? c : mine; }
        if (sum == G) break;
        __builtin_amdgcn_s_sleep(1);
        if ((++sp & 255u) == 0u) { if (xb_ld(&bar[XB_TMO])) break; if (sp > XB_SPIN_CAP) { atomicAdd(&bar[XB_TMO], 1u); break; } }
    }
    nloc = mine > 0u ? mine : 1u; nx = cnt > 0u ? cnt : 1u;
}

__device__ __forceinline__ void xcd_barrier(const XcdBarrier& b) {
    asm volatile("s_waitcnt vmcnt(0)" ::: "memory");
    __syncthreads();
    if (threadIdx.x == 0) {
        unsigned* bar = b.bar;
        __builtin_amdgcn_s_waitcnt(0);
        unsigned nloc = b.st[0], nx = b.st[1];
        if (nloc == 0u) { xcd_barrier_complete(bar, b.x, nloc, nx); b.st[0] = nloc; b.st[1] = nx; }
        const unsigned old = xb_add(&bar[XB_XSUB(b.x)], 1u);
        const unsigned gen = old / nloc;
        if (old + 1u == (gen + 1u) * nloc) {
            __builtin_amdgcn_fence(__ATOMIC_RELEASE, "agent");
            asm volatile("s_waitcnt vmcnt(0)" ::: "memory");
            const unsigned og = xb_add(&bar[XB_TOP], 1u);
            const unsigned tg = og / nx;
            if (og + 1u == (tg + 1u) * nx) xb_add(&bar[XB_TOPGEN], 1u);
            else XB_SPIN(xb_ld(&bar[XB_TOPGEN]) == tg, bar);
            __builtin_amdgcn_fence(__ATOMIC_ACQUIRE, "agent");
            xb_add(&bar[XB_XGEN(b.x)], 1u);
            asm volatile("s_waitcnt vmcnt(0)" ::: "memory");
        } else {
            XB_SPIN(xb_ld(&bar[XB_XGEN(b.x)]) == gen, bar);
            __builtin_amdgcn_fence(__ATOMIC_ACQUIRE, "agent");
            asm volatile("s_waitcnt vmcnt(0)" ::: "memory");
        }
    }
    __syncthreads();
}

__device__ __forceinline__ int fresh_tid(int wave0) { int l; asm volatile("v_mbcnt_lo_u32_b32 %0, -1, 0\n\tv_mbcnt_hi_u32_b32 %0, -1, %0" : "=v"(l)); return wave0 * 64 + l; }
#define PHASE_IDS int G = gridDim.x, bx = blockIdx.x; asm volatile("" : "+s"(G), "+s"(bx)); const int tid = fresh_tid(wave0), lane = tid & 63, wave = wave0; const int gw = bx * 8 + wave, NGW = G * 8; \
    const size_t gt = (size_t)bx * 512 + tid, NGT = (size_t)G * 512; (void)lane; (void)gw; (void)gt; (void)NGW; (void)NGT; (void)wave;

template <int MODE> __device__ __forceinline__ void transpose_item(const float* __restrict__ W, int K, int ldw, int ndst, bf16* __restrict__ WT, LAS float* scr, int item, int lane) {
    const int nblk = ndst / 32, kb = item / nblk, nb = item % nblk, k0 = 64 * kb, n0 = 32 * nb;
    const int n_l = n0 + (lane & 31); const int sc = MODE ? src_col(n_l) : n_l;
#pragma unroll 8
    for (int i = 0; i < 32; ++i) { const int kk = 2 * i + (lane >> 5); scr[kk * 33 + (lane & 31)] = sc >= 0 ? W[(size_t)(k0 + kk) * ldw + sc] : 0.f; }
    asm volatile("s_waitcnt lgkmcnt(0)" ::: "memory");
    const int c = lane & 7;
#pragma unroll
    for (int j = 0; j < 4; ++j) { const int n = (lane >> 3) + 8 * j; const LAS float* s = scr + (8 * c) * 33 + n;
        uint4 o; o.x = pk2(s[0 * 33], s[1 * 33]); o.y = pk2(s[2 * 33], s[3 * 33]); o.z = pk2(s[4 * 33], s[5 * 33]); o.w = pk2(s[6 * 33], s[7 * 33]);
        *(uint4*)(WT + (size_t)(n0 + n) * K + k0 + 8 * c) = o; }
    asm volatile("s_waitcnt lgkmcnt(0)" ::: "memory");
}

__device__ __forceinline__ void rope_body(size_t gid, const bf16* __restrict__ proj, float* __restrict__ qr, float* __restrict__ kr) {
    const int i = (int)(gid & 31), hh = (int)((gid >> 5) % 20), t = (int)(gid / 640);
    const int pos = t % SEQ;
    const float freq = powf(10000.0f, -(float)i / 32.0f), ang = (float)pos * freq, c = cosf(ang), s = sinf(ang);
    const bf16* src; float* dst;
    if (hh < 16) { src = proj + (size_t)t * NP + C_AQ + hh * 64; dst = qr + (size_t)t * 1024 + hh * 64; }
    else { src = proj + (size_t)t * NP + C_AK + (hh - 16) * 64; dst = kr + (size_t)t * 256 + (hh - 16) * 64; }
    const float x1 = bf2f(src[i]), x2 = bf2f(src[32 + i]);
    dst[i] = x1 * c - x2 * s; dst[32 + i] = x2 * c + x1 * s;
}
__device__ __forceinline__ void swa_body(int gid, const float* __restrict__ qr, const float* __restrict__ kr, const bf16* __restrict__ proj, const float* __restrict__ sinks, bf16* __restrict__ ya) {
    const int hq = gid & 15, t = gid >> 4, b = t / SEQ, pos = t % SEQ, g = hq >> 2;
    float q[64], o[64];
#pragma unroll
    for (int d = 0; d < 64; ++d) { q[d] = qr[(size_t)t * 1024 + hq * 64 + d] * 0.125f; o[d] = 0.f; }
    float m = sinks[hq], l = 1.0f;
    const int j0 = pos >= 127 ? pos - 127 : 0;
    for (int j = j0; j <= pos; ++j) {
        const int tk = b * SEQ + j;
        const float* kp = kr + (size_t)tk * 256 + g * 64; const bf16* vp = proj + (size_t)tk * NP + C_AV + g * 64;
        float s = 0.f;
#pragma unroll
        for (int d = 0; d < 64; ++d) s += q[d] * kp[d];
        const float mn = fmaxf(m, s), sc = expf(m - mn), p = expf(s - mn);
        l = l * sc + p; m = mn;
#pragma unroll
        for (int d = 0; d < 64; ++d) o[d] = o[d] * sc + p * bf2f(vp[d]);
    }
    const float inv = 1.0f / l;
    bf16* op = ya + (size_t)t * 1024 + hq * 64;
#pragma unroll
    for (int d = 0; d < 64; d += 2) *(unsigned*)(op + d) = pk2(o[d] * inv, o[d + 1] * inv);
}

__device__ __forceinline__ void mlstm_body(int gid, const bf16* __restrict__ proj, const float* __restrict__ small, const float* __restrict__ gate_b, float* __restrict__ hm) {
    const int dq = gid & 3, v = (gid >> 2) & 255, h = (gid >> 10) & 3, b = gid >> 12;
    float C[32], n[32];
#pragma unroll
    for (int d = 0; d < 32; ++d) { C[d] = 0.f; n[d] = 0.f; }
    const float bi = gate_b[h], bfg = gate_b[4 + h];
    for (int pos = 0; pos < SEQ; ++pos) {
        const size_t t = (size_t)b * SEQ + pos;
        const float ip = small[t * 32 + h] + bi, fp = small[t * 32 + 4 + h] + bfg;
        const float f = sigm(fp), ig = expf(ip);
        const float vv = bf2f(proj[t * NP + C_MV + h * 256 + v]);
        const bf16* qp = proj + t * NP + C_MQ + h * 128 + dq * 32; const bf16* kp = proj + t * NP + C_MK + h * 128 + dq * 32;
        float num = 0.f, den = 0.f;
#pragma unroll
        for (int d = 0; d < 32; ++d) { const float kd = bf2f(kp[d]) * 0.08838834764831845f, qd = bf2f(qp[d]);
            C[d] = f * C[d] + (ig * kd) * vv; n[d] = f * n[d] + ig * kd; num += qd * C[d]; den += qd * n[d]; }
        num = quad_sum(num); den = quad_sum(den);
        if (dq == 0) hm[t * 1024 + h * 256 + v] = num / fmaxf(fabsf(den), 1.0f);
    }
}
__device__ __forceinline__ void mlstm_post_body(int w, int lane, const float* __restrict__ hm, const bf16* __restrict__ proj, const float* __restrict__ norm_w, bf16* __restrict__ ym) {
    const int h = w & 3, t = w >> 2;
    const float4 x = *(const float4*)(hm + (size_t)t * 1024 + h * 256 + lane * 4);
    const float mu = wave_sum((x.x + x.y) + (x.z + x.w)) * (1.0f / 256.0f);
    const float d0 = x.x - mu, d1 = x.y - mu, d2 = x.z - mu, d3 = x.w - mu;
    const float var = wave_sum((d0 * d0 + d1 * d1) + (d2 * d2 + d3 * d3)) * (1.0f / 256.0f);
    const float rs = rsqrtf(var + 1e-6f);
    const int c = h * 256 + lane * 4;
    const float4 nw = *(const float4*)(norm_w + c);
    const bf16* op = proj + (size_t)t * NP + C_MO + c;
    const float y0 = d0 * rs * nw.x * sigm(bf2f(op[0])), y1 = d1 * rs * nw.y * sigm(bf2f(op[1])), y2 = d2 * rs * nw.z * sigm(bf2f(op[2])), y3 = d3 * rs * nw.w * sigm(bf2f(op[3]));
    *(uint2*)(ym + (size_t)t * 1024 + c) = make_uint2(pk2(y0, y1), pk2(y2, y3));
}

__device__ __forceinline__ void ssd_conv_body(size_t gid, const bf16* __restrict__ proj, const float* __restrict__ cw, const float* __restrict__ cb, float* __restrict__ xc) {
    const int c = (int)(gid % 1536); const int t = (int)(gid / 1536); const int pos = t % SEQ;
    float acc = cb[c];
#pragma unroll
    for (int j = 0; j < 4; ++j) { const int pp = pos - 3 + j; if (pp >= 0) acc += cw[j * 1536 + c] * bf2f(proj[(size_t)(t - 3 + j) * NP + C_SXBC + c]); }
    xc[gid] = acc * sigm(acc);
}
__device__ __forceinline__ void ssd_scan_body(int gid, const float* xc, const float* __restrict__ small, const float* __restrict__ dt_bias, const float* __restrict__ a_log, const float* __restrict__ dsk, float* yraw) {
    const int nq = gid & 3, p = (gid >> 2) & 63, hh = (gid >> 8) & 15, b = gid >> 12, g = hh >> 3;
    const float a = -expf(a_log[hh]), dtb = dt_bias[hh], Dk = dsk[hh];
    float hs[32];
#pragma unroll
    for (int n = 0; n < 32; ++n) hs[n] = 0.f;
    for (int pos = 0; pos < SEQ; ++pos) {
        const size_t t = (size_t)b * SEQ + pos;
        const float dtr = small[t * 32 + 8 + hh] + dtb; const float dt = dtr > 20.f ? dtr : log1pf(expf(dtr));
        const float dA = expf(dt * a), xv = xc[t * 1536 + hh * 64 + p], dx = dt * xv;
        const float* Bp = xc + t * 1536 + 1024 + g * 128 + nq * 32; const float* Cp = Bp + 256;
        float y = 0.f;
#pragma unroll
        for (int n = 0; n < 32; ++n) { hs[n] = dA * hs[n] + dx * Bp[n]; y += Cp[n] * hs[n]; }
        y = quad_sum(y);
        if (nq == 0) yraw[t * 1536 + hh * 64 + p] = y + Dk * xv;
    }
}
__device__ __forceinline__ void ssd_post_body(int w, int lane, const float* __restrict__ yraw, const bf16* __restrict__ proj, const float* __restrict__ norm_w, bf16* __restrict__ ys) {
    const int g = w & 1, t = w >> 1, c = g * 512 + lane * 8;
    float y[8]; float ss = 0.f;
#pragma unroll
    for (int i = 0; i < 8; ++i) { const float z = bf2f(proj[(size_t)t * NP + C_SZ + c + i]); y[i] = yraw[(size_t)t * 1536 + c + i] * (z * sigm(z)); ss += y[i] * y[i]; }
    const float rs = rsqrtf(wave_sum(ss) * (1.0f / 512.0f) + 1e-6f);
    unsigned o[4];
#pragma unroll
    for (int i = 0; i < 4; ++i) o[i] = pk2(y[2 * i] * rs * norm_w[c + 2 * i], y[2 * i + 1] * rs * norm_w[c + 2 * i + 1]);
    *(uint4*)(ys + (size_t)t * 1024 + c) = make_uint4(o[0], o[1], o[2], o[3]);
}

__device__ __forceinline__ void ln_body(int t, int lane, const float* in, const float* __restrict__ g, const float* __restrict__ bta, float* outf, bf16* __restrict__ outb) {
    float4 v[8]; float s = 0.f;
#pragma unroll
    for (int j = 0; j < 8; ++j) { v[j] = *(const float4*)(in + (size_t)t * DM + j * 256 + lane * 4); s += (v[j].x + v[j].y) + (v[j].z + v[j].w); }
    const float mu = wave_sum(s) * (1.0f / DM); float q = 0.f;
#pragma unroll
    for (int j = 0; j < 8; ++j) { v[j].x -= mu; v[j].y -= mu; v[j].z -= mu; v[j].w -= mu; q += (v[j].x * v[j].x + v[j].y * v[j].y) + (v[j].z * v[j].z + v[j].w * v[j].w); }
    const float rs = rsqrtf(wave_sum(q) * (1.0f / DM) + 1e-5f);
    asm volatile("" : "+s"(g), "+s"(bta));
#pragma unroll
    for (int j = 0; j < 8; ++j) { const int c = j * 256 + lane * 4; const float4 gg = *(const float4*)(g + c), bb = *(const float4*)(bta + c);
        float4 y; y.x = v[j].x * rs * gg.x + bb.x; y.y = v[j].y * rs * gg.y + bb.y; y.z = v[j].z * rs * gg.z + bb.z; y.w = v[j].w * rs * gg.w + bb.w;
        *(float4*)(outf + (size_t)t * DM + c) = y; *(uint2*)(outb + (size_t)t * DM + c) = make_uint2(pk2(y.x, y.y), pk2(y.z, y.w)); }
}

#define TOPK_INSERT(tv, ti, val, idx) do { _Pragma("unroll") for (int _j = 15; _j >= 1; --_j) { const bool _c1 = (val) > tv[_j - 1], _c0 = (val) > tv[_j]; \
        ti[_j] = _c1 ? ti[_j - 1] : (_c0 ? (idx) : ti[_j]); tv[_j] = _c1 ? tv[_j - 1] : (_c0 ? (val) : tv[_j]); } \
        { const bool _c0 = (val) > tv[0]; ti[0] = _c0 ? (idx) : ti[0]; tv[0] = _c0 ? (val) : tv[0]; } } while (0)
__device__ __forceinline__ void peer_select_body(int h, int t, const float* __restrict__ q, const float* __restrict__ subkeys, int* __restrict__ ids, float* __restrict__ gates) {
    float tv0[16], tv1[16]; int ti0[16], ti1[16];
#pragma unroll
    for (int j = 0; j < 16; ++j) { tv0[j] = -INFINITY; ti0[j] = 0; tv1[j] = -INFINITY; ti1[j] = 0; }
    {
        float qv[128];
        const float* qp = q + (size_t)t * DM + h * 256;
#pragma unroll
        for (int d = 0; d < 128; d += 4) { const float4 x = *(const float4*)(qp + d); qv[d] = x.x; qv[d + 1] = x.y; qv[d + 2] = x.z; qv[d + 3] = x.w; }
        const float* sk = subkeys + (size_t)(h * 2 + 0) * 128 * 128;
        for (int k = 0; k < 128; ++k) {
            float s = 0.f;
#pragma unroll
            for (int d = 0; d < 128; ++d) s += qv[d] * sk[k * 128 + d];
            TOPK_INSERT(tv0, ti0, s, k);
        }
    }
    {
        float qv[128];
        const float* qp = q + (size_t)t * DM + h * 256 + 128;
#pragma unroll
        for (int d = 0; d < 128; d += 4) { const float4 x = *(const float4*)(qp + d); qv[d] = x.x; qv[d + 1] = x.y; qv[d + 2] = x.z; qv[d + 3] = x.w; }
        const float* sk = subkeys + (size_t)(h * 2 + 1) * 128 * 128;
        for (int k = 0; k < 128; ++k) {
            float s = 0.f;
#pragma unroll
            for (int d = 0; d < 128; ++d) s += qv[d] * sk[k * 128 + d];
            TOPK_INSERT(tv1, ti1, s, k);
        }
    }
    float bv[16]; int bi[16];
#pragma unroll
    for (int j = 0; j < 16; ++j) { bv[j] = -INFINITY; bi[j] = 0; }
#pragma unroll
    for (int a = 0; a < 16; ++a)
#pragma unroll
        for (int b = 0; b < 16; ++b) if ((a + 1) * (b + 1) <= 16) { const float cv = tv0[a] + tv1[b]; const int ci = ti0[a] * 128 + ti1[b]; TOPK_INSERT(bv, bi, cv, ci); }
    float den = 0.f, e[16];
#pragma unroll
    for (int j = 0; j < 16; ++j) { e[j] = expf(bv[j] - bv[0]); den += e[j]; }
    const float inv = 1.0f / den;
#pragma unroll
    for (int j = 0; j < 16; ++j) { ids[(size_t)t * 128 + h * 16 + j] = bi[j]; gates[(size_t)t * 128 + h * 16 + j] = e[j] * inv; }
}
__device__ __forceinline__ float gelu_erf(float v) {
    const float av = fabsf(v), t = __builtin_amdgcn_rcpf(av * 0.2316418882f + 1.0f);
    float q = t * 0.5307027145f + (-0.7265760135f); q = q * t + 0.7107068705f; q = q * t + (-0.142248368f); q = q * t + 0.127414796f; q = q * t;
    const float e = __builtin_amdgcn_exp2f((v * v) * (-0.72134752044f));
    const float mm = v * (q * e), r = v - mm;
    return v < 0.f ? mm : r;
}
constexpr float U8_SCALE = 1024.0f, V8_SCALE = 128.0f;
typedef float f32x2_t __attribute__((ext_vector_type(2)));
__device__ __forceinline__ unsigned pack_fp8x4(float a, float b, float c, float d) { int w = 0; w = __builtin_amdgcn_cvt_pk_fp8_f32(a, b, w, false); w = __builtin_amdgcn_cvt_pk_fp8_f32(c, d, w, true); return (unsigned)w; }
__device__ __forceinline__ void tab_to_fp8(size_t i, const float* __restrict__ src, uint4* __restrict__ dst, float sc) {
    const float4* s = (const float4*)src + i * 4; const float4 a = s[0], b = s[1], c = s[2], d = s[3];
    dst[i] = make_uint4(pack_fp8x4(a.x * sc, a.y * sc, a.z * sc, a.w * sc), pack_fp8x4(b.x * sc, b.y * sc, b.z * sc, b.w * sc), pack_fp8x4(c.x * sc, c.y * sc, c.z * sc, c.w * sc), pack_fp8x4(d.x * sc, d.y * sc, d.z * sc, d.w * sc));
}
__device__ __forceinline__ float dot16_fp8(const uint4 w, const float4* xv, float s) {
    const unsigned ww[4] = {w.x, w.y, w.z, w.w};
#pragma unroll
    for (int j = 0; j < 4; ++j) { const f32x2_t lo = __builtin_amdgcn_cvt_pk_f32_fp8((int)ww[j], false), hi = __builtin_amdgcn_cvt_pk_f32_fp8((int)ww[j], true);
        s += (xv[j].x * lo.x + xv[j].y * lo.y) + (xv[j].z * hi.x + xv[j].w * hi.y); }
    return s;
}
__device__ __forceinline__ void axpy16_fp8(const uint4 w, float c, float4* acc) {
    const unsigned ww[4] = {w.x, w.y, w.z, w.w};
#pragma unroll
    for (int j = 0; j < 4; ++j) { const f32x2_t lo = __builtin_amdgcn_cvt_pk_f32_fp8((int)ww[j], false), hi = __builtin_amdgcn_cvt_pk_f32_fp8((int)ww[j], true);
        acc[j].x += c * lo.x; acc[j].y += c * lo.y; acc[j].z += c * hi.x; acc[j].w += c * hi.y; }
}
__device__ __forceinline__ void peer_expert_body(int t, int lane, const float* __restrict__ x1, const int* __restrict__ ids, const float* __restrict__ gates, const unsigned char* __restrict__ U8, const unsigned char* __restrict__ V8,
                                                 const float* __restrict__ g, const float* __restrict__ bta, float* __restrict__ outf, bf16* __restrict__ outb) {
    float4 xv[8], acc[8];
#pragma unroll
    for (int j = 0; j < 2; ++j)
#pragma unroll
        for (int i = 0; i < 4; ++i) { xv[j * 4 + i] = *(const float4*)(x1 + (size_t)t * DM + j * 1024 + lane * 16 + i * 4); acc[j * 4 + i] = make_float4(0.f, 0.f, 0.f, 0.f); }
    const int* idp = ids + (size_t)t * 128; const float* gp = gates + (size_t)t * 128;
    uint4 ua[2][2], va[2][2], ub[2][2], vb[2][2];
#define PEER_LOAD(U_, V_, e_) do { _Pragma("unroll") for (int k_ = 0; k_ < 2; ++k_) { const int id_ = __builtin_amdgcn_readfirstlane(idp[(e_) + k_]); \
        const uint4* up_ = (const uint4*)(U8 + (size_t)id_ * DM) + lane; const uint4* vp_ = (const uint4*)(V8 + (size_t)id_ * DM) + lane; \
        U_[k_][0] = up_[0]; U_[k_][1] = up_[64]; V_[k_][0] = vp_[0]; V_[k_][1] = vp_[64]; } } while (0)
#define SB_ __builtin_amdgcn_sched_barrier(0)
#define PEER_COMP(U_, V_, e_) do { SB_; float s0_ = dot16_fp8(U_[0][0], xv, 0.f); SB_; s0_ = dot16_fp8(U_[0][1], xv + 4, s0_); SB_; float s1_ = dot16_fp8(U_[1][0], xv, 0.f); SB_; s1_ = dot16_fp8(U_[1][1], xv + 4, s1_); SB_; \
        s0_ = wave_sum(s0_); s1_ = wave_sum(s1_); \
        s0_ *= (1.0f / U8_SCALE); s1_ *= (1.0f / U8_SCALE); \
        const float c0_ = gp[(e_)] * (1.0f / V8_SCALE) * gelu_erf(s0_), c1_ = gp[(e_) + 1] * (1.0f / V8_SCALE) * gelu_erf(s1_); SB_; \
        axpy16_fp8(V_[0][0], c0_, acc); SB_; axpy16_fp8(V_[0][1], c0_, acc + 4); SB_; axpy16_fp8(V_[1][0], c1_, acc); SB_; axpy16_fp8(V_[1][1], c1_, acc + 4); SB_; } while (0)
    PEER_LOAD(ua, va, 0);
#pragma nounroll
    for (int e = 0; e < 128; e += 4) {
        PEER_LOAD(ub, vb, e + 2);
        PEER_COMP(ua, va, e);
        if (e + 4 < 128) PEER_LOAD(ua, va, e + 4);
        PEER_COMP(ub, vb, e + 2);
    }
#undef PEER_LOAD
#undef PEER_COMP
#undef SB_
    float s = 0.f;
#pragma unroll
    for (int j = 0; j < 8; ++j) { acc[j].x += ALPHA * xv[j].x; acc[j].y += ALPHA * xv[j].y; acc[j].z += ALPHA * xv[j].z; acc[j].w += ALPHA * xv[j].w; s += (acc[j].x + acc[j].y) + (acc[j].z + acc[j].w); }
    const float mu = wave_sum(s) * (1.0f / DM); float q = 0.f;
#pragma unroll
    for (int j = 0; j < 8; ++j) { acc[j].x -= mu; acc[j].y -= mu; acc[j].z -= mu; acc[j].w -= mu; q += (acc[j].x * acc[j].x + acc[j].y * acc[j].y) + (acc[j].z * acc[j].z + acc[j].w * acc[j].w); }
    const float rs = rsqrtf(wave_sum(q) * (1.0f / DM) + 1e-5f);
    asm volatile("" : "+s"(g), "+s"(bta));
#pragma unroll
    for (int j = 0; j < 2; ++j)
#pragma unroll
        for (int i = 0; i < 4; ++i) { const int c = j * 1024 + lane * 16 + i * 4; const float4 a4 = acc[j * 4 + i]; const float4 gg = *(const float4*)(g + c), bb = *(const float4*)(bta + c);
            float4 y; y.x = a4.x * rs * gg.x + bb.x; y.y = a4.y * rs * gg.y + bb.y; y.z = a4.z * rs * gg.z + bb.z; y.w = a4.w * rs * gg.w + bb.w;
            *(float4*)(outf + (size_t)t * DM + c) = y; *(uint2*)(outb + (size_t)t * DM + c) = make_uint2(pk2(y.x, y.y), pk2(y.z, y.w)); }
}

struct MegaArgs { const float* in[22]; float* out; unsigned char* ws; };
template <int I> __device__ __forceinline__ unsigned long long ld_ptr() {
    unsigned long long v; const auto ka = __builtin_amdgcn_kernarg_segment_ptr();
    asm volatile("s_load_dwordx2 %0, %1, %2\n\ts_waitcnt lgkmcnt(0)" : "=s"(v) : "s"(ka), "n"(I * 8) : "memory");
    return v;
}
#define INF(i) ((const float*)ld_ptr<(i)>())
#define OUTP ((float*)ld_ptr<22>())
#define WSP ((unsigned char*)ld_ptr<23>())
enum { I_X = 0, I_WIN, I_MGATEB, I_MNORMW, I_CONVW, I_CONVB, I_DTB, I_ALOG, I_SSMD, I_SNORMW, I_SINKS, I_MERGEB, I_WBR, I_WOUT, I_LN1G, I_LN1B, I_WQ, I_SUBK, I_PU, I_PV, I_LN2G, I_LN2B };

__global__ void __launch_bounds__(512, 2) mega_fwd(MegaArgs a) {
    extern __shared__ __attribute__((aligned(16))) unsigned char lds_raw[];
    LAS unsigned char* lds = (LAS unsigned char*)lds_raw;
    const int wave0 = __builtin_amdgcn_readfirstlane(threadIdx.x >> 6);
    volatile LAS unsigned* MISC = (volatile LAS unsigned*)(lds + MISC_OFF);
    { PHASE_IDS for (int u = tid; u < (LDS_BYTES - RING_BYTES) / 4; u += 512) ((LAS unsigned*)(lds + RING_BYTES))[u] = 0u; }
    __syncthreads();
    { XcdBarrier b0 = xcd_barrier_post((unsigned*)(WSP + WS_CTL) + CW_BAR, MISC + 8); (void)b0; }
#define GRID_BAR() do { XcdBarrier b_; b_.bar = (unsigned*)(WSP + WS_CTL) + CW_BAR; b_.x = xb_xcc_id(); b_.st = MISC + 8; xcd_barrier(b_); } while (0)

    { PHASE_IDS const float* x = INF(I_X); bf16* xb = (bf16*)(WSP + WS_XB);
      for (size_t i = gt; i < (size_t)T_TOK * DM / 4; i += NGT) { const float4 v = ((const float4*)x)[i]; ((uint2*)xb)[i] = make_uint2(pk2(v.x, v.y), pk2(v.z, v.w)); } }

#pragma nounroll
    for (int l = 0; l < DEPTH; ++l) {
        { PHASE_IDS
            unsigned char* ws = WSP; bf16* WinT = (bf16*)(ws + WS_WIN); bf16* WbT = (bf16*)(ws + WS_WB); bf16* WoT = (bf16*)(ws + WS_WO); bf16* WqT = (bf16*)(ws + WS_WQ); float* bias = (float*)(ws + WS_BIAS);
            const float* w_in = INF(I_WIN) + (size_t)l * DM * IN_COLS; const float* w_branch = INF(I_WBR) + (size_t)l * 3 * 1024 * DM; const float* w_out = INF(I_WOUT) + (size_t)l * DM * DM; const float* peer_wq = INF(I_WQ) + (size_t)l * DM * DM;
            const float* merge_gate_b = INF(I_MERGEB) + (size_t)l * 3 * DM;
            LAS float* scr = (LAS float*)(lds + wave * 16384);
            constexpr int I_IN = (DM / 64) * (NP / 32), I_B = (1024 / 64) * (DM / 32), I_O = (DM / 64) * (DM / 32);
            constexpr int NITEMS = I_IN + 3 * I_B + 2 * I_O;
            for (int it = gw; it < NITEMS; it += NGW) {
                int r = it;
                if (r < I_IN) { transpose_item<1>(w_in, DM, IN_COLS, NP, WinT, scr, r, lane); continue; } r -= I_IN;
                if (r < 3 * I_B) { const int k = r / I_B; transpose_item<0>(w_branch + (size_t)k * 1024 * DM, 1024, DM, DM, WbT + (size_t)k * DM * 1024, scr, r - k * I_B, lane); continue; } r -= 3 * I_B;
                if (r < I_O) { transpose_item<0>(w_out, DM, DM, DM, WoT, scr, r, lane); continue; } r -= I_O;
                transpose_item<0>(peer_wq, DM, DM, DM, WqT, scr, r, lane);
            }
            for (size_t n = gt; n < NP; n += NGT) bias[n] = (n >= C_G && n < C_SMALL) ? merge_gate_b[n - C_G] : 0.f;
        }
        GRID_BAR();
        { PHASE_IDS unsigned char* ws = WSP; pg8::Gemm g{(const bf16*)(ws + WS_XB), (const bf16*)(ws + WS_WIN), T_TOK, NP, DM}; pg8::StaticOrder S; S.init(T_TOK, NP, G, bx);
          pg8::EpiProj E{(bf16*)(ws + WS_PROJ), (const float*)(ws + WS_BIAS), (float*)(ws + WS_SMALL), NP, GATE_TILE_LO, SMALL_TILE, 0};
          pg8::gemm_phase<pg8::EpiProj, pg8::StaticOrder, true, true>(lds, g, S, E, tid); }
        GRID_BAR();
        { PHASE_IDS unsigned char* ws = WSP; const bf16* proj = (const bf16*)(ws + WS_PROJ); float* qr = (float*)(ws + WS_R1); float* kr = (float*)(ws + WS_R1 + 128 * MiB);
          for (size_t i = gt; i < (size_t)T_TOK * 640; i += NGT) rope_body(i, proj, qr, kr); }
        { PHASE_IDS unsigned char* ws = WSP; const bf16* proj = (const bf16*)(ws + WS_PROJ); float* xc = (float*)(ws + WS_R2);
          const float* cw = INF(I_CONVW) + (size_t)l * 4 * 1536; const float* cb = INF(I_CONVB) + l * 1536;
          for (size_t i = gt; i < (size_t)T_TOK * 1536; i += NGT) ssd_conv_body(i, proj, cw, cb, xc); }
        GRID_BAR();
        { PHASE_IDS unsigned char* ws = WSP; const bf16* proj = (const bf16*)(ws + WS_PROJ); const float* small = (const float*)(ws + WS_SMALL);
        if (wave < 2) { float* hm = (float*)(ws + WS_HM); const float* gb = INF(I_MGATEB) + l * 8;
            for (int i = bx * 128 + tid; i < NBATCH * 4 * 256 * 4; i += G * 128) mlstm_body(i, proj, small, gb, hm); }
        else if (wave < 4) { float* xc = (float*)(ws + WS_R2); const float* dtb = INF(I_DTB) + l * 16; const float* alog = INF(I_ALOG) + l * 16; const float* dsk = INF(I_SSMD) + l * 16;
            for (int i = bx * 128 + (tid - 128); i < NBATCH * 16 * 64 * 4; i += G * 128) ssd_scan_body(i, xc, small, dtb, alog, dsk, xc); }
        else { const float* qr = (const float*)(ws + WS_R1); const float* kr = (const float*)(ws + WS_R1 + 128 * MiB); bf16* ya = (bf16*)(ws + WS_Y + 128 * MiB); const float* sinks = INF(I_SINKS) + l * 16;
            for (int i = bx * 256 + (tid - 256); i < T_TOK * 16; i += G * 256) swa_body(i, qr, kr, proj, sinks, ya); } }
        GRID_BAR();
        { PHASE_IDS unsigned char* ws = WSP; const bf16* proj = (const bf16*)(ws + WS_PROJ); const float* hm = (const float*)(ws + WS_HM); bf16* ym = (bf16*)(ws + WS_Y); const float* nw = INF(I_MNORMW) + l * 1024;
          for (int w = gw; w < T_TOK * 4; w += NGW) mlstm_post_body(w, lane, hm, proj, nw, ym); }
        { PHASE_IDS unsigned char* ws = WSP; const bf16* proj = (const bf16*)(ws + WS_PROJ); const float* xc = (const float*)(ws + WS_R2); bf16* ys = (bf16*)(ws + WS_Y + 64 * MiB); const float* nw = INF(I_SNORMW) + l * 1024;
          for (int w = gw; w < T_TOK * 2; w += NGW) ssd_post_body(w, lane, xc, proj, nw, ys); }
        GRID_BAR();
        { PHASE_IDS unsigned char* ws = WSP; pg8::Gemm g{(const bf16*)(ws + WS_Y), (const bf16*)(ws + WS_WB), T_TOK, DM, 1024}; pg8::StaticOrder S; S.init(T_TOK, DM, G, bx);
          pg8::EpiMix<1> E{(bf16*)(ws + WS_R1), (const bf16*)(ws + WS_PROJ) + C_G, DM, NP};
          pg8::gemm_phase<pg8::EpiMix<1>, pg8::StaticOrder, true, true>(lds, g, S, E, tid); }
        __syncthreads();
        { PHASE_IDS unsigned char* ws = WSP; pg8::Gemm g{(const bf16*)(ws + WS_Y + 64 * MiB), (const bf16*)(ws + WS_WB) + (size_t)DM * 1024, T_TOK, DM, 1024}; pg8::StaticOrder S; S.init(T_TOK, DM, G, bx);
          pg8::EpiMix<0> E{(bf16*)(ws + WS_R1), (const bf16*)(ws + WS_PROJ) + C_G + DM, DM, NP};
          pg8::gemm_phase<pg8::EpiMix<0>, pg8::StaticOrder, true, true>(lds, g, S, E, tid); }
        __syncthreads();
        { PHASE_IDS unsigned char* ws = WSP; pg8::Gemm g{(const bf16*)(ws + WS_Y + 128 * MiB), (const bf16*)(ws + WS_WB) + (size_t)2 * DM * 1024, T_TOK, DM, 1024}; pg8::StaticOrder S; S.init(T_TOK, DM, G, bx);
          pg8::EpiMix<0> E{(bf16*)(ws + WS_R1), (const bf16*)(ws + WS_PROJ) + C_G + 2 * DM, DM, NP};
          pg8::gemm_phase<pg8::EpiMix<0>, pg8::StaticOrder, true, true>(lds, g, S, E, tid); }
        GRID_BAR();
        { PHASE_IDS unsigned char* ws = WSP; const float* xin = l == 0 ? INF(I_X) : (const float*)OUTP;
          pg8::Gemm g{(const bf16*)(ws + WS_R1), (const bf16*)(ws + WS_WO), T_TOK, DM, DM}; pg8::StaticOrder S; S.init(T_TOK, DM, G, bx); pg8::EpiResid E{(float*)(ws + WS_BUFB), xin, DM, ALPHA};
          pg8::gemm_phase<pg8::EpiResid, pg8::StaticOrder, true, true>(lds, g, S, E, tid); }
        GRID_BAR();
        { PHASE_IDS unsigned char* ws = WSP; float* bufB = (float*)(ws + WS_BUFB); bf16* xb = (bf16*)(ws + WS_XB); const float* g1 = INF(I_LN1G) + l * DM; const float* b1 = INF(I_LN1B) + l * DM;
          for (int t = gw; t < T_TOK; t += NGW) ln_body(t, lane, bufB, g1, b1, bufB, xb); }
        { PHASE_IDS unsigned char* ws = WSP; constexpr size_t NGRP = (size_t)P_EXPERTS * DM / 16;
          const float* pu = INF(I_PU) + (size_t)l * P_EXPERTS * DM; const float* pv = INF(I_PV) + (size_t)l * P_EXPERTS * DM; uint4* U8 = (uint4*)(ws + WS_R2); uint4* V8 = (uint4*)(ws + WS_R2 + 32 * MiB);
          for (size_t i = gt; i < 2 * NGRP; i += NGT) { if (i < NGRP) tab_to_fp8(i, pu, U8, U8_SCALE); else tab_to_fp8(i - NGRP, pv, V8, V8_SCALE); } }
        GRID_BAR();
        { PHASE_IDS unsigned char* ws = WSP; pg8::Gemm g{(const bf16*)(ws + WS_XB), (const bf16*)(ws + WS_WQ), T_TOK, DM, DM}; pg8::StaticOrder S; S.init(T_TOK, DM, G, bx); pg8::EpiF32 E{(float*)(ws + WS_QF), DM, 0};
          pg8::gemm_phase<pg8::EpiF32, pg8::StaticOrder, true, true>(lds, g, S, E, tid); }
        GRID_BAR();
        { PHASE_IDS unsigned char* ws = WSP; const float* qf = (const float*)(ws + WS_QF); int* ids = (int*)(ws + WS_IDS); float* gates = (float*)(ws + WS_GATES); const float* sk = INF(I_SUBK) + (size_t)l * 8 * 2 * 128 * 128;
          for (int wi = gw; wi < 8 * (T_TOK / 64); wi += NGW) { const int h = wi / (T_TOK / 64), t = (wi % (T_TOK / 64)) * 64 + lane; peer_select_body(h, t, qf, sk, ids, gates); } }
        GRID_BAR();
        { PHASE_IDS unsigned char* ws = WSP; const float* bufB = (const float*)(ws + WS_BUFB); const int* ids = (const int*)(ws + WS_IDS); const float* gates = (const float*)(ws + WS_GATES);
          const unsigned char* U8 = ws + WS_R2; const unsigned char* V8 = ws + WS_R2 + 32 * MiB; const float* g2 = INF(I_LN2G) + l * DM; const float* b2 = INF(I_LN2B) + l * DM; float* out = OUTP; bf16* xb = (bf16*)(ws + WS_XB);
          for (int t = gw; t < T_TOK; t += NGW) peer_expert_body(t, lane, bufB, ids, gates, U8, V8, g2, b2, out, xb); }
        GRID_BAR();
    }
#undef GRID_BAR
}

extern "C" void kernel_launch(void* const* d_in, const int* in_sizes, int n_in, void* d_out, int out_size, void* d_ws, size_t ws_size, hipStream_t stream) {
    static int grid = 0;
    if (grid == 0) {
        if (n_in != 22 || out_size != T_TOK * DM || ws_size < WS_END) { fprintf(stderr, "kernel_launch: unexpected shapes (n_in %d, out %d, ws %zu)\n", n_in, out_size, ws_size); grid = -1; return; }
        int dev = 0, cus = 0, per_cu = 0;
        if (hipGetDevice(&dev) != hipSuccess || hipDeviceGetAttribute(&cus, hipDeviceAttributeMultiprocessorCount, dev) != hipSuccess) { grid = -1; return; }
        if (hipFuncSetAttribute((const void*)mega_fwd, hipFuncAttributeMaxDynamicSharedMemorySize, LDS_BYTES) != hipSuccess) { fprintf(stderr, "kernel_launch: hipFuncSetAttribute failed\n"); grid = -1; return; }
        if (hipOccupancyMaxActiveBlocksPerMultiprocessor(&per_cu, (const void*)mega_fwd, 512, LDS_BYTES) != hipSuccess || per_cu < 1) { fprintf(stderr, "kernel_launch: occupancy query says %d blocks per CU\n", per_cu); (void)hipGetLastError(); grid = -1; return; }
        grid = cus;
    }
    if (grid < 0) return;
    (void)hipMemsetAsync((char*)d_ws + WS_CTL, 0, CTL_ZERO_BYTES, stream);
    MegaArgs a; memset(&a, 0, sizeof(a));
    for (int i = 0; i < 22; ++i) a.in[i] = (const float*)d_in[i];
    a.out = (float*)d_out; a.ws = (unsigned char*)d_ws;
    hipLaunchKernelGGL(mega_fwd, dim3(grid), dim3(512), LDS_BYTES, stream, a);
}
```

```cpp
#include <hip/hip_runtime.h>
#include <cstdio>
#include <cstdint>
#include <cstring>

namespace pg8 {
#define PG8_LAS __attribute__((address_space(3)))
typedef unsigned short bf16_t;
typedef short bf16x8 __attribute__((ext_vector_type(8)));
typedef float f32x4 __attribute__((ext_vector_type(4)));
typedef unsigned u32x4 __attribute__((ext_vector_type(4)));
constexpr int BM = 256, BK = 64, HALF = 128, HTB = HALF * BK * 2  , STAGE_BYTES = 8 * HTB, NXCD = 8, WGM = 8;

__host__ __device__ __forceinline__ int lds_byte(int r, int c) { const int st = (r >> 4) * 2 + (c >> 5), rr = r & 15, cc = c & 31, ob = rr * 64 + cc * 2; return st * 1024 + (ob ^ (((ob >> 9) & 1) << 5)); }
__host__ __device__ __forceinline__ void stage_rc(int b, int& R, int& C) { const int st = b / 1024, sb = b % 1024, swz = sb ^ (((sb >> 9) & 1) << 5); R = (st >> 1) * 16 + swz / 64; C = (st & 1) * 32 + (swz % 64) / 2; }
__host__ __device__ __forceinline__ int perm32(int rho) { const int n = rho >> 4, i = rho & 15; return 8 * (i >> 2) + 4 * n + (i & 3); }

struct Unit { int pm, pn; };
struct Gemm { const bf16_t* A; const bf16_t* Bt; int M, N, K; };

struct StaticOrder {
    int nM, nN, nwg, G, c;
    __host__ __device__ void init(int M, int N, int G_, int c_) { nM = M / BM; nN = N / BM; nwg = nM * nN; G = G_; c = c_; }
    __host__ __device__ bool next(int i, Unit& u) const {
        const long L = (long)i * G + c; if (L >= nwg) return false;
        int wgid = (int)L; { const int q = nwg / NXCD, r = nwg % NXCD, xcd = wgid % NXCD, off = wgid / NXCD; wgid = (xcd < r ? xcd * (q + 1) : r * (q + 1) + (xcd - r) * q) + off; }
        const int nig = WGM * nN, gid = wgid / nig, fm = gid * WGM, gsz = (nM - fm) < WGM ? (nM - fm) : WGM;
        u.pm = fm + ((wgid % nig) % gsz); u.pn = (wgid % nig) / gsz; return true;
    }
    __device__ __forceinline__ void a_ready(const Unit&) const {}
    __device__ __forceinline__ void done(const Unit&) const {}
};

__device__ __forceinline__ unsigned cvt_pk_bf16(float lo, float hi) { unsigned r; asm volatile("v_cvt_pk_bf16_f32 %0, %1, %2" : "=v"(r) : "v"(lo), "v"(hi)); return r; }
typedef float f32x2 __attribute__((ext_vector_type(2)));
__device__ __forceinline__ float bf_lo(unsigned w) { return __uint_as_float(w << 16); }
__device__ __forceinline__ float bf_hi(unsigned w) { return __uint_as_float(w & 0xffff0000u); }
__device__ __forceinline__ float sigmoidf_(float x) { return 1.0f / (1.0f + __expf(-x)); }

struct EpiF32 {
    static constexpr bool PERM = false, AFTER_DRAIN = false;
    float* C; int ldc; int pad;
    __device__ __forceinline__ void operator()(const f32x4 (&acc)[2][2][4][2], const Unit& u, int wr, int wc, int fr, int fq) const {
        const int row0 = u.pm * BM + wr * 64 + fr, col0 = u.pn * BM + wc * 32 + 4 * fq;
#pragma unroll
        for (int ai = 0; ai < 2; ++ai)
#pragma unroll
            for (int m = 0; m < 4; ++m) { float* rowp = C + (size_t)(row0 + ai * HALF + m * 16) * ldc + col0;
#pragma unroll
                for (int bj = 0; bj < 2; ++bj)
#pragma unroll
                    for (int n = 0; n < 2; ++n) *(f32x4*)(rowp + bj * HALF + n * 16) = acc[ai][bj][m][n]; }
    }
};
struct EpiResid {
    static constexpr bool PERM = false, AFTER_DRAIN = false;
    float* C; const float* X; int ldc; float alpha;
    __device__ __forceinline__ void operator()(const f32x4 (&acc)[2][2][4][2], const Unit& u, int wr, int wc, int fr, int fq) const {
        const int row0 = u.pm * BM + wr * 64 + fr, col0 = u.pn * BM + wc * 32 + 4 * fq;
#pragma unroll
        for (int ai = 0; ai < 2; ++ai)
#pragma unroll
            for (int m = 0; m < 4; ++m) { const size_t off = (size_t)(row0 + ai * HALF + m * 16) * ldc + col0;
#pragma unroll
                for (int bj = 0; bj < 2; ++bj)
#pragma unroll
                    for (int n = 0; n < 2; ++n) { const f32x4 xv = *(const f32x4*)(X + off + bj * HALF + n * 16);
                        *(f32x4*)(C + off + bj * HALF + n * 16) = acc[ai][bj][m][n] + xv * alpha; } }
    }
};
struct EpiProj {
    static constexpr bool PERM = true, AFTER_DRAIN = false;
    bf16_t* O; const float* bias; float* small; int ldc; int gate_lo; int small_tile; int pad;
    __device__ __forceinline__ void operator()(const f32x4 (&acc)[2][2][4][2], const Unit& u, int wr, int wc, int fr, int fq) const {
        const int row0 = u.pm * BM + wr * 64 + fr, col0 = u.pn * BM + wc * 32 + 8 * fq;
        if (u.pn == small_tile) {
            if (wc == 0) {
#pragma unroll
                for (int ai = 0; ai < 2; ++ai)
#pragma unroll
                    for (int m = 0; m < 4; ++m) { float* p = small + (size_t)(row0 + ai * HALF + m * 16) * 32 + 8 * fq;
                        *(f32x4*)p = acc[ai][0][m][0]; *(f32x4*)(p + 4) = acc[ai][0][m][1]; }
            }
            return;
        }
        const bool gate = u.pn >= gate_lo;
        f32x4 bv[2][2];
#pragma unroll
        for (int bj = 0; bj < 2; ++bj)
#pragma unroll
            for (int n = 0; n < 2; ++n) bv[bj][n] = gate ? *(const f32x4*)(bias + col0 + bj * HALF + 4 * n) : (f32x4){0.f, 0.f, 0.f, 0.f};
#pragma unroll
        for (int ai = 0; ai < 2; ++ai)
#pragma unroll
            for (int m = 0; m < 4; ++m) { bf16_t* rowp = O + (size_t)(row0 + ai * HALF + m * 16) * ldc + col0;
#pragma unroll
                for (int bj = 0; bj < 2; ++bj) { f32x4 v0 = acc[ai][bj][m][0] + bv[bj][0], v1 = acc[ai][bj][m][1] + bv[bj][1];
                    if (gate) {
#pragma unroll
                        for (int j = 0; j < 4; ++j) { v0[j] = sigmoidf_(v0[j]); v1[j] = sigmoidf_(v1[j]); } }
                    u32x4 w; w.x = cvt_pk_bf16(v0[0], v0[1]); w.y = cvt_pk_bf16(v0[2], v0[3]); w.z = cvt_pk_bf16(v1[0], v1[1]); w.w = cvt_pk_bf16(v1[2], v1[3]);
                    *(u32x4*)(rowp + bj * HALF) = w; } }
    }
};
template <int FIRST> struct EpiMix {
    static constexpr bool PERM = true, AFTER_DRAIN = false;
    bf16_t* O; const bf16_t* G; int ldc; int ldg;
    __device__ __forceinline__ void operator()(const f32x4 (&acc)[2][2][4][2], const Unit& u, int wr, int wc, int fr, int fq) const {
        const int row0 = u.pm * BM + wr * 64 + fr, col0 = u.pn * BM + wc * 32 + 8 * fq;
#pragma unroll
        for (int ai = 0; ai < 2; ++ai)
#pragma unroll
            for (int m = 0; m < 4; ++m) { const int row = row0 + ai * HALF + m * 16; bf16_t* rowp = O + (size_t)row * ldc + col0; const bf16_t* gp = G + (size_t)row * ldg + col0;
#pragma unroll
                for (int bj = 0; bj < 2; ++bj) { const u32x4 gw = *(const u32x4*)(gp + bj * HALF); u32x4 ow = (u32x4){0u, 0u, 0u, 0u}; if (!FIRST) ow = *(const u32x4*)(rowp + bj * HALF);
                    const f32x4 a0 = acc[ai][bj][m][0], a1 = acc[ai][bj][m][1];
                    float r0 = bf_lo(ow.x) + bf_lo(gw.x) * a0[0], r1 = bf_hi(ow.x) + bf_hi(gw.x) * a0[1], r2 = bf_lo(ow.y) + bf_lo(gw.y) * a0[2], r3 = bf_hi(ow.y) + bf_hi(gw.y) * a0[3];
                    float r4 = bf_lo(ow.z) + bf_lo(gw.z) * a1[0], r5 = bf_hi(ow.z) + bf_hi(gw.z) * a1[1], r6 = bf_lo(ow.w) + bf_lo(gw.w) * a1[2], r7 = bf_hi(ow.w) + bf_hi(gw.w) * a1[3];
                    u32x4 w; w.x = cvt_pk_bf16(r0, r1); w.y = cvt_pk_bf16(r2, r3); w.z = cvt_pk_bf16(r4, r5); w.w = cvt_pk_bf16(r6, r7);
                    *(u32x4*)(rowp + bj * HALF) = w; } }
    }
};

template <class Epi, class Sched, bool ALIGN_EPI = false, bool SP2 = false>
__device__ __forceinline__ void gemm_phase(PG8_LAS unsigned char* lds, const Gemm g, const Sched& S, const Epi& E, int tid_) {
    asm volatile("" : "+v"(tid_));
    const int tid = tid_, wid = __builtin_amdgcn_readfirstlane(tid >> 6), lane = tid & 63, wr = wid >> 2, wc = wid & 3, fr = lane & 15, fq = lane >> 4;
    const int K = g.K, nt = K / BK;
    unsigned voffA[2], voffB[2];
#pragma unroll
    for (int i = 0; i < 2; ++i) { int R, C; stage_rc(tid * 16 + i * 8192, R, C); const int Rb = Epi::PERM ? ((R & ~31) + perm32(R & 31)) : R;
        voffA[i] = (unsigned)(R * K + C) * 2u; voffB[i] = (unsigned)(Rb * K + C) * 2u; }
    const size_t kstep = (size_t)(BK * 2);
    const size_t hstep = (size_t)HALF * K * 2;
    const size_t tstep = 2 * hstep;
    const unsigned ldsw = (unsigned)wid * 1024u;
    const int aoff = lds_byte(wr * 64 + fr, fq * 8), boff = lds_byte(wc * 32 + fr, fq * 8);
#define PG8_SA(b, h) (((b) * 2 + (h)) * HTB)
#define PG8_SB(b, h) ((4 + (b) * 2 + (h)) * HTB)
#define PG8_STAGE(bufoff, gbase, voff) do { _Pragma("unroll") for (int _i = 0; _i < 2; ++_i) \
        __builtin_amdgcn_global_load_lds((const unsigned*)((const char*)(gbase) + (voff)[_i]), (PG8_LAS unsigned*)(lds + (bufoff) + ldsw + _i * 8192), 16, 0, 0); } while (0)
#define PG8_LDA(dst, b, h) do { _Pragma("unroll") for (int m = 0; m < 4; ++m) _Pragma("unroll") for (int k = 0; k < 2; ++k) dst[m][k] = *(const PG8_LAS bf16x8*)(lds + PG8_SA(b, h) + aoff + m * 2048 + k * 1024); } while (0)
#define PG8_LDB(dst, b, h) do { _Pragma("unroll") for (int n = 0; n < 2; ++n) _Pragma("unroll") for (int k = 0; k < 2; ++k) dst[n][k] = *(const PG8_LAS bf16x8*)(lds + PG8_SB(b, h) + boff + n * 2048 + k * 1024); } while (0)
#define PG8_MMA(ai, bj, At, Bt) do { __builtin_amdgcn_s_setprio(1); _Pragma("unroll") for (int m = 0; m < 4; ++m) _Pragma("unroll") for (int n = 0; n < 2; ++n) _Pragma("unroll") for (int k = 0; k < 2; ++k) \
        acc[ai][bj][m][n] = __builtin_amdgcn_mfma_f32_16x16x32_bf16(Bt[n][k], At[m][k], acc[ai][bj][m][n], 0, 0, 0); __builtin_amdgcn_s_setprio(0); } while (0)
#define PG8_WAIT_V(n) asm volatile("s_waitcnt vmcnt(" #n ")" ::: "memory")
#define PG8_WAIT_L(n) asm volatile("s_waitcnt lgkmcnt(" #n ")" ::: "memory")
#define PG8_BAR __builtin_amdgcn_s_barrier()
#define PG8_SCHED __builtin_amdgcn_sched_barrier(0)
    Unit cur, nxt; int ui = 0;
    if (!S.next(0, cur)) return;
    f32x4 acc[2][2][4][2];
#pragma unroll
    for (int a = 0; a < 2; ++a)
#pragma unroll
        for (int b = 0; b < 2; ++b)
#pragma unroll
            for (int m = 0; m < 4; ++m)
#pragma unroll
                for (int n = 0; n < 2; ++n) acc[a][b][m][n] = (f32x4){0.f, 0.f, 0.f, 0.f};
    bf16x8 At[4][2], B0[2][2], B1[2][2];
    const char* cA = (const char*)g.A + (size_t)cur.pm * tstep; const char* cB = (const char*)g.Bt + (size_t)cur.pn * tstep;
    S.a_ready(cur);
    if constexpr (SP2) {
        PG8_STAGE(PG8_SB(0, 0), cB, voffB); PG8_STAGE(PG8_SB(0, 1), cB + hstep, voffB); PG8_STAGE(PG8_SA(0, 0), cA, voffA); PG8_STAGE(PG8_SA(0, 1), cA + hstep, voffA);
        if (wr == 1) PG8_BAR;
        PG8_WAIT_V(2); PG8_BAR;
        PG8_STAGE(PG8_SB(1, 0), cB + kstep, voffB); PG8_STAGE(PG8_SA(1, 0), cA + kstep, voffA); PG8_STAGE(PG8_SB(1, 1), cB + hstep + kstep, voffB);
        PG8_WAIT_V(6); PG8_BAR;
    } else {
        PG8_STAGE(PG8_SB(0, 0), cB, voffB); PG8_STAGE(PG8_SA(0, 0), cA, voffA); PG8_STAGE(PG8_SB(0, 1), cB + hstep, voffB); PG8_STAGE(PG8_SA(0, 1), cA + hstep, voffA);
        if (wr == 1) PG8_BAR;
        PG8_WAIT_V(4); PG8_BAR;
        PG8_STAGE(PG8_SB(1, 0), cB + kstep, voffB); PG8_STAGE(PG8_SA(1, 0), cA + kstep, voffA); PG8_STAGE(PG8_SB(1, 1), cB + hstep + kstep, voffB);
        PG8_WAIT_V(6); PG8_BAR;
    }
    for (;;) {
        const bool has_next = S.next(ui + 1, nxt);
        const char* nA = has_next ? (const char*)g.A + (size_t)nxt.pm * tstep : cA; const char* nB = has_next ? (const char*)g.Bt + (size_t)nxt.pn * tstep : cB;
        for (int t = 0; t < nt; t += 2) {
            const bool last = (t == nt - 2);
            const char* a1 = cA + (size_t)(t + 1) * kstep;
            const char* a2 = last ? nA : cA + (size_t)(t + 2) * kstep; const char* b2 = last ? nB : cB + (size_t)(t + 2) * kstep;
            const char* a3 = a2 + kstep; const char* b3 = b2 + kstep;
            if (last && has_next) S.a_ready(nxt);
            if constexpr (SP2) {
            PG8_LDB(B0, 0, 0); PG8_LDB(B1, 0, 1); PG8_SCHED; PG8_LDA(At, 0, 0); PG8_STAGE(PG8_SA(1, 1), a1 + hstep, voffA);
            PG8_WAIT_V(8); PG8_WAIT_L(0); PG8_BAR; PG8_MMA(0, 0, At, B0); PG8_MMA(0, 1, At, B1); PG8_BAR; PG8_SCHED;
            PG8_LDA(At, 0, 1); PG8_STAGE(PG8_SB(0, 0), b2, voffB); PG8_STAGE(PG8_SB(0, 1), b2 + hstep, voffB); PG8_STAGE(PG8_SA(0, 0), a2, voffA);
            PG8_WAIT_V(8); PG8_WAIT_L(0); PG8_BAR; PG8_MMA(1, 0, At, B0); PG8_MMA(1, 1, At, B1); PG8_BAR; PG8_SCHED;
            PG8_LDB(B0, 1, 0); PG8_LDB(B1, 1, 1); PG8_SCHED; PG8_LDA(At, 1, 0); PG8_STAGE(PG8_SA(0, 1), a2 + hstep, voffA);
            PG8_WAIT_V(8); PG8_WAIT_L(0); PG8_BAR; PG8_MMA(0, 0, At, B0); PG8_MMA(0, 1, At, B1); PG8_BAR; PG8_SCHED;
            PG8_LDA(At, 1, 1); PG8_STAGE(PG8_SB(1, 0), b3, voffB); PG8_STAGE(PG8_SB(1, 1), b3 + hstep, voffB); PG8_STAGE(PG8_SA(1, 0), a3, voffA);
            PG8_WAIT_V(8); PG8_WAIT_L(0); PG8_BAR; PG8_MMA(1, 0, At, B0); PG8_MMA(1, 1, At, B1); PG8_BAR; PG8_SCHED;
            } else {
            PG8_LDB(B0, 0, 0); PG8_SCHED; PG8_LDA(At, 0, 0); PG8_STAGE(PG8_SA(1, 1), a1 + hstep, voffA);
            PG8_WAIT_L(8); PG8_BAR; PG8_WAIT_L(0); PG8_MMA(0, 0, At, B0); PG8_BAR; PG8_SCHED;
            PG8_LDB(B1, 0, 1); PG8_STAGE(PG8_SB(0, 0), b2, voffB);
            PG8_BAR; PG8_WAIT_L(0); PG8_MMA(0, 1, At, B1); PG8_BAR;
            PG8_LDA(At, 0, 1); PG8_STAGE(PG8_SA(0, 0), a2, voffA);
            PG8_BAR; PG8_WAIT_L(0); PG8_MMA(1, 0, At, B0); PG8_BAR; PG8_SCHED;
            PG8_STAGE(PG8_SB(0, 1), b2 + hstep, voffB);
            PG8_WAIT_V(6); PG8_BAR; PG8_MMA(1, 1, At, B1); PG8_BAR;
            PG8_LDB(B0, 1, 0); PG8_SCHED; PG8_LDA(At, 1, 0); PG8_STAGE(PG8_SA(0, 1), a2 + hstep, voffA);
            PG8_WAIT_L(8); PG8_BAR; PG8_WAIT_L(0); PG8_MMA(0, 0, At, B0); PG8_BAR; PG8_SCHED;
            PG8_LDB(B1, 1, 1); PG8_STAGE(PG8_SB(1, 0), b3, voffB);
            PG8_BAR; PG8_WAIT_L(0); PG8_MMA(0, 1, At, B1); PG8_BAR;
            PG8_LDA(At, 1, 1); PG8_STAGE(PG8_SA(1, 0), a3, voffA);
            PG8_BAR; PG8_WAIT_L(0); PG8_MMA(1, 0, At, B0); PG8_BAR; PG8_SCHED;
            PG8_STAGE(PG8_SB(1, 1), b3 + hstep, voffB);
            PG8_WAIT_V(6); PG8_BAR; PG8_MMA(1, 1, At, B1); PG8_BAR;
            }
        }
        if constexpr (ALIGN_EPI) { if (wr == 0) PG8_BAR; }
        if constexpr (!Epi::AFTER_DRAIN) { E(acc, cur, wr, wc, fr, fq); S.done(cur); }
        if (!has_next) break;
#pragma unroll
        for (int a = 0; a < 2; ++a)
#pragma unroll
            for (int b = 0; b < 2; ++b)
#pragma unroll
                for (int m = 0; m < 4; ++m)
#pragma unroll
                    for (int n = 0; n < 2; ++n) acc[a][b][m][n] = (f32x4){0.f, 0.f, 0.f, 0.f};
        cur = nxt; cA = nA; cB = nB; ++ui;
        if constexpr (ALIGN_EPI) { if (wr == 1) PG8_BAR; }
    }
    PG8_WAIT_V(0);
    if constexpr (!ALIGN_EPI) { if (wr == 0) PG8_BAR; }
    PG8_BAR;
    if constexpr (Epi::AFTER_DRAIN) { E.fused(acc, cur, wr, wc, fr, fq, lds, wid, lane); S.done(cur); }
#undef PG8_SA
#undef PG8_SB
#undef PG8_STAGE
#undef PG8_LDA
#undef PG8_LDB
#undef PG8_MMA
#undef PG8_WAIT_V
#undef PG8_WAIT_L
#undef PG8_BAR
#undef PG8_SCHED
}
}
typedef unsigned short bf16;
#define LAS __attribute__((address_space(3)))
constexpr int T_TOK = 32768, DM = 2048, SEQ = 4096, NBATCH = 8, DEPTH = 4;
constexpr int IN_COLS = 13336, NP = 13568;
constexpr int C_MQ = 0, C_MK = 512, C_MV = 1024, C_MO = 2048, C_SZ = 3072, C_SXBC = 4096, C_AQ = 5632, C_AK = 6656, C_AV = 6912, C_G = 7168, C_SMALL = 13312;
constexpr int GATE_TILE_LO = C_G / 256, SMALL_TILE = C_SMALL / 256;
constexpr float ALPHA = 1.681792830507429f;
constexpr int P_EXPERTS = 16384;

constexpr size_t MiB = 1u << 20;
constexpr size_t WS_CTL = 0, CTL_ZERO_BYTES = 64 * 1024, WS_WIN = 1 * MiB, WS_WB = 54 * MiB, WS_WO = 66 * MiB, WS_WQ = 74 * MiB, WS_BIAS = 82 * MiB, WS_SMALL = 83 * MiB, WS_ROPE = 87 * MiB,
                 WS_XB = 88 * MiB, WS_BUFB = 216 * MiB, WS_PROJ = 472 * MiB, WS_R1 = 1320 * MiB, WS_Y = 1480 * MiB, WS_R2 = 1672 * MiB, WS_HM = 1864 * MiB, WS_END = 1992 * MiB;
constexpr size_t WS_QF = WS_PROJ, WS_IDS = WS_PROJ + 256 * MiB, WS_GATES = WS_PROJ + 272 * MiB;
constexpr int CW_BAR = 4096;
constexpr int RING_BYTES = 131072, MISC_OFF = RING_BYTES + 320, LDS_BYTES = 147456;

__device__ __forceinline__ unsigned f2bf(float f) { unsigned u = __float_as_uint(f); return (u + 0x7fffu + ((u >> 16) & 1u)) >> 16; }
__device__ __forceinline__ unsigned pk2(float lo, float hi) { return f2bf(lo) | (f2bf(hi) << 16); }
__device__ __forceinline__ float bf2f(bf16 b) { return __uint_as_float(((unsigned)b) << 16); }
__device__ __forceinline__ float sigm(float x) { return 1.0f / (1.0f + expf(-x)); }
template <int CTRL> __device__ __forceinline__ float dpp_f(float v) { return __builtin_bit_cast(float, __builtin_amdgcn_update_dpp(0, __builtin_bit_cast(int, v), CTRL, 0xF, 0xF, true)); }
__device__ __forceinline__ float quad_sum(float v) { v += dpp_f<0xB1>(v); v += dpp_f<0x4E>(v); return v; }
__device__ __forceinline__ float wave_sum(float v) {
    v = quad_sum(v); v += dpp_f<0x141>(v); v += dpp_f<0x140>(v);
    v += __builtin_bit_cast(float, __builtin_amdgcn_ds_swizzle(__builtin_bit_cast(int, v), 0x401F));
    return __builtin_bit_cast(float, __builtin_amdgcn_readlane(__builtin_bit_cast(int, v), 0)) + __builtin_bit_cast(float, __builtin_amdgcn_readlane(__builtin_bit_cast(int, v), 32));
}
__device__ __forceinline__ int src_col(int n) {
    if (n < 3072) return n;
    if (n < 5632) return n + 8;
    if (n < 13312) return n + 24;
    if (n < 13320) return 3072 + (n - 13312);
    if (n < 13336) return 5640 + (n - 13320);
    return -1;
}

#define XB_TMO      128
#define XB_XCNT(j)  (256  + 64 * (j))
#define XB_XSUB(j)  (1280 + 64 * (j))
#define XB_XGEN(j)  (2304 + 64 * (j))
#define XB_TOP      3328
#define XB_TOPGEN   3392
#define XCD_BAR_WORDS 3456
#define XB_SPIN_CAP (1u << 18)

__device__ __forceinline__ unsigned xb_ld(unsigned* p)              { return __hip_atomic_load(p, __ATOMIC_RELAXED, __HIP_MEMORY_SCOPE_AGENT); }
__device__ __forceinline__ unsigned xb_add(unsigned* p, unsigned v) { return __hip_atomic_fetch_add(p, v, __ATOMIC_RELAXED, __HIP_MEMORY_SCOPE_AGENT); }
__device__ __forceinline__ unsigned xb_xcc_id() { return (unsigned)__builtin_amdgcn_s_getreg((3 << 11) | 20) & 0xFu; }
#define XB_SPIN(cond, bar) do { unsigned _sp = 0; while (cond) { __builtin_amdgcn_s_sleep(1); \
    if ((++_sp & 255u) == 0u) { if (xb_ld(&(bar)[XB_TMO])) break; if (_sp > XB_SPIN_CAP) { atomicAdd(&(bar)[XB_TMO], 1u); break; } } } } while (0)

struct XcdBarrier {
    unsigned* bar; unsigned x;
    volatile LAS unsigned* st;
};

__device__ __forceinline__ XcdBarrier xcd_barrier_post(unsigned* bar, volatile LAS unsigned* st) {
    XcdBarrier b; b.bar = bar; b.x = xb_xcc_id(); b.st = st;
    if (threadIdx.x == 0) (void)xb_add(&bar[XB_XCNT(b.x)], 1u);
    return b;
}
__device__ __forceinline__ void xcd_barrier_complete(unsigned* bar, unsigned x, unsigned& nloc, unsigned& nx) {
    const unsigned G = gridDim.x * gridDim.y * gridDim.z;
    unsigned sum, cnt, mine, sp = 0u;
    for (;;) {
        sum = 0u; cnt = 0u; mine = 0u;
#pragma unroll
        for (unsigned j = 0; j < 16; ++j) { const unsigned c = xb_ld(&bar[XB_XCNT(j)]); sum += c; cnt += (c > 0u) ? 1u : 0u; mine = (j == x) ? c : mine; }
        if (sum == G) break;
        __builtin_amdgcn_s_sleep(1);
        if ((++sp & 255u) == 0u) { if (xb_ld(&bar[XB_TMO])) break; if (sp > XB_SPIN_CAP) { atomicAdd(&bar[XB_TMO], 1u); break; } }
    }
    nloc = mine > 0u ? mine : 1u; nx = cnt > 0u ? cnt : 1u;
}

__device__ __forceinline__ void xcd_barrier(const XcdBarrier& b) {
    asm volatile("s_waitcnt vmcnt(0)" ::: "memory");
    __syncthreads();
    if (threadIdx.x == 0) {
        unsigned* bar = b.bar;
        __builtin_amdgcn_s_waitcnt(0);
        unsigned nloc = b.st[0], nx = b.st[1];
        if (nloc == 0u) { xcd_barrier_complete(bar, b.x, nloc, nx); b.st[0] = nloc; b.st[1] = nx; }
        const unsigned old = xb_add(&bar[XB_XSUB(b.x)], 1u);
        const unsigned gen = old / nloc;
        if (old + 1u == (gen + 1u) * nloc) {
            __builtin_amdgcn_fence(__ATOMIC_RELEASE, "agent");
            asm volatile("s_waitcnt vmcnt(0)" ::: "memory");
            const unsigned og = xb_add(&bar[XB_TOP], 1u);
            const unsigned tg = og / nx;
            if (og + 1u == (tg + 1u) * nx) xb_add(&bar[XB_TOPGEN], 1u);
            else XB_SPIN(xb_ld(&bar[XB_TOPGEN]) == tg, bar);
            __builtin_amdgcn_fence(__ATOMIC_ACQUIRE, "agent");
            xb_add(&bar[XB_XGEN(b.x)], 1u);
            asm volatile("s_waitcnt vmcnt(0)" ::: "memory");
        } else {
            XB_SPIN(xb_ld(&bar[XB_XGEN(b.x)]) == gen, bar);
            __builtin_amdgcn_fence(__ATOMIC_ACQUIRE, "agent");
            asm volatile("s_waitcnt vmcnt(0)" ::: "memory");
        }
    }
    __syncthreads();
}

__device__ __forceinline__ int fresh_tid(int wave0) { int l; asm volatile("v_mbcnt_lo_u32_b32 %0, -1, 0\n\tv_mbcnt_hi_u32_b32 %0, -1, %0" : "=v"(l)); return wave0 * 64 + l; }
#define PHASE_IDS int G = gridDim.x, bx = blockIdx.x; asm volatile("" : "+s"(G), "+s"(bx)); const int tid = fresh_tid(wave0), lane = tid & 63, wave = wave0; const int gw = bx * 8 + wave, NGW = G * 8; \
    const size_t gt = (size_t)bx * 512 + tid, NGT = (size_t)G * 512; (void)lane; (void)gw; (void)gt; (void)NGW; (void)NGT; (void)wave;

template <int MODE> __device__ __forceinline__ void transpose_item(const float* __restrict__ W, int K, int ldw, int ndst, bf16* __restrict__ WT, LAS float* scr, int item, int lane) {
    const int nblk = ndst / 32, kb = item / nblk, nb = item % nblk, k0 = 64 * kb, n0 = 32 * nb;
    const int n_l = n0 + (lane & 31); const int sc = MODE ? src_col(n_l) : n_l;
#pragma unroll 8
    for (int i = 0; i < 32; ++i) { const int kk = 2 * i + (lane >> 5); scr[kk * 33 + (lane & 31)] = sc >= 0 ? W[(size_t)(k0 + kk) * ldw + sc] : 0.f; }
    asm volatile("s_waitcnt lgkmcnt(0)" ::: "memory");
    const int c = lane & 7;
#pragma unroll
    for (int j = 0; j < 4; ++j) { const int n = (lane >> 3) + 8 * j; const LAS float* s = scr + (8 * c) * 33 + n;
        uint4 o; o.x = pk2(s[0 * 33], s[1 * 33]); o.y = pk2(s[2 * 33], s[3 * 33]); o.z = pk2(s[4 * 33], s[5 * 33]); o.w = pk2(s[6 * 33], s[7 * 33]);
        *(uint4*)(WT + (size_t)(n0 + n) * K + k0 + 8 * c) = o; }
    asm volatile("s_waitcnt lgkmcnt(0)" ::: "memory");
}

__device__ __forceinline__ void mlstm_body(int gid, const bf16* __restrict__ proj, const float* __restrict__ small, const float* __restrict__ gate_b, float* __restrict__ hm) {
    const int dq = gid & 3, v = (gid >> 2) & 255, h = (gid >> 10) & 3, b = gid >> 12;
    float C[32], n[32];
#pragma unroll
    for (int d = 0; d < 32; ++d) { C[d] = 0.f; n[d] = 0.f; }
    const float bi = gate_b[h], bfg = gate_b[4 + h];
    for (int pos = 0; pos < SEQ; ++pos) {
        const size_t t = (size_t)b * SEQ + pos;
        const float ip = small[t * 32 + h] + bi, fp = small[t * 32 + 4 + h] + bfg;
        const float f = sigm(fp), ig = expf(ip);
        const float vv = bf2f(proj[t * NP + C_MV + h * 256 + v]);
        const bf16* qp = proj + t * NP + C_MQ + h * 128 + dq * 32; const bf16* kp = proj + t * NP + C_MK + h * 128 + dq * 32;
        float num = 0.f, den = 0.f;
#pragma unroll
        for (int d = 0; d < 32; ++d) { const float kd = bf2f(kp[d]) * 0.08838834764831845f, qd = bf2f(qp[d]);
            C[d] = f * C[d] + (ig * kd) * vv; n[d] = f * n[d] + ig * kd; num += qd * C[d]; den += qd * n[d]; }
        num = quad_sum(num); den = quad_sum(den);
        if (dq == 0) hm[t * 1024 + h * 256 + v] = num / fmaxf(fabsf(den), 1.0f);
    }
}
__device__ __forceinline__ void mlstm_post_body(int w, int lane, const float* __restrict__ hm, const bf16* __restrict__ proj, const float* __restrict__ norm_w, bf16* __restrict__ ym) {
    const int h = w & 3, t = w >> 2;
    const float4 x = *(const float4*)(hm + (size_t)t * 1024 + h * 256 + lane * 4);
    const float mu = wave_sum((x.x + x.y) + (x.z + x.w)) * (1.0f / 256.0f);
    const float d0 = x.x - mu, d1 = x.y - mu, d2 = x.z - mu, d3 = x.w - mu;
    const float var = wave_sum((d0 * d0 + d1 * d1) + (d2 * d2 + d3 * d3)) * (1.0f / 256.0f);
    const float rs = rsqrtf(var + 1e-6f);
    const int c = h * 256 + lane * 4;
    const float4 nw = *(const float4*)(norm_w + c);
    const bf16* op = proj + (size_t)t * NP + C_MO + c;
    const float y0 = d0 * rs * nw.x * sigm(bf2f(op[0])), y1 = d1 * rs * nw.y * sigm(bf2f(op[1])), y2 = d2 * rs * nw.z * sigm(bf2f(op[2])), y3 = d3 * rs * nw.w * sigm(bf2f(op[3]));
    *(uint2*)(ym + (size_t)t * 1024 + c) = make_uint2(pk2(y0, y1), pk2(y2, y3));
}

__device__ __forceinline__ void ssd_conv_body(size_t gid, const bf16* __restrict__ proj, const float* __restrict__ cw, const float* __restrict__ cb, float* __restrict__ xc) {
    const int c = (int)(gid % 1536); const int t = (int)(gid / 1536); const int pos = t % SEQ;
    float acc = cb[c];
#pragma unroll
    for (int j = 0; j < 4; ++j) { const int pp = pos - 3 + j; if (pp >= 0) acc += cw[j * 1536 + c] * bf2f(proj[(size_t)(t - 3 + j) * NP + C_SXBC + c]); }
    xc[gid] = acc * sigm(acc);
}
__device__ __forceinline__ void ssd_scan_body(int gid, const float* xc, const float* __restrict__ small, const float* __restrict__ dt_bias, const float* __restrict__ a_log, const float* __restrict__ dsk, float* yraw) {
    const int nq = gid & 3, p = (gid >> 2) & 63, hh = (gid >> 8) & 15, b = gid >> 12, g = hh >> 3;
    const float a = -expf(a_log[hh]), dtb = dt_bias[hh], Dk = dsk[hh];
    float hs[32];
#pragma unroll
    for (int n = 0; n < 32; ++n) hs[n] = 0.f;
    for (int pos = 0; pos < SEQ; ++pos) {
        const size_t t = (size_t)b * SEQ + pos;
        const float dtr = small[t * 32 + 8 + hh] + dtb; const float dt = dtr > 20.f ? dtr : log1pf(expf(dtr));
        const float dA = expf(dt * a), xv = xc[t * 1536 + hh * 64 + p], dx = dt * xv;
        const float* Bp = xc + t * 1536 + 1024 + g * 128 + nq * 32; const float* Cp = Bp + 256;
        float y = 0.f;
#pragma unroll
        for (int n = 0; n < 32; ++n) { hs[n] = dA * hs[n] + dx * Bp[n]; y += Cp[n] * hs[n]; }
        y = quad_sum(y);
        if (nq == 0) yraw[t * 1536 + hh * 64 + p] = y + Dk * xv;
    }
}
__device__ __forceinline__ void ssd_post_body(int w, int lane, const float* __restrict__ yraw, const bf16* __restrict__ proj, const float* __restrict__ norm_w, bf16* __restrict__ ys) {
    const int g = w & 1, t = w >> 1, c = g * 512 + lane * 8;
    float y[8]; float ss = 0.f;
#pragma unroll
    for (int i = 0; i < 8; ++i) { const float z = bf2f(proj[(size_t)t * NP + C_SZ + c + i]); y[i] = yraw[(size_t)t * 1536 + c + i] * (z * sigm(z)); ss += y[i] * y[i]; }
    const float rs = rsqrtf(wave_sum(ss) * (1.0f / 512.0f) + 1e-6f);
    unsigned o[4];
#pragma unroll
    for (int i = 0; i < 4; ++i) o[i] = pk2(y[2 * i] * rs * norm_w[c + 2 * i], y[2 * i + 1] * rs * norm_w[c + 2 * i + 1]);
    *(uint4*)(ys + (size_t)t * 1024 + c) = make_uint4(o[0], o[1], o[2], o[3]);
}

__device__ __forceinline__ void ln_body(int t, int lane, const float* in, const float* __restrict__ g, const float* __restrict__ bta, float* outf, bf16* __restrict__ outb) {
    float4 v[8]; float s = 0.f;
#pragma unroll
    for (int j = 0; j < 8; ++j) { v[j] = *(const float4*)(in + (size_t)t * DM + j * 256 + lane * 4); s += (v[j].x + v[j].y) + (v[j].z + v[j].w); }
    const float mu = wave_sum(s) * (1.0f / DM); float q = 0.f;
#pragma unroll
    for (int j = 0; j < 8; ++j) { v[j].x -= mu; v[j].y -= mu; v[j].z -= mu; v[j].w -= mu; q += (v[j].x * v[j].x + v[j].y * v[j].y) + (v[j].z * v[j].z + v[j].w * v[j].w); }
    const float rs = rsqrtf(wave_sum(q) * (1.0f / DM) + 1e-5f);
    asm volatile("" : "+s"(g), "+s"(bta));
#pragma unroll
    for (int j = 0; j < 8; ++j) { const int c = j * 256 + lane * 4; const float4 gg = *(const float4*)(g + c), bb = *(const float4*)(bta + c);
        float4 y; y.x = v[j].x * rs * gg.x + bb.x; y.y = v[j].y * rs * gg.y + bb.y; y.z = v[j].z * rs * gg.z + bb.z; y.w = v[j].w * rs * gg.w + bb.w;
        *(float4*)(outf + (size_t)t * DM + c) = y; *(uint2*)(outb + (size_t)t * DM + c) = make_uint2(pk2(y.x, y.y), pk2(y.z, y.w)); }
}

#define TOPK_INSERT(tv, ti, val, idx) do { _Pragma("unroll") for (int _j = 15; _j >= 1; --_j) { const bool _c1 = (val) > tv[_j - 1], _c0 = (val) > tv[_j]; \
        ti[_j] = _c1 ? ti[_j - 1] : (_c0 ? (idx) : ti[_j]); tv[_j] = _c1 ? tv[_j - 1] : (_c0 ? (val) : tv[_j]); } \
        { const bool _c0 = (val) > tv[0]; ti[0] = _c0 ? (idx) : ti[0]; tv[0] = _c0 ? (val) : tv[0]; } } while (0)
__device__ __forceinline__ void peer_select_body(int h, int t, const float* __restrict__ q, const float* __restrict__ subkeys, int* __restrict__ ids, float* __restrict__ gates) {
    float tv0[16], tv1[16]; int ti0[16], ti1[16];
#pragma unroll
    for (int j = 0; j < 16; ++j) { tv0[j] = -INFINITY; ti0[j] = 0; tv1[j] = -INFINITY; ti1[j] = 0; }
    {
        float qv[128];
        const float* qp = q + (size_t)t * DM + h * 256;
#pragma unroll
        for (int d = 0; d < 128; d += 4) { const float4 x = *(const float4*)(qp + d); qv[d] = x.x; qv[d + 1] = x.y; qv[d + 2] = x.z; qv[d + 3] = x.w; }
        const float* sk = subkeys + (size_t)(h * 2 + 0) * 128 * 128;
        for (int k = 0; k < 128; ++k) {
            float s = 0.f;
#pragma unroll
            for (int d = 0; d < 128; ++d) s += qv[d] * sk[k * 128 + d];
            TOPK_INSERT(tv0, ti0, s, k);
        }
    }
    {
        float qv[128];
        const float* qp = q + (size_t)t * DM + h * 256 + 128;
#pragma unroll
        for (int d = 0; d < 128; d += 4) { const float4 x = *(const float4*)(qp + d); qv[d] = x.x; qv[d + 1] = x.y; qv[d + 2] = x.z; qv[d + 3] = x.w; }
        const float* sk = subkeys + (size_t)(h * 2 + 1) * 128 * 128;
        for (int k = 0; k < 128; ++k) {
            float s = 0.f;
#pragma unroll
            for (int d = 0; d < 128; ++d) s += qv[d] * sk[k * 128 + d];
            TOPK_INSERT(tv1, ti1, s, k);
        }
    }
    float bv[16]; int bi[16];
#pragma unroll
    for (int j = 0; j < 16; ++j) { bv[j] = -INFINITY; bi[j] = 0; }
#pragma unroll
    for (int a = 0; a < 16; ++a)
#pragma unroll
        for (int b = 0; b < 16; ++b) if ((a + 1) * (b + 1) <= 16) { const float cv = tv0[a] + tv1[b]; const int ci = ti0[a] * 128 + ti1[b]; TOPK_INSERT(bv, bi, cv, ci); }
    float den = 0.f, e[16];
#pragma unroll
    for (int j = 0; j < 16; ++j) { e[j] = expf(bv[j] - bv[0]); den += e[j]; }
    const float inv = 1.0f / den;
#pragma unroll
    for (int j = 0; j < 16; ++j) { ids[(size_t)t * 128 + h * 16 + j] = bi[j]; gates[(size_t)t * 128 + h * 16 + j] = e[j] * inv; }
}
__device__ __forceinline__ float gelu_erf(float v) {
    const float av = fabsf(v), t = __builtin_amdgcn_rcpf(av * 0.2316418882f + 1.0f);
    float q = t * 0.5307027145f + (-0.7265760135f); q = q * t + 0.7107068705f; q = q * t + (-0.142248368f); q = q * t + 0.127414796f; q = q * t;
    const float e = __builtin_amdgcn_exp2f((v * v) * (-0.72134752044f));
    const float mm = v * (q * e), r = v - mm;
    return v < 0.f ? mm : r;
}
constexpr float U8_SCALE = 1024.0f, V8_SCALE = 128.0f;
typedef float f32x2_t __attribute__((ext_vector_type(2)));
__device__ __forceinline__ unsigned pack_fp8x4(float a, float b, float c, float d) { int w = 0; w = __builtin_amdgcn_cvt_pk_fp8_f32(a, b, w, false); w = __builtin_amdgcn_cvt_pk_fp8_f32(c, d, w, true); return (unsigned)w; }
__device__ __forceinline__ void tab_to_fp8(size_t i, const float* __restrict__ src, uint4* __restrict__ dst, float sc) {
    const float4* s = (const float4*)src + i * 4; const float4 a = s[0], b = s[1], c = s[2], d = s[3];
    dst[i] = make_uint4(pack_fp8x4(a.x * sc, a.y * sc, a.z * sc, a.w * sc), pack_fp8x4(b.x * sc, b.y * sc, b.z * sc, b.w * sc), pack_fp8x4(c.x * sc, c.y * sc, c.z * sc, c.w * sc), pack_fp8x4(d.x * sc, d.y * sc, d.z * sc, d.w * sc));
}
__device__ __forceinline__ float dot16_fp8(const uint4 w, const float4* xv, float s) {
    const unsigned ww[4] = {w.x, w.y, w.z, w.w};
#pragma unroll
    for (int j = 0; j < 4; ++j) { const f32x2_t lo = __builtin_amdgcn_cvt_pk_f32_fp8((int)ww[j], false), hi = __builtin_amdgcn_cvt_pk_f32_fp8((int)ww[j], true);
        s += (xv[j].x * lo.x + xv[j].y * lo.y) + (xv[j].z * hi.x + xv[j].w * hi.y); }
    return s;
}
__device__ __forceinline__ void axpy16_fp8(const uint4 w, float c, float4* acc) {
    const unsigned ww[4] = {w.x, w.y, w.z, w.w};
#pragma unroll
    for (int j = 0; j < 4; ++j) { const f32x2_t lo = __builtin_amdgcn_cvt_pk_f32_fp8((int)ww[j], false), hi = __builtin_amdgcn_cvt_pk_f32_fp8((int)ww[j], true);
        acc[j].x += c * lo.x; acc[j].y += c * lo.y; acc[j].z += c * hi.x; acc[j].w += c * hi.y; }
}
__device__ __forceinline__ void peer_expert_body(int t, int lane, const float* __restrict__ x1, const int* __restrict__ ids, const float* __restrict__ gates, const unsigned char* __restrict__ U8, const unsigned char* __restrict__ V8,
                                                 const float* __restrict__ g, const float* __restrict__ bta, float* __restrict__ outf, bf16* __restrict__ outb) {
    float4 xv[8], acc[8];
#pragma unroll
    for (int j = 0; j < 2; ++j)
#pragma unroll
        for (int i = 0; i < 4; ++i) { xv[j * 4 + i] = *(const float4*)(x1 + (size_t)t * DM + j * 1024 + lane * 16 + i * 4); acc[j * 4 + i] = make_float4(0.f, 0.f, 0.f, 0.f); }
    const int* idp = ids + (size_t)t * 128; const float* gp = gates + (size_t)t * 128;
    uint4 ua[2][2], va[2][2], ub[2][2], vb[2][2];
#define PEER_LOAD(U_, V_, e_) do { _Pragma("unroll") for (int k_ = 0; k_ < 2; ++k_) { const int id_ = __builtin_amdgcn_readfirstlane(idp[(e_) + k_]); \
        const uint4* up_ = (const uint4*)(U8 + (size_t)id_ * DM) + lane; const uint4* vp_ = (const uint4*)(V8 + (size_t)id_ * DM) + lane; \
        U_[k_][0] = up_[0]; U_[k_][1] = up_[64]; V_[k_][0] = vp_[0]; V_[k_][1] = vp_[64]; } } while (0)
#define SB_ __builtin_amdgcn_sched_barrier(0)
#define PEER_COMP(U_, V_, e_) do { SB_; float s0_ = dot16_fp8(U_[0][0], xv, 0.f); SB_; s0_ = dot16_fp8(U_[0][1], xv + 4, s0_); SB_; float s1_ = dot16_fp8(U_[1][0], xv, 0.f); SB_; s1_ = dot16_fp8(U_[1][1], xv + 4, s1_); SB_; \
        s0_ = wave_sum(s0_); s1_ = wave_sum(s1_); \
        s0_ *= (1.0f / U8_SCALE); s1_ *= (1.0f / U8_SCALE); \
        const float c0_ = gp[(e_)] * (1.0f / V8_SCALE) * gelu_erf(s0_), c1_ = gp[(e_) + 1] * (1.0f / V8_SCALE) * gelu_erf(s1_); SB_; \
        axpy16_fp8(V_[0][0], c0_, acc); SB_; axpy16_fp8(V_[0][1], c0_, acc + 4); SB_; axpy16_fp8(V_[1][0], c1_, acc); SB_; axpy16_fp8(V_[1][1], c1_, acc + 4); SB_; } while (0)
    PEER_LOAD(ua, va, 0);
#pragma nounroll
    for (int e = 0; e < 128; e += 4) {
        PEER_LOAD(ub, vb, e + 2);
        PEER_COMP(ua, va, e);
        if (e + 4 < 128) PEER_LOAD(ua, va, e + 4);
        PEER_COMP(ub, vb, e + 2);
    }
#undef PEER_LOAD
#undef PEER_COMP
#undef SB_
    float s = 0.f;
#pragma unroll
    for (int j = 0; j < 8; ++j) { acc[j].x += ALPHA * xv[j].x; acc[j].y += ALPHA * xv[j].y; acc[j].z += ALPHA * xv[j].z; acc[j].w += ALPHA * xv[j].w; s += (acc[j].x + acc[j].y) + (acc[j].z + acc[j].w); }
    const float mu = wave_sum(s) * (1.0f / DM); float q = 0.f;
#pragma unroll
    for (int j = 0; j < 8; ++j) { acc[j].x -= mu; acc[j].y -= mu; acc[j].z -= mu; acc[j].w -= mu; q += (acc[j].x * acc[j].x + acc[j].y * acc[j].y) + (acc[j].z * acc[j].z + acc[j].w * acc[j].w); }
    const float rs = rsqrtf(wave_sum(q) * (1.0f / DM) + 1e-5f);
    asm volatile("" : "+s"(g), "+s"(bta));
#pragma unroll
    for (int j = 0; j < 2; ++j)
#pragma unroll
        for (int i = 0; i < 4; ++i) { const int c = j * 1024 + lane * 16 + i * 4; const float4 a4 = acc[j * 4 + i]; const float4 gg = *(const float4*)(g + c), bb = *(const float4*)(bta + c);
            float4 y; y.x = a4.x * rs * gg.x + bb.x; y.y = a4.y * rs * gg.y + bb.y; y.z = a4.z * rs * gg.z + bb.z; y.w = a4.w * rs * gg.w + bb.w;
            *(float4*)(outf + (size_t)t * DM + c) = y; *(uint2*)(outb + (size_t)t * DM + c) = make_uint2(pk2(y.x, y.y), pk2(y.z, y.w)); }
}

typedef short bf16x8_t __attribute__((ext_vector_type(8)));
typedef float f32x4_t __attribute__((ext_vector_type(4)));
typedef unsigned u32x2_t __attribute__((ext_vector_type(2)));
typedef unsigned u32x4_t __attribute__((ext_vector_type(4)));
constexpr int SWA_PITCH = 144;
constexpr int SWA_KS = 0, SWA_VS = 256 * SWA_PITCH, SWA_LDS = 2 * 256 * SWA_PITCH;
static_assert(SWA_LDS <= RING_BYTES, "SWA LDS");
__device__ __forceinline__ float grp4_max(float v) {
    v = fmaxf(v, __builtin_bit_cast(float, __builtin_amdgcn_ds_swizzle(__builtin_bit_cast(int, v), 0x401F)));
    const u32x2_t r = __builtin_amdgcn_permlane32_swap(__builtin_bit_cast(unsigned, v), __builtin_bit_cast(unsigned, v), false, false);
    return fmaxf(__builtin_bit_cast(float, r.x), __builtin_bit_cast(float, r.y));
}
__device__ __forceinline__ float grp4_sum(float v) {
    v += __builtin_bit_cast(float, __builtin_amdgcn_ds_swizzle(__builtin_bit_cast(int, v), 0x401F));
    const u32x2_t r = __builtin_amdgcn_permlane32_swap(__builtin_bit_cast(unsigned, v), __builtin_bit_cast(unsigned, v), false, false);
    return __builtin_bit_cast(float, r.x) + __builtin_bit_cast(float, r.y);
}
__device__ __forceinline__ void tr_read2(unsigned a0, unsigned a1, u32x2_t& r0, u32x2_t& r1) {
    asm volatile("ds_read_b64_tr_b16 %0, %2\n\tds_read_b64_tr_b16 %1, %3\n\ts_waitcnt lgkmcnt(0)" : "=&v"(r0), "=&v"(r1) : "v"(a0), "v"(a1) : "memory");
}
__device__ __forceinline__ void rope8(uint4& lo, uint4& hi, const float4* cs, float scale) {
    unsigned* a = (unsigned*)&lo; unsigned* b = (unsigned*)&hi;
#pragma unroll
    for (int j = 0; j < 4; ++j) {
        const float x1a = __uint_as_float(a[j] << 16), x1b = __uint_as_float(a[j] & 0xffff0000u), x2a = __uint_as_float(b[j] << 16), x2b = __uint_as_float(b[j] & 0xffff0000u);
        const float4 c = cs[j];
        const float y1a = (x1a * c.x - x2a * c.y) * scale, y2a = (x2a * c.x + x1a * c.y) * scale, y1b = (x1b * c.z - x2b * c.w) * scale, y2b = (x2b * c.z + x1b * c.w) * scale;
        a[j] = pk2(y1a, y1b); b[j] = pk2(y2a, y2b);
    }
}
__device__ __forceinline__ void swa_phase(LAS unsigned char* lds, const bf16* __restrict__ proj, const float* __restrict__ rtab  , const float* __restrict__ sinks, bf16* __restrict__ ya,
                                          int tid, int bx, int G) {
    const int lane = tid & 63, w = __builtin_amdgcn_readfirstlane(tid >> 6), l15 = lane & 15, g4 = lane >> 4;
    const unsigned ldsb = (unsigned)(size_t)lds;
    for (int u = bx; u < NBATCH * 32 * 4; u += G) {
        const int kvh = u & 3, nb = (u >> 2) & 31, b = u >> 7;
        const int t0 = b * SEQ + nb * 128;
        __syncthreads();
        for (int it = tid; it < 1024; it += 512) { const int kk = it >> 2, c = it & 3;
            uint4 lo = make_uint4(0u, 0u, 0u, 0u), hi = lo;
            if (nb > 0 || kk >= 128) { const bf16* src = proj + (size_t)(t0 - 128 + kk) * NP + C_AK + kvh * 64 + 8 * c; lo = *(const uint4*)src; hi = *(const uint4*)(src + 32);
                const float4* cs = (const float4*)(rtab + ((size_t)(nb * 128 - 128 + kk) * 32 + 8 * c) * 2); const float4 c4[4] = {cs[0], cs[1], cs[2], cs[3]}; rope8(lo, hi, c4, 1.0f); }
            *(LAS u32x4_t*)(lds + SWA_KS + kk * SWA_PITCH + 16 * c) = __builtin_bit_cast(u32x4_t, lo); *(LAS u32x4_t*)(lds + SWA_KS + kk * SWA_PITCH + 64 + 16 * c) = __builtin_bit_cast(u32x4_t, hi); }
        for (int it = tid; it < 2048; it += 512) { const int kk = it >> 3, c = it & 7;
            uint4 v = make_uint4(0u, 0u, 0u, 0u);
            if (nb > 0 || kk >= 128) v = *(const uint4*)(proj + (size_t)(t0 - 128 + kk) * NP + C_AV + kvh * 64 + 8 * c);
            *(LAS u32x4_t*)(lds + SWA_VS + kk * SWA_PITCH + 16 * c) = __builtin_bit_cast(u32x4_t, v); }
        __syncthreads();
        const int r = w >> 1, hf = w & 1, hq = kvh * 4 + r;
        const float sink = sinks[hq];
#pragma nounroll
        for (int qt = 0; qt < 4; ++qt) {
            const int i0 = 64 * hf + 16 * qt, iq = i0 + l15, tq = t0 + iq, ktb0 = 4 * hf + qt;
            bf16x8_t q0, q1;
            { const bf16* src = proj + (size_t)tq * NP + C_AQ + hq * 64 + 8 * g4; uint4 lo = *(const uint4*)src, hi = *(const uint4*)(src + 32);
              const float4* cs = (const float4*)(rtab + ((size_t)(nb * 128 + iq) * 32 + 8 * g4) * 2); const float4 c4[4] = {cs[0], cs[1], cs[2], cs[3]}; rope8(lo, hi, c4, 0.125f);
              q0 = __builtin_bit_cast(bf16x8_t, lo); q1 = __builtin_bit_cast(bf16x8_t, hi); }
            f32x4_t s[10]; float m = sink;
#pragma unroll
            for (int n = 0; n < 10; ++n) {
                const int kt = (ktb0 + n) < 15 ? (ktb0 + n) : 15;
                const LAS unsigned char* kp = lds + SWA_KS + (16 * kt + l15) * SWA_PITCH + 16 * g4;
                const bf16x8_t a0 = *(const LAS bf16x8_t*)kp, a1 = *(const LAS bf16x8_t*)(kp + 64);
                f32x4_t acc = (f32x4_t){0.f, 0.f, 0.f, 0.f};
                acc = __builtin_amdgcn_mfma_f32_16x16x32_bf16(a0, q0, acc, 0, 0, 0);
                acc = __builtin_amdgcn_mfma_f32_16x16x32_bf16(a1, q1, acc, 0, 0, 0);
#pragma unroll
                for (int e = 0; e < 4; ++e) { const int kk = 16 * (ktb0 + n) + 4 * g4 + e;
                    const bool ok = (kk >= iq + 1) && (kk <= iq + 128) && (nb > 0 || kk >= 128) && (ktb0 + n <= 15);
                    acc[e] = ok ? acc[e] : -1e30f; m = fmaxf(m, acc[e]); }
                s[n] = acc;
            }
            m = grp4_max(m);
            float lsum = 0.f;
#pragma unroll
            for (int n = 0; n < 10; ++n)
#pragma unroll
                for (int e = 0; e < 4; ++e) { const float p = __expf(s[n][e] - m); s[n][e] = p; lsum += p; }
            lsum = grp4_sum(lsum) + __expf(sink - m);
            const float inv = 1.0f / lsum;
            bf16x8_t pf[5];
#pragma unroll
            for (int pi = 0; pi < 5; ++pi) { uint4 w4; w4.x = pk2(s[2 * pi][0], s[2 * pi][1]); w4.y = pk2(s[2 * pi][2], s[2 * pi][3]); w4.z = pk2(s[2 * pi + 1][0], s[2 * pi + 1][1]); w4.w = pk2(s[2 * pi + 1][2], s[2 * pi + 1][3]);
                pf[pi] = __builtin_bit_cast(bf16x8_t, w4); }
            const int qq = l15 >> 2, pp = lane & 3;
#pragma unroll
            for (int dt = 0; dt < 4; ++dt) {
                f32x4_t o = (f32x4_t){0.f, 0.f, 0.f, 0.f};
#pragma unroll
                for (int pi = 0; pi < 5; ++pi) {
                    const int ka = (ktb0 + 2 * pi) < 15 ? (ktb0 + 2 * pi) : 15, kb = (ktb0 + 2 * pi + 1) < 15 ? (ktb0 + 2 * pi + 1) : 15;
                    u32x2_t v0, v1;
                    tr_read2(ldsb + SWA_VS + (16 * ka + 4 * g4 + qq) * SWA_PITCH + (16 * dt + 4 * pp) * 2, ldsb + SWA_VS + (16 * kb + 4 * g4 + qq) * SWA_PITCH + (16 * dt + 4 * pp) * 2, v0, v1);
                    const uint4 av = make_uint4(v0.x, v0.y, v1.x, v1.y);
                    o = __builtin_amdgcn_mfma_f32_16x16x32_bf16(__builtin_bit_cast(bf16x8_t, av), pf[pi], o, 0, 0, 0);
                }
                *(uint2*)(ya + (size_t)tq * 1024 + hq * 64 + 16 * dt + 4 * g4) = make_uint2(pk2(o[0] * inv, o[1] * inv), pk2(o[2] * inv, o[3] * inv));
            }
        }
    }
}

struct MegaArgs { const float* in[22]; float* out; unsigned char* ws; };
template <int I> __device__ __forceinline__ unsigned long long ld_ptr() {
    unsigned long long v; const auto ka = __builtin_amdgcn_kernarg_segment_ptr();
    asm volatile("s_load_dwordx2 %0, %1, %2\n\ts_waitcnt lgkmcnt(0)" : "=s"(v) : "s"(ka), "n"(I * 8) : "memory");
    return v;
}
#define INF(i) ((const float*)ld_ptr<(i)>())
#define OUTP ((float*)ld_ptr<22>())
#define WSP ((unsigned char*)ld_ptr<23>())
enum { I_X = 0, I_WIN, I_MGATEB, I_MNORMW, I_CONVW, I_CONVB, I_DTB, I_ALOG, I_SSMD, I_SNORMW, I_SINKS, I_MERGEB, I_WBR, I_WOUT, I_LN1G, I_LN1B, I_WQ, I_SUBK, I_PU, I_PV, I_LN2G, I_LN2B };

__global__ void __launch_bounds__(512, 2) mega_fwd(MegaArgs a) {
    extern __shared__ __attribute__((aligned(16))) unsigned char lds_raw[];
    LAS unsigned char* lds = (LAS unsigned char*)lds_raw;
    const int wave0 = __builtin_amdgcn_readfirstlane(threadIdx.x >> 6);
    volatile LAS unsigned* MISC = (volatile LAS unsigned*)(lds + MISC_OFF);
    { PHASE_IDS for (int u = tid; u < (LDS_BYTES - RING_BYTES) / 4; u += 512) ((LAS unsigned*)(lds + RING_BYTES))[u] = 0u; }
    __syncthreads();
    { XcdBarrier b0 = xcd_barrier_post((unsigned*)(WSP + WS_CTL) + CW_BAR, MISC + 8); (void)b0; }
#define GRID_BAR() do { XcdBarrier b_; b_.bar = (unsigned*)(WSP + WS_CTL) + CW_BAR; b_.x = xb_xcc_id(); b_.st = MISC + 8; xcd_barrier(b_); } while (0)

    { PHASE_IDS float2* rt = (float2*)(WSP + WS_ROPE);
      for (size_t i = gt; i < (size_t)SEQ * 32; i += NGT) { const int pos = (int)(i >> 5), fi = (int)(i & 31); const float ang = (float)pos * powf(10000.0f, -(float)fi / 32.0f); rt[i] = make_float2(cosf(ang), sinf(ang)); } }
    { PHASE_IDS const float* x = INF(I_X); bf16* xb = (bf16*)(WSP + WS_XB);
      for (size_t i = gt; i < (size_t)T_TOK * DM / 4; i += NGT) { const float4 v = ((const float4*)x)[i]; ((uint2*)xb)[i] = make_uint2(pk2(v.x, v.y), pk2(v.z, v.w)); } }

#pragma nounroll
    for (int l = 0; l < DEPTH; ++l) {
        { PHASE_IDS
            unsigned char* ws = WSP; bf16* WinT = (bf16*)(ws + WS_WIN); bf16* WbT = (bf16*)(ws + WS_WB); bf16* WoT = (bf16*)(ws + WS_WO); bf16* WqT = (bf16*)(ws + WS_WQ); float* bias = (float*)(ws + WS_BIAS);
            const float* w_in = INF(I_WIN) + (size_t)l * DM * IN_COLS; const float* w_branch = INF(I_WBR) + (size_t)l * 3 * 1024 * DM; const float* w_out = INF(I_WOUT) + (size_t)l * DM * DM; const float* peer_wq = INF(I_WQ) + (size_t)l * DM * DM;
            const float* merge_gate_b = INF(I_MERGEB) + (size_t)l * 3 * DM;
            LAS float* scr = (LAS float*)(lds + wave * 16384);
            constexpr int I_IN = (DM / 64) * (NP / 32), I_B = (1024 / 64) * (DM / 32), I_O = (DM / 64) * (DM / 32);
            constexpr int NITEMS = I_IN + 3 * I_B + 2 * I_O;
            for (int it = gw; it < NITEMS; it += NGW) {
                int r = it;
                if (r < I_IN) { transpose_item<1>(w_in, DM, IN_COLS, NP, WinT, scr, r, lane); continue; } r -= I_IN;
                if (r < 3 * I_B) { const int k = r / I_B; transpose_item<0>(w_branch + (size_t)k * 1024 * DM, 1024, DM, DM, WbT + (size_t)k * DM * 1024, scr, r - k * I_B, lane); continue; } r -= 3 * I_B;
                if (r < I_O) { transpose_item<0>(w_out, DM, DM, DM, WoT, scr, r, lane); continue; } r -= I_O;
                transpose_item<0>(peer_wq, DM, DM, DM, WqT, scr, r, lane);
            }
            for (size_t n = gt; n < NP; n += NGT) bias[n] = (n >= C_G && n < C_SMALL) ? merge_gate_b[n - C_G] : 0.f;
        }
        GRID_BAR();
        { PHASE_IDS unsigned char* ws = WSP; pg8::Gemm g{(const bf16*)(ws + WS_XB), (const bf16*)(ws + WS_WIN), T_TOK, NP, DM}; pg8::StaticOrder S; S.init(T_TOK, NP, G, bx);
          pg8::EpiProj E{(bf16*)(ws + WS_PROJ), (const float*)(ws + WS_BIAS), (float*)(ws + WS_SMALL), NP, GATE_TILE_LO, SMALL_TILE, 0};
          pg8::gemm_phase<pg8::EpiProj, pg8::StaticOrder, true, true>(lds, g, S, E, tid); }
        GRID_BAR();
        { PHASE_IDS unsigned char* ws = WSP; const bf16* proj = (const bf16*)(ws + WS_PROJ); float* xc = (float*)(ws + WS_R2);
          const float* cw = INF(I_CONVW) + (size_t)l * 4 * 1536; const float* cb = INF(I_CONVB) + l * 1536;
          for (size_t i = gt; i < (size_t)T_TOK * 1536; i += NGT) ssd_conv_body(i, proj, cw, cb, xc); }
        GRID_BAR();
        { PHASE_IDS unsigned char* ws = WSP; const bf16* proj = (const bf16*)(ws + WS_PROJ); const float* small = (const float*)(ws + WS_SMALL);
        if (wave < 2) { float* hm = (float*)(ws + WS_HM); const float* gb = INF(I_MGATEB) + l * 8;
            for (int i = bx * 128 + tid; i < NBATCH * 4 * 256 * 4; i += G * 128) mlstm_body(i, proj, small, gb, hm); }
        else if (wave < 4) { float* xc = (float*)(ws + WS_R2); const float* dtb = INF(I_DTB) + l * 16; const float* alog = INF(I_ALOG) + l * 16; const float* dsk = INF(I_SSMD) + l * 16;
            for (int i = bx * 128 + (tid - 128); i < NBATCH * 16 * 64 * 4; i += G * 128) ssd_scan_body(i, xc, small, dtb, alog, dsk, xc); }
        }
        { PHASE_IDS unsigned char* ws = WSP; swa_phase(lds, (const bf16*)(ws + WS_PROJ), (const float*)(ws + WS_ROPE), INF(I_SINKS) + l * 16, (bf16*)(ws + WS_Y + 128 * MiB), tid, bx, G); }
        GRID_BAR();
        { PHASE_IDS unsigned char* ws = WSP; const bf16* proj = (const bf16*)(ws + WS_PROJ); const float* hm = (const float*)(ws + WS_HM); bf16* ym = (bf16*)(ws + WS_Y); const float* nw = INF(I_MNORMW) + l * 1024;
          for (int w = gw; w < T_TOK * 4; w += NGW) mlstm_post_body(w, lane, hm, proj, nw, ym); }
        { PHASE_IDS unsigned char* ws = WSP; const bf16* proj = (const bf16*)(ws + WS_PROJ); const float* xc = (const float*)(ws + WS_R2); bf16* ys = (bf16*)(ws + WS_Y + 64 * MiB); const float* nw = INF(I_SNORMW) + l * 1024;
          for (int w = gw; w < T_TOK * 2; w += NGW) ssd_post_body(w, lane, xc, proj, nw, ys); }
        GRID_BAR();
        { PHASE_IDS unsigned char* ws = WSP; pg8::Gemm g{(const bf16*)(ws + WS_Y), (const bf16*)(ws + WS_WB), T_TOK, DM, 1024}; pg8::StaticOrder S; S.init(T_TOK, DM, G, bx);
          pg8::EpiMix<1> E{(bf16*)(ws + WS_R1), (const bf16*)(ws + WS_PROJ) + C_G, DM, NP};
          pg8::gemm_phase<pg8::EpiMix<1>, pg8::StaticOrder, true, true>(lds, g, S, E, tid); }
        __syncthreads();
        { PHASE_IDS unsigned char* ws = WSP; pg8::Gemm g{(const bf16*)(ws + WS_Y + 64 * MiB), (const bf16*)(ws + WS_WB) + (size_t)DM * 1024, T_TOK, DM, 1024}; pg8::StaticOrder S; S.init(T_TOK, DM, G, bx);
          pg8::EpiMix<0> E{(bf16*)(ws + WS_R1), (const bf16*)(ws + WS_PROJ) + C_G + DM, DM, NP};
          pg8::gemm_phase<pg8::EpiMix<0>, pg8::StaticOrder, true, true>(lds, g, S, E, tid); }
        __syncthreads();
        { PHASE_IDS unsigned char* ws = WSP; pg8::Gemm g{(const bf16*)(ws + WS_Y + 128 * MiB), (const bf16*)(ws + WS_WB) + (size_t)2 * DM * 1024, T_TOK, DM, 1024}; pg8::StaticOrder S; S.init(T_TOK, DM, G, bx);
          pg8::EpiMix<0> E{(bf16*)(ws + WS_R1), (const bf16*)(ws + WS_PROJ) + C_G + 2 * DM, DM, NP};
          pg8::gemm_phase<pg8::EpiMix<0>, pg8::StaticOrder, true, true>(lds, g, S, E, tid); }
        GRID_BAR();
        { PHASE_IDS unsigned char* ws = WSP; const float* xin = l == 0 ? INF(I_X) : (const float*)OUTP;
          pg8::Gemm g{(const bf16*)(ws + WS_R1), (const bf16*)(ws + WS_WO), T_TOK, DM, DM}; pg8::StaticOrder S; S.init(T_TOK, DM, G, bx); pg8::EpiResid E{(float*)(ws + WS_BUFB), xin, DM, ALPHA};
          pg8::gemm_phase<pg8::EpiResid, pg8::StaticOrder, true, true>(lds, g, S, E, tid); }
        GRID_BAR();
        { PHASE_IDS unsigned char* ws = WSP; float* bufB = (float*)(ws + WS_BUFB); bf16* xb = (bf16*)(ws + WS_XB); const float* g1 = INF(I_LN1G) + l * DM; const float* b1 = INF(I_LN1B) + l * DM;
          for (int t = gw; t < T_TOK; t += NGW) ln_body(t, lane, bufB, g1, b1, bufB, xb); }
        { PHASE_IDS unsigned char* ws = WSP; constexpr size_t NGRP = (size_t)P_EXPERTS * DM / 16;
          const float* pu = INF(I_PU) + (size_t)l * P_EXPERTS * DM; const float* pv = INF(I_PV) + (size_t)l * P_EXPERTS * DM; uint4* U8 = (uint4*)(ws + WS_R2); uint4* V8 = (uint4*)(ws + WS_R2 + 32 * MiB);
          for (size_t i = gt; i < 2 * NGRP; i += NGT) { if (i < NGRP) tab_to_fp8(i, pu, U8, U8_SCALE); else tab_to_fp8(i - NGRP, pv, V8, V8_SCALE); } }
        GRID_BAR();
        { PHASE_IDS unsigned char* ws = WSP; pg8::Gemm g{(const bf16*)(ws + WS_XB), (const bf16*)(ws + WS_WQ), T_TOK, DM, DM}; pg8::StaticOrder S; S.init(T_TOK, DM, G, bx); pg8::EpiF32 E{(float*)(ws + WS_QF), DM, 0};
          pg8::gemm_phase<pg8::EpiF32, pg8::StaticOrder, true, true>(lds, g, S, E, tid); }
        GRID_BAR();
        { PHASE_IDS unsigned char* ws = WSP; const float* qf = (const float*)(ws + WS_QF); int* ids = (int*)(ws + WS_IDS); float* gates = (float*)(ws + WS_GATES); const float* sk = INF(I_SUBK) + (size_t)l * 8 * 2 * 128 * 128;
          for (int wi = gw; wi < 8 * (T_TOK / 64); wi += NGW) { const int h = wi / (T_TOK / 64), t = (wi % (T_TOK / 64)) * 64 + lane; peer_select_body(h, t, qf, sk, ids, gates); } }
        GRID_BAR();
        { PHASE_IDS unsigned char* ws = WSP; const float* bufB = (const float*)(ws + WS_BUFB); const int* ids = (const int*)(ws + WS_IDS); const float* gates = (const float*)(ws + WS_GATES);
          const unsigned char* U8 = ws + WS_R2; const unsigned char* V8 = ws + WS_R2 + 32 * MiB; const float* g2 = INF(I_LN2G) + l * DM; const float* b2 = INF(I_LN2B) + l * DM; float* out = OUTP; bf16* xb = (bf16*)(ws + WS_XB);
          for (int t = gw; t < T_TOK; t += NGW) peer_expert_body(t, lane, bufB, ids, gates, U8, V8, g2, b2, out, xb); }
        GRID_BAR();
    }
#undef GRID_BAR
}

extern "C" void kernel_launch(void* const* d_in, const int* in_sizes, int n_in, void* d_out, int out_size, void* d_ws, size_t ws_size, hipStream_t stream) {
    static int grid = 0;
    if (grid == 0) {
        if (n_in != 22 || out_size != T_TOK * DM || ws_size < WS_END) { fprintf(stderr, "kernel_launch: unexpected shapes (n_in %d, out %d, ws %zu)\n", n_in, out_size, ws_size); grid = -1; return; }
        int dev = 0, cus = 0, per_cu = 0;
        if (hipGetDevice(&dev) != hipSuccess || hipDeviceGetAttribute(&cus, hipDeviceAttributeMultiprocessorCount, dev) != hipSuccess) { grid = -1; return; }
        if (hipFuncSetAttribute((const void*)mega_fwd, hipFuncAttributeMaxDynamicSharedMemorySize, LDS_BYTES) != hipSuccess) { fprintf(stderr, "kernel_launch: hipFuncSetAttribute failed\n"); grid = -1; return; }
        if (hipOccupancyMaxActiveBlocksPerMultiprocessor(&per_cu, (const void*)mega_fwd, 512, LDS_BYTES) != hipSuccess || per_cu < 1) { fprintf(stderr, "kernel_launch: occupancy query says %d blocks per CU\n", per_cu); (void)hipGetLastError(); grid = -1; return; }
        grid = cus;
    }
    if (grid < 0) return;
    (void)hipMemsetAsync((char*)d_ws + WS_CTL, 0, CTL_ZERO_BYTES, stream);
    MegaArgs a; memset(&a, 0, sizeof(a));
    for (int i = 0; i < 22; ++i) a.in[i] = (const float*)d_in[i];
    a.out = (float*)d_out; a.ws = (unsigned char*)d_ws;
    hipLaunchKernelGGL(mega_fwd, dim3(grid), dim3(512), LDS_BYTES, stream, a);
}
```

```cpp
#include <hip/hip_runtime.h>
#include <cstdio>
#include <cstdint>
#include <cstring>

namespace pg8 {
#define PG8_LAS __attribute__((address_space(3)))
typedef unsigned short bf16_t;
typedef short bf16x8 __attribute__((ext_vector_type(8)));
typedef float f32x4 __attribute__((ext_vector_type(4)));
typedef unsigned u32x4 __attribute__((ext_vector_type(4)));
constexpr int BM = 256, BK = 64, HALF = 128, HTB = HALF * BK * 2  , STAGE_BYTES = 8 * HTB, NXCD = 8, WGM = 8;

__host__ __device__ __forceinline__ int lds_byte(int r, int c) { const int st = (r >> 4) * 2 + (c >> 5), rr = r & 15, cc = c & 31, ob = rr * 64 + cc * 2; return st * 1024 + (ob ^ (((ob >> 9) & 1) << 5)); }
__host__ __device__ __forceinline__ void stage_rc(int b, int& R, int& C) { const int st = b / 1024, sb = b % 1024, swz = sb ^ (((sb >> 9) & 1) << 5); R = (st >> 1) * 16 + swz / 64; C = (st & 1) * 32 + (swz % 64) / 2; }
__host__ __device__ __forceinline__ int perm32(int rho) { const int n = rho >> 4, i = rho & 15; return 8 * (i >> 2) + 4 * n + (i & 3); }

struct Unit { int pm, pn; };
struct Gemm { const bf16_t* A; const bf16_t* Bt; int M, N, K; };

struct StaticOrder {
    int nM, nN, nwg, G, c;
    __host__ __device__ void init(int M, int N, int G_, int c_) { nM = M / BM; nN = N / BM; nwg = nM * nN; G = G_; c = c_; }
    __host__ __device__ bool next(int i, Unit& u) const {
        const long L = (long)i * G + c; if (L >= nwg) return false;
        int wgid = (int)L; { const int q = nwg / NXCD, r = nwg % NXCD, xcd = wgid % NXCD, off = wgid / NXCD; wgid = (xcd < r ? xcd * (q + 1) : r * (q + 1) + (xcd - r) * q) + off; }
        const int nig = WGM * nN, gid = wgid / nig, fm = gid * WGM, gsz = (nM - fm) < WGM ? (nM - fm) : WGM;
        u.pm = fm + ((wgid % nig) % gsz); u.pn = (wgid % nig) / gsz; return true;
    }
    __device__ __forceinline__ void a_ready(const Unit&) const {}
    __device__ __forceinline__ void done(const Unit&) const {}
};

__device__ __forceinline__ unsigned cvt_pk_bf16(float lo, float hi) { unsigned r; asm volatile("v_cvt_pk_bf16_f32 %0, %1, %2" : "=v"(r) : "v"(lo), "v"(hi)); return r; }
typedef float f32x2 __attribute__((ext_vector_type(2)));
__device__ __forceinline__ float bf_lo(unsigned w) { return __uint_as_float(w << 16); }
__device__ __forceinline__ float bf_hi(unsigned w) { return __uint_as_float(w & 0xffff0000u); }
__device__ __forceinline__ float sigmoidf_(float x) { return 1.0f / (1.0f + __expf(-x)); }

struct EpiF32 {
    static constexpr bool PERM = false, AFTER_DRAIN = false;
    float* C; int ldc; int pad;
    __device__ __forceinline__ void operator()(const f32x4 (&acc)[2][2][4][2], const Unit& u, int wr, int wc, int fr, int fq) const {
        const int row0 = u.pm * BM + wr * 64 + fr, col0 = u.pn * BM + wc * 32 + 4 * fq;
#pragma unroll
        for (int ai = 0; ai < 2; ++ai)
#pragma unroll
            for (int m = 0; m < 4; ++m) { float* rowp = C + (size_t)(row0 + ai * HALF + m * 16) * ldc + col0;
#pragma unroll
                for (int bj = 0; bj < 2; ++bj)
#pragma unroll
                    for (int n = 0; n < 2; ++n) *(f32x4*)(rowp + bj * HALF + n * 16) = acc[ai][bj][m][n]; }
    }
};
struct EpiResid {
    static constexpr bool PERM = false, AFTER_DRAIN = false;
    float* C; const float* X; int ldc; float alpha;
    __device__ __forceinline__ void operator()(const f32x4 (&acc)[2][2][4][2], const Unit& u, int wr, int wc, int fr, int fq) const {
        const int row0 = u.pm * BM + wr * 64 + fr, col0 = u.pn * BM + wc * 32 + 4 * fq;
#pragma unroll
        for (int ai = 0; ai < 2; ++ai)
#pragma unroll
            for (int m = 0; m < 4; ++m) { const size_t off = (size_t)(row0 + ai * HALF + m * 16) * ldc + col0;
#pragma unroll
                for (int bj = 0; bj < 2; ++bj)
#pragma unroll
                    for (int n = 0; n < 2; ++n) { const f32x4 xv = *(const f32x4*)(X + off + bj * HALF + n * 16);
                        *(f32x4*)(C + off + bj * HALF + n * 16) = acc[ai][bj][m][n] + xv * alpha; } }
    }
};
struct EpiProj {
    static constexpr bool PERM = true, AFTER_DRAIN = false;
    bf16_t* O; const float* bias; float* small; int ldc; int gate_lo; int small_tile; int pad;
    __device__ __forceinline__ void operator()(const f32x4 (&acc)[2][2][4][2], const Unit& u, int wr, int wc, int fr, int fq) const {
        const int row0 = u.pm * BM + wr * 64 + fr, col0 = u.pn * BM + wc * 32 + 8 * fq;
        if (u.pn == small_tile) {
            if (wc == 0) {
#pragma unroll
                for (int ai = 0; ai < 2; ++ai)
#pragma unroll
                    for (int m = 0; m < 4; ++m) { float* p = small + (size_t)(row0 + ai * HALF + m * 16) * 32 + 8 * fq;
                        *(f32x4*)p = acc[ai][0][m][0]; *(f32x4*)(p + 4) = acc[ai][0][m][1]; }
            }
            return;
        }
        const bool gate = u.pn >= gate_lo;
        f32x4 bv[2][2];
#pragma unroll
        for (int bj = 0; bj < 2; ++bj)
#pragma unroll
            for (int n = 0; n < 2; ++n) bv[bj][n] = gate ? *(const f32x4*)(bias + col0 + bj * HALF + 4 * n) : (f32x4){0.f, 0.f, 0.f, 0.f};
#pragma unroll
        for (int ai = 0; ai < 2; ++ai)
#pragma unroll
            for (int m = 0; m < 4; ++m) { bf16_t* rowp = O + (size_t)(row0 + ai * HALF + m * 16) * ldc + col0;
#pragma unroll
                for (int bj = 0; bj < 2; ++bj) { f32x4 v0 = acc[ai][bj][m][0] + bv[bj][0], v1 = acc[ai][bj][m][1] + bv[bj][1];
                    if (gate) {
#pragma unroll
                        for (int j = 0; j < 4; ++j) { v0[j] = sigmoidf_(v0[j]); v1[j] = sigmoidf_(v1[j]); } }
                    u32x4 w; w.x = cvt_pk_bf16(v0[0], v0[1]); w.y = cvt_pk_bf16(v0[2], v0[3]); w.z = cvt_pk_bf16(v1[0], v1[1]); w.w = cvt_pk_bf16(v1[2], v1[3]);
                    *(u32x4*)(rowp + bj * HALF) = w; } }
    }
};
template <int FIRST> struct EpiMix {
    static constexpr bool PERM = true, AFTER_DRAIN = false;
    bf16_t* O; const bf16_t* G; int ldc; int ldg;
    __device__ __forceinline__ void operator()(const f32x4 (&acc)[2][2][4][2], const Unit& u, int wr, int wc, int fr, int fq) const {
        const int row0 = u.pm * BM + wr * 64 + fr, col0 = u.pn * BM + wc * 32 + 8 * fq;
#pragma unroll
        for (int ai = 0; ai < 2; ++ai)
#pragma unroll
            for (int m = 0; m < 4; ++m) { const int row = row0 + ai * HALF + m * 16; bf16_t* rowp = O + (size_t)row * ldc + col0; const bf16_t* gp = G + (size_t)row * ldg + col0;
#pragma unroll
                for (int bj = 0; bj < 2; ++bj) { const u32x4 gw = *(const u32x4*)(gp + bj * HALF); u32x4 ow = (u32x4){0u, 0u, 0u, 0u}; if (!FIRST) ow = *(const u32x4*)(rowp + bj * HALF);
                    const f32x4 a0 = acc[ai][bj][m][0], a1 = acc[ai][bj][m][1];
                    float r0 = bf_lo(ow.x) + bf_lo(gw.x) * a0[0], r1 = bf_hi(ow.x) + bf_hi(gw.x) * a0[1], r2 = bf_lo(ow.y) + bf_lo(gw.y) * a0[2], r3 = bf_hi(ow.y) + bf_hi(gw.y) * a0[3];
                    float r4 = bf_lo(ow.z) + bf_lo(gw.z) * a1[0], r5 = bf_hi(ow.z) + bf_hi(gw.z) * a1[1], r6 = bf_lo(ow.w) + bf_lo(gw.w) * a1[2], r7 = bf_hi(ow.w) + bf_hi(gw.w) * a1[3];
                    u32x4 w; w.x = cvt_pk_bf16(r0, r1); w.y = cvt_pk_bf16(r2, r3); w.z = cvt_pk_bf16(r4, r5); w.w = cvt_pk_bf16(r6, r7);
                    *(u32x4*)(rowp + bj * HALF) = w; } }
    }
};

template <class Epi, class Sched, bool ALIGN_EPI = false, bool SP2 = false>
__device__ __forceinline__ void gemm_phase(PG8_LAS unsigned char* lds, const Gemm g, const Sched& S, const Epi& E, int tid_) {
    asm volatile("" : "+v"(tid_));
    const int tid = tid_, wid = __builtin_amdgcn_readfirstlane(tid >> 6), lane = tid & 63, wr = wid >> 2, wc = wid & 3, fr = lane & 15, fq = lane >> 4;
    const int K = g.K, nt = K / BK;
    unsigned voffA[2], voffB[2];
#pragma unroll
    for (int i = 0; i < 2; ++i) { int R, C; stage_rc(tid * 16 + i * 8192, R, C); const int Rb = Epi::PERM ? ((R & ~31) + perm32(R & 31)) : R;
        voffA[i] = (unsigned)(R * K + C) * 2u; voffB[i] = (unsigned)(Rb * K + C) * 2u; }
    const size_t kstep = (size_t)(BK * 2);
    const size_t hstep = (size_t)HALF * K * 2;
    const size_t tstep = 2 * hstep;
    const unsigned ldsw = (unsigned)wid * 1024u;
    const int aoff = lds_byte(wr * 64 + fr, fq * 8), boff = lds_byte(wc * 32 + fr, fq * 8);
#define PG8_SA(b, h) (((b) * 2 + (h)) * HTB)
#define PG8_SB(b, h) ((4 + (b) * 2 + (h)) * HTB)
#define PG8_STAGE(bufoff, gbase, voff) do { _Pragma("unroll") for (int _i = 0; _i < 2; ++_i) \
        __builtin_amdgcn_global_load_lds((const unsigned*)((const char*)(gbase) + (voff)[_i]), (PG8_LAS unsigned*)(lds + (bufoff) + ldsw + _i * 8192), 16, 0, 0); } while (0)
#define PG8_LDA(dst, b, h) do { _Pragma("unroll") for (int m = 0; m < 4; ++m) _Pragma("unroll") for (int k = 0; k < 2; ++k) dst[m][k] = *(const PG8_LAS bf16x8*)(lds + PG8_SA(b, h) + aoff + m * 2048 + k * 1024); } while (0)
#define PG8_LDB(dst, b, h) do { _Pragma("unroll") for (int n = 0; n < 2; ++n) _Pragma("unroll") for (int k = 0; k < 2; ++k) dst[n][k] = *(const PG8_LAS bf16x8*)(lds + PG8_SB(b, h) + boff + n * 2048 + k * 1024); } while (0)
#define PG8_MMA(ai, bj, At, Bt) do { __builtin_amdgcn_s_setprio(1); _Pragma("unroll") for (int m = 0; m < 4; ++m) _Pragma("unroll") for (int n = 0; n < 2; ++n) _Pragma("unroll") for (int k = 0; k < 2; ++k) \
        acc[ai][bj][m][n] = __builtin_amdgcn_mfma_f32_16x16x32_bf16(Bt[n][k], At[m][k], acc[ai][bj][m][n], 0, 0, 0); __builtin_amdgcn_s_setprio(0); } while (0)
#define PG8_WAIT_V(n) asm volatile("s_waitcnt vmcnt(" #n ")" ::: "memory")
#define PG8_WAIT_L(n) asm volatile("s_waitcnt lgkmcnt(" #n ")" ::: "memory")
#define PG8_BAR __builtin_amdgcn_s_barrier()
#define PG8_SCHED __builtin_amdgcn_sched_barrier(0)
    Unit cur, nxt; int ui = 0;
    if (!S.next(0, cur)) return;
    f32x4 acc[2][2][4][2];
#pragma unroll
    for (int a = 0; a < 2; ++a)
#pragma unroll
        for (int b = 0; b < 2; ++b)
#pragma unroll
            for (int m = 0; m < 4; ++m)
#pragma unroll
                for (int n = 0; n < 2; ++n) acc[a][b][m][n] = (f32x4){0.f, 0.f, 0.f, 0.f};
    bf16x8 At[4][2], B0[2][2], B1[2][2];
    const char* cA = (const char*)g.A + (size_t)cur.pm * tstep; const char* cB = (const char*)g.Bt + (size_t)cur.pn * tstep;
    S.a_ready(cur);
    if constexpr (SP2) {
        PG8_STAGE(PG8_SB(0, 0), cB, voffB); PG8_STAGE(PG8_SB(0, 1), cB + hstep, voffB); PG8_STAGE(PG8_SA(0, 0), cA, voffA); PG8_STAGE(PG8_SA(0, 1), cA + hstep, voffA);
        if (wr == 1) PG8_BAR;
        PG8_WAIT_V(2); PG8_BAR;
        PG8_STAGE(PG8_SB(1, 0), cB + kstep, voffB); PG8_STAGE(PG8_SA(1, 0), cA + kstep, voffA); PG8_STAGE(PG8_SB(1, 1), cB + hstep + kstep, voffB);
        PG8_WAIT_V(6); PG8_BAR;
    } else {
        PG8_STAGE(PG8_SB(0, 0), cB, voffB); PG8_STAGE(PG8_SA(0, 0), cA, voffA); PG8_STAGE(PG8_SB(0, 1), cB + hstep, voffB); PG8_STAGE(PG8_SA(0, 1), cA + hstep, voffA);
        if (wr == 1) PG8_BAR;
        PG8_WAIT_V(4); PG8_BAR;
        PG8_STAGE(PG8_SB(1, 0), cB + kstep, voffB); PG8_STAGE(PG8_SA(1, 0), cA + kstep, voffA); PG8_STAGE(PG8_SB(1, 1), cB + hstep + kstep, voffB);
        PG8_WAIT_V(6); PG8_BAR;
    }
    for (;;) {
        const bool has_next = S.next(ui + 1, nxt);
        const char* nA = has_next ? (const char*)g.A + (size_t)nxt.pm * tstep : cA; const char* nB = has_next ? (const char*)g.Bt + (size_t)nxt.pn * tstep : cB;
        for (int t = 0; t < nt; t += 2) {
            const bool last = (t == nt - 2);
            const char* a1 = cA + (size_t)(t + 1) * kstep;
            const char* a2 = last ? nA : cA + (size_t)(t + 2) * kstep; const char* b2 = last ? nB : cB + (size_t)(t + 2) * kstep;
            const char* a3 = a2 + kstep; const char* b3 = b2 + kstep;
            if (last && has_next) S.a_ready(nxt);
            if constexpr (SP2) {
            PG8_LDB(B0, 0, 0); PG8_LDB(B1, 0, 1); PG8_SCHED; PG8_LDA(At, 0, 0); PG8_STAGE(PG8_SA(1, 1), a1 + hstep, voffA);
            PG8_WAIT_V(8); PG8_WAIT_L(0); PG8_BAR; PG8_MMA(0, 0, At, B0); PG8_MMA(0, 1, At, B1); PG8_BAR; PG8_SCHED;
            PG8_LDA(At, 0, 1); PG8_STAGE(PG8_SB(0, 0), b2, voffB); PG8_STAGE(PG8_SB(0, 1), b2 + hstep, voffB); PG8_STAGE(PG8_SA(0, 0), a2, voffA);
            PG8_WAIT_V(8); PG8_WAIT_L(0); PG8_BAR; PG8_MMA(1, 0, At, B0); PG8_MMA(1, 1, At, B1); PG8_BAR; PG8_SCHED;
            PG8_LDB(B0, 1, 0); PG8_LDB(B1, 1, 1); PG8_SCHED; PG8_LDA(At, 1, 0); PG8_STAGE(PG8_SA(0, 1), a2 + hstep, voffA);
            PG8_WAIT_V(8); PG8_WAIT_L(0); PG8_BAR; PG8_MMA(0, 0, At, B0); PG8_MMA(0, 1, At, B1); PG8_BAR; PG8_SCHED;
            PG8_LDA(At, 1, 1); PG8_STAGE(PG8_SB(1, 0), b3, voffB); PG8_STAGE(PG8_SB(1, 1), b3 + hstep, voffB); PG8_STAGE(PG8_SA(1, 0), a3, voffA);
            PG8_WAIT_V(8); PG8_WAIT_L(0); PG8_BAR; PG8_MMA(1, 0, At, B0); PG8_MMA(1, 1, At, B1); PG8_BAR; PG8_SCHED;
            } else {
            PG8_LDB(B0, 0, 0); PG8_SCHED; PG8_LDA(At, 0, 0); PG8_STAGE(PG8_SA(1, 1), a1 + hstep, voffA);
            PG8_WAIT_L(8); PG8_BAR; PG8_WAIT_L(0); PG8_MMA(0, 0, At, B0); PG8_BAR; PG8_SCHED;
            PG8_LDB(B1, 0, 1); PG8_STAGE(PG8_SB(0, 0), b2, voffB);
            PG8_BAR; PG8_WAIT_L(0); PG8_MMA(0, 1, At, B1); PG8_BAR;
            PG8_LDA(At, 0, 1); PG8_STAGE(PG8_SA(0, 0), a2, voffA);
            PG8_BAR; PG8_WAIT_L(0); PG8_MMA(1, 0, At, B0); PG8_BAR; PG8_SCHED;
            PG8_STAGE(PG8_SB(0, 1), b2 + hstep, voffB);
            PG8_WAIT_V(6); PG8_BAR; PG8_MMA(1, 1, At, B1); PG8_BAR;
            PG8_LDB(B0, 1, 0); PG8_SCHED; PG8_LDA(At, 1, 0); PG8_STAGE(PG8_SA(0, 1), a2 + hstep, voffA);
            PG8_WAIT_L(8); PG8_BAR; PG8_WAIT_L(0); PG8_MMA(0, 0, At, B0); PG8_BAR; PG8_SCHED;
            PG8_LDB(B1, 1, 1); PG8_STAGE(PG8_SB(1, 0), b3, voffB);
            PG8_BAR; PG8_WAIT_L(0); PG8_MMA(0, 1, At, B1); PG8_BAR;
            PG8_LDA(At, 1, 1); PG8_STAGE(PG8_SA(1, 0), a3, voffA);
            PG8_BAR; PG8_WAIT_L(0); PG8_MMA(1, 0, At, B0); PG8_BAR; PG8_SCHED;
            PG8_STAGE(PG8_SB(1, 1), b3 + hstep, voffB);
            PG8_WAIT_V(6); PG8_BAR; PG8_MMA(1, 1, At, B1); PG8_BAR;
            }
        }
        if constexpr (ALIGN_EPI) { if (wr == 0) PG8_BAR; }
        if constexpr (!Epi::AFTER_DRAIN) { E(acc, cur, wr, wc, fr, fq); S.done(cur); }
        if (!has_next) break;
#pragma unroll
        for (int a = 0; a < 2; ++a)
#pragma unroll
            for (int b = 0; b < 2; ++b)
#pragma unroll
                for (int m = 0; m < 4; ++m)
#pragma unroll
                    for (int n = 0; n < 2; ++n) acc[a][b][m][n] = (f32x4){0.f, 0.f, 0.f, 0.f};
        cur = nxt; cA = nA; cB = nB; ++ui;
        if constexpr (ALIGN_EPI) { if (wr == 1) PG8_BAR; }
    }
    PG8_WAIT_V(0);
    if constexpr (!ALIGN_EPI) { if (wr == 0) PG8_BAR; }
    PG8_BAR;
    if constexpr (Epi::AFTER_DRAIN) { E.fused(acc, cur, wr, wc, fr, fq, lds, wid, lane); S.done(cur); }
#undef PG8_SA
#undef PG8_SB
#undef PG8_STAGE
#undef PG8_LDA
#undef PG8_LDB
#undef PG8_MMA
#undef PG8_WAIT_V
#undef PG8_WAIT_L
#undef PG8_BAR
#undef PG8_SCHED
}
}
typedef unsigned short bf16;
#define LAS __attribute__((address_space(3)))
constexpr int T_TOK = 32768, DM = 2048, SEQ = 4096, NBATCH = 8, DEPTH = 4;
constexpr int IN_COLS = 13336, NP = 13568;
constexpr int C_MQ = 0, C_MK = 512, C_MV = 1024, C_MO = 2048, C_SZ = 3072, C_SXBC = 4096, C_AQ = 5632, C_AK = 6656, C_AV = 6912, C_G = 7168, C_SMALL = 13312;
constexpr int GATE_TILE_LO = C_G / 256, SMALL_TILE = C_SMALL / 256;
constexpr float ALPHA = 1.681792830507429f;
constexpr int P_EXPERTS = 16384;

constexpr size_t MiB = 1u << 20;
constexpr size_t WS_CTL = 0, CTL_ZERO_BYTES = 64 * 1024, WS_WIN = 1 * MiB, WS_WB = 54 * MiB, WS_WO = 66 * MiB, WS_WQ = 74 * MiB, WS_BIAS = 82 * MiB, WS_SMALL = 83 * MiB, WS_ROPE = 87 * MiB,
                 WS_XB = 88 * MiB, WS_BUFB = 216 * MiB, WS_PROJ = 472 * MiB, WS_R1 = 1320 * MiB, WS_Y = 1480 * MiB, WS_R2 = 1672 * MiB, WS_HM = 1864 * MiB, WS_END = 1992 * MiB;
constexpr size_t WS_QF = WS_PROJ, WS_IDS = WS_PROJ + 256 * MiB, WS_GATES = WS_PROJ + 272 * MiB;
constexpr int CW_BAR = 4096;
constexpr int RING_BYTES = 131072, PHASE_LDS_BYTES = 155648, MISC_OFF = PHASE_LDS_BYTES + 320, LDS_BYTES = 163840;

__device__ __forceinline__ unsigned f2bf(float f) { unsigned u = __float_as_uint(f); return (u + 0x7fffu + ((u >> 16) & 1u)) >> 16; }
__device__ __forceinline__ unsigned pk2(float lo, float hi) { return f2bf(lo) | (f2bf(hi) << 16); }
__device__ __forceinline__ float bf2f(bf16 b) { return __uint_as_float(((unsigned)b) << 16); }
__device__ __forceinline__ float sigm(float x) { return 1.0f / (1.0f + expf(-x)); }
template <int CTRL> __device__ __forceinline__ float dpp_f(float v) { return __builtin_bit_cast(float, __builtin_amdgcn_update_dpp(0, __builtin_bit_cast(int, v), CTRL, 0xF, 0xF, true)); }
__device__ __forceinline__ float quad_sum(float v) { v += dpp_f<0xB1>(v); v += dpp_f<0x4E>(v); return v; }
__device__ __forceinline__ float wave_sum(float v) {
    v = quad_sum(v); v += dpp_f<0x141>(v); v += dpp_f<0x140>(v);
    v += __builtin_bit_cast(float, __builtin_amdgcn_ds_swizzle(__builtin_bit_cast(int, v), 0x401F));
    return __builtin_bit_cast(float, __builtin_amdgcn_readlane(__builtin_bit_cast(int, v), 0)) + __builtin_bit_cast(float, __builtin_amdgcn_readlane(__builtin_bit_cast(int, v), 32));
}
__device__ __forceinline__ int src_col(int n) {
    if (n < 3072) return n;
    if (n < 5632) return n + 8;
    if (n < 13312) return n + 24;
    if (n < 13320) return 3072 + (n - 13312);
    if (n < 13336) return 5640 + (n - 13320);
    return -1;
}

#define XB_TMO      128
#define XB_XCNT(j)  (256  + 64 * (j))
#define XB_XSUB(j)  (1280 + 64 * (j))
#define XB_XGEN(j)  (2304 + 64 * (j))
#define XB_TOP      3328
#define XB_TOPGEN   3392
#define XCD_BAR_WORDS 3456
#define XB_SPIN_CAP (1u << 18)

__device__ __forceinline__ unsigned xb_ld(unsigned* p)              { return __hip_atomic_load(p, __ATOMIC_RELAXED, __HIP_MEMORY_SCOPE_AGENT); }
__device__ __forceinline__ unsigned xb_add(unsigned* p, unsigned v) { return __hip_atomic_fetch_add(p, v, __ATOMIC_RELAXED, __HIP_MEMORY_SCOPE_AGENT); }
__device__ __forceinline__ unsigned xb_xcc_id() { return (unsigned)__builtin_amdgcn_s_getreg((3 << 11) | 20) & 0xFu; }
#define XB_SPIN(cond, bar) do { unsigned _sp = 0; while (cond) { __builtin_amdgcn_s_sleep(1); \
    if ((++_sp & 255u) == 0u) { if (xb_ld(&(bar)[XB_TMO])) break; if (_sp > XB_SPIN_CAP) { atomicAdd(&(bar)[XB_TMO], 1u); break; } } } } while (0)

struct XcdBarrier {
    unsigned* bar; unsigned x;
    volatile LAS unsigned* st;
};

__device__ __forceinline__ XcdBarrier xcd_barrier_post(unsigned* bar, volatile LAS unsigned* st) {
    XcdBarrier b; b.bar = bar; b.x = xb_xcc_id(); b.st = st;
    if (threadIdx.x == 0) (void)xb_add(&bar[XB_XCNT(b.x)], 1u);
    return b;
}
__device__ __forceinline__ void xcd_barrier_complete(unsigned* bar, unsigned x, unsigned& nloc, unsigned& nx) {
    const unsigned G = gridDim.x * gridDim.y * gridDim.z;
    unsigned sum, cnt, mine, sp = 0u;
    for (;;) {
        sum = 0u; cnt = 0u; mine = 0u;
#pragma unroll
        for (unsigned j = 0; j < 16; ++j) { const unsigned c = xb_ld(&bar[XB_XCNT(j)]); sum += c; cnt += (c > 0u) ? 1u : 0u; mine = (j == x) ? c : mine; }
        if (sum == G) break;
        __builtin_amdgcn_s_sleep(1);
        if ((++sp & 255u) == 0u) { if (xb_ld(&bar[XB_TMO])) break; if (sp > XB_SPIN_CAP) { atomicAdd(&bar[XB_TMO], 1u); break; } }
    }
    nloc = mine > 0u ? mine : 1u; nx = cnt > 0u ? cnt : 1u;
}

__device__ __forceinline__ void xcd_barrier(const XcdBarrier& b) {
    asm volatile("s_waitcnt vmcnt(0)" ::: "memory");
    __syncthreads();
    if (threadIdx.x == 0) {
        unsigned* bar = b.bar;
        __builtin_amdgcn_s_waitcnt(0);
        unsigned nloc = b.st[0], nx = b.st[1];
        if (nloc == 0u) { xcd_barrier_complete(bar, b.x, nloc, nx); b.st[0] = nloc; b.st[1] = nx; }
        const unsigned old = xb_add(&bar[XB_XSUB(b.x)], 1u);
        const unsigned gen = old / nloc;
        if (old + 1u == (gen + 1u) * nloc) {
            __builtin_amdgcn_fence(__ATOMIC_RELEASE, "agent");
            asm volatile("s_waitcnt vmcnt(0)" ::: "memory");
            const unsigned og = xb_add(&bar[XB_TOP], 1u);
            const unsigned tg = og / nx;
            if (og + 1u == (tg + 1u) * nx) xb_add(&bar[XB_TOPGEN], 1u);
            else XB_SPIN(xb_ld(&bar[XB_TOPGEN]) == tg, bar);
            __builtin_amdgcn_fence(__ATOMIC_ACQUIRE, "agent");
            xb_add(&bar[XB_XGEN(b.x)], 1u);
            asm volatile("s_waitcnt vmcnt(0)" ::: "memory");
        } else {
            XB_SPIN(xb_ld(&bar[XB_XGEN(b.x)]) == gen, bar);
            __builtin_amdgcn_fence(__ATOMIC_ACQUIRE, "agent");
            asm volatile("s_waitcnt vmcnt(0)" ::: "memory");
        }
    }
    __syncthreads();
}

__device__ __forceinline__ int fresh_tid(int wave0) { int l; asm volatile("v_mbcnt_lo_u32_b32 %0, -1, 0\n\tv_mbcnt_hi_u32_b32 %0, -1, %0" : "=v"(l)); return wave0 * 64 + l; }
#define PHASE_IDS int G = gridDim.x, bx = blockIdx.x; asm volatile("" : "+s"(G), "+s"(bx)); const int tid = fresh_tid(wave0), lane = tid & 63, wave = wave0; const int gw = bx * 8 + wave, NGW = G * 8; \
    const size_t gt = (size_t)bx * 512 + tid, NGT = (size_t)G * 512; (void)lane; (void)gw; (void)gt; (void)NGW; (void)NGT; (void)wave;

template <int MODE> __device__ __forceinline__ void transpose_item(const float* __restrict__ W, int K, int ldw, int ndst, bf16* __restrict__ WT, LAS float* scr, int item, int lane) {
    const int nblk = ndst / 32, kb = item / nblk, nb = item % nblk, k0 = 64 * kb, n0 = 32 * nb;
    const int n_l = n0 + (lane & 31); const int sc = MODE ? src_col(n_l) : n_l;
#pragma unroll 8
    for (int i = 0; i < 32; ++i) { const int kk = 2 * i + (lane >> 5); scr[kk * 33 + (lane & 31)] = sc >= 0 ? W[(size_t)(k0 + kk) * ldw + sc] : 0.f; }
    asm volatile("s_waitcnt lgkmcnt(0)" ::: "memory");
    const int c = lane & 7;
#pragma unroll
    for (int j = 0; j < 4; ++j) { const int n = (lane >> 3) + 8 * j; const LAS float* s = scr + (8 * c) * 33 + n;
        uint4 o; o.x = pk2(s[0 * 33], s[1 * 33]); o.y = pk2(s[2 * 33], s[3 * 33]); o.z = pk2(s[4 * 33], s[5 * 33]); o.w = pk2(s[6 * 33], s[7 * 33]);
        *(uint4*)(WT + (size_t)(n0 + n) * K + k0 + 8 * c) = o; }
    asm volatile("s_waitcnt lgkmcnt(0)" ::: "memory");
}

__device__ __forceinline__ void mlstm_post_body(int w, int lane, const float* __restrict__ hm, const bf16* __restrict__ proj, const float* __restrict__ norm_w, bf16* __restrict__ ym) {
    const int h = w & 3, t = w >> 2;
    const float4 x = *(const float4*)(hm + (size_t)t * 1024 + h * 256 + lane * 4);
    const float mu = wave_sum((x.x + x.y) + (x.z + x.w)) * (1.0f / 256.0f);
    const float d0 = x.x - mu, d1 = x.y - mu, d2 = x.z - mu, d3 = x.w - mu;
    const float var = wave_sum((d0 * d0 + d1 * d1) + (d2 * d2 + d3 * d3)) * (1.0f / 256.0f);
    const float rs = rsqrtf(var + 1e-6f);
    const int c = h * 256 + lane * 4;
    const float4 nw = *(const float4*)(norm_w + c);
    const bf16* op = proj + (size_t)t * NP + C_MO + c;
    const float y0 = d0 * rs * nw.x * sigm(bf2f(op[0])), y1 = d1 * rs * nw.y * sigm(bf2f(op[1])), y2 = d2 * rs * nw.z * sigm(bf2f(op[2])), y3 = d3 * rs * nw.w * sigm(bf2f(op[3]));
    *(uint2*)(ym + (size_t)t * 1024 + c) = make_uint2(pk2(y0, y1), pk2(y2, y3));
}

__device__ __forceinline__ void ssd_conv_body(size_t gid, const bf16* __restrict__ proj, const float* __restrict__ cw, const float* __restrict__ cb, bf16* __restrict__ xcb) {
    const int c = (int)(gid % 768) * 2; const int t = (int)(gid / 768); const int pos = t % SEQ;
    float a0 = cb[c], a1 = cb[c + 1];
#pragma unroll
    for (int j = 0; j < 4; ++j) { const int pp = pos - 3 + j; if (pp >= 0) { const unsigned v = *(const unsigned*)(proj + (size_t)(t - 3 + j) * NP + C_SXBC + c); a0 += cw[j * 1536 + c] * __uint_as_float(v << 16); a1 += cw[j * 1536 + c + 1] * __uint_as_float(v & 0xffff0000u); } }
    *(unsigned*)(xcb + (size_t)t * 1536 + c) = pk2(a0 * sigm(a0), a1 * sigm(a1));
}
__device__ __forceinline__ void ssd_post_body(int w, int lane, const float* __restrict__ yraw, const bf16* __restrict__ proj, const float* __restrict__ norm_w, bf16* __restrict__ ys) {
    const int g = w & 1, t = w >> 1, c = g * 512 + lane * 8;
    float y[8]; float ss = 0.f;
#pragma unroll
    for (int i = 0; i < 8; ++i) { const float z = bf2f(proj[(size_t)t * NP + C_SZ + c + i]); y[i] = yraw[(size_t)t * 1024 + c + i] * (z * sigm(z)); ss += y[i] * y[i]; }
    const float rs = rsqrtf(wave_sum(ss) * (1.0f / 512.0f) + 1e-6f);
    unsigned o[4];
#pragma unroll
    for (int i = 0; i < 4; ++i) o[i] = pk2(y[2 * i] * rs * norm_w[c + 2 * i], y[2 * i + 1] * rs * norm_w[c + 2 * i + 1]);
    *(uint4*)(ys + (size_t)t * 1024 + c) = make_uint4(o[0], o[1], o[2], o[3]);
}

__device__ __forceinline__ void ln_body(int t, int lane, const float* in, const float* __restrict__ g, const float* __restrict__ bta, float* outf, bf16* __restrict__ outb) {
    float4 v[8]; float s = 0.f;
#pragma unroll
    for (int j = 0; j < 8; ++j) { v[j] = *(const float4*)(in + (size_t)t * DM + j * 256 + lane * 4); s += (v[j].x + v[j].y) + (v[j].z + v[j].w); }
    const float mu = wave_sum(s) * (1.0f / DM); float q = 0.f;
#pragma unroll
    for (int j = 0; j < 8; ++j) { v[j].x -= mu; v[j].y -= mu; v[j].z -= mu; v[j].w -= mu; q += (v[j].x * v[j].x + v[j].y * v[j].y) + (v[j].z * v[j].z + v[j].w * v[j].w); }
    const float rs = rsqrtf(wave_sum(q) * (1.0f / DM) + 1e-5f);
    asm volatile("" : "+s"(g), "+s"(bta));
#pragma unroll
    for (int j = 0; j < 8; ++j) { const int c = j * 256 + lane * 4; const float4 gg = *(const float4*)(g + c), bb = *(const float4*)(bta + c);
        float4 y; y.x = v[j].x * rs * gg.x + bb.x; y.y = v[j].y * rs * gg.y + bb.y; y.z = v[j].z * rs * gg.z + bb.z; y.w = v[j].w * rs * gg.w + bb.w;
        *(float4*)(outf + (size_t)t * DM + c) = y; *(uint2*)(outb + (size_t)t * DM + c) = make_uint2(pk2(y.x, y.y), pk2(y.z, y.w)); }
}

#define TOPK_INSERT(tv, ti, val, idx) do { _Pragma("unroll") for (int _j = 15; _j >= 1; --_j) { const bool _c1 = (val) > tv[_j - 1], _c0 = (val) > tv[_j]; \
        ti[_j] = _c1 ? ti[_j - 1] : (_c0 ? (idx) : ti[_j]); tv[_j] = _c1 ? tv[_j - 1] : (_c0 ? (val) : tv[_j]); } \
        { const bool _c0 = (val) > tv[0]; ti[0] = _c0 ? (idx) : ti[0]; tv[0] = _c0 ? (val) : tv[0]; } } while (0)
__device__ __forceinline__ void peer_select_body(int h, int t, const float* __restrict__ q, const float* __restrict__ subkeys, int* __restrict__ ids, float* __restrict__ gates) {
    float tv0[16], tv1[16]; int ti0[16], ti1[16];
#pragma unroll
    for (int j = 0; j < 16; ++j) { tv0[j] = -INFINITY; ti0[j] = 0; tv1[j] = -INFINITY; ti1[j] = 0; }
    {
        float qv[128];
        const float* qp = q + (size_t)t * DM + h * 256;
#pragma unroll
        for (int d = 0; d < 128; d += 4) { const float4 x = *(const float4*)(qp + d); qv[d] = x.x; qv[d + 1] = x.y; qv[d + 2] = x.z; qv[d + 3] = x.w; }
        const float* sk = subkeys + (size_t)(h * 2 + 0) * 128 * 128;
        for (int k = 0; k < 128; ++k) {
            float s = 0.f;
#pragma unroll
            for (int d = 0; d < 128; ++d) s += qv[d] * sk[k * 128 + d];
            TOPK_INSERT(tv0, ti0, s, k);
        }
    }
    {
        float qv[128];
        const float* qp = q + (size_t)t * DM + h * 256 + 128;
#pragma unroll
        for (int d = 0; d < 128; d += 4) { const float4 x = *(const float4*)(qp + d); qv[d] = x.x; qv[d + 1] = x.y; qv[d + 2] = x.z; qv[d + 3] = x.w; }
        const float* sk = subkeys + (size_t)(h * 2 + 1) * 128 * 128;
        for (int k = 0; k < 128; ++k) {
            float s = 0.f;
#pragma unroll
            for (int d = 0; d < 128; ++d) s += qv[d] * sk[k * 128 + d];
            TOPK_INSERT(tv1, ti1, s, k);
        }
    }
    float bv[16]; int bi[16];
#pragma unroll
    for (int j = 0; j < 16; ++j) { bv[j] = -INFINITY; bi[j] = 0; }
#pragma unroll
    for (int a = 0; a < 16; ++a)
#pragma unroll
        for (int b = 0; b < 16; ++b) if ((a + 1) * (b + 1) <= 16) { const float cv = tv0[a] + tv1[b]; const int ci = ti0[a] * 128 + ti1[b]; TOPK_INSERT(bv, bi, cv, ci); }
    float den = 0.f, e[16];
#pragma unroll
    for (int j = 0; j < 16; ++j) { e[j] = expf(bv[j] - bv[0]); den += e[j]; }
    const float inv = 1.0f / den;
#pragma unroll
    for (int j = 0; j < 16; ++j) { ids[(size_t)t * 128 + h * 16 + j] = bi[j]; gates[(size_t)t * 128 + h * 16 + j] = e[j] * inv; }
}
__device__ __forceinline__ float gelu_erf(float v) {
    const float av = fabsf(v), t = __builtin_amdgcn_rcpf(av * 0.2316418882f + 1.0f);
    float q = t * 0.5307027145f + (-0.7265760135f); q = q * t + 0.7107068705f; q = q * t + (-0.142248368f); q = q * t + 0.127414796f; q = q * t;
    const float e = __builtin_amdgcn_exp2f((v * v) * (-0.72134752044f));
    const float mm = v * (q * e), r = v - mm;
    return v < 0.f ? mm : r;
}
constexpr float U8_SCALE = 1024.0f, V8_SCALE = 128.0f;
typedef float f32x2_t __attribute__((ext_vector_type(2)));
__device__ __forceinline__ unsigned pack_fp8x4(float a, float b, float c, float d) { int w = 0; w = __builtin_amdgcn_cvt_pk_fp8_f32(a, b, w, false); w = __builtin_amdgcn_cvt_pk_fp8_f32(c, d, w, true); return (unsigned)w; }
__device__ __forceinline__ void tab_to_fp8(size_t i, const float* __restrict__ src, uint4* __restrict__ dst, float sc) {
    const float4* s = (const float4*)src + i * 4; const float4 a = s[0], b = s[1], c = s[2], d = s[3];
    dst[i] = make_uint4(pack_fp8x4(a.x * sc, a.y * sc, a.z * sc, a.w * sc), pack_fp8x4(b.x * sc, b.y * sc, b.z * sc, b.w * sc), pack_fp8x4(c.x * sc, c.y * sc, c.z * sc, c.w * sc), pack_fp8x4(d.x * sc, d.y * sc, d.z * sc, d.w * sc));
}
__device__ __forceinline__ float dot16_fp8(const uint4 w, const float4* xv, float s) {
    const unsigned ww[4] = {w.x, w.y, w.z, w.w};
#pragma unroll
    for (int j = 0; j < 4; ++j) { const f32x2_t lo = __builtin_amdgcn_cvt_pk_f32_fp8((int)ww[j], false), hi = __builtin_amdgcn_cvt_pk_f32_fp8((int)ww[j], true);
        s += (xv[j].x * lo.x + xv[j].y * lo.y) + (xv[j].z * hi.x + xv[j].w * hi.y); }
    return s;
}
__device__ __forceinline__ void axpy16_fp8(const uint4 w, float c, float4* acc) {
    const unsigned ww[4] = {w.x, w.y, w.z, w.w};
#pragma unroll
    for (int j = 0; j < 4; ++j) { const f32x2_t lo = __builtin_amdgcn_cvt_pk_f32_fp8((int)ww[j], false), hi = __builtin_amdgcn_cvt_pk_f32_fp8((int)ww[j], true);
        acc[j].x += c * lo.x; acc[j].y += c * lo.y; acc[j].z += c * hi.x; acc[j].w += c * hi.y; }
}
__device__ __forceinline__ void peer_expert_body(int t, int lane, const float* __restrict__ x1, const int* __restrict__ ids, const float* __restrict__ gates, const unsigned char* __restrict__ U8, const unsigned char* __restrict__ V8,
                                                 const float* __restrict__ g, const float* __restrict__ bta, float* __restrict__ outf, bf16* __restrict__ outb) {
    float4 xv[8], acc[8];
#pragma unroll
    for (int j = 0; j < 2; ++j)
#pragma unroll
        for (int i = 0; i < 4; ++i) { xv[j * 4 + i] = *(const float4*)(x1 + (size_t)t * DM + j * 1024 + lane * 16 + i * 4); acc[j * 4 + i] = make_float4(0.f, 0.f, 0.f, 0.f); }
    const int* idp = ids + (size_t)t * 128; const float* gp = gates + (size_t)t * 128;
    uint4 ua[2][2], va[2][2], ub[2][2], vb[2][2];
#define PEER_LOAD(U_, V_, e_) do { _Pragma("unroll") for (int k_ = 0; k_ < 2; ++k_) { const int id_ = __builtin_amdgcn_readfirstlane(idp[(e_) + k_]); \
        const uint4* up_ = (const uint4*)(U8 + (size_t)id_ * DM) + lane; const uint4* vp_ = (const uint4*)(V8 + (size_t)id_ * DM) + lane; \
        U_[k_][0] = up_[0]; U_[k_][1] = up_[64]; V_[k_][0] = vp_[0]; V_[k_][1] = vp_[64]; } } while (0)
#define SB_ __builtin_amdgcn_sched_barrier(0)
#define PEER_COMP(U_, V_, e_) do { SB_; float s0_ = dot16_fp8(U_[0][0], xv, 0.f); SB_; s0_ = dot16_fp8(U_[0][1], xv + 4, s0_); SB_; float s1_ = dot16_fp8(U_[1][0], xv, 0.f); SB_; s1_ = dot16_fp8(U_[1][1], xv + 4, s1_); SB_; \
        s0_ = wave_sum(s0_); s1_ = wave_sum(s1_); \
        s0_ *= (1.0f / U8_SCALE); s1_ *= (1.0f / U8_SCALE); \
        const float c0_ = gp[(e_)] * (1.0f / V8_SCALE) * gelu_erf(s0_), c1_ = gp[(e_) + 1] * (1.0f / V8_SCALE) * gelu_erf(s1_); SB_; \
        axpy16_fp8(V_[0][0], c0_, acc); SB_; axpy16_fp8(V_[0][1], c0_, acc + 4); SB_; axpy16_fp8(V_[1][0], c1_, acc); SB_; axpy16_fp8(V_[1][1], c1_, acc + 4); SB_; } while (0)
    PEER_LOAD(ua, va, 0);
#pragma nounroll
    for (int e = 0; e < 128; e += 4) {
        PEER_LOAD(ub, vb, e + 2);
        PEER_COMP(ua, va, e);
        if (e + 4 < 128) PEER_LOAD(ua, va, e + 4);
        PEER_COMP(ub, vb, e + 2);
    }
#undef PEER_LOAD
#undef PEER_COMP
#undef SB_
    float s = 0.f;
#pragma unroll
    for (int j = 0; j < 8; ++j) { acc[j].x += ALPHA * xv[j].x; acc[j].y += ALPHA * xv[j].y; acc[j].z += ALPHA * xv[j].z; acc[j].w += ALPHA * xv[j].w; s += (acc[j].x + acc[j].y) + (acc[j].z + acc[j].w); }
    const float mu = wave_sum(s) * (1.0f / DM); float q = 0.f;
#pragma unroll
    for (int j = 0; j < 8; ++j) { acc[j].x -= mu; acc[j].y -= mu; acc[j].z -= mu; acc[j].w -= mu; q += (acc[j].x * acc[j].x + acc[j].y * acc[j].y) + (acc[j].z * acc[j].z + acc[j].w * acc[j].w); }
    const float rs = rsqrtf(wave_sum(q) * (1.0f / DM) + 1e-5f);
    asm volatile("" : "+s"(g), "+s"(bta));
#pragma unroll
    for (int j = 0; j < 2; ++j)
#pragma unroll
        for (int i = 0; i < 4; ++i) { const int c = j * 1024 + lane * 16 + i * 4; const float4 a4 = acc[j * 4 + i]; const float4 gg = *(const float4*)(g + c), bb = *(const float4*)(bta + c);
            float4 y; y.x = a4.x * rs * gg.x + bb.x; y.y = a4.y * rs * gg.y + bb.y; y.z = a4.z * rs * gg.z + bb.z; y.w = a4.w * rs * gg.w + bb.w;
            *(float4*)(outf + (size_t)t * DM + c) = y; *(uint2*)(outb + (size_t)t * DM + c) = make_uint2(pk2(y.x, y.y), pk2(y.z, y.w)); }
}

typedef short bf16x8_t __attribute__((ext_vector_type(8)));
typedef float f32x4_t __attribute__((ext_vector_type(4)));
typedef unsigned u32x2_t __attribute__((ext_vector_type(2)));
typedef unsigned u32x4_t __attribute__((ext_vector_type(4)));
constexpr int SWA_PITCH = 144;
constexpr int SWA_KS = 0, SWA_VS = 256 * SWA_PITCH, SWA_LDS = 2 * 256 * SWA_PITCH;
static_assert(SWA_LDS <= RING_BYTES, "SWA LDS");
__device__ __forceinline__ float grp4_max(float v) {
    v = fmaxf(v, __builtin_bit_cast(float, __builtin_amdgcn_ds_swizzle(__builtin_bit_cast(int, v), 0x401F)));
    const u32x2_t r = __builtin_amdgcn_permlane32_swap(__builtin_bit_cast(unsigned, v), __builtin_bit_cast(unsigned, v), false, false);
    return fmaxf(__builtin_bit_cast(float, r.x), __builtin_bit_cast(float, r.y));
}
__device__ __forceinline__ float grp4_sum(float v) {
    v += __builtin_bit_cast(float, __builtin_amdgcn_ds_swizzle(__builtin_bit_cast(int, v), 0x401F));
    const u32x2_t r = __builtin_amdgcn_permlane32_swap(__builtin_bit_cast(unsigned, v), __builtin_bit_cast(unsigned, v), false, false);
    return __builtin_bit_cast(float, r.x) + __builtin_bit_cast(float, r.y);
}
__device__ __forceinline__ void tr_read2(unsigned a0, unsigned a1, u32x2_t& r0, u32x2_t& r1) {
    asm volatile("ds_read_b64_tr_b16 %0, %2\n\tds_read_b64_tr_b16 %1, %3\n\ts_waitcnt lgkmcnt(0)" : "=&v"(r0), "=&v"(r1) : "v"(a0), "v"(a1) : "memory");
}
__device__ __forceinline__ void rope8(uint4& lo, uint4& hi, const float4* cs, float scale) {
    unsigned* a = (unsigned*)&lo; unsigned* b = (unsigned*)&hi;
#pragma unroll
    for (int j = 0; j < 4; ++j) {
        const float x1a = __uint_as_float(a[j] << 16), x1b = __uint_as_float(a[j] & 0xffff0000u), x2a = __uint_as_float(b[j] << 16), x2b = __uint_as_float(b[j] & 0xffff0000u);
        const float4 c = cs[j];
        const float y1a = (x1a * c.x - x2a * c.y) * scale, y2a = (x2a * c.x + x1a * c.y) * scale, y1b = (x1b * c.z - x2b * c.w) * scale, y2b = (x2b * c.z + x1b * c.w) * scale;
        a[j] = pk2(y1a, y1b); b[j] = pk2(y2a, y2b);
    }
}
__device__ __forceinline__ void swa_phase(LAS unsigned char* lds, const bf16* __restrict__ proj, const float* __restrict__ rtab  , const float* __restrict__ sinks, bf16* __restrict__ ya,
                                          int tid, int bx, int G) {
    const int lane = tid & 63, w = __builtin_amdgcn_readfirstlane(tid >> 6), l15 = lane & 15, g4 = lane >> 4;
    const unsigned ldsb = (unsigned)(size_t)lds;
    for (int u = bx; u < NBATCH * 32 * 4; u += G) {
        const int kvh = u & 3, nb = (u >> 2) & 31, b = u >> 7;
        const int t0 = b * SEQ + nb * 128;
        __syncthreads();
        for (int it = tid; it < 1024; it += 512) { const int kk = it >> 2, c = it & 3;
            uint4 lo = make_uint4(0u, 0u, 0u, 0u), hi = lo;
            if (nb > 0 || kk >= 128) { const bf16* src = proj + (size_t)(t0 - 128 + kk) * NP + C_AK + kvh * 64 + 8 * c; lo = *(const uint4*)src; hi = *(const uint4*)(src + 32);
                const float4* cs = (const float4*)(rtab + ((size_t)(nb * 128 - 128 + kk) * 32 + 8 * c) * 2); const float4 c4[4] = {cs[0], cs[1], cs[2], cs[3]}; rope8(lo, hi, c4, 1.0f); }
            *(LAS u32x4_t*)(lds + SWA_KS + kk * SWA_PITCH + 16 * c) = __builtin_bit_cast(u32x4_t, lo); *(LAS u32x4_t*)(lds + SWA_KS + kk * SWA_PITCH + 64 + 16 * c) = __builtin_bit_cast(u32x4_t, hi); }
        for (int it = tid; it < 2048; it += 512) { const int kk = it >> 3, c = it & 7;
            uint4 v = make_uint4(0u, 0u, 0u, 0u);
            if (nb > 0 || kk >= 128) v = *(const uint4*)(proj + (size_t)(t0 - 128 + kk) * NP + C_AV + kvh * 64 + 8 * c);
            *(LAS u32x4_t*)(lds + SWA_VS + kk * SWA_PITCH + 16 * c) = __builtin_bit_cast(u32x4_t, v); }
        __syncthreads();
        const int r = w >> 1, hf = w & 1, hq = kvh * 4 + r;
        const float sink = sinks[hq];
#pragma nounroll
        for (int qt = 0; qt < 4; ++qt) {
            const int i0 = 64 * hf + 16 * qt, iq = i0 + l15, tq = t0 + iq, ktb0 = 4 * hf + qt;
            bf16x8_t q0, q1;
            { const bf16* src = proj + (size_t)tq * NP + C_AQ + hq * 64 + 8 * g4; uint4 lo = *(const uint4*)src, hi = *(const uint4*)(src + 32);
              const float4* cs = (const float4*)(rtab + ((size_t)(nb * 128 + iq) * 32 + 8 * g4) * 2); const float4 c4[4] = {cs[0], cs[1], cs[2], cs[3]}; rope8(lo, hi, c4, 0.125f);
              q0 = __builtin_bit_cast(bf16x8_t, lo); q1 = __builtin_bit_cast(bf16x8_t, hi); }
            f32x4_t s[10]; float m = sink;
#pragma unroll
            for (int n = 0; n < 10; ++n) {
                const int kt = (ktb0 + n) < 15 ? (ktb0 + n) : 15;
                const LAS unsigned char* kp = lds + SWA_KS + (16 * kt + l15) * SWA_PITCH + 16 * g4;
                const bf16x8_t a0 = *(const LAS bf16x8_t*)kp, a1 = *(const LAS bf16x8_t*)(kp + 64);
                f32x4_t acc = (f32x4_t){0.f, 0.f, 0.f, 0.f};
                acc = __builtin_amdgcn_mfma_f32_16x16x32_bf16(a0, q0, acc, 0, 0, 0);
                acc = __builtin_amdgcn_mfma_f32_16x16x32_bf16(a1, q1, acc, 0, 0, 0);
#pragma unroll
                for (int e = 0; e < 4; ++e) { const int kk = 16 * (ktb0 + n) + 4 * g4 + e;
                    const bool ok = (kk >= iq + 1) && (kk <= iq + 128) && (nb > 0 || kk >= 128) && (ktb0 + n <= 15);
                    acc[e] = ok ? acc[e] : -1e30f; m = fmaxf(m, acc[e]); }
                s[n] = acc;
            }
            m = grp4_max(m);
            float lsum = 0.f;
#pragma unroll
            for (int n = 0; n < 10; ++n)
#pragma unroll
                for (int e = 0; e < 4; ++e) { const float p = __expf(s[n][e] - m); s[n][e] = p; lsum += p; }
            lsum = grp4_sum(lsum) + __expf(sink - m);
            const float inv = 1.0f / lsum;
            bf16x8_t pf[5];
#pragma unroll
            for (int pi = 0; pi < 5; ++pi) { uint4 w4; w4.x = pk2(s[2 * pi][0], s[2 * pi][1]); w4.y = pk2(s[2 * pi][2], s[2 * pi][3]); w4.z = pk2(s[2 * pi + 1][0], s[2 * pi + 1][1]); w4.w = pk2(s[2 * pi + 1][2], s[2 * pi + 1][3]);
                pf[pi] = __builtin_bit_cast(bf16x8_t, w4); }
            const int qq = l15 >> 2, pp = lane & 3;
#pragma unroll
            for (int dt = 0; dt < 4; ++dt) {
                f32x4_t o = (f32x4_t){0.f, 0.f, 0.f, 0.f};
#pragma unroll
                for (int pi = 0; pi < 5; ++pi) {
                    const int ka = (ktb0 + 2 * pi) < 15 ? (ktb0 + 2 * pi) : 15, kb = (ktb0 + 2 * pi + 1) < 15 ? (ktb0 + 2 * pi + 1) : 15;
                    u32x2_t v0, v1;
                    tr_read2(ldsb + SWA_VS + (16 * ka + 4 * g4 + qq) * SWA_PITCH + (16 * dt + 4 * pp) * 2, ldsb + SWA_VS + (16 * kb + 4 * g4 + qq) * SWA_PITCH + (16 * dt + 4 * pp) * 2, v0, v1);
                    const uint4 av = make_uint4(v0.x, v0.y, v1.x, v1.y);
                    o = __builtin_amdgcn_mfma_f32_16x16x32_bf16(__builtin_bit_cast(bf16x8_t, av), pf[pi], o, 0, 0, 0);
                }
                *(uint2*)(ya + (size_t)tq * 1024 + hq * 64 + 16 * dt + 4 * g4) = make_uint2(pk2(o[0] * inv, o[1] * inv), pk2(o[2] * inv, o[3] * inv));
            }
        }
    }
}

constexpr int ML_QP = 272, ML_VP = 112, ML_PP = 144;
constexpr int ML_Q = 0, ML_K = 2 * 64 * ML_QP, ML_V = ML_K + 2 * 64 * ML_QP, ML_VW = ML_V + 2 * 64 * ML_VP, ML_P = ML_VW + 64 * ML_VP, ML_CT = ML_P + 64 * ML_PP,
              ML_VEC = ML_CT + 48 * ML_QP, ML_END = ML_VEC + 4096;
static_assert(ML_END <= RING_BYTES, "mLSTM LDS");
__device__ __forceinline__ void tr_read2q(unsigned a0, unsigned a1, u32x2_t& r0, u32x2_t& r1) {
    asm volatile("ds_read_b64_tr_b16 %0, %2\n\tds_read_b64_tr_b16 %1, %3\n\ts_waitcnt lgkmcnt(0)" : "=&v"(r0), "=&v"(r1) : "v"(a0), "v"(a1) : "memory");
}
__device__ __forceinline__ bf16x8_t mk_frag(u32x2_t lo, u32x2_t hi) { const u32x4_t v = (u32x4_t){lo.x, lo.y, hi.x, hi.y}; return __builtin_bit_cast(bf16x8_t, v); }
#define LBAR() do { asm volatile("s_waitcnt lgkmcnt(0)" ::: "memory"); __builtin_amdgcn_s_barrier(); asm volatile("" ::: "memory"); } while (0)
__device__ __forceinline__ void mlstm_phase(LAS unsigned char* lds, const bf16* __restrict__ proj, const float* __restrict__ small, const float* __restrict__ gate_b, float* __restrict__ hm, int tid, int bx, int G) {
    const int lane = tid & 63, w = __builtin_amdgcn_readfirstlane(tid >> 6), l15 = lane & 15, g4 = lane >> 4, qq = l15 >> 2, pp = lane & 3;
    const unsigned ldsb = (unsigned)(size_t)lds;
    LAS float* vec = (LAS float*)(lds + ML_VEC);
    for (int u = bx; u < NBATCH * 4 * 8; u += G) {
        const int vs = u & 7, h = (u >> 3) & 3, b = u >> 5;
        const float bi = gate_b[h], bfg = gate_b[4 + h];
        LBAR();
        for (int i = tid; i < 2 * 64; i += 512) { LAS unsigned* p = (LAS unsigned*)(lds + ML_V + i * ML_VP + 64); p[0] = 0x00003F80u;
#pragma unroll
            for (int j = 1; j < 8; ++j) p[j] = 0u; }
        for (int i = tid; i < 48 * ML_QP / 4; i += 512) ((LAS unsigned*)(lds + ML_CT))[i] = 0u;
        f32x4_t cacc[3];
#pragma unroll
        for (int i = 0; i < 3; ++i) cacc[i] = (f32x4_t){0.f, 0.f, 0.f, 0.f};
        uint4 pq[2], pk[2], pv; float pgi = 0.f, pgf = 0.f;
        pv = make_uint4(0u, 0u, 0u, 0u);
#define ML_LOAD(c_) do { const size_t tb_ = (size_t)b * SEQ + (size_t)(c_) * 64; \
            _Pragma("unroll") for (int i_ = 0; i_ < 2; ++i_) { const int p_ = tid + 512 * i_, row_ = p_ >> 4, c16_ = p_ & 15; const bf16* s_ = proj + (tb_ + row_) * NP + h * 128 + c16_ * 8; pq[i_] = *(const uint4*)(s_ + C_MQ); pk[i_] = *(const uint4*)(s_ + C_MK); } \
            if (tid < 256) pv = *(const uint4*)(proj + (tb_ + (tid >> 2)) * NP + C_MV + h * 256 + vs * 32 + (tid & 3) * 8); \
            if (tid >= 256 && tid < 320) { pgi = small[(tb_ + (tid - 256)) * 32 + h]; pgf = small[(tb_ + (tid - 256)) * 32 + 4 + h]; } } while (0)
#define ML_STORE(bi_) do { _Pragma("unroll") for (int i_ = 0; i_ < 2; ++i_) { const int p_ = tid + 512 * i_, row_ = p_ >> 4, c16_ = p_ & 15; \
                *(LAS u32x4_t*)(lds + ML_Q + (bi_) * 64 * ML_QP + row_ * ML_QP + c16_ * 16) = __builtin_bit_cast(u32x4_t, pq[i_]); *(LAS u32x4_t*)(lds + ML_K + (bi_) * 64 * ML_QP + row_ * ML_QP + c16_ * 16) = __builtin_bit_cast(u32x4_t, pk[i_]); } \
            if (tid < 256) *(LAS u32x4_t*)(lds + ML_V + (bi_) * 64 * ML_VP + (tid >> 2) * ML_VP + (tid & 3) * 16) = __builtin_bit_cast(u32x4_t, pv); \
            if (tid >= 256 && tid < 320) { vec[(bi_) * 128 + (tid - 256) * 2] = pgi; vec[(bi_) * 128 + (tid - 256) * 2 + 1] = pgf; } } while (0)
        ML_LOAD(0); ML_STORE(0);
        LBAR();
#pragma nounroll
        for (int c = 0; c < 64; ++c) {
            const int bi_cur = c & 1;
            const LAS unsigned char* Qs = lds + ML_Q + bi_cur * 64 * ML_QP; const LAS unsigned char* Ks = lds + ML_K + bi_cur * 64 * ML_QP;
            const unsigned Ksb = ldsb + ML_K + bi_cur * 64 * ML_QP, Vsb = ldsb + ML_V + bi_cur * 64 * ML_VP, Vwb = ldsb + ML_VW;
            if (c + 1 < 64) ML_LOAD(c + 1);
            if (w == 0) {
                const float ip = vec[bi_cur * 128 + lane * 2] + bi, fp = vec[bi_cur * 128 + lane * 2 + 1] + bfg;
                const float lf = fminf(fp, 0.f) - log1pf(__expf(-fabsf(fp)));
                vec[256 + lane] = lf;
                asm volatile("s_waitcnt lgkmcnt(0)" ::: "memory");
                float bsum = 0.f;
#pragma unroll
                for (int j = 0; j < 64; j += 4) { const f32x4_t v4 = *(const LAS f32x4_t*)(vec + 256 + j);
                    bsum += (j + 0 <= lane) ? v4[0] : 0.f; bsum += (j + 1 <= lane) ? v4[1] : 0.f; bsum += (j + 2 <= lane) ? v4[2] : 0.f; bsum += (j + 3 <= lane) ? v4[3] : 0.f; }
                const float gtot = __builtin_bit_cast(float, __builtin_amdgcn_readlane(__builtin_bit_cast(int, bsum), 63));
                vec[320 + lane] = bsum; vec[384 + lane] = ip - bsum; vec[448 + lane] = __expf(bsum); vec[512 + lane] = __expf(gtot - bsum + ip) * 0.08838834764831845f;
                if (lane == 0) vec[640] = __expf(gtot);
            }
            LBAR();
            {
                const int ti = w >> 1;
#pragma unroll
                for (int sj = 0; sj < 2; ++sj) {
                    const int si = 2 * (w & 1) + sj;
                    f32x4_t acc = (f32x4_t){0.f, 0.f, 0.f, 0.f};
                    if (si <= ti) {
#pragma unroll
                        for (int ks = 0; ks < 4; ++ks) {
                            const bf16x8_t a = *(const LAS bf16x8_t*)(Ks + (16 * si + l15) * ML_QP + (32 * ks + 8 * g4) * 2);
                            const bf16x8_t bq = *(const LAS bf16x8_t*)(Qs + (16 * ti + l15) * ML_QP + (32 * ks + 8 * g4) * 2);
                            acc = __builtin_amdgcn_mfma_f32_16x16x32_bf16(a, bq, acc, 0, 0, 0);
                        }
                        const int t = 16 * ti + l15; const float btv = vec[320 + t];
                        const f32x4_t csv = *(const LAS f32x4_t*)(vec + 384 + 16 * si + 4 * g4);
#pragma unroll
                        for (int e = 0; e < 4; ++e) { const int s = 16 * si + 4 * g4 + e; acc[e] = (s <= t) ? acc[e] * __expf(btv + csv[e]) * 0.08838834764831845f : 0.f; }
                    }
                    *(LAS u32x2_t*)(lds + ML_P + (16 * ti + l15) * ML_PP + (16 * si + 4 * g4) * 2) = (u32x2_t){pk2(acc[0], acc[1]), pk2(acc[2], acc[3])};
                }
            }
            if (tid < 384) { const int s = tid / 6, pc = tid % 6; const float wsv = vec[512 + s];
                const u32x4_t v = *(const LAS u32x4_t*)(lds + ML_V + bi_cur * 64 * ML_VP + s * ML_VP + pc * 16); u32x4_t o;
#pragma unroll
                for (int j = 0; j < 4; ++j) o[j] = pk2(__uint_as_float(v[j] << 16) * wsv, __uint_as_float(v[j] & 0xffff0000u) * wsv);
                *(LAS u32x4_t*)(lds + ML_VW + s * ML_VP + pc * 16) = o; }
            LBAR();
            f32x4_t numv[2]; const int ti5 = w >> 1;
            {
                const int nv = (w & 1) ? 1 : 2, v0 = (w & 1) ? 2 : 0;
#pragma unroll
                for (int j = 0; j < 2; ++j) {
                    numv[j] = (f32x4_t){0.f, 0.f, 0.f, 0.f};
                    if (j < nv) {
                        const int vi = v0 + j;
                        f32x4_t ai = (f32x4_t){0.f, 0.f, 0.f, 0.f}, ax = ai;
#pragma unroll
                        for (int ks = 0; ks < 2; ++ks) {
                            const bf16x8_t a = *(const LAS bf16x8_t*)(lds + ML_P + (16 * ti5 + l15) * ML_PP + (32 * ks + 8 * g4) * 2);
                            u32x2_t r0, r1; tr_read2q(Vsb + (32 * ks + 8 * g4 + qq) * ML_VP + (16 * vi + 4 * pp) * 2, Vsb + (32 * ks + 8 * g4 + 4 + qq) * ML_VP + (16 * vi + 4 * pp) * 2, r0, r1);
                            ai = __builtin_amdgcn_mfma_f32_16x16x32_bf16(a, mk_frag(r0, r1), ai, 0, 0, 0);
                        }
#pragma unroll
                        for (int ks = 0; ks < 4; ++ks) {
                            const bf16x8_t a = *(const LAS bf16x8_t*)(Qs + (16 * ti5 + l15) * ML_QP + (32 * ks + 8 * g4) * 2);
                            const bf16x8_t bc = *(const LAS bf16x8_t*)(lds + ML_CT + (16 * vi + l15) * ML_QP + (32 * ks + 8 * g4) * 2);
                            ax = __builtin_amdgcn_mfma_f32_16x16x32_bf16(a, bc, ax, 0, 0, 0);
                        }
                        const f32x4_t eb = *(const LAS f32x4_t*)(vec + 448 + 16 * ti5 + 4 * g4);
                        numv[j] = ai + eb * ax;
                    }
                }
                if ((w & 1) && l15 == 0) *(LAS f32x4_t*)(vec + 576 + 16 * ti5 + 4 * g4) = numv[0];
            }
            LBAR();
            if (!(w & 1)) {
                const f32x4_t dn = *(const LAS f32x4_t*)(vec + 576 + 16 * ti5 + 4 * g4);
                const size_t tb = (size_t)b * SEQ + (size_t)c * 64;
#pragma unroll
                for (int j = 0; j < 2; ++j)
#pragma unroll
                    for (int e = 0; e < 4; ++e) hm[(tb + 16 * ti5 + 4 * g4 + e) * 1024 + h * 256 + vs * 32 + 16 * j + l15] = numv[j][e] / fmaxf(fabsf(dn[e]), 1.0f);
            }
            {
                const float eg = vec[640];
#pragma unroll
                for (int vi = 0; vi < 3; ++vi) {
                    f32x4_t acc = cacc[vi] * eg;
#pragma unroll
                    for (int ks = 0; ks < 2; ++ks) {
                        u32x2_t a0, a1, b0, b1;
                        tr_read2q(Ksb + (32 * ks + 8 * g4 + qq) * ML_QP + (16 * w + 4 * pp) * 2, Ksb + (32 * ks + 8 * g4 + 4 + qq) * ML_QP + (16 * w + 4 * pp) * 2, a0, a1);
                        tr_read2q(Vwb + (32 * ks + 8 * g4 + qq) * ML_VP + (16 * vi + 4 * pp) * 2, Vwb + (32 * ks + 8 * g4 + 4 + qq) * ML_VP + (16 * vi + 4 * pp) * 2, b0, b1);
                        acc = __builtin_amdgcn_mfma_f32_16x16x32_bf16(mk_frag(a0, a1), mk_frag(b0, b1), acc, 0, 0, 0);
                    }
                    cacc[vi] = acc;
                    *(LAS u32x2_t*)(lds + ML_CT + (16 * vi + l15) * ML_QP + (16 * w + 4 * g4) * 2) = (u32x2_t){pk2(acc[0], acc[1]), pk2(acc[2], acc[3])};
                }
            }
            if (c + 1 < 64) ML_STORE(bi_cur ^ 1);
            LBAR();
        }
#undef ML_LOAD
#undef ML_STORE
    }
}

constexpr int SD_BP = 272, SD_XP = 80;
constexpr int SD_B = 0, SD_C = 128 * SD_BP, SD_M = 2 * 128 * SD_BP, SD_H = 3 * 128 * SD_BP, SD_X = SD_H + 32 * SD_BP, SD_XW = SD_X + 128 * SD_XP, SD_VEC = SD_XW + 128 * SD_XP, SD_END = SD_VEC + 4096;
static_assert(SD_END <= PHASE_LDS_BYTES, "SSD LDS");
__device__ __forceinline__ void ssd_phase(LAS unsigned char* lds, const bf16* __restrict__ xcb  , const float* __restrict__ small, const float* __restrict__ dt_bias, const float* __restrict__ a_log,
                                          const float* __restrict__ dsk, float* __restrict__ yraw  , int tid, int bx, int G) {
    const int lane = tid & 63, w = __builtin_amdgcn_readfirstlane(tid >> 6), l15 = lane & 15, g4 = lane >> 4, qq = l15 >> 2, pp = lane & 3;
    const unsigned ldsb = (unsigned)(size_t)lds;
    LAS float* vec = (LAS float*)(lds + SD_VEC);
    for (int u = bx; u < NBATCH * 16 * 2; u += G) {
        const int ph = u & 1, hh = (u >> 1) & 15, b = u >> 5, g = hh >> 3;
        const float a = -__expf(a_log[hh]), dtb = dt_bias[hh], Dk = dsk[hh];
        LBAR();
        for (int i = tid; i < 32 * SD_BP / 4; i += 512) ((LAS unsigned*)(lds + SD_H))[i] = 0u;
        f32x4_t hacc[2];
        hacc[0] = (f32x4_t){0.f, 0.f, 0.f, 0.f}; hacc[1] = hacc[0];
        uint4 pb[4], pc[4], px; float pdt = 0.f;
#define SD_LOAD(c_) do { const size_t tb_ = (size_t)b * SEQ + (size_t)(c_) * 128; \
            _Pragma("unroll") for (int i_ = 0; i_ < 4; ++i_) { const int p_ = tid + 512 * i_, row_ = p_ >> 4, c16_ = p_ & 15; const bf16* s_ = xcb + (tb_ + row_) * 1536 + 1024 + g * 128 + c16_ * 8; pb[i_] = *(const uint4*)s_; pc[i_] = *(const uint4*)(s_ + 256); } \
            px = *(const uint4*)(xcb + (tb_ + (tid >> 2)) * 1536 + hh * 64 + ph * 32 + (tid & 3) * 8); \
            if (tid < 128) pdt = small[(tb_ + tid) * 32 + 8 + hh]; } while (0)
#define SD_STORE() do { _Pragma("unroll") for (int i_ = 0; i_ < 4; ++i_) { const int p_ = tid + 512 * i_, row_ = p_ >> 4, c16_ = p_ & 15; \
                *(LAS u32x4_t*)(lds + SD_B + row_ * SD_BP + c16_ * 16) = __builtin_bit_cast(u32x4_t, pb[i_]); *(LAS u32x4_t*)(lds + SD_C + row_ * SD_BP + c16_ * 16) = __builtin_bit_cast(u32x4_t, pc[i_]); } \
            *(LAS u32x4_t*)(lds + SD_X + (tid >> 2) * SD_XP + (tid & 3) * 16) = __builtin_bit_cast(u32x4_t, px); \
            if (tid < 128) vec[tid] = pdt; } while (0)
        SD_LOAD(0); SD_STORE();
        LBAR();
#pragma nounroll
        for (int c = 0; c < 32; ++c) {
            if (c + 1 < 32) SD_LOAD(c + 1);
            if (w < 2) {
                const float dtr = vec[tid] + dtb; const float dt = dtr > 20.f ? dtr : log1pf(__expf(dtr));
                vec[640 + tid] = dt; vec[128 + tid] = dt * a;
            }
            LBAR();
            if (w < 2) {
                float acs = 0.f;
#pragma unroll 8
                for (int j = 0; j < 128; j += 4) { const f32x4_t v4 = *(const LAS f32x4_t*)(vec + 128 + j);
                    acs += (j + 0 <= tid) ? v4[0] : 0.f; acs += (j + 1 <= tid) ? v4[1] : 0.f; acs += (j + 2 <= tid) ? v4[2] : 0.f; acs += (j + 3 <= tid) ? v4[3] : 0.f; }
                vec[256 + tid] = acs; vec[384 + tid] = __expf(acs);
                if (tid == 127) { vec[768] = acs; vec[769] = __expf(acs); }
            }
            LBAR();
            if (w < 2) { const float atot = vec[768]; vec[512 + tid] = __expf(atot - vec[256 + tid]) * vec[640 + tid]; }
            {
                const int li = w; const int l = 16 * li + l15; const float acl = vec[256 + l];
#pragma unroll
                for (int si = 0; si < 8; ++si) {
                    f32x4_t acc = (f32x4_t){0.f, 0.f, 0.f, 0.f};
                    if (si <= li) {
#pragma unroll
                        for (int ks = 0; ks < 4; ++ks) {
                            const bf16x8_t av = *(const LAS bf16x8_t*)(lds + SD_B + (16 * si + l15) * SD_BP + (32 * ks + 8 * g4) * 2);
                            const bf16x8_t bv = *(const LAS bf16x8_t*)(lds + SD_C + (16 * li + l15) * SD_BP + (32 * ks + 8 * g4) * 2);
                            acc = __builtin_amdgcn_mfma_f32_16x16x32_bf16(av, bv, acc, 0, 0, 0);
                        }
                        const f32x4_t acs = *(const LAS f32x4_t*)(vec + 256 + 16 * si + 4 * g4), dts = *(const LAS f32x4_t*)(vec + 640 + 16 * si + 4 * g4);
#pragma unroll
                        for (int e = 0; e < 4; ++e) { const int s = 16 * si + 4 * g4 + e; acc[e] = (s <= l) ? acc[e] * __expf(acl - acs[e]) * dts[e] : 0.f; }
                    }
                    *(LAS u32x2_t*)(lds + SD_M + l * SD_BP + (16 * si + 4 * g4) * 2) = (u32x2_t){pk2(acc[0], acc[1]), pk2(acc[2], acc[3])};
                }
            }
            LBAR();
            { const int s = tid >> 2, pcx = tid & 3; const float wv = vec[512 + s];
              const u32x4_t v = *(const LAS u32x4_t*)(lds + SD_X + s * SD_XP + pcx * 16); u32x4_t o;
#pragma unroll
              for (int j = 0; j < 4; ++j) o[j] = pk2(__uint_as_float(v[j] << 16) * wv, __uint_as_float(v[j] & 0xffff0000u) * wv);
              *(LAS u32x4_t*)(lds + SD_XW + s * SD_XP + pcx * 16) = o; }
            {
                const int li = w; const size_t tb = (size_t)b * SEQ + (size_t)c * 128;
                const f32x4_t eac = *(const LAS f32x4_t*)(vec + 384 + 16 * li + 4 * g4);
#pragma unroll
                for (int pi = 0; pi < 2; ++pi) {
                    f32x4_t yd = (f32x4_t){0.f, 0.f, 0.f, 0.f}, yo = yd;
#pragma unroll
                    for (int ks = 0; ks < 4; ++ks) {
                        if (32 * ks <= 16 * li + 15) {
                            const bf16x8_t av = *(const LAS bf16x8_t*)(lds + SD_M + (16 * li + l15) * SD_BP + (32 * ks + 8 * g4) * 2);
                            u32x2_t r0, r1; tr_read2q(ldsb + SD_X + (32 * ks + 8 * g4 + qq) * SD_XP + (16 * pi + 4 * pp) * 2, ldsb + SD_X + (32 * ks + 8 * g4 + 4 + qq) * SD_XP + (16 * pi + 4 * pp) * 2, r0, r1);
                            yd = __builtin_amdgcn_mfma_f32_16x16x32_bf16(av, mk_frag(r0, r1), yd, 0, 0, 0);
                        }
                    }
#pragma unroll
                    for (int ks = 0; ks < 4; ++ks) {
                        const bf16x8_t av = *(const LAS bf16x8_t*)(lds + SD_C + (16 * li + l15) * SD_BP + (32 * ks + 8 * g4) * 2);
                        const bf16x8_t bh = *(const LAS bf16x8_t*)(lds + SD_H + (16 * pi + l15) * SD_BP + (32 * ks + 8 * g4) * 2);
                        yo = __builtin_amdgcn_mfma_f32_16x16x32_bf16(av, bh, yo, 0, 0, 0);
                    }
#pragma unroll
                    for (int e = 0; e < 4; ++e) { const int l = 16 * li + 4 * g4 + e;
                        const float xv = __uint_as_float(((unsigned)*(const LAS unsigned short*)(lds + SD_X + l * SD_XP + (16 * pi + l15) * 2)) << 16);
                        yraw[(tb + l) * 1024 + hh * 64 + ph * 32 + 16 * pi + l15] = yd[e] + eac[e] * yo[e] + Dk * xv; }
                }
            }
            LBAR();
            {
                const float ea = vec[769];
#pragma unroll
                for (int pi = 0; pi < 2; ++pi) {
                    f32x4_t acc = hacc[pi] * ea;
#pragma unroll
                    for (int ks = 0; ks < 4; ++ks) {
                        u32x2_t a0, a1, b0, b1;
                        tr_read2q(ldsb + SD_B + (32 * ks + 8 * g4 + qq) * SD_BP + (16 * w + 4 * pp) * 2, ldsb + SD_B + (32 * ks + 8 * g4 + 4 + qq) * SD_BP + (16 * w + 4 * pp) * 2, a0, a1);
                        tr_read2q(ldsb + SD_XW + (32 * ks + 8 * g4 + qq) * SD_XP + (16 * pi + 4 * pp) * 2, ldsb + SD_XW + (32 * ks + 8 * g4 + 4 + qq) * SD_XP + (16 * pi + 4 * pp) * 2, b0, b1);
                        acc = __builtin_amdgcn_mfma_f32_16x16x32_bf16(mk_frag(a0, a1), mk_frag(b0, b1), acc, 0, 0, 0);
                    }
                    hacc[pi] = acc;
                    *(LAS u32x2_t*)(lds + SD_H + (16 * pi + l15) * SD_BP + (16 * w + 4 * g4) * 2) = (u32x2_t){pk2(acc[0], acc[1]), pk2(acc[2], acc[3])};
                }
            }
            LBAR();
            if (c + 1 < 32) SD_STORE();
            LBAR();
        }
#undef SD_LOAD
#undef SD_STORE
    }
}

struct MegaArgs { const float* in[22]; float* out; unsigned char* ws; };
template <int I> __device__ __forceinline__ unsigned long long ld_ptr() {
    unsigned long long v; const auto ka = __builtin_amdgcn_kernarg_segment_ptr();
    asm volatile("s_load_dwordx2 %0, %1, %2\n\ts_waitcnt lgkmcnt(0)" : "=s"(v) : "s"(ka), "n"(I * 8) : "memory");
    return v;
}
#define INF(i) ((const float*)ld_ptr<(i)>())
#define OUTP ((float*)ld_ptr<22>())
#define WSP ((unsigned char*)ld_ptr<23>())
enum { I_X = 0, I_WIN, I_MGATEB, I_MNORMW, I_CONVW, I_CONVB, I_DTB, I_ALOG, I_SSMD, I_SNORMW, I_SINKS, I_MERGEB, I_WBR, I_WOUT, I_LN1G, I_LN1B, I_WQ, I_SUBK, I_PU, I_PV, I_LN2G, I_LN2B };

__global__ void __launch_bounds__(512, 2) mega_fwd(MegaArgs a) {
    extern __shared__ __attribute__((aligned(16))) unsigned char lds_raw[];
    LAS unsigned char* lds = (LAS unsigned char*)lds_raw;
    const int wave0 = __builtin_amdgcn_readfirstlane(threadIdx.x >> 6);
    volatile LAS unsigned* MISC = (volatile LAS unsigned*)(lds + MISC_OFF);
    { PHASE_IDS for (int u = tid; u < (LDS_BYTES - PHASE_LDS_BYTES) / 4; u += 512) ((LAS unsigned*)(lds + PHASE_LDS_BYTES))[u] = 0u; }
    __syncthreads();
    { XcdBarrier b0 = xcd_barrier_post((unsigned*)(WSP + WS_CTL) + CW_BAR, MISC + 8); (void)b0; }
#define GRID_BAR() do { XcdBarrier b_; b_.bar = (unsigned*)(WSP + WS_CTL) + CW_BAR; b_.x = xb_xcc_id(); b_.st = MISC + 8; xcd_barrier(b_); } while (0)

    { PHASE_IDS float2* rt = (float2*)(WSP + WS_ROPE);
      for (size_t i = gt; i < (size_t)SEQ * 32; i += NGT) { const int pos = (int)(i >> 5), fi = (int)(i & 31); const float ang = (float)pos * powf(10000.0f, -(float)fi / 32.0f); rt[i] = make_float2(cosf(ang), sinf(ang)); } }
    { PHASE_IDS const float* x = INF(I_X); bf16* xb = (bf16*)(WSP + WS_XB);
      for (size_t i = gt; i < (size_t)T_TOK * DM / 4; i += NGT) { const float4 v = ((const float4*)x)[i]; ((uint2*)xb)[i] = make_uint2(pk2(v.x, v.y), pk2(v.z, v.w)); } }

#pragma nounroll
    for (int l = 0; l < DEPTH; ++l) {
        { PHASE_IDS
            unsigned char* ws = WSP; bf16* WinT = (bf16*)(ws + WS_WIN); bf16* WbT = (bf16*)(ws + WS_WB); bf16* WoT = (bf16*)(ws + WS_WO); bf16* WqT = (bf16*)(ws + WS_WQ); float* bias = (float*)(ws + WS_BIAS);
            const float* w_in = INF(I_WIN) + (size_t)l * DM * IN_COLS; const float* w_branch = INF(I_WBR) + (size_t)l * 3 * 1024 * DM; const float* w_out = INF(I_WOUT) + (size_t)l * DM * DM; const float* peer_wq = INF(I_WQ) + (size_t)l * DM * DM;
            const float* merge_gate_b = INF(I_MERGEB) + (size_t)l * 3 * DM;
            LAS float* scr = (LAS float*)(lds + wave * 16384);
            constexpr int I_IN = (DM / 64) * (NP / 32), I_B = (1024 / 64) * (DM / 32), I_O = (DM / 64) * (DM / 32);
            constexpr int NITEMS = I_IN + 3 * I_B + 2 * I_O;
            for (int it = gw; it < NITEMS; it += NGW) {
                int r = it;
                if (r < I_IN) { transpose_item<1>(w_in, DM, IN_COLS, NP, WinT, scr, r, lane); continue; } r -= I_IN;
                if (r < 3 * I_B) { const int k = r / I_B; transpose_item<0>(w_branch + (size_t)k * 1024 * DM, 1024, DM, DM, WbT + (size_t)k * DM * 1024, scr, r - k * I_B, lane); continue; } r -= 3 * I_B;
                if (r < I_O) { transpose_item<0>(w_out, DM, DM, DM, WoT, scr, r, lane); continue; } r -= I_O;
                transpose_item<0>(peer_wq, DM, DM, DM, WqT, scr, r, lane);
            }
            for (size_t n = gt; n < NP; n += NGT) bias[n] = (n >= C_G && n < C_SMALL) ? merge_gate_b[n - C_G] : 0.f;
        }
        GRID_BAR();
        { PHASE_IDS unsigned char* ws = WSP; pg8::Gemm g{(const bf16*)(ws + WS_XB), (const bf16*)(ws + WS_WIN), T_TOK, NP, DM}; pg8::StaticOrder S; S.init(T_TOK, NP, G, bx);
          pg8::EpiProj E{(bf16*)(ws + WS_PROJ), (const float*)(ws + WS_BIAS), (float*)(ws + WS_SMALL), NP, GATE_TILE_LO, SMALL_TILE, 0};
          pg8::gemm_phase<pg8::EpiProj, pg8::StaticOrder, true, true>(lds, g, S, E, tid); }
        GRID_BAR();
        { PHASE_IDS unsigned char* ws = WSP; const bf16* proj = (const bf16*)(ws + WS_PROJ); bf16* xcb = (bf16*)(ws + WS_R2);
          const float* cw = INF(I_CONVW) + (size_t)l * 4 * 1536; const float* cb = INF(I_CONVB) + l * 1536;
          for (size_t i = gt; i < (size_t)T_TOK * 768; i += NGT) ssd_conv_body(i, proj, cw, cb, xcb); }
        GRID_BAR();
        { PHASE_IDS unsigned char* ws = WSP; mlstm_phase(lds, (const bf16*)(ws + WS_PROJ), (const float*)(ws + WS_SMALL), INF(I_MGATEB) + l * 8, (float*)(ws + WS_HM), tid, bx, G); }
        { PHASE_IDS unsigned char* ws = WSP; ssd_phase(lds, (const bf16*)(ws + WS_R2), (const float*)(ws + WS_SMALL), INF(I_DTB) + l * 16, INF(I_ALOG) + l * 16, INF(I_SSMD) + l * 16, (float*)(ws + WS_R1), tid, bx, G); }
        { PHASE_IDS unsigned char* ws = WSP; swa_phase(lds, (const bf16*)(ws + WS_PROJ), (const float*)(ws + WS_ROPE), INF(I_SINKS) + l * 16, (bf16*)(ws + WS_Y + 128 * MiB), tid, bx, G); }
        GRID_BAR();
        { PHASE_IDS unsigned char* ws = WSP; const bf16* proj = (const bf16*)(ws + WS_PROJ); const float* hm = (const float*)(ws + WS_HM); bf16* ym = (bf16*)(ws + WS_Y); const float* nw = INF(I_MNORMW) + l * 1024;
          for (int w = gw; w < T_TOK * 4; w += NGW) mlstm_post_body(w, lane, hm, proj, nw, ym); }
        { PHASE_IDS unsigned char* ws = WSP; const bf16* proj = (const bf16*)(ws + WS_PROJ); const float* yraw = (const float*)(ws + WS_R1); bf16* ys = (bf16*)(ws + WS_Y + 64 * MiB); const float* nw = INF(I_SNORMW) + l * 1024;
          for (int w = gw; w < T_TOK * 2; w += NGW) ssd_post_body(w, lane, yraw, proj, nw, ys); }
        GRID_BAR();
        { PHASE_IDS unsigned char* ws = WSP; pg8::Gemm g{(const bf16*)(ws + WS_Y), (const bf16*)(ws + WS_WB), T_TOK, DM, 1024}; pg8::StaticOrder S; S.init(T_TOK, DM, G, bx);
          pg8::EpiMix<1> E{(bf16*)(ws + WS_R1), (const bf16*)(ws + WS_PROJ) + C_G, DM, NP};
          pg8::gemm_phase<pg8::EpiMix<1>, pg8::StaticOrder, true, true>(lds, g, S, E, tid); }
        __syncthreads();
        { PHASE_IDS unsigned char* ws = WSP; pg8::Gemm g{(const bf16*)(ws + WS_Y + 64 * MiB), (const bf16*)(ws + WS_WB) + (size_t)DM * 1024, T_TOK, DM, 1024}; pg8::StaticOrder S; S.init(T_TOK, DM, G, bx);
          pg8::EpiMix<0> E{(bf16*)(ws + WS_R1), (const bf16*)(ws + WS_PROJ) + C_G + DM, DM, NP};
          pg8::gemm_phase<pg8::EpiMix<0>, pg8::StaticOrder, true, true>(lds, g, S, E, tid); }
        __syncthreads();
        { PHASE_IDS unsigned char* ws = WSP; pg8::Gemm g{(const bf16*)(ws + WS_Y + 128 * MiB), (const bf16*)(ws + WS_WB) + (size_t)2 * DM * 1024, T_TOK, DM, 1024}; pg8::StaticOrder S; S.init(T_TOK, DM, G, bx);
          pg8::EpiMix<0> E{(bf16*)(ws + WS_R1), (const bf16*)(ws + WS_PROJ) + C_G + 2 * DM, DM, NP};
          pg8::gemm_phase<pg8::EpiMix<0>, pg8::StaticOrder, true, true>(lds, g, S, E, tid); }
        GRID_BAR();
        { PHASE_IDS unsigned char* ws = WSP; const float* xin = l == 0 ? INF(I_X) : (const float*)OUTP;
          pg8::Gemm g{(const bf16*)(ws + WS_R1), (const bf16*)(ws + WS_WO), T_TOK, DM, DM}; pg8::StaticOrder S; S.init(T_TOK, DM, G, bx); pg8::EpiResid E{(float*)(ws + WS_BUFB), xin, DM, ALPHA};
          pg8::gemm_phase<pg8::EpiResid, pg8::StaticOrder, true, true>(lds, g, S, E, tid); }
        GRID_BAR();
        { PHASE_IDS unsigned char* ws = WSP; float* bufB = (float*)(ws + WS_BUFB); bf16* xb = (bf16*)(ws + WS_XB); const float* g1 = INF(I_LN1G) + l * DM; const float* b1 = INF(I_LN1B) + l * DM;
          for (int t = gw; t < T_TOK; t += NGW) ln_body(t, lane, bufB, g1, b1, bufB, xb); }
        { PHASE_IDS unsigned char* ws = WSP; constexpr size_t NGRP = (size_t)P_EXPERTS * DM / 16;
          const float* pu = INF(I_PU) + (size_t)l * P_EXPERTS * DM; const float* pv = INF(I_PV) + (size_t)l * P_EXPERTS * DM; uint4* U8 = (uint4*)(ws + WS_R2); uint4* V8 = (uint4*)(ws + WS_R2 + 32 * MiB);
          for (size_t i = gt; i < 2 * NGRP; i += NGT) { if (i < NGRP) tab_to_fp8(i, pu, U8, U8_SCALE); else tab_to_fp8(i - NGRP, pv, V8, V8_SCALE); } }
        GRID_BAR();
        { PHASE_IDS unsigned char* ws = WSP; pg8::Gemm g{(const bf16*)(ws + WS_XB), (const bf16*)(ws + WS_WQ), T_TOK, DM, DM}; pg8::StaticOrder S; S.init(T_TOK, DM, G, bx); pg8::EpiF32 E{(float*)(ws + WS_QF), DM, 0};
          pg8::gemm_phase<pg8::EpiF32, pg8::StaticOrder, true, true>(lds, g, S, E, tid); }
        GRID_BAR();
        { PHASE_IDS unsigned char* ws = WSP; const float* qf = (const float*)(ws + WS_QF); int* ids = (int*)(ws + WS_IDS); float* gates = (float*)(ws + WS_GATES); const float* sk = INF(I_SUBK) + (size_t)l * 8 * 2 * 128 * 128;
          for (int wi = gw; wi < 8 * (T_TOK / 64); wi += NGW) { const int h = wi / (T_TOK / 64), t = (wi % (T_TOK / 64)) * 64 + lane; peer_select_body(h, t, qf, sk, ids, gates); } }
        GRID_BAR();
        { PHASE_IDS unsigned char* ws = WSP; const float* bufB = (const float*)(ws + WS_BUFB); const int* ids = (const int*)(ws + WS_IDS); const float* gates = (const float*)(ws + WS_GATES);
          const unsigned char* U8 = ws + WS_R2; const unsigned char* V8 = ws + WS_R2 + 32 * MiB; const float* g2 = INF(I_LN2G) + l * DM; const float* b2 = INF(I_LN2B) + l * DM; float* out = OUTP; bf16* xb = (bf16*)(ws + WS_XB);
          for (int t = gw; t < T_TOK; t += NGW) peer_expert_body(t, lane, bufB, ids, gates, U8, V8, g2, b2, out, xb); }
        GRID_BAR();
    }
#undef GRID_BAR
}

extern "C" void kernel_launch(void* const* d_in, const int* in_sizes, int n_in, void* d_out, int out_size, void* d_ws, size_t ws_size, hipStream_t stream) {
    static int grid = 0;
    if (grid == 0) {
        if (n_in != 22 || out_size != T_TOK * DM || ws_size < WS_END) { fprintf(stderr, "kernel_launch: unexpected shapes (n_in %d, out %d, ws %zu)\n", n_in, out_size, ws_size); grid = -1; return; }
        int dev = 0, cus = 0, per_cu = 0;
        if (hipGetDevice(&dev) != hipSuccess || hipDeviceGetAttribute(&cus, hipDeviceAttributeMultiprocessorCount, dev) != hipSuccess) { grid = -1; return; }
        if (hipFuncSetAttribute((const void*)mega_fwd, hipFuncAttributeMaxDynamicSharedMemorySize, LDS_BYTES) != hipSuccess) { fprintf(stderr, "kernel_launch: hipFuncSetAttribute failed\n"); grid = -1; return; }
        if (hipOccupancyMaxActiveBlocksPerMultiprocessor(&per_cu, (const void*)mega_fwd, 512, LDS_BYTES) != hipSuccess || per_cu < 1) { fprintf(stderr, "kernel_launch: occupancy query says %d blocks per CU\n", per_cu); (void)hipGetLastError(); grid = -1; return; }
        grid = cus;
    }
    if (grid < 0) return;
    (void)hipMemsetAsync((char*)d_ws + WS_CTL, 0, CTL_ZERO_BYTES, stream);
    MegaArgs a; memset(&a, 0, sizeof(a));
    for (int i = 0; i < 22; ++i) a.in[i] = (const float*)d_in[i];
    a.out = (float*)d_out; a.ws = (unsigned char*)d_ws;
    hipLaunchKernelGGL(mega_fwd, dim3(grid), dim3(512), LDS_BYTES, stream, a);
}
```

```cpp
#include <hip/hip_runtime.h>
#include <cstdio>
#include <cstdint>
#include <cstring>

namespace pg8 {
#define PG8_LAS __attribute__((address_space(3)))
typedef unsigned short bf16_t;
typedef short bf16x8 __attribute__((ext_vector_type(8)));
typedef float f32x4 __attribute__((ext_vector_type(4)));
typedef unsigned u32x4 __attribute__((ext_vector_type(4)));
constexpr int BM = 256, BK = 64, HALF = 128, HTB = HALF * BK * 2  , STAGE_BYTES = 8 * HTB, NXCD = 8, WGM = 8;

__host__ __device__ __forceinline__ int lds_byte(int r, int c) { const int st = (r >> 4) * 2 + (c >> 5), rr = r & 15, cc = c & 31, ob = rr * 64 + cc * 2; return st * 1024 + (ob ^ (((ob >> 9) & 1) << 5)); }
__host__ __device__ __forceinline__ void stage_rc(int b, int& R, int& C) { const int st = b / 1024, sb = b % 1024, swz = sb ^ (((sb >> 9) & 1) << 5); R = (st >> 1) * 16 + swz / 64; C = (st & 1) * 32 + (swz % 64) / 2; }
__host__ __device__ __forceinline__ int perm32(int rho) { const int n = rho >> 4, i = rho & 15; return 8 * (i >> 2) + 4 * n + (i & 3); }

struct Unit { int pm, pn; };
struct Gemm { const bf16_t* A; const bf16_t* Bt; int M, N, K; };

struct StaticOrder {
    int nM, nN, nwg, G, c;
    __host__ __device__ void init(int M, int N, int G_, int c_) { nM = M / BM; nN = N / BM; nwg = nM * nN; G = G_; c = c_; }
    __host__ __device__ bool next(int i, Unit& u) const {
        const long L = (long)i * G + c; if (L >= nwg) return false;
        int wgid = (int)L; { const int q = nwg / NXCD, r = nwg % NXCD, xcd = wgid % NXCD, off = wgid / NXCD; wgid = (xcd < r ? xcd * (q + 1) : r * (q + 1) + (xcd - r) * q) + off; }
        const int nig = WGM * nN, gid = wgid / nig, fm = gid * WGM, gsz = (nM - fm) < WGM ? (nM - fm) : WGM;
        u.pm = fm + ((wgid % nig) % gsz); u.pn = (wgid % nig) / gsz; return true;
    }
    __device__ __forceinline__ void a_ready(const Unit&) const {}
    __device__ __forceinline__ void done(const Unit&) const {}
};

__device__ __forceinline__ unsigned cvt_pk_bf16(float lo, float hi) { unsigned r; asm volatile("v_cvt_pk_bf16_f32 %0, %1, %2" : "=v"(r) : "v"(lo), "v"(hi)); return r; }
typedef float f32x2 __attribute__((ext_vector_type(2)));
__device__ __forceinline__ float bf_lo(unsigned w) { return __uint_as_float(w << 16); }
__device__ __forceinline__ float bf_hi(unsigned w) { return __uint_as_float(w & 0xffff0000u); }
__device__ __forceinline__ float sigmoidf_(float x) { return 1.0f / (1.0f + __expf(-x)); }

struct EpiF32 {
    static constexpr bool PERM = false, AFTER_DRAIN = false;
    float* C; int ldc; int pad;
    __device__ __forceinline__ void operator()(const f32x4 (&acc)[2][2][4][2], const Unit& u, int wr, int wc, int fr, int fq) const {
        const int row0 = u.pm * BM + wr * 64 + fr, col0 = u.pn * BM + wc * 32 + 4 * fq;
#pragma unroll
        for (int ai = 0; ai < 2; ++ai)
#pragma unroll
            for (int m = 0; m < 4; ++m) { float* rowp = C + (size_t)(row0 + ai * HALF + m * 16) * ldc + col0;
#pragma unroll
                for (int bj = 0; bj < 2; ++bj)
#pragma unroll
                    for (int n = 0; n < 2; ++n) *(f32x4*)(rowp + bj * HALF + n * 16) = acc[ai][bj][m][n]; }
    }
};
struct EpiResid {
    static constexpr bool PERM = false, AFTER_DRAIN = false;
    float* C; const float* X; int ldc; float alpha;
    __device__ __forceinline__ void operator()(const f32x4 (&acc)[2][2][4][2], const Unit& u, int wr, int wc, int fr, int fq) const {
        const int row0 = u.pm * BM + wr * 64 + fr, col0 = u.pn * BM + wc * 32 + 4 * fq;
#pragma unroll
        for (int ai = 0; ai < 2; ++ai)
#pragma unroll
            for (int m = 0; m < 4; ++m) { const size_t off = (size_t)(row0 + ai * HALF + m * 16) * ldc + col0;
#pragma unroll
                for (int bj = 0; bj < 2; ++bj)
#pragma unroll
                    for (int n = 0; n < 2; ++n) { const f32x4 xv = *(const f32x4*)(X + off + bj * HALF + n * 16);
                        *(f32x4*)(C + off + bj * HALF + n * 16) = acc[ai][bj][m][n] + xv * alpha; } }
    }
};
struct EpiProj {
    static constexpr bool PERM = true, AFTER_DRAIN = false;
    bf16_t* O; const float* bias; float* small; int ldc; int gate_lo; int small_tile; int pad;
    __device__ __forceinline__ void operator()(const f32x4 (&acc)[2][2][4][2], const Unit& u, int wr, int wc, int fr, int fq) const {
        const int row0 = u.pm * BM + wr * 64 + fr, col0 = u.pn * BM + wc * 32 + 8 * fq;
        if (u.pn == small_tile) {
            if (wc == 0) {
#pragma unroll
                for (int ai = 0; ai < 2; ++ai)
#pragma unroll
                    for (int m = 0; m < 4; ++m) { float* p = small + (size_t)(row0 + ai * HALF + m * 16) * 32 + 8 * fq;
                        *(f32x4*)p = acc[ai][0][m][0]; *(f32x4*)(p + 4) = acc[ai][0][m][1]; }
            }
            return;
        }
        const bool gate = u.pn >= gate_lo;
        f32x4 bv[2][2];
#pragma unroll
        for (int bj = 0; bj < 2; ++bj)
#pragma unroll
            for (int n = 0; n < 2; ++n) bv[bj][n] = gate ? *(const f32x4*)(bias + col0 + bj * HALF + 4 * n) : (f32x4){0.f, 0.f, 0.f, 0.f};
#pragma unroll
        for (int ai = 0; ai < 2; ++ai)
#pragma unroll
            for (int m = 0; m < 4; ++m) { bf16_t* rowp = O + (size_t)(row0 + ai * HALF + m * 16) * ldc + col0;
#pragma unroll
                for (int bj = 0; bj < 2; ++bj) { f32x4 v0 = acc[ai][bj][m][0] + bv[bj][0], v1 = acc[ai][bj][m][1] + bv[bj][1];
                    if (gate) {
#pragma unroll
                        for (int j = 0; j < 4; ++j) { v0[j] = sigmoidf_(v0[j]); v1[j] = sigmoidf_(v1[j]); } }
                    u32x4 w; w.x = cvt_pk_bf16(v0[0], v0[1]); w.y = cvt_pk_bf16(v0[2], v0[3]); w.z = cvt_pk_bf16(v1[0], v1[1]); w.w = cvt_pk_bf16(v1[2], v1[3]);
                    *(u32x4*)(rowp + bj * HALF) = w; } }
    }
};
template <int FIRST> struct EpiMix {
    static constexpr bool PERM = true, AFTER_DRAIN = false;
    bf16_t* O; const bf16_t* G; int ldc; int ldg;
    __device__ __forceinline__ void operator()(const f32x4 (&acc)[2][2][4][2], const Unit& u, int wr, int wc, int fr, int fq) const {
        const int row0 = u.pm * BM + wr * 64 + fr, col0 = u.pn * BM + wc * 32 + 8 * fq;
#pragma unroll
        for (int ai = 0; ai < 2; ++ai)
#pragma unroll
            for (int m = 0; m < 4; ++m) { const int row = row0 + ai * HALF + m * 16; bf16_t* rowp = O + (size_t)row * ldc + col0; const bf16_t* gp = G + (size_t)row * ldg + col0;
#pragma unroll
                for (int bj = 0; bj < 2; ++bj) { const u32x4 gw = *(const u32x4*)(gp + bj * HALF); u32x4 ow = (u32x4){0u, 0u, 0u, 0u}; if (!FIRST) ow = *(const u32x4*)(rowp + bj * HALF);
                    const f32x4 a0 = acc[ai][bj][m][0], a1 = acc[ai][bj][m][1];
                    float r0 = bf_lo(ow.x) + bf_lo(gw.x) * a0[0], r1 = bf_hi(ow.x) + bf_hi(gw.x) * a0[1], r2 = bf_lo(ow.y) + bf_lo(gw.y) * a0[2], r3 = bf_hi(ow.y) + bf_hi(gw.y) * a0[3];
                    float r4 = bf_lo(ow.z) + bf_lo(gw.z) * a1[0], r5 = bf_hi(ow.z) + bf_hi(gw.z) * a1[1], r6 = bf_lo(ow.w) + bf_lo(gw.w) * a1[2], r7 = bf_hi(ow.w) + bf_hi(gw.w) * a1[3];
                    u32x4 w; w.x = cvt_pk_bf16(r0, r1); w.y = cvt_pk_bf16(r2, r3); w.z = cvt_pk_bf16(r4, r5); w.w = cvt_pk_bf16(r6, r7);
                    *(u32x4*)(rowp + bj * HALF) = w; } }
    }
};

template <class Epi, class Sched, bool ALIGN_EPI = false, bool SP2 = false>
__device__ __forceinline__ void gemm_phase(PG8_LAS unsigned char* lds, const Gemm g, const Sched& S, const Epi& E, int tid_) {
    asm volatile("" : "+v"(tid_));
    const int tid = tid_, wid = __builtin_amdgcn_readfirstlane(tid >> 6), lane = tid & 63, wr = wid >> 2, wc = wid & 3, fr = lane & 15, fq = lane >> 4;
    const int K = g.K, nt = K / BK;
    unsigned voffA[2], voffB[2];
#pragma unroll
    for (int i = 0; i < 2; ++i) { int R, C; stage_rc(tid * 16 + i * 8192, R, C); const int Rb = Epi::PERM ? ((R & ~31) + perm32(R & 31)) : R;
        voffA[i] = (unsigned)(R * K + C) * 2u; voffB[i] = (unsigned)(Rb * K + C) * 2u; }
    const size_t kstep = (size_t)(BK * 2);
    const size_t hstep = (size_t)HALF * K * 2;
    const size_t tstep = 2 * hstep;
    const unsigned ldsw = (unsigned)wid * 1024u;
    const int aoff = lds_byte(wr * 64 + fr, fq * 8), boff = lds_byte(wc * 32 + fr, fq * 8);
#define PG8_SA(b, h) (((b) * 2 + (h)) * HTB)
#define PG8_SB(b, h) ((4 + (b) * 2 + (h)) * HTB)
#define PG8_STAGE(bufoff, gbase, voff) do { _Pragma("unroll") for (int _i = 0; _i < 2; ++_i) \
        __builtin_amdgcn_global_load_lds((const unsigned*)((const char*)(gbase) + (voff)[_i]), (PG8_LAS unsigned*)(lds + (bufoff) + ldsw + _i * 8192), 16, 0, 0); } while (0)
#define PG8_LDA(dst, b, h) do { _Pragma("unroll") for (int m = 0; m < 4; ++m) _Pragma("unroll") for (int k = 0; k < 2; ++k) dst[m][k] = *(const PG8_LAS bf16x8*)(lds + PG8_SA(b, h) + aoff + m * 2048 + k * 1024); } while (0)
#define PG8_LDB(dst, b, h) do { _Pragma("unroll") for (int n = 0; n < 2; ++n) _Pragma("unroll") for (int k = 0; k < 2; ++k) dst[n][k] = *(const PG8_LAS bf16x8*)(lds + PG8_SB(b, h) + boff + n * 2048 + k * 1024); } while (0)
#define PG8_MMA(ai, bj, At, Bt) do { __builtin_amdgcn_s_setprio(1); _Pragma("unroll") for (int m = 0; m < 4; ++m) _Pragma("unroll") for (int n = 0; n < 2; ++n) _Pragma("unroll") for (int k = 0; k < 2; ++k) \
        acc[ai][bj][m][n] = __builtin_amdgcn_mfma_f32_16x16x32_bf16(Bt[n][k], At[m][k], acc[ai][bj][m][n], 0, 0, 0); __builtin_amdgcn_s_setprio(0); } while (0)
#define PG8_WAIT_V(n) asm volatile("s_waitcnt vmcnt(" #n ")" ::: "memory")
#define PG8_WAIT_L(n) asm volatile("s_waitcnt lgkmcnt(" #n ")" ::: "memory")
#define PG8_BAR __builtin_amdgcn_s_barrier()
#define PG8_SCHED __builtin_amdgcn_sched_barrier(0)
    Unit cur, nxt; int ui = 0;
    if (!S.next(0, cur)) return;
    f32x4 acc[2][2][4][2];
#pragma unroll
    for (int a = 0; a < 2; ++a)
#pragma unroll
        for (int b = 0; b < 2; ++b)
#pragma unroll
            for (int m = 0; m < 4; ++m)
#pragma unroll
                for (int n = 0; n < 2; ++n) acc[a][b][m][n] = (f32x4){0.f, 0.f, 0.f, 0.f};
    bf16x8 At[4][2], B0[2][2], B1[2][2];
    const char* cA = (const char*)g.A + (size_t)cur.pm * tstep; const char* cB = (const char*)g.Bt + (size_t)cur.pn * tstep;
    S.a_ready(cur);
    if constexpr (SP2) {
        PG8_STAGE(PG8_SB(0, 0), cB, voffB); PG8_STAGE(PG8_SB(0, 1), cB + hstep, voffB); PG8_STAGE(PG8_SA(0, 0), cA, voffA); PG8_STAGE(PG8_SA(0, 1), cA + hstep, voffA);
        if (wr == 1) PG8_BAR;
        PG8_WAIT_V(2); PG8_BAR;
        PG8_STAGE(PG8_SB(1, 0), cB + kstep, voffB); PG8_STAGE(PG8_SA(1, 0), cA + kstep, voffA); PG8_STAGE(PG8_SB(1, 1), cB + hstep + kstep, voffB);
        PG8_WAIT_V(6); PG8_BAR;
    } else {
        PG8_STAGE(PG8_SB(0, 0), cB, voffB); PG8_STAGE(PG8_SA(0, 0), cA, voffA); PG8_STAGE(PG8_SB(0, 1), cB + hstep, voffB); PG8_STAGE(PG8_SA(0, 1), cA + hstep, voffA);
        if (wr == 1) PG8_BAR;
        PG8_WAIT_V(4); PG8_BAR;
        PG8_STAGE(PG8_SB(1, 0), cB + kstep, voffB); PG8_STAGE(PG8_SA(1, 0), cA + kstep, voffA); PG8_STAGE(PG8_SB(1, 1), cB + hstep + kstep, voffB);
        PG8_WAIT_V(6); PG8_BAR;
    }
    for (;;) {
        const bool has_next = S.next(ui + 1, nxt);
        const char* nA = has_next ? (const char*)g.A + (size_t)nxt.pm * tstep : cA; const char* nB = has_next ? (const char*)g.Bt + (size_t)nxt.pn * tstep : cB;
        for (int t = 0; t < nt; t += 2) {
            const bool last = (t == nt - 2);
            const char* a1 = cA + (size_t)(t + 1) * kstep;
            const char* a2 = last ? nA : cA + (size_t)(t + 2) * kstep; const char* b2 = last ? nB : cB + (size_t)(t + 2) * kstep;
            const char* a3 = a2 + kstep; const char* b3 = b2 + kstep;
            if (last && has_next) S.a_ready(nxt);
            if constexpr (SP2) {
            PG8_LDB(B0, 0, 0); PG8_LDB(B1, 0, 1); PG8_SCHED; PG8_LDA(At, 0, 0); PG8_STAGE(PG8_SA(1, 1), a1 + hstep, voffA);
            PG8_WAIT_V(8); PG8_WAIT_L(0); PG8_BAR; PG8_MMA(0, 0, At, B0); PG8_MMA(0, 1, At, B1); PG8_BAR; PG8_SCHED;
            PG8_LDA(At, 0, 1); PG8_STAGE(PG8_SB(0, 0), b2, voffB); PG8_STAGE(PG8_SB(0, 1), b2 + hstep, voffB); PG8_STAGE(PG8_SA(0, 0), a2, voffA);
            PG8_WAIT_V(8); PG8_WAIT_L(0); PG8_BAR; PG8_MMA(1, 0, At, B0); PG8_MMA(1, 1, At, B1); PG8_BAR; PG8_SCHED;
            PG8_LDB(B0, 1, 0); PG8_LDB(B1, 1, 1); PG8_SCHED; PG8_LDA(At, 1, 0); PG8_STAGE(PG8_SA(0, 1), a2 + hstep, voffA);
            PG8_WAIT_V(8); PG8_WAIT_L(0); PG8_BAR; PG8_MMA(0, 0, At, B0); PG8_MMA(0, 1, At, B1); PG8_BAR; PG8_SCHED;
            PG8_LDA(At, 1, 1); PG8_STAGE(PG8_SB(1, 0), b3, voffB); PG8_STAGE(PG8_SB(1, 1), b3 + hstep, voffB); PG8_STAGE(PG8_SA(1, 0), a3, voffA);
            PG8_WAIT_V(8); PG8_WAIT_L(0); PG8_BAR; PG8_MMA(1, 0, At, B0); PG8_MMA(1, 1, At, B1); PG8_BAR; PG8_SCHED;
            } else {
            PG8_LDB(B0, 0, 0); PG8_SCHED; PG8_LDA(At, 0, 0); PG8_STAGE(PG8_SA(1, 1), a1 + hstep, voffA);
            PG8_WAIT_L(8); PG8_BAR; PG8_WAIT_L(0); PG8_MMA(0, 0, At, B0); PG8_BAR; PG8_SCHED;
            PG8_LDB(B1, 0, 1); PG8_STAGE(PG8_SB(0, 0), b2, voffB);
            PG8_BAR; PG8_WAIT_L(0); PG8_MMA(0, 1, At, B1); PG8_BAR;
            PG8_LDA(At, 0, 1); PG8_STAGE(PG8_SA(0, 0), a2, voffA);
            PG8_BAR; PG8_WAIT_L(0); PG8_MMA(1, 0, At, B0); PG8_BAR; PG8_SCHED;
            PG8_STAGE(PG8_SB(0, 1), b2 + hstep, voffB);
            PG8_WAIT_V(6); PG8_BAR; PG8_MMA(1, 1, At, B1); PG8_BAR;
            PG8_LDB(B0, 1, 0); PG8_SCHED; PG8_LDA(At, 1, 0); PG8_STAGE(PG8_SA(0, 1), a2 + hstep, voffA);
            PG8_WAIT_L(8); PG8_BAR; PG8_WAIT_L(0); PG8_MMA(0, 0, At, B0); PG8_BAR; PG8_SCHED;
            PG8_LDB(B1, 1, 1); PG8_STAGE(PG8_SB(1, 0), b3, voffB);
            PG8_BAR; PG8_WAIT_L(0); PG8_MMA(0, 1, At, B1); PG8_BAR;
            PG8_LDA(At, 1, 1); PG8_STAGE(PG8_SA(1, 0), a3, voffA);
            PG8_BAR; PG8_WAIT_L(0); PG8_MMA(1, 0, At, B0); PG8_BAR; PG8_SCHED;
            PG8_STAGE(PG8_SB(1, 1), b3 + hstep, voffB);
            PG8_WAIT_V(6); PG8_BAR; PG8_MMA(1, 1, At, B1); PG8_BAR;
            }
        }
        if constexpr (ALIGN_EPI) { if (wr == 0) PG8_BAR; }
        if constexpr (!Epi::AFTER_DRAIN) { E(acc, cur, wr, wc, fr, fq); S.done(cur); }
        if (!has_next) break;
#pragma unroll
        for (int a = 0; a < 2; ++a)
#pragma unroll
            for (int b = 0; b < 2; ++b)
#pragma unroll
                for (int m = 0; m < 4; ++m)
#pragma unroll
                    for (int n = 0; n < 2; ++n) acc[a][b][m][n] = (f32x4){0.f, 0.f, 0.f, 0.f};
        cur = nxt; cA = nA; cB = nB; ++ui;
        if constexpr (ALIGN_EPI) { if (wr == 1) PG8_BAR; }
    }
    PG8_WAIT_V(0);
    if constexpr (!ALIGN_EPI) { if (wr == 0) PG8_BAR; }
    PG8_BAR;
    if constexpr (Epi::AFTER_DRAIN) { E.fused(acc, cur, wr, wc, fr, fq, lds, wid, lane); S.done(cur); }
#undef PG8_SA
#undef PG8_SB
#undef PG8_STAGE
#undef PG8_LDA
#undef PG8_LDB
#undef PG8_MMA
#undef PG8_WAIT_V
#undef PG8_WAIT_L
#undef PG8_BAR
#undef PG8_SCHED
}
}
typedef unsigned short bf16;
#define LAS __attribute__((address_space(3)))
constexpr int T_TOK = 32768, DM = 2048, SEQ = 4096, NBATCH = 8, DEPTH = 4;
constexpr int IN_COLS = 13336, NP = 13568;
constexpr int C_MQ = 0, C_MK = 512, C_MV = 1024, C_MO = 2048, C_SZ = 3072, C_SXBC = 4096, C_AQ = 5632, C_AK = 6656, C_AV = 6912, C_G = 7168, C_SMALL = 13312;
constexpr int GATE_TILE_LO = C_G / 256, SMALL_TILE = C_SMALL / 256;
constexpr float ALPHA = 1.681792830507429f;
constexpr int P_EXPERTS = 16384;

constexpr size_t MiB = 1u << 20;
constexpr size_t WS_CTL = 0, CTL_ZERO_BYTES = 64 * 1024, WS_WIN = 1 * MiB, WS_WB = 54 * MiB, WS_WO = 66 * MiB, WS_WQ = 74 * MiB, WS_BIAS = 82 * MiB, WS_SKB = 82 * MiB + 256 * 1024, WS_SMALL = 83 * MiB, WS_ROPE = 87 * MiB,
                 WS_XB = 88 * MiB, WS_BUFB = 216 * MiB, WS_PROJ = 472 * MiB, WS_R1 = 1320 * MiB, WS_Y = 1480 * MiB, WS_R2 = 1672 * MiB, WS_HM = 1864 * MiB, WS_END = 1992 * MiB;
constexpr size_t WS_QF = WS_PROJ, WS_IDS = WS_PROJ + 256 * MiB, WS_GATES = WS_PROJ + 272 * MiB;
constexpr int CW_BAR = 4096;
constexpr int RING_BYTES = 131072, PHASE_LDS_BYTES = 155648, MISC_OFF = PHASE_LDS_BYTES + 320, LDS_BYTES = 163840;

__device__ __forceinline__ unsigned f2bf(float f) { unsigned u = __float_as_uint(f); return (u + 0x7fffu + ((u >> 16) & 1u)) >> 16; }
__device__ __forceinline__ unsigned pk2(float lo, float hi) { return f2bf(lo) | (f2bf(hi) << 16); }
__device__ __forceinline__ float bf2f(bf16 b) { return __uint_as_float(((unsigned)b) << 16); }
__device__ __forceinline__ float sigm(float x) { return 1.0f / (1.0f + expf(-x)); }
template <int CTRL> __device__ __forceinline__ float dpp_f(float v) { return __builtin_bit_cast(float, __builtin_amdgcn_update_dpp(0, __builtin_bit_cast(int, v), CTRL, 0xF, 0xF, true)); }
__device__ __forceinline__ float quad_sum(float v) { v += dpp_f<0xB1>(v); v += dpp_f<0x4E>(v); return v; }
__device__ __forceinline__ float wave_sum(float v) {
    v = quad_sum(v); v += dpp_f<0x141>(v); v += dpp_f<0x140>(v);
    v += __builtin_bit_cast(float, __builtin_amdgcn_ds_swizzle(__builtin_bit_cast(int, v), 0x401F));
    return __builtin_bit_cast(float, __builtin_amdgcn_readlane(__builtin_bit_cast(int, v), 0)) + __builtin_bit_cast(float, __builtin_amdgcn_readlane(__builtin_bit_cast(int, v), 32));
}
__device__ __forceinline__ int src_col(int n) {
    if (n < 3072) return n;
    if (n < 5632) return n + 8;
    if (n < 13312) return n + 24;
    if (n < 13320) return 3072 + (n - 13312);
    if (n < 13336) return 5640 + (n - 13320);
    return -1;
}

#define XB_TMO      128
#define XB_XCNT(j)  (256  + 64 * (j))
#define XB_XSUB(j)  (1280 + 64 * (j))
#define XB_XGEN(j)  (2304 + 64 * (j))
#define XB_TOP      3328
#define XB_TOPGEN   3392
#define XCD_BAR_WORDS 3456
#define XB_SPIN_CAP (1u << 18)

__device__ __forceinline__ unsigned xb_ld(unsigned* p)              { return __hip_atomic_load(p, __ATOMIC_RELAXED, __HIP_MEMORY_SCOPE_AGENT); }
__device__ __forceinline__ unsigned xb_add(unsigned* p, unsigned v) { return __hip_atomic_fetch_add(p, v, __ATOMIC_RELAXED, __HIP_MEMORY_SCOPE_AGENT); }
__device__ __forceinline__ unsigned xb_xcc_id() { return (unsigned)__builtin_amdgcn_s_getreg((3 << 11) | 20) & 0xFu; }
#define XB_SPIN(cond, bar) do { unsigned _sp = 0; while (cond) { __builtin_amdgcn_s_sleep(1); \
    if ((++_sp & 255u) == 0u) { if (xb_ld(&(bar)[XB_TMO])) break; if (_sp > XB_SPIN_CAP) { atomicAdd(&(bar)[XB_TMO], 1u); break; } } } } while (0)

struct XcdBarrier {
    unsigned* bar; unsigned x;
    volatile LAS unsigned* st;
};

__device__ __forceinline__ XcdBarrier xcd_barrier_post(unsigned* bar, volatile LAS unsigned* st) {
    XcdBarrier b; b.bar = bar; b.x = xb_xcc_id(); b.st = st;
    if (threadIdx.x == 0) (void)xb_add(&bar[XB_XCNT(b.x)], 1u);
    return b;
}
__device__ __forceinline__ void xcd_barrier_complete(unsigned* bar, unsigned x, unsigned& nloc, unsigned& nx) {
    const unsigned G = gridDim.x * gridDim.y * gridDim.z;
    unsigned sum, cnt, mine, sp = 0u;
    for (;;) {
        sum = 0u; cnt = 0u; mine = 0u;
#pragma unroll
        for (unsigned j = 0; j < 16; ++j) { const unsigned c = xb_ld(&bar[XB_XCNT(j)]); sum += c; cnt += (c > 0u) ? 1u : 0u; mine = (j == x) ? c : mine; }
        if (sum == G) break;
        __builtin_amdgcn_s_sleep(1);
        if ((++sp & 255u) == 0u) { if (xb_ld(&bar[XB_TMO])) break; if (sp > XB_SPIN_CAP) { atomicAdd(&bar[XB_TMO], 1u); break; } }
    }
    nloc = mine > 0u ? mine : 1u; nx = cnt > 0u ? cnt : 1u;
}

__device__ __forceinline__ void xcd_barrier(const XcdBarrier& b) {
    asm volatile("s_waitcnt vmcnt(0)" ::: "memory");
    __syncthreads();
    if (threadIdx.x == 0) {
        unsigned* bar = b.bar;
        __builtin_amdgcn_s_waitcnt(0);
        unsigned nloc = b.st[0], nx = b.st[1];
        if (nloc == 0u) { xcd_barrier_complete(bar, b.x, nloc, nx); b.st[0] = nloc; b.st[1] = nx; }
        const unsigned old = xb_add(&bar[XB_XSUB(b.x)], 1u);
        const unsigned gen = old / nloc;
        if (old + 1u == (gen + 1u) * nloc) {
            __builtin_amdgcn_fence(__ATOMIC_RELEASE, "agent");
            asm volatile("s_waitcnt vmcnt(0)" ::: "memory");
            const unsigned og = xb_add(&bar[XB_TOP], 1u);
            const unsigned tg = og / nx;
            if (og + 1u == (tg + 1u) * nx) xb_add(&bar[XB_TOPGEN], 1u);
            else XB_SPIN(xb_ld(&bar[XB_TOPGEN]) == tg, bar);
            __builtin_amdgcn_fence(__ATOMIC_ACQUIRE, "agent");
            xb_add(&bar[XB_XGEN(b.x)], 1u);
            asm volatile("s_waitcnt vmcnt(0)" ::: "memory");
        } else {
            XB_SPIN(xb_ld(&bar[XB_XGEN(b.x)]) == gen, bar);
            __builtin_amdgcn_fence(__ATOMIC_ACQUIRE, "agent");
            asm volatile("s_waitcnt vmcnt(0)" ::: "memory");
        }
    }
    __syncthreads();
}

__device__ __forceinline__ int fresh_tid(int wave0) { int l; asm volatile("v_mbcnt_lo_u32_b32 %0, -1, 0\n\tv_mbcnt_hi_u32_b32 %0, -1, %0" : "=v"(l)); return wave0 * 64 + l; }
#define PHASE_IDS int G = gridDim.x, bx = blockIdx.x; asm volatile("" : "+s"(G), "+s"(bx)); const int tid = fresh_tid(wave0), lane = tid & 63, wave = wave0; const int gw = bx * 8 + wave, NGW = G * 8; \
    const size_t gt = (size_t)bx * 512 + tid, NGT = (size_t)G * 512; (void)lane; (void)gw; (void)gt; (void)NGW; (void)NGT; (void)wave;

template <int MODE> __device__ __forceinline__ void transpose_item(const float* __restrict__ W, int K, int ldw, int ndst, bf16* __restrict__ WT, LAS float* scr, int item, int lane) {
    const int nblk = ndst / 32, kb = item / nblk, nb = item % nblk, k0 = 64 * kb, n0 = 32 * nb;
    const int n_l = n0 + (lane & 31); const int sc = MODE ? src_col(n_l) : n_l;
#pragma unroll 8
    for (int i = 0; i < 32; ++i) { const int kk = 2 * i + (lane >> 5); scr[kk * 33 + (lane & 31)] = sc >= 0 ? W[(size_t)(k0 + kk) * ldw + sc] : 0.f; }
    asm volatile("s_waitcnt lgkmcnt(0)" ::: "memory");
    const int c = lane & 7;
#pragma unroll
    for (int j = 0; j < 4; ++j) { const int n = (lane >> 3) + 8 * j; const LAS float* s = scr + (8 * c) * 33 + n;
        uint4 o; o.x = pk2(s[0 * 33], s[1 * 33]); o.y = pk2(s[2 * 33], s[3 * 33]); o.z = pk2(s[4 * 33], s[5 * 33]); o.w = pk2(s[6 * 33], s[7 * 33]);
        *(uint4*)(WT + (size_t)(n0 + n) * K + k0 + 8 * c) = o; }
    asm volatile("s_waitcnt lgkmcnt(0)" ::: "memory");
}

__device__ __forceinline__ void mlstm_post_body(int w, int lane, const float* __restrict__ hm, const bf16* __restrict__ proj, const float* __restrict__ norm_w, bf16* __restrict__ ym) {
    const int h = w & 3, t = w >> 2;
    const float4 x = *(const float4*)(hm + (size_t)t * 1024 + h * 256 + lane * 4);
    const float mu = wave_sum((x.x + x.y) + (x.z + x.w)) * (1.0f / 256.0f);
    const float d0 = x.x - mu, d1 = x.y - mu, d2 = x.z - mu, d3 = x.w - mu;
    const float var = wave_sum((d0 * d0 + d1 * d1) + (d2 * d2 + d3 * d3)) * (1.0f / 256.0f);
    const float rs = rsqrtf(var + 1e-6f);
    const int c = h * 256 + lane * 4;
    const float4 nw = *(const float4*)(norm_w + c);
    const bf16* op = proj + (size_t)t * NP + C_MO + c;
    const float y0 = d0 * rs * nw.x * sigm(bf2f(op[0])), y1 = d1 * rs * nw.y * sigm(bf2f(op[1])), y2 = d2 * rs * nw.z * sigm(bf2f(op[2])), y3 = d3 * rs * nw.w * sigm(bf2f(op[3]));
    *(uint2*)(ym + (size_t)t * 1024 + c) = make_uint2(pk2(y0, y1), pk2(y2, y3));
}

__device__ __forceinline__ void ssd_conv_body(size_t gid, const bf16* __restrict__ proj, const float* __restrict__ cw, const float* __restrict__ cb, bf16* __restrict__ xcb) {
    const int c = (int)(gid % 768) * 2; const int t = (int)(gid / 768); const int pos = t % SEQ;
    float a0 = cb[c], a1 = cb[c + 1];
#pragma unroll
    for (int j = 0; j < 4; ++j) { const int pp = pos - 3 + j; if (pp >= 0) { const unsigned v = *(const unsigned*)(proj + (size_t)(t - 3 + j) * NP + C_SXBC + c); a0 += cw[j * 1536 + c] * __uint_as_float(v << 16); a1 += cw[j * 1536 + c + 1] * __uint_as_float(v & 0xffff0000u); } }
    *(unsigned*)(xcb + (size_t)t * 1536 + c) = pk2(a0 * sigm(a0), a1 * sigm(a1));
}
__device__ __forceinline__ void ssd_post_body(int w, int lane, const float* __restrict__ yraw, const bf16* __restrict__ proj, const float* __restrict__ norm_w, bf16* __restrict__ ys) {
    const int g = w & 1, t = w >> 1, c = g * 512 + lane * 8;
    float y[8]; float ss = 0.f;
#pragma unroll
    for (int i = 0; i < 8; ++i) { const float z = bf2f(proj[(size_t)t * NP + C_SZ + c + i]); y[i] = yraw[(size_t)t * 1024 + c + i] * (z * sigm(z)); ss += y[i] * y[i]; }
    const float rs = rsqrtf(wave_sum(ss) * (1.0f / 512.0f) + 1e-6f);
    unsigned o[4];
#pragma unroll
    for (int i = 0; i < 4; ++i) o[i] = pk2(y[2 * i] * rs * norm_w[c + 2 * i], y[2 * i + 1] * rs * norm_w[c + 2 * i + 1]);
    *(uint4*)(ys + (size_t)t * 1024 + c) = make_uint4(o[0], o[1], o[2], o[3]);
}

__device__ __forceinline__ void ln_body(int t, int lane, const float* in, const float* __restrict__ g, const float* __restrict__ bta, float* outf, bf16* __restrict__ outb) {
    float4 v[8]; float s = 0.f;
#pragma unroll
    for (int j = 0; j < 8; ++j) { v[j] = *(const float4*)(in + (size_t)t * DM + j * 256 + lane * 4); s += (v[j].x + v[j].y) + (v[j].z + v[j].w); }
    const float mu = wave_sum(s) * (1.0f / DM); float q = 0.f;
#pragma unroll
    for (int j = 0; j < 8; ++j) { v[j].x -= mu; v[j].y -= mu; v[j].z -= mu; v[j].w -= mu; q += (v[j].x * v[j].x + v[j].y * v[j].y) + (v[j].z * v[j].z + v[j].w * v[j].w); }
    const float rs = rsqrtf(wave_sum(q) * (1.0f / DM) + 1e-5f);
    { int z_ = 0; asm volatile("" : "+s"(z_)); g += z_; bta += z_; }
#pragma unroll
    for (int j = 0; j < 8; ++j) { const int c = j * 256 + lane * 4; const float4 gg = *(const float4*)(g + c), bb = *(const float4*)(bta + c);
        float4 y; y.x = v[j].x * rs * gg.x + bb.x; y.y = v[j].y * rs * gg.y + bb.y; y.z = v[j].z * rs * gg.z + bb.z; y.w = v[j].w * rs * gg.w + bb.w;
        *(float4*)(outf + (size_t)t * DM + c) = y; *(uint2*)(outb + (size_t)t * DM + c) = make_uint2(pk2(y.x, y.y), pk2(y.z, y.w)); }
}

__device__ __forceinline__ float gelu_erf(float v) {
    const float av = fabsf(v), t = __builtin_amdgcn_rcpf(av * 0.2316418882f + 1.0f);
    float q = t * 0.5307027145f + (-0.7265760135f); q = q * t + 0.7107068705f; q = q * t + (-0.142248368f); q = q * t + 0.127414796f; q = q * t;
    const float e = __builtin_amdgcn_exp2f((v * v) * (-0.72134752044f));
    const float mm = v * (q * e), r = v - mm;
    return v < 0.f ? mm : r;
}
constexpr float U8_SCALE = 1024.0f, V8_SCALE = 128.0f;
typedef float f32x2_t __attribute__((ext_vector_type(2)));
__device__ __forceinline__ unsigned pack_fp8x4(float a, float b, float c, float d) { int w = 0; w = __builtin_amdgcn_cvt_pk_fp8_f32(a, b, w, false); w = __builtin_amdgcn_cvt_pk_fp8_f32(c, d, w, true); return (unsigned)w; }
__device__ __forceinline__ void tab_to_fp8(size_t i, const float* __restrict__ src, uint4* __restrict__ dst, float sc) {
    const float4* s = (const float4*)src + i * 4; const float4 a = s[0], b = s[1], c = s[2], d = s[3];
    dst[i] = make_uint4(pack_fp8x4(a.x * sc, a.y * sc, a.z * sc, a.w * sc), pack_fp8x4(b.x * sc, b.y * sc, b.z * sc, b.w * sc), pack_fp8x4(c.x * sc, c.y * sc, c.z * sc, c.w * sc), pack_fp8x4(d.x * sc, d.y * sc, d.z * sc, d.w * sc));
}
__device__ __forceinline__ float dot16_fp8(const uint4 w, const float4* xv, float s) {
    const unsigned ww[4] = {w.x, w.y, w.z, w.w};
#pragma unroll
    for (int j = 0; j < 4; ++j) { const f32x2_t lo = __builtin_amdgcn_cvt_pk_f32_fp8((int)ww[j], false), hi = __builtin_amdgcn_cvt_pk_f32_fp8((int)ww[j], true);
        s += (xv[j].x * lo.x + xv[j].y * lo.y) + (xv[j].z * hi.x + xv[j].w * hi.y); }
    return s;
}
__device__ __forceinline__ void axpy16_fp8(const uint4 w, float c, float4* acc) {
    const unsigned ww[4] = {w.x, w.y, w.z, w.w};
#pragma unroll
    for (int j = 0; j < 4; ++j) { const f32x2_t lo = __builtin_amdgcn_cvt_pk_f32_fp8((int)ww[j], false), hi = __builtin_amdgcn_cvt_pk_f32_fp8((int)ww[j], true);
        acc[j].x += c * lo.x; acc[j].y += c * lo.y; acc[j].z += c * hi.x; acc[j].w += c * hi.y; }
}
__device__ __forceinline__ void peer_expert_body(int t, int lane, const float* __restrict__ x1, const int* __restrict__ ids, const float* __restrict__ gates, const unsigned char* __restrict__ U8, const unsigned char* __restrict__ V8,
                                                 const float* __restrict__ g, const float* __restrict__ bta, float* __restrict__ outf, bf16* __restrict__ outb) {
    float4 xv[8], acc[8];
#pragma unroll
    for (int j = 0; j < 2; ++j)
#pragma unroll
        for (int i = 0; i < 4; ++i) { xv[j * 4 + i] = *(const float4*)(x1 + (size_t)t * DM + j * 1024 + lane * 16 + i * 4); acc[j * 4 + i] = make_float4(0.f, 0.f, 0.f, 0.f); }
    const int* idp = ids + (size_t)t * 128; const float* gp = gates + (size_t)t * 128;
    uint4 ua[2][2], va[2][2], ub[2][2], vb[2][2];
#define PEER_LOAD(U_, V_, e_) do { _Pragma("unroll") for (int k_ = 0; k_ < 2; ++k_) { const int id_ = __builtin_amdgcn_readfirstlane(idp[(e_) + k_]); \
        const uint4* up_ = (const uint4*)(U8 + (size_t)id_ * DM) + lane; const uint4* vp_ = (const uint4*)(V8 + (size_t)id_ * DM) + lane; \
        U_[k_][0] = up_[0]; U_[k_][1] = up_[64]; V_[k_][0] = vp_[0]; V_[k_][1] = vp_[64]; } } while (0)
#define SB_ __builtin_amdgcn_sched_barrier(0)
#define PEER_COMP(U_, V_, e_) do { SB_; float s0_ = dot16_fp8(U_[0][0], xv, 0.f); SB_; s0_ = dot16_fp8(U_[0][1], xv + 4, s0_); SB_; float s1_ = dot16_fp8(U_[1][0], xv, 0.f); SB_; s1_ = dot16_fp8(U_[1][1], xv + 4, s1_); SB_; \
        s0_ = wave_sum(s0_); s1_ = wave_sum(s1_); \
        s0_ *= (1.0f / U8_SCALE); s1_ *= (1.0f / U8_SCALE); \
        const float c0_ = gp[(e_)] * (1.0f / V8_SCALE) * gelu_erf(s0_), c1_ = gp[(e_) + 1] * (1.0f / V8_SCALE) * gelu_erf(s1_); SB_; \
        axpy16_fp8(V_[0][0], c0_, acc); SB_; axpy16_fp8(V_[0][1], c0_, acc + 4); SB_; axpy16_fp8(V_[1][0], c1_, acc); SB_; axpy16_fp8(V_[1][1], c1_, acc + 4); SB_; } while (0)
    PEER_LOAD(ua, va, 0);
#pragma nounroll
    for (int e = 0; e < 128; e += 4) {
        PEER_LOAD(ub, vb, e + 2);
        PEER_COMP(ua, va, e);
        if (e + 4 < 128) PEER_LOAD(ua, va, e + 4);
        PEER_COMP(ub, vb, e + 2);
    }
#undef PEER_LOAD
#undef PEER_COMP
#undef SB_
    float s = 0.f;
#pragma unroll
    for (int j = 0; j < 8; ++j) { acc[j].x += ALPHA * xv[j].x; acc[j].y += ALPHA * xv[j].y; acc[j].z += ALPHA * xv[j].z; acc[j].w += ALPHA * xv[j].w; s += (acc[j].x + acc[j].y) + (acc[j].z + acc[j].w); }
    const float mu = wave_sum(s) * (1.0f / DM); float q = 0.f;
#pragma unroll
    for (int j = 0; j < 8; ++j) { acc[j].x -= mu; acc[j].y -= mu; acc[j].z -= mu; acc[j].w -= mu; q += (acc[j].x * acc[j].x + acc[j].y * acc[j].y) + (acc[j].z * acc[j].z + acc[j].w * acc[j].w); }
    const float rs = rsqrtf(wave_sum(q) * (1.0f / DM) + 1e-5f);
    { int z_ = 0; asm volatile("" : "+s"(z_)); g += z_; bta += z_; }
#pragma unroll
    for (int j = 0; j < 2; ++j)
#pragma unroll
        for (int i = 0; i < 4; ++i) { const int c = j * 1024 + lane * 16 + i * 4; const float4 a4 = acc[j * 4 + i]; const float4 gg = *(const float4*)(g + c), bb = *(const float4*)(bta + c);
            float4 y; y.x = a4.x * rs * gg.x + bb.x; y.y = a4.y * rs * gg.y + bb.y; y.z = a4.z * rs * gg.z + bb.z; y.w = a4.w * rs * gg.w + bb.w;
            *(float4*)(outf + (size_t)t * DM + c) = y; *(uint2*)(outb + (size_t)t * DM + c) = make_uint2(pk2(y.x, y.y), pk2(y.z, y.w)); }
}

typedef short bf16x8_t __attribute__((ext_vector_type(8)));
typedef float f32x4_t __attribute__((ext_vector_type(4)));
typedef unsigned u32x2_t __attribute__((ext_vector_type(2)));
typedef unsigned u32x4_t __attribute__((ext_vector_type(4)));
constexpr int SWA_PITCH = 144;
constexpr int SWA_KS = 0, SWA_VS = 256 * SWA_PITCH, SWA_LDS = 2 * 256 * SWA_PITCH;
static_assert(SWA_LDS <= RING_BYTES, "SWA LDS");
__device__ __forceinline__ float grp4_max(float v) {
    v = fmaxf(v, __builtin_bit_cast(float, __builtin_amdgcn_ds_swizzle(__builtin_bit_cast(int, v), 0x401F)));
    const u32x2_t r = __builtin_amdgcn_permlane32_swap(__builtin_bit_cast(unsigned, v), __builtin_bit_cast(unsigned, v), false, false);
    return fmaxf(__builtin_bit_cast(float, r.x), __builtin_bit_cast(float, r.y));
}
__device__ __forceinline__ float grp4_sum(float v) {
    v += __builtin_bit_cast(float, __builtin_amdgcn_ds_swizzle(__builtin_bit_cast(int, v), 0x401F));
    const u32x2_t r = __builtin_amdgcn_permlane32_swap(__builtin_bit_cast(unsigned, v), __builtin_bit_cast(unsigned, v), false, false);
    return __builtin_bit_cast(float, r.x) + __builtin_bit_cast(float, r.y);
}
__device__ __forceinline__ void tr_read2(unsigned a0, unsigned a1, u32x2_t& r0, u32x2_t& r1) {
    asm volatile("ds_read_b64_tr_b16 %0, %2\n\tds_read_b64_tr_b16 %1, %3\n\ts_waitcnt lgkmcnt(0)" : "=&v"(r0), "=&v"(r1) : "v"(a0), "v"(a1) : "memory");
}
__device__ __forceinline__ void rope8(uint4& lo, uint4& hi, const float4* cs, float scale) {
    unsigned* a = (unsigned*)&lo; unsigned* b = (unsigned*)&hi;
#pragma unroll
    for (int j = 0; j < 4; ++j) {
        const float x1a = __uint_as_float(a[j] << 16), x1b = __uint_as_float(a[j] & 0xffff0000u), x2a = __uint_as_float(b[j] << 16), x2b = __uint_as_float(b[j] & 0xffff0000u);
        const float4 c = cs[j];
        const float y1a = (x1a * c.x - x2a * c.y) * scale, y2a = (x2a * c.x + x1a * c.y) * scale, y1b = (x1b * c.z - x2b * c.w) * scale, y2b = (x2b * c.z + x1b * c.w) * scale;
        a[j] = pk2(y1a, y1b); b[j] = pk2(y2a, y2b);
    }
}
__device__ __forceinline__ void swa_phase(LAS unsigned char* lds, const bf16* __restrict__ proj, const float* __restrict__ rtab  , const float* __restrict__ sinks, bf16* __restrict__ ya,
                                          int tid, int bx, int G) {
    const int lane = tid & 63, w = __builtin_amdgcn_readfirstlane(tid >> 6), l15 = lane & 15, g4 = lane >> 4;
    const unsigned ldsb = (unsigned)(size_t)lds;
    for (int u = bx; u < NBATCH * 32 * 4; u += G) {
        const int kvh = u & 3, nb = (u >> 2) & 31, b = u >> 7;
        const int t0 = b * SEQ + nb * 128;
        __syncthreads();
        for (int it = tid; it < 1024; it += 512) { const int kk = it >> 2, c = it & 3;
            uint4 lo = make_uint4(0u, 0u, 0u, 0u), hi = lo;
            if (nb > 0 || kk >= 128) { const bf16* src = proj + (size_t)(t0 - 128 + kk) * NP + C_AK + kvh * 64 + 8 * c; lo = *(const uint4*)src; hi = *(const uint4*)(src + 32);
                const float4* cs = (const float4*)(rtab + ((size_t)(nb * 128 - 128 + kk) * 32 + 8 * c) * 2); const float4 c4[4] = {cs[0], cs[1], cs[2], cs[3]}; rope8(lo, hi, c4, 1.0f); }
            *(LAS u32x4_t*)(lds + SWA_KS + kk * SWA_PITCH + 16 * c) = __builtin_bit_cast(u32x4_t, lo); *(LAS u32x4_t*)(lds + SWA_KS + kk * SWA_PITCH + 64 + 16 * c) = __builtin_bit_cast(u32x4_t, hi); }
        for (int it = tid; it < 2048; it += 512) { const int kk = it >> 3, c = it & 7;
            uint4 v = make_uint4(0u, 0u, 0u, 0u);
            if (nb > 0 || kk >= 128) v = *(const uint4*)(proj + (size_t)(t0 - 128 + kk) * NP + C_AV + kvh * 64 + 8 * c);
            *(LAS u32x4_t*)(lds + SWA_VS + kk * SWA_PITCH + 16 * c) = __builtin_bit_cast(u32x4_t, v); }
        __syncthreads();
        const int r = w >> 1, hf = w & 1, hq = kvh * 4 + r;
        const float sink = sinks[hq];
#pragma nounroll
        for (int qt = 0; qt < 4; ++qt) {
            const int i0 = 64 * hf + 16 * qt, iq = i0 + l15, tq = t0 + iq, ktb0 = 4 * hf + qt;
            bf16x8_t q0, q1;
            { const bf16* src = proj + (size_t)tq * NP + C_AQ + hq * 64 + 8 * g4; uint4 lo = *(const uint4*)src, hi = *(const uint4*)(src + 32);
              const float4* cs = (const float4*)(rtab + ((size_t)(nb * 128 + iq) * 32 + 8 * g4) * 2); const float4 c4[4] = {cs[0], cs[1], cs[2], cs[3]}; rope8(lo, hi, c4, 0.125f);
              q0 = __builtin_bit_cast(bf16x8_t, lo); q1 = __builtin_bit_cast(bf16x8_t, hi); }
            f32x4_t s[10]; float m = sink;
#pragma unroll
            for (int n = 0; n < 10; ++n) {
                const int kt = (ktb0 + n) < 15 ? (ktb0 + n) : 15;
                const LAS unsigned char* kp = lds + SWA_KS + (16 * kt + l15) * SWA_PITCH + 16 * g4;
                const bf16x8_t a0 = *(const LAS bf16x8_t*)kp, a1 = *(const LAS bf16x8_t*)(kp + 64);
                f32x4_t acc = (f32x4_t){0.f, 0.f, 0.f, 0.f};
                acc = __builtin_amdgcn_mfma_f32_16x16x32_bf16(a0, q0, acc, 0, 0, 0);
                acc = __builtin_amdgcn_mfma_f32_16x16x32_bf16(a1, q1, acc, 0, 0, 0);
#pragma unroll
                for (int e = 0; e < 4; ++e) { const int kk = 16 * (ktb0 + n) + 4 * g4 + e;
                    const bool ok = (kk >= iq + 1) && (kk <= iq + 128) && (nb > 0 || kk >= 128) && (ktb0 + n <= 15);
                    acc[e] = ok ? acc[e] : -1e30f; m = fmaxf(m, acc[e]); }
                s[n] = acc;
            }
            m = grp4_max(m);
            float lsum = 0.f;
#pragma unroll
            for (int n = 0; n < 10; ++n)
#pragma unroll
                for (int e = 0; e < 4; ++e) { const float p = __expf(s[n][e] - m); s[n][e] = p; lsum += p; }
            lsum = grp4_sum(lsum) + __expf(sink - m);
            const float inv = 1.0f / lsum;
            bf16x8_t pf[5];
#pragma unroll
            for (int pi = 0; pi < 5; ++pi) { uint4 w4; w4.x = pk2(s[2 * pi][0], s[2 * pi][1]); w4.y = pk2(s[2 * pi][2], s[2 * pi][3]); w4.z = pk2(s[2 * pi + 1][0], s[2 * pi + 1][1]); w4.w = pk2(s[2 * pi + 1][2], s[2 * pi + 1][3]);
                pf[pi] = __builtin_bit_cast(bf16x8_t, w4); }
            const int qq = l15 >> 2, pp = lane & 3;
#pragma unroll
            for (int dt = 0; dt < 4; ++dt) {
                f32x4_t o = (f32x4_t){0.f, 0.f, 0.f, 0.f};
#pragma unroll
                for (int pi = 0; pi < 5; ++pi) {
                    const int ka = (ktb0 + 2 * pi) < 15 ? (ktb0 + 2 * pi) : 15, kb = (ktb0 + 2 * pi + 1) < 15 ? (ktb0 + 2 * pi + 1) : 15;
                    u32x2_t v0, v1;
                    tr_read2(ldsb + SWA_VS + (16 * ka + 4 * g4 + qq) * SWA_PITCH + (16 * dt + 4 * pp) * 2, ldsb + SWA_VS + (16 * kb + 4 * g4 + qq) * SWA_PITCH + (16 * dt + 4 * pp) * 2, v0, v1);
                    const uint4 av = make_uint4(v0.x, v0.y, v1.x, v1.y);
                    o = __builtin_amdgcn_mfma_f32_16x16x32_bf16(__builtin_bit_cast(bf16x8_t, av), pf[pi], o, 0, 0, 0);
                }
                *(uint2*)(ya + (size_t)tq * 1024 + hq * 64 + 16 * dt + 4 * g4) = make_uint2(pk2(o[0] * inv, o[1] * inv), pk2(o[2] * inv, o[3] * inv));
            }
        }
    }
}

constexpr int ML_QP = 272, ML_VP = 112, ML_PP = 144;
constexpr int ML_Q = 0, ML_K = 2 * 64 * ML_QP, ML_V = ML_K + 2 * 64 * ML_QP, ML_VW = ML_V + 2 * 64 * ML_VP, ML_P = ML_VW + 64 * ML_VP, ML_CT = ML_P + 64 * ML_PP,
              ML_VEC = ML_CT + 48 * ML_QP, ML_END = ML_VEC + 4096;
static_assert(ML_END <= RING_BYTES, "mLSTM LDS");
__device__ __forceinline__ void tr_read2q(unsigned a0, unsigned a1, u32x2_t& r0, u32x2_t& r1) {
    asm volatile("ds_read_b64_tr_b16 %0, %2\n\tds_read_b64_tr_b16 %1, %3\n\ts_waitcnt lgkmcnt(0)" : "=&v"(r0), "=&v"(r1) : "v"(a0), "v"(a1) : "memory");
}
__device__ __forceinline__ bf16x8_t mk_frag(u32x2_t lo, u32x2_t hi) { const u32x4_t v = (u32x4_t){lo.x, lo.y, hi.x, hi.y}; return __builtin_bit_cast(bf16x8_t, v); }
#define LBAR() do { asm volatile("s_waitcnt lgkmcnt(0)" ::: "memory"); __builtin_amdgcn_s_barrier(); asm volatile("" ::: "memory"); } while (0)
__device__ __forceinline__ void mlstm_phase(LAS unsigned char* lds, const bf16* __restrict__ proj, const float* __restrict__ small, const float* __restrict__ gate_b, float* __restrict__ hm, int tid, int bx, int G) {
    const int lane = tid & 63, w = __builtin_amdgcn_readfirstlane(tid >> 6), l15 = lane & 15, g4 = lane >> 4, qq = l15 >> 2, pp = lane & 3;
    const unsigned ldsb = (unsigned)(size_t)lds;
    LAS float* vec = (LAS float*)(lds + ML_VEC);
    for (int u = bx; u < NBATCH * 4 * 8; u += G) {
        const int vs = u & 7, h = (u >> 3) & 3, b = u >> 5;
        const float bi = gate_b[h], bfg = gate_b[4 + h];
        LBAR();
        for (int i = tid; i < 2 * 64; i += 512) { LAS unsigned* p = (LAS unsigned*)(lds + ML_V + i * ML_VP + 64); p[0] = 0x00003F80u;
#pragma unroll
            for (int j = 1; j < 8; ++j) p[j] = 0u; }
        for (int i = tid; i < 48 * ML_QP / 4; i += 512) ((LAS unsigned*)(lds + ML_CT))[i] = 0u;
        f32x4_t cacc[3];
#pragma unroll
        for (int i = 0; i < 3; ++i) cacc[i] = (f32x4_t){0.f, 0.f, 0.f, 0.f};
        uint4 pq[2], pk[2], pv; float pgi = 0.f, pgf = 0.f;
        pv = make_uint4(0u, 0u, 0u, 0u);
#define ML_LOAD(c_) do { const size_t tb_ = (size_t)b * SEQ + (size_t)(c_) * 64; \
            _Pragma("unroll") for (int i_ = 0; i_ < 2; ++i_) { const int p_ = tid + 512 * i_, row_ = p_ >> 4, c16_ = p_ & 15; const bf16* s_ = proj + (tb_ + row_) * NP + h * 128 + c16_ * 8; pq[i_] = *(const uint4*)(s_ + C_MQ); pk[i_] = *(const uint4*)(s_ + C_MK); } \
            if (tid < 256) pv = *(const uint4*)(proj + (tb_ + (tid >> 2)) * NP + C_MV + h * 256 + vs * 32 + (tid & 3) * 8); \
            if (tid >= 256 && tid < 320) { pgi = small[(tb_ + (tid - 256)) * 32 + h]; pgf = small[(tb_ + (tid - 256)) * 32 + 4 + h]; } } while (0)
#define ML_STORE(bi_) do { _Pragma("unroll") for (int i_ = 0; i_ < 2; ++i_) { const int p_ = tid + 512 * i_, row_ = p_ >> 4, c16_ = p_ & 15; \
                *(LAS u32x4_t*)(lds + ML_Q + (bi_) * 64 * ML_QP + row_ * ML_QP + c16_ * 16) = __builtin_bit_cast(u32x4_t, pq[i_]); *(LAS u32x4_t*)(lds + ML_K + (bi_) * 64 * ML_QP + row_ * ML_QP + c16_ * 16) = __builtin_bit_cast(u32x4_t, pk[i_]); } \
            if (tid < 256) *(LAS u32x4_t*)(lds + ML_V + (bi_) * 64 * ML_VP + (tid >> 2) * ML_VP + (tid & 3) * 16) = __builtin_bit_cast(u32x4_t, pv); \
            if (tid >= 256 && tid < 320) { vec[(bi_) * 128 + (tid - 256) * 2] = pgi; vec[(bi_) * 128 + (tid - 256) * 2 + 1] = pgf; } } while (0)
        ML_LOAD(0); ML_STORE(0);
        LBAR();
#pragma nounroll
        for (int c = 0; c < 64; ++c) {
            const int bi_cur = c & 1;
            const LAS unsigned char* Qs = lds + ML_Q + bi_cur * 64 * ML_QP; const LAS unsigned char* Ks = lds + ML_K + bi_cur * 64 * ML_QP;
            const unsigned Ksb = ldsb + ML_K + bi_cur * 64 * ML_QP, Vsb = ldsb + ML_V + bi_cur * 64 * ML_VP, Vwb = ldsb + ML_VW;
            if (c + 1 < 64) ML_LOAD(c + 1);
            if (w == 0) {
                const float ip = vec[bi_cur * 128 + lane * 2] + bi, fp = vec[bi_cur * 128 + lane * 2 + 1] + bfg;
                const float lf = fminf(fp, 0.f) - log1pf(__expf(-fabsf(fp)));
                vec[256 + lane] = lf;
                asm volatile("s_waitcnt lgkmcnt(0)" ::: "memory");
                float bsum = 0.f;
#pragma unroll
                for (int j = 0; j < 64; j += 4) { const f32x4_t v4 = *(const LAS f32x4_t*)(vec + 256 + j);
                    bsum += (j + 0 <= lane) ? v4[0] : 0.f; bsum += (j + 1 <= lane) ? v4[1] : 0.f; bsum += (j + 2 <= lane) ? v4[2] : 0.f; bsum += (j + 3 <= lane) ? v4[3] : 0.f; }
                const float gtot = __builtin_bit_cast(float, __builtin_amdgcn_readlane(__builtin_bit_cast(int, bsum), 63));
                vec[320 + lane] = bsum; vec[384 + lane] = ip - bsum; vec[448 + lane] = __expf(bsum); vec[512 + lane] = __expf(gtot - bsum + ip) * 0.08838834764831845f;
                if (lane == 0) vec[640] = __expf(gtot);
            }
            LBAR();
            {
                const int ti = w >> 1;
#pragma unroll
                for (int sj = 0; sj < 2; ++sj) {
                    const int si = 2 * (w & 1) + sj;
                    f32x4_t acc = (f32x4_t){0.f, 0.f, 0.f, 0.f};
                    if (si <= ti) {
#pragma unroll
                        for (int ks = 0; ks < 4; ++ks) {
                            const bf16x8_t a = *(const LAS bf16x8_t*)(Ks + (16 * si + l15) * ML_QP + (32 * ks + 8 * g4) * 2);
                            const bf16x8_t bq = *(const LAS bf16x8_t*)(Qs + (16 * ti + l15) * ML_QP + (32 * ks + 8 * g4) * 2);
                            acc = __builtin_amdgcn_mfma_f32_16x16x32_bf16(a, bq, acc, 0, 0, 0);
                        }
                        const int t = 16 * ti + l15; const float btv = vec[320 + t];
                        const f32x4_t csv = *(const LAS f32x4_t*)(vec + 384 + 16 * si + 4 * g4);
#pragma unroll
                        for (int e = 0; e < 4; ++e) { const int s = 16 * si + 4 * g4 + e; acc[e] = (s <= t) ? acc[e] * __expf(btv + csv[e]) * 0.08838834764831845f : 0.f; }
                    }
                    *(LAS u32x2_t*)(lds + ML_P + (16 * ti + l15) * ML_PP + (16 * si + 4 * g4) * 2) = (u32x2_t){pk2(acc[0], acc[1]), pk2(acc[2], acc[3])};
                }
            }
            if (tid < 384) { const int s = tid / 6, pc = tid % 6; const float wsv = vec[512 + s];
                const u32x4_t v = *(const LAS u32x4_t*)(lds + ML_V + bi_cur * 64 * ML_VP + s * ML_VP + pc * 16); u32x4_t o;
#pragma unroll
                for (int j = 0; j < 4; ++j) o[j] = pk2(__uint_as_float(v[j] << 16) * wsv, __uint_as_float(v[j] & 0xffff0000u) * wsv);
                *(LAS u32x4_t*)(lds + ML_VW + s * ML_VP + pc * 16) = o; }
            LBAR();
            f32x4_t numv[2]; const int ti5 = w >> 1;
            {
                const int nv = (w & 1) ? 1 : 2, v0 = (w & 1) ? 2 : 0;
#pragma unroll
                for (int j = 0; j < 2; ++j) {
                    numv[j] = (f32x4_t){0.f, 0.f, 0.f, 0.f};
                    if (j < nv) {
                        const int vi = v0 + j;
                        f32x4_t ai = (f32x4_t){0.f, 0.f, 0.f, 0.f}, ax = ai;
#pragma unroll
                        for (int ks = 0; ks < 2; ++ks) {
                            const bf16x8_t a = *(const LAS bf16x8_t*)(lds + ML_P + (16 * ti5 + l15) * ML_PP + (32 * ks + 8 * g4) * 2);
                            u32x2_t r0, r1; tr_read2q(Vsb + (32 * ks + 8 * g4 + qq) * ML_VP + (16 * vi + 4 * pp) * 2, Vsb + (32 * ks + 8 * g4 + 4 + qq) * ML_VP + (16 * vi + 4 * pp) * 2, r0, r1);
                            ai = __builtin_amdgcn_mfma_f32_16x16x32_bf16(a, mk_frag(r0, r1), ai, 0, 0, 0);
                        }
#pragma unroll
                        for (int ks = 0; ks < 4; ++ks) {
                            const bf16x8_t a = *(const LAS bf16x8_t*)(Qs + (16 * ti5 + l15) * ML_QP + (32 * ks + 8 * g4) * 2);
                            const bf16x8_t bc = *(const LAS bf16x8_t*)(lds + ML_CT + (16 * vi + l15) * ML_QP + (32 * ks + 8 * g4) * 2);
                            ax = __builtin_amdgcn_mfma_f32_16x16x32_bf16(a, bc, ax, 0, 0, 0);
                        }
                        const f32x4_t eb = *(const LAS f32x4_t*)(vec + 448 + 16 * ti5 + 4 * g4);
                        numv[j] = ai + eb * ax;
                    }
                }
                if ((w & 1) && l15 == 0) *(LAS f32x4_t*)(vec + 576 + 16 * ti5 + 4 * g4) = numv[0];
            }
            LBAR();
            if (!(w & 1)) {
                const f32x4_t dn = *(const LAS f32x4_t*)(vec + 576 + 16 * ti5 + 4 * g4);
                const size_t tb = (size_t)b * SEQ + (size_t)c * 64;
#pragma unroll
                for (int j = 0; j < 2; ++j)
#pragma unroll
                    for (int e = 0; e < 4; ++e) hm[(tb + 16 * ti5 + 4 * g4 + e) * 1024 + h * 256 + vs * 32 + 16 * j + l15] = numv[j][e] / fmaxf(fabsf(dn[e]), 1.0f);
            }
            {
                const float eg = vec[640];
#pragma unroll
                for (int vi = 0; vi < 3; ++vi) {
                    f32x4_t acc = cacc[vi] * eg;
#pragma unroll
                    for (int ks = 0; ks < 2; ++ks) {
                        u32x2_t a0, a1, b0, b1;
                        tr_read2q(Ksb + (32 * ks + 8 * g4 + qq) * ML_QP + (16 * w + 4 * pp) * 2, Ksb + (32 * ks + 8 * g4 + 4 + qq) * ML_QP + (16 * w + 4 * pp) * 2, a0, a1);
                        tr_read2q(Vwb + (32 * ks + 8 * g4 + qq) * ML_VP + (16 * vi + 4 * pp) * 2, Vwb + (32 * ks + 8 * g4 + 4 + qq) * ML_VP + (16 * vi + 4 * pp) * 2, b0, b1);
                        acc = __builtin_amdgcn_mfma_f32_16x16x32_bf16(mk_frag(a0, a1), mk_frag(b0, b1), acc, 0, 0, 0);
                    }
                    cacc[vi] = acc;
                    *(LAS u32x2_t*)(lds + ML_CT + (16 * vi + l15) * ML_QP + (16 * w + 4 * g4) * 2) = (u32x2_t){pk2(acc[0], acc[1]), pk2(acc[2], acc[3])};
                }
            }
            if (c + 1 < 64) ML_STORE(bi_cur ^ 1);
            LBAR();
        }
#undef ML_LOAD
#undef ML_STORE
    }
}

constexpr int SD_BP = 272, SD_XP = 80;
constexpr int SD_B = 0, SD_C = 128 * SD_BP, SD_M = 2 * 128 * SD_BP, SD_H = 3 * 128 * SD_BP, SD_X = SD_H + 32 * SD_BP, SD_XW = SD_X + 128 * SD_XP, SD_VEC = SD_XW + 128 * SD_XP, SD_END = SD_VEC + 4096;
static_assert(SD_END <= PHASE_LDS_BYTES, "SSD LDS");
__device__ __forceinline__ void ssd_phase(LAS unsigned char* lds, const bf16* __restrict__ xcb  , const float* __restrict__ small, const float* __restrict__ dt_bias, const float* __restrict__ a_log,
                                          const float* __restrict__ dsk, float* __restrict__ yraw  , int tid, int bx, int G) {
    const int lane = tid & 63, w = __builtin_amdgcn_readfirstlane(tid >> 6), l15 = lane & 15, g4 = lane >> 4, qq = l15 >> 2, pp = lane & 3;
    const unsigned ldsb = (unsigned)(size_t)lds;
    LAS float* vec = (LAS float*)(lds + SD_VEC);
    for (int u = bx; u < NBATCH * 16 * 2; u += G) {
        const int ph = u & 1, hh = (u >> 1) & 15, b = u >> 5, g = hh >> 3;
        const float a = -__expf(a_log[hh]), dtb = dt_bias[hh], Dk = dsk[hh];
        LBAR();
        for (int i = tid; i < 32 * SD_BP / 4; i += 512) ((LAS unsigned*)(lds + SD_H))[i] = 0u;
        f32x4_t hacc[2];
        hacc[0] = (f32x4_t){0.f, 0.f, 0.f, 0.f}; hacc[1] = hacc[0];
        uint4 pb[4], pc[4], px; float pdt = 0.f;
#define SD_LOAD(c_) do { const size_t tb_ = (size_t)b * SEQ + (size_t)(c_) * 128; \
            _Pragma("unroll") for (int i_ = 0; i_ < 4; ++i_) { const int p_ = tid + 512 * i_, row_ = p_ >> 4, c16_ = p_ & 15; const bf16* s_ = xcb + (tb_ + row_) * 1536 + 1024 + g * 128 + c16_ * 8; pb[i_] = *(const uint4*)s_; pc[i_] = *(const uint4*)(s_ + 256); } \
            px = *(const uint4*)(xcb + (tb_ + (tid >> 2)) * 1536 + hh * 64 + ph * 32 + (tid & 3) * 8); \
            if (tid < 128) pdt = small[(tb_ + tid) * 32 + 8 + hh]; } while (0)
#define SD_STORE() do { _Pragma("unroll") for (int i_ = 0; i_ < 4; ++i_) { const int p_ = tid + 512 * i_, row_ = p_ >> 4, c16_ = p_ & 15; \
                *(LAS u32x4_t*)(lds + SD_B + row_ * SD_BP + c16_ * 16) = __builtin_bit_cast(u32x4_t, pb[i_]); *(LAS u32x4_t*)(lds + SD_C + row_ * SD_BP + c16_ * 16) = __builtin_bit_cast(u32x4_t, pc[i_]); } \
            *(LAS u32x4_t*)(lds + SD_X + (tid >> 2) * SD_XP + (tid & 3) * 16) = __builtin_bit_cast(u32x4_t, px); \
            if (tid < 128) vec[tid] = pdt; } while (0)
        SD_LOAD(0); SD_STORE();
        LBAR();
#pragma nounroll
        for (int c = 0; c < 32; ++c) {
            if (c + 1 < 32) SD_LOAD(c + 1);
            if (w < 2) {
                const float dtr = vec[tid] + dtb; const float dt = dtr > 20.f ? dtr : log1pf(__expf(dtr));
                vec[640 + tid] = dt; vec[128 + tid] = dt * a;
            }
            LBAR();
            if (w < 2) {
                float acs = 0.f;
#pragma unroll 8
                for (int j = 0; j < 128; j += 4) { const f32x4_t v4 = *(const LAS f32x4_t*)(vec + 128 + j);
                    acs += (j + 0 <= tid) ? v4[0] : 0.f; acs += (j + 1 <= tid) ? v4[1] : 0.f; acs += (j + 2 <= tid) ? v4[2] : 0.f; acs += (j + 3 <= tid) ? v4[3] : 0.f; }
                vec[256 + tid] = acs; vec[384 + tid] = __expf(acs);
                if (tid == 127) { vec[768] = acs; vec[769] = __expf(acs); }
            }
            LBAR();
            if (w < 2) { const float atot = vec[768]; vec[512 + tid] = __expf(atot - vec[256 + tid]) * vec[640 + tid]; }
            {
                const int li = w; const int l = 16 * li + l15; const float acl = vec[256 + l];
#pragma unroll
                for (int si = 0; si < 8; ++si) {
                    f32x4_t acc = (f32x4_t){0.f, 0.f, 0.f, 0.f};
                    if (si <= li) {
#pragma unroll
                        for (int ks = 0; ks < 4; ++ks) {
                            const bf16x8_t av = *(const LAS bf16x8_t*)(lds + SD_B + (16 * si + l15) * SD_BP + (32 * ks + 8 * g4) * 2);
                            const bf16x8_t bv = *(const LAS bf16x8_t*)(lds + SD_C + (16 * li + l15) * SD_BP + (32 * ks + 8 * g4) * 2);
                            acc = __builtin_amdgcn_mfma_f32_16x16x32_bf16(av, bv, acc, 0, 0, 0);
                        }
                        const f32x4_t acs = *(const LAS f32x4_t*)(vec + 256 + 16 * si + 4 * g4), dts = *(const LAS f32x4_t*)(vec + 640 + 16 * si + 4 * g4);
#pragma unroll
                        for (int e = 0; e < 4; ++e) { const int s = 16 * si + 4 * g4 + e; acc[e] = (s <= l) ? acc[e] * __expf(acl - acs[e]) * dts[e] : 0.f; }
                    }
                    *(LAS u32x2_t*)(lds + SD_M + l * SD_BP + (16 * si + 4 * g4) * 2) = (u32x2_t){pk2(acc[0], acc[1]), pk2(acc[2], acc[3])};
                }
            }
            LBAR();
            { const int s = tid >> 2, pcx = tid & 3; const float wv = vec[512 + s];
              const u32x4_t v = *(const LAS u32x4_t*)(lds + SD_X + s * SD_XP + pcx * 16); u32x4_t o;
#pragma unroll
              for (int j = 0; j < 4; ++j) o[j] = pk2(__uint_as_float(v[j] << 16) * wv, __uint_as_float(v[j] & 0xffff0000u) * wv);
              *(LAS u32x4_t*)(lds + SD_XW + s * SD_XP + pcx * 16) = o; }
            {
                const int li = w; const size_t tb = (size_t)b * SEQ + (size_t)c * 128;
                const f32x4_t eac = *(const LAS f32x4_t*)(vec + 384 + 16 * li + 4 * g4);
#pragma unroll
                for (int pi = 0; pi < 2; ++pi) {
                    f32x4_t yd = (f32x4_t){0.f, 0.f, 0.f, 0.f}, yo = yd;
#pragma unroll
                    for (int ks = 0; ks < 4; ++ks) {
                        if (32 * ks <= 16 * li + 15) {
                            const bf16x8_t av = *(const LAS bf16x8_t*)(lds + SD_M + (16 * li + l15) * SD_BP + (32 * ks + 8 * g4) * 2);
                            u32x2_t r0, r1; tr_read2q(ldsb + SD_X + (32 * ks + 8 * g4 + qq) * SD_XP + (16 * pi + 4 * pp) * 2, ldsb + SD_X + (32 * ks + 8 * g4 + 4 + qq) * SD_XP + (16 * pi + 4 * pp) * 2, r0, r1);
                            yd = __builtin_amdgcn_mfma_f32_16x16x32_bf16(av, mk_frag(r0, r1), yd, 0, 0, 0);
                        }
                    }
#pragma unroll
                    for (int ks = 0; ks < 4; ++ks) {
                        const bf16x8_t av = *(const LAS bf16x8_t*)(lds + SD_C + (16 * li + l15) * SD_BP + (32 * ks + 8 * g4) * 2);
                        const bf16x8_t bh = *(const LAS bf16x8_t*)(lds + SD_H + (16 * pi + l15) * SD_BP + (32 * ks + 8 * g4) * 2);
                        yo = __builtin_amdgcn_mfma_f32_16x16x32_bf16(av, bh, yo, 0, 0, 0);
                    }
#pragma unroll
                    for (int e = 0; e < 4; ++e) { const int l = 16 * li + 4 * g4 + e;
                        const float xv = __uint_as_float(((unsigned)*(const LAS unsigned short*)(lds + SD_X + l * SD_XP + (16 * pi + l15) * 2)) << 16);
                        yraw[(tb + l) * 1024 + hh * 64 + ph * 32 + 16 * pi + l15] = yd[e] + eac[e] * yo[e] + Dk * xv; }
                }
            }
            LBAR();
            {
                const float ea = vec[769];
#pragma unroll
                for (int pi = 0; pi < 2; ++pi) {
                    f32x4_t acc = hacc[pi] * ea;
#pragma unroll
                    for (int ks = 0; ks < 4; ++ks) {
                        u32x2_t a0, a1, b0, b1;
                        tr_read2q(ldsb + SD_B + (32 * ks + 8 * g4 + qq) * SD_BP + (16 * w + 4 * pp) * 2, ldsb + SD_B + (32 * ks + 8 * g4 + 4 + qq) * SD_BP + (16 * w + 4 * pp) * 2, a0, a1);
                        tr_read2q(ldsb + SD_XW + (32 * ks + 8 * g4 + qq) * SD_XP + (16 * pi + 4 * pp) * 2, ldsb + SD_XW + (32 * ks + 8 * g4 + 4 + qq) * SD_XP + (16 * pi + 4 * pp) * 2, b0, b1);
                        acc = __builtin_amdgcn_mfma_f32_16x16x32_bf16(mk_frag(a0, a1), mk_frag(b0, b1), acc, 0, 0, 0);
                    }
                    hacc[pi] = acc;
                    *(LAS u32x2_t*)(lds + SD_H + (16 * pi + l15) * SD_BP + (16 * w + 4 * g4) * 2) = (u32x2_t){pk2(acc[0], acc[1]), pk2(acc[2], acc[3])};
                }
            }
            LBAR();
            if (c + 1 < 32) SD_STORE();
            LBAR();
        }
#undef SD_LOAD
#undef SD_STORE
    }
}

constexpr int PS_SKP = 272;
constexpr int PS_SK = 0, PS_END = 2 * 128 * PS_SKP;
static_assert(PS_END <= PHASE_LDS_BYTES, "PEER select LDS");
__device__ __forceinline__ unsigned fkey(float f) { const unsigned u = __float_as_uint(f); return u ^ ((unsigned)((int)u >> 31) | 0x80000000u); }
__device__ __forceinline__ float funkey(unsigned k) { return __uint_as_float((k & 0x80000000u) ? (k ^ 0x80000000u) : ~k); }
template <int CTRL> __device__ __forceinline__ unsigned dpp_u(unsigned v) { return (unsigned)__builtin_amdgcn_update_dpp(0, (int)v, CTRL, 0xF, 0xF, true); }
__device__ __forceinline__ unsigned umax(unsigned a, unsigned b) { return a > b ? a : b; }
__device__ __forceinline__ unsigned row_umax(unsigned v) { v = umax(v, dpp_u<0xB1>(v)); v = umax(v, dpp_u<0x4E>(v)); v = umax(v, dpp_u<0x141>(v)); v = umax(v, dpp_u<0x140>(v)); return v; }
__device__ __forceinline__ float row_sum(float v) { v += dpp_f<0xB1>(v); v += dpp_f<0x4E>(v); v += dpp_f<0x141>(v); v += dpp_f<0x140>(v); return v; }
template <int N> __device__ __forceinline__ unsigned row_top16(unsigned (&s)[N], int l15) {
    unsigned mine = 0u;
#pragma unroll
    for (int j = 0; j < 16; ++j) {
        unsigned m = s[0];
#pragma unroll
        for (int i = 1; i < N; ++i) m = umax(m, s[i]);
        m = row_umax(m);
        mine = (l15 == j) ? m : mine;
#pragma unroll
        for (int i = 0; i < N; ++i) s[i] = (s[i] == m) ? 0u : s[i];
    }
    return mine;
}
__device__ __forceinline__ void peer_select_phase(LAS unsigned char* lds, const bf16* __restrict__ qb  , const bf16* __restrict__ skb  , int* __restrict__ ids, float* __restrict__ gates,
                                                  int tid, int bx, int G) {
    const int lane = tid & 63, w = __builtin_amdgcn_readfirstlane(tid >> 6), l15 = lane & 15, g4 = lane >> 4;
    int ca[4], cb[4];
#pragma unroll
    for (int i = 0; i < 4; ++i) { const int sg = 4 * l15 + i; int a = 0, base = 0;
#pragma unroll
        for (int k = 0; k < 15; ++k) { const int cnt = 16 / (k + 1); const bool adv = (a == k) && (sg >= base + cnt); base += adv ? cnt : 0; a += adv ? 1 : 0; }
        ca[i] = a; cb[i] = sg - base; if (sg >= 50) { ca[i] = -1; cb[i] = 0; } }
    for (int u = bx; u < 8 * 32; u += G) {
        const int h = u >> 5, tr = u & 31;
        LBAR();
        for (int it = tid; it < 4096; it += 512) { const int row = it >> 4, c16 = it & 15;
            *(LAS u32x4_t*)(lds + PS_SK + row * PS_SKP + c16 * 16) = __builtin_bit_cast(u32x4_t, *(const uint4*)(skb + ((size_t)h * 256 + row) * 128 + c16 * 8)); }
        LBAR();
#pragma nounroll
        for (int tile = w; tile < 64; tile += 8) {
            const int t0 = tr * 1024 + tile * 16;
            unsigned top[2][4];
#pragma unroll
            for (int c = 0; c < 2; ++c) {
                bf16x8_t af[4];
#pragma unroll
                for (int ks = 0; ks < 4; ++ks) af[ks] = __builtin_bit_cast(bf16x8_t, *(const uint4*)(qb + (size_t)(t0 + l15) * DM + h * 256 + c * 128 + 32 * ks + 8 * g4));
                unsigned key[8][4];
#pragma unroll
                for (int kt = 0; kt < 8; ++kt) {
                    f32x4_t acc = (f32x4_t){0.f, 0.f, 0.f, 0.f};
#pragma unroll
                    for (int ks = 0; ks < 4; ++ks) {
                        const bf16x8_t bfr = *(const LAS bf16x8_t*)(lds + PS_SK + (c * 128 + 16 * kt + l15) * PS_SKP + (32 * ks + 8 * g4) * 2);
                        acc = __builtin_amdgcn_mfma_f32_16x16x32_bf16(af[ks], bfr, acc, 0, 0, 0);
                    }
#pragma unroll
                    for (int e = 0; e < 4; ++e) key[kt][e] = (fkey(acc[e]) & ~0x7Fu) | (unsigned)(127 - (16 * kt + l15));
                }
#pragma unroll
                for (int e = 0; e < 4; ++e) { unsigned s8[8];
#pragma unroll
                    for (int kt = 0; kt < 8; ++kt) s8[kt] = key[kt][e];
                    __builtin_amdgcn_sched_barrier(0); top[c][e] = row_top16<8>(s8, l15); __builtin_amdgcn_sched_barrier(0); }
            }
#pragma unroll
            for (int e = 0; e < 4; ++e) {
                unsigned s4[4];
#pragma unroll
                for (int i = 0; i < 4; ++i) {
                    const int srcA = ((lane & 48) + (ca[i] < 0 ? 0 : ca[i])) * 4, srcB = ((lane & 48) + cb[i]) * 4;
                    const unsigned ka = (unsigned)__builtin_amdgcn_ds_bpermute(srcA, (int)top[0][e]), kb = (unsigned)__builtin_amdgcn_ds_bpermute(srcB, (int)top[1][e]);
                    const float cv = funkey(ka & ~0x7Fu) + funkey(kb & ~0x7Fu);
                    s4[i] = ca[i] < 0 ? 0u : ((fkey(cv) & ~0xFFu) | (unsigned)(255 - (ca[i] * 16 + cb[i])));
                }
                __builtin_amdgcn_sched_barrier(0); const unsigned win = row_top16<4>(s4, l15); __builtin_amdgcn_sched_barrier(0);
                const int jw = 255 - (int)(win & 0xFFu), wa = jw >> 4, wb = jw & 15;
                const unsigned ka = (unsigned)__builtin_amdgcn_ds_bpermute(((lane & 48) + wa) * 4, (int)top[0][e]), kb = (unsigned)__builtin_amdgcn_ds_bpermute(((lane & 48) + wb) * 4, (int)top[1][e]);
                const float bv = funkey(ka & ~0x7Fu) + funkey(kb & ~0x7Fu);
                const int id = (127 - (int)(ka & 0x7Fu)) * 128 + (127 - (int)(kb & 0x7Fu));
                const float mx = __builtin_bit_cast(float, __builtin_amdgcn_ds_bpermute((lane & 48) * 4, __builtin_bit_cast(int, bv)));
                const float ex = __expf(bv - mx), den = row_sum(ex);
                const size_t o = (size_t)(t0 + 4 * g4 + e) * 128 + h * 16 + l15;
                ids[o] = id; gates[o] = ex / den;
            }
        }
    }
}

struct MegaArgs { const float* in[22]; float* out; unsigned char* ws; };
template <int I> __device__ __forceinline__ unsigned long long ld_ptr() {
    unsigned long long v; const auto ka = __builtin_amdgcn_kernarg_segment_ptr();
    asm volatile("s_load_dwordx2 %0, %1, %2\n\ts_waitcnt lgkmcnt(0)" : "=s"(v) : "s"(ka), "n"(I * 8) : "memory");
    return v;
}
#define GAS_ __attribute__((address_space(1)))
#define INF(i) ((const float*)(const GAS_ float*)ld_ptr<(i)>())
#define OUTP ((float*)(GAS_ float*)ld_ptr<22>())
#define WSP ((unsigned char*)(GAS_ unsigned char*)ld_ptr<23>())
enum { I_X = 0, I_WIN, I_MGATEB, I_MNORMW, I_CONVW, I_CONVB, I_DTB, I_ALOG, I_SSMD, I_SNORMW, I_SINKS, I_MERGEB, I_WBR, I_WOUT, I_LN1G, I_LN1B, I_WQ, I_SUBK, I_PU, I_PV, I_LN2G, I_LN2B };

__global__ void __launch_bounds__(512, 2) mega_fwd(MegaArgs a) {
    extern __shared__ __attribute__((aligned(16))) unsigned char lds_raw[];
    LAS unsigned char* lds = (LAS unsigned char*)lds_raw;
    const int wave0 = __builtin_amdgcn_readfirstlane(threadIdx.x >> 6);
    volatile LAS unsigned* MISC = (volatile LAS unsigned*)(lds + MISC_OFF);
    { PHASE_IDS for (int u = tid; u < (LDS_BYTES - PHASE_LDS_BYTES) / 4; u += 512) ((LAS unsigned*)(lds + PHASE_LDS_BYTES))[u] = 0u; }
    __syncthreads();
    { XcdBarrier b0 = xcd_barrier_post((unsigned*)(WSP + WS_CTL) + CW_BAR, MISC + 8); (void)b0; }
#define GRID_BAR() do { XcdBarrier b_; b_.bar = (unsigned*)(WSP + WS_CTL) + CW_BAR; b_.x = xb_xcc_id(); b_.st = MISC + 8; xcd_barrier(b_); } while (0)

    { PHASE_IDS float2* rt = (float2*)(WSP + WS_ROPE);
      for (size_t i = gt; i < (size_t)SEQ * 32; i += NGT) { const int pos = (int)(i >> 5), fi = (int)(i & 31); const float ang = (float)pos * powf(10000.0f, -(float)fi / 32.0f); rt[i] = make_float2(cosf(ang), sinf(ang)); } }
    { PHASE_IDS const float* x = INF(I_X); bf16* xb = (bf16*)(WSP + WS_XB);
      for (size_t i = gt; i < (size_t)T_TOK * DM / 4; i += NGT) { const float4 v = ((const float4*)x)[i]; ((uint2*)xb)[i] = make_uint2(pk2(v.x, v.y), pk2(v.z, v.w)); } }

#pragma nounroll
    for (int l = 0; l < DEPTH; ++l) {
        { PHASE_IDS
            unsigned char* ws = WSP; bf16* WinT = (bf16*)(ws + WS_WIN); bf16* WbT = (bf16*)(ws + WS_WB); bf16* WoT = (bf16*)(ws + WS_WO); bf16* WqT = (bf16*)(ws + WS_WQ); float* bias = (float*)(ws + WS_BIAS);
            const float* w_in = INF(I_WIN) + (size_t)l * DM * IN_COLS; const float* w_branch = INF(I_WBR) + (size_t)l * 3 * 1024 * DM; const float* w_out = INF(I_WOUT) + (size_t)l * DM * DM; const float* peer_wq = INF(I_WQ) + (size_t)l * DM * DM;
            const float* merge_gate_b = INF(I_MERGEB) + (size_t)l * 3 * DM;
            LAS float* scr = (LAS float*)(lds + wave * 16384);
            constexpr int I_IN = (DM / 64) * (NP / 32), I_B = (1024 / 64) * (DM / 32), I_O = (DM / 64) * (DM / 32);
            constexpr int NITEMS = I_IN + 3 * I_B + 2 * I_O;
            for (int it = gw; it < NITEMS; it += NGW) {
                int r = it;
                if (r < I_IN) { transpose_item<1>(w_in, DM, IN_COLS, NP, WinT, scr, r, lane); continue; } r -= I_IN;
                if (r < 3 * I_B) { const int k = r / I_B; transpose_item<0>(w_branch + (size_t)k * 1024 * DM, 1024, DM, DM, WbT + (size_t)k * DM * 1024, scr, r - k * I_B, lane); continue; } r -= 3 * I_B;
                if (r < I_O) { transpose_item<0>(w_out, DM, DM, DM, WoT, scr, r, lane); continue; } r -= I_O;
                transpose_item<0>(peer_wq, DM, DM, DM, WqT, scr, r, lane);
            }
            for (size_t n = gt; n < NP; n += NGT) bias[n] = (n >= C_G && n < C_SMALL) ? merge_gate_b[n - C_G] : 0.f;
            { const float4* sk = (const float4*)(INF(I_SUBK) + (size_t)l * 8 * 2 * 128 * 128); uint2* skb = (uint2*)(ws + WS_SKB);
              for (size_t n = gt; n < 8 * 2 * 128 * 128 / 4; n += NGT) { const float4 v = sk[n]; skb[n] = make_uint2(pk2(v.x, v.y), pk2(v.z, v.w)); } }
        }
        GRID_BAR();
        { PHASE_IDS unsigned char* ws = WSP; pg8::Gemm g{(const bf16*)(ws + WS_XB), (const bf16*)(ws + WS_WIN), T_TOK, NP, DM}; pg8::StaticOrder S; S.init(T_TOK, NP, G, bx);
          pg8::EpiProj E{(bf16*)(ws + WS_PROJ), (const float*)(ws + WS_BIAS), (float*)(ws + WS_SMALL), NP, GATE_TILE_LO, SMALL_TILE, 0};
          pg8::gemm_phase<pg8::EpiProj, pg8::StaticOrder, true, true>(lds, g, S, E, tid); }
        GRID_BAR();
        { PHASE_IDS unsigned char* ws = WSP; const bf16* proj = (const bf16*)(ws + WS_PROJ); bf16* xcb = (bf16*)(ws + WS_R2);
          const float* cw = INF(I_CONVW) + (size_t)l * 4 * 1536; const float* cb = INF(I_CONVB) + l * 1536;
          for (size_t i = gt; i < (size_t)T_TOK * 768; i += NGT) ssd_conv_body(i, proj, cw, cb, xcb); }
        GRID_BAR();
        { PHASE_IDS unsigned char* ws = WSP; mlstm_phase(lds, (const bf16*)(ws + WS_PROJ), (const float*)(ws + WS_SMALL), INF(I_MGATEB) + l * 8, (float*)(ws + WS_HM), tid, bx, G); }
        { PHASE_IDS unsigned char* ws = WSP; ssd_phase(lds, (const bf16*)(ws + WS_R2), (const float*)(ws + WS_SMALL), INF(I_DTB) + l * 16, INF(I_ALOG) + l * 16, INF(I_SSMD) + l * 16, (float*)(ws + WS_R1), tid, bx, G); }
        { PHASE_IDS unsigned char* ws = WSP; swa_phase(lds, (const bf16*)(ws + WS_PROJ), (const float*)(ws + WS_ROPE), INF(I_SINKS) + l * 16, (bf16*)(ws + WS_Y + 128 * MiB), tid, bx, G); }
        GRID_BAR();
        { PHASE_IDS unsigned char* ws = WSP; const bf16* proj = (const bf16*)(ws + WS_PROJ); const float* hm = (const float*)(ws + WS_HM); bf16* ym = (bf16*)(ws + WS_Y); const float* nw = INF(I_MNORMW) + l * 1024;
          for (int w = gw; w < T_TOK * 4; w += NGW) mlstm_post_body(w, lane, hm, proj, nw, ym); }
        { PHASE_IDS unsigned char* ws = WSP; const bf16* proj = (const bf16*)(ws + WS_PROJ); const float* yraw = (const float*)(ws + WS_R1); bf16* ys = (bf16*)(ws + WS_Y + 64 * MiB); const float* nw = INF(I_SNORMW) + l * 1024;
          for (int w = gw; w < T_TOK * 2; w += NGW) ssd_post_body(w, lane, yraw, proj, nw, ys); }
        GRID_BAR();
        { PHASE_IDS unsigned char* ws = WSP; pg8::Gemm g{(const bf16*)(ws + WS_Y), (const bf16*)(ws + WS_WB), T_TOK, DM, 1024}; pg8::StaticOrder S; S.init(T_TOK, DM, G, bx);
          pg8::EpiMix<1> E{(bf16*)(ws + WS_R1), (const bf16*)(ws + WS_PROJ) + C_G, DM, NP};
          pg8::gemm_phase<pg8::EpiMix<1>, pg8::StaticOrder, true, true>(lds, g, S, E, tid); }
        __syncthreads();
        { PHASE_IDS unsigned char* ws = WSP; pg8::Gemm g{(const bf16*)(ws + WS_Y + 64 * MiB), (const bf16*)(ws + WS_WB) + (size_t)DM * 1024, T_TOK, DM, 1024}; pg8::StaticOrder S; S.init(T_TOK, DM, G, bx);
          pg8::EpiMix<0> E{(bf16*)(ws + WS_R1), (const bf16*)(ws + WS_PROJ) + C_G + DM, DM, NP};
          pg8::gemm_phase<pg8::EpiMix<0>, pg8::StaticOrder, true, true>(lds, g, S, E, tid); }
        __syncthreads();
        { PHASE_IDS unsigned char* ws = WSP; pg8::Gemm g{(const bf16*)(ws + WS_Y + 128 * MiB), (const bf16*)(ws + WS_WB) + (size_t)2 * DM * 1024, T_TOK, DM, 1024}; pg8::StaticOrder S; S.init(T_TOK, DM, G, bx);
          pg8::EpiMix<0> E{(bf16*)(ws + WS_R1), (const bf16*)(ws + WS_PROJ) + C_G + 2 * DM, DM, NP};
          pg8::gemm_phase<pg8::EpiMix<0>, pg8::StaticOrder, true, true>(lds, g, S, E, tid); }
        GRID_BAR();
        { PHASE_IDS unsigned char* ws = WSP; const float* xin = l == 0 ? INF(I_X) : (const float*)OUTP;
          pg8::Gemm g{(const bf16*)(ws + WS_R1), (const bf16*)(ws + WS_WO), T_TOK, DM, DM}; pg8::StaticOrder S; S.init(T_TOK, DM, G, bx); pg8::EpiResid E{(float*)(ws + WS_BUFB), xin, DM, ALPHA};
          pg8::gemm_phase<pg8::EpiResid, pg8::StaticOrder, true, true>(lds, g, S, E, tid); }
        GRID_BAR();
        { PHASE_IDS unsigned char* ws = WSP; float* bufB = (float*)(ws + WS_BUFB); bf16* xb = (bf16*)(ws + WS_XB); const float* g1 = INF(I_LN1G) + l * DM; const float* b1 = INF(I_LN1B) + l * DM;
          for (int t = gw; t < T_TOK; t += NGW) ln_body(t, lane, bufB, g1, b1, bufB, xb); }
        { PHASE_IDS unsigned char* ws = WSP; constexpr size_t NGRP = (size_t)P_EXPERTS * DM / 16;
          const float* pu = INF(I_PU) + (size_t)l * P_EXPERTS * DM; const float* pv = INF(I_PV) + (size_t)l * P_EXPERTS * DM; uint4* U8 = (uint4*)(ws + WS_R2); uint4* V8 = (uint4*)(ws + WS_R2 + 32 * MiB);
          for (size_t i = gt; i < 2 * NGRP; i += NGT) { if (i < NGRP) tab_to_fp8(i, pu, U8, U8_SCALE); else tab_to_fp8(i - NGRP, pv, V8, V8_SCALE); } }
        GRID_BAR();
        { PHASE_IDS unsigned char* ws = WSP; pg8::Gemm g{(const bf16*)(ws + WS_XB), (const bf16*)(ws + WS_WQ), T_TOK, DM, DM}; pg8::StaticOrder S; S.init(T_TOK, DM, G, bx);
          pg8::EpiProj E{(bf16*)(ws + WS_QF), nullptr, nullptr, DM, 1 << 20, -1, 0};
          pg8::gemm_phase<pg8::EpiProj, pg8::StaticOrder, true, true>(lds, g, S, E, tid); }
        GRID_BAR();
        { PHASE_IDS unsigned char* ws = WSP; peer_select_phase(lds, (const bf16*)(ws + WS_QF), (const bf16*)(ws + WS_SKB), (int*)(ws + WS_IDS), (float*)(ws + WS_GATES), tid, bx, G); }
        GRID_BAR();
        { PHASE_IDS unsigned char* ws = WSP; const float* bufB = (const float*)(ws + WS_BUFB); const int* ids = (const int*)(ws + WS_IDS); const float* gates = (const float*)(ws + WS_GATES);
          const unsigned char* U8 = ws + WS_R2; const unsigned char* V8 = ws + WS_R2 + 32 * MiB; const float* g2 = INF(I_LN2G) + l * DM; const float* b2 = INF(I_LN2B) + l * DM; float* out = OUTP; bf16* xb = (bf16*)(ws + WS_XB);
          for (int t = gw; t < T_TOK; t += NGW) peer_expert_body(t, lane, bufB, ids, gates, U8, V8, g2, b2, out, xb); }
        GRID_BAR();
    }
#undef GRID_BAR
}

extern "C" void kernel_launch(void* const* d_in, const int* in_sizes, int n_in, void* d_out, int out_size, void* d_ws, size_t ws_size, hipStream_t stream) {
    static int grid = 0;
    if (grid == 0) {
        if (n_in != 22 || out_size != T_TOK * DM || ws_size < WS_END) { fprintf(stderr, "kernel_launch: unexpected shapes (n_in %d, out %d, ws %zu)\n", n_in, out_size, ws_size); grid = -1; return; }
        int dev = 0, cus = 0, per_cu = 0;
        if (hipGetDevice(&dev) != hipSuccess || hipDeviceGetAttribute(&cus, hipDeviceAttributeMultiprocessorCount, dev) != hipSuccess) { grid = -1; return; }
        if (hipFuncSetAttribute((const void*)mega_fwd, hipFuncAttributeMaxDynamicSharedMemorySize, LDS_BYTES) != hipSuccess) { fprintf(stderr, "kernel_launch: hipFuncSetAttribute failed\n"); grid = -1; return; }
        if (hipOccupancyMaxActiveBlocksPerMultiprocessor(&per_cu, (const void*)mega_fwd, 512, LDS_BYTES) != hipSuccess || per_cu < 1) { fprintf(stderr, "kernel_launch: occupancy query says %d blocks per CU\n", per_cu); (void)hipGetLastError(); grid = -1; return; }
        grid = cus;
    }
    if (grid < 0) return;
    (void)hipMemsetAsync((char*)d_ws + WS_CTL, 0, CTL_ZERO_BYTES, stream);
    MegaArgs a; memset(&a, 0, sizeof(a));
    for (int i = 0; i < 22; ++i) a.in[i] = (const float*)d_in[i];
    a.out = (float*)d_out; a.ws = (unsigned char*)d_ws;
    hipLaunchKernelGGL(mega_fwd, dim3(grid), dim3(512), LDS_BYTES, stream, a);
}
```

```cpp
#include <hip/hip_runtime.h>
#include <cstdio>
#include <cstdint>
#include <cstring>

namespace pg8 {
#define PG8_LAS __attribute__((address_space(3)))
typedef unsigned short bf16_t;
typedef short bf16x8 __attribute__((ext_vector_type(8)));
typedef float f32x4 __attribute__((ext_vector_type(4)));
typedef unsigned u32x4 __attribute__((ext_vector_type(4)));
constexpr int BM = 256, BK = 64, HALF = 128, HTB = HALF * BK * 2  , STAGE_BYTES = 8 * HTB, NXCD = 8, WGM = 8;

__host__ __device__ __forceinline__ int lds_byte(int r, int c) { const int st = (r >> 4) * 2 + (c >> 5), rr = r & 15, cc = c & 31, ob = rr * 64 + cc * 2; return st * 1024 + (ob ^ (((ob >> 9) & 1) << 5)); }
__host__ __device__ __forceinline__ void stage_rc(int b, int& R, int& C) { const int st = b / 1024, sb = b % 1024, swz = sb ^ (((sb >> 9) & 1) << 5); R = (st >> 1) * 16 + swz / 64; C = (st & 1) * 32 + (swz % 64) / 2; }
__host__ __device__ __forceinline__ int perm32(int rho) { const int n = rho >> 4, i = rho & 15; return 8 * (i >> 2) + 4 * n + (i & 3); }

struct Unit { int pm, pn; };
struct Gemm { const bf16_t* A; const bf16_t* Bt; int M, N, K; };

struct StaticOrder {
    int nM, nN, nwg, G, c;
    __host__ __device__ void init(int M, int N, int G_, int c_) { nM = M / BM; nN = N / BM; nwg = nM * nN; G = G_; c = c_; }
    __host__ __device__ bool next(int i, Unit& u) const {
        const long L = (long)i * G + c; if (L >= nwg) return false;
        int wgid = (int)L; { const int q = nwg / NXCD, r = nwg % NXCD, xcd = wgid % NXCD, off = wgid / NXCD; wgid = (xcd < r ? xcd * (q + 1) : r * (q + 1) + (xcd - r) * q) + off; }
        const int nig = WGM * nN, gid = wgid / nig, fm = gid * WGM, gsz = (nM - fm) < WGM ? (nM - fm) : WGM;
        u.pm = fm + ((wgid % nig) % gsz); u.pn = (wgid % nig) / gsz; return true;
    }
    __device__ __forceinline__ void a_ready(const Unit&) const {}
    __device__ __forceinline__ void done(const Unit&) const {}
};

__device__ __forceinline__ unsigned cvt_pk_bf16(float lo, float hi) { unsigned r; asm volatile("v_cvt_pk_bf16_f32 %0, %1, %2" : "=v"(r) : "v"(lo), "v"(hi)); return r; }
typedef float f32x2 __attribute__((ext_vector_type(2)));
__device__ __forceinline__ float bf_lo(unsigned w) { return __uint_as_float(w << 16); }
__device__ __forceinline__ float bf_hi(unsigned w) { return __uint_as_float(w & 0xffff0000u); }
__device__ __forceinline__ float sigmoidf_(float x) { return 1.0f / (1.0f + __expf(-x)); }

struct EpiF32 {
    static constexpr bool PERM = false, AFTER_DRAIN = false;
    float* C; int ldc; int pad;
    __device__ __forceinline__ void operator()(const f32x4 (&acc)[2][2][4][2], const Unit& u, int wr, int wc, int fr, int fq) const {
        const int row0 = u.pm * BM + wr * 64 + fr, col0 = u.pn * BM + wc * 32 + 4 * fq;
#pragma unroll
        for (int ai = 0; ai < 2; ++ai)
#pragma unroll
            for (int m = 0; m < 4; ++m) { float* rowp = C + (size_t)(row0 + ai * HALF + m * 16) * ldc + col0;
#pragma unroll
                for (int bj = 0; bj < 2; ++bj)
#pragma unroll
                    for (int n = 0; n < 2; ++n) *(f32x4*)(rowp + bj * HALF + n * 16) = acc[ai][bj][m][n]; }
    }
};
struct EpiResid {
    static constexpr bool PERM = false, AFTER_DRAIN = false;
    float* C; const float* X; int ldc; float alpha;
    __device__ __forceinline__ void operator()(const f32x4 (&acc)[2][2][4][2], const Unit& u, int wr, int wc, int fr, int fq) const {
        const int row0 = u.pm * BM + wr * 64 + fr, col0 = u.pn * BM + wc * 32 + 4 * fq;
#pragma unroll
        for (int ai = 0; ai < 2; ++ai)
#pragma unroll
            for (int m = 0; m < 4; ++m) { const size_t off = (size_t)(row0 + ai * HALF + m * 16) * ldc + col0;
#pragma unroll
                for (int bj = 0; bj < 2; ++bj)
#pragma unroll
                    for (int n = 0; n < 2; ++n) { const f32x4 xv = *(const f32x4*)(X + off + bj * HALF + n * 16);
                        *(f32x4*)(C + off + bj * HALF + n * 16) = acc[ai][bj][m][n] + xv * alpha; } }
    }
};
struct EpiProj {
    static constexpr bool PERM = true, AFTER_DRAIN = false;
    bf16_t* O; const float* bias; float* small; int ldc; int gate_lo; int small_tile; int pad;
    __device__ __forceinline__ void operator()(const f32x4 (&acc)[2][2][4][2], const Unit& u, int wr, int wc, int fr, int fq) const {
        const int row0 = u.pm * BM + wr * 64 + fr, col0 = u.pn * BM + wc * 32 + 8 * fq;
        if (u.pn == small_tile) {
            if (wc == 0) {
#pragma unroll
                for (int ai = 0; ai < 2; ++ai)
#pragma unroll
                    for (int m = 0; m < 4; ++m) { float* p = small + (size_t)(row0 + ai * HALF + m * 16) * 32 + 8 * fq;
                        *(f32x4*)p = acc[ai][0][m][0]; *(f32x4*)(p + 4) = acc[ai][0][m][1]; }
            }
            return;
        }
        const bool gate = u.pn >= gate_lo;
        f32x4 bv[2][2];
#pragma unroll
        for (int bj = 0; bj < 2; ++bj)
#pragma unroll
            for (int n = 0; n < 2; ++n) bv[bj][n] = gate ? *(const f32x4*)(bias + col0 + bj * HALF + 4 * n) : (f32x4){0.f, 0.f, 0.f, 0.f};
#pragma unroll
        for (int ai = 0; ai < 2; ++ai)
#pragma unroll
            for (int m = 0; m < 4; ++m) { bf16_t* rowp = O + (size_t)(row0 + ai * HALF + m * 16) * ldc + col0;
#pragma unroll
                for (int bj = 0; bj < 2; ++bj) { f32x4 v0 = acc[ai][bj][m][0] + bv[bj][0], v1 = acc[ai][bj][m][1] + bv[bj][1];
                    if (gate) {
#pragma unroll
                        for (int j = 0; j < 4; ++j) { v0[j] = sigmoidf_(v0[j]); v1[j] = sigmoidf_(v1[j]); } }
                    u32x4 w; w.x = cvt_pk_bf16(v0[0], v0[1]); w.y = cvt_pk_bf16(v0[2], v0[3]); w.z = cvt_pk_bf16(v1[0], v1[1]); w.w = cvt_pk_bf16(v1[2], v1[3]);
                    *(u32x4*)(rowp + bj * HALF) = w; } }
    }
};
template <int FIRST> struct EpiMix {
    static constexpr bool PERM = true, AFTER_DRAIN = false;
    bf16_t* O; const bf16_t* G; int ldc; int ldg;
    __device__ __forceinline__ void operator()(const f32x4 (&acc)[2][2][4][2], const Unit& u, int wr, int wc, int fr, int fq) const {
        const int row0 = u.pm * BM + wr * 64 + fr, col0 = u.pn * BM + wc * 32 + 8 * fq;
#pragma unroll
        for (int ai = 0; ai < 2; ++ai)
#pragma unroll
            for (int m = 0; m < 4; ++m) { const int row = row0 + ai * HALF + m * 16; bf16_t* rowp = O + (size_t)row * ldc + col0; const bf16_t* gp = G + (size_t)row * ldg + col0;
#pragma unroll
                for (int bj = 0; bj < 2; ++bj) { const u32x4 gw = *(const u32x4*)(gp + bj * HALF); u32x4 ow = (u32x4){0u, 0u, 0u, 0u}; if (!FIRST) ow = *(const u32x4*)(rowp + bj * HALF);
                    const f32x4 a0 = acc[ai][bj][m][0], a1 = acc[ai][bj][m][1];
                    float r0 = bf_lo(ow.x) + bf_lo(gw.x) * a0[0], r1 = bf_hi(ow.x) + bf_hi(gw.x) * a0[1], r2 = bf_lo(ow.y) + bf_lo(gw.y) * a0[2], r3 = bf_hi(ow.y) + bf_hi(gw.y) * a0[3];
                    float r4 = bf_lo(ow.z) + bf_lo(gw.z) * a1[0], r5 = bf_hi(ow.z) + bf_hi(gw.z) * a1[1], r6 = bf_lo(ow.w) + bf_lo(gw.w) * a1[2], r7 = bf_hi(ow.w) + bf_hi(gw.w) * a1[3];
                    u32x4 w; w.x = cvt_pk_bf16(r0, r1); w.y = cvt_pk_bf16(r2, r3); w.z = cvt_pk_bf16(r4, r5); w.w = cvt_pk_bf16(r6, r7);
                    *(u32x4*)(rowp + bj * HALF) = w; } }
    }
};

template <class Epi, class Sched, bool ALIGN_EPI = false, bool SP2 = false>
__device__ __forceinline__ void gemm_phase(PG8_LAS unsigned char* lds, const Gemm g, const Sched& S, const Epi& E, int tid_) {
    asm volatile("" : "+v"(tid_));
    const int tid = tid_, wid = __builtin_amdgcn_readfirstlane(tid >> 6), lane = tid & 63, wr = wid >> 2, wc = wid & 3, fr = lane & 15, fq = lane >> 4;
    const int K = g.K, nt = K / BK;
    unsigned voffA[2], voffB[2];
#pragma unroll
    for (int i = 0; i < 2; ++i) { int R, C; stage_rc(tid * 16 + i * 8192, R, C); const int Rb = Epi::PERM ? ((R & ~31) + perm32(R & 31)) : R;
        voffA[i] = (unsigned)(R * K + C) * 2u; voffB[i] = (unsigned)(Rb * K + C) * 2u; }
    const size_t kstep = (size_t)(BK * 2);
    const size_t hstep = (size_t)HALF * K * 2;
    const size_t tstep = 2 * hstep;
    const unsigned ldsw = (unsigned)wid * 1024u;
    const int aoff = lds_byte(wr * 64 + fr, fq * 8), boff = lds_byte(wc * 32 + fr, fq * 8);
#define PG8_SA(b, h) (((b) * 2 + (h)) * HTB)
#define PG8_SB(b, h) ((4 + (b) * 2 + (h)) * HTB)
#define PG8_STAGE(bufoff, gbase, voff) do { _Pragma("unroll") for (int _i = 0; _i < 2; ++_i) \
        __builtin_amdgcn_global_load_lds((const unsigned*)((const char*)(gbase) + (voff)[_i]), (PG8_LAS unsigned*)(lds + (bufoff) + ldsw + _i * 8192), 16, 0, 0); } while (0)
#define PG8_LDA(dst, b, h) do { _Pragma("unroll") for (int m = 0; m < 4; ++m) _Pragma("unroll") for (int k = 0; k < 2; ++k) dst[m][k] = *(const PG8_LAS bf16x8*)(lds + PG8_SA(b, h) + aoff + m * 2048 + k * 1024); } while (0)
#define PG8_LDB(dst, b, h) do { _Pragma("unroll") for (int n = 0; n < 2; ++n) _Pragma("unroll") for (int k = 0; k < 2; ++k) dst[n][k] = *(const PG8_LAS bf16x8*)(lds + PG8_SB(b, h) + boff + n * 2048 + k * 1024); } while (0)
#define PG8_MMA(ai, bj, At, Bt) do { __builtin_amdgcn_s_setprio(1); _Pragma("unroll") for (int m = 0; m < 4; ++m) _Pragma("unroll") for (int n = 0; n < 2; ++n) _Pragma("unroll") for (int k = 0; k < 2; ++k) \
        acc[ai][bj][m][n] = __builtin_amdgcn_mfma_f32_16x16x32_bf16(Bt[n][k], At[m][k], acc[ai][bj][m][n], 0, 0, 0); __builtin_amdgcn_s_setprio(0); } while (0)
#define PG8_WAIT_V(n) asm volatile("s_waitcnt vmcnt(" #n ")" ::: "memory")
#define PG8_WAIT_L(n) asm volatile("s_waitcnt lgkmcnt(" #n ")" ::: "memory")
#define PG8_BAR __builtin_amdgcn_s_barrier()
#define PG8_SCHED __builtin_amdgcn_sched_barrier(0)
    Unit cur, nxt; int ui = 0;
    if (!S.next(0, cur)) return;
    f32x4 acc[2][2][4][2];
#pragma unroll
    for (int a = 0; a < 2; ++a)
#pragma unroll
        for (int b = 0; b < 2; ++b)
#pragma unroll
            for (int m = 0; m < 4; ++m)
#pragma unroll
                for (int n = 0; n < 2; ++n) acc[a][b][m][n] = (f32x4){0.f, 0.f, 0.f, 0.f};
    bf16x8 At[4][2], B0[2][2], B1[2][2];
    const char* cA = (const char*)g.A + (size_t)cur.pm * tstep; const char* cB = (const char*)g.Bt + (size_t)cur.pn * tstep;
    S.a_ready(cur);
    if constexpr (SP2) {
        PG8_STAGE(PG8_SB(0, 0), cB, voffB); PG8_STAGE(PG8_SB(0, 1), cB + hstep, voffB); PG8_STAGE(PG8_SA(0, 0), cA, voffA); PG8_STAGE(PG8_SA(0, 1), cA + hstep, voffA);
        if (wr == 1) PG8_BAR;
        PG8_WAIT_V(2); PG8_BAR;
        PG8_STAGE(PG8_SB(1, 0), cB + kstep, voffB); PG8_STAGE(PG8_SA(1, 0), cA + kstep, voffA); PG8_STAGE(PG8_SB(1, 1), cB + hstep + kstep, voffB);
        PG8_WAIT_V(6); PG8_BAR;
    } else {
        PG8_STAGE(PG8_SB(0, 0), cB, voffB); PG8_STAGE(PG8_SA(0, 0), cA, voffA); PG8_STAGE(PG8_SB(0, 1), cB + hstep, voffB); PG8_STAGE(PG8_SA(0, 1), cA + hstep, voffA);
        if (wr == 1) PG8_BAR;
        PG8_WAIT_V(4); PG8_BAR;
        PG8_STAGE(PG8_SB(1, 0), cB + kstep, voffB); PG8_STAGE(PG8_SA(1, 0), cA + kstep, voffA); PG8_STAGE(PG8_SB(1, 1), cB + hstep + kstep, voffB);
        PG8_WAIT_V(6); PG8_BAR;
    }
    for (;;) {
        const bool has_next = S.next(ui + 1, nxt);
        const char* nA = has_next ? (const char*)g.A + (size_t)nxt.pm * tstep : cA; const char* nB = has_next ? (const char*)g.Bt + (size_t)nxt.pn * tstep : cB;
        for (int t = 0; t < nt; t += 2) {
            const bool last = (t == nt - 2);
            const char* a1 = cA + (size_t)(t + 1) * kstep;
            const char* a2 = last ? nA : cA + (size_t)(t + 2) * kstep; const char* b2 = last ? nB : cB + (size_t)(t + 2) * kstep;
            const char* a3 = a2 + kstep; const char* b3 = b2 + kstep;
            if (last && has_next) S.a_ready(nxt);
            if constexpr (SP2) {
            PG8_LDB(B0, 0, 0); PG8_LDB(B1, 0, 1); PG8_SCHED; PG8_LDA(At, 0, 0); PG8_STAGE(PG8_SA(1, 1), a1 + hstep, voffA);
            PG8_WAIT_V(8); PG8_WAIT_L(0); PG8_BAR; PG8_MMA(0, 0, At, B0); PG8_MMA(0, 1, At, B1); PG8_BAR; PG8_SCHED;
            PG8_LDA(At, 0, 1); PG8_STAGE(PG8_SB(0, 0), b2, voffB); PG8_STAGE(PG8_SB(0, 1), b2 + hstep, voffB); PG8_STAGE(PG8_SA(0, 0), a2, voffA);
            PG8_WAIT_V(8); PG8_WAIT_L(0); PG8_BAR; PG8_MMA(1, 0, At, B0); PG8_MMA(1, 1, At, B1); PG8_BAR; PG8_SCHED;
            PG8_LDB(B0, 1, 0); PG8_LDB(B1, 1, 1); PG8_SCHED; PG8_LDA(At, 1, 0); PG8_STAGE(PG8_SA(0, 1), a2 + hstep, voffA);
            PG8_WAIT_V(8); PG8_WAIT_L(0); PG8_BAR; PG8_MMA(0, 0, At, B0); PG8_MMA(0, 1, At, B1); PG8_BAR; PG8_SCHED;
            PG8_LDA(At, 1, 1); PG8_STAGE(PG8_SB(1, 0), b3, voffB); PG8_STAGE(PG8_SB(1, 1), b3 + hstep, voffB); PG8_STAGE(PG8_SA(1, 0), a3, voffA);
            PG8_WAIT_V(8); PG8_WAIT_L(0); PG8_BAR; PG8_MMA(1, 0, At, B0); PG8_MMA(1, 1, At, B1); PG8_BAR; PG8_SCHED;
            } else {
            PG8_LDB(B0, 0, 0); PG8_SCHED; PG8_LDA(At, 0, 0); PG8_STAGE(PG8_SA(1, 1), a1 + hstep, voffA);
            PG8_WAIT_L(8); PG8_BAR; PG8_WAIT_L(0); PG8_MMA(0, 0, At, B0); PG8_BAR; PG8_SCHED;
            PG8_LDB(B1, 0, 1); PG8_STAGE(PG8_SB(0, 0), b2, voffB);
            PG8_BAR; PG8_WAIT_L(0); PG8_MMA(0, 1, At, B1); PG8_BAR;
            PG8_LDA(At, 0, 1); PG8_STAGE(PG8_SA(0, 0), a2, voffA);
            PG8_BAR; PG8_WAIT_L(0); PG8_MMA(1, 0, At, B0); PG8_BAR; PG8_SCHED;
            PG8_STAGE(PG8_SB(0, 1), b2 + hstep, voffB);
            PG8_WAIT_V(6); PG8_BAR; PG8_MMA(1, 1, At, B1); PG8_BAR;
            PG8_LDB(B0, 1, 0); PG8_SCHED; PG8_LDA(At, 1, 0); PG8_STAGE(PG8_SA(0, 1), a2 + hstep, voffA);
            PG8_WAIT_L(8); PG8_BAR; PG8_WAIT_L(0); PG8_MMA(0, 0, At, B0); PG8_BAR; PG8_SCHED;
            PG8_LDB(B1, 1, 1); PG8_STAGE(PG8_SB(1, 0), b3, voffB);
            PG8_BAR; PG8_WAIT_L(0); PG8_MMA(0, 1, At, B1); PG8_BAR;
            PG8_LDA(At, 1, 1); PG8_STAGE(PG8_SA(1, 0), a3, voffA);
            PG8_BAR; PG8_WAIT_L(0); PG8_MMA(1, 0, At, B0); PG8_BAR; PG8_SCHED;
            PG8_STAGE(PG8_SB(1, 1), b3 + hstep, voffB);
            PG8_WAIT_V(6); PG8_BAR; PG8_MMA(1, 1, At, B1); PG8_BAR;
            }
        }
        if constexpr (ALIGN_EPI) { if (wr == 0) PG8_BAR; }
        if constexpr (!Epi::AFTER_DRAIN) { E(acc, cur, wr, wc, fr, fq); S.done(cur); }
        if (!has_next) break;
#pragma unroll
        for (int a = 0; a < 2; ++a)
#pragma unroll
            for (int b = 0; b < 2; ++b)
#pragma unroll
                for (int m = 0; m < 4; ++m)
#pragma unroll
                    for (int n = 0; n < 2; ++n) acc[a][b][m][n] = (f32x4){0.f, 0.f, 0.f, 0.f};
        cur = nxt; cA = nA; cB = nB; ++ui;
        if constexpr (ALIGN_EPI) { if (wr == 1) PG8_BAR; }
    }
    PG8_WAIT_V(0);
    if constexpr (!ALIGN_EPI) { if (wr == 0) PG8_BAR; }
    PG8_BAR;
    if constexpr (Epi::AFTER_DRAIN) { E.fused(acc, cur, wr, wc, fr, fq, lds, wid, lane); S.done(cur); }
#undef PG8_SA
#undef PG8_SB
#undef PG8_STAGE
#undef PG8_LDA
#undef PG8_LDB
#undef PG8_MMA
#undef PG8_WAIT_V
#undef PG8_WAIT_L
#undef PG8_BAR
#undef PG8_SCHED
}
}
typedef unsigned short bf16;
#define LAS __attribute__((address_space(3)))
constexpr int T_TOK = 32768, DM = 2048, SEQ = 4096, NBATCH = 8, DEPTH = 4;
constexpr int IN_COLS = 13336, NP = 13568;
constexpr int C_MQ = 0, C_MK = 512, C_MV = 1024, C_MO = 2048, C_SZ = 3072, C_SXBC = 4096, C_AQ = 5632, C_AK = 6656, C_AV = 6912, C_G = 7168, C_SMALL = 13312;
constexpr int GATE_TILE_LO = C_G / 256, SMALL_TILE = C_SMALL / 256;
constexpr float ALPHA = 1.681792830507429f;
constexpr int P_EXPERTS = 16384;

constexpr size_t MiB = 1u << 20;
constexpr size_t WS_CTL = 0, CTL_ZERO_BYTES = 64 * 1024, WS_WIN = 1 * MiB, WS_WB = 54 * MiB, WS_WO = 66 * MiB, WS_WQ = 74 * MiB, WS_BIAS = 82 * MiB, WS_SKB = 82 * MiB + 256 * 1024, WS_SMALL = 83 * MiB, WS_ROPE = 87 * MiB,
                 WS_XB = 88 * MiB, WS_BUFB = 216 * MiB, WS_PROJ = 472 * MiB, WS_R1 = 1320 * MiB, WS_Y = 1480 * MiB, WS_R2 = 1672 * MiB, WS_HM = 1864 * MiB, WS_END = 1992 * MiB;
constexpr size_t WS_QF = WS_PROJ, WS_IDS = WS_PROJ + 256 * MiB, WS_GATES = WS_PROJ + 272 * MiB;
constexpr int CW_BAR = 4096;
constexpr int RING_BYTES = 131072, PHASE_LDS_BYTES = 155648, MISC_OFF = PHASE_LDS_BYTES + 320, LDS_BYTES = 163840;

__device__ __forceinline__ unsigned f2bf(float f) { unsigned u = __float_as_uint(f); return (u + 0x7fffu + ((u >> 16) & 1u)) >> 16; }
__device__ __forceinline__ unsigned pk2(float lo, float hi) { return f2bf(lo) | (f2bf(hi) << 16); }
__device__ __forceinline__ float bf2f(bf16 b) { return __uint_as_float(((unsigned)b) << 16); }
__device__ __forceinline__ float sigm(float x) { return 1.0f / (1.0f + expf(-x)); }
template <int CTRL> __device__ __forceinline__ float dpp_f(float v) { return __builtin_bit_cast(float, __builtin_amdgcn_update_dpp(0, __builtin_bit_cast(int, v), CTRL, 0xF, 0xF, true)); }
__device__ __forceinline__ float quad_sum(float v) { v += dpp_f<0xB1>(v); v += dpp_f<0x4E>(v); return v; }
__device__ __forceinline__ float wave_sum(float v) {
    v = quad_sum(v); v += dpp_f<0x141>(v); v += dpp_f<0x140>(v);
    v += __builtin_bit_cast(float, __builtin_amdgcn_ds_swizzle(__builtin_bit_cast(int, v), 0x401F));
    return __builtin_bit_cast(float, __builtin_amdgcn_readlane(__builtin_bit_cast(int, v), 0)) + __builtin_bit_cast(float, __builtin_amdgcn_readlane(__builtin_bit_cast(int, v), 32));
}
__device__ __forceinline__ int src_col(int n) {
    if (n < 3072) return n;
    if (n < 5632) return n + 8;
    if (n < 13312) return n + 24;
    if (n < 13320) return 3072 + (n - 13312);
    if (n < 13336) return 5640 + (n - 13320);
    return -1;
}

#define XB_TMO      128
#define XB_XCNT(j)  (256  + 64 * (j))
#define XB_XSUB(j)  (1280 + 64 * (j))
#define XB_XGEN(j)  (2304 + 64 * (j))
#define XB_TOP      3328
#define XB_TOPGEN   3392
#define XCD_BAR_WORDS 3456
#define XB_SPIN_CAP (1u << 18)

__device__ __forceinline__ unsigned xb_ld(unsigned* p)              { return __hip_atomic_load(p, __ATOMIC_RELAXED, __HIP_MEMORY_SCOPE_AGENT); }
__device__ __forceinline__ unsigned xb_add(unsigned* p, unsigned v) { return __hip_atomic_fetch_add(p, v, __ATOMIC_RELAXED, __HIP_MEMORY_SCOPE_AGENT); }
__device__ __forceinline__ unsigned xb_xcc_id() { return (unsigned)__builtin_amdgcn_s_getreg((3 << 11) | 20) & 0xFu; }
#define XB_SPIN(cond, bar) do { unsigned _sp = 0; while (cond) { __builtin_amdgcn_s_sleep(1); \
    if ((++_sp & 255u) == 0u) { if (xb_ld(&(bar)[XB_TMO])) break; if (_sp > XB_SPIN_CAP) { atomicAdd(&(bar)[XB_TMO], 1u); break; } } } } while (0)

struct XcdBarrier {
    unsigned* bar; unsigned x;
    volatile LAS unsigned* st;
};

__device__ __forceinline__ XcdBarrier xcd_barrier_post(unsigned* bar, volatile LAS unsigned* st) {
    XcdBarrier b; b.bar = bar; b.x = xb_xcc_id(); b.st = st;
    if (threadIdx.x == 0) (void)xb_add(&bar[XB_XCNT(b.x)], 1u);
    return b;
}
__device__ __forceinline__ void xcd_barrier_complete(unsigned* bar, unsigned x, unsigned& nloc, unsigned& nx) {
    const unsigned G = gridDim.x * gridDim.y * gridDim.z;
    unsigned sum, cnt, mine, sp = 0u;
    for (;;) {
        sum = 0u; cnt = 0u; mine = 0u;
#pragma unroll
        for (unsigned j = 0; j < 16; ++j) { const unsigned c = xb_ld(&bar[XB_XCNT(j)]); sum += c; cnt += (c > 0u) ? 1u : 0u; mine = (j == x) ? c : mine; }
        if (sum == G) break;
        __builtin_amdgcn_s_sleep(1);
        if ((++sp & 255u) == 0u) { if (xb_ld(&bar[XB_TMO])) break; if (sp > XB_SPIN_CAP) { atomicAdd(&bar[XB_TMO], 1u); break; } }
    }
    nloc = mine > 0u ? mine : 1u; nx = cnt > 0u ? cnt : 1u;
}

__device__ __forceinline__ void xcd_barrier(const XcdBarrier& b) {
    asm volatile("s_waitcnt vmcnt(0)" ::: "memory");
    __syncthreads();
    if (threadIdx.x == 0) {
        unsigned* bar = b.bar;
        __builtin_amdgcn_s_waitcnt(0);
        unsigned nloc = b.st[0], nx = b.st[1];
        if (nloc == 0u) { xcd_barrier_complete(bar, b.x, nloc, nx); b.st[0] = nloc; b.st[1] = nx; }
        const unsigned old = xb_add(&bar[XB_XSUB(b.x)], 1u);
        const unsigned gen = old / nloc;
        if (old + 1u == (gen + 1u) * nloc) {
            __builtin_amdgcn_fence(__ATOMIC_RELEASE, "agent");
            asm volatile("s_waitcnt vmcnt(0)" ::: "memory");
            const unsigned og = xb_add(&bar[XB_TOP], 1u);
            const unsigned tg = og / nx;
            if (og + 1u == (tg + 1u) * nx) xb_add(&bar[XB_TOPGEN], 1u);
            else XB_SPIN(xb_ld(&bar[XB_TOPGEN]) == tg, bar);
            __builtin_amdgcn_fence(__ATOMIC_ACQUIRE, "agent");
            xb_add(&bar[XB_XGEN(b.x)], 1u);
            asm volatile("s_waitcnt vmcnt(0)" ::: "memory");
        } else {
            XB_SPIN(xb_ld(&bar[XB_XGEN(b.x)]) == gen, bar);
            __builtin_amdgcn_fence(__ATOMIC_ACQUIRE, "agent");
            asm volatile("s_waitcnt vmcnt(0)" ::: "memory");
        }
    }
    __syncthreads();
}

__device__ __forceinline__ int fresh_tid(int wave0) { int l; asm volatile("v_mbcnt_lo_u32_b32 %0, -1, 0\n\tv_mbcnt_hi_u32_b32 %0, -1, %0" : "=v"(l)); return wave0 * 64 + l; }
#define PHASE_IDS int G = gridDim.x, bx = blockIdx.x; asm volatile("" : "+s"(G), "+s"(bx)); const int tid = fresh_tid(wave0), lane = tid & 63, wave = wave0; const int gw = bx * 8 + wave, NGW = G * 8; \
    const size_t gt = (size_t)bx * 512 + tid, NGT = (size_t)G * 512; (void)lane; (void)gw; (void)gt; (void)NGW; (void)NGT; (void)wave;

template <int MODE> __device__ __forceinline__ void transpose_item(const float* __restrict__ W, int K, int ldw, int ndst, bf16* __restrict__ WT, LAS float* scr, int item, int lane) {
    const int nblk = ndst / 32, kb = item / nblk, nb = item % nblk, k0 = 64 * kb, n0 = 32 * nb;
    const int n_l = n0 + (lane & 31); const int sc = MODE ? src_col(n_l) : n_l;
#pragma unroll 8
    for (int i = 0; i < 32; ++i) { const int kk = 2 * i + (lane >> 5); scr[kk * 33 + (lane & 31)] = sc >= 0 ? W[(size_t)(k0 + kk) * ldw + sc] : 0.f; }
    asm volatile("s_waitcnt lgkmcnt(0)" ::: "memory");
    const int c = lane & 7;
#pragma unroll
    for (int j = 0; j < 4; ++j) { const int n = (lane >> 3) + 8 * j; const LAS float* s = scr + (8 * c) * 33 + n;
        uint4 o; o.x = pk2(s[0 * 33], s[1 * 33]); o.y = pk2(s[2 * 33], s[3 * 33]); o.z = pk2(s[4 * 33], s[5 * 33]); o.w = pk2(s[6 * 33], s[7 * 33]);
        *(uint4*)(WT + (size_t)(n0 + n) * K + k0 + 8 * c) = o; }
    asm volatile("s_waitcnt lgkmcnt(0)" ::: "memory");
}

__device__ __forceinline__ void mlstm_post_body(int w, int lane, const float* __restrict__ hm, const bf16* __restrict__ proj, const float* __restrict__ norm_w, bf16* __restrict__ ym) {
    const int h = w & 3, t = w >> 2;
    const float4 x = *(const float4*)(hm + (size_t)t * 1024 + h * 256 + lane * 4);
    const float mu = wave_sum((x.x + x.y) + (x.z + x.w)) * (1.0f / 256.0f);
    const float d0 = x.x - mu, d1 = x.y - mu, d2 = x.z - mu, d3 = x.w - mu;
    const float var = wave_sum((d0 * d0 + d1 * d1) + (d2 * d2 + d3 * d3)) * (1.0f / 256.0f);
    const float rs = rsqrtf(var + 1e-6f);
    const int c = h * 256 + lane * 4;
    const float4 nw = *(const float4*)(norm_w + c);
    const bf16* op = proj + (size_t)t * NP + C_MO + c;
    const float y0 = d0 * rs * nw.x * sigm(bf2f(op[0])), y1 = d1 * rs * nw.y * sigm(bf2f(op[1])), y2 = d2 * rs * nw.z * sigm(bf2f(op[2])), y3 = d3 * rs * nw.w * sigm(bf2f(op[3]));
    *(uint2*)(ym + (size_t)t * 1024 + c) = make_uint2(pk2(y0, y1), pk2(y2, y3));
}

__device__ __forceinline__ void ssd_conv_body(size_t gid, const bf16* __restrict__ proj, const float* __restrict__ cw, const float* __restrict__ cb, bf16* __restrict__ xcb) {
    const int c = (int)(gid % 768) * 2; const int t = (int)(gid / 768); const int pos = t % SEQ;
    float a0 = cb[c], a1 = cb[c + 1];
#pragma unroll
    for (int j = 0; j < 4; ++j) { const int pp = pos - 3 + j; if (pp >= 0) { const unsigned v = *(const unsigned*)(proj + (size_t)(t - 3 + j) * NP + C_SXBC + c); a0 += cw[j * 1536 + c] * __uint_as_float(v << 16); a1 += cw[j * 1536 + c + 1] * __uint_as_float(v & 0xffff0000u); } }
    *(unsigned*)(xcb + (size_t)t * 1536 + c) = pk2(a0 * sigm(a0), a1 * sigm(a1));
}
__device__ __forceinline__ void ssd_post_body(int w, int lane, const float* __restrict__ yraw, const bf16* __restrict__ proj, const float* __restrict__ norm_w, bf16* __restrict__ ys) {
    const int g = w & 1, t = w >> 1, c = g * 512 + lane * 8;
    float y[8]; float ss = 0.f;
#pragma unroll
    for (int i = 0; i < 8; ++i) { const float z = bf2f(proj[(size_t)t * NP + C_SZ + c + i]); y[i] = yraw[(size_t)t * 1024 + c + i] * (z * sigm(z)); ss += y[i] * y[i]; }
    const float rs = rsqrtf(wave_sum(ss) * (1.0f / 512.0f) + 1e-6f);
    unsigned o[4];
#pragma unroll
    for (int i = 0; i < 4; ++i) o[i] = pk2(y[2 * i] * rs * norm_w[c + 2 * i], y[2 * i + 1] * rs * norm_w[c + 2 * i + 1]);
    *(uint4*)(ys + (size_t)t * 1024 + c) = make_uint4(o[0], o[1], o[2], o[3]);
}

__device__ __forceinline__ void ln_body(int t, int lane, const float* in, const float* __restrict__ g, const float* __restrict__ bta, float* outf, bf16* __restrict__ outb) {
    float4 v[8]; float s = 0.f;
#pragma unroll
    for (int j = 0; j < 8; ++j) { v[j] = *(const float4*)(in + (size_t)t * DM + j * 256 + lane * 4); s += (v[j].x + v[j].y) + (v[j].z + v[j].w); }
    const float mu = wave_sum(s) * (1.0f / DM); float q = 0.f;
#pragma unroll
    for (int j = 0; j < 8; ++j) { v[j].x -= mu; v[j].y -= mu; v[j].z -= mu; v[j].w -= mu; q += (v[j].x * v[j].x + v[j].y * v[j].y) + (v[j].z * v[j].z + v[j].w * v[j].w); }
    const float rs = rsqrtf(wave_sum(q) * (1.0f / DM) + 1e-5f);
    { int z_ = 0; asm volatile("" : "+s"(z_)); g += z_; bta += z_; }
#pragma unroll
    for (int j = 0; j < 8; ++j) { const int c = j * 256 + lane * 4; const float4 gg = *(const float4*)(g + c), bb = *(const float4*)(bta + c);
        float4 y; y.x = v[j].x * rs * gg.x + bb.x; y.y = v[j].y * rs * gg.y + bb.y; y.z = v[j].z * rs * gg.z + bb.z; y.w = v[j].w * rs * gg.w + bb.w;
        *(float4*)(outf + (size_t)t * DM + c) = y; *(uint2*)(outb + (size_t)t * DM + c) = make_uint2(pk2(y.x, y.y), pk2(y.z, y.w)); }
}

__device__ __forceinline__ float gelu_erf(float v) {
    const float av = fabsf(v), t = __builtin_amdgcn_rcpf(av * 0.2316418882f + 1.0f);
    float q = t * 0.5307027145f + (-0.7265760135f); q = q * t + 0.7107068705f; q = q * t + (-0.142248368f); q = q * t + 0.127414796f; q = q * t;
    const float e = __builtin_amdgcn_exp2f((v * v) * (-0.72134752044f));
    const float mm = v * (q * e), r = v - mm;
    return v < 0.f ? mm : r;
}
typedef unsigned u32x4e_t __attribute__((ext_vector_type(4)));
constexpr float U6_SCALE = 64.0f, V6_SCALE = 8.0f;
constexpr int ROW6 = DM * 6 / 8;
typedef float v32f_t __attribute__((ext_vector_type(32)));
typedef __bf16 v32b_t __attribute__((ext_vector_type(32)));
typedef unsigned v6u_t __attribute__((ext_vector_type(6)));
__device__ __forceinline__ void tab_to_fp6(size_t i, const float* __restrict__ src, unsigned char* __restrict__ dst, float sc) {
    const float4* s = (const float4*)src + i * 8; v32b_t b;
#pragma unroll
    for (int j = 0; j < 8; ++j) { const float4 v = s[j]; b[4 * j] = (__bf16)(v.x * sc); b[4 * j + 1] = (__bf16)(v.y * sc); b[4 * j + 2] = (__bf16)(v.z * sc); b[4 * j + 3] = (__bf16)(v.w * sc); }
    const v6u_t p = __builtin_amdgcn_cvt_scalef32_pk32_fp6_bf16(b, 1.0f);
    uint2* d = (uint2*)(dst + i * 24); d[0] = make_uint2(p[0], p[1]); d[1] = make_uint2(p[2], p[3]); d[2] = make_uint2(p[4], p[5]);
}
__device__ __forceinline__ void peer_expert_body(int t, int lane, const float* __restrict__ x1, const int* __restrict__ ids, const float* __restrict__ gates, const unsigned char* __restrict__ U6, const unsigned char* __restrict__ V6,
                                                 const float* __restrict__ g, const float* __restrict__ bta, float* __restrict__ outf, bf16* outb  , LAS unsigned* wl  ) {
    asm volatile("" : "+v"(lane));
    int idA = ids[(size_t)t * 128 + lane], idB = ids[(size_t)t * 128 + 64 + lane]; float gA = gates[(size_t)t * 128 + lane], gB = gates[(size_t)t * 128 + 64 + lane];
    {
        const unsigned kA = ((unsigned)idA << 7) | (unsigned)lane, kB = ((unsigned)idB << 7) | (unsigned)(64 + lane);
        wl[lane] = kA; wl[64 + lane] = kB;
        asm volatile("s_waitcnt lgkmcnt(0)" ::: "memory");
        int rA = 0, rB = 0;
#pragma unroll 8
        for (int j = 0; j < 128; j += 4) { const u32x4e_t k4 = *(const LAS u32x4e_t*)(wl + j);
#pragma unroll
            for (int q = 0; q < 4; ++q) { rA += (k4[q] < kA) ? 1 : 0; rB += (k4[q] < kB) ? 1 : 0; } }
        asm volatile("s_waitcnt lgkmcnt(0)" ::: "memory");
        wl[128 + rA] = (unsigned)idA; wl[256 + rA] = __float_as_uint(gA); wl[128 + rB] = (unsigned)idB; wl[256 + rB] = __float_as_uint(gB);
        asm volatile("s_waitcnt lgkmcnt(0)" ::: "memory");
        idA = (int)wl[128 + lane]; idB = (int)wl[192 + lane]; gA = __uint_as_float(wl[256 + lane]); gB = __uint_as_float(wl[320 + lane]);
        asm volatile("s_waitcnt lgkmcnt(0)" ::: "memory");
    }
#define ID_OF(e_) __builtin_amdgcn_readlane((e_) < 64 ? idA : idB, (e_) & 63)
#define GATE_OF(e_) __builtin_bit_cast(float, __builtin_amdgcn_readlane(__builtin_bit_cast(int, (e_) < 64 ? gA : gB), (e_) & 63))
    uint2 ra[8][3], rb[8][3];
#define ROW_LOAD(R_, T_, e_) do { _Pragma("unroll") for (int k_ = 0; k_ < 8; ++k_) { const int id_ = ID_OF((e_) + k_); \
        const uint2* p_ = (const uint2*)((T_) + (size_t)id_ * ROW6) + lane * 3; R_[k_][0] = p_[0]; R_[k_][1] = p_[1]; R_[k_][2] = p_[2]; } } while (0)
#define PK6(W_) ((v6u_t){W_[0].x, W_[0].y, W_[1].x, W_[1].y, W_[2].x, W_[2].y})
#define SB_ __builtin_amdgcn_sched_barrier(0)
    float c0 = 0.f, c1 = 0.f;
    {
        unsigned xb[16];
#pragma unroll
        for (int i = 0; i < 4; ++i) { const uint4 v = *(const uint4*)(outb + (size_t)t * DM + lane * 32 + i * 8); xb[4 * i] = v.x; xb[4 * i + 1] = v.y; xb[4 * i + 2] = v.z; xb[4 * i + 3] = v.w; }
#define U_COMP(R_, e_) do { _Pragma("unroll") for (int k_ = 0; k_ < 8; ++k_) { SB_; const v32f_t d_ = __builtin_amdgcn_cvt_scalef32_pk32_f32_fp6(PK6(R_[k_]), 1.0f); float a_ = 0.f, b_ = 0.f; \
            _Pragma("unroll") for (int i_ = 0; i_ < 16; ++i_) { a_ += d_[2 * i_] * __uint_as_float(xb[i_] << 16); b_ += d_[2 * i_ + 1] * __uint_as_float(xb[i_] & 0xffff0000u); } \
            const float s_ = wave_sum(a_ + b_) * (1.0f / U6_SCALE); const float cv_ = GATE_OF((e_) + k_) * (1.0f / V6_SCALE) * gelu_erf(s_); \
            const int ee_ = (e_) + k_; c0 = (lane == ee_) ? cv_ : c0; c1 = (lane == ee_ - 64) ? cv_ : c1; } SB_; } while (0)
        ROW_LOAD(ra, U6, 0);
#pragma nounroll
        for (int e = 0; e < 128; e += 16) {
            ROW_LOAD(rb, U6, e + 8);
            U_COMP(ra, e);
            if (e + 16 < 128) ROW_LOAD(ra, U6, e + 16);
            U_COMP(rb, e + 8);
        }
#undef U_COMP
    }
    v32f_t acc;
#pragma unroll
    for (int i = 0; i < 32; ++i) acc[i] = 0.f;
#define V_COMP(R_, e_) do { _Pragma("unroll") for (int k_ = 0; k_ < 8; ++k_) { SB_; const int ee_ = (e_) + k_; \
            const float cv_ = __builtin_bit_cast(float, __builtin_amdgcn_readlane(__builtin_bit_cast(int, ee_ < 64 ? c0 : c1), ee_ & 63)); \
            acc += __builtin_amdgcn_cvt_scalef32_pk32_f32_fp6(PK6(R_[k_]), 1.0f) * cv_; } SB_; } while (0)
    ROW_LOAD(ra, V6, 0);
#pragma nounroll
    for (int e = 0; e < 128; e += 16) {
        ROW_LOAD(rb, V6, e + 8);
        V_COMP(ra, e);
        if (e + 16 < 128) ROW_LOAD(ra, V6, e + 16);
        V_COMP(rb, e + 8);
    }
#undef V_COMP
#undef ID_OF
#undef GATE_OF
#undef ROW_LOAD
#undef PK6
#undef SB_
    float s = 0.f;
#pragma unroll
    for (int i = 0; i < 8; ++i) { const float4 v = *(const float4*)(x1 + (size_t)t * DM + lane * 32 + i * 4); acc[4 * i] += ALPHA * v.x; acc[4 * i + 1] += ALPHA * v.y; acc[4 * i + 2] += ALPHA * v.z; acc[4 * i + 3] += ALPHA * v.w; }
#pragma unroll
    for (int i = 0; i < 32; ++i) s += acc[i];
    const float mu = wave_sum(s) * (1.0f / DM); float q = 0.f;
#pragma unroll
    for (int i = 0; i < 32; ++i) { acc[i] -= mu; q += acc[i] * acc[i]; }
    const float rs = rsqrtf(wave_sum(q) * (1.0f / DM) + 1e-5f);
    { int z_ = 0; asm volatile("" : "+s"(z_)); g += z_; bta += z_; }
#pragma unroll
    for (int i = 0; i < 8; ++i) { const int c = lane * 32 + i * 4; const float4 gg = *(const float4*)(g + c), bb = *(const float4*)(bta + c);
        float4 y; y.x = acc[4 * i] * rs * gg.x + bb.x; y.y = acc[4 * i + 1] * rs * gg.y + bb.y; y.z = acc[4 * i + 2] * rs * gg.z + bb.z; y.w = acc[4 * i + 3] * rs * gg.w + bb.w;
        *(float4*)(outf + (size_t)t * DM + c) = y; *(uint2*)(outb + (size_t)t * DM + c) = make_uint2(pk2(y.x, y.y), pk2(y.z, y.w)); }
}

typedef short bf16x8_t __attribute__((ext_vector_type(8)));
typedef float f32x4_t __attribute__((ext_vector_type(4)));
typedef unsigned u32x2_t __attribute__((ext_vector_type(2)));
typedef unsigned u32x4_t __attribute__((ext_vector_type(4)));
constexpr int SWA_PITCH = 144;
constexpr int SWA_KS = 0, SWA_VS = 256 * SWA_PITCH, SWA_LDS = 2 * 256 * SWA_PITCH;
static_assert(SWA_LDS <= RING_BYTES, "SWA LDS");
__device__ __forceinline__ float grp4_max(float v) {
    v = fmaxf(v, __builtin_bit_cast(float, __builtin_amdgcn_ds_swizzle(__builtin_bit_cast(int, v), 0x401F)));
    const u32x2_t r = __builtin_amdgcn_permlane32_swap(__builtin_bit_cast(unsigned, v), __builtin_bit_cast(unsigned, v), false, false);
    return fmaxf(__builtin_bit_cast(float, r.x), __builtin_bit_cast(float, r.y));
}
__device__ __forceinline__ float grp4_sum(float v) {
    v += __builtin_bit_cast(float, __builtin_amdgcn_ds_swizzle(__builtin_bit_cast(int, v), 0x401F));
    const u32x2_t r = __builtin_amdgcn_permlane32_swap(__builtin_bit_cast(unsigned, v), __builtin_bit_cast(unsigned, v), false, false);
    return __builtin_bit_cast(float, r.x) + __builtin_bit_cast(float, r.y);
}
__device__ __forceinline__ void tr_read2(unsigned a0, unsigned a1, u32x2_t& r0, u32x2_t& r1) {
    asm volatile("ds_read_b64_tr_b16 %0, %2\n\tds_read_b64_tr_b16 %1, %3\n\ts_waitcnt lgkmcnt(0)" : "=&v"(r0), "=&v"(r1) : "v"(a0), "v"(a1) : "memory");
}
__device__ __forceinline__ void rope8(uint4& lo, uint4& hi, const float4* cs, float scale) {
    unsigned* a = (unsigned*)&lo; unsigned* b = (unsigned*)&hi;
#pragma unroll
    for (int j = 0; j < 4; ++j) {
        const float x1a = __uint_as_float(a[j] << 16), x1b = __uint_as_float(a[j] & 0xffff0000u), x2a = __uint_as_float(b[j] << 16), x2b = __uint_as_float(b[j] & 0xffff0000u);
        const float4 c = cs[j];
        const float y1a = (x1a * c.x - x2a * c.y) * scale, y2a = (x2a * c.x + x1a * c.y) * scale, y1b = (x1b * c.z - x2b * c.w) * scale, y2b = (x2b * c.z + x1b * c.w) * scale;
        a[j] = pk2(y1a, y1b); b[j] = pk2(y2a, y2b);
    }
}
__device__ __forceinline__ void swa_phase(LAS unsigned char* lds, const bf16* __restrict__ proj, const float* __restrict__ rtab  , const float* __restrict__ sinks, bf16* __restrict__ ya,
                                          int tid, int bx, int G) {
    const int lane = tid & 63, w = __builtin_amdgcn_readfirstlane(tid >> 6), l15 = lane & 15, g4 = lane >> 4;
    const unsigned ldsb = (unsigned)(size_t)lds;
    for (int u = bx; u < NBATCH * 32 * 4; u += G) {
        const int kvh = u & 3, nb = (u >> 2) & 31, b = u >> 7;
        const int t0 = b * SEQ + nb * 128;
        __syncthreads();
        for (int it = tid; it < 1024; it += 512) { const int kk = it >> 2, c = it & 3;
            uint4 lo = make_uint4(0u, 0u, 0u, 0u), hi = lo;
            if (nb > 0 || kk >= 128) { const bf16* src = proj + (size_t)(t0 - 128 + kk) * NP + C_AK + kvh * 64 + 8 * c; lo = *(const uint4*)src; hi = *(const uint4*)(src + 32);
                const float4* cs = (const float4*)(rtab + ((size_t)(nb * 128 - 128 + kk) * 32 + 8 * c) * 2); const float4 c4[4] = {cs[0], cs[1], cs[2], cs[3]}; rope8(lo, hi, c4, 1.0f); }
            *(LAS u32x4_t*)(lds + SWA_KS + kk * SWA_PITCH + 16 * c) = __builtin_bit_cast(u32x4_t, lo); *(LAS u32x4_t*)(lds + SWA_KS + kk * SWA_PITCH + 64 + 16 * c) = __builtin_bit_cast(u32x4_t, hi); }
        for (int it = tid; it < 2048; it += 512) { const int kk = it >> 3, c = it & 7;
            uint4 v = make_uint4(0u, 0u, 0u, 0u);
            if (nb > 0 || kk >= 128) v = *(const uint4*)(proj + (size_t)(t0 - 128 + kk) * NP + C_AV + kvh * 64 + 8 * c);
            *(LAS u32x4_t*)(lds + SWA_VS + kk * SWA_PITCH + 16 * c) = __builtin_bit_cast(u32x4_t, v); }
        __syncthreads();
        const int r = w >> 1, hf = w & 1, hq = kvh * 4 + r;
        const float sink = sinks[hq];
#pragma nounroll
        for (int qt = 0; qt < 4; ++qt) {
            const int i0 = 64 * hf + 16 * qt, iq = i0 + l15, tq = t0 + iq, ktb0 = 4 * hf + qt;
            bf16x8_t q0, q1;
            { const bf16* src = proj + (size_t)tq * NP + C_AQ + hq * 64 + 8 * g4; uint4 lo = *(const uint4*)src, hi = *(const uint4*)(src + 32);
              const float4* cs = (const float4*)(rtab + ((size_t)(nb * 128 + iq) * 32 + 8 * g4) * 2); const float4 c4[4] = {cs[0], cs[1], cs[2], cs[3]}; rope8(lo, hi, c4, 0.125f);
              q0 = __builtin_bit_cast(bf16x8_t, lo); q1 = __builtin_bit_cast(bf16x8_t, hi); }
            f32x4_t s[10]; float m = sink;
#pragma unroll
            for (int n = 0; n < 10; ++n) {
                const int kt = (ktb0 + n) < 15 ? (ktb0 + n) : 15;
                const LAS unsigned char* kp = lds + SWA_KS + (16 * kt + l15) * SWA_PITCH + 16 * g4;
                const bf16x8_t a0 = *(const LAS bf16x8_t*)kp, a1 = *(const LAS bf16x8_t*)(kp + 64);
                f32x4_t acc = (f32x4_t){0.f, 0.f, 0.f, 0.f};
                acc = __builtin_amdgcn_mfma_f32_16x16x32_bf16(a0, q0, acc, 0, 0, 0);
                acc = __builtin_amdgcn_mfma_f32_16x16x32_bf16(a1, q1, acc, 0, 0, 0);
#pragma unroll
                for (int e = 0; e < 4; ++e) { const int kk = 16 * (ktb0 + n) + 4 * g4 + e;
                    const bool ok = (kk >= iq + 1) && (kk <= iq + 128) && (nb > 0 || kk >= 128) && (ktb0 + n <= 15);
                    acc[e] = ok ? acc[e] : -1e30f; m = fmaxf(m, acc[e]); }
                s[n] = acc;
            }
            m = grp4_max(m);
            float lsum = 0.f;
#pragma unroll
            for (int n = 0; n < 10; ++n)
#pragma unroll
                for (int e = 0; e < 4; ++e) { const float p = __expf(s[n][e] - m); s[n][e] = p; lsum += p; }
            lsum = grp4_sum(lsum) + __expf(sink - m);
            const float inv = 1.0f / lsum;
            bf16x8_t pf[5];
#pragma unroll
            for (int pi = 0; pi < 5; ++pi) { uint4 w4; w4.x = pk2(s[2 * pi][0], s[2 * pi][1]); w4.y = pk2(s[2 * pi][2], s[2 * pi][3]); w4.z = pk2(s[2 * pi + 1][0], s[2 * pi + 1][1]); w4.w = pk2(s[2 * pi + 1][2], s[2 * pi + 1][3]);
                pf[pi] = __builtin_bit_cast(bf16x8_t, w4); }
            const int qq = l15 >> 2, pp = lane & 3;
#pragma unroll
            for (int dt = 0; dt < 4; ++dt) {
                f32x4_t o = (f32x4_t){0.f, 0.f, 0.f, 0.f};
#pragma unroll
                for (int pi = 0; pi < 5; ++pi) {
                    const int ka = (ktb0 + 2 * pi) < 15 ? (ktb0 + 2 * pi) : 15, kb = (ktb0 + 2 * pi + 1) < 15 ? (ktb0 + 2 * pi + 1) : 15;
                    u32x2_t v0, v1;
                    tr_read2(ldsb + SWA_VS + (16 * ka + 4 * g4 + qq) * SWA_PITCH + (16 * dt + 4 * pp) * 2, ldsb + SWA_VS + (16 * kb + 4 * g4 + qq) * SWA_PITCH + (16 * dt + 4 * pp) * 2, v0, v1);
                    const uint4 av = make_uint4(v0.x, v0.y, v1.x, v1.y);
                    o = __builtin_amdgcn_mfma_f32_16x16x32_bf16(__builtin_bit_cast(bf16x8_t, av), pf[pi], o, 0, 0, 0);
                }
                *(uint2*)(ya + (size_t)tq * 1024 + hq * 64 + 16 * dt + 4 * g4) = make_uint2(pk2(o[0] * inv, o[1] * inv), pk2(o[2] * inv, o[3] * inv));
            }
        }
    }
}

constexpr int ML_QP = 272, ML_VP = 112, ML_PP = 144;
constexpr int ML_Q = 0, ML_K = 2 * 64 * ML_QP, ML_V = ML_K + 2 * 64 * ML_QP, ML_VW = ML_V + 2 * 64 * ML_VP, ML_P = ML_VW + 64 * ML_VP, ML_CT = ML_P + 64 * ML_PP,
              ML_VEC = ML_CT + 48 * ML_QP, ML_END = ML_VEC + 4096;
static_assert(ML_END <= RING_BYTES, "mLSTM LDS");
__device__ __forceinline__ void tr_read2q(unsigned a0, unsigned a1, u32x2_t& r0, u32x2_t& r1) {
    asm volatile("ds_read_b64_tr_b16 %0, %2\n\tds_read_b64_tr_b16 %1, %3\n\ts_waitcnt lgkmcnt(0)" : "=&v"(r0), "=&v"(r1) : "v"(a0), "v"(a1) : "memory");
}
__device__ __forceinline__ bf16x8_t mk_frag(u32x2_t lo, u32x2_t hi) { const u32x4_t v = (u32x4_t){lo.x, lo.y, hi.x, hi.y}; return __builtin_bit_cast(bf16x8_t, v); }
#define LBAR() do { asm volatile("s_waitcnt lgkmcnt(0)" ::: "memory"); __builtin_amdgcn_s_barrier(); asm volatile("" ::: "memory"); } while (0)
__device__ __forceinline__ void mlstm_phase(LAS unsigned char* lds, const bf16* __restrict__ proj, const float* __restrict__ small, const float* __restrict__ gate_b, float* __restrict__ hm, int tid, int bx, int G) {
    const int lane = tid & 63, w = __builtin_amdgcn_readfirstlane(tid >> 6), l15 = lane & 15, g4 = lane >> 4, qq = l15 >> 2, pp = lane & 3;
    const unsigned ldsb = (unsigned)(size_t)lds;
    LAS float* vec = (LAS float*)(lds + ML_VEC);
    for (int u = bx; u < NBATCH * 4 * 8; u += G) {
        const int vs = u & 7, h = (u >> 3) & 3, b = u >> 5;
        const float bi = gate_b[h], bfg = gate_b[4 + h];
        LBAR();
        for (int i = tid; i < 2 * 64; i += 512) { LAS unsigned* p = (LAS unsigned*)(lds + ML_V + i * ML_VP + 64); p[0] = 0x00003F80u;
#pragma unroll
            for (int j = 1; j < 8; ++j) p[j] = 0u; }
        for (int i = tid; i < 48 * ML_QP / 4; i += 512) ((LAS unsigned*)(lds + ML_CT))[i] = 0u;
        f32x4_t cacc[3];
#pragma unroll
        for (int i = 0; i < 3; ++i) cacc[i] = (f32x4_t){0.f, 0.f, 0.f, 0.f};
        uint4 pq[2], pk[2], pv; float pgi = 0.f, pgf = 0.f;
        pv = make_uint4(0u, 0u, 0u, 0u);
#define ML_LOAD(c_) do { const size_t tb_ = (size_t)b * SEQ + (size_t)(c_) * 64; \
            _Pragma("unroll") for (int i_ = 0; i_ < 2; ++i_) { const int p_ = tid + 512 * i_, row_ = p_ >> 4, c16_ = p_ & 15; const bf16* s_ = proj + (tb_ + row_) * NP + h * 128 + c16_ * 8; pq[i_] = *(const uint4*)(s_ + C_MQ); pk[i_] = *(const uint4*)(s_ + C_MK); } \
            if (tid < 256) pv = *(const uint4*)(proj + (tb_ + (tid >> 2)) * NP + C_MV + h * 256 + vs * 32 + (tid & 3) * 8); \
            if (tid >= 256 && tid < 320) { pgi = small[(tb_ + (tid - 256)) * 32 + h]; pgf = small[(tb_ + (tid - 256)) * 32 + 4 + h]; } } while (0)
#define ML_STORE(bi_) do { _Pragma("unroll") for (int i_ = 0; i_ < 2; ++i_) { const int p_ = tid + 512 * i_, row_ = p_ >> 4, c16_ = p_ & 15; \
                *(LAS u32x4_t*)(lds + ML_Q + (bi_) * 64 * ML_QP + row_ * ML_QP + c16_ * 16) = __builtin_bit_cast(u32x4_t, pq[i_]); *(LAS u32x4_t*)(lds + ML_K + (bi_) * 64 * ML_QP + row_ * ML_QP + c16_ * 16) = __builtin_bit_cast(u32x4_t, pk[i_]); } \
            if (tid < 256) *(LAS u32x4_t*)(lds + ML_V + (bi_) * 64 * ML_VP + (tid >> 2) * ML_VP + (tid & 3) * 16) = __builtin_bit_cast(u32x4_t, pv); \
            if (tid >= 256 && tid < 320) { vec[(bi_) * 128 + (tid - 256) * 2] = pgi; vec[(bi_) * 128 + (tid - 256) * 2 + 1] = pgf; } } while (0)
        ML_LOAD(0); ML_STORE(0);
        LBAR();
#pragma nounroll
        for (int c = 0; c < 64; ++c) {
            const int bi_cur = c & 1;
            const LAS unsigned char* Qs = lds + ML_Q + bi_cur * 64 * ML_QP; const LAS unsigned char* Ks = lds + ML_K + bi_cur * 64 * ML_QP;
            const unsigned Ksb = ldsb + ML_K + bi_cur * 64 * ML_QP, Vsb = ldsb + ML_V + bi_cur * 64 * ML_VP, Vwb = ldsb + ML_VW;
            if (c + 1 < 64) ML_LOAD(c + 1);
            if (w == 0) {
                const float ip = vec[bi_cur * 128 + lane * 2] + bi, fp = vec[bi_cur * 128 + lane * 2 + 1] + bfg;
                const float lf = fminf(fp, 0.f) - log1pf(__expf(-fabsf(fp)));
                vec[256 + lane] = lf;
                asm volatile("s_waitcnt lgkmcnt(0)" ::: "memory");
                float bsum = 0.f;
#pragma unroll
                for (int j = 0; j < 64; j += 4) { const f32x4_t v4 = *(const LAS f32x4_t*)(vec + 256 + j);
                    bsum += (j + 0 <= lane) ? v4[0] : 0.f; bsum += (j + 1 <= lane) ? v4[1] : 0.f; bsum += (j + 2 <= lane) ? v4[2] : 0.f; bsum += (j + 3 <= lane) ? v4[3] : 0.f; }
                const float gtot = __builtin_bit_cast(float, __builtin_amdgcn_readlane(__builtin_bit_cast(int, bsum), 63));
                vec[320 + lane] = bsum; vec[384 + lane] = ip - bsum; vec[448 + lane] = __expf(bsum); vec[512 + lane] = __expf(gtot - bsum + ip) * 0.08838834764831845f;
                if (lane == 0) vec[640] = __expf(gtot);
            }
            LBAR();
            {
                const int ti = w >> 1;
#pragma unroll
                for (int sj = 0; sj < 2; ++sj) {
                    const int si = 2 * (w & 1) + sj;
                    f32x4_t acc = (f32x4_t){0.f, 0.f, 0.f, 0.f};
                    if (si <= ti) {
#pragma unroll
                        for (int ks = 0; ks < 4; ++ks) {
                            const bf16x8_t a = *(const LAS bf16x8_t*)(Ks + (16 * si + l15) * ML_QP + (32 * ks + 8 * g4) * 2);
                            const bf16x8_t bq = *(const LAS bf16x8_t*)(Qs + (16 * ti + l15) * ML_QP + (32 * ks + 8 * g4) * 2);
                            acc = __builtin_amdgcn_mfma_f32_16x16x32_bf16(a, bq, acc, 0, 0, 0);
                        }
                        const int t = 16 * ti + l15; const float btv = vec[320 + t];
                        const f32x4_t csv = *(const LAS f32x4_t*)(vec + 384 + 16 * si + 4 * g4);
#pragma unroll
                        for (int e = 0; e < 4; ++e) { const int s = 16 * si + 4 * g4 + e; acc[e] = (s <= t) ? acc[e] * __expf(btv + csv[e]) * 0.08838834764831845f : 0.f; }
                    }
                    *(LAS u32x2_t*)(lds + ML_P + (16 * ti + l15) * ML_PP + (16 * si + 4 * g4) * 2) = (u32x2_t){pk2(acc[0], acc[1]), pk2(acc[2], acc[3])};
                }
            }
            if (tid < 384) { const int s = tid / 6, pc = tid % 6; const float wsv = vec[512 + s];
                const u32x4_t v = *(const LAS u32x4_t*)(lds + ML_V + bi_cur * 64 * ML_VP + s * ML_VP + pc * 16); u32x4_t o;
#pragma unroll
                for (int j = 0; j < 4; ++j) o[j] = pk2(__uint_as_float(v[j] << 16) * wsv, __uint_as_float(v[j] & 0xffff0000u) * wsv);
                *(LAS u32x4_t*)(lds + ML_VW + s * ML_VP + pc * 16) = o; }
            LBAR();
            f32x4_t numv[2]; const int ti5 = w >> 1;
            {
                const int nv = (w & 1) ? 1 : 2, v0 = (w & 1) ? 2 : 0;
#pragma unroll
                for (int j = 0; j < 2; ++j) {
                    numv[j] = (f32x4_t){0.f, 0.f, 0.f, 0.f};
                    if (j < nv) {
                        const int vi = v0 + j;
                        f32x4_t ai = (f32x4_t){0.f, 0.f, 0.f, 0.f}, ax = ai;
#pragma unroll
                        for (int ks = 0; ks < 2; ++ks) {
                            const bf16x8_t a = *(const LAS bf16x8_t*)(lds + ML_P + (16 * ti5 + l15) * ML_PP + (32 * ks + 8 * g4) * 2);
                            u32x2_t r0, r1; tr_read2q(Vsb + (32 * ks + 8 * g4 + qq) * ML_VP + (16 * vi + 4 * pp) * 2, Vsb + (32 * ks + 8 * g4 + 4 + qq) * ML_VP + (16 * vi + 4 * pp) * 2, r0, r1);
                            ai = __builtin_amdgcn_mfma_f32_16x16x32_bf16(a, mk_frag(r0, r1), ai, 0, 0, 0);
                        }
#pragma unroll
                        for (int ks = 0; ks < 4; ++ks) {
                            const bf16x8_t a = *(const LAS bf16x8_t*)(Qs + (16 * ti5 + l15) * ML_QP + (32 * ks + 8 * g4) * 2);
                            const bf16x8_t bc = *(const LAS bf16x8_t*)(lds + ML_CT + (16 * vi + l15) * ML_QP + (32 * ks + 8 * g4) * 2);
                            ax = __builtin_amdgcn_mfma_f32_16x16x32_bf16(a, bc, ax, 0, 0, 0);
                        }
                        const f32x4_t eb = *(const LAS f32x4_t*)(vec + 448 + 16 * ti5 + 4 * g4);
                        numv[j] = ai + eb * ax;
                    }
                }
                if ((w & 1) && l15 == 0) *(LAS f32x4_t*)(vec + 576 + 16 * ti5 + 4 * g4) = numv[0];
            }
            LBAR();
            if (!(w & 1)) {
                const f32x4_t dn = *(const LAS f32x4_t*)(vec + 576 + 16 * ti5 + 4 * g4);
                const size_t tb = (size_t)b * SEQ + (size_t)c * 64;
#pragma unroll
                for (int j = 0; j < 2; ++j)
#pragma unroll
                    for (int e = 0; e < 4; ++e) hm[(tb + 16 * ti5 + 4 * g4 + e) * 1024 + h * 256 + vs * 32 + 16 * j + l15] = numv[j][e] / fmaxf(fabsf(dn[e]), 1.0f);
            }
            {
                const float eg = vec[640];
#pragma unroll
                for (int vi = 0; vi < 3; ++vi) {
                    f32x4_t acc = cacc[vi] * eg;
#pragma unroll
                    for (int ks = 0; ks < 2; ++ks) {
                        u32x2_t a0, a1, b0, b1;
                        tr_read2q(Ksb + (32 * ks + 8 * g4 + qq) * ML_QP + (16 * w + 4 * pp) * 2, Ksb + (32 * ks + 8 * g4 + 4 + qq) * ML_QP + (16 * w + 4 * pp) * 2, a0, a1);
                        tr_read2q(Vwb + (32 * ks + 8 * g4 + qq) * ML_VP + (16 * vi + 4 * pp) * 2, Vwb + (32 * ks + 8 * g4 + 4 + qq) * ML_VP + (16 * vi + 4 * pp) * 2, b0, b1);
                        acc = __builtin_amdgcn_mfma_f32_16x16x32_bf16(mk_frag(a0, a1), mk_frag(b0, b1), acc, 0, 0, 0);
                    }
                    cacc[vi] = acc;
                    *(LAS u32x2_t*)(lds + ML_CT + (16 * vi + l15) * ML_QP + (16 * w + 4 * g4) * 2) = (u32x2_t){pk2(acc[0], acc[1]), pk2(acc[2], acc[3])};
                }
            }
            if (c + 1 < 64) ML_STORE(bi_cur ^ 1);
            LBAR();
        }
#undef ML_LOAD
#undef ML_STORE
    }
}

constexpr int SD_BP = 272, SD_XP = 80;
constexpr int SD_B = 0, SD_C = 128 * SD_BP, SD_M = 2 * 128 * SD_BP, SD_H = 3 * 128 * SD_BP, SD_X = SD_H + 32 * SD_BP, SD_XW = SD_X + 128 * SD_XP, SD_VEC = SD_XW + 128 * SD_XP, SD_END = SD_VEC + 4096;
static_assert(SD_END <= PHASE_LDS_BYTES, "SSD LDS");
__device__ __forceinline__ void ssd_phase(LAS unsigned char* lds, const bf16* __restrict__ xcb  , const float* __restrict__ small, const float* __restrict__ dt_bias, const float* __restrict__ a_log,
                                          const float* __restrict__ dsk, float* __restrict__ yraw  , int tid, int bx, int G) {
    const int lane = tid & 63, w = __builtin_amdgcn_readfirstlane(tid >> 6), l15 = lane & 15, g4 = lane >> 4, qq = l15 >> 2, pp = lane & 3;
    const unsigned ldsb = (unsigned)(size_t)lds;
    LAS float* vec = (LAS float*)(lds + SD_VEC);
    for (int u = bx; u < NBATCH * 16 * 2; u += G) {
        const int ph = u & 1, hh = (u >> 1) & 15, b = u >> 5, g = hh >> 3;
        const float a = -__expf(a_log[hh]), dtb = dt_bias[hh], Dk = dsk[hh];
        LBAR();
        for (int i = tid; i < 32 * SD_BP / 4; i += 512) ((LAS unsigned*)(lds + SD_H))[i] = 0u;
        f32x4_t hacc[2];
        hacc[0] = (f32x4_t){0.f, 0.f, 0.f, 0.f}; hacc[1] = hacc[0];
        uint4 pb[4], pc[4], px; float pdt = 0.f;
#define SD_LOAD(c_) do { const size_t tb_ = (size_t)b * SEQ + (size_t)(c_) * 128; \
            _Pragma("unroll") for (int i_ = 0; i_ < 4; ++i_) { const int p_ = tid + 512 * i_, row_ = p_ >> 4, c16_ = p_ & 15; const bf16* s_ = xcb + (tb_ + row_) * 1536 + 1024 + g * 128 + c16_ * 8; pb[i_] = *(const uint4*)s_; pc[i_] = *(const uint4*)(s_ + 256); } \
            px = *(const uint4*)(xcb + (tb_ + (tid >> 2)) * 1536 + hh * 64 + ph * 32 + (tid & 3) * 8); \
            if (tid < 128) pdt = small[(tb_ + tid) * 32 + 8 + hh]; } while (0)
#define SD_STORE() do { _Pragma("unroll") for (int i_ = 0; i_ < 4; ++i_) { const int p_ = tid + 512 * i_, row_ = p_ >> 4, c16_ = p_ & 15; \
                *(LAS u32x4_t*)(lds + SD_B + row_ * SD_BP + c16_ * 16) = __builtin_bit_cast(u32x4_t, pb[i_]); *(LAS u32x4_t*)(lds + SD_C + row_ * SD_BP + c16_ * 16) = __builtin_bit_cast(u32x4_t, pc[i_]); } \
            *(LAS u32x4_t*)(lds + SD_X + (tid >> 2) * SD_XP + (tid & 3) * 16) = __builtin_bit_cast(u32x4_t, px); \
            if (tid < 128) vec[tid] = pdt; } while (0)
        SD_LOAD(0); SD_STORE();
        LBAR();
#pragma nounroll
        for (int c = 0; c < 32; ++c) {
            if (c + 1 < 32) SD_LOAD(c + 1);
            if (w < 2) {
                const float dtr = vec[tid] + dtb; const float dt = dtr > 20.f ? dtr : log1pf(__expf(dtr));
                vec[640 + tid] = dt; vec[128 + tid] = dt * a;
            }
            LBAR();
            if (w < 2) {
                float acs = 0.f;
#pragma unroll 8
                for (int j = 0; j < 128; j += 4) { const f32x4_t v4 = *(const LAS f32x4_t*)(vec + 128 + j);
                    acs += (j + 0 <= tid) ? v4[0] : 0.f; acs += (j + 1 <= tid) ? v4[1] : 0.f; acs += (j + 2 <= tid) ? v4[2] : 0.f; acs += (j + 3 <= tid) ? v4[3] : 0.f; }
                vec[256 + tid] = acs; vec[384 + tid] = __expf(acs);
                if (tid == 127) { vec[768] = acs; vec[769] = __expf(acs); }
            }
            LBAR();
            if (w < 2) { const float atot = vec[768]; vec[512 + tid] = __expf(atot - vec[256 + tid]) * vec[640 + tid]; }
            {
                const int li = w; const int l = 16 * li + l15; const float acl = vec[256 + l];
#pragma unroll
                for (int si = 0; si < 8; ++si) {
                    f32x4_t acc = (f32x4_t){0.f, 0.f, 0.f, 0.f};
                    if (si <= li) {
#pragma unroll
                        for (int ks = 0; ks < 4; ++ks) {
                            const bf16x8_t av = *(const LAS bf16x8_t*)(lds + SD_B + (16 * si + l15) * SD_BP + (32 * ks + 8 * g4) * 2);
                            const bf16x8_t bv = *(const LAS bf16x8_t*)(lds + SD_C + (16 * li + l15) * SD_BP + (32 * ks + 8 * g4) * 2);
                            acc = __builtin_amdgcn_mfma_f32_16x16x32_bf16(av, bv, acc, 0, 0, 0);
                        }
                        const f32x4_t acs = *(const LAS f32x4_t*)(vec + 256 + 16 * si + 4 * g4), dts = *(const LAS f32x4_t*)(vec + 640 + 16 * si + 4 * g4);
#pragma unroll
                        for (int e = 0; e < 4; ++e) { const int s = 16 * si + 4 * g4 + e; acc[e] = (s <= l) ? acc[e] * __expf(acl - acs[e]) * dts[e] : 0.f; }
                    }
                    *(LAS u32x2_t*)(lds + SD_M + l * SD_BP + (16 * si + 4 * g4) * 2) = (u32x2_t){pk2(acc[0], acc[1]), pk2(acc[2], acc[3])};
                }
            }
            LBAR();
            { const int s = tid >> 2, pcx = tid & 3; const float wv = vec[512 + s];
              const u32x4_t v = *(const LAS u32x4_t*)(lds + SD_X + s * SD_XP + pcx * 16); u32x4_t o;
#pragma unroll
              for (int j = 0; j < 4; ++j) o[j] = pk2(__uint_as_float(v[j] << 16) * wv, __uint_as_float(v[j] & 0xffff0000u) * wv);
              *(LAS u32x4_t*)(lds + SD_XW + s * SD_XP + pcx * 16) = o; }
            {
                const int li = w; const size_t tb = (size_t)b * SEQ + (size_t)c * 128;
                const f32x4_t eac = *(const LAS f32x4_t*)(vec + 384 + 16 * li + 4 * g4);
#pragma unroll
                for (int pi = 0; pi < 2; ++pi) {
                    f32x4_t yd = (f32x4_t){0.f, 0.f, 0.f, 0.f}, yo = yd;
#pragma unroll
                    for (int ks = 0; ks < 4; ++ks) {
                        if (32 * ks <= 16 * li + 15) {
                            const bf16x8_t av = *(const LAS bf16x8_t*)(lds + SD_M + (16 * li + l15) * SD_BP + (32 * ks + 8 * g4) * 2);
                            u32x2_t r0, r1; tr_read2q(ldsb + SD_X + (32 * ks + 8 * g4 + qq) * SD_XP + (16 * pi + 4 * pp) * 2, ldsb + SD_X + (32 * ks + 8 * g4 + 4 + qq) * SD_XP + (16 * pi + 4 * pp) * 2, r0, r1);
                            yd = __builtin_amdgcn_mfma_f32_16x16x32_bf16(av, mk_frag(r0, r1), yd, 0, 0, 0);
                        }
                    }
#pragma unroll
                    for (int ks = 0; ks < 4; ++ks) {
                        const bf16x8_t av = *(const LAS bf16x8_t*)(lds + SD_C + (16 * li + l15) * SD_BP + (32 * ks + 8 * g4) * 2);
                        const bf16x8_t bh = *(const LAS bf16x8_t*)(lds + SD_H + (16 * pi + l15) * SD_BP + (32 * ks + 8 * g4) * 2);
                        yo = __builtin_amdgcn_mfma_f32_16x16x32_bf16(av, bh, yo, 0, 0, 0);
                    }
#pragma unroll
                    for (int e = 0; e < 4; ++e) { const int l = 16 * li + 4 * g4 + e;
                        const float xv = __uint_as_float(((unsigned)*(const LAS unsigned short*)(lds + SD_X + l * SD_XP + (16 * pi + l15) * 2)) << 16);
                        yraw[(tb + l) * 1024 + hh * 64 + ph * 32 + 16 * pi + l15] = yd[e] + eac[e] * yo[e] + Dk * xv; }
                }
            }
            LBAR();
            {
                const float ea = vec[769];
#pragma unroll
                for (int pi = 0; pi < 2; ++pi) {
                    f32x4_t acc = hacc[pi] * ea;
#pragma unroll
                    for (int ks = 0; ks < 4; ++ks) {
                        u32x2_t a0, a1, b0, b1;
                        tr_read2q(ldsb + SD_B + (32 * ks + 8 * g4 + qq) * SD_BP + (16 * w + 4 * pp) * 2, ldsb + SD_B + (32 * ks + 8 * g4 + 4 + qq) * SD_BP + (16 * w + 4 * pp) * 2, a0, a1);
                        tr_read2q(ldsb + SD_XW + (32 * ks + 8 * g4 + qq) * SD_XP + (16 * pi + 4 * pp) * 2, ldsb + SD_XW + (32 * ks + 8 * g4 + 4 + qq) * SD_XP + (16 * pi + 4 * pp) * 2, b0, b1);
                        acc = __builtin_amdgcn_mfma_f32_16x16x32_bf16(mk_frag(a0, a1), mk_frag(b0, b1), acc, 0, 0, 0);
                    }
                    hacc[pi] = acc;
                    *(LAS u32x2_t*)(lds + SD_H + (16 * pi + l15) * SD_BP + (16 * w + 4 * g4) * 2) = (u32x2_t){pk2(acc[0], acc[1]), pk2(acc[2], acc[3])};
                }
            }
            LBAR();
            if (c + 1 < 32) SD_STORE();
            LBAR();
        }
#undef SD_LOAD
#undef SD_STORE
    }
}

constexpr int PS_SKP = 272;
constexpr int PS_SK = 0, PS_END = 2 * 128 * PS_SKP;
static_assert(PS_END <= PHASE_LDS_BYTES, "PEER select LDS");
__device__ __forceinline__ unsigned fkey(float f) { const unsigned u = __float_as_uint(f); return u ^ ((unsigned)((int)u >> 31) | 0x80000000u); }
__device__ __forceinline__ float funkey(unsigned k) { return __uint_as_float((k & 0x80000000u) ? (k ^ 0x80000000u) : ~k); }
template <int CTRL> __device__ __forceinline__ unsigned dpp_u(unsigned v) { return (unsigned)__builtin_amdgcn_update_dpp(0, (int)v, CTRL, 0xF, 0xF, true); }
__device__ __forceinline__ unsigned umax(unsigned a, unsigned b) { return a > b ? a : b; }
__device__ __forceinline__ unsigned row_umax(unsigned v) { v = umax(v, dpp_u<0xB1>(v)); v = umax(v, dpp_u<0x4E>(v)); v = umax(v, dpp_u<0x141>(v)); v = umax(v, dpp_u<0x140>(v)); return v; }
__device__ __forceinline__ float row_sum(float v) { v += dpp_f<0xB1>(v); v += dpp_f<0x4E>(v); v += dpp_f<0x141>(v); v += dpp_f<0x140>(v); return v; }
template <int N> __device__ __forceinline__ unsigned row_top16(unsigned (&s)[N], int l15) {
    unsigned mine = 0u;
#pragma unroll
    for (int j = 0; j < 16; ++j) {
        unsigned m = s[0];
#pragma unroll
        for (int i = 1; i < N; ++i) m = umax(m, s[i]);
        m = row_umax(m);
        mine = (l15 == j) ? m : mine;
#pragma unroll
        for (int i = 0; i < N; ++i) s[i] = (s[i] == m) ? 0u : s[i];
    }
    return mine;
}
__device__ __forceinline__ void peer_select_phase(LAS unsigned char* lds, const bf16* __restrict__ qb  , const bf16* __restrict__ skb  , int* __restrict__ ids, float* __restrict__ gates,
                                                  int tid, int bx, int G) {
    const int lane = tid & 63, w = __builtin_amdgcn_readfirstlane(tid >> 6), l15 = lane & 15, g4 = lane >> 4;
    int ca[4], cb[4];
#pragma unroll
    for (int i = 0; i < 4; ++i) { const int sg = 4 * l15 + i; int a = 0, base = 0;
#pragma unroll
        for (int k = 0; k < 15; ++k) { const int cnt = 16 / (k + 1); const bool adv = (a == k) && (sg >= base + cnt); base += adv ? cnt : 0; a += adv ? 1 : 0; }
        ca[i] = a; cb[i] = sg - base; if (sg >= 50) { ca[i] = -1; cb[i] = 0; } }
    for (int u = bx; u < 8 * 32; u += G) {
        const int h = u >> 5, tr = u & 31;
        LBAR();
        for (int it = tid; it < 4096; it += 512) { const int row = it >> 4, c16 = it & 15;
            *(LAS u32x4_t*)(lds + PS_SK + row * PS_SKP + c16 * 16) = __builtin_bit_cast(u32x4_t, *(const uint4*)(skb + ((size_t)h * 256 + row) * 128 + c16 * 8)); }
        LBAR();
#pragma nounroll
        for (int tile = w; tile < 64; tile += 8) {
            const int t0 = tr * 1024 + tile * 16;
            unsigned top[2][4];
#pragma unroll
            for (int c = 0; c < 2; ++c) {
                bf16x8_t af[4];
#pragma unroll
                for (int ks = 0; ks < 4; ++ks) af[ks] = __builtin_bit_cast(bf16x8_t, *(const uint4*)(qb + (size_t)(t0 + l15) * DM + h * 256 + c * 128 + 32 * ks + 8 * g4));
                unsigned key[8][4];
#pragma unroll
                for (int kt = 0; kt < 8; ++kt) {
                    f32x4_t acc = (f32x4_t){0.f, 0.f, 0.f, 0.f};
#pragma unroll
                    for (int ks = 0; ks < 4; ++ks) {
                        const bf16x8_t bfr = *(const LAS bf16x8_t*)(lds + PS_SK + (c * 128 + 16 * kt + l15) * PS_SKP + (32 * ks + 8 * g4) * 2);
                        acc = __builtin_amdgcn_mfma_f32_16x16x32_bf16(af[ks], bfr, acc, 0, 0, 0);
                    }
#pragma unroll
                    for (int e = 0; e < 4; ++e) key[kt][e] = (fkey(acc[e]) & ~0x7Fu) | (unsigned)(127 - (16 * kt + l15));
                }
#pragma unroll
                for (int e = 0; e < 4; ++e) { unsigned s8[8];
#pragma unroll
                    for (int kt = 0; kt < 8; ++kt) s8[kt] = key[kt][e];
                    __builtin_amdgcn_sched_barrier(0); top[c][e] = row_top16<8>(s8, l15); __builtin_amdgcn_sched_barrier(0); }
            }
#pragma unroll
            for (int e = 0; e < 4; ++e) {
                unsigned s4[4];
#pragma unroll
                for (int i = 0; i < 4; ++i) {
                    const int srcA = ((lane & 48) + (ca[i] < 0 ? 0 : ca[i])) * 4, srcB = ((lane & 48) + cb[i]) * 4;
                    const unsigned ka = (unsigned)__builtin_amdgcn_ds_bpermute(srcA, (int)top[0][e]), kb = (unsigned)__builtin_amdgcn_ds_bpermute(srcB, (int)top[1][e]);
                    const float cv = funkey(ka & ~0x7Fu) + funkey(kb & ~0x7Fu);
                    s4[i] = ca[i] < 0 ? 0u : ((fkey(cv) & ~0xFFu) | (unsigned)(255 - (ca[i] * 16 + cb[i])));
                }
                __builtin_amdgcn_sched_barrier(0); const unsigned win = row_top16<4>(s4, l15); __builtin_amdgcn_sched_barrier(0);
                const int jw = 255 - (int)(win & 0xFFu), wa = jw >> 4, wb = jw & 15;
                const unsigned ka = (unsigned)__builtin_amdgcn_ds_bpermute(((lane & 48) + wa) * 4, (int)top[0][e]), kb = (unsigned)__builtin_amdgcn_ds_bpermute(((lane & 48) + wb) * 4, (int)top[1][e]);
                const float bv = funkey(ka & ~0x7Fu) + funkey(kb & ~0x7Fu);
                const int id = (127 - (int)(ka & 0x7Fu)) * 128 + (127 - (int)(kb & 0x7Fu));
                const float mx = __builtin_bit_cast(float, __builtin_amdgcn_ds_bpermute((lane & 48) * 4, __builtin_bit_cast(int, bv)));
                const float ex = __expf(bv - mx), den = row_sum(ex);
                const size_t o = (size_t)(t0 + 4 * g4 + e) * 128 + h * 16 + l15;
                ids[o] = id; gates[o] = ex / den;
            }
        }
    }
}

struct MegaArgs { const float* in[22]; float* out; unsigned char* ws; };
template <int I> __device__ __forceinline__ unsigned long long ld_ptr() {
    unsigned long long v; const auto ka = __builtin_amdgcn_kernarg_segment_ptr();
    asm volatile("s_load_dwordx2 %0, %1, %2\n\ts_waitcnt lgkmcnt(0)" : "=s"(v) : "s"(ka), "n"(I * 8) : "memory");
    return v;
}
#define GAS_ __attribute__((address_space(1)))
#define INF(i) ((const float*)(const GAS_ float*)ld_ptr<(i)>())
#define OUTP ((float*)(GAS_ float*)ld_ptr<22>())
#define WSP ((unsigned char*)(GAS_ unsigned char*)ld_ptr<23>())
enum { I_X = 0, I_WIN, I_MGATEB, I_MNORMW, I_CONVW, I_CONVB, I_DTB, I_ALOG, I_SSMD, I_SNORMW, I_SINKS, I_MERGEB, I_WBR, I_WOUT, I_LN1G, I_LN1B, I_WQ, I_SUBK, I_PU, I_PV, I_LN2G, I_LN2B };

__global__ void __launch_bounds__(512, 2) mega_fwd(MegaArgs a) {
    extern __shared__ __attribute__((aligned(16))) unsigned char lds_raw[];
    LAS unsigned char* lds = (LAS unsigned char*)lds_raw;
    const int wave0 = __builtin_amdgcn_readfirstlane(threadIdx.x >> 6);
    volatile LAS unsigned* MISC = (volatile LAS unsigned*)(lds + MISC_OFF);
    { PHASE_IDS for (int u = tid; u < (LDS_BYTES - PHASE_LDS_BYTES) / 4; u += 512) ((LAS unsigned*)(lds + PHASE_LDS_BYTES))[u] = 0u; }
    __syncthreads();
    { XcdBarrier b0 = xcd_barrier_post((unsigned*)(WSP + WS_CTL) + CW_BAR, MISC + 8); (void)b0; }
#define GRID_BAR() do { XcdBarrier b_; b_.bar = (unsigned*)(WSP + WS_CTL) + CW_BAR; b_.x = xb_xcc_id(); b_.st = MISC + 8; xcd_barrier(b_); } while (0)

    { PHASE_IDS float2* rt = (float2*)(WSP + WS_ROPE);
      for (size_t i = gt; i < (size_t)SEQ * 32; i += NGT) { const int pos = (int)(i >> 5), fi = (int)(i & 31); const float ang = (float)pos * powf(10000.0f, -(float)fi / 32.0f); rt[i] = make_float2(cosf(ang), sinf(ang)); } }
    { PHASE_IDS const float* x = INF(I_X); bf16* xb = (bf16*)(WSP + WS_XB);
      for (size_t i = gt; i < (size_t)T_TOK * DM / 4; i += NGT) { const float4 v = ((const float4*)x)[i]; ((uint2*)xb)[i] = make_uint2(pk2(v.x, v.y), pk2(v.z, v.w)); } }

#pragma nounroll
    for (int l = 0; l < DEPTH; ++l) {
        { PHASE_IDS
            unsigned char* ws = WSP; bf16* WinT = (bf16*)(ws + WS_WIN); bf16* WbT = (bf16*)(ws + WS_WB); bf16* WoT = (bf16*)(ws + WS_WO); bf16* WqT = (bf16*)(ws + WS_WQ); float* bias = (float*)(ws + WS_BIAS);
            const float* w_in = INF(I_WIN) + (size_t)l * DM * IN_COLS; const float* w_branch = INF(I_WBR) + (size_t)l * 3 * 1024 * DM; const float* w_out = INF(I_WOUT) + (size_t)l * DM * DM; const float* peer_wq = INF(I_WQ) + (size_t)l * DM * DM;
            const float* merge_gate_b = INF(I_MERGEB) + (size_t)l * 3 * DM;
            LAS float* scr = (LAS float*)(lds + wave * 16384);
            constexpr int I_IN = (DM / 64) * (NP / 32), I_B = (1024 / 64) * (DM / 32), I_O = (DM / 64) * (DM / 32);
            constexpr int NITEMS = I_IN + 3 * I_B + 2 * I_O;
            for (int it = gw; it < NITEMS; it += NGW) {
                int r = it;
                if (r < I_IN) { transpose_item<1>(w_in, DM, IN_COLS, NP, WinT, scr, r, lane); continue; } r -= I_IN;
                if (r < 3 * I_B) { const int k = r / I_B; transpose_item<0>(w_branch + (size_t)k * 1024 * DM, 1024, DM, DM, WbT + (size_t)k * DM * 1024, scr, r - k * I_B, lane); continue; } r -= 3 * I_B;
                if (r < I_O) { transpose_item<0>(w_out, DM, DM, DM, WoT, scr, r, lane); continue; } r -= I_O;
                transpose_item<0>(peer_wq, DM, DM, DM, WqT, scr, r, lane);
            }
            for (size_t n = gt; n < NP; n += NGT) bias[n] = (n >= C_G && n < C_SMALL) ? merge_gate_b[n - C_G] : 0.f;
            { const float4* sk = (const float4*)(INF(I_SUBK) + (size_t)l * 8 * 2 * 128 * 128); uint2* skb = (uint2*)(ws + WS_SKB);
              for (size_t n = gt; n < 8 * 2 * 128 * 128 / 4; n += NGT) { const float4 v = sk[n]; skb[n] = make_uint2(pk2(v.x, v.y), pk2(v.z, v.w)); } }
        }
        GRID_BAR();
        { PHASE_IDS unsigned char* ws = WSP; pg8::Gemm g{(const bf16*)(ws + WS_XB), (const bf16*)(ws + WS_WIN), T_TOK, NP, DM}; pg8::StaticOrder S; S.init(T_TOK, NP, G, bx);
          pg8::EpiProj E{(bf16*)(ws + WS_PROJ), (const float*)(ws + WS_BIAS), (float*)(ws + WS_SMALL), NP, GATE_TILE_LO, SMALL_TILE, 0};
          pg8::gemm_phase<pg8::EpiProj, pg8::StaticOrder, true, true>(lds, g, S, E, tid); }
        GRID_BAR();
        { PHASE_IDS unsigned char* ws = WSP; const bf16* proj = (const bf16*)(ws + WS_PROJ); bf16* xcb = (bf16*)(ws + WS_R2);
          const float* cw = INF(I_CONVW) + (size_t)l * 4 * 1536; const float* cb = INF(I_CONVB) + l * 1536;
          for (size_t i = gt; i < (size_t)T_TOK * 768; i += NGT) ssd_conv_body(i, proj, cw, cb, xcb); }
        GRID_BAR();
        { PHASE_IDS unsigned char* ws = WSP; mlstm_phase(lds, (const bf16*)(ws + WS_PROJ), (const float*)(ws + WS_SMALL), INF(I_MGATEB) + l * 8, (float*)(ws + WS_HM), tid, bx, G); }
        { PHASE_IDS unsigned char* ws = WSP; ssd_phase(lds, (const bf16*)(ws + WS_R2), (const float*)(ws + WS_SMALL), INF(I_DTB) + l * 16, INF(I_ALOG) + l * 16, INF(I_SSMD) + l * 16, (float*)(ws + WS_R1), tid, bx, G); }
        { PHASE_IDS unsigned char* ws = WSP; swa_phase(lds, (const bf16*)(ws + WS_PROJ), (const float*)(ws + WS_ROPE), INF(I_SINKS) + l * 16, (bf16*)(ws + WS_Y + 128 * MiB), tid, bx, G); }
        GRID_BAR();
        { PHASE_IDS unsigned char* ws = WSP; const bf16* proj = (const bf16*)(ws + WS_PROJ); const float* hm = (const float*)(ws + WS_HM); bf16* ym = (bf16*)(ws + WS_Y); const float* nw = INF(I_MNORMW) + l * 1024;
          for (int w = gw; w < T_TOK * 4; w += NGW) mlstm_post_body(w, lane, hm, proj, nw, ym); }
        { PHASE_IDS unsigned char* ws = WSP; const bf16* proj = (const bf16*)(ws + WS_PROJ); const float* yraw = (const float*)(ws + WS_R1); bf16* ys = (bf16*)(ws + WS_Y + 64 * MiB); const float* nw = INF(I_SNORMW) + l * 1024;
          for (int w = gw; w < T_TOK * 2; w += NGW) ssd_post_body(w, lane, yraw, proj, nw, ys); }
        GRID_BAR();
        { PHASE_IDS unsigned char* ws = WSP; pg8::Gemm g{(const bf16*)(ws + WS_Y), (const bf16*)(ws + WS_WB), T_TOK, DM, 1024}; pg8::StaticOrder S; S.init(T_TOK, DM, G, bx);
          pg8::EpiMix<1> E{(bf16*)(ws + WS_R1), (const bf16*)(ws + WS_PROJ) + C_G, DM, NP};
          pg8::gemm_phase<pg8::EpiMix<1>, pg8::StaticOrder, true, true>(lds, g, S, E, tid); }
        __syncthreads();
        { PHASE_IDS unsigned char* ws = WSP; pg8::Gemm g{(const bf16*)(ws + WS_Y + 64 * MiB), (const bf16*)(ws + WS_WB) + (size_t)DM * 1024, T_TOK, DM, 1024}; pg8::StaticOrder S; S.init(T_TOK, DM, G, bx);
          pg8::EpiMix<0> E{(bf16*)(ws + WS_R1), (const bf16*)(ws + WS_PROJ) + C_G + DM, DM, NP};
          pg8::gemm_phase<pg8::EpiMix<0>, pg8::StaticOrder, true, true>(lds, g, S, E, tid); }
        __syncthreads();
        { PHASE_IDS unsigned char* ws = WSP; pg8::Gemm g{(const bf16*)(ws + WS_Y + 128 * MiB), (const bf16*)(ws + WS_WB) + (size_t)2 * DM * 1024, T_TOK, DM, 1024}; pg8::StaticOrder S; S.init(T_TOK, DM, G, bx);
          pg8::EpiMix<0> E{(bf16*)(ws + WS_R1), (const bf16*)(ws + WS_PROJ) + C_G + 2 * DM, DM, NP};
          pg8::gemm_phase<pg8::EpiMix<0>, pg8::StaticOrder, true, true>(lds, g, S, E, tid); }
        GRID_BAR();
        { PHASE_IDS unsigned char* ws = WSP; const float* xin = l == 0 ? INF(I_X) : (const float*)OUTP;
          pg8::Gemm g{(const bf16*)(ws + WS_R1), (const bf16*)(ws + WS_WO), T_TOK, DM, DM}; pg8::StaticOrder S; S.init(T_TOK, DM, G, bx); pg8::EpiResid E{(float*)(ws + WS_BUFB), xin, DM, ALPHA};
          pg8::gemm_phase<pg8::EpiResid, pg8::StaticOrder, true, true>(lds, g, S, E, tid); }
        GRID_BAR();
        { PHASE_IDS unsigned char* ws = WSP; float* bufB = (float*)(ws + WS_BUFB); bf16* xb = (bf16*)(ws + WS_XB); const float* g1 = INF(I_LN1G) + l * DM; const float* b1 = INF(I_LN1B) + l * DM;
          for (int t = gw; t < T_TOK; t += NGW) ln_body(t, lane, bufB, g1, b1, bufB, xb); }
        { PHASE_IDS unsigned char* ws = WSP; constexpr size_t NGRP = (size_t)P_EXPERTS * DM / 32;
          const float* pu = INF(I_PU) + (size_t)l * P_EXPERTS * DM; const float* pv = INF(I_PV) + (size_t)l * P_EXPERTS * DM; unsigned char* U6 = ws + WS_R2; unsigned char* V6 = ws + WS_R2 + 32 * MiB;
          for (size_t i = gt; i < 2 * NGRP; i += NGT) { if (i < NGRP) tab_to_fp6(i, pu, U6, U6_SCALE); else tab_to_fp6(i - NGRP, pv, V6, V6_SCALE); } }
        GRID_BAR();
        { PHASE_IDS unsigned char* ws = WSP; pg8::Gemm g{(const bf16*)(ws + WS_XB), (const bf16*)(ws + WS_WQ), T_TOK, DM, DM}; pg8::StaticOrder S; S.init(T_TOK, DM, G, bx);
          pg8::EpiProj E{(bf16*)(ws + WS_QF), nullptr, nullptr, DM, 1 << 20, -1, 0};
          pg8::gemm_phase<pg8::EpiProj, pg8::StaticOrder, true, true>(lds, g, S, E, tid); }
        GRID_BAR();
        { PHASE_IDS unsigned char* ws = WSP; peer_select_phase(lds, (const bf16*)(ws + WS_QF), (const bf16*)(ws + WS_SKB), (int*)(ws + WS_IDS), (float*)(ws + WS_GATES), tid, bx, G); }
        GRID_BAR();
        { PHASE_IDS unsigned char* ws = WSP; const float* bufB = (const float*)(ws + WS_BUFB); const int* ids = (const int*)(ws + WS_IDS); const float* gates = (const float*)(ws + WS_GATES);
          const unsigned char* U8 = ws + WS_R2; const unsigned char* V8 = ws + WS_R2 + 32 * MiB;     const float* g2 = INF(I_LN2G) + l * DM; const float* b2 = INF(I_LN2B) + l * DM; float* out = OUTP; bf16* xb = (bf16*)(ws + WS_XB);
          LAS unsigned* wl = (LAS unsigned*)(lds + wave * 2048);
          for (int t = gw; t < T_TOK; t += NGW) peer_expert_body(t, lane, bufB, ids, gates, U8, V8, g2, b2, out, xb, wl); }
        GRID_BAR();
    }
#undef GRID_BAR
}

extern "C" void kernel_launch(void* const* d_in, const int* in_sizes, int n_in, void* d_out, int out_size, void* d_ws, size_t ws_size, hipStream_t stream) {
    static int grid = 0;
    if (grid == 0) {
        if (n_in != 22 || out_size != T_TOK * DM || ws_size < WS_END) { fprintf(stderr, "kernel_launch: unexpected shapes (n_in %d, out %d, ws %zu)\n", n_in, out_size, ws_size); grid = -1; return; }
        int dev = 0, cus = 0, per_cu = 0;
        if (hipGetDevice(&dev) != hipSuccess || hipDeviceGetAttribute(&cus, hipDeviceAttributeMultiprocessorCount, dev) != hipSuccess) { grid = -1; return; }
        if (hipFuncSetAttribute((const void*)mega_fwd, hipFuncAttributeMaxDynamicSharedMemorySize, LDS_BYTES) != hipSuccess) { fprintf(stderr, "kernel_launch: hipFuncSetAttribute failed\n"); grid = -1; return; }
        if (hipOccupancyMaxActiveBlocksPerMultiprocessor(&per_cu, (const void*)mega_fwd, 512, LDS_BYTES) != hipSuccess || per_cu < 1) { fprintf(stderr, "kernel_launch: occupancy query says %d blocks per CU\n", per_cu); (void)hipGetLastError(); grid = -1; return; }
        grid = cus;
    }
    if (grid < 0) return;
    (void)hipMemsetAsync((char*)d_ws + WS_CTL, 0, CTL_ZERO_BYTES, stream);
    MegaArgs a; memset(&a, 0, sizeof(a));
    for (int i = 0; i < 22; ++i) a.in[i] = (const float*)d_in[i];
    a.out = (float*)d_out; a.ws = (unsigned char*)d_ws;
    hipLaunchKernelGGL(mega_fwd, dim3(grid), dim3(512), LDS_BYTES, stream, a);
}
```

```cpp
#include <hip/hip_runtime.h>
#include <cstdio>
#include <cstdint>
#include <cstring>

namespace pg8 {
#define PG8_LAS __attribute__((address_space(3)))
typedef unsigned short bf16_t;
typedef short bf16x8 __attribute__((ext_vector_type(8)));
typedef float f32x4 __attribute__((ext_vector_type(4)));
typedef unsigned u32x4 __attribute__((ext_vector_type(4)));
constexpr int BM = 256, BK = 64, HALF = 128, HTB = HALF * BK * 2  , STAGE_BYTES = 8 * HTB, NXCD = 8, WGM = 8;

__host__ __device__ __forceinline__ int lds_byte(int r, int c) { const int st = (r >> 4) * 2 + (c >> 5), rr = r & 15, cc = c & 31, ob = rr * 64 + cc * 2; return st * 1024 + (ob ^ (((ob >> 9) & 1) << 5)); }
__host__ __device__ __forceinline__ void stage_rc(int b, int& R, int& C) { const int st = b / 1024, sb = b % 1024, swz = sb ^ (((sb >> 9) & 1) << 5); R = (st >> 1) * 16 + swz / 64; C = (st & 1) * 32 + (swz % 64) / 2; }
__host__ __device__ __forceinline__ int perm32(int rho) { const int n = rho >> 4, i = rho & 15; return 8 * (i >> 2) + 4 * n + (i & 3); }

struct Unit { int pm, pn; };
struct Gemm { const bf16_t* A; const bf16_t* Bt; int M, N, K; };

struct StaticOrder {
    int nM, nN, nwg, G, c;
    __host__ __device__ void init(int M, int N, int G_, int c_) { nM = M / BM; nN = N / BM; nwg = nM * nN; G = G_; c = c_; }
    __host__ __device__ bool next(int i, Unit& u) const {
        const long L = (long)i * G + c; if (L >= nwg) return false;
        int wgid = (int)L; { const int q = nwg / NXCD, r = nwg % NXCD, xcd = wgid % NXCD, off = wgid / NXCD; wgid = (xcd < r ? xcd * (q + 1) : r * (q + 1) + (xcd - r) * q) + off; }
        const int nig = WGM * nN, gid = wgid / nig, fm = gid * WGM, gsz = (nM - fm) < WGM ? (nM - fm) : WGM;
        u.pm = fm + ((wgid % nig) % gsz); u.pn = (wgid % nig) / gsz; return true;
    }
    __device__ __forceinline__ void a_ready(const Unit&) const {}
    __device__ __forceinline__ void done(const Unit&) const {}
};

__device__ __forceinline__ unsigned cvt_pk_bf16(float lo, float hi) { unsigned r; asm volatile("v_cvt_pk_bf16_f32 %0, %1, %2" : "=v"(r) : "v"(lo), "v"(hi)); return r; }
typedef float f32x2 __attribute__((ext_vector_type(2)));
__device__ __forceinline__ float bf_lo(unsigned w) { return __uint_as_float(w << 16); }
__device__ __forceinline__ float bf_hi(unsigned w) { return __uint_as_float(w & 0xffff0000u); }
__device__ __forceinline__ float sigmoidf_(float x) { return 1.0f / (1.0f + __expf(-x)); }

struct EpiF32 {
    static constexpr bool PERM = false, AFTER_DRAIN = false;
    float* C; int ldc; int pad;
    __device__ __forceinline__ void operator()(const f32x4 (&acc)[2][2][4][2], const Unit& u, int wr, int wc, int fr, int fq) const {
        const int row0 = u.pm * BM + wr * 64 + fr, col0 = u.pn * BM + wc * 32 + 4 * fq;
#pragma unroll
        for (int ai = 0; ai < 2; ++ai)
#pragma unroll
            for (int m = 0; m < 4; ++m) { float* rowp = C + (size_t)(row0 + ai * HALF + m * 16) * ldc + col0;
#pragma unroll
                for (int bj = 0; bj < 2; ++bj)
#pragma unroll
                    for (int n = 0; n < 2; ++n) *(f32x4*)(rowp + bj * HALF + n * 16) = acc[ai][bj][m][n]; }
    }
};
struct EpiResid {
    static constexpr bool PERM = false, AFTER_DRAIN = false;
    float* C; const float* X; int ldc; float alpha;
    __device__ __forceinline__ void operator()(const f32x4 (&acc)[2][2][4][2], const Unit& u, int wr, int wc, int fr, int fq) const {
        const int row0 = u.pm * BM + wr * 64 + fr, col0 = u.pn * BM + wc * 32 + 4 * fq;
#pragma unroll
        for (int ai = 0; ai < 2; ++ai)
#pragma unroll
            for (int m = 0; m < 4; ++m) { const size_t off = (size_t)(row0 + ai * HALF + m * 16) * ldc + col0;
#pragma unroll
                for (int bj = 0; bj < 2; ++bj)
#pragma unroll
                    for (int n = 0; n < 2; ++n) { const f32x4 xv = *(const f32x4*)(X + off + bj * HALF + n * 16);
                        *(f32x4*)(C + off + bj * HALF + n * 16) = acc[ai][bj][m][n] + xv * alpha; } }
    }
};
struct EpiProj {
    static constexpr bool PERM = true, AFTER_DRAIN = false;
    bf16_t* O; const float* bias; float* small; int ldc; int gate_lo; int small_tile; int pad;
    __device__ __forceinline__ void operator()(const f32x4 (&acc)[2][2][4][2], const Unit& u, int wr, int wc, int fr, int fq) const {
        const int row0 = u.pm * BM + wr * 64 + fr, col0 = u.pn * BM + wc * 32 + 8 * fq;
        if (u.pn == small_tile) {
            if (wc == 0) {
#pragma unroll
                for (int ai = 0; ai < 2; ++ai)
#pragma unroll
                    for (int m = 0; m < 4; ++m) { float* p = small + (size_t)(row0 + ai * HALF + m * 16) * 32 + 8 * fq;
                        *(f32x4*)p = acc[ai][0][m][0]; *(f32x4*)(p + 4) = acc[ai][0][m][1]; }
            }
            return;
        }
        const bool gate = u.pn >= gate_lo;
        f32x4 bv[2][2];
#pragma unroll
        for (int bj = 0; bj < 2; ++bj)
#pragma unroll
            for (int n = 0; n < 2; ++n) bv[bj][n] = gate ? *(const f32x4*)(bias + col0 + bj * HALF + 4 * n) : (f32x4){0.f, 0.f, 0.f, 0.f};
#pragma unroll
        for (int ai = 0; ai < 2; ++ai)
#pragma unroll
            for (int m = 0; m < 4; ++m) { bf16_t* rowp = O + (size_t)(row0 + ai * HALF + m * 16) * ldc + col0;
#pragma unroll
                for (int bj = 0; bj < 2; ++bj) { f32x4 v0 = acc[ai][bj][m][0] + bv[bj][0], v1 = acc[ai][bj][m][1] + bv[bj][1];
                    if (gate) {
#pragma unroll
                        for (int j = 0; j < 4; ++j) { v0[j] = sigmoidf_(v0[j]); v1[j] = sigmoidf_(v1[j]); } }
                    u32x4 w; w.x = cvt_pk_bf16(v0[0], v0[1]); w.y = cvt_pk_bf16(v0[2], v0[3]); w.z = cvt_pk_bf16(v1[0], v1[1]); w.w = cvt_pk_bf16(v1[2], v1[3]);
                    *(u32x4*)(rowp + bj * HALF) = w; } }
    }
};
template <int FIRST> struct EpiMix {
    static constexpr bool PERM = true, AFTER_DRAIN = false;
    bf16_t* O; const bf16_t* G; int ldc; int ldg;
    __device__ __forceinline__ void operator()(const f32x4 (&acc)[2][2][4][2], const Unit& u, int wr, int wc, int fr, int fq) const {
        const int row0 = u.pm * BM + wr * 64 + fr, col0 = u.pn * BM + wc * 32 + 8 * fq;
#pragma unroll
        for (int ai = 0; ai < 2; ++ai)
#pragma unroll
            for (int m = 0; m < 4; ++m) { const int row = row0 + ai * HALF + m * 16; bf16_t* rowp = O + (size_t)row * ldc + col0; const bf16_t* gp = G + (size_t)row * ldg + col0;
#pragma unroll
                for (int bj = 0; bj < 2; ++bj) { const u32x4 gw = *(const u32x4*)(gp + bj * HALF); u32x4 ow = (u32x4){0u, 0u, 0u, 0u}; if (!FIRST) ow = *(const u32x4*)(rowp + bj * HALF);
                    const f32x4 a0 = acc[ai][bj][m][0], a1 = acc[ai][bj][m][1];
                    float r0 = bf_lo(ow.x) + bf_lo(gw.x) * a0[0], r1 = bf_hi(ow.x) + bf_hi(gw.x) * a0[1], r2 = bf_lo(ow.y) + bf_lo(gw.y) * a0[2], r3 = bf_hi(ow.y) + bf_hi(gw.y) * a0[3];
                    float r4 = bf_lo(ow.z) + bf_lo(gw.z) * a1[0], r5 = bf_hi(ow.z) + bf_hi(gw.z) * a1[1], r6 = bf_lo(ow.w) + bf_lo(gw.w) * a1[2], r7 = bf_hi(ow.w) + bf_hi(gw.w) * a1[3];
                    u32x4 w; w.x = cvt_pk_bf16(r0, r1); w.y = cvt_pk_bf16(r2, r3); w.z = cvt_pk_bf16(r4, r5); w.w = cvt_pk_bf16(r6, r7);
                    *(u32x4*)(rowp + bj * HALF) = w; } }
    }
};

template <class Epi, class Sched, bool ALIGN_EPI = false, bool SP2 = false>
__device__ __forceinline__ void gemm_phase(PG8_LAS unsigned char* lds, const Gemm g, const Sched& S, const Epi& E, int tid_) {
    asm volatile("" : "+v"(tid_));
    const int tid = tid_, wid = __builtin_amdgcn_readfirstlane(tid >> 6), lane = tid & 63, wr = wid >> 2, wc = wid & 3, fr = lane & 15, fq = lane >> 4;
    const int K = g.K, nt = K / BK;
    unsigned voffA[2], voffB[2];
#pragma unroll
    for (int i = 0; i < 2; ++i) { int R, C; stage_rc(tid * 16 + i * 8192, R, C); const int Rb = Epi::PERM ? ((R & ~31) + perm32(R & 31)) : R;
        voffA[i] = (unsigned)(R * K + C) * 2u; voffB[i] = (unsigned)(Rb * K + C) * 2u; }
    const size_t kstep = (size_t)(BK * 2);
    const size_t hstep = (size_t)HALF * K * 2;
    const size_t tstep = 2 * hstep;
    const unsigned ldsw = (unsigned)wid * 1024u;
    const int aoff = lds_byte(wr * 64 + fr, fq * 8), boff = lds_byte(wc * 32 + fr, fq * 8);
#define PG8_SA(b, h) (((b) * 2 + (h)) * HTB)
#define PG8_SB(b, h) ((4 + (b) * 2 + (h)) * HTB)
#define PG8_STAGE(bufoff, gbase, voff) do { _Pragma("unroll") for (int _i = 0; _i < 2; ++_i) \
        __builtin_amdgcn_global_load_lds((const unsigned*)((const char*)(gbase) + (voff)[_i]), (PG8_LAS unsigned*)(lds + (bufoff) + ldsw + _i * 8192), 16, 0, 0); } while (0)
#define PG8_LDA(dst, b, h) do { _Pragma("unroll") for (int m = 0; m < 4; ++m) _Pragma("unroll") for (int k = 0; k < 2; ++k) dst[m][k] = *(const PG8_LAS bf16x8*)(lds + PG8_SA(b, h) + aoff + m * 2048 + k * 1024); } while (0)
#define PG8_LDB(dst, b, h) do { _Pragma("unroll") for (int n = 0; n < 2; ++n) _Pragma("unroll") for (int k = 0; k < 2; ++k) dst[n][k] = *(const PG8_LAS bf16x8*)(lds + PG8_SB(b, h) + boff + n * 2048 + k * 1024); } while (0)
#define PG8_MMA(ai, bj, At, Bt) do { __builtin_amdgcn_s_setprio(1); _Pragma("unroll") for (int m = 0; m < 4; ++m) _Pragma("unroll") for (int n = 0; n < 2; ++n) _Pragma("unroll") for (int k = 0; k < 2; ++k) \
        acc[ai][bj][m][n] = __builtin_amdgcn_mfma_f32_16x16x32_bf16(Bt[n][k], At[m][k], acc[ai][bj][m][n], 0, 0, 0); __builtin_amdgcn_s_setprio(0); } while (0)
#define PG8_WAIT_V(n) asm volatile("s_waitcnt vmcnt(" #n ")" ::: "memory")
#define PG8_WAIT_L(n) asm volatile("s_waitcnt lgkmcnt(" #n ")" ::: "memory")
#define PG8_BAR __builtin_amdgcn_s_barrier()
#define PG8_SCHED __builtin_amdgcn_sched_barrier(0)
    Unit cur, nxt; int ui = 0;
    if (!S.next(0, cur)) return;
    f32x4 acc[2][2][4][2];
#pragma unroll
    for (int a = 0; a < 2; ++a)
#pragma unroll
        for (int b = 0; b < 2; ++b)
#pragma unroll
            for (int m = 0; m < 4; ++m)
#pragma unroll
                for (int n = 0; n < 2; ++n) acc[a][b][m][n] = (f32x4){0.f, 0.f, 0.f, 0.f};
    bf16x8 At[4][2], B0[2][2], B1[2][2];
    const char* cA = (const char*)g.A + (size_t)cur.pm * tstep; const char* cB = (const char*)g.Bt + (size_t)cur.pn * tstep;
    S.a_ready(cur);
    if constexpr (SP2) {
        PG8_STAGE(PG8_SB(0, 0), cB, voffB); PG8_STAGE(PG8_SB(0, 1), cB + hstep, voffB); PG8_STAGE(PG8_SA(0, 0), cA, voffA); PG8_STAGE(PG8_SA(0, 1), cA + hstep, voffA);
        if (wr == 1) PG8_BAR;
        PG8_WAIT_V(2); PG8_BAR;
        PG8_STAGE(PG8_SB(1, 0), cB + kstep, voffB); PG8_STAGE(PG8_SA(1, 0), cA + kstep, voffA); PG8_STAGE(PG8_SB(1, 1), cB + hstep + kstep, voffB);
        PG8_WAIT_V(6); PG8_BAR;
    } else {
        PG8_STAGE(PG8_SB(0, 0), cB, voffB); PG8_STAGE(PG8_SA(0, 0), cA, voffA); PG8_STAGE(PG8_SB(0, 1), cB + hstep, voffB); PG8_STAGE(PG8_SA(0, 1), cA + hstep, voffA);
        if (wr == 1) PG8_BAR;
        PG8_WAIT_V(4); PG8_BAR;
        PG8_STAGE(PG8_SB(1, 0), cB + kstep, voffB); PG8_STAGE(PG8_SA(1, 0), cA + kstep, voffA); PG8_STAGE(PG8_SB(1, 1), cB + hstep + kstep, voffB);
        PG8_WAIT_V(6); PG8_BAR;
    }
    for (;;) {
        const bool has_next = S.next(ui + 1, nxt);
        const char* nA = has_next ? (const char*)g.A + (size_t)nxt.pm * tstep : cA; const char* nB = has_next ? (const char*)g.Bt + (size_t)nxt.pn * tstep : cB;
        for (int t = 0; t < nt; t += 2) {
            const bool last = (t == nt - 2);
            const char* a1 = cA + (size_t)(t + 1) * kstep;
            const char* a2 = last ? nA : cA + (size_t)(t + 2) * kstep; const char* b2 = last ? nB : cB + (size_t)(t + 2) * kstep;
            const char* a3 = a2 + kstep; const char* b3 = b2 + kstep;
            if (last && has_next) S.a_ready(nxt);
            if constexpr (SP2) {
            PG8_LDB(B0, 0, 0); PG8_LDB(B1, 0, 1); PG8_SCHED; PG8_LDA(At, 0, 0); PG8_STAGE(PG8_SA(1, 1), a1 + hstep, voffA);
            PG8_WAIT_V(8); PG8_WAIT_L(0); PG8_BAR; PG8_MMA(0, 0, At, B0); PG8_MMA(0, 1, At, B1); PG8_BAR; PG8_SCHED;
            PG8_LDA(At, 0, 1); PG8_STAGE(PG8_SB(0, 0), b2, voffB); PG8_STAGE(PG8_SB(0, 1), b2 + hstep, voffB); PG8_STAGE(PG8_SA(0, 0), a2, voffA);
            PG8_WAIT_V(8); PG8_WAIT_L(0); PG8_BAR; PG8_MMA(1, 0, At, B0); PG8_MMA(1, 1, At, B1); PG8_BAR; PG8_SCHED;
            PG8_LDB(B0, 1, 0); PG8_LDB(B1, 1, 1); PG8_SCHED; PG8_LDA(At, 1, 0); PG8_STAGE(PG8_SA(0, 1), a2 + hstep, voffA);
            PG8_WAIT_V(8); PG8_WAIT_L(0); PG8_BAR; PG8_MMA(0, 0, At, B0); PG8_MMA(0, 1, At, B1); PG8_BAR; PG8_SCHED;
            PG8_LDA(At, 1, 1); PG8_STAGE(PG8_SB(1, 0), b3, voffB); PG8_STAGE(PG8_SB(1, 1), b3 + hstep, voffB); PG8_STAGE(PG8_SA(1, 0), a3, voffA);
            PG8_WAIT_V(8); PG8_WAIT_L(0); PG8_BAR; PG8_MMA(1, 0, At, B0); PG8_MMA(1, 1, At, B1); PG8_BAR; PG8_SCHED;
            } else {
            PG8_LDB(B0, 0, 0); PG8_SCHED; PG8_LDA(At, 0, 0); PG8_STAGE(PG8_SA(1, 1), a1 + hstep, voffA);
            PG8_WAIT_L(8); PG8_BAR; PG8_WAIT_L(0); PG8_MMA(0, 0, At, B0); PG8_BAR; PG8_SCHED;
            PG8_LDB(B1, 0, 1); PG8_STAGE(PG8_SB(0, 0), b2, voffB);
            PG8_BAR; PG8_WAIT_L(0); PG8_MMA(0, 1, At, B1); PG8_BAR;
            PG8_LDA(At, 0, 1); PG8_STAGE(PG8_SA(0, 0), a2, voffA);
            PG8_BAR; PG8_WAIT_L(0); PG8_MMA(1, 0, At, B0); PG8_BAR; PG8_SCHED;
            PG8_STAGE(PG8_SB(0, 1), b2 + hstep, voffB);
            PG8_WAIT_V(6); PG8_BAR; PG8_MMA(1, 1, At, B1); PG8_BAR;
            PG8_LDB(B0, 1, 0); PG8_SCHED; PG8_LDA(At, 1, 0); PG8_STAGE(PG8_SA(0, 1), a2 + hstep, voffA);
            PG8_WAIT_L(8); PG8_BAR; PG8_WAIT_L(0); PG8_MMA(0, 0, At, B0); PG8_BAR; PG8_SCHED;
            PG8_LDB(B1, 1, 1); PG8_STAGE(PG8_SB(1, 0), b3, voffB);
            PG8_BAR; PG8_WAIT_L(0); PG8_MMA(0, 1, At, B1); PG8_BAR;
            PG8_LDA(At, 1, 1); PG8_STAGE(PG8_SA(1, 0), a3, voffA);
            PG8_BAR; PG8_WAIT_L(0); PG8_MMA(1, 0, At, B0); PG8_BAR; PG8_SCHED;
            PG8_STAGE(PG8_SB(1, 1), b3 + hstep, voffB);
            PG8_WAIT_V(6); PG8_BAR; PG8_MMA(1, 1, At, B1); PG8_BAR;
            }
        }
        if constexpr (ALIGN_EPI) { if (wr == 0) PG8_BAR; }
        if constexpr (!Epi::AFTER_DRAIN) { E(acc, cur, wr, wc, fr, fq); S.done(cur); }
        if (!has_next) break;
#pragma unroll
        for (int a = 0; a < 2; ++a)
#pragma unroll
            for (int b = 0; b < 2; ++b)
#pragma unroll
                for (int m = 0; m < 4; ++m)
#pragma unroll
                    for (int n = 0; n < 2; ++n) acc[a][b][m][n] = (f32x4){0.f, 0.f, 0.f, 0.f};
        cur = nxt; cA = nA; cB = nB; ++ui;
        if constexpr (ALIGN_EPI) { if (wr == 1) PG8_BAR; }
    }
    PG8_WAIT_V(0);
    if constexpr (!ALIGN_EPI) { if (wr == 0) PG8_BAR; }
    PG8_BAR;
    if constexpr (Epi::AFTER_DRAIN) { E.fused(acc, cur, wr, wc, fr, fq, lds, wid, lane); S.done(cur); }
#undef PG8_SA
#undef PG8_SB
#undef PG8_STAGE
#undef PG8_LDA
#undef PG8_LDB
#undef PG8_MMA
#undef PG8_WAIT_V
#undef PG8_WAIT_L
#undef PG8_BAR
#undef PG8_SCHED
}
}
typedef unsigned short bf16;
#define LAS __attribute__((address_space(3)))
constexpr int T_TOK = 32768, DM = 2048, SEQ = 4096, NBATCH = 8, DEPTH = 4;
constexpr int IN_COLS = 13336, NP = 13568;
constexpr int C_MQ = 0, C_MK = 512, C_MV = 1024, C_MO = 2048, C_SZ = 3072, C_SXBC = 4096, C_AQ = 5632, C_AK = 6656, C_AV = 6912, C_G = 7168, C_SMALL = 13312;
constexpr int GATE_TILE_LO = C_G / 256, SMALL_TILE = C_SMALL / 256;
constexpr float ALPHA = 1.681792830507429f;
constexpr int P_EXPERTS = 16384;

constexpr size_t MiB = 1u << 20;
constexpr size_t WS_CTL = 0, CTL_ZERO_BYTES = 64 * 1024, WS_WIN = 1 * MiB, WS_WB = 54 * MiB, WS_WO = 66 * MiB, WS_WQ = 74 * MiB, WS_BIAS = 82 * MiB, WS_SKB = 82 * MiB + 256 * 1024, WS_SMALL = 83 * MiB, WS_ROPE = 87 * MiB,
                 WS_XB = 88 * MiB, WS_BUFB = 216 * MiB, WS_PROJ = 472 * MiB, WS_R1 = 1320 * MiB, WS_Y = 1480 * MiB, WS_R2 = 1672 * MiB, WS_HM = 1864 * MiB, WS_END = 1992 * MiB;
constexpr size_t WS_QF = WS_PROJ, WS_IDS = WS_PROJ + 256 * MiB, WS_GATES = WS_PROJ + 272 * MiB;
constexpr int CW_BAR = 4096;
constexpr int RING_BYTES = 131072, PHASE_LDS_BYTES = 155648, MISC_OFF = PHASE_LDS_BYTES + 320, LDS_BYTES = 163840;

__device__ __forceinline__ unsigned f2bf(float f) { unsigned u = __float_as_uint(f); return (u + 0x7fffu + ((u >> 16) & 1u)) >> 16; }
__device__ __forceinline__ unsigned pk2(float lo, float hi) { return f2bf(lo) | (f2bf(hi) << 16); }
__device__ __forceinline__ float bf2f(bf16 b) { return __uint_as_float(((unsigned)b) << 16); }
__device__ __forceinline__ float sigm(float x) { return 1.0f / (1.0f + expf(-x)); }
template <int CTRL> __device__ __forceinline__ float dpp_f(float v) { return __builtin_bit_cast(float, __builtin_amdgcn_update_dpp(0, __builtin_bit_cast(int, v), CTRL, 0xF, 0xF, true)); }
__device__ __forceinline__ float quad_sum(float v) { v += dpp_f<0xB1>(v); v += dpp_f<0x4E>(v); return v; }
__device__ __forceinline__ float wave_sum(float v) {
    v = quad_sum(v); v += dpp_f<0x141>(v); v += dpp_f<0x140>(v);
    v += __builtin_bit_cast(float, __builtin_amdgcn_ds_swizzle(__builtin_bit_cast(int, v), 0x401F));
    return __builtin_bit_cast(float, __builtin_amdgcn_readlane(__builtin_bit_cast(int, v), 0)) + __builtin_bit_cast(float, __builtin_amdgcn_readlane(__builtin_bit_cast(int, v), 32));
}
__device__ __forceinline__ int src_col(int n) {
    if (n < 3072) return n;
    if (n < 5632) return n + 8;
    if (n < 13312) return n + 24;
    if (n < 13320) return 3072 + (n - 13312);
    if (n < 13336) return 5640 + (n - 13320);
    return -1;
}

#define XB_TMO      128
#define XB_XCNT(j)  (256  + 64 * (j))
#define XB_XSUB(j)  (1280 + 64 * (j))
#define XB_XGEN(j)  (2304 + 64 * (j))
#define XB_TOP      3328
#define XB_TOPGEN   3392
#define XCD_BAR_WORDS 3456
#define XB_SPIN_CAP (1u << 18)

__device__ __forceinline__ unsigned xb_ld(unsigned* p)              { return __hip_atomic_load(p, __ATOMIC_RELAXED, __HIP_MEMORY_SCOPE_AGENT); }
__device__ __forceinline__ unsigned xb_add(unsigned* p, unsigned v) { return __hip_atomic_fetch_add(p, v, __ATOMIC_RELAXED, __HIP_MEMORY_SCOPE_AGENT); }
__device__ __forceinline__ unsigned xb_xcc_id() { return (unsigned)__builtin_amdgcn_s_getreg((3 << 11) | 20) & 0xFu; }
#define XB_SPIN(cond, bar) do { unsigned _sp = 0; while (cond) { __builtin_amdgcn_s_sleep(1); \
    if ((++_sp & 255u) == 0u) { if (xb_ld(&(bar)[XB_TMO])) break; if (_sp > XB_SPIN_CAP) { atomicAdd(&(bar)[XB_TMO], 1u); break; } } } } while (0)

struct XcdBarrier {
    unsigned* bar; unsigned x;
    volatile LAS unsigned* st;
};

__device__ __forceinline__ XcdBarrier xcd_barrier_post(unsigned* bar, volatile LAS unsigned* st) {
    XcdBarrier b; b.bar = bar; b.x = xb_xcc_id(); b.st = st;
    if (threadIdx.x == 0) (void)xb_add(&bar[XB_XCNT(b.x)], 1u);
    return b;
}
__device__ __forceinline__ void xcd_barrier_complete(unsigned* bar, unsigned x, unsigned& nloc, unsigned& nx) {
    const unsigned G = gridDim.x * gridDim.y * gridDim.z;
    unsigned sum, cnt, mine, sp = 0u;
    for (;;) {
        sum = 0u; cnt = 0u; mine = 0u;
#pragma unroll
        for (unsigned j = 0; j < 16; ++j) { const unsigned c = xb_ld(&bar[XB_XCNT(j)]); sum += c; cnt += (c > 0u) ? 1u : 0u; mine = (j == x) ? c : mine; }
        if (sum == G) break;
        __builtin_amdgcn_s_sleep(1);
        if ((++sp & 255u) == 0u) { if (xb_ld(&bar[XB_TMO])) break; if (sp > XB_SPIN_CAP) { atomicAdd(&bar[XB_TMO], 1u); break; } }
    }
    nloc = mine > 0u ? mine : 1u; nx = cnt > 0u ? cnt : 1u;
}

__device__ __forceinline__ void xcd_barrier(const XcdBarrier& b) {
    asm volatile("s_waitcnt vmcnt(0)" ::: "memory");
    __syncthreads();
    if (threadIdx.x == 0) {
        unsigned* bar = b.bar;
        __builtin_amdgcn_s_waitcnt(0);
        unsigned nloc = b.st[0], nx = b.st[1];
        if (nloc == 0u) { xcd_barrier_complete(bar, b.x, nloc, nx); b.st[0] = nloc; b.st[1] = nx; }
        const unsigned old = xb_add(&bar[XB_XSUB(b.x)], 1u);
        const unsigned gen = old / nloc;
        if (old + 1u == (gen + 1u) * nloc) {
            __builtin_amdgcn_fence(__ATOMIC_RELEASE, "agent");
            asm volatile("s_waitcnt vmcnt(0)" ::: "memory");
            const unsigned og = xb_add(&bar[XB_TOP], 1u);
            const unsigned tg = og / nx;
            if (og + 1u == (tg + 1u) * nx) xb_add(&bar[XB_TOPGEN], 1u);
            else XB_SPIN(xb_ld(&bar[XB_TOPGEN]) == tg, bar);
            __builtin_amdgcn_fence(__ATOMIC_ACQUIRE, "agent");
            xb_add(&bar[XB_XGEN(b.x)], 1u);
            asm volatile("s_waitcnt vmcnt(0)" ::: "memory");
        } else {
            XB_SPIN(xb_ld(&bar[XB_XGEN(b.x)]) == gen, bar);
            __builtin_amdgcn_fence(__ATOMIC_ACQUIRE, "agent");
            asm volatile("s_waitcnt vmcnt(0)" ::: "memory");
        }
    }
    __syncthreads();
}

__device__ __forceinline__ int fresh_tid(int wave0) { int l; asm volatile("v_mbcnt_lo_u32_b32 %0, -1, 0\n\tv_mbcnt_hi_u32_b32 %0, -1, %0" : "=v"(l)); return wave0 * 64 + l; }
#define PHASE_IDS int G = gridDim.x, bx = blockIdx.x; asm volatile("" : "+s"(G), "+s"(bx)); const int tid = fresh_tid(wave0), lane = tid & 63, wave = wave0; const int gw = bx * 8 + wave, NGW = G * 8; \
    const size_t gt = (size_t)bx * 512 + tid, NGT = (size_t)G * 512; (void)lane; (void)gw; (void)gt; (void)NGW; (void)NGT; (void)wave;

template <int MODE> __device__ __forceinline__ void transpose_item(const float* __restrict__ W, int K, int ldw, int ndst, bf16* __restrict__ WT, LAS float* scr, int item, int lane) {
    const int nblk = ndst / 32, kb = item / nblk, nb = item % nblk, k0 = 64 * kb, n0 = 32 * nb;
    const int n_l = n0 + (lane & 31); const int sc = MODE ? src_col(n_l) : n_l;
    float tv[32];
#pragma unroll
    for (int i = 0; i < 32; ++i) { const int kk = 2 * i + (lane >> 5); tv[i] = sc >= 0 ? W[(size_t)(k0 + kk) * ldw + sc] : 0.f; }
#pragma unroll
    for (int i = 0; i < 32; ++i) { const int kk = 2 * i + (lane >> 5); scr[kk * 33 + (lane & 31)] = tv[i]; }
    asm volatile("s_waitcnt lgkmcnt(0)" ::: "memory");
    const int c = lane & 7;
#pragma unroll
    for (int j = 0; j < 4; ++j) { const int n = (lane >> 3) + 8 * j; const LAS float* s = scr + (8 * c) * 33 + n;
        uint4 o; o.x = pk2(s[0 * 33], s[1 * 33]); o.y = pk2(s[2 * 33], s[3 * 33]); o.z = pk2(s[4 * 33], s[5 * 33]); o.w = pk2(s[6 * 33], s[7 * 33]);
        *(uint4*)(WT + (size_t)(n0 + n) * K + k0 + 8 * c) = o; }
    asm volatile("s_waitcnt lgkmcnt(0)" ::: "memory");
}

__device__ __forceinline__ void mlstm_post_tok(int t, int lane, const float* __restrict__ hm, const bf16* __restrict__ proj, const float* __restrict__ norm_w, bf16* __restrict__ ym) {
    float4 x[4], nw[4]; uint2 ov[4];
#pragma unroll
    for (int h = 0; h < 4; ++h) { const int c = h * 256 + lane * 4; x[h] = *(const float4*)(hm + (size_t)t * 1024 + c); nw[h] = *(const float4*)(norm_w + c); ov[h] = *(const uint2*)(proj + (size_t)t * NP + C_MO + c); }
#pragma unroll
    for (int h = 0; h < 4; ++h) {
        const float mu = wave_sum((x[h].x + x[h].y) + (x[h].z + x[h].w)) * (1.0f / 256.0f);
        const float d0 = x[h].x - mu, d1 = x[h].y - mu, d2 = x[h].z - mu, d3 = x[h].w - mu;
        const float rs = rsqrtf(wave_sum((d0 * d0 + d1 * d1) + (d2 * d2 + d3 * d3)) * (1.0f / 256.0f) + 1e-6f);
        const float y0 = d0 * rs * nw[h].x * sigm(__uint_as_float(ov[h].x << 16)), y1 = d1 * rs * nw[h].y * sigm(__uint_as_float(ov[h].x & 0xffff0000u));
        const float y2 = d2 * rs * nw[h].z * sigm(__uint_as_float(ov[h].y << 16)), y3 = d3 * rs * nw[h].w * sigm(__uint_as_float(ov[h].y & 0xffff0000u));
        *(uint2*)(ym + (size_t)t * 1024 + h * 256 + lane * 4) = make_uint2(pk2(y0, y1), pk2(y2, y3));
    }
}

__device__ __forceinline__ void ssd_conv_item(int item, const bf16* __restrict__ proj, const float* __restrict__ cw, const float* __restrict__ cb, bf16* __restrict__ xcb) {
    const int c8 = item % 192, tb = item / 192, t0 = tb * 4, pos0 = t0 % SEQ, c = c8 * 8;
    uint4 r[7];
#pragma unroll
    for (int j = 0; j < 7; ++j) { r[j] = make_uint4(0u, 0u, 0u, 0u); if (j >= 3 || pos0 > 0) r[j] = *(const uint4*)(proj + (size_t)(t0 - 3 + j) * NP + C_SXBC + c); }
    float w[4][8], bs[8];
#pragma unroll
    for (int j = 0; j < 4; ++j) { const float4 a = *(const float4*)(cw + j * 1536 + c), b = *(const float4*)(cw + j * 1536 + c + 4); w[j][0] = a.x; w[j][1] = a.y; w[j][2] = a.z; w[j][3] = a.w; w[j][4] = b.x; w[j][5] = b.y; w[j][6] = b.z; w[j][7] = b.w; }
    { const float4 a = *(const float4*)(cb + c), b = *(const float4*)(cb + c + 4); bs[0] = a.x; bs[1] = a.y; bs[2] = a.z; bs[3] = a.w; bs[4] = b.x; bs[5] = b.y; bs[6] = b.z; bs[7] = b.w; }
#pragma unroll
    for (int o = 0; o < 4; ++o) {
        float acc[8];
#pragma unroll
        for (int i = 0; i < 8; ++i) acc[i] = bs[i];
#pragma unroll
        for (int j = 0; j < 4; ++j) { const unsigned rw[4] = {r[o + j].x, r[o + j].y, r[o + j].z, r[o + j].w};
#pragma unroll
            for (int i = 0; i < 4; ++i) { acc[2 * i] += w[j][2 * i] * __uint_as_float(rw[i] << 16); acc[2 * i + 1] += w[j][2 * i + 1] * __uint_as_float(rw[i] & 0xffff0000u); } }
        uint4 ov; ov.x = pk2(acc[0] * sigm(acc[0]), acc[1] * sigm(acc[1])); ov.y = pk2(acc[2] * sigm(acc[2]), acc[3] * sigm(acc[3])); ov.z = pk2(acc[4] * sigm(acc[4]), acc[5] * sigm(acc[5])); ov.w = pk2(acc[6] * sigm(acc[6]), acc[7] * sigm(acc[7]));
        *(uint4*)(xcb + (size_t)(t0 + o) * 1536 + c) = ov;
    }
}
__device__ __forceinline__ void ssd_post_tok2(int tp, int lane, const float* __restrict__ yraw, const bf16* __restrict__ proj, const float* __restrict__ norm_w, bf16* __restrict__ ys) {
    float4 ya[4], yb[4]; uint4 zv[4];
#pragma unroll
    for (int i = 0; i < 4; ++i) { const int t = 2 * tp + (i >> 1), c = (i & 1) * 512 + lane * 8; ya[i] = *(const float4*)(yraw + (size_t)t * 1024 + c); yb[i] = *(const float4*)(yraw + (size_t)t * 1024 + c + 4); zv[i] = *(const uint4*)(proj + (size_t)t * NP + C_SZ + c); }
#pragma unroll
    for (int i = 0; i < 4; ++i) { const int t = 2 * tp + (i >> 1), c = (i & 1) * 512 + lane * 8;
        const float yv[8] = {ya[i].x, ya[i].y, ya[i].z, ya[i].w, yb[i].x, yb[i].y, yb[i].z, yb[i].w}; const unsigned zw[4] = {zv[i].x, zv[i].y, zv[i].z, zv[i].w};
        float y[8], ss = 0.f;
#pragma unroll
        for (int k = 0; k < 4; ++k) { const float z0 = __uint_as_float(zw[k] << 16), z1 = __uint_as_float(zw[k] & 0xffff0000u); y[2 * k] = yv[2 * k] * (z0 * sigm(z0)); y[2 * k + 1] = yv[2 * k + 1] * (z1 * sigm(z1)); ss += y[2 * k] * y[2 * k] + y[2 * k + 1] * y[2 * k + 1]; }
        const float rs = rsqrtf(wave_sum(ss) * (1.0f / 512.0f) + 1e-6f);
        const float4 n0 = *(const float4*)(norm_w + c), n1 = *(const float4*)(norm_w + c + 4);
        *(uint4*)(ys + (size_t)t * 1024 + c) = make_uint4(pk2(y[0] * rs * n0.x, y[1] * rs * n0.y), pk2(y[2] * rs * n0.z, y[3] * rs * n0.w), pk2(y[4] * rs * n1.x, y[5] * rs * n1.y), pk2(y[6] * rs * n1.z, y[7] * rs * n1.w));
    }
}

__device__ __forceinline__ void ln_body2(int tp, int lane, const float* in, const float* __restrict__ g, const float* __restrict__ bta, float* outf, bf16* __restrict__ outb) {
    float4 v[2][8];
#pragma unroll
    for (int r = 0; r < 2; ++r)
#pragma unroll
        for (int j = 0; j < 8; ++j) v[r][j] = *(const float4*)(in + (size_t)(2 * tp + r) * DM + j * 256 + lane * 4);
    { int z_ = 0; asm volatile("" : "+s"(z_)); g += z_; bta += z_; }
#pragma unroll
    for (int r = 0; r < 2; ++r) {
        const int t = 2 * tp + r; float s = 0.f;
#pragma unroll
        for (int j = 0; j < 8; ++j) s += (v[r][j].x + v[r][j].y) + (v[r][j].z + v[r][j].w);
        const float mu = wave_sum(s) * (1.0f / DM); float q = 0.f;
#pragma unroll
        for (int j = 0; j < 8; ++j) { v[r][j].x -= mu; v[r][j].y -= mu; v[r][j].z -= mu; v[r][j].w -= mu; q += (v[r][j].x * v[r][j].x + v[r][j].y * v[r][j].y) + (v[r][j].z * v[r][j].z + v[r][j].w * v[r][j].w); }
        const float rs = rsqrtf(wave_sum(q) * (1.0f / DM) + 1e-5f);
#pragma unroll
        for (int j = 0; j < 8; ++j) { const int c = j * 256 + lane * 4; const float4 gg = *(const float4*)(g + c), bb = *(const float4*)(bta + c);
            float4 y; y.x = v[r][j].x * rs * gg.x + bb.x; y.y = v[r][j].y * rs * gg.y + bb.y; y.z = v[r][j].z * rs * gg.z + bb.z; y.w = v[r][j].w * rs * gg.w + bb.w;
            *(float4*)(outf + (size_t)t * DM + c) = y; *(uint2*)(outb + (size_t)t * DM + c) = make_uint2(pk2(y.x, y.y), pk2(y.z, y.w)); }
    }
}

__device__ __forceinline__ float gelu_erf(float v) {
    const float av = fabsf(v), t = __builtin_amdgcn_rcpf(av * 0.2316418882f + 1.0f);
    float q = t * 0.5307027145f + (-0.7265760135f); q = q * t + 0.7107068705f; q = q * t + (-0.142248368f); q = q * t + 0.127414796f; q = q * t;
    const float e = __builtin_amdgcn_exp2f((v * v) * (-0.72134752044f));
    const float mm = v * (q * e), r = v - mm;
    return v < 0.f ? mm : r;
}
typedef unsigned u32x4e_t __attribute__((ext_vector_type(4)));
constexpr float U6_SCALE = 64.0f, V6_SCALE = 8.0f;
constexpr int ROW6 = DM * 6 / 8;
typedef float v32f_t __attribute__((ext_vector_type(32)));
typedef __bf16 v32b_t __attribute__((ext_vector_type(32)));
typedef unsigned v6u_t __attribute__((ext_vector_type(6)));
__device__ __forceinline__ void tab_to_fp6(size_t i, const float* __restrict__ src, unsigned char* __restrict__ dst, float sc) {
    const float4* s = (const float4*)src + i * 8; v32b_t b;
#pragma unroll
    for (int j = 0; j < 8; ++j) { const float4 v = s[j]; b[4 * j] = (__bf16)(v.x * sc); b[4 * j + 1] = (__bf16)(v.y * sc); b[4 * j + 2] = (__bf16)(v.z * sc); b[4 * j + 3] = (__bf16)(v.w * sc); }
    const v6u_t p = __builtin_amdgcn_cvt_scalef32_pk32_fp6_bf16(b, 1.0f);
    uint2* d = (uint2*)(dst + i * 24); d[0] = make_uint2(p[0], p[1]); d[1] = make_uint2(p[2], p[3]); d[2] = make_uint2(p[4], p[5]);
}
__device__ __forceinline__ void peer_expert_body(int t, int lane, const float* __restrict__ x1, const int* __restrict__ ids, const float* __restrict__ gates, const unsigned char* __restrict__ U6, const unsigned char* __restrict__ V6,
                                                 const float* __restrict__ g, const float* __restrict__ bta, float* __restrict__ outf, bf16* outb  , LAS unsigned* wl  ) {
    asm volatile("" : "+v"(lane));
    int idA = ids[(size_t)t * 128 + lane], idB = ids[(size_t)t * 128 + 64 + lane]; float gA = gates[(size_t)t * 128 + lane], gB = gates[(size_t)t * 128 + 64 + lane];
    {
        const unsigned kA = ((unsigned)idA << 7) | (unsigned)lane, kB = ((unsigned)idB << 7) | (unsigned)(64 + lane);
        wl[lane] = kA; wl[64 + lane] = kB;
        asm volatile("s_waitcnt lgkmcnt(0)" ::: "memory");
        int rA = 0, rB = 0;
#pragma unroll 8
        for (int j = 0; j < 128; j += 4) { const u32x4e_t k4 = *(const LAS u32x4e_t*)(wl + j);
#pragma unroll
            for (int q = 0; q < 4; ++q) { rA += (k4[q] < kA) ? 1 : 0; rB += (k4[q] < kB) ? 1 : 0; } }
        asm volatile("s_waitcnt lgkmcnt(0)" ::: "memory");
        wl[128 + rA] = (unsigned)idA; wl[256 + rA] = __float_as_uint(gA); wl[128 + rB] = (unsigned)idB; wl[256 + rB] = __float_as_uint(gB);
        asm volatile("s_waitcnt lgkmcnt(0)" ::: "memory");
        idA = (int)wl[128 + lane]; idB = (int)wl[192 + lane]; gA = __uint_as_float(wl[256 + lane]); gB = __uint_as_float(wl[320 + lane]);
        asm volatile("s_waitcnt lgkmcnt(0)" ::: "memory");
    }
#define ID_OF(e_) __builtin_amdgcn_readlane((e_) < 64 ? idA : idB, (e_) & 63)
#define GATE_OF(e_) __builtin_bit_cast(float, __builtin_amdgcn_readlane(__builtin_bit_cast(int, (e_) < 64 ? gA : gB), (e_) & 63))
    uint2 ra[8][3], rb[8][3];
#define ROW_LOAD(R_, T_, e_) do { _Pragma("unroll") for (int k_ = 0; k_ < 8; ++k_) { const int id_ = ID_OF((e_) + k_); \
        const uint2* p_ = (const uint2*)((T_) + (size_t)id_ * ROW6) + lane * 3; R_[k_][0] = p_[0]; R_[k_][1] = p_[1]; R_[k_][2] = p_[2]; } } while (0)
#define PK6(W_) ((v6u_t){W_[0].x, W_[0].y, W_[1].x, W_[1].y, W_[2].x, W_[2].y})
#define SB_ __builtin_amdgcn_sched_barrier(0)
    float c0 = 0.f, c1 = 0.f;
    {
        unsigned xb[16];
#pragma unroll
        for (int i = 0; i < 4; ++i) { const uint4 v = *(const uint4*)(outb + (size_t)t * DM + lane * 32 + i * 8); xb[4 * i] = v.x; xb[4 * i + 1] = v.y; xb[4 * i + 2] = v.z; xb[4 * i + 3] = v.w; }
#define U_COMP(R_, e_) do { _Pragma("unroll") for (int k_ = 0; k_ < 8; ++k_) { SB_; const v32f_t d_ = __builtin_amdgcn_cvt_scalef32_pk32_f32_fp6(PK6(R_[k_]), 1.0f); float a_ = 0.f, b_ = 0.f; \
            _Pragma("unroll") for (int i_ = 0; i_ < 16; ++i_) { a_ += d_[2 * i_] * __uint_as_float(xb[i_] << 16); b_ += d_[2 * i_ + 1] * __uint_as_float(xb[i_] & 0xffff0000u); } \
            const float s_ = wave_sum(a_ + b_) * (1.0f / U6_SCALE); const float cv_ = GATE_OF((e_) + k_) * (1.0f / V6_SCALE) * gelu_erf(s_); \
            const int ee_ = (e_) + k_; c0 = (lane == ee_) ? cv_ : c0; c1 = (lane == ee_ - 64) ? cv_ : c1; } SB_; } while (0)
        ROW_LOAD(ra, U6, 0);
#pragma nounroll
        for (int e = 0; e < 128; e += 16) {
            ROW_LOAD(rb, U6, e + 8);
            U_COMP(ra, e);
            if (e + 16 < 128) ROW_LOAD(ra, U6, e + 16);
            U_COMP(rb, e + 8);
        }
#undef U_COMP
    }
    v32f_t acc;
#pragma unroll
    for (int i = 0; i < 32; ++i) acc[i] = 0.f;
#define V_COMP(R_, e_) do { _Pragma("unroll") for (int k_ = 0; k_ < 8; ++k_) { SB_; const int ee_ = (e_) + k_; \
            const float cv_ = __builtin_bit_cast(float, __builtin_amdgcn_readlane(__builtin_bit_cast(int, ee_ < 64 ? c0 : c1), ee_ & 63)); \
            acc += __builtin_amdgcn_cvt_scalef32_pk32_f32_fp6(PK6(R_[k_]), 1.0f) * cv_; } SB_; } while (0)
    ROW_LOAD(ra, V6, 0);
#pragma nounroll
    for (int e = 0; e < 128; e += 16) {
        ROW_LOAD(rb, V6, e + 8);
        V_COMP(ra, e);
        if (e + 16 < 128) ROW_LOAD(ra, V6, e + 16);
        V_COMP(rb, e + 8);
    }
#undef V_COMP
#undef ID_OF
#undef GATE_OF
#undef ROW_LOAD
#undef PK6
#undef SB_
    float s = 0.f;
#pragma unroll
    for (int i = 0; i < 8; ++i) { const float4 v = *(const float4*)(x1 + (size_t)t * DM + lane * 32 + i * 4); acc[4 * i] += ALPHA * v.x; acc[4 * i + 1] += ALPHA * v.y; acc[4 * i + 2] += ALPHA * v.z; acc[4 * i + 3] += ALPHA * v.w; }
#pragma unroll
    for (int i = 0; i < 32; ++i) s += acc[i];
    const float mu = wave_sum(s) * (1.0f / DM); float q = 0.f;
#pragma unroll
    for (int i = 0; i < 32; ++i) { acc[i] -= mu; q += acc[i] * acc[i]; }
    const float rs = rsqrtf(wave_sum(q) * (1.0f / DM) + 1e-5f);
    { int z_ = 0; asm volatile("" : "+s"(z_)); g += z_; bta += z_; }
#pragma unroll
    for (int i = 0; i < 8; ++i) { const int c = lane * 32 + i * 4; const float4 gg = *(const float4*)(g + c), bb = *(const float4*)(bta + c);
        float4 y; y.x = acc[4 * i] * rs * gg.x + bb.x; y.y = acc[4 * i + 1] * rs * gg.y + bb.y; y.z = acc[4 * i + 2] * rs * gg.z + bb.z; y.w = acc[4 * i + 3] * rs * gg.w + bb.w;
        *(float4*)(outf + (size_t)t * DM + c) = y; *(uint2*)(outb + (size_t)t * DM + c) = make_uint2(pk2(y.x, y.y), pk2(y.z, y.w)); }
}

typedef short bf16x8_t __attribute__((ext_vector_type(8)));
typedef float f32x4_t __attribute__((ext_vector_type(4)));
typedef unsigned u32x2_t __attribute__((ext_vector_type(2)));
typedef unsigned u32x4_t __attribute__((ext_vector_type(4)));
constexpr int SWA_PITCH = 144;
constexpr int SWA_KS = 0, SWA_VS = 256 * SWA_PITCH, SWA_LDS = 2 * 256 * SWA_PITCH;
static_assert(SWA_LDS <= RING_BYTES, "SWA LDS");
__device__ __forceinline__ float grp4_max(float v) {
    v = fmaxf(v, __builtin_bit_cast(float, __builtin_amdgcn_ds_swizzle(__builtin_bit_cast(int, v), 0x401F)));
    const u32x2_t r = __builtin_amdgcn_permlane32_swap(__builtin_bit_cast(unsigned, v), __builtin_bit_cast(unsigned, v), false, false);
    return fmaxf(__builtin_bit_cast(float, r.x), __builtin_bit_cast(float, r.y));
}
__device__ __forceinline__ float grp4_sum(float v) {
    v += __builtin_bit_cast(float, __builtin_amdgcn_ds_swizzle(__builtin_bit_cast(int, v), 0x401F));
    const u32x2_t r = __builtin_amdgcn_permlane32_swap(__builtin_bit_cast(unsigned, v), __builtin_bit_cast(unsigned, v), false, false);
    return __builtin_bit_cast(float, r.x) + __builtin_bit_cast(float, r.y);
}
__device__ __forceinline__ void tr_read2(unsigned a0, unsigned a1, u32x2_t& r0, u32x2_t& r1) {
    asm volatile("ds_read_b64_tr_b16 %0, %2\n\tds_read_b64_tr_b16 %1, %3\n\ts_waitcnt lgkmcnt(0)" : "=&v"(r0), "=&v"(r1) : "v"(a0), "v"(a1) : "memory");
}
__device__ __forceinline__ void rope8(uint4& lo, uint4& hi, const float4* cs, float scale) {
    unsigned* a = (unsigned*)&lo; unsigned* b = (unsigned*)&hi;
#pragma unroll
    for (int j = 0; j < 4; ++j) {
        const float x1a = __uint_as_float(a[j] << 16), x1b = __uint_as_float(a[j] & 0xffff0000u), x2a = __uint_as_float(b[j] << 16), x2b = __uint_as_float(b[j] & 0xffff0000u);
        const float4 c = cs[j];
        const float y1a = (x1a * c.x - x2a * c.y) * scale, y2a = (x2a * c.x + x1a * c.y) * scale, y1b = (x1b * c.z - x2b * c.w) * scale, y2b = (x2b * c.z + x1b * c.w) * scale;
        a[j] = pk2(y1a, y1b); b[j] = pk2(y2a, y2b);
    }
}
__device__ __forceinline__ void swa_phase(LAS unsigned char* lds, const bf16* __restrict__ proj, const float* __restrict__ rtab  , const float* __restrict__ sinks, bf16* __restrict__ ya,
                                          int tid, int bx, int G) {
    const int lane = tid & 63, w = __builtin_amdgcn_readfirstlane(tid >> 6), l15 = lane & 15, g4 = lane >> 4;
    const unsigned ldsb = (unsigned)(size_t)lds;
    for (int u = bx; u < NBATCH * 32 * 4; u += G) {
        const int kvh = u & 3, nb = (u >> 2) & 31, b = u >> 7;
        const int t0 = b * SEQ + nb * 128;
        __syncthreads();
        for (int it = tid; it < 1024; it += 512) { const int kk = it >> 2, c = it & 3;
            uint4 lo = make_uint4(0u, 0u, 0u, 0u), hi = lo;
            if (nb > 0 || kk >= 128) { const bf16* src = proj + (size_t)(t0 - 128 + kk) * NP + C_AK + kvh * 64 + 8 * c; lo = *(const uint4*)src; hi = *(const uint4*)(src + 32);
                const float4* cs = (const float4*)(rtab + ((size_t)(nb * 128 - 128 + kk) * 32 + 8 * c) * 2); const float4 c4[4] = {cs[0], cs[1], cs[2], cs[3]}; rope8(lo, hi, c4, 1.0f); }
            *(LAS u32x4_t*)(lds + SWA_KS + kk * SWA_PITCH + 16 * c) = __builtin_bit_cast(u32x4_t, lo); *(LAS u32x4_t*)(lds + SWA_KS + kk * SWA_PITCH + 64 + 16 * c) = __builtin_bit_cast(u32x4_t, hi); }
        for (int it = tid; it < 2048; it += 512) { const int kk = it >> 3, c = it & 7;
            uint4 v = make_uint4(0u, 0u, 0u, 0u);
            if (nb > 0 || kk >= 128) v = *(const uint4*)(proj + (size_t)(t0 - 128 + kk) * NP + C_AV + kvh * 64 + 8 * c);
            *(LAS u32x4_t*)(lds + SWA_VS + kk * SWA_PITCH + 16 * c) = __builtin_bit_cast(u32x4_t, v); }
        __syncthreads();
        const int r = w >> 1, hf = w & 1, hq = kvh * 4 + r;
        const float sink = sinks[hq];
#pragma nounroll
        for (int qt = 0; qt < 4; ++qt) {
            const int i0 = 64 * hf + 16 * qt, iq = i0 + l15, tq = t0 + iq, ktb0 = 4 * hf + qt;
            bf16x8_t q0, q1;
            { const bf16* src = proj + (size_t)tq * NP + C_AQ + hq * 64 + 8 * g4; uint4 lo = *(const uint4*)src, hi = *(const uint4*)(src + 32);
              const float4* cs = (const float4*)(rtab + ((size_t)(nb * 128 + iq) * 32 + 8 * g4) * 2); const float4 c4[4] = {cs[0], cs[1], cs[2], cs[3]}; rope8(lo, hi, c4, 0.125f);
              q0 = __builtin_bit_cast(bf16x8_t, lo); q1 = __builtin_bit_cast(bf16x8_t, hi); }
            f32x4_t s[10]; float m = sink;
#pragma unroll
            for (int n = 0; n < 10; ++n) {
                const int kt = (ktb0 + n) < 15 ? (ktb0 + n) : 15;
                const LAS unsigned char* kp = lds + SWA_KS + (16 * kt + l15) * SWA_PITCH + 16 * g4;
                const bf16x8_t a0 = *(const LAS bf16x8_t*)kp, a1 = *(const LAS bf16x8_t*)(kp + 64);
                f32x4_t acc = (f32x4_t){0.f, 0.f, 0.f, 0.f};
                acc = __builtin_amdgcn_mfma_f32_16x16x32_bf16(a0, q0, acc, 0, 0, 0);
                acc = __builtin_amdgcn_mfma_f32_16x16x32_bf16(a1, q1, acc, 0, 0, 0);
#pragma unroll
                for (int e = 0; e < 4; ++e) { const int kk = 16 * (ktb0 + n) + 4 * g4 + e;
                    const bool ok = (kk >= iq + 1) && (kk <= iq + 128) && (nb > 0 || kk >= 128) && (ktb0 + n <= 15);
                    acc[e] = ok ? acc[e] : -1e30f; m = fmaxf(m, acc[e]); }
                s[n] = acc;
            }
            m = grp4_max(m);
            float lsum = 0.f;
#pragma unroll
            for (int n = 0; n < 10; ++n)
#pragma unroll
                for (int e = 0; e < 4; ++e) { const float p = __expf(s[n][e] - m); s[n][e] = p; lsum += p; }
            lsum = grp4_sum(lsum) + __expf(sink - m);
            const float inv = 1.0f / lsum;
            bf16x8_t pf[5];
#pragma unroll
            for (int pi = 0; pi < 5; ++pi) { uint4 w4; w4.x = pk2(s[2 * pi][0], s[2 * pi][1]); w4.y = pk2(s[2 * pi][2], s[2 * pi][3]); w4.z = pk2(s[2 * pi + 1][0], s[2 * pi + 1][1]); w4.w = pk2(s[2 * pi + 1][2], s[2 * pi + 1][3]);
                pf[pi] = __builtin_bit_cast(bf16x8_t, w4); }
            const int qq = l15 >> 2, pp = lane & 3;
#pragma unroll
            for (int dt = 0; dt < 4; ++dt) {
                f32x4_t o = (f32x4_t){0.f, 0.f, 0.f, 0.f};
#pragma unroll
                for (int pi = 0; pi < 5; ++pi) {
                    const int ka = (ktb0 + 2 * pi) < 15 ? (ktb0 + 2 * pi) : 15, kb = (ktb0 + 2 * pi + 1) < 15 ? (ktb0 + 2 * pi + 1) : 15;
                    u32x2_t v0, v1;
                    tr_read2(ldsb + SWA_VS + (16 * ka + 4 * g4 + qq) * SWA_PITCH + (16 * dt + 4 * pp) * 2, ldsb + SWA_VS + (16 * kb + 4 * g4 + qq) * SWA_PITCH + (16 * dt + 4 * pp) * 2, v0, v1);
                    const uint4 av = make_uint4(v0.x, v0.y, v1.x, v1.y);
                    o = __builtin_amdgcn_mfma_f32_16x16x32_bf16(__builtin_bit_cast(bf16x8_t, av), pf[pi], o, 0, 0, 0);
                }
                *(uint2*)(ya + (size_t)tq * 1024 + hq * 64 + 16 * dt + 4 * g4) = make_uint2(pk2(o[0] * inv, o[1] * inv), pk2(o[2] * inv, o[3] * inv));
            }
        }
    }
}

constexpr int ML_QP = 272, ML_VP = 112, ML_PP = 144;
constexpr int ML_Q = 0, ML_K = 2 * 64 * ML_QP, ML_V = ML_K + 2 * 64 * ML_QP, ML_VW = ML_V + 2 * 64 * ML_VP, ML_P = ML_VW + 64 * ML_VP, ML_CT = ML_P + 64 * ML_PP,
              ML_VEC = ML_CT + 48 * ML_QP, ML_END = ML_VEC + 4096;
static_assert(ML_END <= RING_BYTES, "mLSTM LDS");
__device__ __forceinline__ void tr_read2q(unsigned a0, unsigned a1, u32x2_t& r0, u32x2_t& r1) {
    asm volatile("ds_read_b64_tr_b16 %0, %2\n\tds_read_b64_tr_b16 %1, %3\n\ts_waitcnt lgkmcnt(0)" : "=&v"(r0), "=&v"(r1) : "v"(a0), "v"(a1) : "memory");
}
__device__ __forceinline__ bf16x8_t mk_frag(u32x2_t lo, u32x2_t hi) { const u32x4_t v = (u32x4_t){lo.x, lo.y, hi.x, hi.y}; return __builtin_bit_cast(bf16x8_t, v); }
#define LBAR() do { asm volatile("s_waitcnt lgkmcnt(0)" ::: "memory"); __builtin_amdgcn_s_barrier(); asm volatile("" ::: "memory"); } while (0)
__device__ __forceinline__ void mlstm_phase(LAS unsigned char* lds, const bf16* __restrict__ proj, const float* __restrict__ small, const float* __restrict__ gate_b, float* __restrict__ hm, int tid, int bx, int G) {
    const int lane = tid & 63, w = __builtin_amdgcn_readfirstlane(tid >> 6), l15 = lane & 15, g4 = lane >> 4, qq = l15 >> 2, pp = lane & 3;
    const unsigned ldsb = (unsigned)(size_t)lds;
    LAS float* vec = (LAS float*)(lds + ML_VEC);
    for (int u = bx; u < NBATCH * 4 * 8; u += G) {
        const int vs = u & 7, h = (u >> 3) & 3, b = u >> 5;
        const float bi = gate_b[h], bfg = gate_b[4 + h];
        LBAR();
        for (int i = tid; i < 2 * 64; i += 512) { LAS unsigned* p = (LAS unsigned*)(lds + ML_V + i * ML_VP + 64); p[0] = 0x00003F80u;
#pragma unroll
            for (int j = 1; j < 8; ++j) p[j] = 0u; }
        for (int i = tid; i < 48 * ML_QP / 4; i += 512) ((LAS unsigned*)(lds + ML_CT))[i] = 0u;
        f32x4_t cacc[3];
#pragma unroll
        for (int i = 0; i < 3; ++i) cacc[i] = (f32x4_t){0.f, 0.f, 0.f, 0.f};
        uint4 pq[2], pk[2], pv; float pgi = 0.f, pgf = 0.f;
        pv = make_uint4(0u, 0u, 0u, 0u);
#define ML_LOAD(c_) do { const size_t tb_ = (size_t)b * SEQ + (size_t)(c_) * 64; \
            _Pragma("unroll") for (int i_ = 0; i_ < 2; ++i_) { const int p_ = tid + 512 * i_, row_ = p_ >> 4, c16_ = p_ & 15; const bf16* s_ = proj + (tb_ + row_) * NP + h * 128 + c16_ * 8; pq[i_] = *(const uint4*)(s_ + C_MQ); pk[i_] = *(const uint4*)(s_ + C_MK); } \
            if (tid < 256) pv = *(const uint4*)(proj + (tb_ + (tid >> 2)) * NP + C_MV + h * 256 + vs * 32 + (tid & 3) * 8); \
            if (tid >= 256 && tid < 320) { pgi = small[(tb_ + (tid - 256)) * 32 + h]; pgf = small[(tb_ + (tid - 256)) * 32 + 4 + h]; } } while (0)
#define ML_STORE(bi_) do { _Pragma("unroll") for (int i_ = 0; i_ < 2; ++i_) { const int p_ = tid + 512 * i_, row_ = p_ >> 4, c16_ = p_ & 15; \
                *(LAS u32x4_t*)(lds + ML_Q + (bi_) * 64 * ML_QP + row_ * ML_QP + c16_ * 16) = __builtin_bit_cast(u32x4_t, pq[i_]); *(LAS u32x4_t*)(lds + ML_K + (bi_) * 64 * ML_QP + row_ * ML_QP + c16_ * 16) = __builtin_bit_cast(u32x4_t, pk[i_]); } \
            if (tid < 256) *(LAS u32x4_t*)(lds + ML_V + (bi_) * 64 * ML_VP + (tid >> 2) * ML_VP + (tid & 3) * 16) = __builtin_bit_cast(u32x4_t, pv); \
            if (tid >= 256 && tid < 320) { vec[(bi_) * 128 + (tid - 256) * 2] = pgi; vec[(bi_) * 128 + (tid - 256) * 2 + 1] = pgf; } } while (0)
        ML_LOAD(0); ML_STORE(0);
        LBAR();
#pragma nounroll
        for (int c = 0; c < 64; ++c) {
            const int bi_cur = c & 1;
            const LAS unsigned char* Qs = lds + ML_Q + bi_cur * 64 * ML_QP; const LAS unsigned char* Ks = lds + ML_K + bi_cur * 64 * ML_QP;
            const unsigned Ksb = ldsb + ML_K + bi_cur * 64 * ML_QP, Vsb = ldsb + ML_V + bi_cur * 64 * ML_VP, Vwb = ldsb + ML_VW;
            if (c + 1 < 64) ML_LOAD(c + 1);
            if (w == 0) {
                const float ip = vec[bi_cur * 128 + lane * 2] + bi, fp = vec[bi_cur * 128 + lane * 2 + 1] + bfg;
                const float lf = fminf(fp, 0.f) - log1pf(__expf(-fabsf(fp)));
                vec[256 + lane] = lf;
                asm volatile("s_waitcnt lgkmcnt(0)" ::: "memory");
                float bsum = 0.f;
#pragma unroll
                for (int j = 0; j < 64; j += 4) { const f32x4_t v4 = *(const LAS f32x4_t*)(vec + 256 + j);
                    bsum += (j + 0 <= lane) ? v4[0] : 0.f; bsum += (j + 1 <= lane) ? v4[1] : 0.f; bsum += (j + 2 <= lane) ? v4[2] : 0.f; bsum += (j + 3 <= lane) ? v4[3] : 0.f; }
                const float gtot = __builtin_bit_cast(float, __builtin_amdgcn_readlane(__builtin_bit_cast(int, bsum), 63));
                vec[320 + lane] = bsum; vec[384 + lane] = ip - bsum; vec[448 + lane] = __expf(bsum); vec[512 + lane] = __expf(gtot - bsum + ip) * 0.08838834764831845f;
                if (lane == 0) vec[640] = __expf(gtot);
            }
            LBAR();
            {
                const int ti = w >> 1;
#pragma unroll
                for (int sj = 0; sj < 2; ++sj) {
                    const int si = 2 * (w & 1) + sj;
                    f32x4_t acc = (f32x4_t){0.f, 0.f, 0.f, 0.f};
                    if (si <= ti) {
#pragma unroll
                        for (int ks = 0; ks < 4; ++ks) {
                            const bf16x8_t a = *(const LAS bf16x8_t*)(Ks + (16 * si + l15) * ML_QP + (32 * ks + 8 * g4) * 2);
                            const bf16x8_t bq = *(const LAS bf16x8_t*)(Qs + (16 * ti + l15) * ML_QP + (32 * ks + 8 * g4) * 2);
                            acc = __builtin_amdgcn_mfma_f32_16x16x32_bf16(a, bq, acc, 0, 0, 0);
                        }
                        const int t = 16 * ti + l15; const float btv = vec[320 + t];
                        const f32x4_t csv = *(const LAS f32x4_t*)(vec + 384 + 16 * si + 4 * g4);
#pragma unroll
                        for (int e = 0; e < 4; ++e) { const int s = 16 * si + 4 * g4 + e; acc[e] = (s <= t) ? acc[e] * __expf(btv + csv[e]) * 0.08838834764831845f : 0.f; }
                    }
                    *(LAS u32x2_t*)(lds + ML_P + (16 * ti + l15) * ML_PP + (16 * si + 4 * g4) * 2) = (u32x2_t){pk2(acc[0], acc[1]), pk2(acc[2], acc[3])};
                }
            }
            if (tid < 384) { const int s = tid / 6, pc = tid % 6; const float wsv = vec[512 + s];
                const u32x4_t v = *(const LAS u32x4_t*)(lds + ML_V + bi_cur * 64 * ML_VP + s * ML_VP + pc * 16); u32x4_t o;
#pragma unroll
                for (int j = 0; j < 4; ++j) o[j] = pk2(__uint_as_float(v[j] << 16) * wsv, __uint_as_float(v[j] & 0xffff0000u) * wsv);
                *(LAS u32x4_t*)(lds + ML_VW + s * ML_VP + pc * 16) = o; }
            LBAR();
            f32x4_t numv[2]; const int ti5 = w >> 1;
            {
                const int nv = (w & 1) ? 1 : 2, v0 = (w & 1) ? 2 : 0;
#pragma unroll
                for (int j = 0; j < 2; ++j) {
                    numv[j] = (f32x4_t){0.f, 0.f, 0.f, 0.f};
                    if (j < nv) {
                        const int vi = v0 + j;
                        f32x4_t ai = (f32x4_t){0.f, 0.f, 0.f, 0.f}, ax = ai;
#pragma unroll
                        for (int ks = 0; ks < 2; ++ks) {
                            const bf16x8_t a = *(const LAS bf16x8_t*)(lds + ML_P + (16 * ti5 + l15) * ML_PP + (32 * ks + 8 * g4) * 2);
                            u32x2_t r0, r1; tr_read2q(Vsb + (32 * ks + 8 * g4 + qq) * ML_VP + (16 * vi + 4 * pp) * 2, Vsb + (32 * ks + 8 * g4 + 4 + qq) * ML_VP + (16 * vi + 4 * pp) * 2, r0, r1);
                            ai = __builtin_amdgcn_mfma_f32_16x16x32_bf16(a, mk_frag(r0, r1), ai, 0, 0, 0);
                        }
#pragma unroll
                        for (int ks = 0; ks < 4; ++ks) {
                            const bf16x8_t a = *(const LAS bf16x8_t*)(Qs + (16 * ti5 + l15) * ML_QP + (32 * ks + 8 * g4) * 2);
                            const bf16x8_t bc = *(const LAS bf16x8_t*)(lds + ML_CT + (16 * vi + l15) * ML_QP + (32 * ks + 8 * g4) * 2);
                            ax = __builtin_amdgcn_mfma_f32_16x16x32_bf16(a, bc, ax, 0, 0, 0);
                        }
                        const f32x4_t eb = *(const LAS f32x4_t*)(vec + 448 + 16 * ti5 + 4 * g4);
                        numv[j] = ai + eb * ax;
                    }
                }
                if ((w & 1) && l15 == 0) *(LAS f32x4_t*)(vec + 576 + 16 * ti5 + 4 * g4) = numv[0];
            }
            LBAR();
            if (!(w & 1)) {
                const f32x4_t dn = *(const LAS f32x4_t*)(vec + 576 + 16 * ti5 + 4 * g4);
                const size_t tb = (size_t)b * SEQ + (size_t)c * 64;
#pragma unroll
                for (int j = 0; j < 2; ++j)
#pragma unroll
                    for (int e = 0; e < 4; ++e) hm[(tb + 16 * ti5 + 4 * g4 + e) * 1024 + h * 256 + vs * 32 + 16 * j + l15] = numv[j][e] / fmaxf(fabsf(dn[e]), 1.0f);
            }
            {
                const float eg = vec[640];
#pragma unroll
                for (int vi = 0; vi < 3; ++vi) {
                    f32x4_t acc = cacc[vi] * eg;
#pragma unroll
                    for (int ks = 0; ks < 2; ++ks) {
                        u32x2_t a0, a1, b0, b1;
                        tr_read2q(Ksb + (32 * ks + 8 * g4 + qq) * ML_QP + (16 * w + 4 * pp) * 2, Ksb + (32 * ks + 8 * g4 + 4 + qq) * ML_QP + (16 * w + 4 * pp) * 2, a0, a1);
                        tr_read2q(Vwb + (32 * ks + 8 * g4 + qq) * ML_VP + (16 * vi + 4 * pp) * 2, Vwb + (32 * ks + 8 * g4 + 4 + qq) * ML_VP + (16 * vi + 4 * pp) * 2, b0, b1);
                        acc = __builtin_amdgcn_mfma_f32_16x16x32_bf16(mk_frag(a0, a1), mk_frag(b0, b1), acc, 0, 0, 0);
                    }
                    cacc[vi] = acc;
                    *(LAS u32x2_t*)(lds + ML_CT + (16 * vi + l15) * ML_QP + (16 * w + 4 * g4) * 2) = (u32x2_t){pk2(acc[0], acc[1]), pk2(acc[2], acc[3])};
                }
            }
            if (c + 1 < 64) ML_STORE(bi_cur ^ 1);
            LBAR();
        }
#undef ML_LOAD
#undef ML_STORE
    }
}

constexpr int SD_BP = 272, SD_XP = 80;
constexpr int SD_B = 0, SD_C = 128 * SD_BP, SD_M = 2 * 128 * SD_BP, SD_H = 3 * 128 * SD_BP, SD_X = SD_H + 32 * SD_BP, SD_XW = SD_X + 128 * SD_XP, SD_VEC = SD_XW + 128 * SD_XP, SD_END = SD_VEC + 4096;
static_assert(SD_END <= PHASE_LDS_BYTES, "SSD LDS");
__device__ __forceinline__ void ssd_phase(LAS unsigned char* lds, const bf16* __restrict__ xcb  , const float* __restrict__ small, const float* __restrict__ dt_bias, const float* __restrict__ a_log,
                                          const float* __restrict__ dsk, float* __restrict__ yraw  , int tid, int bx, int G) {
    const int lane = tid & 63, w = __builtin_amdgcn_readfirstlane(tid >> 6), l15 = lane & 15, g4 = lane >> 4, qq = l15 >> 2, pp = lane & 3;
    const unsigned ldsb = (unsigned)(size_t)lds;
    LAS float* vec = (LAS float*)(lds + SD_VEC);
    for (int u = bx; u < NBATCH * 16 * 2; u += G) {
        const int ph = u & 1, hh = (u >> 1) & 15, b = u >> 5, g = hh >> 3;
        const float a = -__expf(a_log[hh]), dtb = dt_bias[hh], Dk = dsk[hh];
        LBAR();
        for (int i = tid; i < 32 * SD_BP / 4; i += 512) ((LAS unsigned*)(lds + SD_H))[i] = 0u;
        f32x4_t hacc[2];
        hacc[0] = (f32x4_t){0.f, 0.f, 0.f, 0.f}; hacc[1] = hacc[0];
        uint4 pb[4], pc[4], px; float pdt = 0.f;
#define SD_LOAD(c_) do { const size_t tb_ = (size_t)b * SEQ + (size_t)(c_) * 128; \
            _Pragma("unroll") for (int i_ = 0; i_ < 4; ++i_) { const int p_ = tid + 512 * i_, row_ = p_ >> 4, c16_ = p_ & 15; const bf16* s_ = xcb + (tb_ + row_) * 1536 + 1024 + g * 128 + c16_ * 8; pb[i_] = *(const uint4*)s_; pc[i_] = *(const uint4*)(s_ + 256); } \
            px = *(const uint4*)(xcb + (tb_ + (tid >> 2)) * 1536 + hh * 64 + ph * 32 + (tid & 3) * 8); \
            if (tid < 128) pdt = small[(tb_ + tid) * 32 + 8 + hh]; } while (0)
#define SD_STORE() do { _Pragma("unroll") for (int i_ = 0; i_ < 4; ++i_) { const int p_ = tid + 512 * i_, row_ = p_ >> 4, c16_ = p_ & 15; \
                *(LAS u32x4_t*)(lds + SD_B + row_ * SD_BP + c16_ * 16) = __builtin_bit_cast(u32x4_t, pb[i_]); *(LAS u32x4_t*)(lds + SD_C + row_ * SD_BP + c16_ * 16) = __builtin_bit_cast(u32x4_t, pc[i_]); } \
            *(LAS u32x4_t*)(lds + SD_X + (tid >> 2) * SD_XP + (tid & 3) * 16) = __builtin_bit_cast(u32x4_t, px); \
            if (tid < 128) vec[tid] = pdt; } while (0)
        SD_LOAD(0); SD_STORE();
        LBAR();
#pragma nounroll
        for (int c = 0; c < 32; ++c) {
            if (c + 1 < 32) SD_LOAD(c + 1);
            if (w < 2) {
                const float dtr = vec[tid] + dtb; const float dt = dtr > 20.f ? dtr : log1pf(__expf(dtr));
                vec[640 + tid] = dt; vec[128 + tid] = dt * a;
            }
            LBAR();
            if (w < 2) {
                float acs = 0.f;
#pragma unroll 8
                for (int j = 0; j < 128; j += 4) { const f32x4_t v4 = *(const LAS f32x4_t*)(vec + 128 + j);
                    acs += (j + 0 <= tid) ? v4[0] : 0.f; acs += (j + 1 <= tid) ? v4[1] : 0.f; acs += (j + 2 <= tid) ? v4[2] : 0.f; acs += (j + 3 <= tid) ? v4[3] : 0.f; }
                vec[256 + tid] = acs; vec[384 + tid] = __expf(acs);
                if (tid == 127) { vec[768] = acs; vec[769] = __expf(acs); }
            }
            LBAR();
            if (w < 2) { const float atot = vec[768]; vec[512 + tid] = __expf(atot - vec[256 + tid]) * vec[640 + tid]; }
            {
                const int li = w; const int l = 16 * li + l15; const float acl = vec[256 + l];
#pragma unroll
                for (int si = 0; si < 8; ++si) {
                    f32x4_t acc = (f32x4_t){0.f, 0.f, 0.f, 0.f};
                    if (si <= li) {
#pragma unroll
                        for (int ks = 0; ks < 4; ++ks) {
                            const bf16x8_t av = *(const LAS bf16x8_t*)(lds + SD_B + (16 * si + l15) * SD_BP + (32 * ks + 8 * g4) * 2);
                            const bf16x8_t bv = *(const LAS bf16x8_t*)(lds + SD_C + (16 * li + l15) * SD_BP + (32 * ks + 8 * g4) * 2);
                            acc = __builtin_amdgcn_mfma_f32_16x16x32_bf16(av, bv, acc, 0, 0, 0);
                        }
                        const f32x4_t acs = *(const LAS f32x4_t*)(vec + 256 + 16 * si + 4 * g4), dts = *(const LAS f32x4_t*)(vec + 640 + 16 * si + 4 * g4);
#pragma unroll
                        for (int e = 0; e < 4; ++e) { const int s = 16 * si + 4 * g4 + e; acc[e] = (s <= l) ? acc[e] * __expf(acl - acs[e]) * dts[e] : 0.f; }
                    }
                    *(LAS u32x2_t*)(lds + SD_M + l * SD_BP + (16 * si + 4 * g4) * 2) = (u32x2_t){pk2(acc[0], acc[1]), pk2(acc[2], acc[3])};
                }
            }
            LBAR();
            { const int s = tid >> 2, pcx = tid & 3; const float wv = vec[512 + s];
              const u32x4_t v = *(const LAS u32x4_t*)(lds + SD_X + s * SD_XP + pcx * 16); u32x4_t o;
#pragma unroll
              for (int j = 0; j < 4; ++j) o[j] = pk2(__uint_as_float(v[j] << 16) * wv, __uint_as_float(v[j] & 0xffff0000u) * wv);
              *(LAS u32x4_t*)(lds + SD_XW + s * SD_XP + pcx * 16) = o; }
            {
                const int li = w; const size_t tb = (size_t)b * SEQ + (size_t)c * 128;
                const f32x4_t eac = *(const LAS f32x4_t*)(vec + 384 + 16 * li + 4 * g4);
#pragma unroll
                for (int pi = 0; pi < 2; ++pi) {
                    f32x4_t yd = (f32x4_t){0.f, 0.f, 0.f, 0.f}, yo = yd;
#pragma unroll
                    for (int ks = 0; ks < 4; ++ks) {
                        if (32 * ks <= 16 * li + 15) {
                            const bf16x8_t av = *(const LAS bf16x8_t*)(lds + SD_M + (16 * li + l15) * SD_BP + (32 * ks + 8 * g4) * 2);
                            u32x2_t r0, r1; tr_read2q(ldsb + SD_X + (32 * ks + 8 * g4 + qq) * SD_XP + (16 * pi + 4 * pp) * 2, ldsb + SD_X + (32 * ks + 8 * g4 + 4 + qq) * SD_XP + (16 * pi + 4 * pp) * 2, r0, r1);
                            yd = __builtin_amdgcn_mfma_f32_16x16x32_bf16(av, mk_frag(r0, r1), yd, 0, 0, 0);
                        }
                    }
#pragma unroll
                    for (int ks = 0; ks < 4; ++ks) {
                        const bf16x8_t av = *(const LAS bf16x8_t*)(lds + SD_C + (16 * li + l15) * SD_BP + (32 * ks + 8 * g4) * 2);
                        const bf16x8_t bh = *(const LAS bf16x8_t*)(lds + SD_H + (16 * pi + l15) * SD_BP + (32 * ks + 8 * g4) * 2);
                        yo = __builtin_amdgcn_mfma_f32_16x16x32_bf16(av, bh, yo, 0, 0, 0);
                    }
#pragma unroll
                    for (int e = 0; e < 4; ++e) { const int l = 16 * li + 4 * g4 + e;
                        const float xv = __uint_as_float(((unsigned)*(const LAS unsigned short*)(lds + SD_X + l * SD_XP + (16 * pi + l15) * 2)) << 16);
                        yraw[(tb + l) * 1024 + hh * 64 + ph * 32 + 16 * pi + l15] = yd[e] + eac[e] * yo[e] + Dk * xv; }
                }
            }
            LBAR();
            {
                const float ea = vec[769];
#pragma unroll
                for (int pi = 0; pi < 2; ++pi) {
                    f32x4_t acc = hacc[pi] * ea;
#pragma unroll
                    for (int ks = 0; ks < 4; ++ks) {
                        u32x2_t a0, a1, b0, b1;
                        tr_read2q(ldsb + SD_B + (32 * ks + 8 * g4 + qq) * SD_BP + (16 * w + 4 * pp) * 2, ldsb + SD_B + (32 * ks + 8 * g4 + 4 + qq) * SD_BP + (16 * w + 4 * pp) * 2, a0, a1);
                        tr_read2q(ldsb + SD_XW + (32 * ks + 8 * g4 + qq) * SD_XP + (16 * pi + 4 * pp) * 2, ldsb + SD_XW + (32 * ks + 8 * g4 + 4 + qq) * SD_XP + (16 * pi + 4 * pp) * 2, b0, b1);
                        acc = __builtin_amdgcn_mfma_f32_16x16x32_bf16(mk_frag(a0, a1), mk_frag(b0, b1), acc, 0, 0, 0);
                    }
                    hacc[pi] = acc;
                    *(LAS u32x2_t*)(lds + SD_H + (16 * pi + l15) * SD_BP + (16 * w + 4 * g4) * 2) = (u32x2_t){pk2(acc[0], acc[1]), pk2(acc[2], acc[3])};
                }
            }
            LBAR();
            if (c + 1 < 32) SD_STORE();
            LBAR();
        }
#undef SD_LOAD
#undef SD_STORE
    }
}

constexpr int PS_SKP = 272;
constexpr int PS_SK = 0, PS_END = 2 * 128 * PS_SKP;
static_assert(PS_END <= PHASE_LDS_BYTES, "PEER select LDS");
__device__ __forceinline__ unsigned fkey(float f) { const unsigned u = __float_as_uint(f); return u ^ ((unsigned)((int)u >> 31) | 0x80000000u); }
__device__ __forceinline__ float funkey(unsigned k) { return __uint_as_float((k & 0x80000000u) ? (k ^ 0x80000000u) : ~k); }
template <int CTRL> __device__ __forceinline__ unsigned dpp_u(unsigned v) { return (unsigned)__builtin_amdgcn_update_dpp(0, (int)v, CTRL, 0xF, 0xF, true); }
__device__ __forceinline__ unsigned umax(unsigned a, unsigned b) { return a > b ? a : b; }
__device__ __forceinline__ unsigned row_umax(unsigned v) { v = umax(v, dpp_u<0xB1>(v)); v = umax(v, dpp_u<0x4E>(v)); v = umax(v, dpp_u<0x141>(v)); v = umax(v, dpp_u<0x140>(v)); return v; }
__device__ __forceinline__ float row_sum(float v) { v += dpp_f<0xB1>(v); v += dpp_f<0x4E>(v); v += dpp_f<0x141>(v); v += dpp_f<0x140>(v); return v; }
template <int N> __device__ __forceinline__ unsigned row_top16(unsigned (&s)[N], int l15) {
    unsigned mine = 0u;
#pragma unroll
    for (int j = 0; j < 16; ++j) {
        unsigned m = s[0];
#pragma unroll
        for (int i = 1; i < N; ++i) m = umax(m, s[i]);
        m = row_umax(m);
        mine = (l15 == j) ? m : mine;
#pragma unroll
        for (int i = 0; i < N; ++i) s[i] = (s[i] == m) ? 0u : s[i];
    }
    return mine;
}
__device__ __forceinline__ void peer_select_phase(LAS unsigned char* lds, const bf16* __restrict__ qb  , const bf16* __restrict__ skb  , int* __restrict__ ids, float* __restrict__ gates,
                                                  int tid, int bx, int G) {
    const int lane = tid & 63, w = __builtin_amdgcn_readfirstlane(tid >> 6), l15 = lane & 15, g4 = lane >> 4;
    int ca[4], cb[4];
#pragma unroll
    for (int i = 0; i < 4; ++i) { const int sg = 4 * l15 + i; int a = 0, base = 0;
#pragma unroll
        for (int k = 0; k < 15; ++k) { const int cnt = 16 / (k + 1); const bool adv = (a == k) && (sg >= base + cnt); base += adv ? cnt : 0; a += adv ? 1 : 0; }
        ca[i] = a; cb[i] = sg - base; if (sg >= 50) { ca[i] = -1; cb[i] = 0; } }
    for (int u = bx; u < 8 * 32; u += G) {
        const int h = u >> 5, tr = u & 31;
        LBAR();
        for (int it = tid; it < 4096; it += 512) { const int row = it >> 4, c16 = it & 15;
            *(LAS u32x4_t*)(lds + PS_SK + row * PS_SKP + c16 * 16) = __builtin_bit_cast(u32x4_t, *(const uint4*)(skb + ((size_t)h * 256 + row) * 128 + c16 * 8)); }
        LBAR();
#pragma nounroll
        for (int tile = w; tile < 64; tile += 8) {
            const int t0 = tr * 1024 + tile * 16;
            unsigned top[2][4];
#pragma unroll
            for (int c = 0; c < 2; ++c) {
                bf16x8_t af[4];
#pragma unroll
                for (int ks = 0; ks < 4; ++ks) af[ks] = __builtin_bit_cast(bf16x8_t, *(const uint4*)(qb + (size_t)(t0 + l15) * DM + h * 256 + c * 128 + 32 * ks + 8 * g4));
                unsigned key[8][4];
#pragma unroll
                for (int kt = 0; kt < 8; ++kt) {
                    f32x4_t acc = (f32x4_t){0.f, 0.f, 0.f, 0.f};
#pragma unroll
                    for (int ks = 0; ks < 4; ++ks) {
                        const bf16x8_t bfr = *(const LAS bf16x8_t*)(lds + PS_SK + (c * 128 + 16 * kt + l15) * PS_SKP + (32 * ks + 8 * g4) * 2);
                        acc = __builtin_amdgcn_mfma_f32_16x16x32_bf16(af[ks], bfr, acc, 0, 0, 0);
                    }
#pragma unroll
                    for (int e = 0; e < 4; ++e) key[kt][e] = (fkey(acc[e]) & ~0x7Fu) | (unsigned)(127 - (16 * kt + l15));
                }
#pragma unroll
                for (int e = 0; e < 4; ++e) { unsigned s8[8];
#pragma unroll
                    for (int kt = 0; kt < 8; ++kt) s8[kt] = key[kt][e];
                    __builtin_amdgcn_sched_barrier(0); top[c][e] = row_top16<8>(s8, l15); __builtin_amdgcn_sched_barrier(0); }
            }
#pragma unroll
            for (int e = 0; e < 4; ++e) {
                unsigned s4[4];
#pragma unroll
                for (int i = 0; i < 4; ++i) {
                    const int srcA = ((lane & 48) + (ca[i] < 0 ? 0 : ca[i])) * 4, srcB = ((lane & 48) + cb[i]) * 4;
                    const unsigned ka = (unsigned)__builtin_amdgcn_ds_bpermute(srcA, (int)top[0][e]), kb = (unsigned)__builtin_amdgcn_ds_bpermute(srcB, (int)top[1][e]);
                    const float cv = funkey(ka & ~0x7Fu) + funkey(kb & ~0x7Fu);
                    s4[i] = ca[i] < 0 ? 0u : ((fkey(cv) & ~0xFFu) | (unsigned)(255 - (ca[i] * 16 + cb[i])));
                }
                __builtin_amdgcn_sched_barrier(0); const unsigned win = row_top16<4>(s4, l15); __builtin_amdgcn_sched_barrier(0);
                const int jw = 255 - (int)(win & 0xFFu), wa = jw >> 4, wb = jw & 15;
                const unsigned ka = (unsigned)__builtin_amdgcn_ds_bpermute(((lane & 48) + wa) * 4, (int)top[0][e]), kb = (unsigned)__builtin_amdgcn_ds_bpermute(((lane & 48) + wb) * 4, (int)top[1][e]);
                const float bv = funkey(ka & ~0x7Fu) + funkey(kb & ~0x7Fu);
                const int id = (127 - (int)(ka & 0x7Fu)) * 128 + (127 - (int)(kb & 0x7Fu));
                const float mx = __builtin_bit_cast(float, __builtin_amdgcn_ds_bpermute((lane & 48) * 4, __builtin_bit_cast(int, bv)));
                const float ex = __expf(bv - mx), den = row_sum(ex);
                const size_t o = (size_t)(t0 + 4 * g4 + e) * 128 + h * 16 + l15;
                ids[o] = id; gates[o] = ex / den;
            }
        }
    }
}

struct MegaArgs { const float* in[22]; float* out; unsigned char* ws; };
template <int I> __device__ __forceinline__ unsigned long long ld_ptr() {
    unsigned long long v; const auto ka = __builtin_amdgcn_kernarg_segment_ptr();
    asm volatile("s_load_dwordx2 %0, %1, %2\n\ts_waitcnt lgkmcnt(0)" : "=s"(v) : "s"(ka), "n"(I * 8) : "memory");
    return v;
}
#define GAS_ __attribute__((address_space(1)))
#define INF(i) ((const float*)(const GAS_ float*)ld_ptr<(i)>())
#define OUTP ((float*)(GAS_ float*)ld_ptr<22>())
#define WSP ((unsigned char*)(GAS_ unsigned char*)ld_ptr<23>())
enum { I_X = 0, I_WIN, I_MGATEB, I_MNORMW, I_CONVW, I_CONVB, I_DTB, I_ALOG, I_SSMD, I_SNORMW, I_SINKS, I_MERGEB, I_WBR, I_WOUT, I_LN1G, I_LN1B, I_WQ, I_SUBK, I_PU, I_PV, I_LN2G, I_LN2B };

__global__ void __launch_bounds__(512, 2) mega_fwd(MegaArgs a) {
    extern __shared__ __attribute__((aligned(16))) unsigned char lds_raw[];
    LAS unsigned char* lds = (LAS unsigned char*)lds_raw;
    const int wave0 = __builtin_amdgcn_readfirstlane(threadIdx.x >> 6);
    volatile LAS unsigned* MISC = (volatile LAS unsigned*)(lds + MISC_OFF);
    { PHASE_IDS for (int u = tid; u < (LDS_BYTES - PHASE_LDS_BYTES) / 4; u += 512) ((LAS unsigned*)(lds + PHASE_LDS_BYTES))[u] = 0u; }
    __syncthreads();
    { XcdBarrier b0 = xcd_barrier_post((unsigned*)(WSP + WS_CTL) + CW_BAR, MISC + 8); (void)b0; }
#define GRID_BAR() do { XcdBarrier b_; b_.bar = (unsigned*)(WSP + WS_CTL) + CW_BAR; b_.x = xb_xcc_id(); b_.st = MISC + 8; xcd_barrier(b_); } while (0)

    { PHASE_IDS float2* rt = (float2*)(WSP + WS_ROPE);
      for (size_t i = gt; i < (size_t)SEQ * 32; i += NGT) { const int pos = (int)(i >> 5), fi = (int)(i & 31); const float ang = (float)pos * powf(10000.0f, -(float)fi / 32.0f); rt[i] = make_float2(cosf(ang), sinf(ang)); } }
    { PHASE_IDS const float* x = INF(I_X); bf16* xb = (bf16*)(WSP + WS_XB);
      for (size_t i = gt; i < (size_t)T_TOK * DM / 4; i += NGT) { const float4 v = ((const float4*)x)[i]; ((uint2*)xb)[i] = make_uint2(pk2(v.x, v.y), pk2(v.z, v.w)); } }

#pragma nounroll
    for (int l = 0; l < DEPTH; ++l) {
        { PHASE_IDS
            unsigned char* ws = WSP; bf16* WinT = (bf16*)(ws + WS_WIN); bf16* WbT = (bf16*)(ws + WS_WB); bf16* WoT = (bf16*)(ws + WS_WO); bf16* WqT = (bf16*)(ws + WS_WQ); float* bias = (float*)(ws + WS_BIAS);
            const float* w_in = INF(I_WIN) + (size_t)l * DM * IN_COLS; const float* w_branch = INF(I_WBR) + (size_t)l * 3 * 1024 * DM; const float* w_out = INF(I_WOUT) + (size_t)l * DM * DM; const float* peer_wq = INF(I_WQ) + (size_t)l * DM * DM;
            const float* merge_gate_b = INF(I_MERGEB) + (size_t)l * 3 * DM;
            LAS float* scr = (LAS float*)(lds + wave * 16384);
            constexpr int I_IN = (DM / 64) * (NP / 32), I_B = (1024 / 64) * (DM / 32), I_O = (DM / 64) * (DM / 32);
            constexpr int NITEMS = I_IN + 3 * I_B + 2 * I_O;
            for (int it = gw; it < NITEMS; it += NGW) {
                int r = it;
                if (r < I_IN) { transpose_item<1>(w_in, DM, IN_COLS, NP, WinT, scr, r, lane); continue; } r -= I_IN;
                if (r < 3 * I_B) { const int k = r / I_B; transpose_item<0>(w_branch + (size_t)k * 1024 * DM, 1024, DM, DM, WbT + (size_t)k * DM * 1024, scr, r - k * I_B, lane); continue; } r -= 3 * I_B;
                if (r < I_O) { transpose_item<0>(w_out, DM, DM, DM, WoT, scr, r, lane); continue; } r -= I_O;
                transpose_item<0>(peer_wq, DM, DM, DM, WqT, scr, r, lane);
            }
            for (size_t n = gt; n < NP; n += NGT) bias[n] = (n >= C_G && n < C_SMALL) ? merge_gate_b[n - C_G] : 0.f;
            { const float4* sk = (const float4*)(INF(I_SUBK) + (size_t)l * 8 * 2 * 128 * 128); uint2* skb = (uint2*)(ws + WS_SKB);
              for (size_t n = gt; n < 8 * 2 * 128 * 128 / 4; n += NGT) { const float4 v = sk[n]; skb[n] = make_uint2(pk2(v.x, v.y), pk2(v.z, v.w)); } }
        }
        GRID_BAR();
        { PHASE_IDS unsigned char* ws = WSP; pg8::Gemm g{(const bf16*)(ws + WS_XB), (const bf16*)(ws + WS_WIN), T_TOK, NP, DM}; pg8::StaticOrder S; S.init(T_TOK, NP, G, bx);
          pg8::EpiProj E{(bf16*)(ws + WS_PROJ), (const float*)(ws + WS_BIAS), (float*)(ws + WS_SMALL), NP, GATE_TILE_LO, SMALL_TILE, 0};
          pg8::gemm_phase<pg8::EpiProj, pg8::StaticOrder, true, true>(lds, g, S, E, tid); }
        GRID_BAR();
        { PHASE_IDS unsigned char* ws = WSP; const bf16* proj = (const bf16*)(ws + WS_PROJ); bf16* xcb = (bf16*)(ws + WS_R2);
          const float* cw = INF(I_CONVW) + (size_t)l * 4 * 1536; const float* cb = INF(I_CONVB) + l * 1536;
          for (int i = (int)gt; i < 192 * (T_TOK / 4); i += (int)NGT) ssd_conv_item(i, proj, cw, cb, xcb); }
        GRID_BAR();
        { PHASE_IDS unsigned char* ws = WSP; mlstm_phase(lds, (const bf16*)(ws + WS_PROJ), (const float*)(ws + WS_SMALL), INF(I_MGATEB) + l * 8, (float*)(ws + WS_HM), tid, bx, G); }
        { PHASE_IDS unsigned char* ws = WSP; ssd_phase(lds, (const bf16*)(ws + WS_R2), (const float*)(ws + WS_SMALL), INF(I_DTB) + l * 16, INF(I_ALOG) + l * 16, INF(I_SSMD) + l * 16, (float*)(ws + WS_R1), tid, bx, G); }
        { PHASE_IDS unsigned char* ws = WSP; swa_phase(lds, (const bf16*)(ws + WS_PROJ), (const float*)(ws + WS_ROPE), INF(I_SINKS) + l * 16, (bf16*)(ws + WS_Y + 128 * MiB), tid, bx, G); }
        GRID_BAR();
        { PHASE_IDS unsigned char* ws = WSP; const bf16* proj = (const bf16*)(ws + WS_PROJ); const float* hm = (const float*)(ws + WS_HM); bf16* ym = (bf16*)(ws + WS_Y); const float* nw = INF(I_MNORMW) + l * 1024;
          for (int t = gw; t < T_TOK; t += NGW) mlstm_post_tok(t, lane, hm, proj, nw, ym); }
        { PHASE_IDS unsigned char* ws = WSP; const bf16* proj = (const bf16*)(ws + WS_PROJ); const float* yraw = (const float*)(ws + WS_R1); bf16* ys = (bf16*)(ws + WS_Y + 64 * MiB); const float* nw = INF(I_SNORMW) + l * 1024;
          for (int tp = gw; tp < T_TOK / 2; tp += NGW) ssd_post_tok2(tp, lane, yraw, proj, nw, ys); }
        GRID_BAR();
        { PHASE_IDS unsigned char* ws = WSP; pg8::Gemm g{(const bf16*)(ws + WS_Y), (const bf16*)(ws + WS_WB), T_TOK, DM, 1024}; pg8::StaticOrder S; S.init(T_TOK, DM, G, bx);
          pg8::EpiMix<1> E{(bf16*)(ws + WS_R1), (const bf16*)(ws + WS_PROJ) + C_G, DM, NP};
          pg8::gemm_phase<pg8::EpiMix<1>, pg8::StaticOrder, true, true>(lds, g, S, E, tid); }
        __syncthreads();
        { PHASE_IDS unsigned char* ws = WSP; pg8::Gemm g{(const bf16*)(ws + WS_Y + 64 * MiB), (const bf16*)(ws + WS_WB) + (size_t)DM * 1024, T_TOK, DM, 1024}; pg8::StaticOrder S; S.init(T_TOK, DM, G, bx);
          pg8::EpiMix<0> E{(bf16*)(ws + WS_R1), (const bf16*)(ws + WS_PROJ) + C_G + DM, DM, NP};
          pg8::gemm_phase<pg8::EpiMix<0>, pg8::StaticOrder, true, true>(lds, g, S, E, tid); }
        __syncthreads();
        { PHASE_IDS unsigned char* ws = WSP; pg8::Gemm g{(const bf16*)(ws + WS_Y + 128 * MiB), (const bf16*)(ws + WS_WB) + (size_t)2 * DM * 1024, T_TOK, DM, 1024}; pg8::StaticOrder S; S.init(T_TOK, DM, G, bx);
          pg8::EpiMix<0> E{(bf16*)(ws + WS_R1), (const bf16*)(ws + WS_PROJ) + C_G + 2 * DM, DM, NP};
          pg8::gemm_phase<pg8::EpiMix<0>, pg8::StaticOrder, true, true>(lds, g, S, E, tid); }
        GRID_BAR();
        { PHASE_IDS unsigned char* ws = WSP; const float* xin = l == 0 ? INF(I_X) : (const float*)OUTP;
          pg8::Gemm g{(const bf16*)(ws + WS_R1), (const bf16*)(ws + WS_WO), T_TOK, DM, DM}; pg8::StaticOrder S; S.init(T_TOK, DM, G, bx); pg8::EpiResid E{(float*)(ws + WS_BUFB), xin, DM, ALPHA};
          pg8::gemm_phase<pg8::EpiResid, pg8::StaticOrder, true, true>(lds, g, S, E, tid); }
        GRID_BAR();
        { PHASE_IDS unsigned char* ws = WSP; float* bufB = (float*)(ws + WS_BUFB); bf16* xb = (bf16*)(ws + WS_XB); const float* g1 = INF(I_LN1G) + l * DM; const float* b1 = INF(I_LN1B) + l * DM;
          for (int tp = gw; tp < T_TOK / 2; tp += NGW) ln_body2(tp, lane, bufB, g1, b1, bufB, xb); }
        { PHASE_IDS unsigned char* ws = WSP; constexpr size_t NGRP = (size_t)P_EXPERTS * DM / 32;
          const float* pu = INF(I_PU) + (size_t)l * P_EXPERTS * DM; const float* pv = INF(I_PV) + (size_t)l * P_EXPERTS * DM; unsigned char* U6 = ws + WS_R2; unsigned char* V6 = ws + WS_R2 + 32 * MiB;
          for (size_t i = gt; i < NGRP; i += NGT) { tab_to_fp6(i, pu, U6, U6_SCALE); tab_to_fp6(i, pv, V6, V6_SCALE); } }
        GRID_BAR();
        { PHASE_IDS unsigned char* ws = WSP; pg8::Gemm g{(const bf16*)(ws + WS_XB), (const bf16*)(ws + WS_WQ), T_TOK, DM, DM}; pg8::StaticOrder S; S.init(T_TOK, DM, G, bx);
          pg8::EpiProj E{(bf16*)(ws + WS_QF), nullptr, nullptr, DM, 1 << 20, -1, 0};
          pg8::gemm_phase<pg8::EpiProj, pg8::StaticOrder, true, true>(lds, g, S, E, tid); }
        GRID_BAR();
        { PHASE_IDS unsigned char* ws = WSP; peer_select_phase(lds, (const bf16*)(ws + WS_QF), (const bf16*)(ws + WS_SKB), (int*)(ws + WS_IDS), (float*)(ws + WS_GATES), tid, bx, G); }
        GRID_BAR();
        { PHASE_IDS unsigned char* ws = WSP; const float* bufB = (const float*)(ws + WS_BUFB); const int* ids = (const int*)(ws + WS_IDS); const float* gates = (const float*)(ws + WS_GATES);
          const unsigned char* U8 = ws + WS_R2; const unsigned char* V8 = ws + WS_R2 + 32 * MiB;     const float* g2 = INF(I_LN2G) + l * DM; const float* b2 = INF(I_LN2B) + l * DM; float* out = OUTP; bf16* xb = (bf16*)(ws + WS_XB);
          LAS unsigned* wl = (LAS unsigned*)(lds + wave * 2048);
          for (int t = gw; t < T_TOK; t += NGW) peer_expert_body(t, lane, bufB, ids, gates, U8, V8, g2, b2, out, xb, wl); }
        GRID_BAR();
    }
#undef GRID_BAR
}

extern "C" void kernel_launch(void* const* d_in, const int* in_sizes, int n_in, void* d_out, int out_size, void* d_ws, size_t ws_size, hipStream_t stream) {
    static int grid = 0;
    if (grid == 0) {
        if (n_in != 22 || out_size != T_TOK * DM || ws_size < WS_END) { fprintf(stderr, "kernel_launch: unexpected shapes (n_in %d, out %d, ws %zu)\n", n_in, out_size, ws_size); grid = -1; return; }
        int dev = 0, cus = 0, per_cu = 0;
        if (hipGetDevice(&dev) != hipSuccess || hipDeviceGetAttribute(&cus, hipDeviceAttributeMultiprocessorCount, dev) != hipSuccess) { grid = -1; return; }
        if (hipFuncSetAttribute((const void*)mega_fwd, hipFuncAttributeMaxDynamicSharedMemorySize, LDS_BYTES) != hipSuccess) { fprintf(stderr, "kernel_launch: hipFuncSetAttribute failed\n"); grid = -1; return; }
        if (hipOccupancyMaxActiveBlocksPerMultiprocessor(&per_cu, (const void*)mega_fwd, 512, LDS_BYTES) != hipSuccess || per_cu < 1) { fprintf(stderr, "kernel_launch: occupancy query says %d blocks per CU\n", per_cu); (void)hipGetLastError(); grid = -1; return; }
        grid = cus;
    }
    if (grid < 0) return;
    (void)hipMemsetAsync((char*)d_ws + WS_CTL, 0, CTL_ZERO_BYTES, stream);
    MegaArgs a; memset(&a, 0, sizeof(a));
    for (int i = 0; i < 22; ++i) a.in[i] = (const float*)d_in[i];
    a.out = (float*)d_out; a.ws = (unsigned char*)d_ws;
    hipLaunchKernelGGL(mega_fwd, dim3(grid), dim3(512), LDS_BYTES, stream, a);
}
```

```cpp
#include <hip/hip_runtime.h>
#include <cstdio>
#include <cstdint>
#include <cstring>

namespace pg8 {
#define PG8_LAS __attribute__((address_space(3)))
typedef unsigned short bf16_t;
typedef short bf16x8 __attribute__((ext_vector_type(8)));
typedef float f32x4 __attribute__((ext_vector_type(4)));
typedef unsigned u32x4 __attribute__((ext_vector_type(4)));
constexpr int BM = 256, BK = 64, HALF = 128, HTB = HALF * BK * 2  , STAGE_BYTES = 8 * HTB, NXCD = 8, WGM = 8;

__host__ __device__ __forceinline__ int lds_byte(int r, int c) { const int st = (r >> 4) * 2 + (c >> 5), rr = r & 15, cc = c & 31, ob = rr * 64 + cc * 2; return st * 1024 + (ob ^ (((ob >> 9) & 1) << 5)); }
__host__ __device__ __forceinline__ void stage_rc(int b, int& R, int& C) { const int st = b / 1024, sb = b % 1024, swz = sb ^ (((sb >> 9) & 1) << 5); R = (st >> 1) * 16 + swz / 64; C = (st & 1) * 32 + (swz % 64) / 2; }
__host__ __device__ __forceinline__ int perm32(int rho) { const int n = rho >> 4, i = rho & 15; return 8 * (i >> 2) + 4 * n + (i & 3); }

struct Unit { int pm, pn; };
struct Gemm { const bf16_t* A; const bf16_t* Bt; int M, N, K; };

struct StaticOrder {
    int nM, nN, nwg, G, c;
    __host__ __device__ void init(int M, int N, int G_, int c_) { nM = M / BM; nN = N / BM; nwg = nM * nN; G = G_; c = c_; }
    __host__ __device__ bool next(int i, Unit& u) const {
        const long L = (long)i * G + c; if (L >= nwg) return false;
        int wgid = (int)L; { const int q = nwg / NXCD, r = nwg % NXCD, xcd = wgid % NXCD, off = wgid / NXCD; wgid = (xcd < r ? xcd * (q + 1) : r * (q + 1) + (xcd - r) * q) + off; }
        const int nig = WGM * nN, gid = wgid / nig, fm = gid * WGM, gsz = (nM - fm) < WGM ? (nM - fm) : WGM;
        u.pm = fm + ((wgid % nig) % gsz); u.pn = (wgid % nig) / gsz; return true;
    }
    __device__ __forceinline__ void a_ready(const Unit&) const {}
    __device__ __forceinline__ void done(const Unit&) const {}
};

__device__ __forceinline__ unsigned cvt_pk_bf16(float lo, float hi) { unsigned r; asm volatile("v_cvt_pk_bf16_f32 %0, %1, %2" : "=v"(r) : "v"(lo), "v"(hi)); return r; }
typedef float f32x2 __attribute__((ext_vector_type(2)));
__device__ __forceinline__ float bf_lo(unsigned w) { return __uint_as_float(w << 16); }
__device__ __forceinline__ float bf_hi(unsigned w) { return __uint_as_float(w & 0xffff0000u); }
__device__ __forceinline__ float sigmoidf_(float x) { return 1.0f / (1.0f + __expf(-x)); }

struct EpiF32 {
    static constexpr bool PERM = false, AFTER_DRAIN = false;
    float* C; int ldc; int pad;
    __device__ __forceinline__ void operator()(const f32x4 (&acc)[2][2][4][2], const Unit& u, int wr, int wc, int fr, int fq) const {
        const int row0 = u.pm * BM + wr * 64 + fr, col0 = u.pn * BM + wc * 32 + 4 * fq;
#pragma unroll
        for (int ai = 0; ai < 2; ++ai)
#pragma unroll
            for (int m = 0; m < 4; ++m) { float* rowp = C + (size_t)(row0 + ai * HALF + m * 16) * ldc + col0;
#pragma unroll
                for (int bj = 0; bj < 2; ++bj)
#pragma unroll
                    for (int n = 0; n < 2; ++n) *(f32x4*)(rowp + bj * HALF + n * 16) = acc[ai][bj][m][n]; }
    }
};
struct EpiResid {
    static constexpr bool PERM = false, AFTER_DRAIN = false;
    float* C; const float* X; int ldc; float alpha;
    __device__ __forceinline__ void operator()(const f32x4 (&acc)[2][2][4][2], const Unit& u, int wr, int wc, int fr, int fq) const {
        const int row0 = u.pm * BM + wr * 64 + fr, col0 = u.pn * BM + wc * 32 + 4 * fq;
#pragma unroll
        for (int ai = 0; ai < 2; ++ai)
#pragma unroll
            for (int m = 0; m < 4; ++m) { const size_t off = (size_t)(row0 + ai * HALF + m * 16) * ldc + col0;
#pragma unroll
                for (int bj = 0; bj < 2; ++bj)
#pragma unroll
                    for (int n = 0; n < 2; ++n) { const f32x4 xv = *(const f32x4*)(X + off + bj * HALF + n * 16);
                        *(f32x4*)(C + off + bj * HALF + n * 16) = acc[ai][bj][m][n] + xv * alpha; } }
    }
};
struct EpiProj {
    static constexpr bool PERM = true, AFTER_DRAIN = false;
    bf16_t* O; const float* bias; float* small; int ldc; int gate_lo; int small_tile; int pad;
    __device__ __forceinline__ void operator()(const f32x4 (&acc)[2][2][4][2], const Unit& u, int wr, int wc, int fr, int fq) const {
        const int row0 = u.pm * BM + wr * 64 + fr, col0 = u.pn * BM + wc * 32 + 8 * fq;
        if (u.pn == small_tile) {
            if (wc == 0) {
#pragma unroll
                for (int ai = 0; ai < 2; ++ai)
#pragma unroll
                    for (int m = 0; m < 4; ++m) { float* p = small + (size_t)(row0 + ai * HALF + m * 16) * 32 + 8 * fq;
                        *(f32x4*)p = acc[ai][0][m][0]; *(f32x4*)(p + 4) = acc[ai][0][m][1]; }
            }
            return;
        }
        const bool gate = u.pn >= gate_lo;
        f32x4 bv[2][2];
#pragma unroll
        for (int bj = 0; bj < 2; ++bj)
#pragma unroll
            for (int n = 0; n < 2; ++n) bv[bj][n] = gate ? *(const f32x4*)(bias + col0 + bj * HALF + 4 * n) : (f32x4){0.f, 0.f, 0.f, 0.f};
#pragma unroll
        for (int ai = 0; ai < 2; ++ai)
#pragma unroll
            for (int m = 0; m < 4; ++m) { bf16_t* rowp = O + (size_t)(row0 + ai * HALF + m * 16) * ldc + col0;
#pragma unroll
                for (int bj = 0; bj < 2; ++bj) { f32x4 v0 = acc[ai][bj][m][0] + bv[bj][0], v1 = acc[ai][bj][m][1] + bv[bj][1];
                    if (gate) {
#pragma unroll
                        for (int j = 0; j < 4; ++j) { v0[j] = sigmoidf_(v0[j]); v1[j] = sigmoidf_(v1[j]); } }
                    u32x4 w; w.x = cvt_pk_bf16(v0[0], v0[1]); w.y = cvt_pk_bf16(v0[2], v0[3]); w.z = cvt_pk_bf16(v1[0], v1[1]); w.w = cvt_pk_bf16(v1[2], v1[3]);
                    *(u32x4*)(rowp + bj * HALF) = w; } }
    }
};
template <int FIRST> struct EpiMix {
    static constexpr bool PERM = true, AFTER_DRAIN = false;
    bf16_t* O; const bf16_t* G; int ldc; int ldg;
    __device__ __forceinline__ void operator()(const f32x4 (&acc)[2][2][4][2], const Unit& u, int wr, int wc, int fr, int fq) const {
        const int row0 = u.pm * BM + wr * 64 + fr, col0 = u.pn * BM + wc * 32 + 8 * fq;
#pragma unroll
        for (int ai = 0; ai < 2; ++ai)
#pragma unroll
            for (int m = 0; m < 4; ++m) { const int row = row0 + ai * HALF + m * 16; bf16_t* rowp = O + (size_t)row * ldc + col0; const bf16_t* gp = G + (size_t)row * ldg + col0;
#pragma unroll
                for (int bj = 0; bj < 2; ++bj) { const u32x4 gw = *(const u32x4*)(gp + bj * HALF); u32x4 ow = (u32x4){0u, 0u, 0u, 0u}; if (!FIRST) ow = *(const u32x4*)(rowp + bj * HALF);
                    const f32x4 a0 = acc[ai][bj][m][0], a1 = acc[ai][bj][m][1];
                    float r0 = bf_lo(ow.x) + bf_lo(gw.x) * a0[0], r1 = bf_hi(ow.x) + bf_hi(gw.x) * a0[1], r2 = bf_lo(ow.y) + bf_lo(gw.y) * a0[2], r3 = bf_hi(ow.y) + bf_hi(gw.y) * a0[3];
                    float r4 = bf_lo(ow.z) + bf_lo(gw.z) * a1[0], r5 = bf_hi(ow.z) + bf_hi(gw.z) * a1[1], r6 = bf_lo(ow.w) + bf_lo(gw.w) * a1[2], r7 = bf_hi(ow.w) + bf_hi(gw.w) * a1[3];
                    u32x4 w; w.x = cvt_pk_bf16(r0, r1); w.y = cvt_pk_bf16(r2, r3); w.z = cvt_pk_bf16(r4, r5); w.w = cvt_pk_bf16(r6, r7);
                    *(u32x4*)(rowp + bj * HALF) = w; } }
    }
};

template <class Epi, class Sched, bool ALIGN_EPI = false, bool SP2 = false>
__device__ __forceinline__ void gemm_phase(PG8_LAS unsigned char* lds, const Gemm g, const Sched& S, const Epi& E, int tid_) {
    asm volatile("" : "+v"(tid_));
    const int tid = tid_, wid = __builtin_amdgcn_readfirstlane(tid >> 6), lane = tid & 63, wr = wid >> 2, wc = wid & 3, fr = lane & 15, fq = lane >> 4;
    const int K = g.K, nt = K / BK;
    unsigned voffA[2], voffB[2];
#pragma unroll
    for (int i = 0; i < 2; ++i) { int R, C; stage_rc(tid * 16 + i * 8192, R, C); const int Rb = Epi::PERM ? ((R & ~31) + perm32(R & 31)) : R;
        voffA[i] = (unsigned)(R * K + C) * 2u; voffB[i] = (unsigned)(Rb * K + C) * 2u; }
    const size_t kstep = (size_t)(BK * 2);
    const size_t hstep = (size_t)HALF * K * 2;
    const size_t tstep = 2 * hstep;
    const unsigned ldsw = (unsigned)wid * 1024u;
    const int aoff = lds_byte(wr * 64 + fr, fq * 8), boff = lds_byte(wc * 32 + fr, fq * 8);
#define PG8_SA(b, h) (((b) * 2 + (h)) * HTB)
#define PG8_SB(b, h) ((4 + (b) * 2 + (h)) * HTB)
#define PG8_STAGE(bufoff, gbase, voff) do { _Pragma("unroll") for (int _i = 0; _i < 2; ++_i) \
        __builtin_amdgcn_global_load_lds((const unsigned*)((const char*)(gbase) + (voff)[_i]), (PG8_LAS unsigned*)(lds + (bufoff) + ldsw + _i * 8192), 16, 0, 0); } while (0)
#define PG8_LDA(dst, b, h) do { _Pragma("unroll") for (int m = 0; m < 4; ++m) _Pragma("unroll") for (int k = 0; k < 2; ++k) dst[m][k] = *(const PG8_LAS bf16x8*)(lds + PG8_SA(b, h) + aoff + m * 2048 + k * 1024); } while (0)
#define PG8_LDB(dst, b, h) do { _Pragma("unroll") for (int n = 0; n < 2; ++n) _Pragma("unroll") for (int k = 0; k < 2; ++k) dst[n][k] = *(const PG8_LAS bf16x8*)(lds + PG8_SB(b, h) + boff + n * 2048 + k * 1024); } while (0)
#define PG8_MMA(ai, bj, At, Bt) do { __builtin_amdgcn_s_setprio(1); _Pragma("unroll") for (int m = 0; m < 4; ++m) _Pragma("unroll") for (int n = 0; n < 2; ++n) _Pragma("unroll") for (int k = 0; k < 2; ++k) \
        acc[ai][bj][m][n] = __builtin_amdgcn_mfma_f32_16x16x32_bf16(Bt[n][k], At[m][k], acc[ai][bj][m][n], 0, 0, 0); __builtin_amdgcn_s_setprio(0); } while (0)
#define PG8_WAIT_V(n) asm volatile("s_waitcnt vmcnt(" #n ")" ::: "memory")
#define PG8_WAIT_L(n) asm volatile("s_waitcnt lgkmcnt(" #n ")" ::: "memory")
#define PG8_BAR __builtin_amdgcn_s_barrier()
#define PG8_SCHED __builtin_amdgcn_sched_barrier(0)
    Unit cur, nxt; int ui = 0;
    if (!S.next(0, cur)) return;
    f32x4 acc[2][2][4][2];
#pragma unroll
    for (int a = 0; a < 2; ++a)
#pragma unroll
        for (int b = 0; b < 2; ++b)
#pragma unroll
            for (int m = 0; m < 4; ++m)
#pragma unroll
                for (int n = 0; n < 2; ++n) acc[a][b][m][n] = (f32x4){0.f, 0.f, 0.f, 0.f};
    bf16x8 At[4][2], B0[2][2], B1[2][2];
    const char* cA = (const char*)g.A + (size_t)cur.pm * tstep; const char* cB = (const char*)g.Bt + (size_t)cur.pn * tstep;
    S.a_ready(cur);
    if constexpr (SP2) {
        PG8_STAGE(PG8_SB(0, 0), cB, voffB); PG8_STAGE(PG8_SB(0, 1), cB + hstep, voffB); PG8_STAGE(PG8_SA(0, 0), cA, voffA); PG8_STAGE(PG8_SA(0, 1), cA + hstep, voffA);
        if (wr == 1) PG8_BAR;
        PG8_WAIT_V(2); PG8_BAR;
        PG8_STAGE(PG8_SB(1, 0), cB + kstep, voffB); PG8_STAGE(PG8_SA(1, 0), cA + kstep, voffA); PG8_STAGE(PG8_SB(1, 1), cB + hstep + kstep, voffB);
        PG8_WAIT_V(6); PG8_BAR;
    } else {
        PG8_STAGE(PG8_SB(0, 0), cB, voffB); PG8_STAGE(PG8_SA(0, 0), cA, voffA); PG8_STAGE(PG8_SB(0, 1), cB + hstep, voffB); PG8_STAGE(PG8_SA(0, 1), cA + hstep, voffA);
        if (wr == 1) PG8_BAR;
        PG8_WAIT_V(4); PG8_BAR;
        PG8_STAGE(PG8_SB(1, 0), cB + kstep, voffB); PG8_STAGE(PG8_SA(1, 0), cA + kstep, voffA); PG8_STAGE(PG8_SB(1, 1), cB + hstep + kstep, voffB);
        PG8_WAIT_V(6); PG8_BAR;
    }
    for (;;) {
        const bool has_next = S.next(ui + 1, nxt);
        const char* nA = has_next ? (const char*)g.A + (size_t)nxt.pm * tstep : cA; const char* nB = has_next ? (const char*)g.Bt + (size_t)nxt.pn * tstep : cB;
        for (int t = 0; t < nt; t += 2) {
            const bool last = (t == nt - 2);
            const char* a1 = cA + (size_t)(t + 1) * kstep;
            const char* a2 = last ? nA : cA + (size_t)(t + 2) * kstep; const char* b2 = last ? nB : cB + (size_t)(t + 2) * kstep;
            const char* a3 = a2 + kstep; const char* b3 = b2 + kstep;
            if (last && has_next) S.a_ready(nxt);
            if constexpr (SP2) {
            PG8_LDB(B0, 0, 0); PG8_LDB(B1, 0, 1); PG8_SCHED; PG8_LDA(At, 0, 0); PG8_STAGE(PG8_SA(1, 1), a1 + hstep, voffA);
            PG8_WAIT_V(8); PG8_WAIT_L(0); PG8_BAR; PG8_MMA(0, 0, At, B0); PG8_MMA(0, 1, At, B1); PG8_BAR; PG8_SCHED;
            PG8_LDA(At, 0, 1); PG8_STAGE(PG8_SB(0, 0), b2, voffB); PG8_STAGE(PG8_SB(0, 1), b2 + hstep, voffB); PG8_STAGE(PG8_SA(0, 0), a2, voffA);
            PG8_WAIT_V(8); PG8_WAIT_L(0); PG8_BAR; PG8_MMA(1, 0, At, B0); PG8_MMA(1, 1, At, B1); PG8_BAR; PG8_SCHED;
            PG8_LDB(B0, 1, 0); PG8_LDB(B1, 1, 1); PG8_SCHED; PG8_LDA(At, 1, 0); PG8_STAGE(PG8_SA(0, 1), a2 + hstep, voffA);
            PG8_WAIT_V(8); PG8_WAIT_L(0); PG8_BAR; PG8_MMA(0, 0, At, B0); PG8_MMA(0, 1, At, B1); PG8_BAR; PG8_SCHED;
            PG8_LDA(At, 1, 1); PG8_STAGE(PG8_SB(1, 0), b3, voffB); PG8_STAGE(PG8_SB(1, 1), b3 + hstep, voffB); PG8_STAGE(PG8_SA(1, 0), a3, voffA);
            PG8_WAIT_V(8); PG8_WAIT_L(0); PG8_BAR; PG8_MMA(1, 0, At, B0); PG8_MMA(1, 1, At, B1); PG8_BAR; PG8_SCHED;
            } else {
            PG8_LDB(B0, 0, 0); PG8_SCHED; PG8_LDA(At, 0, 0); PG8_STAGE(PG8_SA(1, 1), a1 + hstep, voffA);
            PG8_WAIT_L(8); PG8_BAR; PG8_WAIT_L(0); PG8_MMA(0, 0, At, B0); PG8_BAR; PG8_SCHED;
            PG8_LDB(B1, 0, 1); PG8_STAGE(PG8_SB(0, 0), b2, voffB);
            PG8_BAR; PG8_WAIT_L(0); PG8_MMA(0, 1, At, B1); PG8_BAR;
            PG8_LDA(At, 0, 1); PG8_STAGE(PG8_SA(0, 0), a2, voffA);
            PG8_BAR; PG8_WAIT_L(0); PG8_MMA(1, 0, At, B0); PG8_BAR; PG8_SCHED;
            PG8_STAGE(PG8_SB(0, 1), b2 + hstep, voffB);
            PG8_WAIT_V(6); PG8_BAR; PG8_MMA(1, 1, At, B1); PG8_BAR;
            PG8_LDB(B0, 1, 0); PG8_SCHED; PG8_LDA(At, 1, 0); PG8_STAGE(PG8_SA(0, 1), a2 + hstep, voffA);
            PG8_WAIT_L(8); PG8_BAR; PG8_WAIT_L(0); PG8_MMA(0, 0, At, B0); PG8_BAR; PG8_SCHED;
            PG8_LDB(B1, 1, 1); PG8_STAGE(PG8_SB(1, 0), b3, voffB);
            PG8_BAR; PG8_WAIT_L(0); PG8_MMA(0, 1, At, B1); PG8_BAR;
            PG8_LDA(At, 1, 1); PG8_STAGE(PG8_SA(1, 0), a3, voffA);
            PG8_BAR; PG8_WAIT_L(0); PG8_MMA(1, 0, At, B0); PG8_BAR; PG8_SCHED;
            PG8_STAGE(PG8_SB(1, 1), b3 + hstep, voffB);
            PG8_WAIT_V(6); PG8_BAR; PG8_MMA(1, 1, At, B1); PG8_BAR;
            }
        }
        if constexpr (ALIGN_EPI) { if (wr == 0) PG8_BAR; }
        if constexpr (!Epi::AFTER_DRAIN) { E(acc, cur, wr, wc, fr, fq); S.done(cur); }
        if (!has_next) break;
#pragma unroll
        for (int a = 0; a < 2; ++a)
#pragma unroll
            for (int b = 0; b < 2; ++b)
#pragma unroll
                for (int m = 0; m < 4; ++m)
#pragma unroll
                    for (int n = 0; n < 2; ++n) acc[a][b][m][n] = (f32x4){0.f, 0.f, 0.f, 0.f};
        cur = nxt; cA = nA; cB = nB; ++ui;
        if constexpr (ALIGN_EPI) { if (wr == 1) PG8_BAR; }
    }
    PG8_WAIT_V(0);
    if constexpr (!ALIGN_EPI) { if (wr == 0) PG8_BAR; }
    PG8_BAR;
    if constexpr (Epi::AFTER_DRAIN) { E.fused(acc, cur, wr, wc, fr, fq, lds, wid, lane); S.done(cur); }
#undef PG8_SA
#undef PG8_SB
#undef PG8_STAGE
#undef PG8_LDA
#undef PG8_LDB
#undef PG8_MMA
#undef PG8_WAIT_V
#undef PG8_WAIT_L
#undef PG8_BAR
#undef PG8_SCHED
}
}
typedef unsigned short bf16;
#define LAS __attribute__((address_space(3)))
constexpr int T_TOK = 32768, DM = 2048, SEQ = 4096, NBATCH = 8, DEPTH = 4;
constexpr int IN_COLS = 13336, NP = 13568;
constexpr int C_MQ = 0, C_MK = 512, C_MV = 1024, C_MO = 2048, C_SZ = 3072, C_SXBC = 4096, C_AQ = 5632, C_AK = 6656, C_AV = 6912, C_G = 7168, C_SMALL = 13312;
constexpr int GATE_TILE_LO = C_G / 256, SMALL_TILE = C_SMALL / 256;
constexpr float ALPHA = 1.681792830507429f;
constexpr int P_EXPERTS = 16384;

constexpr size_t MiB = 1u << 20;
constexpr size_t WS_CTL = 0, CTL_ZERO_BYTES = 64 * 1024, WS_WIN = 1 * MiB, WS_WB = 54 * MiB, WS_WO = 66 * MiB, WS_WQ = 74 * MiB, WS_BIAS = 82 * MiB, WS_SKB = 82 * MiB + 256 * 1024, WS_SMALL = 83 * MiB, WS_ROPE = 87 * MiB,
                 WS_XB = 88 * MiB, WS_BUFB = 216 * MiB, WS_PROJ = 472 * MiB, WS_R1 = 1320 * MiB, WS_Y = 1480 * MiB, WS_R2 = 1672 * MiB, WS_HM = 1864 * MiB, WS_END = 1992 * MiB;
constexpr size_t WS_QF = WS_PROJ, WS_IDS = WS_PROJ + 256 * MiB, WS_GATES = WS_PROJ + 272 * MiB;
constexpr int CW_BAR = 4096;
constexpr int RING_BYTES = 131072, PHASE_LDS_BYTES = 155648, MISC_OFF = PHASE_LDS_BYTES + 320, LDS_BYTES = 163840;

__device__ __forceinline__ unsigned f2bf(float f) { unsigned u = __float_as_uint(f); return (u + 0x7fffu + ((u >> 16) & 1u)) >> 16; }
__device__ __forceinline__ unsigned pk2(float lo, float hi) { return f2bf(lo) | (f2bf(hi) << 16); }
__device__ __forceinline__ float bf2f(bf16 b) { return __uint_as_float(((unsigned)b) << 16); }
__device__ __forceinline__ float sigm(float x) { return 1.0f / (1.0f + expf(-x)); }
template <int CTRL> __device__ __forceinline__ float dpp_f(float v) { return __builtin_bit_cast(float, __builtin_amdgcn_update_dpp(0, __builtin_bit_cast(int, v), CTRL, 0xF, 0xF, true)); }
__device__ __forceinline__ float quad_sum(float v) { v += dpp_f<0xB1>(v); v += dpp_f<0x4E>(v); return v; }
__device__ __forceinline__ float wave_sum(float v) {
    v = quad_sum(v); v += dpp_f<0x141>(v); v += dpp_f<0x140>(v);
    v += __builtin_bit_cast(float, __builtin_amdgcn_ds_swizzle(__builtin_bit_cast(int, v), 0x401F));
    return __builtin_bit_cast(float, __builtin_amdgcn_readlane(__builtin_bit_cast(int, v), 0)) + __builtin_bit_cast(float, __builtin_amdgcn_readlane(__builtin_bit_cast(int, v), 32));
}
__device__ __forceinline__ int src_col(int n) {
    if (n < 3072) return n;
    if (n < 5632) return n + 8;
    if (n < 13312) return n + 24;
    if (n < 13320) return 3072 + (n - 13312);
    if (n < 13336) return 5640 + (n - 13320);
    return -1;
}

#define XB_TMO      128
#define XB_XCNT(j)  (256  + 64 * (j))
#define XB_XSUB(j)  (1280 + 64 * (j))
#define XB_XGEN(j)  (2304 + 64 * (j))
#define XB_TOP      3328
#define XB_TOPGEN   3392
#define XCD_BAR_WORDS 3456
#define XB_SPIN_CAP (1u << 18)

__device__ __forceinline__ unsigned xb_ld(unsigned* p)              { return __hip_atomic_load(p, __ATOMIC_RELAXED, __HIP_MEMORY_SCOPE_AGENT); }
__device__ __forceinline__ unsigned xb_add(unsigned* p, unsigned v) { return __hip_atomic_fetch_add(p, v, __ATOMIC_RELAXED, __HIP_MEMORY_SCOPE_AGENT); }
__device__ __forceinline__ unsigned xb_xcc_id() { return (unsigned)__builtin_amdgcn_s_getreg((3 << 11) | 20) & 0xFu; }
#define XB_SPIN(cond, bar) do { unsigned _sp = 0; while (cond) { __builtin_amdgcn_s_sleep(1); \
    if ((++_sp & 255u) == 0u) { if (xb_ld(&(bar)[XB_TMO])) break; if (_sp > XB_SPIN_CAP) { atomicAdd(&(bar)[XB_TMO], 1u); break; } } } } while (0)

struct XcdBarrier {
    unsigned* bar; unsigned x;
    volatile LAS unsigned* st;
};

__device__ __forceinline__ XcdBarrier xcd_barrier_post(unsigned* bar, volatile LAS unsigned* st) {
    XcdBarrier b; b.bar = bar; b.x = xb_xcc_id(); b.st = st;
    if (threadIdx.x == 0) (void)xb_add(&bar[XB_XCNT(b.x)], 1u);
    return b;
}
__device__ __forceinline__ void xcd_barrier_complete(unsigned* bar, unsigned x, unsigned& nloc, unsigned& nx) {
    const unsigned G = gridDim.x * gridDim.y * gridDim.z;
    unsigned sum, cnt, mine, sp = 0u;
    for (;;) {
        sum = 0u; cnt = 0u; mine = 0u;
#pragma unroll
        for (unsigned j = 0; j < 16; ++j) { const unsigned c = xb_ld(&bar[XB_XCNT(j)]); sum += c; cnt += (c > 0u) ? 1u : 0u; mine = (j == x) ? c : mine; }
        if (sum == G) break;
        __builtin_amdgcn_s_sleep(1);
        if ((++sp & 255u) == 0u) { if (xb_ld(&bar[XB_TMO])) break; if (sp > XB_SPIN_CAP) { atomicAdd(&bar[XB_TMO], 1u); break; } }
    }
    nloc = mine > 0u ? mine : 1u; nx = cnt > 0u ? cnt : 1u;
}

__device__ __forceinline__ void xcd_barrier(const XcdBarrier& b) {
    asm volatile("s_waitcnt vmcnt(0)" ::: "memory");
    __syncthreads();
    if (threadIdx.x == 0) {
        unsigned* bar = b.bar;
        __builtin_amdgcn_s_waitcnt(0);
        unsigned nloc = b.st[0], nx = b.st[1];
        if (nloc == 0u) { xcd_barrier_complete(bar, b.x, nloc, nx); b.st[0] = nloc; b.st[1] = nx; }
        const unsigned old = xb_add(&bar[XB_XSUB(b.x)], 1u);
        const unsigned gen = old / nloc;
        if (old + 1u == (gen + 1u) * nloc) {
            __builtin_amdgcn_fence(__ATOMIC_RELEASE, "agent");
            asm volatile("s_waitcnt vmcnt(0)" ::: "memory");
            const unsigned og = xb_add(&bar[XB_TOP], 1u);
            const unsigned tg = og / nx;
            if (og + 1u == (tg + 1u) * nx) xb_add(&bar[XB_TOPGEN], 1u);
            else XB_SPIN(xb_ld(&bar[XB_TOPGEN]) == tg, bar);
            __builtin_amdgcn_fence(__ATOMIC_ACQUIRE, "agent");
            xb_add(&bar[XB_XGEN(b.x)], 1u);
            asm volatile("s_waitcnt vmcnt(0)" ::: "memory");
        } else {
            XB_SPIN(xb_ld(&bar[XB_XGEN(b.x)]) == gen, bar);
            __builtin_amdgcn_fence(__ATOMIC_ACQUIRE, "agent");
            asm volatile("s_waitcnt vmcnt(0)" ::: "memory");
        }
    }
    __syncthreads();
}

__device__ __forceinline__ int fresh_tid(int wave0) { int l; asm volatile("v_mbcnt_lo_u32_b32 %0, -1, 0\n\tv_mbcnt_hi_u32_b32 %0, -1, %0" : "=v"(l)); return wave0 * 64 + l; }
#define PHASE_IDS int G = gridDim.x, bx = blockIdx.x; asm volatile("" : "+s"(G), "+s"(bx)); const int tid = fresh_tid(wave0), lane = tid & 63, wave = wave0; const int gw = bx * 8 + wave, NGW = G * 8; \
    const size_t gt = (size_t)bx * 512 + tid, NGT = (size_t)G * 512; (void)lane; (void)gw; (void)gt; (void)NGW; (void)NGT; (void)wave;

template <int MODE> __device__ __forceinline__ void transpose_item(const float* __restrict__ W, int K, int ldw, int ndst, bf16* __restrict__ WT, LAS float* scr, int item, int lane) {
    const int nblk = ndst / 32, kb = item / nblk, nb = item % nblk, k0 = 64 * kb, n0 = 32 * nb;
    const int n_l = n0 + (lane & 31); const int sc = MODE ? src_col(n_l) : n_l;
    float tv[32];
#pragma unroll
    for (int i = 0; i < 32; ++i) { const int kk = 2 * i + (lane >> 5); tv[i] = sc >= 0 ? W[(size_t)(k0 + kk) * ldw + sc] : 0.f; }
#pragma unroll
    for (int i = 0; i < 32; ++i) { const int kk = 2 * i + (lane >> 5); scr[kk * 33 + (lane & 31)] = tv[i]; }
    asm volatile("s_waitcnt lgkmcnt(0)" ::: "memory");
    const int c = lane & 7;
#pragma unroll
    for (int j = 0; j < 4; ++j) { const int n = (lane >> 3) + 8 * j; const LAS float* s = scr + (8 * c) * 33 + n;
        uint4 o; o.x = pk2(s[0 * 33], s[1 * 33]); o.y = pk2(s[2 * 33], s[3 * 33]); o.z = pk2(s[4 * 33], s[5 * 33]); o.w = pk2(s[6 * 33], s[7 * 33]);
        *(uint4*)(WT + (size_t)(n0 + n) * K + k0 + 8 * c) = o; }
    asm volatile("s_waitcnt lgkmcnt(0)" ::: "memory");
}

__device__ __forceinline__ void mlstm_post_tok(int t, int lane, const float* __restrict__ hm, const bf16* __restrict__ proj, const float* __restrict__ norm_w, bf16* __restrict__ ym) {
    float4 x[4], nw[4]; uint2 ov[4];
#pragma unroll
    for (int h = 0; h < 4; ++h) { const int c = h * 256 + lane * 4; x[h] = *(const float4*)(hm + (size_t)t * 1024 + c); nw[h] = *(const float4*)(norm_w + c); ov[h] = *(const uint2*)(proj + (size_t)t * NP + C_MO + c); }
#pragma unroll
    for (int h = 0; h < 4; ++h) {
        const float mu = wave_sum((x[h].x + x[h].y) + (x[h].z + x[h].w)) * (1.0f / 256.0f);
        const float d0 = x[h].x - mu, d1 = x[h].y - mu, d2 = x[h].z - mu, d3 = x[h].w - mu;
        const float rs = rsqrtf(wave_sum((d0 * d0 + d1 * d1) + (d2 * d2 + d3 * d3)) * (1.0f / 256.0f) + 1e-6f);
        const float y0 = d0 * rs * nw[h].x * sigm(__uint_as_float(ov[h].x << 16)), y1 = d1 * rs * nw[h].y * sigm(__uint_as_float(ov[h].x & 0xffff0000u));
        const float y2 = d2 * rs * nw[h].z * sigm(__uint_as_float(ov[h].y << 16)), y3 = d3 * rs * nw[h].w * sigm(__uint_as_float(ov[h].y & 0xffff0000u));
        *(uint2*)(ym + (size_t)t * 1024 + h * 256 + lane * 4) = make_uint2(pk2(y0, y1), pk2(y2, y3));
    }
}

__device__ __forceinline__ void ssd_conv_item(int item, const bf16* __restrict__ proj, const float* __restrict__ cw, const float* __restrict__ cb, bf16* __restrict__ xcb) {
    const int c8 = item % 192, tb = item / 192, t0 = tb * 4, pos0 = t0 % SEQ, c = c8 * 8;
    uint4 r[7];
#pragma unroll
    for (int j = 0; j < 7; ++j) { r[j] = make_uint4(0u, 0u, 0u, 0u); if (j >= 3 || pos0 > 0) r[j] = *(const uint4*)(proj + (size_t)(t0 - 3 + j) * NP + C_SXBC + c); }
    float w[4][8], bs[8];
#pragma unroll
    for (int j = 0; j < 4; ++j) { const float4 a = *(const float4*)(cw + j * 1536 + c), b = *(const float4*)(cw + j * 1536 + c + 4); w[j][0] = a.x; w[j][1] = a.y; w[j][2] = a.z; w[j][3] = a.w; w[j][4] = b.x; w[j][5] = b.y; w[j][6] = b.z; w[j][7] = b.w; }
    { const float4 a = *(const float4*)(cb + c), b = *(const float4*)(cb + c + 4); bs[0] = a.x; bs[1] = a.y; bs[2] = a.z; bs[3] = a.w; bs[4] = b.x; bs[5] = b.y; bs[6] = b.z; bs[7] = b.w; }
#pragma unroll
    for (int o = 0; o < 4; ++o) {
        float acc[8];
#pragma unroll
        for (int i = 0; i < 8; ++i) acc[i] = bs[i];
#pragma unroll
        for (int j = 0; j < 4; ++j) { const unsigned rw[4] = {r[o + j].x, r[o + j].y, r[o + j].z, r[o + j].w};
#pragma unroll
            for (int i = 0; i < 4; ++i) { acc[2 * i] += w[j][2 * i] * __uint_as_float(rw[i] << 16); acc[2 * i + 1] += w[j][2 * i + 1] * __uint_as_float(rw[i] & 0xffff0000u); } }
        uint4 ov; ov.x = pk2(acc[0] * sigm(acc[0]), acc[1] * sigm(acc[1])); ov.y = pk2(acc[2] * sigm(acc[2]), acc[3] * sigm(acc[3])); ov.z = pk2(acc[4] * sigm(acc[4]), acc[5] * sigm(acc[5])); ov.w = pk2(acc[6] * sigm(acc[6]), acc[7] * sigm(acc[7]));
        *(uint4*)(xcb + (size_t)(t0 + o) * 1536 + c) = ov;
    }
}
__device__ __forceinline__ void ssd_post_tok2(int tp, int lane, const float* __restrict__ yraw, const bf16* __restrict__ proj, const float* __restrict__ norm_w, bf16* __restrict__ ys) {
    float4 ya[4], yb[4]; uint4 zv[4];
#pragma unroll
    for (int i = 0; i < 4; ++i) { const int t = 2 * tp + (i >> 1), c = (i & 1) * 512 + lane * 8; ya[i] = *(const float4*)(yraw + (size_t)t * 1024 + c); yb[i] = *(const float4*)(yraw + (size_t)t * 1024 + c + 4); zv[i] = *(const uint4*)(proj + (size_t)t * NP + C_SZ + c); }
#pragma unroll
    for (int i = 0; i < 4; ++i) { const int t = 2 * tp + (i >> 1), c = (i & 1) * 512 + lane * 8;
        const float yv[8] = {ya[i].x, ya[i].y, ya[i].z, ya[i].w, yb[i].x, yb[i].y, yb[i].z, yb[i].w}; const unsigned zw[4] = {zv[i].x, zv[i].y, zv[i].z, zv[i].w};
        float y[8], ss = 0.f;
#pragma unroll
        for (int k = 0; k < 4; ++k) { const float z0 = __uint_as_float(zw[k] << 16), z1 = __uint_as_float(zw[k] & 0xffff0000u); y[2 * k] = yv[2 * k] * (z0 * sigm(z0)); y[2 * k + 1] = yv[2 * k + 1] * (z1 * sigm(z1)); ss += y[2 * k] * y[2 * k] + y[2 * k + 1] * y[2 * k + 1]; }
        const float rs = rsqrtf(wave_sum(ss) * (1.0f / 512.0f) + 1e-6f);
        const float4 n0 = *(const float4*)(norm_w + c), n1 = *(const float4*)(norm_w + c + 4);
        *(uint4*)(ys + (size_t)t * 1024 + c) = make_uint4(pk2(y[0] * rs * n0.x, y[1] * rs * n0.y), pk2(y[2] * rs * n0.z, y[3] * rs * n0.w), pk2(y[4] * rs * n1.x, y[5] * rs * n1.y), pk2(y[6] * rs * n1.z, y[7] * rs * n1.w));
    }
}

__device__ __forceinline__ void ln_body2(int tp, int lane, const float* in, const float* __restrict__ g, const float* __restrict__ bta, float* outf, bf16* __restrict__ outb) {
    float4 v[2][8];
#pragma unroll
    for (int r = 0; r < 2; ++r)
#pragma unroll
        for (int j = 0; j < 8; ++j) v[r][j] = *(const float4*)(in + (size_t)(2 * tp + r) * DM + j * 256 + lane * 4);
    { int z_ = 0; asm volatile("" : "+s"(z_)); g += z_; bta += z_; }
#pragma unroll
    for (int r = 0; r < 2; ++r) {
        const int t = 2 * tp + r; float s = 0.f;
#pragma unroll
        for (int j = 0; j < 8; ++j) s += (v[r][j].x + v[r][j].y) + (v[r][j].z + v[r][j].w);
        const float mu = wave_sum(s) * (1.0f / DM); float q = 0.f;
#pragma unroll
        for (int j = 0; j < 8; ++j) { v[r][j].x -= mu; v[r][j].y -= mu; v[r][j].z -= mu; v[r][j].w -= mu; q += (v[r][j].x * v[r][j].x + v[r][j].y * v[r][j].y) + (v[r][j].z * v[r][j].z + v[r][j].w * v[r][j].w); }
        const float rs = rsqrtf(wave_sum(q) * (1.0f / DM) + 1e-5f);
#pragma unroll
        for (int j = 0; j < 8; ++j) { const int c = j * 256 + lane * 4; const float4 gg = *(const float4*)(g + c), bb = *(const float4*)(bta + c);
            float4 y; y.x = v[r][j].x * rs * gg.x + bb.x; y.y = v[r][j].y * rs * gg.y + bb.y; y.z = v[r][j].z * rs * gg.z + bb.z; y.w = v[r][j].w * rs * gg.w + bb.w;
            *(float4*)(outf + (size_t)t * DM + c) = y; *(uint2*)(outb + (size_t)t * DM + c) = make_uint2(pk2(y.x, y.y), pk2(y.z, y.w)); }
    }
}

__device__ __forceinline__ float gelu_erf(float v) {
    const float av = fabsf(v), t = __builtin_amdgcn_rcpf(av * 0.2316418882f + 1.0f);
    float q = t * 0.5307027145f + (-0.7265760135f); q = q * t + 0.7107068705f; q = q * t + (-0.142248368f); q = q * t + 0.127414796f; q = q * t;
    const float e = __builtin_amdgcn_exp2f((v * v) * (-0.72134752044f));
    const float mm = v * (q * e), r = v - mm;
    return v < 0.f ? mm : r;
}
typedef unsigned u32x4e_t __attribute__((ext_vector_type(4)));
constexpr float U6_SCALE = 64.0f, V6_SCALE = 8.0f;
constexpr int ROW6 = DM * 6 / 8;
typedef float v32f_t __attribute__((ext_vector_type(32)));
typedef __bf16 v32b_t __attribute__((ext_vector_type(32)));
typedef unsigned v6u_t __attribute__((ext_vector_type(6)));
__device__ __forceinline__ void tab_to_fp6(size_t i, const float* __restrict__ src, unsigned char* __restrict__ dst, float sc) {
    const float4* s = (const float4*)src + i * 8; v32b_t b;
#pragma unroll
    for (int j = 0; j < 8; ++j) { const float4 v = s[j]; b[4 * j] = (__bf16)(v.x * sc); b[4 * j + 1] = (__bf16)(v.y * sc); b[4 * j + 2] = (__bf16)(v.z * sc); b[4 * j + 3] = (__bf16)(v.w * sc); }
    const v6u_t p = __builtin_amdgcn_cvt_scalef32_pk32_fp6_bf16(b, 1.0f);
    uint2* d = (uint2*)(dst + i * 24); d[0] = make_uint2(p[0], p[1]); d[1] = make_uint2(p[2], p[3]); d[2] = make_uint2(p[4], p[5]);
}
__device__ __forceinline__ void peer_expert_body(int t, int lane, const float* __restrict__ x1, const int* __restrict__ ids, const float* __restrict__ gates, const unsigned char* __restrict__ U6, const unsigned char* __restrict__ V6,
                                                 const float* __restrict__ g, const float* __restrict__ bta, float* __restrict__ outf, bf16* outb  , LAS unsigned* wl  ) {
    asm volatile("" : "+v"(lane));
    int idA = ids[(size_t)t * 128 + lane], idB = ids[(size_t)t * 128 + 64 + lane]; float gA = gates[(size_t)t * 128 + lane], gB = gates[(size_t)t * 128 + 64 + lane];
    {
        const unsigned kA = ((unsigned)idA << 7) | (unsigned)lane, kB = ((unsigned)idB << 7) | (unsigned)(64 + lane);
        wl[lane] = kA; wl[64 + lane] = kB;
        asm volatile("s_waitcnt lgkmcnt(0)" ::: "memory");
        int rA = 0, rB = 0;
#pragma unroll 8
        for (int j = 0; j < 128; j += 4) { const u32x4e_t k4 = *(const LAS u32x4e_t*)(wl + j);
#pragma unroll
            for (int q = 0; q < 4; ++q) { rA += (k4[q] < kA) ? 1 : 0; rB += (k4[q] < kB) ? 1 : 0; } }
        asm volatile("s_waitcnt lgkmcnt(0)" ::: "memory");
        wl[128 + rA] = (unsigned)idA; wl[256 + rA] = __float_as_uint(gA); wl[128 + rB] = (unsigned)idB; wl[256 + rB] = __float_as_uint(gB);
        asm volatile("s_waitcnt lgkmcnt(0)" ::: "memory");
        idA = (int)wl[128 + lane]; idB = (int)wl[192 + lane]; gA = __uint_as_float(wl[256 + lane]); gB = __uint_as_float(wl[320 + lane]);
        asm volatile("s_waitcnt lgkmcnt(0)" ::: "memory");
    }
#define ID_OF(e_) __builtin_amdgcn_readlane((e_) < 64 ? idA : idB, (e_) & 63)
#define GATE_OF(e_) __builtin_bit_cast(float, __builtin_amdgcn_readlane(__builtin_bit_cast(int, (e_) < 64 ? gA : gB), (e_) & 63))
    uint2 ra[8][3], rb[8][3];
#define ROW_LOAD(R_, T_, e_) do { _Pragma("unroll") for (int k_ = 0; k_ < 8; ++k_) { const int id_ = ID_OF((e_) + k_); \
        const uint2* p_ = (const uint2*)((T_) + (size_t)id_ * ROW6) + lane * 3; R_[k_][0] = p_[0]; R_[k_][1] = p_[1]; R_[k_][2] = p_[2]; } } while (0)
#define PK6(W_) ((v6u_t){W_[0].x, W_[0].y, W_[1].x, W_[1].y, W_[2].x, W_[2].y})
#define SB_ __builtin_amdgcn_sched_barrier(0)
    float c0 = 0.f, c1 = 0.f;
    {
        unsigned xb[16];
#pragma unroll
        for (int i = 0; i < 4; ++i) { const uint4 v = *(const uint4*)(outb + (size_t)t * DM + lane * 32 + i * 8); xb[4 * i] = v.x; xb[4 * i + 1] = v.y; xb[4 * i + 2] = v.z; xb[4 * i + 3] = v.w; }
#define U_COMP(R_, e_) do { _Pragma("unroll") for (int k_ = 0; k_ < 8; ++k_) { SB_; const v32f_t d_ = __builtin_amdgcn_cvt_scalef32_pk32_f32_fp6(PK6(R_[k_]), 1.0f); float a_ = 0.f, b_ = 0.f; \
            _Pragma("unroll") for (int i_ = 0; i_ < 16; ++i_) { a_ += d_[2 * i_] * __uint_as_float(xb[i_] << 16); b_ += d_[2 * i_ + 1] * __uint_as_float(xb[i_] & 0xffff0000u); } \
            const float s_ = wave_sum(a_ + b_) * (1.0f / U6_SCALE); const float cv_ = GATE_OF((e_) + k_) * (1.0f / V6_SCALE) * gelu_erf(s_); \
            const int ee_ = (e_) + k_; c0 = (lane == ee_) ? cv_ : c0; c1 = (lane == ee_ - 64) ? cv_ : c1; } SB_; } while (0)
        ROW_LOAD(ra, U6, 0);
#pragma nounroll
        for (int e = 0; e < 128; e += 16) {
            ROW_LOAD(rb, U6, e + 8);
            U_COMP(ra, e);
            if (e + 16 < 128) ROW_LOAD(ra, U6, e + 16);
            U_COMP(rb, e + 8);
        }
#undef U_COMP
    }
    v32f_t acc;
#pragma unroll
    for (int i = 0; i < 32; ++i) acc[i] = 0.f;
#define V_COMP(R_, e_) do { _Pragma("unroll") for (int k_ = 0; k_ < 8; ++k_) { SB_; const int ee_ = (e_) + k_; \
            const float cv_ = __builtin_bit_cast(float, __builtin_amdgcn_readlane(__builtin_bit_cast(int, ee_ < 64 ? c0 : c1), ee_ & 63)); \
            acc += __builtin_amdgcn_cvt_scalef32_pk32_f32_fp6(PK6(R_[k_]), 1.0f) * cv_; } SB_; } while (0)
    ROW_LOAD(ra, V6, 0);
#pragma nounroll
    for (int e = 0; e < 128; e += 16) {
        ROW_LOAD(rb, V6, e + 8);
        V_COMP(ra, e);
        if (e + 16 < 128) ROW_LOAD(ra, V6, e + 16);
        V_COMP(rb, e + 8);
    }
#undef V_COMP
#undef ID_OF
#undef GATE_OF
#undef ROW_LOAD
#undef PK6
#undef SB_
    float s = 0.f;
#pragma unroll
    for (int i = 0; i < 8; ++i) { const float4 v = *(const float4*)(x1 + (size_t)t * DM + lane * 32 + i * 4); acc[4 * i] += ALPHA * v.x; acc[4 * i + 1] += ALPHA * v.y; acc[4 * i + 2] += ALPHA * v.z; acc[4 * i + 3] += ALPHA * v.w; }
#pragma unroll
    for (int i = 0; i < 32; ++i) s += acc[i];
    const float mu = wave_sum(s) * (1.0f / DM); float q = 0.f;
#pragma unroll
    for (int i = 0; i < 32; ++i) { acc[i] -= mu; q += acc[i] * acc[i]; }
    const float rs = rsqrtf(wave_sum(q) * (1.0f / DM) + 1e-5f);
    { int z_ = 0; asm volatile("" : "+s"(z_)); g += z_; bta += z_; }
#pragma unroll
    for (int i = 0; i < 8; ++i) { const int c = lane * 32 + i * 4; const float4 gg = *(const float4*)(g + c), bb = *(const float4*)(bta + c);
        float4 y; y.x = acc[4 * i] * rs * gg.x + bb.x; y.y = acc[4 * i + 1] * rs * gg.y + bb.y; y.z = acc[4 * i + 2] * rs * gg.z + bb.z; y.w = acc[4 * i + 3] * rs * gg.w + bb.w;
        *(float4*)(outf + (size_t)t * DM + c) = y; *(uint2*)(outb + (size_t)t * DM + c) = make_uint2(pk2(y.x, y.y), pk2(y.z, y.w)); }
}

typedef short bf16x8_t __attribute__((ext_vector_type(8)));
typedef float f32x4_t __attribute__((ext_vector_type(4)));
typedef unsigned u32x2_t __attribute__((ext_vector_type(2)));
typedef unsigned u32x4_t __attribute__((ext_vector_type(4)));
constexpr int SWA_PITCH = 144;
constexpr int SWA_KS = 0, SWA_VS = 256 * SWA_PITCH, SWA_LDS = 2 * 256 * SWA_PITCH;
static_assert(SWA_LDS <= RING_BYTES, "SWA LDS");
__device__ __forceinline__ float grp4_max(float v) {
    v = fmaxf(v, __builtin_bit_cast(float, __builtin_amdgcn_ds_swizzle(__builtin_bit_cast(int, v), 0x401F)));
    const u32x2_t r = __builtin_amdgcn_permlane32_swap(__builtin_bit_cast(unsigned, v), __builtin_bit_cast(unsigned, v), false, false);
    return fmaxf(__builtin_bit_cast(float, r.x), __builtin_bit_cast(float, r.y));
}
__device__ __forceinline__ float grp4_sum(float v) {
    v += __builtin_bit_cast(float, __builtin_amdgcn_ds_swizzle(__builtin_bit_cast(int, v), 0x401F));
    const u32x2_t r = __builtin_amdgcn_permlane32_swap(__builtin_bit_cast(unsigned, v), __builtin_bit_cast(unsigned, v), false, false);
    return __builtin_bit_cast(float, r.x) + __builtin_bit_cast(float, r.y);
}
__device__ __forceinline__ void tr_read2(unsigned a0, unsigned a1, u32x2_t& r0, u32x2_t& r1) {
    asm volatile("ds_read_b64_tr_b16 %0, %2\n\tds_read_b64_tr_b16 %1, %3\n\ts_waitcnt lgkmcnt(0)" : "=&v"(r0), "=&v"(r1) : "v"(a0), "v"(a1) : "memory");
}
__device__ __forceinline__ void rope8(uint4& lo, uint4& hi, const float4* cs, float scale) {
    unsigned* a = (unsigned*)&lo; unsigned* b = (unsigned*)&hi;
#pragma unroll
    for (int j = 0; j < 4; ++j) {
        const float x1a = __uint_as_float(a[j] << 16), x1b = __uint_as_float(a[j] & 0xffff0000u), x2a = __uint_as_float(b[j] << 16), x2b = __uint_as_float(b[j] & 0xffff0000u);
        const float4 c = cs[j];
        const float y1a = (x1a * c.x - x2a * c.y) * scale, y2a = (x2a * c.x + x1a * c.y) * scale, y1b = (x1b * c.z - x2b * c.w) * scale, y2b = (x2b * c.z + x1b * c.w) * scale;
        a[j] = pk2(y1a, y1b); b[j] = pk2(y2a, y2b);
    }
}
__device__ __forceinline__ void swa_phase(LAS unsigned char* lds, const bf16* __restrict__ proj, const float* __restrict__ rtab  , const float* __restrict__ sinks, bf16* __restrict__ ya,
                                          int tid, int bx, int G) {
    const int lane = tid & 63, w = __builtin_amdgcn_readfirstlane(tid >> 6), l15 = lane & 15, g4 = lane >> 4;
    const unsigned ldsb = (unsigned)(size_t)lds;
    for (int u = bx; u < NBATCH * 32 * 4; u += G) {
        const int kvh = u & 3, nb = (u >> 2) & 31, b = u >> 7;
        const int t0 = b * SEQ + nb * 128;
        __syncthreads();
        for (int it = tid; it < 1024; it += 512) { const int kk = it >> 2, c = it & 3;
            uint4 lo = make_uint4(0u, 0u, 0u, 0u), hi = lo;
            if (nb > 0 || kk >= 128) { const bf16* src = proj + (size_t)(t0 - 128 + kk) * NP + C_AK + kvh * 64 + 8 * c; lo = *(const uint4*)src; hi = *(const uint4*)(src + 32);
                const float4* cs = (const float4*)(rtab + ((size_t)(nb * 128 - 128 + kk) * 32 + 8 * c) * 2); const float4 c4[4] = {cs[0], cs[1], cs[2], cs[3]}; rope8(lo, hi, c4, 1.0f); }
            *(LAS u32x4_t*)(lds + SWA_KS + kk * SWA_PITCH + 16 * c) = __builtin_bit_cast(u32x4_t, lo); *(LAS u32x4_t*)(lds + SWA_KS + kk * SWA_PITCH + 64 + 16 * c) = __builtin_bit_cast(u32x4_t, hi); }
        for (int it = tid; it < 2048; it += 512) { const int kk = it >> 3, c = it & 7;
            uint4 v = make_uint4(0u, 0u, 0u, 0u);
            if (nb > 0 || kk >= 128) v = *(const uint4*)(proj + (size_t)(t0 - 128 + kk) * NP + C_AV + kvh * 64 + 8 * c);
            *(LAS u32x4_t*)(lds + SWA_VS + kk * SWA_PITCH + 16 * c) = __builtin_bit_cast(u32x4_t, v); }
        __syncthreads();
        const int r = w >> 1, hf = w & 1, hq = kvh * 4 + r;
        const float sink = sinks[hq];
#pragma nounroll
        for (int qt = 0; qt < 4; ++qt) {
            const int i0 = 64 * hf + 16 * qt, iq = i0 + l15, tq = t0 + iq, ktb0 = 4 * hf + qt;
            bf16x8_t q0, q1;
            { const bf16* src = proj + (size_t)tq * NP + C_AQ + hq * 64 + 8 * g4; uint4 lo = *(const uint4*)src, hi = *(const uint4*)(src + 32);
              const float4* cs = (const float4*)(rtab + ((size_t)(nb * 128 + iq) * 32 + 8 * g4) * 2); const float4 c4[4] = {cs[0], cs[1], cs[2], cs[3]}; rope8(lo, hi, c4, 0.125f);
              q0 = __builtin_bit_cast(bf16x8_t, lo); q1 = __builtin_bit_cast(bf16x8_t, hi); }
            f32x4_t s[10]; float m = sink;
#pragma unroll
            for (int n = 0; n < 10; ++n) {
                const int kt = (ktb0 + n) < 15 ? (ktb0 + n) : 15;
                const LAS unsigned char* kp = lds + SWA_KS + (16 * kt + l15) * SWA_PITCH + 16 * g4;
                const bf16x8_t a0 = *(const LAS bf16x8_t*)kp, a1 = *(const LAS bf16x8_t*)(kp + 64);
                f32x4_t acc = (f32x4_t){0.f, 0.f, 0.f, 0.f};
                acc = __builtin_amdgcn_mfma_f32_16x16x32_bf16(a0, q0, acc, 0, 0, 0);
                acc = __builtin_amdgcn_mfma_f32_16x16x32_bf16(a1, q1, acc, 0, 0, 0);
#pragma unroll
                for (int e = 0; e < 4; ++e) { const int kk = 16 * (ktb0 + n) + 4 * g4 + e;
                    const bool ok = (kk >= iq + 1) && (kk <= iq + 128) && (nb > 0 || kk >= 128) && (ktb0 + n <= 15);
                    acc[e] = ok ? acc[e] : -1e30f; m = fmaxf(m, acc[e]); }
                s[n] = acc;
            }
            m = grp4_max(m);
            float lsum = 0.f;
#pragma unroll
            for (int n = 0; n < 10; ++n)
#pragma unroll
                for (int e = 0; e < 4; ++e) { const float p = __expf(s[n][e] - m); s[n][e] = p; lsum += p; }
            lsum = grp4_sum(lsum) + __expf(sink - m);
            const float inv = 1.0f / lsum;
            bf16x8_t pf[5];
#pragma unroll
            for (int pi = 0; pi < 5; ++pi) { uint4 w4; w4.x = pk2(s[2 * pi][0], s[2 * pi][1]); w4.y = pk2(s[2 * pi][2], s[2 * pi][3]); w4.z = pk2(s[2 * pi + 1][0], s[2 * pi + 1][1]); w4.w = pk2(s[2 * pi + 1][2], s[2 * pi + 1][3]);
                pf[pi] = __builtin_bit_cast(bf16x8_t, w4); }
            const int qq = l15 >> 2, pp = lane & 3;
#pragma unroll
            for (int dt = 0; dt < 4; ++dt) {
                f32x4_t o = (f32x4_t){0.f, 0.f, 0.f, 0.f};
#pragma unroll
                for (int pi = 0; pi < 5; ++pi) {
                    const int ka = (ktb0 + 2 * pi) < 15 ? (ktb0 + 2 * pi) : 15, kb = (ktb0 + 2 * pi + 1) < 15 ? (ktb0 + 2 * pi + 1) : 15;
                    u32x2_t v0, v1;
                    tr_read2(ldsb + SWA_VS + (16 * ka + 4 * g4 + qq) * SWA_PITCH + (16 * dt + 4 * pp) * 2, ldsb + SWA_VS + (16 * kb + 4 * g4 + qq) * SWA_PITCH + (16 * dt + 4 * pp) * 2, v0, v1);
                    const uint4 av = make_uint4(v0.x, v0.y, v1.x, v1.y);
                    o = __builtin_amdgcn_mfma_f32_16x16x32_bf16(__builtin_bit_cast(bf16x8_t, av), pf[pi], o, 0, 0, 0);
                }
                *(uint2*)(ya + (size_t)tq * 1024 + hq * 64 + 16 * dt + 4 * g4) = make_uint2(pk2(o[0] * inv, o[1] * inv), pk2(o[2] * inv, o[3] * inv));
            }
        }
    }
}

constexpr size_t WS_MG = WS_R1 + 128 * MiB, WS_MEG = WS_MG + 2 * MiB, WS_SG = WS_MG + 3 * MiB, WS_SEA = WS_SG + 8 * MiB;
__device__ __forceinline__ void mlstm_gate_item(int item, int lane, LAS float* wl, const float* __restrict__ small, const float* __restrict__ gate_b, float4* __restrict__ mg, float* __restrict__ meg) {
    const int ch = item & 63, h = (item >> 6) & 3, b = item >> 8; const size_t t = (size_t)b * SEQ + ch * 64 + lane;
    const float ip = small[t * 32 + h] + gate_b[h], fp = small[t * 32 + 4 + h] + gate_b[4 + h];
    wl[lane] = fminf(fp, 0.f) - log1pf(__expf(-fabsf(fp)));
    asm volatile("s_waitcnt lgkmcnt(0)" ::: "memory");
    float bs = 0.f;
#pragma unroll
    for (int j = 0; j < 64; j += 4) { const f32x4_t v4 = *(const LAS f32x4_t*)(wl + j);
        bs += (j + 0 <= lane) ? v4[0] : 0.f; bs += (j + 1 <= lane) ? v4[1] : 0.f; bs += (j + 2 <= lane) ? v4[2] : 0.f; bs += (j + 3 <= lane) ? v4[3] : 0.f; }
    const float gt = __builtin_bit_cast(float, __builtin_amdgcn_readlane(__builtin_bit_cast(int, bs), 63));
    mg[t * 4 + h] = make_float4(bs, ip - bs, __expf(bs), __expf(gt - bs + ip) * 0.08838834764831845f);
    if (lane == 0) meg[(b * 4 + h) * 64 + ch] = __expf(gt);
    asm volatile("s_waitcnt lgkmcnt(0)" ::: "memory");
}
__device__ __forceinline__ void ssd_gate_item(int item, int lane, LAS float* wl, const float* __restrict__ small, const float* __restrict__ dt_bias, const float* __restrict__ a_log, float4* __restrict__ sg, float* __restrict__ sea) {
    const int ch = item & 31, hh = (item >> 5) & 15, b = item >> 9; const size_t t0 = (size_t)b * SEQ + ch * 128;
    const float a = -__expf(a_log[hh]), dtb = dt_bias[hh];
    float dt[2];
#pragma unroll
    for (int r = 0; r < 2; ++r) { const float dtr = small[(t0 + lane + 64 * r) * 32 + 8 + hh] + dtb; dt[r] = dtr > 20.f ? dtr : log1pf(__expf(dtr)); wl[lane + 64 * r] = dt[r] * a; }
    asm volatile("s_waitcnt lgkmcnt(0)" ::: "memory");
    float a0 = 0.f, a1 = 0.f;
#pragma unroll 8
    for (int j = 0; j < 128; j += 4) { const f32x4_t v4 = *(const LAS f32x4_t*)(wl + j);
#pragma unroll
        for (int q = 0; q < 4; ++q) { a0 += (j + q <= lane) ? v4[q] : 0.f; a1 += (j + q <= lane + 64) ? v4[q] : 0.f; } }
    const float atot = __builtin_bit_cast(float, __builtin_amdgcn_readlane(__builtin_bit_cast(int, a1), 63));
    sg[(t0 + lane) * 16 + hh] = make_float4(dt[0], a0, __expf(a0), __expf(atot - a0) * dt[0]);
    sg[(t0 + lane + 64) * 16 + hh] = make_float4(dt[1], a1, __expf(a1), __expf(atot - a1) * dt[1]);
    if (lane == 0) sea[(b * 16 + hh) * 32 + ch] = __expf(atot);
    asm volatile("s_waitcnt lgkmcnt(0)" ::: "memory");
}

constexpr int ML_QP = 272, ML_VP = 112, ML_PP = 144;
constexpr int ML_Q = 0, ML_K = 2 * 64 * ML_QP, ML_V = ML_K + 2 * 64 * ML_QP, ML_VW = ML_V + 2 * 64 * ML_VP, ML_P = ML_VW + 64 * ML_VP, ML_CT = ML_P + 64 * ML_PP,
              ML_VEC = ML_CT + 48 * ML_QP, ML_END = ML_VEC + 4096;
static_assert(ML_END <= RING_BYTES, "mLSTM LDS");
__device__ __forceinline__ void tr_read2q(unsigned a0, unsigned a1, u32x2_t& r0, u32x2_t& r1) {
    asm volatile("ds_read_b64_tr_b16 %0, %2\n\tds_read_b64_tr_b16 %1, %3\n\ts_waitcnt lgkmcnt(0)" : "=&v"(r0), "=&v"(r1) : "v"(a0), "v"(a1) : "memory");
}
__device__ __forceinline__ bf16x8_t mk_frag(u32x2_t lo, u32x2_t hi) { const u32x4_t v = (u32x4_t){lo.x, lo.y, hi.x, hi.y}; return __builtin_bit_cast(bf16x8_t, v); }
#define LBAR() do { asm volatile("s_waitcnt lgkmcnt(0)" ::: "memory"); __builtin_amdgcn_s_barrier(); asm volatile("" ::: "memory"); } while (0)
__device__ __forceinline__ void mlstm_phase(LAS unsigned char* lds, const bf16* __restrict__ proj, const float4* __restrict__ mg, const float* __restrict__ meg, float* __restrict__ hm, int tid, int bx, int G) {
    const int lane = tid & 63, w = __builtin_amdgcn_readfirstlane(tid >> 6), l15 = lane & 15, g4 = lane >> 4, qq = l15 >> 2, pp = lane & 3;
    const unsigned ldsb = (unsigned)(size_t)lds;
    LAS float* vec = (LAS float*)(lds + ML_VEC);
    for (int u = bx; u < NBATCH * 4 * 8; u += G) {
        const int vs = u & 7, h = (u >> 3) & 3, b = u >> 5;
        LBAR();
        for (int i = tid; i < 2 * 64; i += 512) { LAS unsigned* p = (LAS unsigned*)(lds + ML_V + i * ML_VP + 64); p[0] = 0x00003F80u;
#pragma unroll
            for (int j = 1; j < 8; ++j) p[j] = 0u; }
        for (int i = tid; i < 48 * ML_QP / 4; i += 512) ((LAS unsigned*)(lds + ML_CT))[i] = 0u;
        f32x4_t cacc[3];
#pragma unroll
        for (int i = 0; i < 3; ++i) cacc[i] = (f32x4_t){0.f, 0.f, 0.f, 0.f};
        struct MLRegs { uint4 pq[2], pk[2], pv; float4 pg; float peg; } rs[2];
#pragma unroll
        for (int i = 0; i < 2; ++i) { rs[i].pv = make_uint4(0u, 0u, 0u, 0u); rs[i].pg = make_float4(0.f, 0.f, 0.f, 0.f); rs[i].peg = 0.f; }
#define ML_LOAD(R_, c_) do { const size_t tb_ = (size_t)b * SEQ + (size_t)(c_) * 64; \
            _Pragma("unroll") for (int i_ = 0; i_ < 2; ++i_) { const int p_ = tid + 512 * i_, row_ = p_ >> 4, c16_ = p_ & 15; const bf16* s_ = proj + (tb_ + row_) * NP + h * 128 + c16_ * 8; R_.pq[i_] = *(const uint4*)(s_ + C_MQ); R_.pk[i_] = *(const uint4*)(s_ + C_MK); } \
            if (tid < 256) R_.pv = *(const uint4*)(proj + (tb_ + (tid >> 2)) * NP + C_MV + h * 256 + vs * 32 + (tid & 3) * 8); \
            if (tid >= 256 && tid < 320) { R_.pg = mg[(tb_ + (tid - 256)) * 4 + h]; R_.peg = meg[(b * 4 + h) * 64 + (c_)]; } } while (0)
#define ML_STORE(R_, bi_) do { _Pragma("unroll") for (int i_ = 0; i_ < 2; ++i_) { const int p_ = tid + 512 * i_, row_ = p_ >> 4, c16_ = p_ & 15; \
                *(LAS u32x4_t*)(lds + ML_Q + (bi_) * 64 * ML_QP + row_ * ML_QP + c16_ * 16) = __builtin_bit_cast(u32x4_t, R_.pq[i_]); *(LAS u32x4_t*)(lds + ML_K + (bi_) * 64 * ML_QP + row_ * ML_QP + c16_ * 16) = __builtin_bit_cast(u32x4_t, R_.pk[i_]); } \
            if (tid < 256) *(LAS u32x4_t*)(lds + ML_V + (bi_) * 64 * ML_VP + (tid >> 2) * ML_VP + (tid & 3) * 16) = __builtin_bit_cast(u32x4_t, R_.pv); \
            if (tid >= 256 && tid < 320) { LAS float* v_ = vec + (bi_) * 320 + (tid - 256); v_[0] = R_.pg.x; v_[64] = R_.pg.y; v_[128] = R_.pg.z; v_[192] = R_.pg.w; if (tid == 256) vec[(bi_) * 320 + 256] = R_.peg; } } while (0)
        ML_LOAD(rs[0], 0); ML_STORE(rs[0], 0); ML_LOAD(rs[1], 1);
        LBAR();
#pragma nounroll
        for (int c2 = 0; c2 < 64; c2 += 2) {
#pragma unroll
          for (int par = 0; par < 2; ++par) {
            const int c = c2 + par, bi_cur = par;
            const LAS unsigned char* Qs = lds + ML_Q + bi_cur * 64 * ML_QP; const LAS unsigned char* Ks = lds + ML_K + bi_cur * 64 * ML_QP;
            const unsigned Ksb = ldsb + ML_K + bi_cur * 64 * ML_QP, Vsb = ldsb + ML_V + bi_cur * 64 * ML_VP, Vwb = ldsb + ML_VW;
            if (c + 2 < 64) ML_LOAD(rs[par], c + 2);
            const LAS float* vb = vec + bi_cur * 320;
            {
                const int ti = w >> 1;
#pragma unroll
                for (int sj = 0; sj < 2; ++sj) {
                    const int si = 2 * (w & 1) + sj;
                    f32x4_t acc = (f32x4_t){0.f, 0.f, 0.f, 0.f};
                    if (si <= ti) {
#pragma unroll
                        for (int ks = 0; ks < 4; ++ks) {
                            const bf16x8_t a = *(const LAS bf16x8_t*)(Ks + (16 * si + l15) * ML_QP + (32 * ks + 8 * g4) * 2);
                            const bf16x8_t bq = *(const LAS bf16x8_t*)(Qs + (16 * ti + l15) * ML_QP + (32 * ks + 8 * g4) * 2);
                            acc = __builtin_amdgcn_mfma_f32_16x16x32_bf16(a, bq, acc, 0, 0, 0);
                        }
                        const int t = 16 * ti + l15; const float btv = vb[t];
                        const f32x4_t csv = *(const LAS f32x4_t*)(vb + 64 + 16 * si + 4 * g4);
#pragma unroll
                        for (int e = 0; e < 4; ++e) { const int s = 16 * si + 4 * g4 + e; acc[e] = (s <= t) ? acc[e] * __expf(btv + csv[e]) * 0.08838834764831845f : 0.f; }
                    }
                    *(LAS u32x2_t*)(lds + ML_P + (16 * ti + l15) * ML_PP + (16 * si + 4 * g4) * 2) = (u32x2_t){pk2(acc[0], acc[1]), pk2(acc[2], acc[3])};
                }
            }
            if (tid < 384) { const int s = tid / 6, pc = tid % 6; const float wsv = vb[192 + s];
                const u32x4_t v = *(const LAS u32x4_t*)(lds + ML_V + bi_cur * 64 * ML_VP + s * ML_VP + pc * 16); u32x4_t o;
#pragma unroll
                for (int j = 0; j < 4; ++j) o[j] = pk2(__uint_as_float(v[j] << 16) * wsv, __uint_as_float(v[j] & 0xffff0000u) * wsv);
                *(LAS u32x4_t*)(lds + ML_VW + s * ML_VP + pc * 16) = o; }
            LBAR();
            f32x4_t numv[2]; const int ti5 = w >> 1;
            {
                const int nv = (w & 1) ? 1 : 2, v0 = (w & 1) ? 2 : 0;
#pragma unroll
                for (int j = 0; j < 2; ++j) {
                    numv[j] = (f32x4_t){0.f, 0.f, 0.f, 0.f};
                    if (j < nv) {
                        const int vi = v0 + j;
                        f32x4_t ai = (f32x4_t){0.f, 0.f, 0.f, 0.f}, ax = ai;
#pragma unroll
                        for (int ks = 0; ks < 2; ++ks) {
                            const bf16x8_t a = *(const LAS bf16x8_t*)(lds + ML_P + (16 * ti5 + l15) * ML_PP + (32 * ks + 8 * g4) * 2);
                            u32x2_t r0, r1; tr_read2q(Vsb + (32 * ks + 8 * g4 + qq) * ML_VP + (16 * vi + 4 * pp) * 2, Vsb + (32 * ks + 8 * g4 + 4 + qq) * ML_VP + (16 * vi + 4 * pp) * 2, r0, r1);
                            ai = __builtin_amdgcn_mfma_f32_16x16x32_bf16(a, mk_frag(r0, r1), ai, 0, 0, 0);
                        }
#pragma unroll
                        for (int ks = 0; ks < 4; ++ks) {
                            const bf16x8_t a = *(const LAS bf16x8_t*)(Qs + (16 * ti5 + l15) * ML_QP + (32 * ks + 8 * g4) * 2);
                            const bf16x8_t bc = *(const LAS bf16x8_t*)(lds + ML_CT + (16 * vi + l15) * ML_QP + (32 * ks + 8 * g4) * 2);
                            ax = __builtin_amdgcn_mfma_f32_16x16x32_bf16(a, bc, ax, 0, 0, 0);
                        }
                        const f32x4_t eb = *(const LAS f32x4_t*)(vb + 128 + 16 * ti5 + 4 * g4);
                        numv[j] = ai + eb * ax;
                    }
                }
                if ((w & 1) && l15 == 0) *(LAS f32x4_t*)(vec + 640 + 16 * ti5 + 4 * g4) = numv[0];
            }
            LBAR();
            if (!(w & 1)) {
                const f32x4_t dn = *(const LAS f32x4_t*)(vec + 640 + 16 * ti5 + 4 * g4);
                const size_t tb = (size_t)b * SEQ + (size_t)c * 64;
#pragma unroll
                for (int j = 0; j < 2; ++j)
#pragma unroll
                    for (int e = 0; e < 4; ++e) hm[(tb + 16 * ti5 + 4 * g4 + e) * 1024 + h * 256 + vs * 32 + 16 * j + l15] = numv[j][e] / fmaxf(fabsf(dn[e]), 1.0f);
            }
            {
                const float eg = vb[256];
#pragma unroll
                for (int vi = 0; vi < 3; ++vi) {
                    f32x4_t acc = cacc[vi] * eg;
#pragma unroll
                    for (int ks = 0; ks < 2; ++ks) {
                        u32x2_t a0, a1, b0, b1;
                        tr_read2q(Ksb + (32 * ks + 8 * g4 + qq) * ML_QP + (16 * w + 4 * pp) * 2, Ksb + (32 * ks + 8 * g4 + 4 + qq) * ML_QP + (16 * w + 4 * pp) * 2, a0, a1);
                        tr_read2q(Vwb + (32 * ks + 8 * g4 + qq) * ML_VP + (16 * vi + 4 * pp) * 2, Vwb + (32 * ks + 8 * g4 + 4 + qq) * ML_VP + (16 * vi + 4 * pp) * 2, b0, b1);
                        acc = __builtin_amdgcn_mfma_f32_16x16x32_bf16(mk_frag(a0, a1), mk_frag(b0, b1), acc, 0, 0, 0);
                    }
                    cacc[vi] = acc;
                    *(LAS u32x2_t*)(lds + ML_CT + (16 * vi + l15) * ML_QP + (16 * w + 4 * g4) * 2) = (u32x2_t){pk2(acc[0], acc[1]), pk2(acc[2], acc[3])};
                }
            }
            if (c + 1 < 64) ML_STORE(rs[par ^ 1], bi_cur ^ 1);
            LBAR();
          }
        }
#undef ML_LOAD
#undef ML_STORE
    }
}

constexpr int SD_BP = 272, SD_XP = 80;
constexpr int SD_B = 0, SD_C = 128 * SD_BP, SD_M = 2 * 128 * SD_BP, SD_H = 3 * 128 * SD_BP, SD_X = SD_H + 32 * SD_BP, SD_XW = SD_X + 128 * SD_XP, SD_VEC = SD_XW + 128 * SD_XP, SD_END = SD_VEC + 4096;
static_assert(SD_END <= PHASE_LDS_BYTES, "SSD LDS");
__device__ __forceinline__ void ssd_phase(LAS unsigned char* lds, const bf16* __restrict__ xcb  , const float4* __restrict__ sg, const float* __restrict__ sea,
                                          const float* __restrict__ dsk, float* __restrict__ yraw  , int tid, int bx, int G) {
    const int lane = tid & 63, w = __builtin_amdgcn_readfirstlane(tid >> 6), l15 = lane & 15, g4 = lane >> 4, qq = l15 >> 2, pp = lane & 3;
    const unsigned ldsb = (unsigned)(size_t)lds;
    LAS float* vec = (LAS float*)(lds + SD_VEC);
    for (int u = bx; u < NBATCH * 16 * 2; u += G) {
        const int ph = u & 1, hh = (u >> 1) & 15, b = u >> 5, g = hh >> 3;
        const float Dk = dsk[hh];
        LBAR();
        for (int i = tid; i < 32 * SD_BP / 4; i += 512) ((LAS unsigned*)(lds + SD_H))[i] = 0u;
        f32x4_t hacc[2];
        hacc[0] = (f32x4_t){0.f, 0.f, 0.f, 0.f}; hacc[1] = hacc[0];
        uint4 pb[4], pc[4], px; float4 pg = make_float4(0.f, 0.f, 0.f, 0.f); float pea = 0.f;
#define SD_LOAD(c_) do { const size_t tb_ = (size_t)b * SEQ + (size_t)(c_) * 128; \
            _Pragma("unroll") for (int i_ = 0; i_ < 4; ++i_) { const int p_ = tid + 512 * i_, row_ = p_ >> 4, c16_ = p_ & 15; const bf16* s_ = xcb + (tb_ + row_) * 1536 + 1024 + g * 128 + c16_ * 8; pb[i_] = *(const uint4*)s_; pc[i_] = *(const uint4*)(s_ + 256); } \
            px = *(const uint4*)(xcb + (tb_ + (tid >> 2)) * 1536 + hh * 64 + ph * 32 + (tid & 3) * 8); \
            if (tid < 128) { pg = sg[(tb_ + tid) * 16 + hh]; pea = sea[(b * 16 + hh) * 32 + (c_)]; } } while (0)
#define SD_STORE() do { _Pragma("unroll") for (int i_ = 0; i_ < 4; ++i_) { const int p_ = tid + 512 * i_, row_ = p_ >> 4, c16_ = p_ & 15; \
                *(LAS u32x4_t*)(lds + SD_B + row_ * SD_BP + c16_ * 16) = __builtin_bit_cast(u32x4_t, pb[i_]); *(LAS u32x4_t*)(lds + SD_C + row_ * SD_BP + c16_ * 16) = __builtin_bit_cast(u32x4_t, pc[i_]); } \
            *(LAS u32x4_t*)(lds + SD_X + (tid >> 2) * SD_XP + (tid & 3) * 16) = __builtin_bit_cast(u32x4_t, px); \
            if (tid < 128) { vec[640 + tid] = pg.x; vec[256 + tid] = pg.y; vec[384 + tid] = pg.z; vec[512 + tid] = pg.w; if (tid == 0) vec[769] = pea; } } while (0)
        SD_LOAD(0); SD_STORE();
        LBAR();
#pragma nounroll
        for (int c = 0; c < 32; ++c) {
            if (c + 1 < 32) SD_LOAD(c + 1);
            {
                const int li = w; const int l = 16 * li + l15; const float acl = vec[256 + l];
#pragma unroll
                for (int si = 0; si < 8; ++si) {
                    f32x4_t acc = (f32x4_t){0.f, 0.f, 0.f, 0.f};
                    if (si <= li) {
#pragma unroll
                        for (int ks = 0; ks < 4; ++ks) {
                            const bf16x8_t av = *(const LAS bf16x8_t*)(lds + SD_B + (16 * si + l15) * SD_BP + (32 * ks + 8 * g4) * 2);
                            const bf16x8_t bv = *(const LAS bf16x8_t*)(lds + SD_C + (16 * li + l15) * SD_BP + (32 * ks + 8 * g4) * 2);
                            acc = __builtin_amdgcn_mfma_f32_16x16x32_bf16(av, bv, acc, 0, 0, 0);
                        }
                        const f32x4_t acs = *(const LAS f32x4_t*)(vec + 256 + 16 * si + 4 * g4), dts = *(const LAS f32x4_t*)(vec + 640 + 16 * si + 4 * g4);
#pragma unroll
                        for (int e = 0; e < 4; ++e) { const int s = 16 * si + 4 * g4 + e; acc[e] = (s <= l) ? acc[e] * __expf(acl - acs[e]) * dts[e] : 0.f; }
                    }
                    *(LAS u32x2_t*)(lds + SD_M + l * SD_BP + (16 * si + 4 * g4) * 2) = (u32x2_t){pk2(acc[0], acc[1]), pk2(acc[2], acc[3])};
                }
            }
            LBAR();
            { const int s = tid >> 2, pcx = tid & 3; const float wv = vec[512 + s];
              const u32x4_t v = *(const LAS u32x4_t*)(lds + SD_X + s * SD_XP + pcx * 16); u32x4_t o;
#pragma unroll
              for (int j = 0; j < 4; ++j) o[j] = pk2(__uint_as_float(v[j] << 16) * wv, __uint_as_float(v[j] & 0xffff0000u) * wv);
              *(LAS u32x4_t*)(lds + SD_XW + s * SD_XP + pcx * 16) = o; }
            {
                const int li = w; const size_t tb = (size_t)b * SEQ + (size_t)c * 128;
                const f32x4_t eac = *(const LAS f32x4_t*)(vec + 384 + 16 * li + 4 * g4);
#pragma unroll
                for (int pi = 0; pi < 2; ++pi) {
                    f32x4_t yd = (f32x4_t){0.f, 0.f, 0.f, 0.f}, yo = yd;
#pragma unroll
                    for (int ks = 0; ks < 4; ++ks) {
                        if (32 * ks <= 16 * li + 15) {
                            const bf16x8_t av = *(const LAS bf16x8_t*)(lds + SD_M + (16 * li + l15) * SD_BP + (32 * ks + 8 * g4) * 2);
                            u32x2_t r0, r1; tr_read2q(ldsb + SD_X + (32 * ks + 8 * g4 + qq) * SD_XP + (16 * pi + 4 * pp) * 2, ldsb + SD_X + (32 * ks + 8 * g4 + 4 + qq) * SD_XP + (16 * pi + 4 * pp) * 2, r0, r1);
                            yd = __builtin_amdgcn_mfma_f32_16x16x32_bf16(av, mk_frag(r0, r1), yd, 0, 0, 0);
                        }
                    }
#pragma unroll
                    for (int ks = 0; ks < 4; ++ks) {
                        const bf16x8_t av = *(const LAS bf16x8_t*)(lds + SD_C + (16 * li + l15) * SD_BP + (32 * ks + 8 * g4) * 2);
                        const bf16x8_t bh = *(const LAS bf16x8_t*)(lds + SD_H + (16 * pi + l15) * SD_BP + (32 * ks + 8 * g4) * 2);
                        yo = __builtin_amdgcn_mfma_f32_16x16x32_bf16(av, bh, yo, 0, 0, 0);
                    }
#pragma unroll
                    for (int e = 0; e < 4; ++e) { const int l = 16 * li + 4 * g4 + e;
                        const float xv = __uint_as_float(((unsigned)*(const LAS unsigned short*)(lds + SD_X + l * SD_XP + (16 * pi + l15) * 2)) << 16);
                        yraw[(tb + l) * 1024 + hh * 64 + ph * 32 + 16 * pi + l15] = yd[e] + eac[e] * yo[e] + Dk * xv; }
                }
            }
            LBAR();
            {
                const float ea = vec[769];
#pragma unroll
                for (int pi = 0; pi < 2; ++pi) {
                    f32x4_t acc = hacc[pi] * ea;
#pragma unroll
                    for (int ks = 0; ks < 4; ++ks) {
                        u32x2_t a0, a1, b0, b1;
                        tr_read2q(ldsb + SD_B + (32 * ks + 8 * g4 + qq) * SD_BP + (16 * w + 4 * pp) * 2, ldsb + SD_B + (32 * ks + 8 * g4 + 4 + qq) * SD_BP + (16 * w + 4 * pp) * 2, a0, a1);
                        tr_read2q(ldsb + SD_XW + (32 * ks + 8 * g4 + qq) * SD_XP + (16 * pi + 4 * pp) * 2, ldsb + SD_XW + (32 * ks + 8 * g4 + 4 + qq) * SD_XP + (16 * pi + 4 * pp) * 2, b0, b1);
                        acc = __builtin_amdgcn_mfma_f32_16x16x32_bf16(mk_frag(a0, a1), mk_frag(b0, b1), acc, 0, 0, 0);
                    }
                    hacc[pi] = acc;
                    *(LAS u32x2_t*)(lds + SD_H + (16 * pi + l15) * SD_BP + (16 * w + 4 * g4) * 2) = (u32x2_t){pk2(acc[0], acc[1]), pk2(acc[2], acc[3])};
                }
            }
            LBAR();
            if (c + 1 < 32) SD_STORE();
            LBAR();
        }
#undef SD_LOAD
#undef SD_STORE
    }
}

constexpr int PS_SKP = 272;
constexpr int PS_SK = 0, PS_END = 2 * 128 * PS_SKP;
static_assert(PS_END <= PHASE_LDS_BYTES, "PEER select LDS");
__device__ __forceinline__ unsigned fkey(float f) { const unsigned u = __float_as_uint(f); return u ^ ((unsigned)((int)u >> 31) | 0x80000000u); }
__device__ __forceinline__ float funkey(unsigned k) { return __uint_as_float((k & 0x80000000u) ? (k ^ 0x80000000u) : ~k); }
template <int CTRL> __device__ __forceinline__ unsigned dpp_u(unsigned v) { return (unsigned)__builtin_amdgcn_update_dpp(0, (int)v, CTRL, 0xF, 0xF, true); }
__device__ __forceinline__ unsigned umax(unsigned a, unsigned b) { return a > b ? a : b; }
__device__ __forceinline__ unsigned row_umax(unsigned v) { v = umax(v, dpp_u<0xB1>(v)); v = umax(v, dpp_u<0x4E>(v)); v = umax(v, dpp_u<0x141>(v)); v = umax(v, dpp_u<0x140>(v)); return v; }
__device__ __forceinline__ float row_sum(float v) { v += dpp_f<0xB1>(v); v += dpp_f<0x4E>(v); v += dpp_f<0x141>(v); v += dpp_f<0x140>(v); return v; }
template <int N> __device__ __forceinline__ unsigned row_top16(unsigned (&s)[N], int l15) {
    unsigned mine = 0u;
#pragma unroll
    for (int j = 0; j < 16; ++j) {
        unsigned m = s[0];
#pragma unroll
        for (int i = 1; i < N; ++i) m = umax(m, s[i]);
        m = row_umax(m);
        mine = (l15 == j) ? m : mine;
#pragma unroll
        for (int i = 0; i < N; ++i) s[i] = (s[i] == m) ? 0u : s[i];
    }
    return mine;
}
__device__ __forceinline__ void peer_select_phase(LAS unsigned char* lds, const bf16* __restrict__ qb  , const bf16* __restrict__ skb  , int* __restrict__ ids, float* __restrict__ gates,
                                                  int tid, int bx, int G) {
    const int lane = tid & 63, w = __builtin_amdgcn_readfirstlane(tid >> 6), l15 = lane & 15, g4 = lane >> 4;
    int ca[4], cb[4];
#pragma unroll
    for (int i = 0; i < 4; ++i) { const int sg = 4 * l15 + i; int a = 0, base = 0;
#pragma unroll
        for (int k = 0; k < 15; ++k) { const int cnt = 16 / (k + 1); const bool adv = (a == k) && (sg >= base + cnt); base += adv ? cnt : 0; a += adv ? 1 : 0; }
        ca[i] = a; cb[i] = sg - base; if (sg >= 50) { ca[i] = -1; cb[i] = 0; } }
    for (int u = bx; u < 8 * 32; u += G) {
        const int h = u >> 5, tr = u & 31;
        LBAR();
        for (int it = tid; it < 4096; it += 512) { const int row = it >> 4, c16 = it & 15;
            *(LAS u32x4_t*)(lds + PS_SK + row * PS_SKP + c16 * 16) = __builtin_bit_cast(u32x4_t, *(const uint4*)(skb + ((size_t)h * 256 + row) * 128 + c16 * 8)); }
        LBAR();
#pragma nounroll
        for (int tile = w; tile < 64; tile += 8) {
            const int t0 = tr * 1024 + tile * 16;
            unsigned top[2][4];
#pragma unroll
            for (int c = 0; c < 2; ++c) {
                bf16x8_t af[4];
#pragma unroll
                for (int ks = 0; ks < 4; ++ks) af[ks] = __builtin_bit_cast(bf16x8_t, *(const uint4*)(qb + (size_t)(t0 + l15) * DM + h * 256 + c * 128 + 32 * ks + 8 * g4));
                unsigned key[8][4];
#pragma unroll
                for (int kt = 0; kt < 8; ++kt) {
                    f32x4_t acc = (f32x4_t){0.f, 0.f, 0.f, 0.f};
#pragma unroll
                    for (int ks = 0; ks < 4; ++ks) {
                        const bf16x8_t bfr = *(const LAS bf16x8_t*)(lds + PS_SK + (c * 128 + 16 * kt + l15) * PS_SKP + (32 * ks + 8 * g4) * 2);
                        acc = __builtin_amdgcn_mfma_f32_16x16x32_bf16(af[ks], bfr, acc, 0, 0, 0);
                    }
#pragma unroll
                    for (int e = 0; e < 4; ++e) key[kt][e] = (fkey(acc[e]) & ~0x7Fu) | (unsigned)(127 - (16 * kt + l15));
                }
#pragma unroll
                for (int e = 0; e < 4; ++e) { unsigned s8[8];
#pragma unroll
                    for (int kt = 0; kt < 8; ++kt) s8[kt] = key[kt][e];
                    __builtin_amdgcn_sched_barrier(0); top[c][e] = row_top16<8>(s8, l15); __builtin_amdgcn_sched_barrier(0); }
            }
#pragma unroll
            for (int e = 0; e < 4; ++e) {
                unsigned s4[4];
#pragma unroll
                for (int i = 0; i < 4; ++i) {
                    const int srcA = ((lane & 48) + (ca[i] < 0 ? 0 : ca[i])) * 4, srcB = ((lane & 48) + cb[i]) * 4;
                    const unsigned ka = (unsigned)__builtin_amdgcn_ds_bpermute(srcA, (int)top[0][e]), kb = (unsigned)__builtin_amdgcn_ds_bpermute(srcB, (int)top[1][e]);
                    const float cv = funkey(ka & ~0x7Fu) + funkey(kb & ~0x7Fu);
                    s4[i] = ca[i] < 0 ? 0u : ((fkey(cv) & ~0xFFu) | (unsigned)(255 - (ca[i] * 16 + cb[i])));
                }
                __builtin_amdgcn_sched_barrier(0); const unsigned win = row_top16<4>(s4, l15); __builtin_amdgcn_sched_barrier(0);
                const int jw = 255 - (int)(win & 0xFFu), wa = jw >> 4, wb = jw & 15;
                const unsigned ka = (unsigned)__builtin_amdgcn_ds_bpermute(((lane & 48) + wa) * 4, (int)top[0][e]), kb = (unsigned)__builtin_amdgcn_ds_bpermute(((lane & 48) + wb) * 4, (int)top[1][e]);
                const float bv = funkey(ka & ~0x7Fu) + funkey(kb & ~0x7Fu);
                const int id = (127 - (int)(ka & 0x7Fu)) * 128 + (127 - (int)(kb & 0x7Fu));
                const float mx = __builtin_bit_cast(float, __builtin_amdgcn_ds_bpermute((lane & 48) * 4, __builtin_bit_cast(int, bv)));
                const float ex = __expf(bv - mx), den = row_sum(ex);
                const size_t o = (size_t)(t0 + 4 * g4 + e) * 128 + h * 16 + l15;
                ids[o] = id; gates[o] = ex / den;
            }
        }
    }
}

struct MegaArgs { const float* in[22]; float* out; unsigned char* ws; };
template <int I> __device__ __forceinline__ unsigned long long ld_ptr() {
    unsigned long long v; const auto ka = __builtin_amdgcn_kernarg_segment_ptr();
    asm volatile("s_load_dwordx2 %0, %1, %2\n\ts_waitcnt lgkmcnt(0)" : "=s"(v) : "s"(ka), "n"(I * 8) : "memory");
    return v;
}
#define GAS_ __attribute__((address_space(1)))
#define INF(i) ((const float*)(const GAS_ float*)ld_ptr<(i)>())
#define OUTP ((float*)(GAS_ float*)ld_ptr<22>())
#define WSP ((unsigned char*)(GAS_ unsigned char*)ld_ptr<23>())
enum { I_X = 0, I_WIN, I_MGATEB, I_MNORMW, I_CONVW, I_CONVB, I_DTB, I_ALOG, I_SSMD, I_SNORMW, I_SINKS, I_MERGEB, I_WBR, I_WOUT, I_LN1G, I_LN1B, I_WQ, I_SUBK, I_PU, I_PV, I_LN2G, I_LN2B };

__global__ void __launch_bounds__(512, 2) mega_fwd(MegaArgs a) {
    extern __shared__ __attribute__((aligned(16))) unsigned char lds_raw[];
    LAS unsigned char* lds = (LAS unsigned char*)lds_raw;
    const int wave0 = __builtin_amdgcn_readfirstlane(threadIdx.x >> 6);
    volatile LAS unsigned* MISC = (volatile LAS unsigned*)(lds + MISC_OFF);
    { PHASE_IDS for (int u = tid; u < (LDS_BYTES - PHASE_LDS_BYTES) / 4; u += 512) ((LAS unsigned*)(lds + PHASE_LDS_BYTES))[u] = 0u; }
    __syncthreads();
    { XcdBarrier b0 = xcd_barrier_post((unsigned*)(WSP + WS_CTL) + CW_BAR, MISC + 8); (void)b0; }
#define GRID_BAR() do { XcdBarrier b_; b_.bar = (unsigned*)(WSP + WS_CTL) + CW_BAR; b_.x = xb_xcc_id(); b_.st = MISC + 8; xcd_barrier(b_); } while (0)

    { PHASE_IDS float2* rt = (float2*)(WSP + WS_ROPE);
      for (size_t i = gt; i < (size_t)SEQ * 32; i += NGT) { const int pos = (int)(i >> 5), fi = (int)(i & 31); const float ang = (float)pos * powf(10000.0f, -(float)fi / 32.0f); rt[i] = make_float2(cosf(ang), sinf(ang)); } }
    { PHASE_IDS const float* x = INF(I_X); bf16* xb = (bf16*)(WSP + WS_XB);
      for (size_t i = gt; i < (size_t)T_TOK * DM / 4; i += NGT) { const float4 v = ((const float4*)x)[i]; ((uint2*)xb)[i] = make_uint2(pk2(v.x, v.y), pk2(v.z, v.w)); } }

#pragma nounroll
    for (int l = 0; l < DEPTH; ++l) {
        { PHASE_IDS
            unsigned char* ws = WSP; bf16* WinT = (bf16*)(ws + WS_WIN); bf16* WbT = (bf16*)(ws + WS_WB); bf16* WoT = (bf16*)(ws + WS_WO); bf16* WqT = (bf16*)(ws + WS_WQ); float* bias = (float*)(ws + WS_BIAS);
            const float* w_in = INF(I_WIN) + (size_t)l * DM * IN_COLS; const float* w_branch = INF(I_WBR) + (size_t)l * 3 * 1024 * DM; const float* w_out = INF(I_WOUT) + (size_t)l * DM * DM; const float* peer_wq = INF(I_WQ) + (size_t)l * DM * DM;
            const float* merge_gate_b = INF(I_MERGEB) + (size_t)l * 3 * DM;
            LAS float* scr = (LAS float*)(lds + wave * 16384);
            constexpr int I_IN = (DM / 64) * (NP / 32), I_B = (1024 / 64) * (DM / 32), I_O = (DM / 64) * (DM / 32);
            constexpr int NITEMS = I_IN + 3 * I_B + 2 * I_O;
            for (int it = gw; it < NITEMS; it += NGW) {
                int r = it;
                if (r < I_IN) { transpose_item<1>(w_in, DM, IN_COLS, NP, WinT, scr, r, lane); continue; } r -= I_IN;
                if (r < 3 * I_B) { const int k = r / I_B; transpose_item<0>(w_branch + (size_t)k * 1024 * DM, 1024, DM, DM, WbT + (size_t)k * DM * 1024, scr, r - k * I_B, lane); continue; } r -= 3 * I_B;
                if (r < I_O) { transpose_item<0>(w_out, DM, DM, DM, WoT, scr, r, lane); continue; } r -= I_O;
                transpose_item<0>(peer_wq, DM, DM, DM, WqT, scr, r, lane);
            }
            for (size_t n = gt; n < NP; n += NGT) bias[n] = (n >= C_G && n < C_SMALL) ? merge_gate_b[n - C_G] : 0.f;
            { const float4* sk = (const float4*)(INF(I_SUBK) + (size_t)l * 8 * 2 * 128 * 128); uint2* skb = (uint2*)(ws + WS_SKB);
              for (size_t n = gt; n < 8 * 2 * 128 * 128 / 4; n += NGT) { const float4 v = sk[n]; skb[n] = make_uint2(pk2(v.x, v.y), pk2(v.z, v.w)); } }
        }
        GRID_BAR();
        { PHASE_IDS unsigned char* ws = WSP; pg8::Gemm g{(const bf16*)(ws + WS_XB), (const bf16*)(ws + WS_WIN), T_TOK, NP, DM}; pg8::StaticOrder S; S.init(T_TOK, NP, G, bx);
          pg8::EpiProj E{(bf16*)(ws + WS_PROJ), (const float*)(ws + WS_BIAS), (float*)(ws + WS_SMALL), NP, GATE_TILE_LO, SMALL_TILE, 0};
          pg8::gemm_phase<pg8::EpiProj, pg8::StaticOrder, true, true>(lds, g, S, E, tid); }
        GRID_BAR();
        { PHASE_IDS unsigned char* ws = WSP; const bf16* proj = (const bf16*)(ws + WS_PROJ); bf16* xcb = (bf16*)(ws + WS_R2);
          const float* cw = INF(I_CONVW) + (size_t)l * 4 * 1536; const float* cb = INF(I_CONVB) + l * 1536;
          for (int i = (int)gt; i < 192 * (T_TOK / 4); i += (int)NGT) ssd_conv_item(i, proj, cw, cb, xcb); }
        { PHASE_IDS unsigned char* ws = WSP; const float* small = (const float*)(ws + WS_SMALL); LAS float* wl = (LAS float*)(lds + wave * 1024);
          for (int i = gw; i < NBATCH * 4 * 64; i += NGW) mlstm_gate_item(i, lane, wl, small, INF(I_MGATEB) + l * 8, (float4*)(ws + WS_MG), (float*)(ws + WS_MEG));
          for (int i = gw; i < NBATCH * 16 * 32; i += NGW) ssd_gate_item(i, lane, wl, small, INF(I_DTB) + l * 16, INF(I_ALOG) + l * 16, (float4*)(ws + WS_SG), (float*)(ws + WS_SEA)); }
        GRID_BAR();
        { PHASE_IDS unsigned char* ws = WSP; mlstm_phase(lds, (const bf16*)(ws + WS_PROJ), (const float4*)(ws + WS_MG), (const float*)(ws + WS_MEG), (float*)(ws + WS_HM), tid, bx, G); }
        { PHASE_IDS unsigned char* ws = WSP; ssd_phase(lds, (const bf16*)(ws + WS_R2), (const float4*)(ws + WS_SG), (const float*)(ws + WS_SEA), INF(I_SSMD) + l * 16, (float*)(ws + WS_R1), tid, bx, G); }
        { PHASE_IDS unsigned char* ws = WSP; swa_phase(lds, (const bf16*)(ws + WS_PROJ), (const float*)(ws + WS_ROPE), INF(I_SINKS) + l * 16, (bf16*)(ws + WS_Y + 128 * MiB), tid, bx, G); }
        GRID_BAR();
        { PHASE_IDS unsigned char* ws = WSP; const bf16* proj = (const bf16*)(ws + WS_PROJ); const float* hm = (const float*)(ws + WS_HM); bf16* ym = (bf16*)(ws + WS_Y); const float* nw = INF(I_MNORMW) + l * 1024;
          for (int t = gw; t < T_TOK; t += NGW) mlstm_post_tok(t, lane, hm, proj, nw, ym); }
        { PHASE_IDS unsigned char* ws = WSP; const bf16* proj = (const bf16*)(ws + WS_PROJ); const float* yraw = (const float*)(ws + WS_R1); bf16* ys = (bf16*)(ws + WS_Y + 64 * MiB); const float* nw = INF(I_SNORMW) + l * 1024;
          for (int tp = gw; tp < T_TOK / 2; tp += NGW) ssd_post_tok2(tp, lane, yraw, proj, nw, ys); }
        GRID_BAR();
        { PHASE_IDS unsigned char* ws = WSP; pg8::Gemm g{(const bf16*)(ws + WS_Y), (const bf16*)(ws + WS_WB), T_TOK, DM, 1024}; pg8::StaticOrder S; S.init(T_TOK, DM, G, bx);
          pg8::EpiMix<1> E{(bf16*)(ws + WS_R1), (const bf16*)(ws + WS_PROJ) + C_G, DM, NP};
          pg8::gemm_phase<pg8::EpiMix<1>, pg8::StaticOrder, true, true>(lds, g, S, E, tid); }
        __syncthreads();
        { PHASE_IDS unsigned char* ws = WSP; pg8::Gemm g{(const bf16*)(ws + WS_Y + 64 * MiB), (const bf16*)(ws + WS_WB) + (size_t)DM * 1024, T_TOK, DM, 1024}; pg8::StaticOrder S; S.init(T_TOK, DM, G, bx);
          pg8::EpiMix<0> E{(bf16*)(ws + WS_R1), (const bf16*)(ws + WS_PROJ) + C_G + DM, DM, NP};
          pg8::gemm_phase<pg8::EpiMix<0>, pg8::StaticOrder, true, true>(lds, g, S, E, tid); }
        __syncthreads();
        { PHASE_IDS unsigned char* ws = WSP; pg8::Gemm g{(const bf16*)(ws + WS_Y + 128 * MiB), (const bf16*)(ws + WS_WB) + (size_t)2 * DM * 1024, T_TOK, DM, 1024}; pg8::StaticOrder S; S.init(T_TOK, DM, G, bx);
          pg8::EpiMix<0> E{(bf16*)(ws + WS_R1), (const bf16*)(ws + WS_PROJ) + C_G + 2 * DM, DM, NP};
          pg8::gemm_phase<pg8::EpiMix<0>, pg8::StaticOrder, true, true>(lds, g, S, E, tid); }
        GRID_BAR();
        { PHASE_IDS unsigned char* ws = WSP; const float* xin = l == 0 ? INF(I_X) : (const float*)OUTP;
          pg8::Gemm g{(const bf16*)(ws + WS_R1), (const bf16*)(ws + WS_WO), T_TOK, DM, DM}; pg8::StaticOrder S; S.init(T_TOK, DM, G, bx); pg8::EpiResid E{(float*)(ws + WS_BUFB), xin, DM, ALPHA};
          pg8::gemm_phase<pg8::EpiResid, pg8::StaticOrder, true, true>(lds, g, S, E, tid); }
        GRID_BAR();
        { PHASE_IDS unsigned char* ws = WSP; float* bufB = (float*)(ws + WS_BUFB); bf16* xb = (bf16*)(ws + WS_XB); const float* g1 = INF(I_LN1G) + l * DM; const float* b1 = INF(I_LN1B) + l * DM;
          for (int tp = gw; tp < T_TOK / 2; tp += NGW) ln_body2(tp, lane, bufB, g1, b1, bufB, xb); }
        { PHASE_IDS unsigned char* ws = WSP; constexpr size_t NGRP = (size_t)P_EXPERTS * DM / 32;
          const float* pu = INF(I_PU) + (size_t)l * P_EXPERTS * DM; const float* pv = INF(I_PV) + (size_t)l * P_EXPERTS * DM; unsigned char* U6 = ws + WS_R2; unsigned char* V6 = ws + WS_R2 + 32 * MiB;
          for (size_t i = gt; i < NGRP; i += NGT) { tab_to_fp6(i, pu, U6, U6_SCALE); tab_to_fp6(i, pv, V6, V6_SCALE); } }
        GRID_BAR();
        { PHASE_IDS unsigned char* ws = WSP; pg8::Gemm g{(const bf16*)(ws + WS_XB), (const bf16*)(ws + WS_WQ), T_TOK, DM, DM}; pg8::StaticOrder S; S.init(T_TOK, DM, G, bx);
          pg8::EpiProj E{(bf16*)(ws + WS_QF), nullptr, nullptr, DM, 1 << 20, -1, 0};
          pg8::gemm_phase<pg8::EpiProj, pg8::StaticOrder, true, true>(lds, g, S, E, tid); }
        GRID_BAR();
        { PHASE_IDS unsigned char* ws = WSP; peer_select_phase(lds, (const bf16*)(ws + WS_QF), (const bf16*)(ws + WS_SKB), (int*)(ws + WS_IDS), (float*)(ws + WS_GATES), tid, bx, G); }
        GRID_BAR();
        { PHASE_IDS unsigned char* ws = WSP; const float* bufB = (const float*)(ws + WS_BUFB); const int* ids = (const int*)(ws + WS_IDS); const float* gates = (const float*)(ws + WS_GATES);
          const unsigned char* U8 = ws + WS_R2; const unsigned char* V8 = ws + WS_R2 + 32 * MiB;     const float* g2 = INF(I_LN2G) + l * DM; const float* b2 = INF(I_LN2B) + l * DM; float* out = OUTP; bf16* xb = (bf16*)(ws + WS_XB);
          LAS unsigned* wl = (LAS unsigned*)(lds + wave * 2048);
          for (int t = gw; t < T_TOK; t += NGW) peer_expert_body(t, lane, bufB, ids, gates, U8, V8, g2, b2, out, xb, wl); }
        GRID_BAR();
    }
#undef GRID_BAR
}

extern "C" void kernel_launch(void* const* d_in, const int* in_sizes, int n_in, void* d_out, int out_size, void* d_ws, size_t ws_size, hipStream_t stream) {
    static int grid = 0;
    if (grid == 0) {
        if (n_in != 22 || out_size != T_TOK * DM || ws_size < WS_END) { fprintf(stderr, "kernel_launch: unexpected shapes (n_in %d, out %d, ws %zu)\n", n_in, out_size, ws_size); grid = -1; return; }
        int dev = 0, cus = 0, per_cu = 0;
        if (hipGetDevice(&dev) != hipSuccess || hipDeviceGetAttribute(&cus, hipDeviceAttributeMultiprocessorCount, dev) != hipSuccess) { grid = -1; return; }
        if (hipFuncSetAttribute((const void*)mega_fwd, hipFuncAttributeMaxDynamicSharedMemorySize, LDS_BYTES) != hipSuccess) { fprintf(stderr, "kernel_launch: hipFuncSetAttribute failed\n"); grid = -1; return; }
        if (hipOccupancyMaxActiveBlocksPerMultiprocessor(&per_cu, (const void*)mega_fwd, 512, LDS_BYTES) != hipSuccess || per_cu < 1) { fprintf(stderr, "kernel_launch: occupancy query says %d blocks per CU\n", per_cu); (void)hipGetLastError(); grid = -1; return; }
        grid = cus;
    }
    if (grid < 0) return;
    (void)hipMemsetAsync((char*)d_ws + WS_CTL, 0, CTL_ZERO_BYTES, stream);
    MegaArgs a; memset(&a, 0, sizeof(a));
    for (int i = 0; i < 22; ++i) a.in[i] = (const float*)d_in[i];
    a.out = (float*)d_out; a.ws = (unsigned char*)d_ws;
    hipLaunchKernelGGL(mega_fwd, dim3(grid), dim3(512), LDS_BYTES, stream, a);
}
```

```cpp
#include <hip/hip_runtime.h>
#include <cstdio>
#include <cstdint>
#include <cstring>

namespace pg8 {
#define PG8_LAS __attribute__((address_space(3)))
typedef unsigned short bf16_t;
typedef short bf16x8 __attribute__((ext_vector_type(8)));
typedef float f32x4 __attribute__((ext_vector_type(4)));
typedef unsigned u32x4 __attribute__((ext_vector_type(4)));
typedef unsigned u32x2 __attribute__((ext_vector_type(2)));
constexpr int BM = 256, BK = 64, HALF = 128, HTB = HALF * BK * 2  , STAGE_BYTES = 8 * HTB, NXCD = 8, WGM = 8;

__host__ __device__ __forceinline__ int lds_byte(int r, int c) { const int st = (r >> 4) * 2 + (c >> 5), rr = r & 15, cc = c & 31, ob = rr * 64 + cc * 2; return st * 1024 + (ob ^ (((ob >> 9) & 1) << 5)); }
__host__ __device__ __forceinline__ void stage_rc(int b, int& R, int& C) { const int st = b / 1024, sb = b % 1024, swz = sb ^ (((sb >> 9) & 1) << 5); R = (st >> 1) * 16 + swz / 64; C = (st & 1) * 32 + (swz % 64) / 2; }
__host__ __device__ __forceinline__ int perm32(int rho) { const int n = rho >> 4, i = rho & 15; return 8 * (i >> 2) + 4 * n + (i & 3); }

struct Unit { int pm, pn; };
struct Gemm { const bf16_t* A; const bf16_t* Bt; int M, N, K; };

typedef int i32x4 __attribute__((ext_vector_type(4)));
typedef int i32x8 __attribute__((ext_vector_type(8)));
struct StaticOrder {
    int nM, nN, nwg, G, c, rfrom, rto, rfrom2, rto2, i0, i1, wgm;
    __host__ __device__ void init(int M, int N, int G_, int c_) { nM = M / BM; nN = N / BM; nwg = nM * nN; G = G_; c = c_; rfrom = -1; rto = -1; rfrom2 = -1; rto2 = -1; i0 = 0; i1 = 1 << 30; wgm = WGM; }
    __host__ __device__ bool next(int i, Unit& u) const {
        if (i + i0 >= i1) return false;
        const long L = (long)(i + i0) * G + c; if (L >= nwg) return false;
        int wgid = (int)L; { const int q = nwg / NXCD, r = nwg % NXCD, xcd = wgid % NXCD, off = wgid / NXCD; wgid = (xcd < r ? xcd * (q + 1) : r * (q + 1) + (xcd - r) * q) + off; }
        const int nig = wgm * nN, gid = wgid / nig, fm = gid * wgm, gsz = (nM - fm) < wgm ? (nM - fm) : wgm;
        u.pm = fm + ((wgid % nig) % gsz); u.pn = (wgid % nig) / gsz; if (u.pn == rfrom) u.pn = rto; else if (u.pn == rfrom2) u.pn = rto2; return true;
    }
    __device__ __forceinline__ void a_ready(const Unit&) const {}
    __device__ __forceinline__ void done(const Unit&) const {}
};

typedef float cvt2f_t __attribute__((ext_vector_type(2)));
typedef __bf16 cvt2b_t __attribute__((ext_vector_type(2)));
__device__ __forceinline__ unsigned cvt_pk_bf16(float lo, float hi) { const cvt2f_t f = {lo, hi}; return __builtin_bit_cast(unsigned, __builtin_convertvector(f, cvt2b_t)); }
typedef float f32x2 __attribute__((ext_vector_type(2)));
__device__ __forceinline__ float bf_lo(unsigned w) { return __uint_as_float(w << 16); }
__device__ __forceinline__ float bf_hi(unsigned w) { return __uint_as_float(w & 0xffff0000u); }
__device__ __forceinline__ unsigned cvt_pk4_fp8(float a, float b, float c, float d) { int p = __builtin_amdgcn_cvt_pk_fp8_f32(a, b, 0, false); p = __builtin_amdgcn_cvt_pk_fp8_f32(c, d, p, true); return (unsigned)p; }
__device__ __forceinline__ float sigmoidf_(float x) { return __builtin_amdgcn_rcpf(1.0f + __expf(-x)); }

struct EpiF32 {
    static constexpr bool PERM = false, AFTER_DRAIN = false;
    float* C; int ldc; int pad;
    __device__ __forceinline__ void operator()(const f32x4 (&acc)[2][2][4][2], const Unit& u, int wr, int wc, int fr, int fq) const {
        const int row0 = u.pm * BM + wr * 64 + fr, col0 = u.pn * BM + wc * 32 + 4 * fq;
#pragma unroll
        for (int ai = 0; ai < 2; ++ai)
#pragma unroll
            for (int m = 0; m < 4; ++m) { float* rowp = C + (size_t)(row0 + ai * HALF + m * 16) * ldc + col0;
#pragma unroll
                for (int bj = 0; bj < 2; ++bj)
#pragma unroll
                    for (int n = 0; n < 2; ++n) *(f32x4*)(rowp + bj * HALF + n * 16) = acc[ai][bj][m][n]; }
    }
};
struct EpiResid {
    static constexpr bool PERM = false, AFTER_DRAIN = false;
    float* C; const float* X; int ldc; float alpha;
    __device__ __forceinline__ void operator()(const f32x4 (&acc)[2][2][4][2], const Unit& u, int wr, int wc, int fr, int fq) const {
        const int row0 = u.pm * BM + wr * 64 + fr, col0 = u.pn * BM + wc * 32 + 4 * fq;
#pragma unroll
        for (int ai = 0; ai < 2; ++ai)
#pragma unroll
            for (int m = 0; m < 4; ++m) { const size_t off = (size_t)(row0 + ai * HALF + m * 16) * ldc + col0;
#pragma unroll
                for (int bj = 0; bj < 2; ++bj)
#pragma unroll
                    for (int n = 0; n < 2; ++n) { const f32x4 xv = *(const f32x4*)(X + off + bj * HALF + n * 16);
                        *(f32x4*)(C + off + bj * HALF + n * 16) = acc[ai][bj][m][n] + xv * alpha; } }
    }
};
template <int ASH = 0> struct EpiResidB {
    static constexpr bool PERM = true, AFTER_DRAIN = false;
    static constexpr float ascale = 1.0f / (float)(1 << ASH);
    bf16_t* O; int ldc; float alpha; int pad;
    __device__ __forceinline__ void operator()(const f32x4 (&acc)[2][2][4][2], const Unit& u, int wr, int wc, int fr, int fq) const {
        const int row0 = u.pm * BM + wr * 64 + fr, col0 = u.pn * BM + wc * 32 + 8 * fq;
#pragma unroll
        for (int ai = 0; ai < 2; ++ai) {
            u32x4 ow[4][2];
#pragma unroll
            for (int m = 0; m < 4; ++m)
#pragma unroll
                for (int bj = 0; bj < 2; ++bj) ow[m][bj] = *(const u32x4*)(O + (size_t)(row0 + ai * HALF + m * 16) * ldc + col0 + bj * HALF);
#pragma unroll
            for (int m = 0; m < 4; ++m) { bf16_t* rowp = O + (size_t)(row0 + ai * HALF + m * 16) * ldc + col0;
#pragma unroll
                for (int bj = 0; bj < 2; ++bj) { const u32x4 o = ow[m][bj];
                    const f32x4 a0 = acc[ai][bj][m][0], a1 = acc[ai][bj][m][1];
                    const float r0 = bf_lo(o.x) * alpha + a0[0] * ascale, r1 = bf_hi(o.x) * alpha + a0[1] * ascale, r2 = bf_lo(o.y) * alpha + a0[2] * ascale, r3 = bf_hi(o.y) * alpha + a0[3] * ascale;
                    const float r4 = bf_lo(o.z) * alpha + a1[0] * ascale, r5 = bf_hi(o.z) * alpha + a1[1] * ascale, r6 = bf_lo(o.w) * alpha + a1[2] * ascale, r7 = bf_hi(o.w) * alpha + a1[3] * ascale;
                    u32x4 w; w.x = cvt_pk_bf16(r0, r1); w.y = cvt_pk_bf16(r2, r3); w.z = cvt_pk_bf16(r4, r5); w.w = cvt_pk_bf16(r6, r7);
                    *(u32x4*)(rowp + bj * HALF) = w; } }
        }
    }
};
struct EpiProj {
    static constexpr bool PERM = true, AFTER_DRAIN = false;
    bf16_t* O; const float* bias; float* small; int ldc; int gate_lo; int small_tile; int pn_off; float ascale;
    __device__ __forceinline__ void operator()(const f32x4 (&acc)[2][2][4][2], const Unit& u, int wr, int wc, int fr, int fq) const {
        const int pn = u.pn + pn_off; const int row0 = u.pm * BM + wr * 64 + fr, col0 = pn * BM + wc * 32 + 8 * fq;
        if (pn == small_tile) {
            if (wc == 0) {
#pragma unroll
                for (int ai = 0; ai < 2; ++ai)
#pragma unroll
                    for (int m = 0; m < 4; ++m) { float* p = small + (size_t)(row0 + ai * HALF + m * 16) * 32 + 8 * fq;
                        *(f32x4*)p = acc[ai][0][m][0]; *(f32x4*)(p + 4) = acc[ai][0][m][1]; }
            }
            return;
        }
        const bool gate = pn >= gate_lo;
        f32x4 bv[2][2];
#pragma unroll
        for (int bj = 0; bj < 2; ++bj)
#pragma unroll
            for (int n = 0; n < 2; ++n) bv[bj][n] = gate ? *(const f32x4*)(bias + col0 + bj * HALF + 4 * n) : (f32x4){0.f, 0.f, 0.f, 0.f};
#pragma unroll
        for (int ai = 0; ai < 2; ++ai)
#pragma unroll
            for (int m = 0; m < 4; ++m) { bf16_t* rowp = O + (size_t)(row0 + ai * HALF + m * 16) * ldc + col0;
#pragma unroll
                for (int bj = 0; bj < 2; ++bj) { f32x4 v0 = acc[ai][bj][m][0] * ascale + bv[bj][0], v1 = acc[ai][bj][m][1] * ascale + bv[bj][1];
                    if (gate) {
#pragma unroll
                        for (int j = 0; j < 4; ++j) { v0[j] = sigmoidf_(v0[j]); v1[j] = sigmoidf_(v1[j]); } }
                    u32x4 w; w.x = cvt_pk_bf16(v0[0], v0[1]); w.y = cvt_pk_bf16(v0[2], v0[3]); w.z = cvt_pk_bf16(v1[0], v1[1]); w.w = cvt_pk_bf16(v1[2], v1[3]);
                    *(u32x4*)(rowp + bj * HALF) = w; } }
    }
};
template <int FIRST, int LASTQ = 0, int ASH = 0, int QSH = 0> struct EpiMix {
    static constexpr bool PERM = true, AFTER_DRAIN = false;
    static constexpr float ascale = 1.0f / (float)(1 << ASH), qscale = (float)(1 << QSH);
    bf16_t* O; const bf16_t* G; int ldc; int ldg; unsigned char* Q;
    __device__ __forceinline__ void operator()(const f32x4 (&acc)[2][2][4][2], const Unit& u, int wr, int wc, int fr, int fq) const {
        const int row0 = u.pm * BM + wr * 64 + fr, col0 = u.pn * BM + wc * 32 + 8 * fq;
#pragma unroll
        for (int ai = 0; ai < 2; ++ai) {
            u32x4 gwv[4][2], owv[4][2];
#pragma unroll
            for (int m = 0; m < 4; ++m)
#pragma unroll
                for (int bj = 0; bj < 2; ++bj) { const int row = row0 + ai * HALF + m * 16;
                    gwv[m][bj] = *(const u32x4*)(G + (size_t)row * ldg + col0 + bj * HALF);
                    owv[m][bj] = (u32x4){0u, 0u, 0u, 0u}; if (!FIRST) owv[m][bj] = *(const u32x4*)(O + (size_t)row * ldc + col0 + bj * HALF); }
#pragma unroll
            for (int m = 0; m < 4; ++m) { const int row = row0 + ai * HALF + m * 16; bf16_t* rowp = O + (size_t)row * ldc + col0;
#pragma unroll
                for (int bj = 0; bj < 2; ++bj) { const u32x4 gw = gwv[m][bj], ow = owv[m][bj];
                    const f32x4 a0 = acc[ai][bj][m][0] * ascale, a1 = acc[ai][bj][m][1] * ascale;
                    float r0 = bf_lo(ow.x) + bf_lo(gw.x) * a0[0], r1 = bf_hi(ow.x) + bf_hi(gw.x) * a0[1], r2 = bf_lo(ow.y) + bf_lo(gw.y) * a0[2], r3 = bf_hi(ow.y) + bf_hi(gw.y) * a0[3];
                    float r4 = bf_lo(ow.z) + bf_lo(gw.z) * a1[0], r5 = bf_hi(ow.z) + bf_hi(gw.z) * a1[1], r6 = bf_lo(ow.w) + bf_lo(gw.w) * a1[2], r7 = bf_hi(ow.w) + bf_hi(gw.w) * a1[3];
                    if constexpr (LASTQ) { *(u32x2*)(Q + (size_t)row * ldc + col0 + bj * HALF) = (u32x2){cvt_pk4_fp8(r0 * qscale, r1 * qscale, r2 * qscale, r3 * qscale), cvt_pk4_fp8(r4 * qscale, r5 * qscale, r6 * qscale, r7 * qscale)}; }
                    else { u32x4 w; w.x = cvt_pk_bf16(r0, r1); w.y = cvt_pk_bf16(r2, r3); w.z = cvt_pk_bf16(r4, r5); w.w = cvt_pk_bf16(r6, r7);
                        *(u32x4*)(rowp + bj * HALF) = w; } } }
        }
    }
};
template <class Epi, class Sched, bool ALIGN_EPI = false, bool SP2 = false, bool FP8 = false>
__device__ __forceinline__ void gemm_phase(PG8_LAS unsigned char* lds, const Gemm g, const Sched& S, const Epi& E, int tid_) {
    asm volatile("" : "+v"(tid_));
    const int tid = tid_, wid = __builtin_amdgcn_readfirstlane(tid >> 6), lane = tid & 63, wr = wid >> 2, wc = wid & 3, fr = lane & 15, fq = lane >> 4;
    const int K = g.K, nt = K / BK;
    unsigned voffA[2], voffB[2];
#pragma unroll
    for (int i = 0; i < 2; ++i) { int R, C; stage_rc(tid * 16 + i * 8192, R, C); const int Rb = Epi::PERM ? ((R & ~31) + perm32(R & 31)) : R;
        voffA[i] = (unsigned)(R * K + C) * 2u; voffB[i] = (unsigned)(Rb * K + C) * 2u; }
    const size_t kstep = (size_t)(BK * 2);
    const size_t hstep = (size_t)HALF * K * 2;
    const size_t tstep = 2 * hstep;
    const unsigned ldsw = (unsigned)wid * 1024u;
    const int aoff = lds_byte(wr * 64 + fr, fq * 8), boff = lds_byte(wc * 32 + fr, fq * 8);
#define PG8_SA(b, h) (((b) * 2 + (h)) * HTB)
#define PG8_SB(b, h) ((4 + (b) * 2 + (h)) * HTB)
#define PG8_STAGE(bufoff, gbase, voff) do { _Pragma("unroll") for (int _i = 0; _i < 2; ++_i) \
        __builtin_amdgcn_global_load_lds((const unsigned*)((const char*)(gbase) + (voff)[_i]), (PG8_LAS unsigned*)(lds + (bufoff) + ldsw + _i * 8192), 16, 0, 0); } while (0)
#define PG8_LDA(dst, b, h) do { _Pragma("unroll") for (int m = 0; m < 4; ++m) _Pragma("unroll") for (int k = 0; k < 2; ++k) dst[m][k] = *(const PG8_LAS bf16x8*)(lds + PG8_SA(b, h) + aoff + m * 2048 + k * 1024); } while (0)
#define PG8_LDB(dst, b, h) do { _Pragma("unroll") for (int n = 0; n < 2; ++n) _Pragma("unroll") for (int k = 0; k < 2; ++k) dst[n][k] = *(const PG8_LAS bf16x8*)(lds + PG8_SB(b, h) + boff + n * 2048 + k * 1024); } while (0)
#define PG8_CAT(lo, hi) ((i32x8){__builtin_bit_cast(i32x4, lo)[0], __builtin_bit_cast(i32x4, lo)[1], __builtin_bit_cast(i32x4, lo)[2], __builtin_bit_cast(i32x4, lo)[3], __builtin_bit_cast(i32x4, hi)[0], __builtin_bit_cast(i32x4, hi)[1], __builtin_bit_cast(i32x4, hi)[2], __builtin_bit_cast(i32x4, hi)[3]})
#define PG8_MMA(ai, bj, At, Bt) do { __builtin_amdgcn_s_setprio(1); _Pragma("unroll") for (int m = 0; m < 4; ++m) _Pragma("unroll") for (int n = 0; n < 2; ++n) { \
        if constexpr (FP8) { asm volatile("v_mfma_scale_f32_16x16x128_f8f6f4 %0, %1, %2, %0, %3, %3 op_sel_hi:[0,0,0]" : "+v"(acc[ai][bj][m][n]) : "v"(PG8_CAT(Bt[n][0], Bt[n][1])), "v"(PG8_CAT(At[m][0], At[m][1])), "v"(fp8_unit_scale)); } \
        else { _Pragma("unroll") for (int k = 0; k < 2; ++k) acc[ai][bj][m][n] = __builtin_amdgcn_mfma_f32_16x16x32_bf16(Bt[n][k], At[m][k], acc[ai][bj][m][n], 0, 0, 0); } } \
        __builtin_amdgcn_s_setprio(0); } while (0)
#define PG8_WAIT_V(n) asm volatile("s_waitcnt vmcnt(" #n ")" ::: "memory")
#define PG8_WAIT_L(n) asm volatile("s_waitcnt lgkmcnt(" #n ")" ::: "memory")
#define PG8_BAR __builtin_amdgcn_s_barrier()
#define PG8_SCHED __builtin_amdgcn_sched_barrier(0)
    Unit cur, nxt; int ui = 0;
    [[maybe_unused]] int fp8_unit_scale = 0x7F7F7F7F;
    if constexpr (FP8) asm volatile("" : "+v"(fp8_unit_scale));
    if (!S.next(0, cur)) return;
    f32x4 acc[2][2][4][2];
#pragma unroll
    for (int a = 0; a < 2; ++a)
#pragma unroll
        for (int b = 0; b < 2; ++b)
#pragma unroll
            for (int m = 0; m < 4; ++m)
#pragma unroll
                for (int n = 0; n < 2; ++n) acc[a][b][m][n] = (f32x4){0.f, 0.f, 0.f, 0.f};
    bf16x8 At[4][2], B0[2][2], B1[2][2];
    const char* cA = (const char*)g.A + (size_t)cur.pm * tstep; const char* cB = (const char*)g.Bt + (size_t)cur.pn * tstep;
    S.a_ready(cur);
    if constexpr (SP2) {
        PG8_STAGE(PG8_SB(0, 0), cB, voffB); PG8_STAGE(PG8_SB(0, 1), cB + hstep, voffB); PG8_STAGE(PG8_SA(0, 0), cA, voffA); PG8_STAGE(PG8_SA(0, 1), cA + hstep, voffA);
        if (wr == 1) PG8_BAR;
        PG8_WAIT_V(2); PG8_BAR;
        PG8_STAGE(PG8_SB(1, 0), cB + kstep, voffB); PG8_STAGE(PG8_SA(1, 0), cA + kstep, voffA); PG8_STAGE(PG8_SB(1, 1), cB + hstep + kstep, voffB);
        PG8_WAIT_V(6); PG8_BAR;
    } else {
        PG8_STAGE(PG8_SB(0, 0), cB, voffB); PG8_STAGE(PG8_SA(0, 0), cA, voffA); PG8_STAGE(PG8_SB(0, 1), cB + hstep, voffB); PG8_STAGE(PG8_SA(0, 1), cA + hstep, voffA);
        if (wr == 1) PG8_BAR;
        PG8_WAIT_V(4); PG8_BAR;
        PG8_STAGE(PG8_SB(1, 0), cB + kstep, voffB); PG8_STAGE(PG8_SA(1, 0), cA + kstep, voffA); PG8_STAGE(PG8_SB(1, 1), cB + hstep + kstep, voffB);
        PG8_WAIT_V(6); PG8_BAR;
    }
    for (;;) {
        const bool has_next = S.next(ui + 1, nxt);
        const char* nA = has_next ? (const char*)g.A + (size_t)nxt.pm * tstep : cA; const char* nB = has_next ? (const char*)g.Bt + (size_t)nxt.pn * tstep : cB;
        for (int t = 0; t < nt; t += 2) {
            const bool last = (t == nt - 2);
            const char* a1 = cA + (size_t)(t + 1) * kstep;
            const char* a2 = last ? nA : cA + (size_t)(t + 2) * kstep; const char* b2 = last ? nB : cB + (size_t)(t + 2) * kstep;
            const char* a3 = a2 + kstep; const char* b3 = b2 + kstep;
            if (last && has_next) S.a_ready(nxt);
            if constexpr (SP2) {
            PG8_LDB(B0, 0, 0); PG8_LDB(B1, 0, 1); PG8_SCHED; PG8_LDA(At, 0, 0); PG8_STAGE(PG8_SA(1, 1), a1 + hstep, voffA);
            PG8_WAIT_V(8); PG8_WAIT_L(0); PG8_BAR; PG8_MMA(0, 0, At, B0); PG8_MMA(0, 1, At, B1); PG8_BAR; PG8_SCHED;
            PG8_LDA(At, 0, 1); PG8_STAGE(PG8_SB(0, 0), b2, voffB); PG8_STAGE(PG8_SB(0, 1), b2 + hstep, voffB); PG8_STAGE(PG8_SA(0, 0), a2, voffA);
            PG8_WAIT_V(8); PG8_WAIT_L(0); PG8_BAR; PG8_MMA(1, 0, At, B0); PG8_MMA(1, 1, At, B1); PG8_BAR; PG8_SCHED;
            PG8_LDB(B0, 1, 0); PG8_LDB(B1, 1, 1); PG8_SCHED; PG8_LDA(At, 1, 0); PG8_STAGE(PG8_SA(0, 1), a2 + hstep, voffA);
            PG8_WAIT_V(8); PG8_WAIT_L(0); PG8_BAR; PG8_MMA(0, 0, At, B0); PG8_MMA(0, 1, At, B1); PG8_BAR; PG8_SCHED;
            PG8_LDA(At, 1, 1); PG8_STAGE(PG8_SB(1, 0), b3, voffB); PG8_STAGE(PG8_SB(1, 1), b3 + hstep, voffB); PG8_STAGE(PG8_SA(1, 0), a3, voffA);
            PG8_WAIT_V(8); PG8_WAIT_L(0); PG8_BAR; PG8_MMA(1, 0, At, B0); PG8_MMA(1, 1, At, B1); PG8_BAR; PG8_SCHED;
            } else {
            PG8_LDB(B0, 0, 0); PG8_SCHED; PG8_LDA(At, 0, 0); PG8_STAGE(PG8_SA(1, 1), a1 + hstep, voffA);
            PG8_WAIT_L(8); PG8_BAR; PG8_WAIT_L(0); PG8_MMA(0, 0, At, B0); PG8_BAR; PG8_SCHED;
            PG8_LDB(B1, 0, 1); PG8_STAGE(PG8_SB(0, 0), b2, voffB);
            PG8_BAR; PG8_WAIT_L(0); PG8_MMA(0, 1, At, B1); PG8_BAR;
            PG8_LDA(At, 0, 1); PG8_STAGE(PG8_SA(0, 0), a2, voffA);
            PG8_BAR; PG8_WAIT_L(0); PG8_MMA(1, 0, At, B0); PG8_BAR; PG8_SCHED;
            PG8_STAGE(PG8_SB(0, 1), b2 + hstep, voffB);
            PG8_WAIT_V(6); PG8_BAR; PG8_MMA(1, 1, At, B1); PG8_BAR;
            PG8_LDB(B0, 1, 0); PG8_SCHED; PG8_LDA(At, 1, 0); PG8_STAGE(PG8_SA(0, 1), a2 + hstep, voffA);
            PG8_WAIT_L(8); PG8_BAR; PG8_WAIT_L(0); PG8_MMA(0, 0, At, B0); PG8_BAR; PG8_SCHED;
            PG8_LDB(B1, 1, 1); PG8_STAGE(PG8_SB(1, 0), b3, voffB);
            PG8_BAR; PG8_WAIT_L(0); PG8_MMA(0, 1, At, B1); PG8_BAR;
            PG8_LDA(At, 1, 1); PG8_STAGE(PG8_SA(1, 0), a3, voffA);
            PG8_BAR; PG8_WAIT_L(0); PG8_MMA(1, 0, At, B0); PG8_BAR; PG8_SCHED;
            PG8_STAGE(PG8_SB(1, 1), b3 + hstep, voffB);
            PG8_WAIT_V(6); PG8_BAR; PG8_MMA(1, 1, At, B1); PG8_BAR;
            }
        }
        if constexpr (FP8) asm volatile("s_nop 15\n\ts_nop 15\n\ts_nop 15" ::: "memory");
        if constexpr (ALIGN_EPI) { if (wr == 0) PG8_BAR; }
        if constexpr (!Epi::AFTER_DRAIN) { E(acc, cur, wr, wc, fr, fq); S.done(cur); }
        if (!has_next) break;
#pragma unroll
        for (int a = 0; a < 2; ++a)
#pragma unroll
            for (int b = 0; b < 2; ++b)
#pragma unroll
                for (int m = 0; m < 4; ++m)
#pragma unroll
                    for (int n = 0; n < 2; ++n) acc[a][b][m][n] = (f32x4){0.f, 0.f, 0.f, 0.f};
        cur = nxt; cA = nA; cB = nB; ++ui;
        if constexpr (ALIGN_EPI) { if (wr == 1) PG8_BAR; }
    }
    PG8_WAIT_V(0);
    if constexpr (!ALIGN_EPI) { if (wr == 0) PG8_BAR; }
    PG8_BAR;
    if constexpr (Epi::AFTER_DRAIN) { E.fused(acc, cur, wr, wc, fr, fq, lds, wid, lane); S.done(cur); }
#undef PG8_SA
#undef PG8_SB
#undef PG8_STAGE
#undef PG8_LDA
#undef PG8_LDB
#undef PG8_MMA
#undef PG8_CAT
#undef PG8_WAIT_V
#undef PG8_WAIT_L
#undef PG8_BAR
#undef PG8_SCHED
}
}
typedef unsigned short bf16;
#define LAS __attribute__((address_space(3)))
constexpr int T_TOK = 32768, DM = 2048, SEQ = 4096, NBATCH = 8, DEPTH = 4;
constexpr int IN_COLS = 13336, NP = 13568;
constexpr int C_MQ = 0, C_MK = 512, C_MV = 1024, C_MO = 2048, C_SZ = 3072, C_SXBC = 4096, C_AQ = 5632, C_AK = 6656, C_AV = 6912, C_G = 7168, C_SMALL = 13312;
constexpr int GATE_TILE_LO = C_G / 256, SMALL_TILE = C_SMALL / 256;
constexpr float ALPHA = 1.681792830507429f;
constexpr int P_EXPERTS = 16384;

constexpr size_t MiB = 1u << 20;
constexpr size_t WS_CTL = 0, CTL_ZERO_BYTES = 64 * 1024, WS_WIN = 1 * MiB, WS_WB = 54 * MiB, WS_WO = 66 * MiB, WS_WQ = 74 * MiB, WS_BIAS = 82 * MiB, WS_SKB = 82 * MiB + 256 * 1024, WS_SMALL = 83 * MiB, WS_ROPE = 87 * MiB,
                 WS_TAB = 1480 * MiB  , WS_XB = 88 * MiB, WS_XQ = 216 * MiB  , WS_WG8 = 280 * MiB  , WS_WB8 = 306 * MiB  , WS_YQ = 312 * MiB  , WS_R1Q = 408 * MiB  , WS_WO8 = 54 * MiB  , WS_PROJ = 472 * MiB, WS_R1 = 1320 * MiB, WS_Y = 1480 * MiB, WS_R2 = 1672 * MiB, WS_HM = 1864 * MiB, WS_END = 1992 * MiB;
constexpr size_t WS_QF = WS_PROJ, WS_IDS = WS_PROJ + 256 * MiB, WS_GATES = WS_PROJ + 272 * MiB;
constexpr int CW_BAR = 4096;
constexpr int RING_BYTES = 131072, PHASE_LDS_BYTES = 155648, MISC_OFF = PHASE_LDS_BYTES + 320, LDS_BYTES = 163840;

__device__ __forceinline__ unsigned f2bf(float f) { unsigned u = __float_as_uint(f); return (u + 0x7fffu + ((u >> 16) & 1u)) >> 16; }
typedef float f32x4e_t __attribute__((ext_vector_type(4)));
typedef float pk2f_t __attribute__((ext_vector_type(2)));
typedef __bf16 pk2b_t __attribute__((ext_vector_type(2)));
__device__ __forceinline__ unsigned pk2(float lo, float hi) { const pk2f_t f = {lo, hi}; return __builtin_bit_cast(unsigned, __builtin_convertvector(f, pk2b_t)); }
__device__ __forceinline__ unsigned pk4_fp8(float a, float b, float c, float d) { int p = __builtin_amdgcn_cvt_pk_fp8_f32(a, b, 0, false); p = __builtin_amdgcn_cvt_pk_fp8_f32(c, d, p, true); return (unsigned)p; }
constexpr float ACT8_SCALE = 4.0f;
static_assert(ACT8_SCALE == 4.0f, "epilogue shifts");
constexpr float WG8_SCALE = 64.0f;
__device__ __forceinline__ float bf2f(bf16 b) { return __uint_as_float(((unsigned)b) << 16); }
__device__ __forceinline__ float sigm(float x) { return __builtin_amdgcn_rcpf(1.0f + __expf(-x)); }
__device__ __forceinline__ void halves32(float& lo, float& hi) { asm volatile("s_nop 1\n\tv_permlane32_swap_b32 %0, %1" : "+v"(lo), "+v"(hi)); }
template <int CTRL> __device__ __forceinline__ float dpp_f(float v) { return __builtin_bit_cast(float, __builtin_amdgcn_update_dpp(0, __builtin_bit_cast(int, v), CTRL, 0xF, 0xF, true)); }
__device__ __forceinline__ float quad_sum(float v) { v += dpp_f<0xB1>(v); v += dpp_f<0x4E>(v); return v; }
__device__ __forceinline__ float wave_sum(float v) {
    v = quad_sum(v); v += dpp_f<0x141>(v); v += dpp_f<0x140>(v);
    v += __builtin_bit_cast(float, __builtin_amdgcn_ds_swizzle(__builtin_bit_cast(int, v), 0x401F));
    return __builtin_bit_cast(float, __builtin_amdgcn_readlane(__builtin_bit_cast(int, v), 0)) + __builtin_bit_cast(float, __builtin_amdgcn_readlane(__builtin_bit_cast(int, v), 32));
}
__device__ __forceinline__ int src_col(int n) {
    if (n < 3072) return n;
    if (n < 5632) return n + 8;
    if (n < 13312) return n + 24;
    if (n < 13320) return 3072 + (n - 13312);
    if (n < 13336) return 5640 + (n - 13320);
    return -1;
}

#define XB_TMO      128
#define XB_XCNT(j)  (256  + 64 * (j))
#define XB_XSUB(j)  (1280 + 64 * (j))
#define XB_XGEN(j)  (2304 + 64 * (j))
#define XB_TOP      3328
#define XB_TOPGEN   3392
#define XCD_BAR_WORDS 3456
#define XB_SPIN_CAP (1u << 18)

__device__ __forceinline__ unsigned xb_ld(unsigned* p)              { return __hip_atomic_load(p, __ATOMIC_RELAXED, __HIP_MEMORY_SCOPE_AGENT); }
__device__ __forceinline__ unsigned xb_add(unsigned* p, unsigned v) { return __hip_atomic_fetch_add(p, v, __ATOMIC_RELAXED, __HIP_MEMORY_SCOPE_AGENT); }
__device__ __forceinline__ unsigned xb_xcc_id() { return (unsigned)__builtin_amdgcn_s_getreg((3 << 11) | 20) & 0xFu; }
#define XB_SPIN(cond, bar) do { unsigned _sp = 0; while (cond) { __builtin_amdgcn_s_sleep(1); \
    if ((++_sp & 255u) == 0u) { if (xb_ld(&(bar)[XB_TMO])) break; if (_sp > XB_SPIN_CAP) { atomicAdd(&(bar)[XB_TMO], 1u); break; } } } } while (0)

struct XcdBarrier {
    unsigned* bar; unsigned x;
    volatile LAS unsigned* st;
};

__device__ __forceinline__ XcdBarrier xcd_barrier_post(unsigned* bar, volatile LAS unsigned* st) {
    XcdBarrier b; b.bar = bar; b.x = xb_xcc_id(); b.st = st;
    if (threadIdx.x == 0) (void)xb_add(&bar[XB_XCNT(b.x)], 1u);
    return b;
}
__device__ __forceinline__ void xcd_barrier_complete(unsigned* bar, unsigned x, unsigned& nloc, unsigned& nx) {
    const unsigned G = gridDim.x * gridDim.y * gridDim.z;
    unsigned sum, cnt, mine, sp = 0u;
    for (;;) {
        sum = 0u; cnt = 0u; mine = 0u;
#pragma unroll
        for (unsigned j = 0; j < 16; ++j) { const unsigned c = xb_ld(&bar[XB_XCNT(j)]); sum += c; cnt += (c > 0u) ? 1u : 0u; mine = (j == x) ? c : mine; }
        if (sum == G) break;
        __builtin_amdgcn_s_sleep(1);
        if ((++sp & 255u) == 0u) { if (xb_ld(&bar[XB_TMO])) break; if (sp > XB_SPIN_CAP) { atomicAdd(&bar[XB_TMO], 1u); break; } }
    }
    nloc = mine > 0u ? mine : 1u; nx = cnt > 0u ? cnt : 1u;
}

__device__ __forceinline__ void xcd_barrier(const XcdBarrier& b) {
    asm volatile("s_waitcnt vmcnt(0)" ::: "memory");
    __syncthreads();
    if (threadIdx.x == 0) {
        unsigned* bar = b.bar;
        __builtin_amdgcn_s_waitcnt(0);
        unsigned nloc = b.st[0], nx = b.st[1];
        if (nloc == 0u) { xcd_barrier_complete(bar, b.x, nloc, nx); b.st[0] = nloc; b.st[1] = nx; }
        const unsigned old = xb_add(&bar[XB_XSUB(b.x)], 1u);
        const unsigned gen = old / nloc;
        if (old + 1u == (gen + 1u) * nloc) {
            __builtin_amdgcn_fence(__ATOMIC_RELEASE, "agent");
            asm volatile("s_waitcnt vmcnt(0)" ::: "memory");
            const unsigned og = xb_add(&bar[XB_TOP], 1u);
            const unsigned tg = og / nx;
            if (og + 1u == (tg + 1u) * nx) xb_add(&bar[XB_TOPGEN], 1u);
            else XB_SPIN(xb_ld(&bar[XB_TOPGEN]) == tg, bar);
            __builtin_amdgcn_fence(__ATOMIC_ACQUIRE, "agent");
            xb_add(&bar[XB_XGEN(b.x)], 1u);
            asm volatile("s_waitcnt vmcnt(0)" ::: "memory");
        } else {
            XB_SPIN(xb_ld(&bar[XB_XGEN(b.x)]) == gen, bar);
            __builtin_amdgcn_fence(__ATOMIC_ACQUIRE, "agent");
            asm volatile("s_waitcnt vmcnt(0)" ::: "memory");
        }
    }
    __syncthreads();
}

__device__ __forceinline__ int fresh_tid(int wave0) { int l; asm volatile("v_mbcnt_lo_u32_b32 %0, -1, 0\n\tv_mbcnt_hi_u32_b32 %0, -1, %0" : "=v"(l)); return wave0 * 64 + l; }
#define PHASE_IDS int G = gridDim.x, bx = blockIdx.x; asm volatile("" : "+s"(G), "+s"(bx)); const int tid = fresh_tid(wave0), lane = tid & 63, wave = wave0; const int gw = bx * 8 + wave, NGW = G * 8; \
    const size_t gt = (size_t)bx * 512 + tid, NGT = (size_t)G * 512; (void)lane; (void)gw; (void)gt; (void)NGW; (void)NGT; (void)wave;

template <int MODE> __device__ __forceinline__ void transpose_item(const float* __restrict__ W, int K, int ldw, int ndst, bf16* __restrict__ WT, LAS float* scr, int item, int lane, unsigned char* __restrict__ W8 = nullptr) {
    const int nblk = ndst / 32, kb = item / nblk, nb = item % nblk, k0 = 64 * kb, n0 = 32 * nb;
    const int n_l = n0 + (lane & 31); const int sc = MODE ? src_col(n_l) : n_l;
    float tv[32];
#pragma unroll
    for (int i = 0; i < 32; ++i) { const int kk = 2 * i + (lane >> 5); tv[i] = sc >= 0 ? W[(size_t)(k0 + kk) * ldw + sc] : 0.f; }
#pragma unroll
    for (int i = 0; i < 32; ++i) { const int kk = 2 * i + (lane >> 5); scr[kk * 33 + (lane & 31)] = tv[i]; }
    asm volatile("s_waitcnt lgkmcnt(0)" ::: "memory");
    const int c = lane & 7;
#pragma unroll
    for (int j = 0; j < 4; ++j) { const int n = (lane >> 3) + 8 * j; const LAS float* s = scr + (8 * c) * 33 + n;
        if (MODE == 2 || (MODE == 1 && n0 < C_SMALL))
            *(uint2*)(W8 + (size_t)(n0 + n) * K + k0 + 8 * c) = make_uint2(pk4_fp8(s[0 * 33] * WG8_SCALE, s[1 * 33] * WG8_SCALE, s[2 * 33] * WG8_SCALE, s[3 * 33] * WG8_SCALE), pk4_fp8(s[4 * 33] * WG8_SCALE, s[5 * 33] * WG8_SCALE, s[6 * 33] * WG8_SCALE, s[7 * 33] * WG8_SCALE));
        if (MODE == 2 || (MODE == 1 && n0 < C_SMALL && !(n0 >= C_AV && n0 < C_AV + 256))) continue;
        uint4 o; o.x = pk2(s[0 * 33], s[1 * 33]); o.y = pk2(s[2 * 33], s[3 * 33]); o.z = pk2(s[4 * 33], s[5 * 33]); o.w = pk2(s[6 * 33], s[7 * 33]);
        *(uint4*)(WT + (size_t)(n0 + n) * K + k0 + 8 * c) = o; }
    asm volatile("s_waitcnt lgkmcnt(0)" ::: "memory");
}

__device__ __forceinline__ void mlstm_post_tok(int t, int lane, const bf16* __restrict__ hm, const bf16* __restrict__ proj, const LAS float* norm_w  , unsigned char* __restrict__ ym  ) {
    float4 x[4], nw[4]; uint2 ov[4];
#pragma unroll
    for (int h = 0; h < 4; ++h) { const int c = h * 256 + lane * 4; { const uint2 xr = *(const uint2*)(hm + (size_t)t * 1024 + c); x[h] = make_float4(__uint_as_float(xr.x << 16), __uint_as_float(xr.x & 0xffff0000u), __uint_as_float(xr.y << 16), __uint_as_float(xr.y & 0xffff0000u)); } { const f32x4e_t q_ = *(const LAS f32x4e_t*)(norm_w + c); nw[h] = make_float4(q_[0], q_[1], q_[2], q_[3]); } ov[h] = *(const uint2*)(proj + (size_t)t * NP + C_MO + c); }
#pragma unroll
    for (int h = 0; h < 4; ++h) {
        const float mu = wave_sum((x[h].x + x[h].y) + (x[h].z + x[h].w)) * (1.0f / 256.0f);
        const float d0 = x[h].x - mu, d1 = x[h].y - mu, d2 = x[h].z - mu, d3 = x[h].w - mu;
        const float rs = rsqrtf(wave_sum((d0 * d0 + d1 * d1) + (d2 * d2 + d3 * d3)) * (1.0f / 256.0f) + 1e-6f);
        const float y0 = d0 * rs * nw[h].x * sigm(__uint_as_float(ov[h].x << 16)), y1 = d1 * rs * nw[h].y * sigm(__uint_as_float(ov[h].x & 0xffff0000u));
        const float y2 = d2 * rs * nw[h].z * sigm(__uint_as_float(ov[h].y << 16)), y3 = d3 * rs * nw[h].w * sigm(__uint_as_float(ov[h].y & 0xffff0000u));
        *(unsigned*)(ym + (size_t)t * 1024 + h * 256 + lane * 4) = pk4_fp8(y0 * ACT8_SCALE, y1 * ACT8_SCALE, y2 * ACT8_SCALE, y3 * ACT8_SCALE);
    }
}

__device__ __forceinline__ void ssd_conv_item(int item, const bf16* __restrict__ proj, const LAS float* cw  , const LAS float* cb  , bf16* __restrict__ xcb) {
    const int c8 = item % 192, tb = item / 192, t0 = tb * 8, pos0 = t0 % SEQ, c = c8 * 8;
    uint4 r[11];
#pragma unroll
    for (int j = 0; j < 11; ++j) { r[j] = make_uint4(0u, 0u, 0u, 0u); if (j >= 3 || pos0 > 0) r[j] = *(const uint4*)(proj + (size_t)(t0 - 3 + j) * NP + C_SXBC + c); }
    float w[4][8], bs[8];
#pragma unroll
    for (int j = 0; j < 4; ++j) { const f32x4e_t a = *(const LAS f32x4e_t*)(cw + j * 1536 + c), b = *(const LAS f32x4e_t*)(cw + j * 1536 + c + 4); w[j][0] = a.x; w[j][1] = a.y; w[j][2] = a.z; w[j][3] = a.w; w[j][4] = b.x; w[j][5] = b.y; w[j][6] = b.z; w[j][7] = b.w; }
    { const f32x4e_t a = *(const LAS f32x4e_t*)(cb + c), b = *(const LAS f32x4e_t*)(cb + c + 4); bs[0] = a.x; bs[1] = a.y; bs[2] = a.z; bs[3] = a.w; bs[4] = b.x; bs[5] = b.y; bs[6] = b.z; bs[7] = b.w; }
#pragma unroll
    for (int o = 0; o < 8; ++o) {
        float acc[8];
#pragma unroll
        for (int i = 0; i < 8; ++i) acc[i] = bs[i];
#pragma unroll
        for (int j = 0; j < 4; ++j) { const unsigned rw[4] = {r[o + j].x, r[o + j].y, r[o + j].z, r[o + j].w};
#pragma unroll
            for (int i = 0; i < 4; ++i) { acc[2 * i] += w[j][2 * i] * __uint_as_float(rw[i] << 16); acc[2 * i + 1] += w[j][2 * i + 1] * __uint_as_float(rw[i] & 0xffff0000u); } }
        uint4 ov; ov.x = pk2(acc[0] * sigm(acc[0]), acc[1] * sigm(acc[1])); ov.y = pk2(acc[2] * sigm(acc[2]), acc[3] * sigm(acc[3])); ov.z = pk2(acc[4] * sigm(acc[4]), acc[5] * sigm(acc[5])); ov.w = pk2(acc[6] * sigm(acc[6]), acc[7] * sigm(acc[7]));
        *(uint4*)(xcb + (size_t)(t0 + o) * 1536 + c) = ov;
    }
}
__device__ __forceinline__ void ssd_post_tok2(int tp, int lane, const bf16* __restrict__ yraw, const bf16* __restrict__ proj, const LAS float* norm_w  , unsigned char* __restrict__ ys  ) {
    uint4 yr[4]; uint4 zv[4];
#pragma unroll
    for (int i = 0; i < 4; ++i) { const int t = 2 * tp + (i >> 1), c = (i & 1) * 512 + lane * 8; yr[i] = *(const uint4*)(yraw + (size_t)t * 1024 + c); zv[i] = *(const uint4*)(proj + (size_t)t * NP + C_SZ + c); }
#pragma unroll
    for (int i = 0; i < 4; ++i) { const int t = 2 * tp + (i >> 1), c = (i & 1) * 512 + lane * 8;
        const float yv[8] = {__uint_as_float(yr[i].x << 16), __uint_as_float(yr[i].x & 0xffff0000u), __uint_as_float(yr[i].y << 16), __uint_as_float(yr[i].y & 0xffff0000u), __uint_as_float(yr[i].z << 16), __uint_as_float(yr[i].z & 0xffff0000u), __uint_as_float(yr[i].w << 16), __uint_as_float(yr[i].w & 0xffff0000u)}; const unsigned zw[4] = {zv[i].x, zv[i].y, zv[i].z, zv[i].w};
        float y[8], ss = 0.f;
#pragma unroll
        for (int k = 0; k < 4; ++k) { const float z0 = __uint_as_float(zw[k] << 16), z1 = __uint_as_float(zw[k] & 0xffff0000u); y[2 * k] = yv[2 * k] * (z0 * sigm(z0)); y[2 * k + 1] = yv[2 * k + 1] * (z1 * sigm(z1)); ss += y[2 * k] * y[2 * k] + y[2 * k + 1] * y[2 * k + 1]; }
        const float rs = rsqrtf(wave_sum(ss) * (1.0f / 512.0f) + 1e-6f);
        const f32x4e_t n0q = *(const LAS f32x4e_t*)(norm_w + c), n1q = *(const LAS f32x4e_t*)(norm_w + c + 4); const float4 n0 = make_float4(n0q[0], n0q[1], n0q[2], n0q[3]), n1 = make_float4(n1q[0], n1q[1], n1q[2], n1q[3]);
        { const float r4 = rs * ACT8_SCALE; *(uint2*)(ys + (size_t)t * 1024 + c) = make_uint2(pk4_fp8(y[0] * r4 * n0.x, y[1] * r4 * n0.y, y[2] * r4 * n0.z, y[3] * r4 * n0.w), pk4_fp8(y[4] * r4 * n1.x, y[5] * r4 * n1.y, y[6] * r4 * n1.z, y[7] * r4 * n1.w)); }
    }
}

__device__ __forceinline__ void ln_body2(int tp, int lane, const float* in, const float* __restrict__ g, const float* __restrict__ bta, float* outf, bf16* __restrict__ outb) {
    float4 v[2][8];
#pragma unroll
    for (int r = 0; r < 2; ++r)
#pragma unroll
        for (int j = 0; j < 8; ++j) v[r][j] = *(const float4*)(in + (size_t)(2 * tp + r) * DM + j * 256 + lane * 4);
    { int z_ = 0; asm volatile("" : "+s"(z_)); g += z_; bta += z_; }
#pragma unroll
    for (int r = 0; r < 2; ++r) {
        const int t = 2 * tp + r; float s = 0.f;
#pragma unroll
        for (int j = 0; j < 8; ++j) s += (v[r][j].x + v[r][j].y) + (v[r][j].z + v[r][j].w);
        const float mu = wave_sum(s) * (1.0f / DM); float q = 0.f;
#pragma unroll
        for (int j = 0; j < 8; ++j) { v[r][j].x -= mu; v[r][j].y -= mu; v[r][j].z -= mu; v[r][j].w -= mu; q += (v[r][j].x * v[r][j].x + v[r][j].y * v[r][j].y) + (v[r][j].z * v[r][j].z + v[r][j].w * v[r][j].w); }
        const float rs = rsqrtf(wave_sum(q) * (1.0f / DM) + 1e-5f);
#pragma unroll
        for (int j = 0; j < 8; ++j) { const int c = j * 256 + lane * 4; const float4 gg = *(const float4*)(g + c), bb = *(const float4*)(bta + c);
            float4 y; y.x = v[r][j].x * rs * gg.x + bb.x; y.y = v[r][j].y * rs * gg.y + bb.y; y.z = v[r][j].z * rs * gg.z + bb.z; y.w = v[r][j].w * rs * gg.w + bb.w;
            *(float4*)(outf + (size_t)t * DM + c) = y; *(uint2*)(outb + (size_t)t * DM + c) = make_uint2(pk2(y.x, y.y), pk2(y.z, y.w)); }
    }
}

__device__ __forceinline__ void ln_body2b(int tp, int lane, bf16* xb, const LAS float* g  , const LAS float* bta  ) {
    uint4 v[2][4];
#pragma unroll
    for (int r = 0; r < 2; ++r)
#pragma unroll
        for (int j = 0; j < 4; ++j) v[r][j] = *(const uint4*)(xb + (size_t)(2 * tp + r) * DM + j * 512 + lane * 8);
#pragma unroll
    for (int r = 0; r < 2; ++r) {
        const int t = 2 * tp + r; float f[32]; float s = 0.f;
#pragma unroll
        for (int j = 0; j < 4; ++j) { const unsigned w4[4] = {v[r][j].x, v[r][j].y, v[r][j].z, v[r][j].w};
#pragma unroll
            for (int k = 0; k < 4; ++k) { f[8 * j + 2 * k] = __uint_as_float(w4[k] << 16); f[8 * j + 2 * k + 1] = __uint_as_float(w4[k] & 0xffff0000u); } }
#pragma unroll
        for (int i = 0; i < 32; i += 4) s += (f[i] + f[i + 1]) + (f[i + 2] + f[i + 3]);
        const float mu = wave_sum(s) * (1.0f / DM); float q = 0.f;
#pragma unroll
        for (int i = 0; i < 32; ++i) { f[i] -= mu; q += f[i] * f[i]; }
        const float rs = rsqrtf(wave_sum(q) * (1.0f / DM) + 1e-5f);
#pragma unroll
        for (int j = 0; j < 4; ++j) { const int c = j * 512 + lane * 8; const f32x4e_t g0 = *(const LAS f32x4e_t*)(g + c), g1 = *(const LAS f32x4e_t*)(g + c + 4), b0 = *(const LAS f32x4e_t*)(bta + c), b1 = *(const LAS f32x4e_t*)(bta + c + 4);
            *(uint4*)(xb + (size_t)t * DM + c) = make_uint4(pk2(f[8 * j] * rs * g0.x + b0.x, f[8 * j + 1] * rs * g0.y + b0.y), pk2(f[8 * j + 2] * rs * g0.z + b0.z, f[8 * j + 3] * rs * g0.w + b0.w),
                                                            pk2(f[8 * j + 4] * rs * g1.x + b1.x, f[8 * j + 5] * rs * g1.y + b1.y), pk2(f[8 * j + 6] * rs * g1.z + b1.z, f[8 * j + 7] * rs * g1.w + b1.w)); }
    }
}

__device__ __forceinline__ float gelu_erf(float v) {
    const float av = fabsf(v), t = __builtin_amdgcn_rcpf(av * 0.2316418882f + 1.0f);
    float q = t * 0.5307027145f + (-0.7265760135f); q = q * t + 0.7107068705f; q = q * t + (-0.142248368f); q = q * t + 0.127414796f; q = q * t;
    const float e = __builtin_amdgcn_exp2f((v * v) * (-0.72134752044f));
    const float mm = v * (q * e), r = v - mm;
    return v < 0.f ? mm : r;
}
typedef unsigned u32x4e_t __attribute__((ext_vector_type(4)));
typedef float f32x4e_t __attribute__((ext_vector_type(4)));
typedef unsigned u32x2e_t __attribute__((ext_vector_type(2)));
constexpr float U6_SCALE = 80.0f, V4_SCALE = 16.0f;
constexpr int ROW4 = DM / 2;
constexpr int ROW6 = DM * 6 / 8;
typedef float v32f_t __attribute__((ext_vector_type(32)));
typedef float f32x2_t __attribute__((ext_vector_type(2)));
typedef __bf16 v32b_t __attribute__((ext_vector_type(32)));
typedef unsigned v6u_t __attribute__((ext_vector_type(6)));
typedef __bf16 v2b_t __attribute__((ext_vector_type(2)));
__device__ __forceinline__ void tab_to_fp6(size_t i, const float* __restrict__ src, unsigned char* __restrict__ dst, float sc) {
    const float4* s = (const float4*)src + i * 8; v32b_t b;
#pragma unroll
    for (int j = 0; j < 8; ++j) { const float4 v = s[j]; b[4 * j] = (__bf16)(v.x * sc); b[4 * j + 1] = (__bf16)(v.y * sc); b[4 * j + 2] = (__bf16)(v.z * sc); b[4 * j + 3] = (__bf16)(v.w * sc); }
    const v6u_t p = __builtin_amdgcn_cvt_scalef32_pk32_fp6_bf16(b, 1.0f);
    uint2* d = (uint2*)(dst + i * 24); d[0] = make_uint2(p[0], p[1]); d[1] = make_uint2(p[2], p[3]); d[2] = make_uint2(p[4], p[5]);
}
__device__ __forceinline__ void tab_to_fp4(size_t i, const float* __restrict__ src, unsigned char* __restrict__ dst, float sc) {
    const float4* s = (const float4*)src + i * 8; unsigned w[4];
#pragma unroll
    for (int j = 0; j < 4; ++j) { const float4 a = s[2 * j], b = s[2 * j + 1]; unsigned x = 0u;
        x = __builtin_amdgcn_cvt_scalef32_pk_fp4_f32(x, a.x * sc, a.y * sc, 1.0f, 0); x = __builtin_amdgcn_cvt_scalef32_pk_fp4_f32(x, a.z * sc, a.w * sc, 1.0f, 1);
        x = __builtin_amdgcn_cvt_scalef32_pk_fp4_f32(x, b.x * sc, b.y * sc, 1.0f, 2); x = __builtin_amdgcn_cvt_scalef32_pk_fp4_f32(x, b.z * sc, b.w * sc, 1.0f, 3); w[j] = x; }
    *(uint4*)(dst + i * 16) = make_uint4(w[0], w[1], w[2], w[3]);
}
__device__ __forceinline__ void tab_fp4_store(const float4 (&q)[4], unsigned char* __restrict__ dst8, float sc) {
    unsigned w[2];
#pragma unroll
    for (int j = 0; j < 2; ++j) { const float4 a = q[2 * j], b = q[2 * j + 1]; unsigned x = 0u;
        x = __builtin_amdgcn_cvt_scalef32_pk_fp4_f32(x, a.x * sc, a.y * sc, 1.0f, 0); x = __builtin_amdgcn_cvt_scalef32_pk_fp4_f32(x, a.z * sc, a.w * sc, 1.0f, 1);
        x = __builtin_amdgcn_cvt_scalef32_pk_fp4_f32(x, b.x * sc, b.y * sc, 1.0f, 2); x = __builtin_amdgcn_cvt_scalef32_pk_fp4_f32(x, b.z * sc, b.w * sc, 1.0f, 3); w[j] = x; }
    *(uint2*)dst8 = make_uint2(w[0], w[1]);
}
constexpr int TAB_PER_WG = (P_EXPERTS * (DM / 32)) / 128;
__device__ __forceinline__ void peer_expert_body(int t, int lane, bool last, const int* __restrict__ ids, const float* __restrict__ gates, const unsigned char* __restrict__ U6, const unsigned char* __restrict__ V6,
                                                 const LAS float* gl  , const LAS float* bl  , float* __restrict__ outf, bf16* outb  , unsigned char* __restrict__ outq  , LAS unsigned* wl  ) {
    asm volatile("" : "+v"(lane));
    int idA = ids[(size_t)t * 128 + lane], idB = ids[(size_t)t * 128 + 64 + lane]; float gA = gates[(size_t)t * 128 + lane], gB = gates[(size_t)t * 128 + 64 + lane];
    {
        const unsigned kA = ((unsigned)idA << 7) | (unsigned)lane, kB = ((unsigned)idB << 7) | (unsigned)(64 + lane);
        wl[lane] = kA; wl[64 + lane] = kB;
        asm volatile("s_waitcnt lgkmcnt(0)" ::: "memory");
        int rA = 0, rB = 0;
#pragma unroll 8
        for (int j = 0; j < 128; j += 4) { const u32x4e_t k4 = *(const LAS u32x4e_t*)(wl + j);
#pragma unroll
            for (int q = 0; q < 4; ++q) { rA += (k4[q] < kA) ? 1 : 0; rB += (k4[q] < kB) ? 1 : 0; } }
        asm volatile("s_waitcnt lgkmcnt(0)" ::: "memory");
        wl[128 + rA] = (unsigned)idA; wl[256 + rA] = __float_as_uint(gA); wl[128 + rB] = (unsigned)idB; wl[256 + rB] = __float_as_uint(gB);
        asm volatile("s_waitcnt lgkmcnt(0)" ::: "memory");
        idA = (int)wl[128 + lane]; idB = (int)wl[192 + lane]; gA = __uint_as_float(wl[256 + lane]); gB = __uint_as_float(wl[320 + lane]);
        asm volatile("s_waitcnt lgkmcnt(0)" ::: "memory");
    }
#define ID_OF(e_) __builtin_amdgcn_readlane((e_) < 64 ? idA : idB, (e_) & 63)
#define GATE_OF(e_) __builtin_bit_cast(float, __builtin_amdgcn_readlane(__builtin_bit_cast(int, (e_) < 64 ? gA : gB), (e_) & 63))
    uint4 ra[8], rb[8];
#define ROW_LOAD(R_, T_, e_) do { _Pragma("unroll") for (int k_ = 0; k_ < 8; ++k_) { const int id_ = ID_OF((e_) + k_); R_[k_] = *((const uint4*)((T_) + (size_t)id_ * ROW4) + lane); } } while (0)
#define V4_PAIR(D_, W_, j_, b_) do { const f32x2_t t_ = __builtin_amdgcn_cvt_scalef32_pk_f32_fp4(W_, 1.0f, b_); D_[8 * (j_) + 2 * (b_)] = t_.x; D_[8 * (j_) + 2 * (b_) + 1] = t_.y; } while (0)
#define V4_DWORD(D_, W_, j_) do { V4_PAIR(D_, W_, j_, 0); V4_PAIR(D_, W_, j_, 1); V4_PAIR(D_, W_, j_, 2); V4_PAIR(D_, W_, j_, 3); } while (0)
#define UDOT4(W_, j_) do { a_ = __builtin_amdgcn_fdot2_f32_bf16(__builtin_amdgcn_cvt_scalef32_pk_bf16_fp4(W_, 1.0f, 0), __builtin_bit_cast(v2b_t, xb[4 * (j_)]), a_, false); \
        b_ = __builtin_amdgcn_fdot2_f32_bf16(__builtin_amdgcn_cvt_scalef32_pk_bf16_fp4(W_, 1.0f, 1), __builtin_bit_cast(v2b_t, xb[4 * (j_) + 1]), b_, false); \
        a_ = __builtin_amdgcn_fdot2_f32_bf16(__builtin_amdgcn_cvt_scalef32_pk_bf16_fp4(W_, 1.0f, 2), __builtin_bit_cast(v2b_t, xb[4 * (j_) + 2]), a_, false); \
        b_ = __builtin_amdgcn_fdot2_f32_bf16(__builtin_amdgcn_cvt_scalef32_pk_bf16_fp4(W_, 1.0f, 3), __builtin_bit_cast(v2b_t, xb[4 * (j_) + 3]), b_, false); } while (0)
#define DEC4(D_, R_) do { V4_DWORD(D_, R_.x, 0); V4_DWORD(D_, R_.y, 1); V4_DWORD(D_, R_.z, 2); V4_DWORD(D_, R_.w, 3); } while (0)
#define PK6(W_) ((v6u_t){W_[0].x, W_[0].y, W_[1].x, W_[1].y, W_[2].x, W_[2].y})
#define SB_ __builtin_amdgcn_sched_barrier(0)
    float c0 = 0.f, c1 = 0.f;
    unsigned xb[16];
    {
#pragma unroll
        for (int i = 0; i < 4; ++i) { const uint4 v = *(const uint4*)(outb + (size_t)t * DM + lane * 32 + i * 8); xb[4 * i] = v.x; xb[4 * i + 1] = v.y; xb[4 * i + 2] = v.z; xb[4 * i + 3] = v.w; }
#define U_COMP(R_, e_) do { float p_[8]; _Pragma("unroll") for (int k_ = 0; k_ < 8; ++k_) { SB_; float a_ = 0.f, b_ = 0.f; UDOT4(R_[k_].x, 0); UDOT4(R_[k_].y, 1); UDOT4(R_[k_].z, 2); UDOT4(R_[k_].w, 3); p_[k_] = a_ + b_; } SB_; \
        { const bool o1_ = lane & 1, o2_ = lane & 2, o4_ = lane & 4; float w_[4], u_[2]; \
          _Pragma("unroll") for (int j_ = 0; j_ < 4; ++j_) { const float keep_ = o1_ ? p_[2 * j_ + 1] : p_[2 * j_], send_ = o1_ ? p_[2 * j_] : p_[2 * j_ + 1]; w_[j_] = keep_ + dpp_f<0xB1>(send_); } \
          _Pragma("unroll") for (int j_ = 0; j_ < 2; ++j_) { const float keep_ = o2_ ? w_[2 * j_ + 1] : w_[2 * j_], send_ = o2_ ? w_[2 * j_] : w_[2 * j_ + 1]; u_[j_] = keep_ + dpp_f<0x4E>(send_); } \
          float s_; { const float keep_ = o4_ ? u_[1] : u_[0], send_ = o4_ ? u_[0] : u_[1]; s_ = keep_ + __builtin_bit_cast(float, __builtin_amdgcn_ds_swizzle(__builtin_bit_cast(int, send_), 0x101F)); } \
          s_ += __builtin_bit_cast(float, __builtin_amdgcn_ds_swizzle(__builtin_bit_cast(int, s_), 0x201F)); s_ += __builtin_bit_cast(float, __builtin_amdgcn_ds_swizzle(__builtin_bit_cast(int, s_), 0x401F)); \
          { float lo_ = s_, hi_ = s_; halves32(lo_, hi_); s_ = lo_ + hi_; } \
          s_ *= (1.0f / U6_SCALE); const float ge_ = gelu_erf(s_) * (1.0f / V4_SCALE); \
          const bool in_ = ((lane ^ (e_)) & 56) == 0;              \
          if ((e_) < 64) c0 = in_ ? gA * ge_ : c0; else c1 = in_ ? gB * ge_ : c1; } } while (0)
        ROW_LOAD(ra, U6, 0);
#pragma nounroll
        for (int e = 0; e < 128; e += 16) {
            ROW_LOAD(rb, U6, e + 8);
            U_COMP(ra, e);
            if (e + 16 < 128) ROW_LOAD(ra, U6, e + 16);
            U_COMP(rb, e + 8);
        }
#undef U_COMP
    }
    v32f_t acc;
#pragma unroll
    for (int i = 0; i < 32; ++i) acc[i] = 0.f;
#define V_COMP(R_, e_) do { _Pragma("unroll") for (int k_ = 0; k_ < 8; ++k_) { SB_; const int ee_ = (e_) + k_; \
            const float cv_ = __builtin_bit_cast(float, __builtin_amdgcn_readlane(__builtin_bit_cast(int, ee_ < 64 ? c0 : c1), ee_ & 63)); \
            v32f_t d_; DEC4(d_, R_[k_]); acc += d_ * cv_; } SB_; } while (0)
    ROW_LOAD(ra, V6, 0);
#pragma nounroll
    for (int e = 0; e < 128; e += 16) {
        ROW_LOAD(rb, V6, e + 8);
        V_COMP(ra, e);
        if (e + 16 < 128) ROW_LOAD(ra, V6, e + 16);
        V_COMP(rb, e + 8);
    }
#undef V_COMP
#undef ID_OF
#undef GATE_OF
#undef ROW_LOAD
#undef PK6
#undef V4_PAIR
#undef V4_DWORD
#undef DEC4
#undef UDOT4
#undef SB_
    float s = 0.f;
#pragma unroll
    for (int i = 0; i < 16; ++i) { acc[2 * i] += ALPHA * __uint_as_float(xb[i] << 16); acc[2 * i + 1] += ALPHA * __uint_as_float(xb[i] & 0xffff0000u); }
#pragma unroll
    for (int i = 0; i < 32; ++i) s += acc[i];
    const float mu = wave_sum(s) * (1.0f / DM); float q = 0.f;
#pragma unroll
    for (int i = 0; i < 32; ++i) { acc[i] -= mu; q += acc[i] * acc[i]; }
    const float rs = rsqrtf(wave_sum(q) * (1.0f / DM) + 1e-5f);
#pragma unroll
    for (int i = 0; i < 8; ++i) { const int c = lane * 32 + i * 4; const f32x4e_t gq = *(const LAS f32x4e_t*)(gl + (i * 64 + lane) * 4), bq = *(const LAS f32x4e_t*)(bl + (i * 64 + lane) * 4);
        const float4 gg = make_float4(gq[0], gq[1], gq[2], gq[3]), bb = make_float4(bq[0], bq[1], bq[2], bq[3]);
        float4 y; y.x = acc[4 * i] * rs * gg.x + bb.x; y.y = acc[4 * i + 1] * rs * gg.y + bb.y; y.z = acc[4 * i + 2] * rs * gg.z + bb.z; y.w = acc[4 * i + 3] * rs * gg.w + bb.w;
        if (last) *(float4*)(outf + (size_t)t * DM + c) = y; else { *(uint2*)(outb + (size_t)t * DM + c) = make_uint2(pk2(y.x, y.y), pk2(y.z, y.w)); *(unsigned*)(outq + (size_t)t * DM + c) = pk4_fp8(y.x, y.y, y.z, y.w); } }
}

typedef short bf16x8_t __attribute__((ext_vector_type(8)));
typedef float f32x4_t __attribute__((ext_vector_type(4)));
typedef unsigned u32x2_t __attribute__((ext_vector_type(2)));
typedef unsigned u32x4_t __attribute__((ext_vector_type(4)));
constexpr int SWA_PITCH = 144;
constexpr int SWA_KS = 0, SWA_VS = 256 * SWA_PITCH, SWA_LDS = 2 * 256 * SWA_PITCH;
static_assert(SWA_LDS <= RING_BYTES, "SWA LDS");
__device__ __forceinline__ float grp4_max(float v) {
    v = fmaxf(v, __builtin_bit_cast(float, __builtin_amdgcn_ds_swizzle(__builtin_bit_cast(int, v), 0x401F)));
    float lo = v, hi = v; halves32(lo, hi);
    return fmaxf(lo, hi);
}
__device__ __forceinline__ float grp4_sum(float v) {
    v += __builtin_bit_cast(float, __builtin_amdgcn_ds_swizzle(__builtin_bit_cast(int, v), 0x401F));
    float lo = v, hi = v; halves32(lo, hi);
    return lo + hi;
}
__device__ __forceinline__ void tr_read2(unsigned a0, unsigned a1, u32x2_t& r0, u32x2_t& r1) {
    asm volatile("ds_read_b64_tr_b16 %0, %2\n\tds_read_b64_tr_b16 %1, %3\n\ts_waitcnt lgkmcnt(0)" : "=&v"(r0), "=&v"(r1) : "v"(a0), "v"(a1) : "memory");
}
__device__ __forceinline__ void rope8(uint4& lo, uint4& hi, const float4* cs, float scale) {
    unsigned* a = (unsigned*)&lo; unsigned* b = (unsigned*)&hi;
#pragma unroll
    for (int j = 0; j < 4; ++j) {
        const float x1a = __uint_as_float(a[j] << 16), x1b = __uint_as_float(a[j] & 0xffff0000u), x2a = __uint_as_float(b[j] << 16), x2b = __uint_as_float(b[j] & 0xffff0000u);
        const float4 c = cs[j];
        const float y1a = (x1a * c.x - x2a * c.y) * scale, y2a = (x2a * c.x + x1a * c.y) * scale, y1b = (x1b * c.z - x2b * c.w) * scale, y2b = (x2b * c.z + x1b * c.w) * scale;
        a[j] = pk2(y1a, y1b); b[j] = pk2(y2a, y2b);
    }
}
__device__ __forceinline__ void swa_phase(LAS unsigned char* lds, const bf16* __restrict__ proj, const float* __restrict__ rtab  , const float* __restrict__ sinks, unsigned char* __restrict__ ya  ,
                                          int tid, int bx, int G) {
    const int lane = tid & 63, w = __builtin_amdgcn_readfirstlane(tid >> 6), l15 = lane & 15, g4 = lane >> 4;
    const unsigned ldsb = (unsigned)(size_t)lds;
    constexpr int NSWA = NBATCH * 32 * 4, NSWA_LO = NSWA * 4 / 8;
    const int hb = G >> 1; int u0 = bx, u1 = NSWA, ust = G;
    if (hb > 0) { if (bx < hb) { u1 = NSWA_LO; ust = hb; } else { u0 = NSWA_LO + bx - hb; ust = G - hb; } }
    uint4 klo[2], khi[2], vv[4]; float4 kcs[2][4];
#define SWA_LOAD(u_) do { const int kvh_ = (u_) & 3, nb_ = ((u_) >> 2) & 31, b_ = (u_) >> 7, t0_ = b_ * SEQ + nb_ * 128; \
        _Pragma("unroll") for (int i_ = 0; i_ < 2; ++i_) { const int it_ = tid + 512 * i_, kk_ = it_ >> 2, c_ = it_ & 3; klo[i_] = make_uint4(0u, 0u, 0u, 0u); khi[i_] = klo[i_]; \
            _Pragma("unroll") for (int j_ = 0; j_ < 4; ++j_) kcs[i_][j_] = make_float4(0.f, 0.f, 0.f, 0.f); \
            if (nb_ > 0 || kk_ >= 128) { const bf16* src_ = proj + (size_t)(t0_ - 128 + kk_) * NP + C_AK + kvh_ * 64 + 8 * c_; klo[i_] = *(const uint4*)src_; khi[i_] = *(const uint4*)(src_ + 32); \
                const float4* cs_ = (const float4*)(rtab + ((size_t)(nb_ * 128 - 128 + kk_) * 32 + 8 * c_) * 2); kcs[i_][0] = cs_[0]; kcs[i_][1] = cs_[1]; kcs[i_][2] = cs_[2]; kcs[i_][3] = cs_[3]; } } \
        _Pragma("unroll") for (int i_ = 0; i_ < 4; ++i_) { const int it_ = tid + 512 * i_, kk_ = it_ >> 3, c_ = it_ & 7; vv[i_] = make_uint4(0u, 0u, 0u, 0u); \
            if (nb_ > 0 || kk_ >= 128) vv[i_] = *(const uint4*)(proj + (size_t)(t0_ - 128 + kk_) * NP + C_AV + kvh_ * 64 + 8 * c_); } } while (0)
#define SWA_STORE() do { \
        _Pragma("unroll") for (int i_ = 0; i_ < 2; ++i_) { const int it_ = tid + 512 * i_, kk_ = it_ >> 2, c_ = it_ & 3; uint4 lo_ = klo[i_], hi_ = khi[i_]; rope8(lo_, hi_, kcs[i_], 1.0f);     \
            *(LAS u32x4_t*)(lds + SWA_KS + kk_ * SWA_PITCH + 16 * c_) = __builtin_bit_cast(u32x4_t, lo_); *(LAS u32x4_t*)(lds + SWA_KS + kk_ * SWA_PITCH + 64 + 16 * c_) = __builtin_bit_cast(u32x4_t, hi_); } \
        _Pragma("unroll") for (int i_ = 0; i_ < 4; ++i_) { const int it_ = tid + 512 * i_, kk_ = it_ >> 3, c_ = it_ & 7; *(LAS u32x4_t*)(lds + SWA_VS + kk_ * SWA_PITCH + 16 * c_) = __builtin_bit_cast(u32x4_t, vv[i_]); } } while (0)
    if (u0 < u1) SWA_LOAD(u0);
    for (int u = u0; u < u1; u += ust) {
        const int kvh = u & 3, nb = (u >> 2) & 31, b = u >> 7;
        const int t0 = b * SEQ + nb * 128;
        const int r = w >> 1, hf = w & 1, hq = kvh * 4 + r;
        uint4 nqlo, nqhi; float4 nqcs[4];
#define SWA_QLOAD(qt_) do { const int iq_ = 64 * hf + 16 * (qt_) + l15; const bf16* src_ = proj + (size_t)(t0 + iq_) * NP + C_AQ + hq * 64 + 8 * g4; nqlo = *(const uint4*)src_; nqhi = *(const uint4*)(src_ + 32); \
            const float4* cs_ = (const float4*)(rtab + ((size_t)(nb * 128 + iq_) * 32 + 8 * g4) * 2); nqcs[0] = cs_[0]; nqcs[1] = cs_[1]; nqcs[2] = cs_[2]; nqcs[3] = cs_[3]; } while (0)
        SWA_QLOAD(0);
        __syncthreads();
        SWA_STORE();
        if (u + ust < u1) SWA_LOAD(u + ust);
        __syncthreads();
        const float sink = sinks[hq];
#pragma nounroll
        for (int qt = 0; qt < 4; ++qt) {
            const int i0 = 64 * hf + 16 * qt, iq = i0 + l15, tq = t0 + iq, ktb0 = 4 * hf + qt;
            bf16x8_t q0, q1;
            { uint4 lo = nqlo, hi = nqhi; rope8(lo, hi, nqcs, 0.125f); q0 = __builtin_bit_cast(bf16x8_t, lo); q1 = __builtin_bit_cast(bf16x8_t, hi); }
            if (qt + 1 < 4) SWA_QLOAD(qt + 1);
            f32x4_t s[9]; float m = sink; const int d0 = 4 * g4 - l15;
#pragma unroll
            for (int n = 0; n < 9; ++n) {
                const LAS unsigned char* kp = lds + SWA_KS + (16 * (ktb0 + n) + l15) * SWA_PITCH + 16 * g4;
                const bf16x8_t a0 = *(const LAS bf16x8_t*)kp, a1 = *(const LAS bf16x8_t*)(kp + 64);
                f32x4_t acc = (f32x4_t){0.f, 0.f, 0.f, 0.f};
                acc = __builtin_amdgcn_mfma_f32_16x16x32_bf16(a0, q0, acc, 0, 0, 0);
                acc = __builtin_amdgcn_mfma_f32_16x16x32_bf16(a1, q1, acc, 0, 0, 0);
                const bool tv = (nb > 0) || (ktb0 + n >= 8);
#pragma unroll
                for (int e = 0; e < 4; ++e) { const bool ok = tv && (n == 0 ? (d0 + e >= 1) : n == 8 ? (d0 + e <= 0) : true);
                    acc[e] = ok ? acc[e] : -1e30f; m = fmaxf(m, acc[e]); }
                s[n] = acc;
            }
            m = grp4_max(m);
            float lsum = 0.f;
#pragma unroll
            for (int n = 0; n < 9; ++n)
#pragma unroll
                for (int e = 0; e < 4; ++e) { const float p = __expf(s[n][e] - m); s[n][e] = p; lsum += p; }
            lsum = grp4_sum(lsum) + __expf(sink - m);
            const float inv = __builtin_amdgcn_rcpf(lsum);
            bf16x8_t pf[5];
#pragma unroll
            for (int pi = 0; pi < 4; ++pi) { uint4 w4; w4.x = pk2(s[2 * pi][0], s[2 * pi][1]); w4.y = pk2(s[2 * pi][2], s[2 * pi][3]); w4.z = pk2(s[2 * pi + 1][0], s[2 * pi + 1][1]); w4.w = pk2(s[2 * pi + 1][2], s[2 * pi + 1][3]);
                pf[pi] = __builtin_bit_cast(bf16x8_t, w4); }
            { uint4 w4; w4.x = pk2(s[8][0], s[8][1]); w4.y = pk2(s[8][2], s[8][3]); w4.z = 0u; w4.w = 0u; pf[4] = __builtin_bit_cast(bf16x8_t, w4); }
            const int qq = l15 >> 2, pp = lane & 3;
#pragma unroll
            for (int dt = 0; dt < 4; ++dt) {
                f32x4_t o = (f32x4_t){0.f, 0.f, 0.f, 0.f};
#pragma unroll
                for (int pi = 0; pi < 5; ++pi) {
                    const int ka = (ktb0 + 2 * pi) < 15 ? (ktb0 + 2 * pi) : 15, kb = (ktb0 + 2 * pi + 1) < 15 ? (ktb0 + 2 * pi + 1) : 15;
                    u32x2_t v0, v1;
                    tr_read2(ldsb + SWA_VS + (16 * ka + 4 * g4 + qq) * SWA_PITCH + (16 * dt + 4 * pp) * 2, ldsb + SWA_VS + (16 * kb + 4 * g4 + qq) * SWA_PITCH + (16 * dt + 4 * pp) * 2, v0, v1);
                    const uint4 av = make_uint4(v0.x, v0.y, v1.x, v1.y);
                    o = __builtin_amdgcn_mfma_f32_16x16x32_bf16(__builtin_bit_cast(bf16x8_t, av), pf[pi], o, 0, 0, 0);
                }
                { const float i4 = inv * ACT8_SCALE; *(unsigned*)(ya + (size_t)tq * 1024 + hq * 64 + 16 * dt + 4 * g4) = pk4_fp8(o[0] * i4, o[1] * i4, o[2] * i4, o[3] * i4); }
            }
        }
    }
#undef SWA_LOAD
#undef SWA_STORE
#undef SWA_QLOAD
}

constexpr size_t WS_MG = WS_R1 + 128 * MiB, WS_MEG = WS_MG + 2 * MiB, WS_SG = WS_MG + 3 * MiB, WS_SEA = WS_SG + 8 * MiB;
__device__ __forceinline__ void mlstm_gate_item(int item, int lane, LAS float* wl, const float* __restrict__ small, const float* __restrict__ gate_b, float4* __restrict__ mg, float* __restrict__ meg) {
    const int ch = item & 63, h = (item >> 6) & 3, b = item >> 8; const size_t t = (size_t)b * SEQ + ch * 64 + lane;
    const float ip = small[t * 32 + h] + gate_b[h], fp = small[t * 32 + 4 + h] + gate_b[4 + h];
    wl[lane] = fminf(fp, 0.f) - log1pf(__expf(-fabsf(fp)));
    asm volatile("s_waitcnt lgkmcnt(0)" ::: "memory");
    float bs = 0.f;
#pragma unroll
    for (int j = 0; j < 64; j += 4) { const f32x4_t v4 = *(const LAS f32x4_t*)(wl + j);
        bs += (j + 0 <= lane) ? v4[0] : 0.f; bs += (j + 1 <= lane) ? v4[1] : 0.f; bs += (j + 2 <= lane) ? v4[2] : 0.f; bs += (j + 3 <= lane) ? v4[3] : 0.f; }
    const float gt = __builtin_bit_cast(float, __builtin_amdgcn_readlane(__builtin_bit_cast(int, bs), 63));
    mg[t * 4 + h] = make_float4(bs, ip - bs, __expf(bs), __expf(gt - bs + ip) * 0.08838834764831845f);
    if (lane == 0) meg[(b * 4 + h) * 64 + ch] = __expf(gt);
    asm volatile("s_waitcnt lgkmcnt(0)" ::: "memory");
}
__device__ __forceinline__ void ssd_gate_item(int item, int lane, LAS float* wl, const float* __restrict__ small, const float* __restrict__ dt_bias, const float* __restrict__ a_log, float4* __restrict__ sg, float* __restrict__ sea) {
    const int ch = item & 31, hh = (item >> 5) & 15, b = item >> 9; const size_t t0 = (size_t)b * SEQ + ch * 128;
    const float a = -__expf(a_log[hh]), dtb = dt_bias[hh];
    float dt[2];
#pragma unroll
    for (int r = 0; r < 2; ++r) { const float dtr = small[(t0 + lane + 64 * r) * 32 + 8 + hh] + dtb; dt[r] = dtr > 20.f ? dtr : log1pf(__expf(dtr)); wl[lane + 64 * r] = dt[r] * a; }
    asm volatile("s_waitcnt lgkmcnt(0)" ::: "memory");
    float a0 = 0.f, a1 = 0.f;
#pragma unroll 8
    for (int j = 0; j < 128; j += 4) { const f32x4_t v4 = *(const LAS f32x4_t*)(wl + j);
#pragma unroll
        for (int q = 0; q < 4; ++q) { a0 += (j + q <= lane) ? v4[q] : 0.f; a1 += (j + q <= lane + 64) ? v4[q] : 0.f; } }
    const float atot = __builtin_bit_cast(float, __builtin_amdgcn_readlane(__builtin_bit_cast(int, a1), 63));
    sg[(t0 + lane) * 16 + hh] = make_float4(dt[0], a0, __expf(a0), __expf(atot - a0) * dt[0]);
    sg[(t0 + lane + 64) * 16 + hh] = make_float4(dt[1], a1, __expf(a1), __expf(atot - a1) * dt[1]);
    if (lane == 0) sea[(b * 16 + hh) * 32 + ch] = __expf(atot);
    asm volatile("s_waitcnt lgkmcnt(0)" ::: "memory");
}

constexpr int ML_QP = 272, ML_VP = 176, ML_PP = 144;
constexpr int ML_UNITS = NBATCH * 4 * 4;
constexpr int ML_Q = 0, ML_K = 2 * 64 * ML_QP, ML_V = ML_K + 2 * 64 * ML_QP, ML_VW = ML_V + 2 * 64 * ML_VP, ML_P = ML_VW + 64 * ML_VP, ML_CT = ML_P + 64 * ML_PP,
              ML_VEC = ML_CT + 80 * ML_QP, ML_END = ML_VEC + 4096;
static_assert(ML_END <= PHASE_LDS_BYTES, "mLSTM LDS");
__device__ __forceinline__ void tr_read2q(unsigned a0, unsigned a1, u32x2_t& r0, u32x2_t& r1) {
    asm volatile("ds_read_b64_tr_b16 %0, %2\n\tds_read_b64_tr_b16 %1, %3\n\ts_waitcnt lgkmcnt(0)" : "=&v"(r0), "=&v"(r1) : "v"(a0), "v"(a1) : "memory");
}
__device__ __forceinline__ bf16x8_t mk_frag(u32x2_t lo, u32x2_t hi) { const u32x4_t v = (u32x4_t){lo.x, lo.y, hi.x, hi.y}; return __builtin_bit_cast(bf16x8_t, v); }
#define LBAR() do { asm volatile("s_waitcnt lgkmcnt(0)" ::: "memory"); __builtin_amdgcn_s_barrier(); asm volatile("" ::: "memory"); } while (0)
__device__ __forceinline__ void mlstm_phase(LAS unsigned char* lds, const bf16* __restrict__ proj, const float4* __restrict__ mg, const float* __restrict__ meg, bf16* __restrict__ hm, int tid, int bx, int G, const float* __restrict__ tsrc  , unsigned char* __restrict__ tdst) {
    const int lane0 = tid & 63, w = __builtin_amdgcn_readfirstlane(tid >> 6);
    const unsigned ldsb = (unsigned)(size_t)lds;
    LAS float* vec = (LAS float*)(lds + ML_VEC);
    for (int u = bx; u < ML_UNITS; u += G) {
        const int vs = u & 3, h = (u >> 2) & 3, b = u >> 4;
        LBAR();
        for (int i = tid; i < 2 * 64; i += 512) { LAS unsigned* p = (LAS unsigned*)(lds + ML_V + i * ML_VP + 128); unsigned zz = 0u; asm volatile("" : "+v"(zz));     p[0] = 0x00003F80u | zz;
#pragma unroll
            for (int j = 1; j < 8; ++j) p[j] = zz; }
        for (int i = tid; i < 80 * ML_QP / 4; i += 512) ((LAS unsigned*)(lds + ML_CT))[i] = 0u;
        f32x4_t cacc[5];
#pragma unroll
        for (int i = 0; i < 5; ++i) cacc[i] = (f32x4_t){0.f, 0.f, 0.f, 0.f};
        struct MLRegs { uint4 pq[2], pk[2], pv; float4 pg; float peg; } rs[2];
#pragma unroll
        for (int i = 0; i < 2; ++i) { rs[i].pv = make_uint4(0u, 0u, 0u, 0u); rs[i].pg = make_float4(0.f, 0.f, 0.f, 0.f); rs[i].peg = 0.f; }
#define ML_LOAD(R_, c_) do { const size_t tb_ = (size_t)b * SEQ + (size_t)(c_) * 64; \
            _Pragma("unroll") for (int i_ = 0; i_ < 2; ++i_) { const int p_ = tid + 512 * i_, row_ = p_ >> 4, c16_ = p_ & 15; const bf16* s_ = proj + (tb_ + row_) * NP + h * 128 + c16_ * 8; R_.pq[i_] = *(const uint4*)(s_ + C_MQ); R_.pk[i_] = *(const uint4*)(s_ + C_MK); } \
            R_.pv = *(const uint4*)(proj + (tb_ + (tid >> 3)) * NP + C_MV + h * 256 + vs * 64 + (tid & 7) * 8); \
            if (tid >= 256 && tid < 320) { R_.pg = mg[(tb_ + (tid - 256)) * 4 + h]; R_.peg = meg[(b * 4 + h) * 64 + (c_)]; } } while (0)
#define ML_STORE(R_, bi_) do { _Pragma("unroll") for (int i_ = 0; i_ < 2; ++i_) { const int p_ = tid + 512 * i_, row_ = p_ >> 4, c16_ = p_ & 15; \
                *(LAS u32x4_t*)(lds + ML_Q + (bi_) * 64 * ML_QP + row_ * ML_QP + c16_ * 16) = __builtin_bit_cast(u32x4_t, R_.pq[i_]); *(LAS u32x4_t*)(lds + ML_K + (bi_) * 64 * ML_QP + row_ * ML_QP + c16_ * 16) = __builtin_bit_cast(u32x4_t, R_.pk[i_]); } \
            *(LAS u32x4_t*)(lds + ML_V + (bi_) * 64 * ML_VP + (tid >> 3) * ML_VP + (tid & 7) * 16) = __builtin_bit_cast(u32x4_t, R_.pv); \
            if (tid >= 256 && tid < 320) { LAS float* v_ = vec + (bi_) * 320 + (tid - 256); v_[0] = R_.pg.x; v_[64] = R_.pg.y; v_[128] = R_.pg.z; v_[192] = R_.pg.w; if (tid == 256) vec[(bi_) * 320 + 256] = R_.peg; } } while (0)
        ML_LOAD(rs[0], 0); ML_STORE(rs[0], 0); ML_LOAD(rs[1], 1);
        LBAR();
#pragma nounroll
        for (int c2 = 0; c2 < 64; c2 += 2) {
          int lane = lane0; asm volatile("" : "+v"(lane));
          const int l15 = lane & 15, g4 = lane >> 4, qq = l15 >> 2, pp = lane & 3;
#pragma unroll
          for (int par = 0; par < 2; ++par) {
            const int c = c2 + par, bi_cur = par;
            const LAS unsigned char* Qs = lds + ML_Q + bi_cur * 64 * ML_QP; const LAS unsigned char* Ks = lds + ML_K + bi_cur * 64 * ML_QP;
            const unsigned Ksb = ldsb + ML_K + bi_cur * 64 * ML_QP, Vsb = ldsb + ML_V + bi_cur * 64 * ML_VP, Vwb = ldsb + ML_VW;
            if (c + 2 < 64) ML_LOAD(rs[par], c + 2);
            float4 tq[4]; const size_t tgi = ((size_t)bx * TAB_PER_WG + (size_t)c * 128) * 2 + tid;
            if (tsrc && tid < 256) {
#pragma unroll
                for (int j = 0; j < 4; ++j) tq[j] = ((const float4*)tsrc)[tgi * 4 + j]; }
            const LAS float* vb = vec + bi_cur * 320;
            {
                const int ti = w >> 1;
#pragma unroll
                for (int sj = 0; sj < 2; ++sj) {
                    const int si = 2 * (w & 1) + sj;
                    f32x4_t acc = (f32x4_t){0.f, 0.f, 0.f, 0.f};
                    if (si <= ti) {
#pragma unroll
                        for (int ks = 0; ks < 4; ++ks) {
                            const bf16x8_t a = *(const LAS bf16x8_t*)(Ks + (16 * si + l15) * ML_QP + (32 * ks + 8 * g4) * 2);
                            const bf16x8_t bq = *(const LAS bf16x8_t*)(Qs + (16 * ti + l15) * ML_QP + (32 * ks + 8 * g4) * 2);
                            acc = __builtin_amdgcn_mfma_f32_16x16x32_bf16(a, bq, acc, 0, 0, 0);
                        }
                        const int t = 16 * ti + l15; const float btv = vb[t];
                        const f32x4_t csv = *(const LAS f32x4_t*)(vb + 64 + 16 * si + 4 * g4);
#pragma unroll
                        for (int e = 0; e < 4; ++e) { const int s = 16 * si + 4 * g4 + e; acc[e] = (s <= t) ? acc[e] * __expf(btv + csv[e]) * 0.08838834764831845f : 0.f; }
                    }
                    *(LAS u32x2_t*)(lds + ML_P + (16 * ti + l15) * ML_PP + (16 * si + 4 * g4) * 2) = (u32x2_t){pk2(acc[0], acc[1]), pk2(acc[2], acc[3])};
                }
            }
            for (int it = tid; it < 640; it += 512) { const int s = it / 10, pc = it % 10; const float wsv = vb[192 + s];
                const u32x4_t v = *(const LAS u32x4_t*)(lds + ML_V + bi_cur * 64 * ML_VP + s * ML_VP + pc * 16); u32x4_t o;
#pragma unroll
                for (int j = 0; j < 4; ++j) o[j] = pk2(__uint_as_float(v[j] << 16) * wsv, __uint_as_float(v[j] & 0xffff0000u) * wsv);
                *(LAS u32x4_t*)(lds + ML_VW + s * ML_VP + pc * 16) = o; }
            LBAR();
            f32x4_t numv[3]; const int ti5 = w >> 1;
            {
                const int nv = (w & 1) ? 2 : 3, v0 = (w & 1) ? 3 : 0;
                bf16x8_t pfr[2], qfr[4];
#pragma unroll
                for (int ks = 0; ks < 2; ++ks) pfr[ks] = *(const LAS bf16x8_t*)(lds + ML_P + (16 * ti5 + l15) * ML_PP + (32 * ks + 8 * g4) * 2);
#pragma unroll
                for (int ks = 0; ks < 4; ++ks) qfr[ks] = *(const LAS bf16x8_t*)(Qs + (16 * ti5 + l15) * ML_QP + (32 * ks + 8 * g4) * 2);
#pragma unroll
                for (int j = 0; j < 3; ++j) {
                    numv[j] = (f32x4_t){0.f, 0.f, 0.f, 0.f};
                    if (j < nv) {
                        const int vi = v0 + j;
                        f32x4_t ai = (f32x4_t){0.f, 0.f, 0.f, 0.f}, ax = ai;
#pragma unroll
                        for (int ks = 0; ks < 2; ++ks) {
                            u32x2_t r0, r1; tr_read2q(Vsb + (32 * ks + 8 * g4 + qq) * ML_VP + (16 * vi + 4 * pp) * 2, Vsb + (32 * ks + 8 * g4 + 4 + qq) * ML_VP + (16 * vi + 4 * pp) * 2, r0, r1);
                            ai = __builtin_amdgcn_mfma_f32_16x16x32_bf16(pfr[ks], mk_frag(r0, r1), ai, 0, 0, 0);
                        }
#pragma unroll
                        for (int ks = 0; ks < 4; ++ks) {
                            const bf16x8_t bc = *(const LAS bf16x8_t*)(lds + ML_CT + (16 * vi + l15) * ML_QP + (32 * ks + 8 * g4) * 2);
                            ax = __builtin_amdgcn_mfma_f32_16x16x32_bf16(qfr[ks], bc, ax, 0, 0, 0);
                        }
                        const f32x4_t eb = *(const LAS f32x4_t*)(vb + 128 + 16 * ti5 + 4 * g4);
                        numv[j] = ai + eb * ax;
                    }
                }
                if ((w & 1) && l15 == 0) *(LAS f32x4_t*)(vec + 640 + 16 * ti5 + 4 * g4) = numv[1];
            }
            LBAR();
            {
                const f32x4_t dn = *(const LAS f32x4_t*)(vec + 640 + 16 * ti5 + 4 * g4);
                const size_t tb = (size_t)b * SEQ + (size_t)c * 64;
                const int nw = (w & 1) ? 1 : 3, v0 = (w & 1) ? 3 : 0;
                f32x4_t rdn;
#pragma unroll
                for (int e = 0; e < 4; ++e) rdn[e] = __builtin_amdgcn_rcpf(fmaxf(fabsf(dn[e]), 1.0f));
#pragma unroll
                for (int j = 0; j < 3; ++j)
                    if (j < nw) {
#pragma unroll
                        for (int e = 0; e < 4; ++e) hm[(tb + 16 * ti5 + 4 * g4 + e) * 1024 + h * 256 + vs * 64 + 16 * (v0 + j) + l15] = (bf16)pk2(numv[j][e] * rdn[e], 0.f);
                    }
            }
            {
                const float eg = vb[256];
                bf16x8_t kf[2];
#pragma unroll
                for (int ks = 0; ks < 2; ++ks) { u32x2_t a0, a1; tr_read2q(Ksb + (32 * ks + 8 * g4 + qq) * ML_QP + (16 * w + 4 * pp) * 2, Ksb + (32 * ks + 8 * g4 + 4 + qq) * ML_QP + (16 * w + 4 * pp) * 2, a0, a1); kf[ks] = mk_frag(a0, a1); }
#pragma unroll
                for (int vi = 0; vi < 5; ++vi) {
                    f32x4_t acc = cacc[vi] * eg;
#pragma unroll
                    for (int ks = 0; ks < 2; ++ks) {
                        u32x2_t b0, b1;
                        tr_read2q(Vwb + (32 * ks + 8 * g4 + qq) * ML_VP + (16 * vi + 4 * pp) * 2, Vwb + (32 * ks + 8 * g4 + 4 + qq) * ML_VP + (16 * vi + 4 * pp) * 2, b0, b1);
                        acc = __builtin_amdgcn_mfma_f32_16x16x32_bf16(kf[ks], mk_frag(b0, b1), acc, 0, 0, 0);
                    }
                    cacc[vi] = acc;
                    *(LAS u32x2_t*)(lds + ML_CT + (16 * vi + l15) * ML_QP + (16 * w + 4 * g4) * 2) = (u32x2_t){pk2(acc[0], acc[1]), pk2(acc[2], acc[3])};
                }
            }
            if (tsrc && tid < 256) tab_fp4_store(tq, tdst + tgi * 8, U6_SCALE);
            if (c + 1 < 64) ML_STORE(rs[par ^ 1], bi_cur ^ 1);
            LBAR();
          }
        }
#undef ML_LOAD
#undef ML_STORE
    }
}

constexpr int SD_BP = 272, SD_XP = 144;
constexpr int SD_UNITS = NBATCH * 16;
constexpr int SD_B = 0, SD_C = 128 * SD_BP, SD_M = 2 * 128 * SD_BP, SD_H = 3 * 128 * SD_BP, SD_X = SD_H + 64 * SD_BP, SD_VEC = SD_X + 128 * SD_XP, SD_END = SD_VEC + 4096;
static_assert(SD_END <= PHASE_LDS_BYTES, "SSD LDS");
__device__ __forceinline__ void ssd_phase(LAS unsigned char* lds, const bf16* __restrict__ xcb  , const float4* __restrict__ sg, const float* __restrict__ sea,
                                          const float* __restrict__ dsk, bf16* __restrict__ yraw  , int tid, int bx, int G, const float* __restrict__ tsrc  , unsigned char* __restrict__ tdst) {
    const int lane0 = tid & 63, w = __builtin_amdgcn_readfirstlane(tid >> 6);
    const unsigned ldsb = (unsigned)(size_t)lds;
    LAS float* vec = (LAS float*)(lds + SD_VEC);
    const int hb = G >> 1;
    if (bx >= hb) for (int u = bx - hb; u < SD_UNITS; u += G - hb) {
        const int hh = u & 15, b = u >> 4, g = hh >> 3;
        const float Dk = dsk[hh];
        LBAR();
        for (int i = tid; i < 64 * SD_BP / 4; i += 512) ((LAS unsigned*)(lds + SD_H))[i] = 0u;
        for (int i = tid; i < 128 * SD_BP / 4; i += 512) ((LAS unsigned*)(lds + SD_M))[i] = 0u;
        f32x4_t hacc[4];
#pragma unroll
        for (int i = 0; i < 4; ++i) hacc[i] = (f32x4_t){0.f, 0.f, 0.f, 0.f};
        uint4 pb[4], pc[4], px[2]; float4 pg = make_float4(0.f, 0.f, 0.f, 0.f); float pea = 0.f;
#define SD_LOAD(c_) do { const size_t tb_ = (size_t)b * SEQ + (size_t)(c_) * 128; \
            _Pragma("unroll") for (int i_ = 0; i_ < 4; ++i_) { const int p_ = tid + 512 * i_, row_ = p_ >> 4, c16_ = p_ & 15; const bf16* s_ = xcb + (tb_ + row_) * 1536 + 1024 + g * 128 + c16_ * 8; pb[i_] = *(const uint4*)s_; pc[i_] = *(const uint4*)(s_ + 256); } \
            _Pragma("unroll") for (int i_ = 0; i_ < 2; ++i_) { const int p_ = tid + 512 * i_; px[i_] = *(const uint4*)(xcb + (tb_ + (p_ >> 3)) * 1536 + hh * 64 + (p_ & 7) * 8); } \
            if (tid < 128) { pg = sg[(tb_ + tid) * 16 + hh]; pea = sea[(b * 16 + hh) * 32 + (c_)]; } } while (0)
#define SD_STORE() do { _Pragma("unroll") for (int i_ = 0; i_ < 4; ++i_) { const int p_ = tid + 512 * i_, row_ = p_ >> 4, c16_ = p_ & 15; \
                *(LAS u32x4_t*)(lds + SD_B + row_ * SD_BP + c16_ * 16) = __builtin_bit_cast(u32x4_t, pb[i_]); *(LAS u32x4_t*)(lds + SD_C + row_ * SD_BP + c16_ * 16) = __builtin_bit_cast(u32x4_t, pc[i_]); } \
            _Pragma("unroll") for (int i_ = 0; i_ < 2; ++i_) { const int p_ = tid + 512 * i_; *(LAS u32x4_t*)(lds + SD_X + (p_ >> 3) * SD_XP + (p_ & 7) * 16) = __builtin_bit_cast(u32x4_t, px[i_]); } \
            if (tid < 128) { vec[640 + tid] = pg.x; vec[256 + tid] = pg.y; vec[384 + tid] = pg.z; vec[512 + tid] = pg.w; if (tid == 0) vec[769] = pea; } } while (0)
        SD_LOAD(0); SD_STORE();
        LBAR();
#pragma nounroll
        for (int c = 0; c < 32; ++c) {
            int lane = lane0; asm volatile("" : "+v"(lane));
            const int l15 = lane & 15, g4 = lane >> 4, qq = l15 >> 2, pp = lane & 3;
            if (c + 1 < 32) SD_LOAD(c + 1);
            float4 tq[4]; const size_t tgi = ((size_t)(bx - hb) * TAB_PER_WG + (size_t)c * 256) * 2 + tid;
            if (tsrc) {
#pragma unroll
                for (int j = 0; j < 4; ++j) tq[j] = ((const float4*)tsrc)[tgi * 4 + j]; }
            {
#pragma unroll
                for (int k = 0; k < 5; ++k) {
                    int li, si;
                    if (w >= 4) { li = w; si = w - 4 + k; } else if (k <= w) { li = w; si = k; } else { li = 7 - w; si = k - w - 1; }
                    if (w >= 4 || k <= 3) {
                        const int l = 16 * li + l15; const float acl = vec[256 + l];
                        f32x4_t acc = (f32x4_t){0.f, 0.f, 0.f, 0.f};
#pragma unroll
                        for (int ks = 0; ks < 4; ++ks) {
                            const bf16x8_t av = *(const LAS bf16x8_t*)(lds + SD_B + (16 * si + l15) * SD_BP + (32 * ks + 8 * g4) * 2);
                            const bf16x8_t bv = *(const LAS bf16x8_t*)(lds + SD_C + (16 * li + l15) * SD_BP + (32 * ks + 8 * g4) * 2);
                            acc = __builtin_amdgcn_mfma_f32_16x16x32_bf16(av, bv, acc, 0, 0, 0);
                        }
                        const f32x4_t acs = *(const LAS f32x4_t*)(vec + 256 + 16 * si + 4 * g4), dts = *(const LAS f32x4_t*)(vec + 640 + 16 * si + 4 * g4);
#pragma unroll
                        for (int e = 0; e < 4; ++e) { const int s = 16 * si + 4 * g4 + e; acc[e] = (s <= l) ? acc[e] * __expf(acl - acs[e]) * dts[e] : 0.f; }
                        *(LAS u32x2_t*)(lds + SD_M + l * SD_BP + (16 * si + 4 * g4) * 2) = (u32x2_t){pk2(acc[0], acc[1]), pk2(acc[2], acc[3])};
                    }
                }
            }
            LBAR();
#pragma unroll
            for (int i_ = 0; i_ < 4; ++i_) { const int p_ = tid + 512 * i_, s = p_ >> 4, c16 = p_ & 15; const float wv = vec[512 + s];
                LAS u32x4_t* bp = (LAS u32x4_t*)(lds + SD_B + s * SD_BP + c16 * 16); const u32x4_t v = *bp; u32x4_t o;
#pragma unroll
                for (int j = 0; j < 4; ++j) o[j] = pk2(__uint_as_float(v[j] << 16) * wv, __uint_as_float(v[j] & 0xffff0000u) * wv);
                *bp = o; }
            {
                const int li = w; const size_t tb = (size_t)b * SEQ + (size_t)c * 128;
                const f32x4_t eac = *(const LAS f32x4_t*)(vec + 384 + 16 * li + 4 * g4);
                bf16x8_t mf[4], cf[4];
#pragma unroll
                for (int ks = 0; ks < 4; ++ks) {
                    mf[ks] = *(const LAS bf16x8_t*)(lds + SD_M + (16 * li + l15) * SD_BP + (32 * ks + 8 * g4) * 2);
                    cf[ks] = *(const LAS bf16x8_t*)(lds + SD_C + (16 * li + l15) * SD_BP + (32 * ks + 8 * g4) * 2);
                }
#pragma unroll
                for (int pi = 0; pi < 4; ++pi) {
                    f32x4_t yd = (f32x4_t){0.f, 0.f, 0.f, 0.f}, yo = yd;
#pragma unroll
                    for (int ks = 0; ks < 4; ++ks) {
                        if (32 * ks <= 16 * li + 15) {
                            u32x2_t r0, r1; tr_read2q(ldsb + SD_X + (32 * ks + 8 * g4 + qq) * SD_XP + (16 * pi + 4 * pp) * 2, ldsb + SD_X + (32 * ks + 8 * g4 + 4 + qq) * SD_XP + (16 * pi + 4 * pp) * 2, r0, r1);
                            yd = __builtin_amdgcn_mfma_f32_16x16x32_bf16(mf[ks], mk_frag(r0, r1), yd, 0, 0, 0);
                        }
                    }
#pragma unroll
                    for (int ks = 0; ks < 4; ++ks) {
                        const bf16x8_t bh = *(const LAS bf16x8_t*)(lds + SD_H + (16 * pi + l15) * SD_BP + (32 * ks + 8 * g4) * 2);
                        yo = __builtin_amdgcn_mfma_f32_16x16x32_bf16(cf[ks], bh, yo, 0, 0, 0);
                    }
#pragma unroll
                    for (int e = 0; e < 4; ++e) { const int l = 16 * li + 4 * g4 + e;
                        const float xv = __uint_as_float(((unsigned)*(const LAS unsigned short*)(lds + SD_X + l * SD_XP + (16 * pi + l15) * 2)) << 16);
                        yraw[(tb + l) * 1024 + hh * 64 + 16 * pi + l15] = (bf16)pk2(yd[e] + eac[e] * yo[e] + Dk * xv, 0.f); }
                }
            }
            LBAR();
            {
                const float ea = vec[769];
                bf16x8_t kf[4];
#pragma unroll
                for (int ks = 0; ks < 4; ++ks) { u32x2_t a0, a1; tr_read2q(ldsb + SD_B + (32 * ks + 8 * g4 + qq) * SD_BP + (16 * w + 4 * pp) * 2, ldsb + SD_B + (32 * ks + 8 * g4 + 4 + qq) * SD_BP + (16 * w + 4 * pp) * 2, a0, a1); kf[ks] = mk_frag(a0, a1); }
#pragma unroll
                for (int pi = 0; pi < 4; ++pi) {
                    f32x4_t acc = hacc[pi] * ea;
#pragma unroll
                    for (int ks = 0; ks < 4; ++ks) {
                        u32x2_t b0, b1;
                        tr_read2q(ldsb + SD_X + (32 * ks + 8 * g4 + qq) * SD_XP + (16 * pi + 4 * pp) * 2, ldsb + SD_X + (32 * ks + 8 * g4 + 4 + qq) * SD_XP + (16 * pi + 4 * pp) * 2, b0, b1);
                        acc = __builtin_amdgcn_mfma_f32_16x16x32_bf16(kf[ks], mk_frag(b0, b1), acc, 0, 0, 0);
                    }
                    hacc[pi] = acc;
                    *(LAS u32x2_t*)(lds + SD_H + (16 * pi + l15) * SD_BP + (16 * w + 4 * g4) * 2) = (u32x2_t){pk2(acc[0], acc[1]), pk2(acc[2], acc[3])};
                }
            }
            LBAR();
            if (tsrc) tab_fp4_store(tq, tdst + tgi * 8, V4_SCALE);
            if (c + 1 < 32) SD_STORE();
            LBAR();
        }
#undef SD_LOAD
#undef SD_STORE
    }
}

constexpr int PS_SKP = 272;
constexpr int PS_SK = 0, PS_END = 2 * 128 * PS_SKP;
static_assert(PS_END <= PHASE_LDS_BYTES, "PEER select LDS");
__device__ __forceinline__ unsigned fkey(float f) { const unsigned u = __float_as_uint(f); return u ^ ((unsigned)((int)u >> 31) | 0x80000000u); }
__device__ __forceinline__ float funkey(unsigned k) { return __uint_as_float((k & 0x80000000u) ? (k ^ 0x80000000u) : ~k); }
template <int CTRL> __device__ __forceinline__ unsigned dpp_u(unsigned v) { return (unsigned)__builtin_amdgcn_update_dpp(0, (int)v, CTRL, 0xF, 0xF, true); }
__device__ __forceinline__ unsigned umax(unsigned a, unsigned b) { return a > b ? a : b; }
__device__ __forceinline__ unsigned row_umax(unsigned v) { v = umax(v, dpp_u<0xB1>(v)); v = umax(v, dpp_u<0x4E>(v)); v = umax(v, dpp_u<0x141>(v)); v = umax(v, dpp_u<0x140>(v)); return v; }
__device__ __forceinline__ float row_sum(float v) { v += dpp_f<0xB1>(v); v += dpp_f<0x4E>(v); v += dpp_f<0x141>(v); v += dpp_f<0x140>(v); return v; }
template <int N> __device__ __forceinline__ unsigned row_top16(unsigned (&s)[N], int l15) {
    unsigned mine = 0u;
#pragma unroll
    for (int j = 0; j < 16; ++j) {
        unsigned m = s[0];
#pragma unroll
        for (int i = 1; i < N; ++i) m = umax(m, s[i]);
        m = row_umax(m);
        mine = (l15 == j) ? m : mine;
#pragma unroll
        for (int i = 0; i < N; ++i) s[i] = (s[i] == m) ? 0u : s[i];
    }
    return mine;
}
__device__ __forceinline__ void ce_desc(unsigned& a, unsigned& b) { const unsigned hi = umax(a, b), lo = a < b ? a : b; a = hi; b = lo; }
__device__ __forceinline__ void sort_desc(unsigned (&s)[8]) {
    ce_desc(s[0], s[1]); ce_desc(s[2], s[3]); ce_desc(s[4], s[5]); ce_desc(s[6], s[7]);
    ce_desc(s[0], s[2]); ce_desc(s[1], s[3]); ce_desc(s[4], s[6]); ce_desc(s[5], s[7]);
    ce_desc(s[1], s[2]); ce_desc(s[5], s[6]);
    ce_desc(s[0], s[4]); ce_desc(s[1], s[5]); ce_desc(s[2], s[6]); ce_desc(s[3], s[7]);
    ce_desc(s[2], s[4]); ce_desc(s[3], s[5]);
    ce_desc(s[1], s[2]); ce_desc(s[3], s[4]); ce_desc(s[5], s[6]);
}
__device__ __forceinline__ void sort_desc(unsigned (&s)[4]) { ce_desc(s[0], s[1]); ce_desc(s[2], s[3]); ce_desc(s[0], s[2]); ce_desc(s[1], s[3]); ce_desc(s[1], s[2]); }
template <int N> __device__ __forceinline__ void row_top16x4(unsigned (&s)[4][N], int l15, unsigned (&mine)[4]) {
#pragma unroll
    for (int e = 0; e < 4; ++e) { sort_desc(s[e]); mine[e] = 0u; }
#pragma unroll
    for (int j = 0; j < 16; ++j) {
        unsigned mx[4];
#pragma unroll
        for (int e = 0; e < 4; ++e) mx[e] = s[e][0];
#pragma unroll
        for (int e = 0; e < 4; ++e) mx[e] = umax(mx[e], dpp_u<0xB1>(mx[e]));
#pragma unroll
        for (int e = 0; e < 4; ++e) mx[e] = umax(mx[e], dpp_u<0x4E>(mx[e]));
#pragma unroll
        for (int e = 0; e < 4; ++e) mx[e] = umax(mx[e], dpp_u<0x141>(mx[e]));
#pragma unroll
        for (int e = 0; e < 4; ++e) mx[e] = umax(mx[e], dpp_u<0x140>(mx[e]));
#pragma unroll
        for (int e = 0; e < 4; ++e) {
            mine[e] = (l15 == j) ? mx[e] : mine[e];
            const bool win = s[e][0] == mx[e];
#pragma unroll
            for (int i = 0; i + 1 < N; ++i) s[e][i] = win ? s[e][i + 1] : s[e][i];
            s[e][N - 1] = win ? 0u : s[e][N - 1];
        }
    }
}
__device__ __forceinline__ void peer_select_phase(LAS unsigned char* lds, const bf16* __restrict__ qb  , const bf16* __restrict__ skb  , int* __restrict__ ids, float* __restrict__ gates,
                                                  int tid, int bx, int G) {
    const int lane = tid & 63, w = __builtin_amdgcn_readfirstlane(tid >> 6), l15 = lane & 15, g4 = lane >> 4;
    int ca[4], cb[4];
#pragma unroll
    for (int i = 0; i < 4; ++i) { const int sg = 4 * l15 + i; int a = 0, base = 0;
#pragma unroll
        for (int k = 0; k < 15; ++k) { const int cnt = 16 / (k + 1); const bool adv = (a == k) && (sg >= base + cnt); base += adv ? cnt : 0; a += adv ? 1 : 0; }
        ca[i] = a; cb[i] = sg - base; if (sg >= 50) { ca[i] = -1; cb[i] = 0; } }
    for (int u = bx; u < 8 * 32; u += G) {
        const int h = u >> 5, tr = u & 31;
        LBAR();
        for (int it = tid; it < 4096; it += 512) { const int row = it >> 4, c16 = it & 15;
            *(LAS u32x4_t*)(lds + PS_SK + row * PS_SKP + c16 * 16) = __builtin_bit_cast(u32x4_t, *(const uint4*)(skb + ((size_t)h * 256 + row) * 128 + c16 * 8)); }
        LBAR();
#pragma nounroll
        for (int tile = w; tile < 64; tile += 8) {
            const int t0 = tr * 1024 + tile * 16;
            unsigned top[2][4];
#pragma unroll
            for (int c = 0; c < 2; ++c) {
                bf16x8_t af[4];
#pragma unroll
                for (int ks = 0; ks < 4; ++ks) af[ks] = __builtin_bit_cast(bf16x8_t, *(const uint4*)(qb + (size_t)(t0 + l15) * DM + h * 256 + c * 128 + 32 * ks + 8 * g4));
                unsigned key[8][4];
#pragma unroll
                for (int kt = 0; kt < 8; ++kt) {
                    f32x4_t acc = (f32x4_t){0.f, 0.f, 0.f, 0.f};
#pragma unroll
                    for (int ks = 0; ks < 4; ++ks) {
                        const bf16x8_t bfr = *(const LAS bf16x8_t*)(lds + PS_SK + (c * 128 + 16 * kt + l15) * PS_SKP + (32 * ks + 8 * g4) * 2);
                        acc = __builtin_amdgcn_mfma_f32_16x16x32_bf16(af[ks], bfr, acc, 0, 0, 0);
                    }
#pragma unroll
                    for (int e = 0; e < 4; ++e) key[kt][e] = (fkey(acc[e]) & ~0x7Fu) | (unsigned)(127 - (16 * kt + l15));
                }
                { unsigned s8[4][8];
#pragma unroll
                  for (int e = 0; e < 4; ++e)
#pragma unroll
                      for (int kt = 0; kt < 8; ++kt) s8[e][kt] = key[kt][e];
                  __builtin_amdgcn_sched_barrier(0); row_top16x4<8>(s8, l15, top[c]); __builtin_amdgcn_sched_barrier(0); }
            }
            unsigned s4[4][4], win4[4];
#pragma unroll
            for (int e = 0; e < 4; ++e)
#pragma unroll
                for (int i = 0; i < 4; ++i) {
                    const int srcA = ((lane & 48) + (ca[i] < 0 ? 0 : ca[i])) * 4, srcB = ((lane & 48) + cb[i]) * 4;
                    const unsigned ka = (unsigned)__builtin_amdgcn_ds_bpermute(srcA, (int)top[0][e]), kb = (unsigned)__builtin_amdgcn_ds_bpermute(srcB, (int)top[1][e]);
                    const float cv = funkey(ka & ~0x7Fu) + funkey(kb & ~0x7Fu);
                    s4[e][i] = ca[i] < 0 ? 0u : ((fkey(cv) & ~0xFFu) | (unsigned)(255 - (ca[i] * 16 + cb[i])));
                }
            __builtin_amdgcn_sched_barrier(0); row_top16x4<4>(s4, l15, win4); __builtin_amdgcn_sched_barrier(0);
#pragma unroll
            for (int e = 0; e < 4; ++e) {
                const unsigned win = win4[e];
                const int jw = 255 - (int)(win & 0xFFu), wa = jw >> 4, wb = jw & 15;
                const unsigned ka = (unsigned)__builtin_amdgcn_ds_bpermute(((lane & 48) + wa) * 4, (int)top[0][e]), kb = (unsigned)__builtin_amdgcn_ds_bpermute(((lane & 48) + wb) * 4, (int)top[1][e]);
                const float bv = funkey(ka & ~0x7Fu) + funkey(kb & ~0x7Fu);
                const int id = (127 - (int)(ka & 0x7Fu)) * 128 + (127 - (int)(kb & 0x7Fu));
                const float mx = __builtin_bit_cast(float, __builtin_amdgcn_ds_bpermute((lane & 48) * 4, __builtin_bit_cast(int, bv)));
                const float ex = __expf(bv - mx), den = row_sum(ex);
                const size_t o = (size_t)(t0 + 4 * g4 + e) * 128 + h * 16 + l15;
                ids[o] = id; gates[o] = ex * __builtin_amdgcn_rcpf(den);
            }
        }
    }
}

struct MegaArgs { const float* in[22]; float* out; unsigned char* ws; };
template <int I> __device__ __forceinline__ unsigned long long ld_ptr() {
    unsigned long long v; const auto ka = __builtin_amdgcn_kernarg_segment_ptr();
    asm volatile("s_load_dwordx2 %0, %1, %2\n\ts_waitcnt lgkmcnt(0)" : "=s"(v) : "s"(ka), "n"(I * 8) : "memory");
    return v;
}
#define GAS_ __attribute__((address_space(1)))
#define INF(i) ((const float*)(const GAS_ float*)ld_ptr<(i)>())
#define OUTP ((float*)(GAS_ float*)ld_ptr<22>())
#define WSP ((unsigned char*)(GAS_ unsigned char*)ld_ptr<23>())
enum { I_X = 0, I_WIN, I_MGATEB, I_MNORMW, I_CONVW, I_CONVB, I_DTB, I_ALOG, I_SSMD, I_SNORMW, I_SINKS, I_MERGEB, I_WBR, I_WOUT, I_LN1G, I_LN1B, I_WQ, I_SUBK, I_PU, I_PV, I_LN2G, I_LN2B };

__global__ void __launch_bounds__(512, 2) mega_fwd(MegaArgs a) {
    extern __shared__ __attribute__((aligned(16))) unsigned char lds_raw[];
    LAS unsigned char* lds = (LAS unsigned char*)lds_raw;
    const int wave0 = __builtin_amdgcn_readfirstlane(threadIdx.x >> 6);
    volatile LAS unsigned* MISC = (volatile LAS unsigned*)(lds + MISC_OFF);
    { PHASE_IDS for (int u = tid; u < (LDS_BYTES - PHASE_LDS_BYTES) / 4; u += 512) ((LAS unsigned*)(lds + PHASE_LDS_BYTES))[u] = 0u; }
    __syncthreads();
    { XcdBarrier b0 = xcd_barrier_post((unsigned*)(WSP + WS_CTL) + CW_BAR, MISC + 8); (void)b0; }
#define GRID_BAR() do { XcdBarrier b_; b_.bar = (unsigned*)(WSP + WS_CTL) + CW_BAR; b_.x = xb_xcc_id(); b_.st = MISC + 8; xcd_barrier(b_); } while (0)

    { PHASE_IDS float2* rt = (float2*)(WSP + WS_ROPE);
      for (size_t i = gt; i < (size_t)SEQ * 32; i += NGT) { const int pos = (int)(i >> 5), fi = (int)(i & 31); const float ang = (float)pos * powf(10000.0f, -(float)fi / 32.0f); rt[i] = make_float2(cosf(ang), sinf(ang)); } }
    { PHASE_IDS const float* x = INF(I_X); bf16* xb = (bf16*)(WSP + WS_XB);
      unsigned* xq = (unsigned*)(WSP + WS_XQ);
      for (size_t i = gt; i < (size_t)T_TOK * DM / 4; i += NGT) { const float4 v = ((const float4*)x)[i]; ((uint2*)xb)[i] = make_uint2(pk2(v.x, v.y), pk2(v.z, v.w)); xq[i] = pk4_fp8(v.x, v.y, v.z, v.w); } }

#pragma nounroll
    for (int l = 0; l < DEPTH; ++l) {
        { PHASE_IDS
            unsigned char* ws = WSP; bf16* WinT = (bf16*)(ws + WS_WIN); bf16* WbT = (bf16*)(ws + WS_WB); bf16* WoT = (bf16*)(ws + WS_WO); bf16* WqT = (bf16*)(ws + WS_WQ); float* bias = (float*)(ws + WS_BIAS);
            const float* w_in = INF(I_WIN) + (size_t)l * DM * IN_COLS; const float* w_branch = INF(I_WBR) + (size_t)l * 3 * 1024 * DM; const float* w_out = INF(I_WOUT) + (size_t)l * DM * DM; const float* peer_wq = INF(I_WQ) + (size_t)l * DM * DM;
            const float* merge_gate_b = INF(I_MERGEB) + (size_t)l * 3 * DM;
            LAS float* scr = (LAS float*)(lds + wave * 16384);
            constexpr int I_IN = (DM / 64) * (NP / 32), I_B = (1024 / 64) * (DM / 32), I_O = (DM / 64) * (DM / 32);
            constexpr int NITEMS = I_IN + 3 * I_B + 2 * I_O;
            for (int it = gw; it < NITEMS; it += NGW) {
                int r = it;
                if (r < I_IN) { transpose_item<1>(w_in, DM, IN_COLS, NP, WinT, scr, r, lane, ws + WS_WG8); continue; } r -= I_IN;
                if (r < 3 * I_B) { const int k = r / I_B; transpose_item<2>(w_branch + (size_t)k * 1024 * DM, 1024, DM, DM, nullptr, scr, r - k * I_B, lane, ws + WS_WB8 + (size_t)k * DM * 1024); continue; } r -= 3 * I_B;
                if (r < I_O) { transpose_item<2>(w_out, DM, DM, DM, nullptr, scr, r, lane, ws + WS_WO8); continue; } r -= I_O;
                transpose_item<0>(peer_wq, DM, DM, DM, WqT, scr, r, lane);
            }
            for (size_t n = gt; n < NP; n += NGT) bias[n] = (n >= C_G && n < C_SMALL) ? merge_gate_b[n - C_G] : 0.f;
            { const float4* sk = (const float4*)(INF(I_SUBK) + (size_t)l * 8 * 2 * 128 * 128); uint2* skb = (uint2*)(ws + WS_SKB);
              for (size_t n = gt; n < 8 * 2 * 128 * 128 / 4; n += NGT) { const float4 v = sk[n]; skb[n] = make_uint2(pk2(v.x, v.y), pk2(v.z, v.w)); } }
        }
        GRID_BAR();
        { PHASE_IDS unsigned char* ws = WSP; pg8::Gemm g{(const bf16*)(ws + WS_XQ), (const bf16*)(ws + WS_WG8), T_TOK, C_SMALL - 256, DM / 2}; pg8::StaticOrder S; S.init(T_TOK, C_SMALL - 256, G, bx); S.rfrom = C_AV / 256; S.rto = SMALL_TILE - 1; S.wgm = 4;
          pg8::EpiProj E{(bf16*)(ws + WS_PROJ), (const float*)(ws + WS_BIAS), (float*)(ws + WS_SMALL), NP, GATE_TILE_LO, SMALL_TILE, 0, 1.0f / WG8_SCALE};
          pg8::gemm_phase<pg8::EpiProj, pg8::StaticOrder, true, true, true>(lds, g, S, E, tid); }
        __syncthreads();
        { PHASE_IDS unsigned char* ws = WSP; pg8::Gemm g{(const bf16*)(ws + WS_XB), (const bf16*)(ws + WS_WIN), T_TOK, 512, DM}; pg8::StaticOrder S; S.init(T_TOK, 512, G, bx); S.rfrom = 0; S.rto = C_AV / 256; S.rfrom2 = 1; S.rto2 = SMALL_TILE;
          pg8::EpiProj E{(bf16*)(ws + WS_PROJ), (const float*)(ws + WS_BIAS), (float*)(ws + WS_SMALL), NP, GATE_TILE_LO, SMALL_TILE, 0, 1.0f};
          pg8::gemm_phase<pg8::EpiProj, pg8::StaticOrder, true, true>(lds, g, S, E, tid); }
        GRID_BAR();
        { PHASE_IDS unsigned char* ws = WSP; const bf16* proj = (const bf16*)(ws + WS_PROJ); bf16* xcb = (bf16*)(ws + WS_R2);
          const float* cwg = INF(I_CONVW) + (size_t)l * 4 * 1536; const float* cbg = INF(I_CONVB) + l * 1536;
          LAS float* cw = (LAS float*)(lds + 16384); LAS float* cb = cw + 4 * 1536;
          for (int n = tid; n < 4 * 1536 / 4; n += 512) { const float4 v = ((const float4*)cwg)[n]; *(LAS f32x4e_t*)(cw + 4 * n) = (f32x4e_t){v.x, v.y, v.z, v.w}; }
          for (int n = tid; n < 1536 / 4; n += 512) { const float4 v = ((const float4*)cbg)[n]; *(LAS f32x4e_t*)(cb + 4 * n) = (f32x4e_t){v.x, v.y, v.z, v.w}; }
          asm volatile("s_waitcnt lgkmcnt(0)" ::: "memory"); __builtin_amdgcn_s_barrier(); asm volatile("" ::: "memory");
          for (int i = (int)gt; i < 192 * (T_TOK / 8); i += (int)NGT) ssd_conv_item(i, proj, cw, cb, xcb); }
        { PHASE_IDS unsigned char* ws = WSP; const float* small = (const float*)(ws + WS_SMALL); LAS float* wl = (LAS float*)(lds + wave * 1024);
          for (int i = gw; i < NBATCH * 4 * 64; i += NGW) mlstm_gate_item(i, lane, wl, small, INF(I_MGATEB) + l * 8, (float4*)(ws + WS_MG), (float*)(ws + WS_MEG));
          for (int i = gw; i < NBATCH * 16 * 32; i += NGW) ssd_gate_item(i, lane, wl, small, INF(I_DTB) + l * 16, INF(I_ALOG) + l * 16, (float4*)(ws + WS_SG), (float*)(ws + WS_SEA)); }
        GRID_BAR();
        { PHASE_IDS unsigned char* ws = WSP; mlstm_phase(lds, (const bf16*)(ws + WS_PROJ), (const float4*)(ws + WS_MG), (const float*)(ws + WS_MEG), (bf16*)(ws + WS_HM), tid, bx, G, G == 256 ? INF(I_PU) + (size_t)l * P_EXPERTS * DM : nullptr, ws + WS_TAB); }
        { PHASE_IDS unsigned char* ws = WSP; ssd_phase(lds, (const bf16*)(ws + WS_R2), (const float4*)(ws + WS_SG), (const float*)(ws + WS_SEA), INF(I_SSMD) + l * 16, (bf16*)(ws + WS_R1), tid, bx, G, G == 256 ? INF(I_PV) + (size_t)l * P_EXPERTS * DM : nullptr, ws + WS_TAB + 32 * MiB); }
        { PHASE_IDS unsigned char* ws = WSP; swa_phase(lds, (const bf16*)(ws + WS_PROJ), (const float*)(ws + WS_ROPE), INF(I_SINKS) + l * 16, ws + WS_YQ + 64 * MiB, tid, bx, G); }
        GRID_BAR();
        { PHASE_IDS unsigned char* ws = WSP; const bf16* proj = (const bf16*)(ws + WS_PROJ); const bf16* hm = (const bf16*)(ws + WS_HM); unsigned char* ym = ws + WS_YQ; const float* nwg = INF(I_MNORMW) + l * 1024; const float* nsg = INF(I_SNORMW) + l * 1024;
          LAS float* nw = (LAS float*)lds; LAS float* nsl = nw + 1024;
          if (tid < 256) { const float4 v = ((const float4*)nwg)[tid]; *(LAS f32x4e_t*)(nw + 4 * tid) = (f32x4e_t){v.x, v.y, v.z, v.w}; }
          else { const float4 v = ((const float4*)nsg)[tid - 256]; *(LAS f32x4e_t*)(nsl + 4 * (tid - 256)) = (f32x4e_t){v.x, v.y, v.z, v.w}; }
          asm volatile("s_waitcnt lgkmcnt(0)" ::: "memory"); __builtin_amdgcn_s_barrier(); asm volatile("" ::: "memory");
          for (int t = gw; t < T_TOK; t += NGW) mlstm_post_tok(t, lane, hm, proj, nw, ym); }
        { PHASE_IDS unsigned char* ws = WSP; const bf16* proj = (const bf16*)(ws + WS_PROJ); const bf16* yraw = (const bf16*)(ws + WS_R1); unsigned char* ys = ws + WS_YQ + 32 * MiB; const LAS float* nw = (const LAS float*)lds + 1024;
          for (int tp = gw; tp < T_TOK / 2; tp += NGW) ssd_post_tok2(tp, lane, yraw, proj, nw, ys); }
        GRID_BAR();
        { PHASE_IDS unsigned char* ws = WSP; pg8::Gemm g{(const bf16*)(ws + WS_YQ), (const bf16*)(ws + WS_WB8), T_TOK, DM, 512}; pg8::StaticOrder S; S.init(T_TOK, DM, G, bx); S.wgm = 4;
          pg8::EpiMix<1, 0, 8, 2> E{(bf16*)(ws + WS_R1), (const bf16*)(ws + WS_PROJ) + C_G, DM, NP, nullptr};
          pg8::gemm_phase<pg8::EpiMix<1, 0, 8, 2>, pg8::StaticOrder, true, true, true>(lds, g, S, E, tid); }
        __syncthreads();
        { PHASE_IDS unsigned char* ws = WSP; pg8::Gemm g{(const bf16*)(ws + WS_YQ + 32 * MiB), (const bf16*)(ws + WS_WB8 + (size_t)DM * 1024), T_TOK, DM, 512}; pg8::StaticOrder S; S.init(T_TOK, DM, G, bx); S.wgm = 4;
          pg8::EpiMix<0, 0, 8, 2> E{(bf16*)(ws + WS_R1), (const bf16*)(ws + WS_PROJ) + C_G + DM, DM, NP, nullptr};
          pg8::gemm_phase<pg8::EpiMix<0, 0, 8, 2>, pg8::StaticOrder, true, true, true>(lds, g, S, E, tid); }
        __syncthreads();
        { PHASE_IDS unsigned char* ws = WSP; pg8::Gemm g{(const bf16*)(ws + WS_YQ + 64 * MiB), (const bf16*)(ws + WS_WB8 + (size_t)2 * DM * 1024), T_TOK, DM, 512}; pg8::StaticOrder S; S.init(T_TOK, DM, G, bx); S.wgm = 4;
          pg8::EpiMix<0, 1, 8, 2> E{(bf16*)(ws + WS_R1), (const bf16*)(ws + WS_PROJ) + C_G + 2 * DM, DM, NP, ws + WS_R1Q};
          pg8::gemm_phase<pg8::EpiMix<0, 1, 8, 2>, pg8::StaticOrder, true, true, true>(lds, g, S, E, tid); }
        GRID_BAR();
        { PHASE_IDS unsigned char* ws = WSP;
          pg8::Gemm g{(const bf16*)(ws + WS_R1Q), (const bf16*)(ws + WS_WO8), T_TOK, DM, DM / 2}; pg8::StaticOrder S; S.init(T_TOK, DM, G, bx); S.wgm = 4; pg8::EpiResidB<8> E{(bf16*)(ws + WS_XB), DM, ALPHA, 0};
          pg8::gemm_phase<pg8::EpiResidB<8>, pg8::StaticOrder, true, true, true>(lds, g, S, E, tid); }
        GRID_BAR();
        { PHASE_IDS unsigned char* ws = WSP; bf16* xb = (bf16*)(ws + WS_XB); const float* g1g = INF(I_LN1G) + l * DM; const float* b1g = INF(I_LN1B) + l * DM;
          LAS float* g1 = (LAS float*)lds; LAS float* b1 = g1 + DM;
          { const float4 v = ((const float4*)g1g)[tid], w = ((const float4*)b1g)[tid]; *(LAS f32x4e_t*)(g1 + 4 * tid) = (f32x4e_t){v.x, v.y, v.z, v.w}; *(LAS f32x4e_t*)(b1 + 4 * tid) = (f32x4e_t){w.x, w.y, w.z, w.w}; }
          asm volatile("s_waitcnt lgkmcnt(0)" ::: "memory"); __builtin_amdgcn_s_barrier(); asm volatile("" ::: "memory");
          for (int tp = gw; tp < T_TOK / 2; tp += NGW) ln_body2b(tp, lane, xb, g1, b1); }
        { PHASE_IDS unsigned char* ws = WSP; constexpr size_t NGRP = (size_t)P_EXPERTS * DM / 32;
          const float* pu = INF(I_PU) + (size_t)l * P_EXPERTS * DM; const float* pv = INF(I_PV) + (size_t)l * P_EXPERTS * DM; unsigned char* U6 = ws + WS_TAB; unsigned char* V6 = ws + WS_TAB + 32 * MiB;
          if (G != 256) for (size_t i = gt; i < NGRP; i += NGT) { tab_to_fp4(i, pu, U6, U6_SCALE); tab_to_fp4(i, pv, V6, V4_SCALE); } }
        GRID_BAR();
        { PHASE_IDS unsigned char* ws = WSP; pg8::Gemm g{(const bf16*)(ws + WS_XB), (const bf16*)(ws + WS_WQ), T_TOK, DM, DM}; pg8::StaticOrder S; S.init(T_TOK, DM, G, bx); S.wgm = 4;
          pg8::EpiProj E{(bf16*)(ws + WS_QF), nullptr, nullptr, DM, 1 << 20, -1, 0, 1.0f};
          pg8::gemm_phase<pg8::EpiProj, pg8::StaticOrder, true, true>(lds, g, S, E, tid); }
        GRID_BAR();
        { PHASE_IDS unsigned char* ws = WSP; peer_select_phase(lds, (const bf16*)(ws + WS_QF), (const bf16*)(ws + WS_SKB), (int*)(ws + WS_IDS), (float*)(ws + WS_GATES), tid, bx, G); }
        GRID_BAR();
        { PHASE_IDS unsigned char* ws = WSP; const int* ids = (const int*)(ws + WS_IDS); const float* gates = (const float*)(ws + WS_GATES);
          const unsigned char* U8 = ws + WS_TAB; const unsigned char* V8 = ws + WS_TAB + 32 * MiB;     const float* g2 = INF(I_LN2G) + l * DM; const float* b2 = INF(I_LN2B) + l * DM; float* out = OUTP; bf16* xb = (bf16*)(ws + WS_XB);
          LAS unsigned* wl = (LAS unsigned*)(lds + wave * 2048);
          LAS float* gl = (LAS float*)(lds + 16384); LAS float* bl = gl + DM;
          for (int n = tid; n < DM / 4; n += 512) { const int ln_ = n >> 3, i_ = n & 7; const float4 gv = ((const float4*)g2)[n], bv = ((const float4*)b2)[n];
              *(LAS f32x4e_t*)(gl + (i_ * 64 + ln_) * 4) = (f32x4e_t){gv.x, gv.y, gv.z, gv.w}; *(LAS f32x4e_t*)(bl + (i_ * 64 + ln_) * 4) = (f32x4e_t){bv.x, bv.y, bv.z, bv.w}; }
          asm volatile("s_waitcnt lgkmcnt(0)" ::: "memory"); __builtin_amdgcn_s_barrier(); asm volatile("" ::: "memory");
          for (int t = gw; t < T_TOK; t += NGW) peer_expert_body(t, lane, l == DEPTH - 1, ids, gates, U8, V8, gl, bl, out, xb, ws + WS_XQ, wl); }
        GRID_BAR();
    }
#undef GRID_BAR
}

extern "C" void kernel_launch(void* const* d_in, const int* in_sizes, int n_in, void* d_out, int out_size, void* d_ws, size_t ws_size, hipStream_t stream) {
    static int grid = 0;
    if (grid == 0) {
        if (n_in != 22 || out_size != T_TOK * DM || ws_size < WS_END) { fprintf(stderr, "kernel_launch: unexpected shapes (n_in %d, out %d, ws %zu)\n", n_in, out_size, ws_size); grid = -1; return; }
        int dev = 0, cus = 0, per_cu = 0;
        if (hipGetDevice(&dev) != hipSuccess || hipDeviceGetAttribute(&cus, hipDeviceAttributeMultiprocessorCount, dev) != hipSuccess) { grid = -1; return; }
        if (hipFuncSetAttribute((const void*)mega_fwd, hipFuncAttributeMaxDynamicSharedMemorySize, LDS_BYTES) != hipSuccess) { fprintf(stderr, "kernel_launch: hipFuncSetAttribute failed\n"); grid = -1; return; }
        if (hipOccupancyMaxActiveBlocksPerMultiprocessor(&per_cu, (const void*)mega_fwd, 512, LDS_BYTES) != hipSuccess || per_cu < 1) { fprintf(stderr, "kernel_launch: occupancy query says %d blocks per CU\n", per_cu); (void)hipGetLastError(); grid = -1; return; }
        grid = cus;
    }
    if (grid < 0) return;
    (void)hipMemsetAsync((char*)d_ws + WS_CTL, 0, CTL_ZERO_BYTES, stream);
    MegaArgs a; memset(&a, 0, sizeof(a));
    for (int i = 0; i < 22; ++i) a.in[i] = (const float*)d_in[i];
    a.out = (float*)d_out; a.ws = (unsigned char*)d_ws;
    hipLaunchKernelGGL(mega_fwd, dim3(grid), dim3(512), LDS_BYTES, stream, a);
}
```

```cpp
#include <hip/hip_runtime.h>
#include <cstdio>
#include <cstdint>
#include <cstring>

namespace pg8 {
#define PG8_LAS __attribute__((address_space(3)))
typedef unsigned short bf16_t;
typedef short bf16x8 __attribute__((ext_vector_type(8)));
typedef float f32x4 __attribute__((ext_vector_type(4)));
typedef unsigned u32x4 __attribute__((ext_vector_type(4)));
typedef unsigned u32x2 __attribute__((ext_vector_type(2)));
constexpr int BM = 256, BK = 64, HALF = 128, HTB = HALF * BK * 2  , STAGE_BYTES = 8 * HTB, NXCD = 8, WGM = 8;

__host__ __device__ __forceinline__ int lds_byte(int r, int c) { const int st = (r >> 4) * 2 + (c >> 5), rr = r & 15, cc = c & 31, ob = rr * 64 + cc * 2; return st * 1024 + (ob ^ (((ob >> 9) & 1) << 5)); }
__host__ __device__ __forceinline__ void stage_rc(int b, int& R, int& C) { const int st = b / 1024, sb = b % 1024, swz = sb ^ (((sb >> 9) & 1) << 5); R = (st >> 1) * 16 + swz / 64; C = (st & 1) * 32 + (swz % 64) / 2; }
__host__ __device__ __forceinline__ int perm32(int rho) { const int n = rho >> 4, i = rho & 15; return 8 * (i >> 2) + 4 * n + (i & 3); }

struct Unit { int pm, pn; };
struct Gemm { const bf16_t* A; const bf16_t* Bt; int M, N, K; };

typedef int i32x4 __attribute__((ext_vector_type(4)));
typedef int i32x8 __attribute__((ext_vector_type(8)));
struct StaticOrder {
    int nM, nN, nwg, G, c, rfrom, rto, rfrom2, rto2, i0, i1, wgm;
    __host__ __device__ void init(int M, int N, int G_, int c_) { nM = M / BM; nN = N / BM; nwg = nM * nN; G = G_; c = c_; rfrom = -1; rto = -1; rfrom2 = -1; rto2 = -1; i0 = 0; i1 = 1 << 30; wgm = WGM; }
    __host__ __device__ bool next(int i, Unit& u) const {
        if (i + i0 >= i1) return false;
        const long L = (long)(i + i0) * G + c; if (L >= nwg) return false;
        int wgid = (int)L; { const int q = nwg / NXCD, r = nwg % NXCD, xcd = wgid % NXCD, off = wgid / NXCD; wgid = (xcd < r ? xcd * (q + 1) : r * (q + 1) + (xcd - r) * q) + off; }
        const int nig = wgm * nN, gid = wgid / nig, fm = gid * wgm, gsz = (nM - fm) < wgm ? (nM - fm) : wgm;
        u.pm = fm + ((wgid % nig) % gsz); u.pn = (wgid % nig) / gsz; if (u.pn == rfrom) u.pn = rto; else if (u.pn == rfrom2) u.pn = rto2; return true;
    }
    __device__ __forceinline__ void a_ready(const Unit&) const {}
    __device__ __forceinline__ void done(const Unit&) const {}
};

typedef float cvt2f_t __attribute__((ext_vector_type(2)));
typedef __bf16 cvt2b_t __attribute__((ext_vector_type(2)));
__device__ __forceinline__ unsigned cvt_pk_bf16(float lo, float hi) { const cvt2f_t f = {lo, hi}; return __builtin_bit_cast(unsigned, __builtin_convertvector(f, cvt2b_t)); }
typedef float f32x2 __attribute__((ext_vector_type(2)));
__device__ __forceinline__ float bf_lo(unsigned w) { return __uint_as_float(w << 16); }
__device__ __forceinline__ float bf_hi(unsigned w) { return __uint_as_float(w & 0xffff0000u); }
__device__ __forceinline__ unsigned cvt_pk4_fp8(float a, float b, float c, float d) { int p = __builtin_amdgcn_cvt_pk_fp8_f32(a, b, 0, false); p = __builtin_amdgcn_cvt_pk_fp8_f32(c, d, p, true); return (unsigned)p; }
__device__ __forceinline__ float sigmoidf_(float x) { return __builtin_amdgcn_rcpf(1.0f + __expf(-x)); }

struct EpiF32 {
    static constexpr bool PERM = false, AFTER_DRAIN = false;
    float* C; int ldc; int pad;
    __device__ __forceinline__ void operator()(const f32x4 (&acc)[2][2][4][2], const Unit& u, int wr, int wc, int fr, int fq) const {
        const int row0 = u.pm * BM + wr * 64 + fr, col0 = u.pn * BM + wc * 32 + 4 * fq;
#pragma unroll
        for (int ai = 0; ai < 2; ++ai)
#pragma unroll
            for (int m = 0; m < 4; ++m) { float* rowp = C + (size_t)(row0 + ai * HALF + m * 16) * ldc + col0;
#pragma unroll
                for (int bj = 0; bj < 2; ++bj)
#pragma unroll
                    for (int n = 0; n < 2; ++n) *(f32x4*)(rowp + bj * HALF + n * 16) = acc[ai][bj][m][n]; }
    }
};
struct EpiResid {
    static constexpr bool PERM = false, AFTER_DRAIN = false;
    float* C; const float* X; int ldc; float alpha;
    __device__ __forceinline__ void operator()(const f32x4 (&acc)[2][2][4][2], const Unit& u, int wr, int wc, int fr, int fq) const {
        const int row0 = u.pm * BM + wr * 64 + fr, col0 = u.pn * BM + wc * 32 + 4 * fq;
#pragma unroll
        for (int ai = 0; ai < 2; ++ai)
#pragma unroll
            for (int m = 0; m < 4; ++m) { const size_t off = (size_t)(row0 + ai * HALF + m * 16) * ldc + col0;
#pragma unroll
                for (int bj = 0; bj < 2; ++bj)
#pragma unroll
                    for (int n = 0; n < 2; ++n) { const f32x4 xv = *(const f32x4*)(X + off + bj * HALF + n * 16);
                        *(f32x4*)(C + off + bj * HALF + n * 16) = acc[ai][bj][m][n] + xv * alpha; } }
    }
};
template <int ASH = 0> struct EpiResidB {
    static constexpr bool PERM = true, AFTER_DRAIN = false;
    static constexpr float ascale = 1.0f / (float)(1 << ASH);
    bf16_t* O; int ldc; float alpha; int pad;
    __device__ __forceinline__ void operator()(const f32x4 (&acc)[2][2][4][2], const Unit& u, int wr, int wc, int fr, int fq) const {
        const int row0 = u.pm * BM + wr * 64 + fr, col0 = u.pn * BM + wc * 32 + 8 * fq;
#pragma unroll
        for (int ai = 0; ai < 2; ++ai) {
            u32x4 ow[4][2];
#pragma unroll
            for (int m = 0; m < 4; ++m)
#pragma unroll
                for (int bj = 0; bj < 2; ++bj) ow[m][bj] = *(const u32x4*)(O + (size_t)(row0 + ai * HALF + m * 16) * ldc + col0 + bj * HALF);
#pragma unroll
            for (int m = 0; m < 4; ++m) { bf16_t* rowp = O + (size_t)(row0 + ai * HALF + m * 16) * ldc + col0;
#pragma unroll
                for (int bj = 0; bj < 2; ++bj) { const u32x4 o = ow[m][bj];
                    const f32x4 a0 = acc[ai][bj][m][0], a1 = acc[ai][bj][m][1];
                    const float r0 = bf_lo(o.x) * alpha + a0[0] * ascale, r1 = bf_hi(o.x) * alpha + a0[1] * ascale, r2 = bf_lo(o.y) * alpha + a0[2] * ascale, r3 = bf_hi(o.y) * alpha + a0[3] * ascale;
                    const float r4 = bf_lo(o.z) * alpha + a1[0] * ascale, r5 = bf_hi(o.z) * alpha + a1[1] * ascale, r6 = bf_lo(o.w) * alpha + a1[2] * ascale, r7 = bf_hi(o.w) * alpha + a1[3] * ascale;
                    u32x4 w; w.x = cvt_pk_bf16(r0, r1); w.y = cvt_pk_bf16(r2, r3); w.z = cvt_pk_bf16(r4, r5); w.w = cvt_pk_bf16(r6, r7);
                    *(u32x4*)(rowp + bj * HALF) = w; } }
        }
    }
};
struct EpiProj {
    static constexpr bool PERM = true, AFTER_DRAIN = false;
    bf16_t* O; const float* bias; float* small; int ldc; int gate_lo; int small_tile; int pn_off; float ascale;
    __device__ __forceinline__ void operator()(const f32x4 (&acc)[2][2][4][2], const Unit& u, int wr, int wc, int fr, int fq) const {
        const int pn = u.pn + pn_off; const int row0 = u.pm * BM + wr * 64 + fr, col0 = pn * BM + wc * 32 + 8 * fq;
        if (pn == small_tile) {
            if (wc == 0) {
#pragma unroll
                for (int ai = 0; ai < 2; ++ai)
#pragma unroll
                    for (int m = 0; m < 4; ++m) { float* p = small + (size_t)(row0 + ai * HALF + m * 16) * 32 + 8 * fq;
                        *(f32x4*)p = acc[ai][0][m][0]; *(f32x4*)(p + 4) = acc[ai][0][m][1]; }
            }
            return;
        }
        const bool gate = pn >= gate_lo;
        f32x4 bv[2][2];
#pragma unroll
        for (int bj = 0; bj < 2; ++bj)
#pragma unroll
            for (int n = 0; n < 2; ++n) bv[bj][n] = gate ? *(const f32x4*)(bias + col0 + bj * HALF + 4 * n) : (f32x4){0.f, 0.f, 0.f, 0.f};
#pragma unroll
        for (int ai = 0; ai < 2; ++ai)
#pragma unroll
            for (int m = 0; m < 4; ++m) { bf16_t* rowp = O + (size_t)(row0 + ai * HALF + m * 16) * ldc + col0;
#pragma unroll
                for (int bj = 0; bj < 2; ++bj) { f32x4 v0 = acc[ai][bj][m][0] * ascale + bv[bj][0], v1 = acc[ai][bj][m][1] * ascale + bv[bj][1];
                    if (gate) {
#pragma unroll
                        for (int j = 0; j < 4; ++j) { v0[j] = sigmoidf_(v0[j]); v1[j] = sigmoidf_(v1[j]); } }
                    u32x4 w; w.x = cvt_pk_bf16(v0[0], v0[1]); w.y = cvt_pk_bf16(v0[2], v0[3]); w.z = cvt_pk_bf16(v1[0], v1[1]); w.w = cvt_pk_bf16(v1[2], v1[3]);
                    *(u32x4*)(rowp + bj * HALF) = w; } }
    }
};
template <int FIRST, int LASTQ = 0, int ASH = 0, int QSH = 0> struct EpiMix {
    static constexpr bool PERM = true, AFTER_DRAIN = false;
    static constexpr float ascale = 1.0f / (float)(1 << ASH), qscale = (float)(1 << QSH);
    bf16_t* O; const bf16_t* G; int ldc; int ldg; unsigned char* Q;
    __device__ __forceinline__ void operator()(const f32x4 (&acc)[2][2][4][2], const Unit& u, int wr, int wc, int fr, int fq) const {
        const int row0 = u.pm * BM + wr * 64 + fr, col0 = u.pn * BM + wc * 32 + 8 * fq;
#pragma unroll
        for (int ai = 0; ai < 2; ++ai) {
            u32x4 gwv[4][2], owv[4][2];
#pragma unroll
            for (int m = 0; m < 4; ++m)
#pragma unroll
                for (int bj = 0; bj < 2; ++bj) { const int row = row0 + ai * HALF + m * 16;
                    gwv[m][bj] = *(const u32x4*)(G + (size_t)row * ldg + col0 + bj * HALF);
                    owv[m][bj] = (u32x4){0u, 0u, 0u, 0u}; if (!FIRST) owv[m][bj] = *(const u32x4*)(O + (size_t)row * ldc + col0 + bj * HALF); }
#pragma unroll
            for (int m = 0; m < 4; ++m) { const int row = row0 + ai * HALF + m * 16; bf16_t* rowp = O + (size_t)row * ldc + col0;
#pragma unroll
                for (int bj = 0; bj < 2; ++bj) { const u32x4 gw = gwv[m][bj], ow = owv[m][bj];
                    const f32x4 a0 = acc[ai][bj][m][0] * ascale, a1 = acc[ai][bj][m][1] * ascale;
                    float r0 = bf_lo(ow.x) + bf_lo(gw.x) * a0[0], r1 = bf_hi(ow.x) + bf_hi(gw.x) * a0[1], r2 = bf_lo(ow.y) + bf_lo(gw.y) * a0[2], r3 = bf_hi(ow.y) + bf_hi(gw.y) * a0[3];
                    float r4 = bf_lo(ow.z) + bf_lo(gw.z) * a1[0], r5 = bf_hi(ow.z) + bf_hi(gw.z) * a1[1], r6 = bf_lo(ow.w) + bf_lo(gw.w) * a1[2], r7 = bf_hi(ow.w) + bf_hi(gw.w) * a1[3];
                    if constexpr (LASTQ) { *(u32x2*)(Q + (size_t)row * ldc + col0 + bj * HALF) = (u32x2){cvt_pk4_fp8(r0 * qscale, r1 * qscale, r2 * qscale, r3 * qscale), cvt_pk4_fp8(r4 * qscale, r5 * qscale, r6 * qscale, r7 * qscale)}; }
                    else { u32x4 w; w.x = cvt_pk_bf16(r0, r1); w.y = cvt_pk_bf16(r2, r3); w.z = cvt_pk_bf16(r4, r5); w.w = cvt_pk_bf16(r6, r7);
                        *(u32x4*)(rowp + bj * HALF) = w; } } }
        }
    }
};
template <class Epi, class Sched, bool ALIGN_EPI = false, bool SP2 = false, bool FP8 = false>
__device__ __forceinline__ void gemm_phase(PG8_LAS unsigned char* lds, const Gemm g, const Sched& S, const Epi& E, int tid_) {
    asm volatile("" : "+v"(tid_));
    const int tid = tid_, wid = __builtin_amdgcn_readfirstlane(tid >> 6), lane = tid & 63, wr = wid >> 2, wc = wid & 3, fr = lane & 15, fq = lane >> 4;
    const int K = g.K, nt = K / BK;
    unsigned voffA[2], voffB[2];
#pragma unroll
    for (int i = 0; i < 2; ++i) { int R, C; stage_rc(tid * 16 + i * 8192, R, C); const int Rb = Epi::PERM ? ((R & ~31) + perm32(R & 31)) : R;
        voffA[i] = (unsigned)(R * K + C) * 2u; voffB[i] = (unsigned)(Rb * K + C) * 2u; }
    const size_t kstep = (size_t)(BK * 2);
    const size_t hstep = (size_t)HALF * K * 2;
    const size_t tstep = 2 * hstep;
    const unsigned ldsw = (unsigned)wid * 1024u;
    const int aoff = lds_byte(wr * 64 + fr, fq * 8), boff = lds_byte(wc * 32 + fr, fq * 8);
#define PG8_SA(b, h) (((b) * 2 + (h)) * HTB)
#define PG8_SB(b, h) ((4 + (b) * 2 + (h)) * HTB)
#define PG8_STAGE(bufoff, gbase, voff) do { _Pragma("unroll") for (int _i = 0; _i < 2; ++_i) \
        __builtin_amdgcn_global_load_lds((const unsigned*)((const char*)(gbase) + (voff)[_i]), (PG8_LAS unsigned*)(lds + (bufoff) + ldsw + _i * 8192), 16, 0, 0); } while (0)
#define PG8_LDA(dst, b, h) do { _Pragma("unroll") for (int m = 0; m < 4; ++m) _Pragma("unroll") for (int k = 0; k < 2; ++k) dst[m][k] = *(const PG8_LAS bf16x8*)(lds + PG8_SA(b, h) + aoff + m * 2048 + k * 1024); } while (0)
#define PG8_LDB(dst, b, h) do { _Pragma("unroll") for (int n = 0; n < 2; ++n) _Pragma("unroll") for (int k = 0; k < 2; ++k) dst[n][k] = *(const PG8_LAS bf16x8*)(lds + PG8_SB(b, h) + boff + n * 2048 + k * 1024); } while (0)
#define PG8_CAT(lo, hi) ((i32x8){__builtin_bit_cast(i32x4, lo)[0], __builtin_bit_cast(i32x4, lo)[1], __builtin_bit_cast(i32x4, lo)[2], __builtin_bit_cast(i32x4, lo)[3], __builtin_bit_cast(i32x4, hi)[0], __builtin_bit_cast(i32x4, hi)[1], __builtin_bit_cast(i32x4, hi)[2], __builtin_bit_cast(i32x4, hi)[3]})
#define PG8_MMA(ai, bj, At, Bt) do { __builtin_amdgcn_s_setprio(1); _Pragma("unroll") for (int m = 0; m < 4; ++m) _Pragma("unroll") for (int n = 0; n < 2; ++n) { \
        if constexpr (FP8) { asm volatile("v_mfma_scale_f32_16x16x128_f8f6f4 %0, %1, %2, %0, %3, %3 op_sel_hi:[0,0,0]" : "+v"(acc[ai][bj][m][n]) : "v"(PG8_CAT(Bt[n][0], Bt[n][1])), "v"(PG8_CAT(At[m][0], At[m][1])), "v"(fp8_unit_scale)); } \
        else { _Pragma("unroll") for (int k = 0; k < 2; ++k) acc[ai][bj][m][n] = __builtin_amdgcn_mfma_f32_16x16x32_bf16(Bt[n][k], At[m][k], acc[ai][bj][m][n], 0, 0, 0); } } \
        __builtin_amdgcn_s_setprio(0); } while (0)
#define PG8_WAIT_V(n) asm volatile("s_waitcnt vmcnt(" #n ")" ::: "memory")
#define PG8_WAIT_L(n) asm volatile("s_waitcnt lgkmcnt(" #n ")" ::: "memory")
#define PG8_BAR __builtin_amdgcn_s_barrier()
#define PG8_SCHED __builtin_amdgcn_sched_barrier(0)
    Unit cur, nxt; int ui = 0;
    [[maybe_unused]] int fp8_unit_scale = 0x7F7F7F7F;
    if constexpr (FP8) asm volatile("" : "+v"(fp8_unit_scale));
    if (!S.next(0, cur)) return;
    f32x4 acc[2][2][4][2];
#pragma unroll
    for (int a = 0; a < 2; ++a)
#pragma unroll
        for (int b = 0; b < 2; ++b)
#pragma unroll
            for (int m = 0; m < 4; ++m)
#pragma unroll
                for (int n = 0; n < 2; ++n) acc[a][b][m][n] = (f32x4){0.f, 0.f, 0.f, 0.f};
    bf16x8 At[4][2], B0[2][2], B1[2][2];
    const char* cA = (const char*)g.A + (size_t)cur.pm * tstep; const char* cB = (const char*)g.Bt + (size_t)cur.pn * tstep;
    S.a_ready(cur);
    if constexpr (SP2) {
        PG8_STAGE(PG8_SB(0, 0), cB, voffB); PG8_STAGE(PG8_SB(0, 1), cB + hstep, voffB); PG8_STAGE(PG8_SA(0, 0), cA, voffA); PG8_STAGE(PG8_SA(0, 1), cA + hstep, voffA);
        if (wr == 1) PG8_BAR;
        PG8_WAIT_V(2); PG8_BAR;
        PG8_STAGE(PG8_SB(1, 0), cB + kstep, voffB); PG8_STAGE(PG8_SA(1, 0), cA + kstep, voffA); PG8_STAGE(PG8_SB(1, 1), cB + hstep + kstep, voffB);
        PG8_WAIT_V(6); PG8_BAR;
    } else {
        PG8_STAGE(PG8_SB(0, 0), cB, voffB); PG8_STAGE(PG8_SA(0, 0), cA, voffA); PG8_STAGE(PG8_SB(0, 1), cB + hstep, voffB); PG8_STAGE(PG8_SA(0, 1), cA + hstep, voffA);
        if (wr == 1) PG8_BAR;
        PG8_WAIT_V(4); PG8_BAR;
        PG8_STAGE(PG8_SB(1, 0), cB + kstep, voffB); PG8_STAGE(PG8_SA(1, 0), cA + kstep, voffA); PG8_STAGE(PG8_SB(1, 1), cB + hstep + kstep, voffB);
        PG8_WAIT_V(6); PG8_BAR;
    }
    for (;;) {
        const bool has_next = S.next(ui + 1, nxt);
        const char* nA = has_next ? (const char*)g.A + (size_t)nxt.pm * tstep : cA; const char* nB = has_next ? (const char*)g.Bt + (size_t)nxt.pn * tstep : cB;
        for (int t = 0; t < nt; t += 2) {
            const bool last = (t == nt - 2);
            const char* a1 = cA + (size_t)(t + 1) * kstep;
            const char* a2 = last ? nA : cA + (size_t)(t + 2) * kstep; const char* b2 = last ? nB : cB + (size_t)(t + 2) * kstep;
            const char* a3 = a2 + kstep; const char* b3 = b2 + kstep;
            if (last && has_next) S.a_ready(nxt);
            if constexpr (SP2) {
            PG8_LDB(B0, 0, 0); PG8_LDB(B1, 0, 1); PG8_SCHED; PG8_LDA(At, 0, 0); PG8_STAGE(PG8_SA(1, 1), a1 + hstep, voffA);
            PG8_WAIT_V(8); PG8_WAIT_L(0); PG8_BAR; PG8_MMA(0, 0, At, B0); PG8_MMA(0, 1, At, B1); PG8_BAR; PG8_SCHED;
            PG8_LDA(At, 0, 1); PG8_STAGE(PG8_SB(0, 0), b2, voffB); PG8_STAGE(PG8_SB(0, 1), b2 + hstep, voffB); PG8_STAGE(PG8_SA(0, 0), a2, voffA);
            PG8_WAIT_V(8); PG8_WAIT_L(0); PG8_BAR; PG8_MMA(1, 0, At, B0); PG8_MMA(1, 1, At, B1); PG8_BAR; PG8_SCHED;
            PG8_LDB(B0, 1, 0); PG8_LDB(B1, 1, 1); PG8_SCHED; PG8_LDA(At, 1, 0); PG8_STAGE(PG8_SA(0, 1), a2 + hstep, voffA);
            PG8_WAIT_V(8); PG8_WAIT_L(0); PG8_BAR; PG8_MMA(0, 0, At, B0); PG8_MMA(0, 1, At, B1); PG8_BAR; PG8_SCHED;
            PG8_LDA(At, 1, 1); PG8_STAGE(PG8_SB(1, 0), b3, voffB); PG8_STAGE(PG8_SB(1, 1), b3 + hstep, voffB); PG8_STAGE(PG8_SA(1, 0), a3, voffA);
            PG8_WAIT_V(8); PG8_WAIT_L(0); PG8_BAR; PG8_MMA(1, 0, At, B0); PG8_MMA(1, 1, At, B1); PG8_BAR; PG8_SCHED;
            } else {
            PG8_LDB(B0, 0, 0); PG8_SCHED; PG8_LDA(At, 0, 0); PG8_STAGE(PG8_SA(1, 1), a1 + hstep, voffA);
            PG8_WAIT_L(8); PG8_BAR; PG8_WAIT_L(0); PG8_MMA(0, 0, At, B0); PG8_BAR; PG8_SCHED;
            PG8_LDB(B1, 0, 1); PG8_STAGE(PG8_SB(0, 0), b2, voffB);
            PG8_BAR; PG8_WAIT_L(0); PG8_MMA(0, 1, At, B1); PG8_BAR;
            PG8_LDA(At, 0, 1); PG8_STAGE(PG8_SA(0, 0), a2, voffA);
            PG8_BAR; PG8_WAIT_L(0); PG8_MMA(1, 0, At, B0); PG8_BAR; PG8_SCHED;
            PG8_STAGE(PG8_SB(0, 1), b2 + hstep, voffB);
            PG8_WAIT_V(6); PG8_BAR; PG8_MMA(1, 1, At, B1); PG8_BAR;
            PG8_LDB(B0, 1, 0); PG8_SCHED; PG8_LDA(At, 1, 0); PG8_STAGE(PG8_SA(0, 1), a2 + hstep, voffA);
            PG8_WAIT_L(8); PG8_BAR; PG8_WAIT_L(0); PG8_MMA(0, 0, At, B0); PG8_BAR; PG8_SCHED;
            PG8_LDB(B1, 1, 1); PG8_STAGE(PG8_SB(1, 0), b3, voffB);
            PG8_BAR; PG8_WAIT_L(0); PG8_MMA(0, 1, At, B1); PG8_BAR;
            PG8_LDA(At, 1, 1); PG8_STAGE(PG8_SA(1, 0), a3, voffA);
            PG8_BAR; PG8_WAIT_L(0); PG8_MMA(1, 0, At, B0); PG8_BAR; PG8_SCHED;
            PG8_STAGE(PG8_SB(1, 1), b3 + hstep, voffB);
            PG8_WAIT_V(6); PG8_BAR; PG8_MMA(1, 1, At, B1); PG8_BAR;
            }
        }
        if constexpr (FP8) asm volatile("s_nop 15\n\ts_nop 15\n\ts_nop 15" ::: "memory");
        if constexpr (ALIGN_EPI) { if (wr == 0) PG8_BAR; }
        if constexpr (!Epi::AFTER_DRAIN) { E(acc, cur, wr, wc, fr, fq); S.done(cur); }
        if (!has_next) break;
#pragma unroll
        for (int a = 0; a < 2; ++a)
#pragma unroll
            for (int b = 0; b < 2; ++b)
#pragma unroll
                for (int m = 0; m < 4; ++m)
#pragma unroll
                    for (int n = 0; n < 2; ++n) acc[a][b][m][n] = (f32x4){0.f, 0.f, 0.f, 0.f};
        cur = nxt; cA = nA; cB = nB; ++ui;
        if constexpr (ALIGN_EPI) { if (wr == 1) PG8_BAR; }
    }
    PG8_WAIT_V(0);
    if constexpr (!ALIGN_EPI) { if (wr == 0) PG8_BAR; }
    PG8_BAR;
    if constexpr (Epi::AFTER_DRAIN) { E.fused(acc, cur, wr, wc, fr, fq, lds, wid, lane); S.done(cur); }
#undef PG8_SA
#undef PG8_SB
#undef PG8_STAGE
#undef PG8_LDA
#undef PG8_LDB
#undef PG8_MMA
#undef PG8_CAT
#undef PG8_WAIT_V
#undef PG8_WAIT_L
#undef PG8_BAR
#undef PG8_SCHED
}
}
typedef unsigned short bf16;
#define LAS __attribute__((address_space(3)))
constexpr int T_TOK = 32768, DM = 2048, SEQ = 4096, NBATCH = 8, DEPTH = 4;
constexpr int IN_COLS = 13336, NP = 13568;
constexpr int C_MQ = 0, C_MK = 512, C_MV = 1024, C_MO = 2048, C_SZ = 3072, C_SXBC = 4096, C_AQ = 5632, C_AK = 6656, C_AV = 6912, C_G = 7168, C_SMALL = 13312;
constexpr int GATE_TILE_LO = C_G / 256, SMALL_TILE = C_SMALL / 256;
constexpr float ALPHA = 1.681792830507429f;
constexpr int P_EXPERTS = 16384;

constexpr size_t MiB = 1u << 20;
constexpr size_t WS_CTL = 0, CTL_ZERO_BYTES = 64 * 1024, WS_WIN = 1 * MiB, WS_WB = 54 * MiB, WS_WO = 66 * MiB, WS_WQ = 74 * MiB, WS_BIAS = 82 * MiB, WS_SKB = 82 * MiB + 256 * 1024, WS_SMALL = 83 * MiB, WS_ROPE = 87 * MiB,
                 WS_TAB = 1480 * MiB  , WS_XB = 88 * MiB, WS_XQ = 216 * MiB  , WS_WG8 = 280 * MiB  , WS_WB8 = 306 * MiB  , WS_YQ = 312 * MiB  , WS_R1Q = 408 * MiB  , WS_WO8 = 54 * MiB  , WS_PROJ = 472 * MiB, WS_R1 = 1320 * MiB, WS_Y = 1480 * MiB, WS_R2 = 1672 * MiB, WS_HM = 1864 * MiB, WS_END = 1992 * MiB;
constexpr size_t WS_QF = WS_PROJ, WS_IDS = WS_PROJ + 256 * MiB, WS_GATES = WS_PROJ + 272 * MiB;
constexpr int CW_BAR = 4096;
constexpr int RING_BYTES = 131072, PHASE_LDS_BYTES = 155648, MISC_OFF = PHASE_LDS_BYTES + 320, LDS_BYTES = 163840;

__device__ __forceinline__ unsigned f2bf(float f) { unsigned u = __float_as_uint(f); return (u + 0x7fffu + ((u >> 16) & 1u)) >> 16; }
typedef float f32x4e_t __attribute__((ext_vector_type(4)));
typedef float pk2f_t __attribute__((ext_vector_type(2)));
typedef __bf16 pk2b_t __attribute__((ext_vector_type(2)));
__device__ __forceinline__ unsigned pk2(float lo, float hi) { const pk2f_t f = {lo, hi}; return __builtin_bit_cast(unsigned, __builtin_convertvector(f, pk2b_t)); }
__device__ __forceinline__ unsigned pk4_fp8(float a, float b, float c, float d) { int p = __builtin_amdgcn_cvt_pk_fp8_f32(a, b, 0, false); p = __builtin_amdgcn_cvt_pk_fp8_f32(c, d, p, true); return (unsigned)p; }
constexpr float ACT8_SCALE = 4.0f;
static_assert(ACT8_SCALE == 4.0f, "epilogue shifts");
constexpr float WG8_SCALE = 64.0f;
__device__ __forceinline__ float bf2f(bf16 b) { return __uint_as_float(((unsigned)b) << 16); }
__device__ __forceinline__ float sigm(float x) { return __builtin_amdgcn_rcpf(1.0f + __expf(-x)); }
__device__ __forceinline__ void halves32(float& lo, float& hi) { asm volatile("s_nop 1\n\tv_permlane32_swap_b32 %0, %1" : "+v"(lo), "+v"(hi)); }
template <int CTRL> __device__ __forceinline__ float dpp_f(float v) { return __builtin_bit_cast(float, __builtin_amdgcn_update_dpp(0, __builtin_bit_cast(int, v), CTRL, 0xF, 0xF, true)); }
__device__ __forceinline__ float quad_sum(float v) { v += dpp_f<0xB1>(v); v += dpp_f<0x4E>(v); return v; }
__device__ __forceinline__ float wave_sum(float v) {
    v = quad_sum(v); v += dpp_f<0x141>(v); v += dpp_f<0x140>(v);
    v += __builtin_bit_cast(float, __builtin_amdgcn_ds_swizzle(__builtin_bit_cast(int, v), 0x401F));
    return __builtin_bit_cast(float, __builtin_amdgcn_readlane(__builtin_bit_cast(int, v), 0)) + __builtin_bit_cast(float, __builtin_amdgcn_readlane(__builtin_bit_cast(int, v), 32));
}
__device__ __forceinline__ int src_col(int n) {
    if (n < 3072) return n;
    if (n < 5632) return n + 8;
    if (n < 13312) return n + 24;
    if (n < 13320) return 3072 + (n - 13312);
    if (n < 13336) return 5640 + (n - 13320);
    return -1;
}

#define XB_TMO      128
#define XB_XCNT(j)  (256  + 64 * (j))
#define XB_XSUB(j)  (1280 + 64 * (j))
#define XB_XGEN(j)  (2304 + 64 * (j))
#define XB_TOP      3328
#define XB_TOPGEN   3392
#define XCD_BAR_WORDS 3456
#define XB_SPIN_CAP (1u << 18)

__device__ __forceinline__ unsigned xb_ld(unsigned* p)              { return __hip_atomic_load(p, __ATOMIC_RELAXED, __HIP_MEMORY_SCOPE_AGENT); }
__device__ __forceinline__ unsigned xb_add(unsigned* p, unsigned v) { return __hip_atomic_fetch_add(p, v, __ATOMIC_RELAXED, __HIP_MEMORY_SCOPE_AGENT); }
__device__ __forceinline__ unsigned xb_xcc_id() { return (unsigned)__builtin_amdgcn_s_getreg((3 << 11) | 20) & 0xFu; }
#define XB_SPIN(cond, bar) do { unsigned _sp = 0; while (cond) { __builtin_amdgcn_s_sleep(1); \
    if ((++_sp & 255u) == 0u) { if (xb_ld(&(bar)[XB_TMO])) break; if (_sp > XB_SPIN_CAP) { atomicAdd(&(bar)[XB_TMO], 1u); break; } } } } while (0)

struct XcdBarrier {
    unsigned* bar; unsigned x;
    volatile LAS unsigned* st;
};

__device__ __forceinline__ XcdBarrier xcd_barrier_post(unsigned* bar, volatile LAS unsigned* st) {
    XcdBarrier b; b.bar = bar; b.x = xb_xcc_id(); b.st = st;
    if (threadIdx.x == 0) (void)xb_add(&bar[XB_XCNT(b.x)], 1u);
    return b;
}
__device__ __forceinline__ void xcd_barrier_complete(unsigned* bar, unsigned x, unsigned& nloc, unsigned& nx) {
    const unsigned G = gridDim.x * gridDim.y * gridDim.z;
    unsigned sum, cnt, mine, sp = 0u;
    for (;;) {
        sum = 0u; cnt = 0u; mine = 0u;
#pragma unroll
        for (unsigned j = 0; j < 16; ++j) { const unsigned c = xb_ld(&bar[XB_XCNT(j)]); sum += c; cnt += (c > 0u) ? 1u : 0u; mine = (j == x) ? c : mine; }
        if (sum == G) break;
        __builtin_amdgcn_s_sleep(1);
        if ((++sp & 255u) == 0u) { if (xb_ld(&bar[XB_TMO])) break; if (sp > XB_SPIN_CAP) { atomicAdd(&bar[XB_TMO], 1u); break; } }
    }
    nloc = mine > 0u ? mine : 1u; nx = cnt > 0u ? cnt : 1u;
}

__device__ __forceinline__ void xcd_barrier(const XcdBarrier& b) {
    asm volatile("s_waitcnt vmcnt(0)" ::: "memory");
    __syncthreads();
    if (threadIdx.x == 0) {
        unsigned* bar = b.bar;
        __builtin_amdgcn_s_waitcnt(0);
        unsigned nloc = b.st[0], nx = b.st[1];
        if (nloc == 0u) { xcd_barrier_complete(bar, b.x, nloc, nx); b.st[0] = nloc; b.st[1] = nx; }
        const unsigned old = xb_add(&bar[XB_XSUB(b.x)], 1u);
        const unsigned gen = old / nloc;
        if (old + 1u == (gen + 1u) * nloc) {
            __builtin_amdgcn_fence(__ATOMIC_RELEASE, "agent");
            asm volatile("s_waitcnt vmcnt(0)" ::: "memory");
            const unsigned og = xb_add(&bar[XB_TOP], 1u);
            const unsigned tg = og / nx;
            if (og + 1u == (tg + 1u) * nx) xb_add(&bar[XB_TOPGEN], 1u);
            else XB_SPIN(xb_ld(&bar[XB_TOPGEN]) == tg, bar);
            __builtin_amdgcn_fence(__ATOMIC_ACQUIRE, "agent");
            xb_add(&bar[XB_XGEN(b.x)], 1u);
            asm volatile("s_waitcnt vmcnt(0)" ::: "memory");
        } else {
            XB_SPIN(xb_ld(&bar[XB_XGEN(b.x)]) == gen, bar);
            __builtin_amdgcn_fence(__ATOMIC_ACQUIRE, "agent");
            asm volatile("s_waitcnt vmcnt(0)" ::: "memory");
        }
    }
    __syncthreads();
}

__device__ __forceinline__ int fresh_tid(int wave0) { int l; asm volatile("v_mbcnt_lo_u32_b32 %0, -1, 0\n\tv_mbcnt_hi_u32_b32 %0, -1, %0" : "=v"(l)); return wave0 * 64 + l; }
#define PHASE_IDS int G = gridDim.x, bx = blockIdx.x; asm volatile("" : "+s"(G), "+s"(bx)); const int tid = fresh_tid(wave0), lane = tid & 63, wave = wave0; const int gw = bx * 8 + wave, NGW = G * 8; \
    const size_t gt = (size_t)bx * 512 + tid, NGT = (size_t)G * 512; (void)lane; (void)gw; (void)gt; (void)NGW; (void)NGT; (void)wave;

template <int MODE> __device__ __forceinline__ void transpose_item(const float* __restrict__ W, int K, int ldw, int ndst, bf16* __restrict__ WT, LAS float* scr, int item, int lane, unsigned char* __restrict__ W8 = nullptr) {
    const int nblk = ndst / 32, kb = item / nblk, nb = item % nblk, k0 = 64 * kb, n0 = 32 * nb;
    const int n_l = n0 + (lane & 31); const int sc = MODE ? src_col(n_l) : n_l;
    float tv[32];
#pragma unroll
    for (int i = 0; i < 32; ++i) { const int kk = 2 * i + (lane >> 5); tv[i] = sc >= 0 ? W[(size_t)(k0 + kk) * ldw + sc] : 0.f; }
#pragma unroll
    for (int i = 0; i < 32; ++i) { const int kk = 2 * i + (lane >> 5); scr[kk * 33 + (lane & 31)] = tv[i]; }
    asm volatile("s_waitcnt lgkmcnt(0)" ::: "memory");
    const int c = lane & 7;
#pragma unroll
    for (int j = 0; j < 4; ++j) { const int n = (lane >> 3) + 8 * j; const LAS float* s = scr + (8 * c) * 33 + n;
        if (MODE == 2 || (MODE == 1 && n0 < C_SMALL))
            *(uint2*)(W8 + (size_t)(n0 + n) * K + k0 + 8 * c) = make_uint2(pk4_fp8(s[0 * 33] * WG8_SCALE, s[1 * 33] * WG8_SCALE, s[2 * 33] * WG8_SCALE, s[3 * 33] * WG8_SCALE), pk4_fp8(s[4 * 33] * WG8_SCALE, s[5 * 33] * WG8_SCALE, s[6 * 33] * WG8_SCALE, s[7 * 33] * WG8_SCALE));
        if (MODE == 2 || (MODE == 1 && n0 < C_SMALL && !(n0 >= C_AV && n0 < C_AV + 256))) continue;
        uint4 o; o.x = pk2(s[0 * 33], s[1 * 33]); o.y = pk2(s[2 * 33], s[3 * 33]); o.z = pk2(s[4 * 33], s[5 * 33]); o.w = pk2(s[6 * 33], s[7 * 33]);
        *(uint4*)(WT + (size_t)(n0 + n) * K + k0 + 8 * c) = o; }
    asm volatile("s_waitcnt lgkmcnt(0)" ::: "memory");
}

__device__ __forceinline__ void mlstm_post_tok(int t, int lane, const bf16* __restrict__ hm, const bf16* __restrict__ proj, const LAS float* norm_w  , unsigned char* __restrict__ ym  ) {
    float4 x[4], nw[4]; uint2 ov[4];
#pragma unroll
    for (int h = 0; h < 4; ++h) { const int c = h * 256 + lane * 4; { const uint2 xr = *(const uint2*)(hm + (size_t)t * 1024 + c); x[h] = make_float4(__uint_as_float(xr.x << 16), __uint_as_float(xr.x & 0xffff0000u), __uint_as_float(xr.y << 16), __uint_as_float(xr.y & 0xffff0000u)); } { const f32x4e_t q_ = *(const LAS f32x4e_t*)(norm_w + c); nw[h] = make_float4(q_[0], q_[1], q_[2], q_[3]); } ov[h] = *(const uint2*)(proj + (size_t)t * NP + C_MO + c); }
#pragma unroll
    for (int h = 0; h < 4; ++h) {
        const float mu = wave_sum((x[h].x + x[h].y) + (x[h].z + x[h].w)) * (1.0f / 256.0f);
        const float d0 = x[h].x - mu, d1 = x[h].y - mu, d2 = x[h].z - mu, d3 = x[h].w - mu;
        const float rs = rsqrtf(wave_sum((d0 * d0 + d1 * d1) + (d2 * d2 + d3 * d3)) * (1.0f / 256.0f) + 1e-6f);
        const float y0 = d0 * rs * nw[h].x * sigm(__uint_as_float(ov[h].x << 16)), y1 = d1 * rs * nw[h].y * sigm(__uint_as_float(ov[h].x & 0xffff0000u));
        const float y2 = d2 * rs * nw[h].z * sigm(__uint_as_float(ov[h].y << 16)), y3 = d3 * rs * nw[h].w * sigm(__uint_as_float(ov[h].y & 0xffff0000u));
        *(unsigned*)(ym + (size_t)t * 1024 + h * 256 + lane * 4) = pk4_fp8(y0 * ACT8_SCALE, y1 * ACT8_SCALE, y2 * ACT8_SCALE, y3 * ACT8_SCALE);
    }
}

__device__ __forceinline__ void ssd_conv_item(int item, const bf16* __restrict__ proj, const LAS float* cw  , const LAS float* cb  , bf16* __restrict__ xcb) {
    const int c8 = item % 192, tb = item / 192, t0 = tb * 8, pos0 = t0 % SEQ, c = c8 * 8;
    uint4 r[11];
#pragma unroll
    for (int j = 0; j < 11; ++j) { r[j] = make_uint4(0u, 0u, 0u, 0u); if (j >= 3 || pos0 > 0) r[j] = *(const uint4*)(proj + (size_t)(t0 - 3 + j) * NP + C_SXBC + c); }
    float w[4][8], bs[8];
#pragma unroll
    for (int j = 0; j < 4; ++j) { const f32x4e_t a = *(const LAS f32x4e_t*)(cw + j * 1536 + c), b = *(const LAS f32x4e_t*)(cw + j * 1536 + c + 4); w[j][0] = a.x; w[j][1] = a.y; w[j][2] = a.z; w[j][3] = a.w; w[j][4] = b.x; w[j][5] = b.y; w[j][6] = b.z; w[j][7] = b.w; }
    { const f32x4e_t a = *(const LAS f32x4e_t*)(cb + c), b = *(const LAS f32x4e_t*)(cb + c + 4); bs[0] = a.x; bs[1] = a.y; bs[2] = a.z; bs[3] = a.w; bs[4] = b.x; bs[5] = b.y; bs[6] = b.z; bs[7] = b.w; }
#pragma unroll
    for (int o = 0; o < 8; ++o) {
        float acc[8];
#pragma unroll
        for (int i = 0; i < 8; ++i) acc[i] = bs[i];
#pragma unroll
        for (int j = 0; j < 4; ++j) { const unsigned rw[4] = {r[o + j].x, r[o + j].y, r[o + j].z, r[o + j].w};
#pragma unroll
            for (int i = 0; i < 4; ++i) { acc[2 * i] += w[j][2 * i] * __uint_as_float(rw[i] << 16); acc[2 * i + 1] += w[j][2 * i + 1] * __uint_as_float(rw[i] & 0xffff0000u); } }
        uint4 ov; ov.x = pk2(acc[0] * sigm(acc[0]), acc[1] * sigm(acc[1])); ov.y = pk2(acc[2] * sigm(acc[2]), acc[3] * sigm(acc[3])); ov.z = pk2(acc[4] * sigm(acc[4]), acc[5] * sigm(acc[5])); ov.w = pk2(acc[6] * sigm(acc[6]), acc[7] * sigm(acc[7]));
        *(uint4*)(xcb + (size_t)(t0 + o) * 1536 + c) = ov;
    }
}
__device__ __forceinline__ void ssd_post_tok2(int tp, int lane, const bf16* __restrict__ yraw, const bf16* __restrict__ proj, const LAS float* norm_w  , unsigned char* __restrict__ ys  ) {
    uint4 yr[4]; uint4 zv[4];
#pragma unroll
    for (int i = 0; i < 4; ++i) { const int t = 2 * tp + (i >> 1), c = (i & 1) * 512 + lane * 8; yr[i] = *(const uint4*)(yraw + (size_t)t * 1024 + c); zv[i] = *(const uint4*)(proj + (size_t)t * NP + C_SZ + c); }
#pragma unroll
    for (int i = 0; i < 4; ++i) { const int t = 2 * tp + (i >> 1), c = (i & 1) * 512 + lane * 8;
        const float yv[8] = {__uint_as_float(yr[i].x << 16), __uint_as_float(yr[i].x & 0xffff0000u), __uint_as_float(yr[i].y << 16), __uint_as_float(yr[i].y & 0xffff0000u), __uint_as_float(yr[i].z << 16), __uint_as_float(yr[i].z & 0xffff0000u), __uint_as_float(yr[i].w << 16), __uint_as_float(yr[i].w & 0xffff0000u)}; const unsigned zw[4] = {zv[i].x, zv[i].y, zv[i].z, zv[i].w};
        float y[8], ss = 0.f;
#pragma unroll
        for (int k = 0; k < 4; ++k) { const float z0 = __uint_as_float(zw[k] << 16), z1 = __uint_as_float(zw[k] & 0xffff0000u); y[2 * k] = yv[2 * k] * (z0 * sigm(z0)); y[2 * k + 1] = yv[2 * k + 1] * (z1 * sigm(z1)); ss += y[2 * k] * y[2 * k] + y[2 * k + 1] * y[2 * k + 1]; }
        const float rs = rsqrtf(wave_sum(ss) * (1.0f / 512.0f) + 1e-6f);
        const f32x4e_t n0q = *(const LAS f32x4e_t*)(norm_w + c), n1q = *(const LAS f32x4e_t*)(norm_w + c + 4); const float4 n0 = make_float4(n0q[0], n0q[1], n0q[2], n0q[3]), n1 = make_float4(n1q[0], n1q[1], n1q[2], n1q[3]);
        { const float r4 = rs * ACT8_SCALE; *(uint2*)(ys + (size_t)t * 1024 + c) = make_uint2(pk4_fp8(y[0] * r4 * n0.x, y[1] * r4 * n0.y, y[2] * r4 * n0.z, y[3] * r4 * n0.w), pk4_fp8(y[4] * r4 * n1.x, y[5] * r4 * n1.y, y[6] * r4 * n1.z, y[7] * r4 * n1.w)); }
    }
}

__device__ __forceinline__ void ln_body2(int tp, int lane, const float* in, const float* __restrict__ g, const float* __restrict__ bta, float* outf, bf16* __restrict__ outb) {
    float4 v[2][8];
#pragma unroll
    for (int r = 0; r < 2; ++r)
#pragma unroll
        for (int j = 0; j < 8; ++j) v[r][j] = *(const float4*)(in + (size_t)(2 * tp + r) * DM + j * 256 + lane * 4);
    { int z_ = 0; asm volatile("" : "+s"(z_)); g += z_; bta += z_; }
#pragma unroll
    for (int r = 0; r < 2; ++r) {
        const int t = 2 * tp + r; float s = 0.f;
#pragma unroll
        for (int j = 0; j < 8; ++j) s += (v[r][j].x + v[r][j].y) + (v[r][j].z + v[r][j].w);
        const float mu = wave_sum(s) * (1.0f / DM); float q = 0.f;
#pragma unroll
        for (int j = 0; j < 8; ++j) { v[r][j].x -= mu; v[r][j].y -= mu; v[r][j].z -= mu; v[r][j].w -= mu; q += (v[r][j].x * v[r][j].x + v[r][j].y * v[r][j].y) + (v[r][j].z * v[r][j].z + v[r][j].w * v[r][j].w); }
        const float rs = rsqrtf(wave_sum(q) * (1.0f / DM) + 1e-5f);
#pragma unroll
        for (int j = 0; j < 8; ++j) { const int c = j * 256 + lane * 4; const float4 gg = *(const float4*)(g + c), bb = *(const float4*)(bta + c);
            float4 y; y.x = v[r][j].x * rs * gg.x + bb.x; y.y = v[r][j].y * rs * gg.y + bb.y; y.z = v[r][j].z * rs * gg.z + bb.z; y.w = v[r][j].w * rs * gg.w + bb.w;
            *(float4*)(outf + (size_t)t * DM + c) = y; *(uint2*)(outb + (size_t)t * DM + c) = make_uint2(pk2(y.x, y.y), pk2(y.z, y.w)); }
    }
}

__device__ __forceinline__ void ln_body2b(int tp, int lane, bf16* xb, const LAS float* g  , const LAS float* bta  ) {
    uint4 v[2][4];
#pragma unroll
    for (int r = 0; r < 2; ++r)
#pragma unroll
        for (int j = 0; j < 4; ++j) v[r][j] = *(const uint4*)(xb + (size_t)(2 * tp + r) * DM + j * 512 + lane * 8);
#pragma unroll
    for (int r = 0; r < 2; ++r) {
        const int t = 2 * tp + r; float f[32]; float s = 0.f;
#pragma unroll
        for (int j = 0; j < 4; ++j) { const unsigned w4[4] = {v[r][j].x, v[r][j].y, v[r][j].z, v[r][j].w};
#pragma unroll
            for (int k = 0; k < 4; ++k) { f[8 * j + 2 * k] = __uint_as_float(w4[k] << 16); f[8 * j + 2 * k + 1] = __uint_as_float(w4[k] & 0xffff0000u); } }
#pragma unroll
        for (int i = 0; i < 32; i += 4) s += (f[i] + f[i + 1]) + (f[i + 2] + f[i + 3]);
        const float mu = wave_sum(s) * (1.0f / DM); float q = 0.f;
#pragma unroll
        for (int i = 0; i < 32; ++i) { f[i] -= mu; q += f[i] * f[i]; }
        const float rs = rsqrtf(wave_sum(q) * (1.0f / DM) + 1e-5f);
#pragma unroll
        for (int j = 0; j < 4; ++j) { const int c = j * 512 + lane * 8; const f32x4e_t g0 = *(const LAS f32x4e_t*)(g + c), g1 = *(const LAS f32x4e_t*)(g + c + 4), b0 = *(const LAS f32x4e_t*)(bta + c), b1 = *(const LAS f32x4e_t*)(bta + c + 4);
            *(uint4*)(xb + (size_t)t * DM + c) = make_uint4(pk2(f[8 * j] * rs * g0.x + b0.x, f[8 * j + 1] * rs * g0.y + b0.y), pk2(f[8 * j + 2] * rs * g0.z + b0.z, f[8 * j + 3] * rs * g0.w + b0.w),
                                                            pk2(f[8 * j + 4] * rs * g1.x + b1.x, f[8 * j + 5] * rs * g1.y + b1.y), pk2(f[8 * j + 6] * rs * g1.z + b1.z, f[8 * j + 7] * rs * g1.w + b1.w)); }
    }
}

__device__ __forceinline__ float gelu_erf(float v) {
    const float av = fabsf(v), t = __builtin_amdgcn_rcpf(av * 0.2316418882f + 1.0f);
    float q = t * 0.5307027145f + (-0.7265760135f); q = q * t + 0.7107068705f; q = q * t + (-0.142248368f); q = q * t + 0.127414796f; q = q * t;
    const float e = __builtin_amdgcn_exp2f((v * v) * (-0.72134752044f));
    const float mm = v * (q * e), r = v - mm;
    return v < 0.f ? mm : r;
}
typedef unsigned u32x4e_t __attribute__((ext_vector_type(4)));
typedef float f32x4e_t __attribute__((ext_vector_type(4)));
typedef unsigned u32x2e_t __attribute__((ext_vector_type(2)));
constexpr float U6_SCALE = 80.0f, V4_SCALE = 16.0f;
constexpr int ROW4 = DM / 2;
constexpr int ROW6 = DM * 6 / 8;
typedef float v32f_t __attribute__((ext_vector_type(32)));
typedef float f32x2_t __attribute__((ext_vector_type(2)));
typedef __bf16 v32b_t __attribute__((ext_vector_type(32)));
typedef unsigned v6u_t __attribute__((ext_vector_type(6)));
typedef __bf16 v2b_t __attribute__((ext_vector_type(2)));
__device__ __forceinline__ void tab_to_fp6(size_t i, const float* __restrict__ src, unsigned char* __restrict__ dst, float sc) {
    const float4* s = (const float4*)src + i * 8; v32b_t b;
#pragma unroll
    for (int j = 0; j < 8; ++j) { const float4 v = s[j]; b[4 * j] = (__bf16)(v.x * sc); b[4 * j + 1] = (__bf16)(v.y * sc); b[4 * j + 2] = (__bf16)(v.z * sc); b[4 * j + 3] = (__bf16)(v.w * sc); }
    const v6u_t p = __builtin_amdgcn_cvt_scalef32_pk32_fp6_bf16(b, 1.0f);
    uint2* d = (uint2*)(dst + i * 24); d[0] = make_uint2(p[0], p[1]); d[1] = make_uint2(p[2], p[3]); d[2] = make_uint2(p[4], p[5]);
}
__device__ __forceinline__ void tab_to_fp4(size_t i, const float* __restrict__ src, unsigned char* __restrict__ dst, float sc) {
    const float4* s = (const float4*)src + i * 8; unsigned w[4];
#pragma unroll
    for (int j = 0; j < 4; ++j) { const float4 a = s[2 * j], b = s[2 * j + 1]; unsigned x = 0u;
        x = __builtin_amdgcn_cvt_scalef32_pk_fp4_f32(x, a.x * sc, a.y * sc, 1.0f, 0); x = __builtin_amdgcn_cvt_scalef32_pk_fp4_f32(x, a.z * sc, a.w * sc, 1.0f, 1);
        x = __builtin_amdgcn_cvt_scalef32_pk_fp4_f32(x, b.x * sc, b.y * sc, 1.0f, 2); x = __builtin_amdgcn_cvt_scalef32_pk_fp4_f32(x, b.z * sc, b.w * sc, 1.0f, 3); w[j] = x; }
    *(uint4*)(dst + i * 16) = make_uint4(w[0], w[1], w[2], w[3]);
}
__device__ __forceinline__ void tab_fp4_store(const float4 (&q)[4], unsigned char* __restrict__ dst8, float sc) {
    unsigned w[2];
#pragma unroll
    for (int j = 0; j < 2; ++j) { const float4 a = q[2 * j], b = q[2 * j + 1]; unsigned x = 0u;
        x = __builtin_amdgcn_cvt_scalef32_pk_fp4_f32(x, a.x * sc, a.y * sc, 1.0f, 0); x = __builtin_amdgcn_cvt_scalef32_pk_fp4_f32(x, a.z * sc, a.w * sc, 1.0f, 1);
        x = __builtin_amdgcn_cvt_scalef32_pk_fp4_f32(x, b.x * sc, b.y * sc, 1.0f, 2); x = __builtin_amdgcn_cvt_scalef32_pk_fp4_f32(x, b.z * sc, b.w * sc, 1.0f, 3); w[j] = x; }
    *(uint2*)dst8 = make_uint2(w[0], w[1]);
}
constexpr int TAB_PER_WG = (P_EXPERTS * (DM / 32)) / 128;
__device__ __forceinline__ void peer_expert_body(int t, int lane, bool last, const int* __restrict__ ids, const float* __restrict__ gates, const unsigned char* __restrict__ U6, const unsigned char* __restrict__ V6,
                                                 const LAS float* gl  , const LAS float* bl  , float* __restrict__ outf, bf16* outb  , unsigned char* __restrict__ outq  , LAS unsigned* wl  ) {
    asm volatile("" : "+v"(lane));
    int idA = ids[(size_t)t * 128 + lane], idB = ids[(size_t)t * 128 + 64 + lane]; float gA = gates[(size_t)t * 128 + lane], gB = gates[(size_t)t * 128 + 64 + lane];
    {
        const unsigned kA = ((unsigned)idA << 7) | (unsigned)lane, kB = ((unsigned)idB << 7) | (unsigned)(64 + lane);
        wl[lane] = kA; wl[64 + lane] = kB;
        asm volatile("s_waitcnt lgkmcnt(0)" ::: "memory");
        int rA = 0, rB = 0;
#pragma unroll 8
        for (int j = 0; j < 128; j += 4) { const u32x4e_t k4 = *(const LAS u32x4e_t*)(wl + j);
#pragma unroll
            for (int q = 0; q < 4; ++q) { rA += (k4[q] < kA) ? 1 : 0; rB += (k4[q] < kB) ? 1 : 0; } }
        asm volatile("s_waitcnt lgkmcnt(0)" ::: "memory");
        wl[128 + rA] = (unsigned)idA; wl[256 + rA] = __float_as_uint(gA); wl[128 + rB] = (unsigned)idB; wl[256 + rB] = __float_as_uint(gB);
        asm volatile("s_waitcnt lgkmcnt(0)" ::: "memory");
        idA = (int)wl[128 + lane]; idB = (int)wl[192 + lane]; gA = __uint_as_float(wl[256 + lane]); gB = __uint_as_float(wl[320 + lane]);
        asm volatile("s_waitcnt lgkmcnt(0)" ::: "memory");
    }
#define ID_OF(e_) __builtin_amdgcn_readlane((e_) < 64 ? idA : idB, (e_) & 63)
#define GATE_OF(e_) __builtin_bit_cast(float, __builtin_amdgcn_readlane(__builtin_bit_cast(int, (e_) < 64 ? gA : gB), (e_) & 63))
    uint4 ra[8], rb[8];
#define ROW_LOAD(R_, T_, e_) do { _Pragma("unroll") for (int k_ = 0; k_ < 8; ++k_) { const int id_ = ID_OF((e_) + k_); R_[k_] = *((const uint4*)((T_) + (size_t)id_ * ROW4) + lane); } } while (0)
#define V4_PAIR(D_, W_, j_, b_) do { const f32x2_t t_ = __builtin_amdgcn_cvt_scalef32_pk_f32_fp4(W_, 1.0f, b_); D_[8 * (j_) + 2 * (b_)] = t_.x; D_[8 * (j_) + 2 * (b_) + 1] = t_.y; } while (0)
#define V4_DWORD(D_, W_, j_) do { V4_PAIR(D_, W_, j_, 0); V4_PAIR(D_, W_, j_, 1); V4_PAIR(D_, W_, j_, 2); V4_PAIR(D_, W_, j_, 3); } while (0)
#define UDOT4(W_, j_) do { a_ = __builtin_amdgcn_fdot2_f32_bf16(__builtin_amdgcn_cvt_scalef32_pk_bf16_fp4(W_, 1.0f, 0), __builtin_bit_cast(v2b_t, xb[4 * (j_)]), a_, false); \
        b_ = __builtin_amdgcn_fdot2_f32_bf16(__builtin_amdgcn_cvt_scalef32_pk_bf16_fp4(W_, 1.0f, 1), __builtin_bit_cast(v2b_t, xb[4 * (j_) + 1]), b_, false); \
        a_ = __builtin_amdgcn_fdot2_f32_bf16(__builtin_amdgcn_cvt_scalef32_pk_bf16_fp4(W_, 1.0f, 2), __builtin_bit_cast(v2b_t, xb[4 * (j_) + 2]), a_, false); \
        b_ = __builtin_amdgcn_fdot2_f32_bf16(__builtin_amdgcn_cvt_scalef32_pk_bf16_fp4(W_, 1.0f, 3), __builtin_bit_cast(v2b_t, xb[4 * (j_) + 3]), b_, false); } while (0)
#define DEC4(D_, R_) do { V4_DWORD(D_, R_.x, 0); V4_DWORD(D_, R_.y, 1); V4_DWORD(D_, R_.z, 2); V4_DWORD(D_, R_.w, 3); } while (0)
#define PK6(W_) ((v6u_t){W_[0].x, W_[0].y, W_[1].x, W_[1].y, W_[2].x, W_[2].y})
#define SB_ __builtin_amdgcn_sched_barrier(0)
    float c0 = 0.f, c1 = 0.f;
    unsigned xb[16];
    {
#pragma unroll
        for (int i = 0; i < 4; ++i) { const uint4 v = *(const uint4*)(outb + (size_t)t * DM + lane * 32 + i * 8); xb[4 * i] = v.x; xb[4 * i + 1] = v.y; xb[4 * i + 2] = v.z; xb[4 * i + 3] = v.w; }
#define U_COMP(R_, e_) do { float p_[8]; _Pragma("unroll") for (int k_ = 0; k_ < 8; ++k_) { SB_; float a_ = 0.f, b_ = 0.f; UDOT4(R_[k_].x, 0); UDOT4(R_[k_].y, 1); UDOT4(R_[k_].z, 2); UDOT4(R_[k_].w, 3); p_[k_] = a_ + b_; } SB_; \
        { const bool o1_ = lane & 1, o2_ = lane & 2, o4_ = lane & 4; float w_[4], u_[2]; \
          _Pragma("unroll") for (int j_ = 0; j_ < 4; ++j_) { const float keep_ = o1_ ? p_[2 * j_ + 1] : p_[2 * j_], send_ = o1_ ? p_[2 * j_] : p_[2 * j_ + 1]; w_[j_] = keep_ + dpp_f<0xB1>(send_); } \
          _Pragma("unroll") for (int j_ = 0; j_ < 2; ++j_) { const float keep_ = o2_ ? w_[2 * j_ + 1] : w_[2 * j_], send_ = o2_ ? w_[2 * j_] : w_[2 * j_ + 1]; u_[j_] = keep_ + dpp_f<0x4E>(send_); } \
          float s_; { const float keep_ = o4_ ? u_[1] : u_[0], send_ = o4_ ? u_[0] : u_[1]; s_ = keep_ + __builtin_bit_cast(float, __builtin_amdgcn_ds_swizzle(__builtin_bit_cast(int, send_), 0x101F)); } \
          s_ += __builtin_bit_cast(float, __builtin_amdgcn_ds_swizzle(__builtin_bit_cast(int, s_), 0x201F)); s_ += __builtin_bit_cast(float, __builtin_amdgcn_ds_swizzle(__builtin_bit_cast(int, s_), 0x401F)); \
          { float lo_ = s_, hi_ = s_; halves32(lo_, hi_); s_ = lo_ + hi_; } \
          s_ *= (1.0f / U6_SCALE); const float ge_ = gelu_erf(s_) * (1.0f / V4_SCALE); \
          const bool in_ = ((lane ^ (e_)) & 56) == 0;              \
          if ((e_) < 64) c0 = in_ ? gA * ge_ : c0; else c1 = in_ ? gB * ge_ : c1; } } while (0)
        ROW_LOAD(ra, U6, 0);
#pragma nounroll
        for (int e = 0; e < 128; e += 16) {
            ROW_LOAD(rb, U6, e + 8);
            U_COMP(ra, e);
            if (e + 16 < 128) ROW_LOAD(ra, U6, e + 16);
            U_COMP(rb, e + 8);
        }
#undef U_COMP
    }
    v32f_t acc;
#pragma unroll
    for (int i = 0; i < 32; ++i) acc[i] = 0.f;
#define V_COMP(R_, e_) do { _Pragma("unroll") for (int k_ = 0; k_ < 8; ++k_) { SB_; const int ee_ = (e_) + k_; \
            const float cv_ = __builtin_bit_cast(float, __builtin_amdgcn_readlane(__builtin_bit_cast(int, ee_ < 64 ? c0 : c1), ee_ & 63)); \
            v32f_t d_; DEC4(d_, R_[k_]); acc += d_ * cv_; } SB_; } while (0)
    ROW_LOAD(ra, V6, 0);
#pragma nounroll
    for (int e = 0; e < 128; e += 16) {
        ROW_LOAD(rb, V6, e + 8);
        V_COMP(ra, e);
        if (e + 16 < 128) ROW_LOAD(ra, V6, e + 16);
        V_COMP(rb, e + 8);
    }
#undef V_COMP
#undef ID_OF
#undef GATE_OF
#undef ROW_LOAD
#undef PK6
#undef V4_PAIR
#undef V4_DWORD
#undef DEC4
#undef UDOT4
#undef SB_
    float s = 0.f;
#pragma unroll
    for (int i = 0; i < 16; ++i) { acc[2 * i] += ALPHA * __uint_as_float(xb[i] << 16); acc[2 * i + 1] += ALPHA * __uint_as_float(xb[i] & 0xffff0000u); }
#pragma unroll
    for (int i = 0; i < 32; ++i) s += acc[i];
    const float mu = wave_sum(s) * (1.0f / DM); float q = 0.f;
#pragma unroll
    for (int i = 0; i < 32; ++i) { acc[i] -= mu; q += acc[i] * acc[i]; }
    const float rs = rsqrtf(wave_sum(q) * (1.0f / DM) + 1e-5f);
#pragma unroll
    for (int i = 0; i < 8; i += 2) { const int c = lane * 32 + i * 4; float y[8];
#pragma unroll
        for (int h = 0; h < 2; ++h) { const f32x4e_t gq = *(const LAS f32x4e_t*)(gl + ((i + h) * 64 + lane) * 4), bq = *(const LAS f32x4e_t*)(bl + ((i + h) * 64 + lane) * 4);
#pragma unroll
            for (int k = 0; k < 4; ++k) y[4 * h + k] = acc[4 * (i + h) + k] * rs * gq[k] + bq[k]; }
        if (last) { *(float4*)(outf + (size_t)t * DM + c) = make_float4(y[0], y[1], y[2], y[3]); *(float4*)(outf + (size_t)t * DM + c + 4) = make_float4(y[4], y[5], y[6], y[7]); }
        else { *(uint4*)(outb + (size_t)t * DM + c) = make_uint4(pk2(y[0], y[1]), pk2(y[2], y[3]), pk2(y[4], y[5]), pk2(y[6], y[7])); *(uint2*)(outq + (size_t)t * DM + c) = make_uint2(pk4_fp8(y[0], y[1], y[2], y[3]), pk4_fp8(y[4], y[5], y[6], y[7])); } }
}

typedef short bf16x8_t __attribute__((ext_vector_type(8)));
typedef float f32x4_t __attribute__((ext_vector_type(4)));
typedef unsigned u32x2_t __attribute__((ext_vector_type(2)));
typedef unsigned u32x4_t __attribute__((ext_vector_type(4)));
constexpr int SWA_PITCH = 144;
constexpr int SWA_KS = 0, SWA_VS = 256 * SWA_PITCH, SWA_LDS = 2 * 256 * SWA_PITCH;
static_assert(SWA_LDS <= RING_BYTES, "SWA LDS");
__device__ __forceinline__ float grp4_max(float v) {
    v = fmaxf(v, __builtin_bit_cast(float, __builtin_amdgcn_ds_swizzle(__builtin_bit_cast(int, v), 0x401F)));
    float lo = v, hi = v; halves32(lo, hi);
    return fmaxf(lo, hi);
}
__device__ __forceinline__ float grp4_sum(float v) {
    v += __builtin_bit_cast(float, __builtin_amdgcn_ds_swizzle(__builtin_bit_cast(int, v), 0x401F));
    float lo = v, hi = v; halves32(lo, hi);
    return lo + hi;
}
__device__ __forceinline__ void tr_read2(unsigned a0, unsigned a1, u32x2_t& r0, u32x2_t& r1) {
    asm volatile("ds_read_b64_tr_b16 %0, %2\n\tds_read_b64_tr_b16 %1, %3\n\ts_waitcnt lgkmcnt(0)" : "=&v"(r0), "=&v"(r1) : "v"(a0), "v"(a1) : "memory");
}
__device__ __forceinline__ void rope8(uint4& lo, uint4& hi, const float4* cs, float scale) {
    unsigned* a = (unsigned*)&lo; unsigned* b = (unsigned*)&hi;
#pragma unroll
    for (int j = 0; j < 4; ++j) {
        const float x1a = __uint_as_float(a[j] << 16), x1b = __uint_as_float(a[j] & 0xffff0000u), x2a = __uint_as_float(b[j] << 16), x2b = __uint_as_float(b[j] & 0xffff0000u);
        const float4 c = cs[j];
        const float y1a = (x1a * c.x - x2a * c.y) * scale, y2a = (x2a * c.x + x1a * c.y) * scale, y1b = (x1b * c.z - x2b * c.w) * scale, y2b = (x2b * c.z + x1b * c.w) * scale;
        a[j] = pk2(y1a, y1b); b[j] = pk2(y2a, y2b);
    }
}
__device__ __forceinline__ void swa_phase(LAS unsigned char* lds, const bf16* __restrict__ proj, const float* __restrict__ rtab  , const float* __restrict__ sinks, unsigned char* __restrict__ ya  ,
                                          int tid, int bx, int G) {
    const int lane = tid & 63, w = __builtin_amdgcn_readfirstlane(tid >> 6), l15 = lane & 15, g4 = lane >> 4;
    const unsigned ldsb = (unsigned)(size_t)lds;
    constexpr int NSWA = NBATCH * 32 * 4, NSWA_LO = NSWA * 4 / 8;
    const int hb = G >> 1; int u0 = bx, u1 = NSWA, ust = G;
    if (hb > 0) { if (bx < hb) { u1 = NSWA_LO; ust = hb; } else { u0 = NSWA_LO + bx - hb; ust = G - hb; } }
    uint4 klo[2], khi[2], vv[4]; float4 kcs[2][4];
#define SWA_LOAD(u_) do { const int kvh_ = (u_) & 3, nb_ = ((u_) >> 2) & 31, b_ = (u_) >> 7, t0_ = b_ * SEQ + nb_ * 128; \
        _Pragma("unroll") for (int i_ = 0; i_ < 2; ++i_) { const int it_ = tid + 512 * i_, kk_ = it_ >> 2, c_ = it_ & 3; klo[i_] = make_uint4(0u, 0u, 0u, 0u); khi[i_] = klo[i_]; \
            _Pragma("unroll") for (int j_ = 0; j_ < 4; ++j_) kcs[i_][j_] = make_float4(0.f, 0.f, 0.f, 0.f); \
            if (nb_ > 0 || kk_ >= 128) { const bf16* src_ = proj + (size_t)(t0_ - 128 + kk_) * NP + C_AK + kvh_ * 64 + 8 * c_; klo[i_] = *(const uint4*)src_; khi[i_] = *(const uint4*)(src_ + 32); \
                const float4* cs_ = (const float4*)(rtab + ((size_t)(nb_ * 128 - 128 + kk_) * 32 + 8 * c_) * 2); kcs[i_][0] = cs_[0]; kcs[i_][1] = cs_[1]; kcs[i_][2] = cs_[2]; kcs[i_][3] = cs_[3]; } } \
        _Pragma("unroll") for (int i_ = 0; i_ < 4; ++i_) { const int it_ = tid + 512 * i_, kk_ = it_ >> 3, c_ = it_ & 7; vv[i_] = make_uint4(0u, 0u, 0u, 0u); \
            if (nb_ > 0 || kk_ >= 128) vv[i_] = *(const uint4*)(proj + (size_t)(t0_ - 128 + kk_) * NP + C_AV + kvh_ * 64 + 8 * c_); } } while (0)
#define SWA_STORE() do { \
        _Pragma("unroll") for (int i_ = 0; i_ < 2; ++i_) { const int it_ = tid + 512 * i_, kk_ = it_ >> 2, c_ = it_ & 3; uint4 lo_ = klo[i_], hi_ = khi[i_]; rope8(lo_, hi_, kcs[i_], 1.0f);     \
            *(LAS u32x4_t*)(lds + SWA_KS + kk_ * SWA_PITCH + 16 * c_) = __builtin_bit_cast(u32x4_t, lo_); *(LAS u32x4_t*)(lds + SWA_KS + kk_ * SWA_PITCH + 64 + 16 * c_) = __builtin_bit_cast(u32x4_t, hi_); } \
        _Pragma("unroll") for (int i_ = 0; i_ < 4; ++i_) { const int it_ = tid + 512 * i_, kk_ = it_ >> 3, c_ = it_ & 7; *(LAS u32x4_t*)(lds + SWA_VS + kk_ * SWA_PITCH + 16 * c_) = __builtin_bit_cast(u32x4_t, vv[i_]); } } while (0)
    if (u0 < u1) SWA_LOAD(u0);
    for (int u = u0; u < u1; u += ust) {
        const int kvh = u & 3, nb = (u >> 2) & 31, b = u >> 7;
        const int t0 = b * SEQ + nb * 128;
        const int r = w >> 1, hf = w & 1, hq = kvh * 4 + r;
        uint4 nqlo, nqhi; float4 nqcs[4];
#define SWA_QLOAD(qt_) do { const int iq_ = 64 * hf + 16 * (qt_) + l15; const bf16* src_ = proj + (size_t)(t0 + iq_) * NP + C_AQ + hq * 64 + 8 * g4; nqlo = *(const uint4*)src_; nqhi = *(const uint4*)(src_ + 32); \
            const float4* cs_ = (const float4*)(rtab + ((size_t)(nb * 128 + iq_) * 32 + 8 * g4) * 2); nqcs[0] = cs_[0]; nqcs[1] = cs_[1]; nqcs[2] = cs_[2]; nqcs[3] = cs_[3]; } while (0)
        SWA_QLOAD(0);
        __syncthreads();
        SWA_STORE();
        if (u + ust < u1) SWA_LOAD(u + ust);
        __syncthreads();
        const float sink = sinks[hq];
#pragma nounroll
        for (int qt = 0; qt < 4; ++qt) {
            const int i0 = 64 * hf + 16 * qt, iq = i0 + l15, tq = t0 + iq, ktb0 = 4 * hf + qt;
            bf16x8_t q0, q1;
            { uint4 lo = nqlo, hi = nqhi; rope8(lo, hi, nqcs, 0.125f); q0 = __builtin_bit_cast(bf16x8_t, lo); q1 = __builtin_bit_cast(bf16x8_t, hi); }
            if (qt + 1 < 4) SWA_QLOAD(qt + 1);
            f32x4_t s[9]; float m = sink; const int d0 = 4 * g4 - l15;
#pragma unroll
            for (int n = 0; n < 9; ++n) {
                const LAS unsigned char* kp = lds + SWA_KS + (16 * (ktb0 + n) + l15) * SWA_PITCH + 16 * g4;
                const bf16x8_t a0 = *(const LAS bf16x8_t*)kp, a1 = *(const LAS bf16x8_t*)(kp + 64);
                f32x4_t acc = (f32x4_t){0.f, 0.f, 0.f, 0.f};
                acc = __builtin_amdgcn_mfma_f32_16x16x32_bf16(a0, q0, acc, 0, 0, 0);
                acc = __builtin_amdgcn_mfma_f32_16x16x32_bf16(a1, q1, acc, 0, 0, 0);
                const bool tv = (nb > 0) || (ktb0 + n >= 8);
#pragma unroll
                for (int e = 0; e < 4; ++e) { const bool ok = tv && (n == 0 ? (d0 + e >= 1) : n == 8 ? (d0 + e <= 0) : true);
                    acc[e] = ok ? acc[e] : -1e30f; m = fmaxf(m, acc[e]); }
                s[n] = acc;
            }
            m = grp4_max(m);
            float lsum = 0.f;
#pragma unroll
            for (int n = 0; n < 9; ++n)
#pragma unroll
                for (int e = 0; e < 4; ++e) { const float p = __expf(s[n][e] - m); s[n][e] = p; lsum += p; }
            lsum = grp4_sum(lsum) + __expf(sink - m);
            const float inv = __builtin_amdgcn_rcpf(lsum);
            bf16x8_t pf[5];
#pragma unroll
            for (int pi = 0; pi < 4; ++pi) { uint4 w4; w4.x = pk2(s[2 * pi][0], s[2 * pi][1]); w4.y = pk2(s[2 * pi][2], s[2 * pi][3]); w4.z = pk2(s[2 * pi + 1][0], s[2 * pi + 1][1]); w4.w = pk2(s[2 * pi + 1][2], s[2 * pi + 1][3]);
                pf[pi] = __builtin_bit_cast(bf16x8_t, w4); }
            { uint4 w4; w4.x = pk2(s[8][0], s[8][1]); w4.y = pk2(s[8][2], s[8][3]); w4.z = 0u; w4.w = 0u; pf[4] = __builtin_bit_cast(bf16x8_t, w4); }
            const int qq = l15 >> 2, pp = lane & 3;
#pragma unroll
            for (int dt = 0; dt < 4; ++dt) {
                f32x4_t o = (f32x4_t){0.f, 0.f, 0.f, 0.f};
#pragma unroll
                for (int pi = 0; pi < 5; ++pi) {
                    const int ka = (ktb0 + 2 * pi) < 15 ? (ktb0 + 2 * pi) : 15, kb = (ktb0 + 2 * pi + 1) < 15 ? (ktb0 + 2 * pi + 1) : 15;
                    u32x2_t v0, v1;
                    tr_read2(ldsb + SWA_VS + (16 * ka + 4 * g4 + qq) * SWA_PITCH + (16 * dt + 4 * pp) * 2, ldsb + SWA_VS + (16 * kb + 4 * g4 + qq) * SWA_PITCH + (16 * dt + 4 * pp) * 2, v0, v1);
                    const uint4 av = make_uint4(v0.x, v0.y, v1.x, v1.y);
                    o = __builtin_amdgcn_mfma_f32_16x16x32_bf16(__builtin_bit_cast(bf16x8_t, av), pf[pi], o, 0, 0, 0);
                }
                { const float i4 = inv * ACT8_SCALE; *(unsigned*)(ya + (size_t)tq * 1024 + hq * 64 + 16 * dt + 4 * g4) = pk4_fp8(o[0] * i4, o[1] * i4, o[2] * i4, o[3] * i4); }
            }
        }
    }
#undef SWA_LOAD
#undef SWA_STORE
#undef SWA_QLOAD
}

constexpr size_t WS_MG = WS_R1 + 128 * MiB, WS_MEG = WS_MG + 2 * MiB, WS_SG = WS_MG + 3 * MiB, WS_SEA = WS_SG + 8 * MiB;
__device__ __forceinline__ void mlstm_gate_item(int item, int lane, LAS float* wl, const float* __restrict__ small, const float* __restrict__ gate_b, float4* __restrict__ mg, float* __restrict__ meg) {
    const int ch = item & 63, h = (item >> 6) & 3, b = item >> 8; const size_t t = (size_t)b * SEQ + ch * 64 + lane;
    const float ip = small[t * 32 + h] + gate_b[h], fp = small[t * 32 + 4 + h] + gate_b[4 + h];
    wl[lane] = fminf(fp, 0.f) - log1pf(__expf(-fabsf(fp)));
    asm volatile("s_waitcnt lgkmcnt(0)" ::: "memory");
    float bs = 0.f;
#pragma unroll
    for (int j = 0; j < 64; j += 4) { const f32x4_t v4 = *(const LAS f32x4_t*)(wl + j);
        bs += (j + 0 <= lane) ? v4[0] : 0.f; bs += (j + 1 <= lane) ? v4[1] : 0.f; bs += (j + 2 <= lane) ? v4[2] : 0.f; bs += (j + 3 <= lane) ? v4[3] : 0.f; }
    const float gt = __builtin_bit_cast(float, __builtin_amdgcn_readlane(__builtin_bit_cast(int, bs), 63));
    mg[t * 4 + h] = make_float4(bs, ip - bs, __expf(bs), __expf(gt - bs + ip) * 0.08838834764831845f);
    if (lane == 0) meg[(b * 4 + h) * 64 + ch] = __expf(gt);
    asm volatile("s_waitcnt lgkmcnt(0)" ::: "memory");
}
__device__ __forceinline__ void ssd_gate_item(int item, int lane, LAS float* wl, const float* __restrict__ small, const float* __restrict__ dt_bias, const float* __restrict__ a_log, float4* __restrict__ sg, float* __restrict__ sea) {
    const int ch = item & 31, hh = (item >> 5) & 15, b = item >> 9; const size_t t0 = (size_t)b * SEQ + ch * 128;
    const float a = -__expf(a_log[hh]), dtb = dt_bias[hh];
    float dt[2];
#pragma unroll
    for (int r = 0; r < 2; ++r) { const float dtr = small[(t0 + lane + 64 * r) * 32 + 8 + hh] + dtb; dt[r] = dtr > 20.f ? dtr : log1pf(__expf(dtr)); wl[lane + 64 * r] = dt[r] * a; }
    asm volatile("s_waitcnt lgkmcnt(0)" ::: "memory");
    float a0 = 0.f, a1 = 0.f;
#pragma unroll 8
    for (int j = 0; j < 128; j += 4) { const f32x4_t v4 = *(const LAS f32x4_t*)(wl + j);
#pragma unroll
        for (int q = 0; q < 4; ++q) { a0 += (j + q <= lane) ? v4[q] : 0.f; a1 += (j + q <= lane + 64) ? v4[q] : 0.f; } }
    const float atot = __builtin_bit_cast(float, __builtin_amdgcn_readlane(__builtin_bit_cast(int, a1), 63));
    sg[(t0 + lane) * 16 + hh] = make_float4(dt[0], a0, __expf(a0), __expf(atot - a0) * dt[0]);
    sg[(t0 + lane + 64) * 16 + hh] = make_float4(dt[1], a1, __expf(a1), __expf(atot - a1) * dt[1]);
    if (lane == 0) sea[(b * 16 + hh) * 32 + ch] = __expf(atot);
    asm volatile("s_waitcnt lgkmcnt(0)" ::: "memory");
}

constexpr int ML_QP = 272, ML_VP = 176, ML_PP = 144;
constexpr int ML_UNITS = NBATCH * 4 * 4;
constexpr int ML_Q = 0, ML_K = 2 * 64 * ML_QP, ML_V = ML_K + 2 * 64 * ML_QP, ML_VW = ML_V + 2 * 64 * ML_VP, ML_P = ML_VW + 64 * ML_VP, ML_CT = ML_P + 64 * ML_PP,
              ML_VEC = ML_CT + 80 * ML_QP, ML_END = ML_VEC + 4096;
static_assert(ML_END <= PHASE_LDS_BYTES, "mLSTM LDS");
__device__ __forceinline__ void tr_read2q(unsigned a0, unsigned a1, u32x2_t& r0, u32x2_t& r1) {
    asm volatile("ds_read_b64_tr_b16 %0, %2\n\tds_read_b64_tr_b16 %1, %3\n\ts_waitcnt lgkmcnt(0)" : "=&v"(r0), "=&v"(r1) : "v"(a0), "v"(a1) : "memory");
}
__device__ __forceinline__ bf16x8_t mk_frag(u32x2_t lo, u32x2_t hi) { const u32x4_t v = (u32x4_t){lo.x, lo.y, hi.x, hi.y}; return __builtin_bit_cast(bf16x8_t, v); }
#define LBAR() do { asm volatile("s_waitcnt lgkmcnt(0)" ::: "memory"); __builtin_amdgcn_s_barrier(); asm volatile("" ::: "memory"); } while (0)
__device__ __forceinline__ void mlstm_phase(LAS unsigned char* lds, const bf16* __restrict__ proj, const float4* __restrict__ mg, const float* __restrict__ meg, bf16* __restrict__ hm, int tid, int bx, int G, const float* __restrict__ tsrc  , unsigned char* __restrict__ tdst) {
    const int lane0 = tid & 63, w = __builtin_amdgcn_readfirstlane(tid >> 6);
    const unsigned ldsb = (unsigned)(size_t)lds;
    LAS float* vec = (LAS float*)(lds + ML_VEC);
    for (int u = bx; u < ML_UNITS; u += G) {
        const int vs = u & 3, h = (u >> 2) & 3, b = u >> 4;
        LBAR();
        for (int i = tid; i < 2 * 64; i += 512) { LAS unsigned* p = (LAS unsigned*)(lds + ML_V + i * ML_VP + 128); unsigned zz = 0u; asm volatile("" : "+v"(zz));     p[0] = 0x00003F80u | zz;
#pragma unroll
            for (int j = 1; j < 8; ++j) p[j] = zz; }
        for (int i = tid; i < 80 * ML_QP / 4; i += 512) ((LAS unsigned*)(lds + ML_CT))[i] = 0u;
        f32x4_t cacc[5];
#pragma unroll
        for (int i = 0; i < 5; ++i) cacc[i] = (f32x4_t){0.f, 0.f, 0.f, 0.f};
        struct MLRegs { uint4 pq[2], pk[2], pv; float4 pg; float peg; } rs[2];
#pragma unroll
        for (int i = 0; i < 2; ++i) { rs[i].pv = make_uint4(0u, 0u, 0u, 0u); rs[i].pg = make_float4(0.f, 0.f, 0.f, 0.f); rs[i].peg = 0.f; }
#define ML_LOAD(R_, c_) do { const size_t tb_ = (size_t)b * SEQ + (size_t)(c_) * 64; \
            _Pragma("unroll") for (int i_ = 0; i_ < 2; ++i_) { const int p_ = tid + 512 * i_, row_ = p_ >> 4, c16_ = p_ & 15; const bf16* s_ = proj + (tb_ + row_) * NP + h * 128 + c16_ * 8; R_.pq[i_] = *(const uint4*)(s_ + C_MQ); R_.pk[i_] = *(const uint4*)(s_ + C_MK); } \
            R_.pv = *(const uint4*)(proj + (tb_ + (tid >> 3)) * NP + C_MV + h * 256 + vs * 64 + (tid & 7) * 8); \
            if (tid >= 256 && tid < 320) { R_.pg = mg[(tb_ + (tid - 256)) * 4 + h]; R_.peg = meg[(b * 4 + h) * 64 + (c_)]; } } while (0)
#define ML_STORE(R_, bi_) do { _Pragma("unroll") for (int i_ = 0; i_ < 2; ++i_) { const int p_ = tid + 512 * i_, row_ = p_ >> 4, c16_ = p_ & 15; \
                *(LAS u32x4_t*)(lds + ML_Q + (bi_) * 64 * ML_QP + row_ * ML_QP + c16_ * 16) = __builtin_bit_cast(u32x4_t, R_.pq[i_]); *(LAS u32x4_t*)(lds + ML_K + (bi_) * 64 * ML_QP + row_ * ML_QP + c16_ * 16) = __builtin_bit_cast(u32x4_t, R_.pk[i_]); } \
            *(LAS u32x4_t*)(lds + ML_V + (bi_) * 64 * ML_VP + (tid >> 3) * ML_VP + (tid & 7) * 16) = __builtin_bit_cast(u32x4_t, R_.pv); \
            if (tid >= 256 && tid < 320) { LAS float* v_ = vec + (bi_) * 320 + (tid - 256); v_[0] = R_.pg.x; v_[64] = R_.pg.y; v_[128] = R_.pg.z; v_[192] = R_.pg.w; if (tid == 256) vec[(bi_) * 320 + 256] = R_.peg; } } while (0)
        ML_LOAD(rs[0], 0); ML_STORE(rs[0], 0); ML_LOAD(rs[1], 1);
        LBAR();
#pragma nounroll
        for (int c2 = 0; c2 < 64; c2 += 2) {
          int lane = lane0; asm volatile("" : "+v"(lane));
          const int l15 = lane & 15, g4 = lane >> 4, qq = l15 >> 2, pp = lane & 3;
#pragma unroll
          for (int par = 0; par < 2; ++par) {
            const int c = c2 + par, bi_cur = par;
            const LAS unsigned char* Qs = lds + ML_Q + bi_cur * 64 * ML_QP; const LAS unsigned char* Ks = lds + ML_K + bi_cur * 64 * ML_QP;
            const unsigned Ksb = ldsb + ML_K + bi_cur * 64 * ML_QP, Vsb = ldsb + ML_V + bi_cur * 64 * ML_VP, Vwb = ldsb + ML_VW;
            if (c + 2 < 64) ML_LOAD(rs[par], c + 2);
            float4 tq[4]; const size_t tgi = ((size_t)bx * TAB_PER_WG + (size_t)c * 128) * 2 + tid;
            if (tsrc && tid < 256) {
#pragma unroll
                for (int j = 0; j < 4; ++j) tq[j] = ((const float4*)tsrc)[tgi * 4 + j]; }
            const LAS float* vb = vec + bi_cur * 320;
            {
                const int ti = w >> 1;
#pragma unroll
                for (int sj = 0; sj < 2; ++sj) {
                    const int si = 2 * (w & 1) + sj;
                    f32x4_t acc = (f32x4_t){0.f, 0.f, 0.f, 0.f};
                    if (si <= ti) {
#pragma unroll
                        for (int ks = 0; ks < 4; ++ks) {
                            const bf16x8_t a = *(const LAS bf16x8_t*)(Ks + (16 * si + l15) * ML_QP + (32 * ks + 8 * g4) * 2);
                            const bf16x8_t bq = *(const LAS bf16x8_t*)(Qs + (16 * ti + l15) * ML_QP + (32 * ks + 8 * g4) * 2);
                            acc = __builtin_amdgcn_mfma_f32_16x16x32_bf16(a, bq, acc, 0, 0, 0);
                        }
                        const int t = 16 * ti + l15; const float btv = vb[t];
                        const f32x4_t csv = *(const LAS f32x4_t*)(vb + 64 + 16 * si + 4 * g4);
#pragma unroll
                        for (int e = 0; e < 4; ++e) { const int s = 16 * si + 4 * g4 + e; acc[e] = (s <= t) ? acc[e] * __expf(btv + csv[e]) * 0.08838834764831845f : 0.f; }
                    }
                    *(LAS u32x2_t*)(lds + ML_P + (16 * ti + l15) * ML_PP + (16 * si + 4 * g4) * 2) = (u32x2_t){pk2(acc[0], acc[1]), pk2(acc[2], acc[3])};
                }
            }
            for (int it = tid; it < 640; it += 512) { const int s = it / 10, pc = it % 10; const float wsv = vb[192 + s];
                const u32x4_t v = *(const LAS u32x4_t*)(lds + ML_V + bi_cur * 64 * ML_VP + s * ML_VP + pc * 16); u32x4_t o;
#pragma unroll
                for (int j = 0; j < 4; ++j) o[j] = pk2(__uint_as_float(v[j] << 16) * wsv, __uint_as_float(v[j] & 0xffff0000u) * wsv);
                *(LAS u32x4_t*)(lds + ML_VW + s * ML_VP + pc * 16) = o; }
            LBAR();
            f32x4_t numv[3]; const int ti5 = w >> 1;
            {
                const int nv = (w & 1) ? 2 : 3, v0 = (w & 1) ? 3 : 0;
                bf16x8_t pfr[2], qfr[4];
#pragma unroll
                for (int ks = 0; ks < 2; ++ks) pfr[ks] = *(const LAS bf16x8_t*)(lds + ML_P + (16 * ti5 + l15) * ML_PP + (32 * ks + 8 * g4) * 2);
#pragma unroll
                for (int ks = 0; ks < 4; ++ks) qfr[ks] = *(const LAS bf16x8_t*)(Qs + (16 * ti5 + l15) * ML_QP + (32 * ks + 8 * g4) * 2);
#pragma unroll
                for (int j = 0; j < 3; ++j) {
                    numv[j] = (f32x4_t){0.f, 0.f, 0.f, 0.f};
                    if (j < nv) {
                        const int vi = v0 + j;
                        f32x4_t ai = (f32x4_t){0.f, 0.f, 0.f, 0.f}, ax = ai;
#pragma unroll
                        for (int ks = 0; ks < 2; ++ks) {
                            u32x2_t r0, r1; tr_read2q(Vsb + (32 * ks + 8 * g4 + qq) * ML_VP + (16 * vi + 4 * pp) * 2, Vsb + (32 * ks + 8 * g4 + 4 + qq) * ML_VP + (16 * vi + 4 * pp) * 2, r0, r1);
                            ai = __builtin_amdgcn_mfma_f32_16x16x32_bf16(pfr[ks], mk_frag(r0, r1), ai, 0, 0, 0);
                        }
#pragma unroll
                        for (int ks = 0; ks < 4; ++ks) {
                            const bf16x8_t bc = *(const LAS bf16x8_t*)(lds + ML_CT + (16 * vi + l15) * ML_QP + (32 * ks + 8 * g4) * 2);
                            ax = __builtin_amdgcn_mfma_f32_16x16x32_bf16(qfr[ks], bc, ax, 0, 0, 0);
                        }
                        const f32x4_t eb = *(const LAS f32x4_t*)(vb + 128 + 16 * ti5 + 4 * g4);
                        numv[j] = ai + eb * ax;
                    }
                }
                if ((w & 1) && l15 == 0) *(LAS f32x4_t*)(vec + 640 + 16 * ti5 + 4 * g4) = numv[1];
            }
            LBAR();
            {
                const f32x4_t dn = *(const LAS f32x4_t*)(vec + 640 + 16 * ti5 + 4 * g4);
                const size_t tb = (size_t)b * SEQ + (size_t)c * 64;
                const int nw = (w & 1) ? 1 : 3, v0 = (w & 1) ? 3 : 0;
                f32x4_t rdn;
#pragma unroll
                for (int e = 0; e < 4; ++e) rdn[e] = __builtin_amdgcn_rcpf(fmaxf(fabsf(dn[e]), 1.0f));
#pragma unroll
                for (int j = 0; j < 3; ++j)
                    if (j < nw) {
#pragma unroll
                        for (int e = 0; e < 4; ++e) hm[(tb + 16 * ti5 + 4 * g4 + e) * 1024 + h * 256 + vs * 64 + 16 * (v0 + j) + l15] = (bf16)pk2(numv[j][e] * rdn[e], 0.f);
                    }
            }
            {
                const float eg = vb[256];
                bf16x8_t kf[2];
#pragma unroll
                for (int ks = 0; ks < 2; ++ks) { u32x2_t a0, a1; tr_read2q(Ksb + (32 * ks + 8 * g4 + qq) * ML_QP + (16 * w + 4 * pp) * 2, Ksb + (32 * ks + 8 * g4 + 4 + qq) * ML_QP + (16 * w + 4 * pp) * 2, a0, a1); kf[ks] = mk_frag(a0, a1); }
#pragma unroll
                for (int vi = 0; vi < 5; ++vi) {
                    f32x4_t acc = cacc[vi] * eg;
#pragma unroll
                    for (int ks = 0; ks < 2; ++ks) {
                        u32x2_t b0, b1;
                        tr_read2q(Vwb + (32 * ks + 8 * g4 + qq) * ML_VP + (16 * vi + 4 * pp) * 2, Vwb + (32 * ks + 8 * g4 + 4 + qq) * ML_VP + (16 * vi + 4 * pp) * 2, b0, b1);
                        acc = __builtin_amdgcn_mfma_f32_16x16x32_bf16(kf[ks], mk_frag(b0, b1), acc, 0, 0, 0);
                    }
                    cacc[vi] = acc;
                    *(LAS u32x2_t*)(lds + ML_CT + (16 * vi + l15) * ML_QP + (16 * w + 4 * g4) * 2) = (u32x2_t){pk2(acc[0], acc[1]), pk2(acc[2], acc[3])};
                }
            }
            if (tsrc && tid < 256) tab_fp4_store(tq, tdst + tgi * 8, U6_SCALE);
            if (c + 1 < 64) ML_STORE(rs[par ^ 1], bi_cur ^ 1);
            LBAR();
          }
        }
#undef ML_LOAD
#undef ML_STORE
    }
}

constexpr int SD_BP = 272, SD_XP = 144;
constexpr int SD_UNITS = NBATCH * 16;
constexpr int SD_B = 0, SD_C = 128 * SD_BP, SD_M = 2 * 128 * SD_BP, SD_H = 3 * 128 * SD_BP, SD_X = SD_H + 64 * SD_BP, SD_VEC = SD_X + 128 * SD_XP, SD_END = SD_VEC + 4096;
static_assert(SD_END <= PHASE_LDS_BYTES, "SSD LDS");
__device__ __forceinline__ void ssd_phase(LAS unsigned char* lds, const bf16* __restrict__ xcb  , const float4* __restrict__ sg, const float* __restrict__ sea,
                                          const float* __restrict__ dsk, bf16* __restrict__ yraw  , int tid, int bx, int G, const float* __restrict__ tsrc  , unsigned char* __restrict__ tdst) {
    const int lane0 = tid & 63, w = __builtin_amdgcn_readfirstlane(tid >> 6);
    const unsigned ldsb = (unsigned)(size_t)lds;
    LAS float* vec = (LAS float*)(lds + SD_VEC);
    const int hb = G >> 1;
    if (bx >= hb) for (int u = bx - hb; u < SD_UNITS; u += G - hb) {
        const int hh = u & 15, b = u >> 4, g = hh >> 3;
        const float Dk = dsk[hh];
        LBAR();
        for (int i = tid; i < 64 * SD_BP / 4; i += 512) ((LAS unsigned*)(lds + SD_H))[i] = 0u;
        for (int i = tid; i < 128 * SD_BP / 4; i += 512) ((LAS unsigned*)(lds + SD_M))[i] = 0u;
        f32x4_t hacc[4];
#pragma unroll
        for (int i = 0; i < 4; ++i) hacc[i] = (f32x4_t){0.f, 0.f, 0.f, 0.f};
        uint4 pb[4], pc[4], px[2]; float4 pg = make_float4(0.f, 0.f, 0.f, 0.f); float pea = 0.f;
#define SD_LOAD(c_) do { const size_t tb_ = (size_t)b * SEQ + (size_t)(c_) * 128; \
            _Pragma("unroll") for (int i_ = 0; i_ < 4; ++i_) { const int p_ = tid + 512 * i_, row_ = p_ >> 4, c16_ = p_ & 15; const bf16* s_ = xcb + (tb_ + row_) * 1536 + 1024 + g * 128 + c16_ * 8; pb[i_] = *(const uint4*)s_; pc[i_] = *(const uint4*)(s_ + 256); } \
            _Pragma("unroll") for (int i_ = 0; i_ < 2; ++i_) { const int p_ = tid + 512 * i_; px[i_] = *(const uint4*)(xcb + (tb_ + (p_ >> 3)) * 1536 + hh * 64 + (p_ & 7) * 8); } \
            if (tid < 128) { pg = sg[(tb_ + tid) * 16 + hh]; pea = sea[(b * 16 + hh) * 32 + (c_)]; } } while (0)
#define SD_STORE() do { _Pragma("unroll") for (int i_ = 0; i_ < 4; ++i_) { const int p_ = tid + 512 * i_, row_ = p_ >> 4, c16_ = p_ & 15; \
                *(LAS u32x4_t*)(lds + SD_B + row_ * SD_BP + c16_ * 16) = __builtin_bit_cast(u32x4_t, pb[i_]); *(LAS u32x4_t*)(lds + SD_C + row_ * SD_BP + c16_ * 16) = __builtin_bit_cast(u32x4_t, pc[i_]); } \
            _Pragma("unroll") for (int i_ = 0; i_ < 2; ++i_) { const int p_ = tid + 512 * i_; *(LAS u32x4_t*)(lds + SD_X + (p_ >> 3) * SD_XP + (p_ & 7) * 16) = __builtin_bit_cast(u32x4_t, px[i_]); } \
            if (tid < 128) { vec[640 + tid] = pg.x; vec[256 + tid] = pg.y; vec[384 + tid] = pg.z; vec[512 + tid] = pg.w; if (tid == 0) vec[769] = pea; } } while (0)
        SD_LOAD(0); SD_STORE();
        LBAR();
#pragma nounroll
        for (int c = 0; c < 32; ++c) {
            int lane = lane0; asm volatile("" : "+v"(lane));
            const int l15 = lane & 15, g4 = lane >> 4, qq = l15 >> 2, pp = lane & 3;
            if (c + 1 < 32) SD_LOAD(c + 1);
            float4 tq[4]; const size_t tgi = ((size_t)(bx - hb) * TAB_PER_WG + (size_t)c * 256) * 2 + tid;
            if (tsrc) {
#pragma unroll
                for (int j = 0; j < 4; ++j) tq[j] = ((const float4*)tsrc)[tgi * 4 + j]; }
            {
#pragma unroll
                for (int k = 0; k < 5; ++k) {
                    int li, si;
                    if (w >= 4) { li = w; si = w - 4 + k; } else if (k <= w) { li = w; si = k; } else { li = 7 - w; si = k - w - 1; }
                    if (w >= 4 || k <= 3) {
                        const int l = 16 * li + l15; const float acl = vec[256 + l];
                        f32x4_t acc = (f32x4_t){0.f, 0.f, 0.f, 0.f};
#pragma unroll
                        for (int ks = 0; ks < 4; ++ks) {
                            const bf16x8_t av = *(const LAS bf16x8_t*)(lds + SD_B + (16 * si + l15) * SD_BP + (32 * ks + 8 * g4) * 2);
                            const bf16x8_t bv = *(const LAS bf16x8_t*)(lds + SD_C + (16 * li + l15) * SD_BP + (32 * ks + 8 * g4) * 2);
                            acc = __builtin_amdgcn_mfma_f32_16x16x32_bf16(av, bv, acc, 0, 0, 0);
                        }
                        const f32x4_t acs = *(const LAS f32x4_t*)(vec + 256 + 16 * si + 4 * g4), dts = *(const LAS f32x4_t*)(vec + 640 + 16 * si + 4 * g4);
#pragma unroll
                        for (int e = 0; e < 4; ++e) { const int s = 16 * si + 4 * g4 + e; acc[e] = (s <= l) ? acc[e] * __expf(acl - acs[e]) * dts[e] : 0.f; }
                        *(LAS u32x2_t*)(lds + SD_M + l * SD_BP + (16 * si + 4 * g4) * 2) = (u32x2_t){pk2(acc[0], acc[1]), pk2(acc[2], acc[3])};
                    }
                }
            }
            LBAR();
#pragma unroll
            for (int i_ = 0; i_ < 4; ++i_) { const int p_ = tid + 512 * i_, s = p_ >> 4, c16 = p_ & 15; const float wv = vec[512 + s];
                LAS u32x4_t* bp = (LAS u32x4_t*)(lds + SD_B + s * SD_BP + c16 * 16); const u32x4_t v = *bp; u32x4_t o;
#pragma unroll
                for (int j = 0; j < 4; ++j) o[j] = pk2(__uint_as_float(v[j] << 16) * wv, __uint_as_float(v[j] & 0xffff0000u) * wv);
                *bp = o; }
            {
                const int li = w; const size_t tb = (size_t)b * SEQ + (size_t)c * 128;
                const f32x4_t eac = *(const LAS f32x4_t*)(vec + 384 + 16 * li + 4 * g4);
                bf16x8_t mf[4], cf[4];
#pragma unroll
                for (int ks = 0; ks < 4; ++ks) {
                    mf[ks] = *(const LAS bf16x8_t*)(lds + SD_M + (16 * li + l15) * SD_BP + (32 * ks + 8 * g4) * 2);
                    cf[ks] = *(const LAS bf16x8_t*)(lds + SD_C + (16 * li + l15) * SD_BP + (32 * ks + 8 * g4) * 2);
                }
#pragma unroll
                for (int pi = 0; pi < 4; ++pi) {
                    f32x4_t yd = (f32x4_t){0.f, 0.f, 0.f, 0.f}, yo = yd;
#pragma unroll
                    for (int ks = 0; ks < 4; ++ks) {
                        if (32 * ks <= 16 * li + 15) {
                            u32x2_t r0, r1; tr_read2q(ldsb + SD_X + (32 * ks + 8 * g4 + qq) * SD_XP + (16 * pi + 4 * pp) * 2, ldsb + SD_X + (32 * ks + 8 * g4 + 4 + qq) * SD_XP + (16 * pi + 4 * pp) * 2, r0, r1);
                            yd = __builtin_amdgcn_mfma_f32_16x16x32_bf16(mf[ks], mk_frag(r0, r1), yd, 0, 0, 0);
                        }
                    }
#pragma unroll
                    for (int ks = 0; ks < 4; ++ks) {
                        const bf16x8_t bh = *(const LAS bf16x8_t*)(lds + SD_H + (16 * pi + l15) * SD_BP + (32 * ks + 8 * g4) * 2);
                        yo = __builtin_amdgcn_mfma_f32_16x16x32_bf16(cf[ks], bh, yo, 0, 0, 0);
                    }
#pragma unroll
                    for (int e = 0; e < 4; ++e) { const int l = 16 * li + 4 * g4 + e;
                        const float xv = __uint_as_float(((unsigned)*(const LAS unsigned short*)(lds + SD_X + l * SD_XP + (16 * pi + l15) * 2)) << 16);
                        yraw[(tb + l) * 1024 + hh * 64 + 16 * pi + l15] = (bf16)pk2(yd[e] + eac[e] * yo[e] + Dk * xv, 0.f); }
                }
            }
            LBAR();
            {
                const float ea = vec[769];
                bf16x8_t kf[4];
#pragma unroll
                for (int ks = 0; ks < 4; ++ks) { u32x2_t a0, a1; tr_read2q(ldsb + SD_B + (32 * ks + 8 * g4 + qq) * SD_BP + (16 * w + 4 * pp) * 2, ldsb + SD_B + (32 * ks + 8 * g4 + 4 + qq) * SD_BP + (16 * w + 4 * pp) * 2, a0, a1); kf[ks] = mk_frag(a0, a1); }
#pragma unroll
                for (int pi = 0; pi < 4; ++pi) {
                    f32x4_t acc = hacc[pi] * ea;
#pragma unroll
                    for (int ks = 0; ks < 4; ++ks) {
                        u32x2_t b0, b1;
                        tr_read2q(ldsb + SD_X + (32 * ks + 8 * g4 + qq) * SD_XP + (16 * pi + 4 * pp) * 2, ldsb + SD_X + (32 * ks + 8 * g4 + 4 + qq) * SD_XP + (16 * pi + 4 * pp) * 2, b0, b1);
                        acc = __builtin_amdgcn_mfma_f32_16x16x32_bf16(kf[ks], mk_frag(b0, b1), acc, 0, 0, 0);
                    }
                    hacc[pi] = acc;
                    *(LAS u32x2_t*)(lds + SD_H + (16 * pi + l15) * SD_BP + (16 * w + 4 * g4) * 2) = (u32x2_t){pk2(acc[0], acc[1]), pk2(acc[2], acc[3])};
                }
            }
            LBAR();
            if (tsrc) tab_fp4_store(tq, tdst + tgi * 8, V4_SCALE);
            if (c + 1 < 32) SD_STORE();
            LBAR();
        }
#undef SD_LOAD
#undef SD_STORE
    }
}

constexpr int PS_SKP = 272;
constexpr int PS_SK = 0, PS_END = 2 * 128 * PS_SKP;
static_assert(PS_END <= PHASE_LDS_BYTES, "PEER select LDS");
__device__ __forceinline__ unsigned fkey(float f) { const unsigned u = __float_as_uint(f); return u ^ ((unsigned)((int)u >> 31) | 0x80000000u); }
__device__ __forceinline__ float funkey(unsigned k) { return __uint_as_float((k & 0x80000000u) ? (k ^ 0x80000000u) : ~k); }
template <int CTRL> __device__ __forceinline__ unsigned dpp_u(unsigned v) { return (unsigned)__builtin_amdgcn_update_dpp(0, (int)v, CTRL, 0xF, 0xF, true); }
__device__ __forceinline__ unsigned umax(unsigned a, unsigned b) { return a > b ? a : b; }
__device__ __forceinline__ unsigned row_umax(unsigned v) { v = umax(v, dpp_u<0xB1>(v)); v = umax(v, dpp_u<0x4E>(v)); v = umax(v, dpp_u<0x141>(v)); v = umax(v, dpp_u<0x140>(v)); return v; }
__device__ __forceinline__ float row_sum(float v) { v += dpp_f<0xB1>(v); v += dpp_f<0x4E>(v); v += dpp_f<0x141>(v); v += dpp_f<0x140>(v); return v; }
template <int N> __device__ __forceinline__ unsigned row_top16(unsigned (&s)[N], int l15) {
    unsigned mine = 0u;
#pragma unroll
    for (int j = 0; j < 16; ++j) {
        unsigned m = s[0];
#pragma unroll
        for (int i = 1; i < N; ++i) m = umax(m, s[i]);
        m = row_umax(m);
        mine = (l15 == j) ? m : mine;
#pragma unroll
        for (int i = 0; i < N; ++i) s[i] = (s[i] == m) ? 0u : s[i];
    }
    return mine;
}
__device__ __forceinline__ void ce_desc(unsigned& a, unsigned& b) { const unsigned hi = umax(a, b), lo = a < b ? a : b; a = hi; b = lo; }
__device__ __forceinline__ void sort_desc(unsigned (&s)[8]) {
    ce_desc(s[0], s[1]); ce_desc(s[2], s[3]); ce_desc(s[4], s[5]); ce_desc(s[6], s[7]);
    ce_desc(s[0], s[2]); ce_desc(s[1], s[3]); ce_desc(s[4], s[6]); ce_desc(s[5], s[7]);
    ce_desc(s[1], s[2]); ce_desc(s[5], s[6]);
    ce_desc(s[0], s[4]); ce_desc(s[1], s[5]); ce_desc(s[2], s[6]); ce_desc(s[3], s[7]);
    ce_desc(s[2], s[4]); ce_desc(s[3], s[5]);
    ce_desc(s[1], s[2]); ce_desc(s[3], s[4]); ce_desc(s[5], s[6]);
}
__device__ __forceinline__ void sort_desc(unsigned (&s)[4]) { ce_desc(s[0], s[1]); ce_desc(s[2], s[3]); ce_desc(s[0], s[2]); ce_desc(s[1], s[3]); ce_desc(s[1], s[2]); }
template <int N> __device__ __forceinline__ void row_top16x4(unsigned (&s)[4][N], int l15, unsigned (&mine)[4]) {
#pragma unroll
    for (int e = 0; e < 4; ++e) { sort_desc(s[e]); mine[e] = 0u; }
#pragma unroll
    for (int j = 0; j < 16; ++j) {
        unsigned mx[4];
#pragma unroll
        for (int e = 0; e < 4; ++e) mx[e] = s[e][0];
#pragma unroll
        for (int e = 0; e < 4; ++e) mx[e] = umax(mx[e], dpp_u<0xB1>(mx[e]));
#pragma unroll
        for (int e = 0; e < 4; ++e) mx[e] = umax(mx[e], dpp_u<0x4E>(mx[e]));
#pragma unroll
        for (int e = 0; e < 4; ++e) mx[e] = umax(mx[e], dpp_u<0x141>(mx[e]));
#pragma unroll
        for (int e = 0; e < 4; ++e) mx[e] = umax(mx[e], dpp_u<0x140>(mx[e]));
#pragma unroll
        for (int e = 0; e < 4; ++e) {
            mine[e] = (l15 == j) ? mx[e] : mine[e];
            const bool win = s[e][0] == mx[e];
#pragma unroll
            for (int i = 0; i + 1 < N; ++i) s[e][i] = win ? s[e][i + 1] : s[e][i];
            s[e][N - 1] = win ? 0u : s[e][N - 1];
        }
    }
}
__device__ __forceinline__ void peer_select_phase(LAS unsigned char* lds, const bf16* __restrict__ qb  , const bf16* __restrict__ skb  , int* __restrict__ ids, float* __restrict__ gates,
                                                  int tid, int bx, int G) {
    const int lane = tid & 63, w = __builtin_amdgcn_readfirstlane(tid >> 6), l15 = lane & 15, g4 = lane >> 4;
    int ca[4], cb[4];
#pragma unroll
    for (int i = 0; i < 4; ++i) { const int sg = 4 * l15 + i; int a = 0, base = 0;
#pragma unroll
        for (int k = 0; k < 15; ++k) { const int cnt = 16 / (k + 1); const bool adv = (a == k) && (sg >= base + cnt); base += adv ? cnt : 0; a += adv ? 1 : 0; }
        ca[i] = a; cb[i] = sg - base; if (sg >= 50) { ca[i] = -1; cb[i] = 0; } }
    for (int u = bx; u < 8 * 32; u += G) {
        const int h = u >> 5, tr = u & 31;
        LBAR();
        for (int it = tid; it < 4096; it += 512) { const int row = it >> 4, c16 = it & 15;
            *(LAS u32x4_t*)(lds + PS_SK + row * PS_SKP + c16 * 16) = __builtin_bit_cast(u32x4_t, *(const uint4*)(skb + ((size_t)h * 256 + row) * 128 + c16 * 8)); }
        LBAR();
#pragma nounroll
        for (int tile = w; tile < 64; tile += 8) {
            const int t0 = tr * 1024 + tile * 16;
            unsigned top[2][4];
#pragma unroll
            for (int c = 0; c < 2; ++c) {
                bf16x8_t af[4];
#pragma unroll
                for (int ks = 0; ks < 4; ++ks) af[ks] = __builtin_bit_cast(bf16x8_t, *(const uint4*)(qb + (size_t)(t0 + l15) * DM + h * 256 + c * 128 + 32 * ks + 8 * g4));
                unsigned key[8][4];
#pragma unroll
                for (int kt = 0; kt < 8; ++kt) {
                    f32x4_t acc = (f32x4_t){0.f, 0.f, 0.f, 0.f};
#pragma unroll
                    for (int ks = 0; ks < 4; ++ks) {
                        const bf16x8_t bfr = *(const LAS bf16x8_t*)(lds + PS_SK + (c * 128 + 16 * kt + l15) * PS_SKP + (32 * ks + 8 * g4) * 2);
                        acc = __builtin_amdgcn_mfma_f32_16x16x32_bf16(af[ks], bfr, acc, 0, 0, 0);
                    }
#pragma unroll
                    for (int e = 0; e < 4; ++e) key[kt][e] = (fkey(acc[e]) & ~0x7Fu) | (unsigned)(127 - (16 * kt + l15));
                }
                { unsigned s8[4][8];
#pragma unroll
                  for (int e = 0; e < 4; ++e)
#pragma unroll
                      for (int kt = 0; kt < 8; ++kt) s8[e][kt] = key[kt][e];
                  __builtin_amdgcn_sched_barrier(0); row_top16x4<8>(s8, l15, top[c]); __builtin_amdgcn_sched_barrier(0); }
            }
            unsigned s4[4][4], win4[4];
#pragma unroll
            for (int e = 0; e < 4; ++e)
#pragma unroll
                for (int i = 0; i < 4; ++i) {
                    const int srcA = ((lane & 48) + (ca[i] < 0 ? 0 : ca[i])) * 4, srcB = ((lane & 48) + cb[i]) * 4;
                    const unsigned ka = (unsigned)__builtin_amdgcn_ds_bpermute(srcA, (int)top[0][e]), kb = (unsigned)__builtin_amdgcn_ds_bpermute(srcB, (int)top[1][e]);
                    const float cv = funkey(ka & ~0x7Fu) + funkey(kb & ~0x7Fu);
                    s4[e][i] = ca[i] < 0 ? 0u : ((fkey(cv) & ~0xFFu) | (unsigned)(255 - (ca[i] * 16 + cb[i])));
                }
            __builtin_amdgcn_sched_barrier(0); row_top16x4<4>(s4, l15, win4); __builtin_amdgcn_sched_barrier(0);
#pragma unroll
            for (int e = 0; e < 4; ++e) {
                const unsigned win = win4[e];
                const int jw = 255 - (int)(win & 0xFFu), wa = jw >> 4, wb = jw & 15;
                const unsigned ka = (unsigned)__builtin_amdgcn_ds_bpermute(((lane & 48) + wa) * 4, (int)top[0][e]), kb = (unsigned)__builtin_amdgcn_ds_bpermute(((lane & 48) + wb) * 4, (int)top[1][e]);
                const float bv = funkey(ka & ~0x7Fu) + funkey(kb & ~0x7Fu);
                const int id = (127 - (int)(ka & 0x7Fu)) * 128 + (127 - (int)(kb & 0x7Fu));
                const float mx = __builtin_bit_cast(float, __builtin_amdgcn_ds_bpermute((lane & 48) * 4, __builtin_bit_cast(int, bv)));
                const float ex = __expf(bv - mx), den = row_sum(ex);
                const size_t o = (size_t)(t0 + 4 * g4 + e) * 128 + h * 16 + l15;
                ids[o] = id; gates[o] = ex * __builtin_amdgcn_rcpf(den);
            }
        }
    }
}

struct MegaArgs { const float* in[22]; float* out; unsigned char* ws; };
template <int I> __device__ __forceinline__ unsigned long long ld_ptr() {
    unsigned long long v; const auto ka = __builtin_amdgcn_kernarg_segment_ptr();
    asm volatile("s_load_dwordx2 %0, %1, %2\n\ts_waitcnt lgkmcnt(0)" : "=s"(v) : "s"(ka), "n"(I * 8) : "memory");
    return v;
}
#define GAS_ __attribute__((address_space(1)))
#define INF(i) ((const float*)(const GAS_ float*)ld_ptr<(i)>())
#define OUTP ((float*)(GAS_ float*)ld_ptr<22>())
#define WSP ((unsigned char*)(GAS_ unsigned char*)ld_ptr<23>())
enum { I_X = 0, I_WIN, I_MGATEB, I_MNORMW, I_CONVW, I_CONVB, I_DTB, I_ALOG, I_SSMD, I_SNORMW, I_SINKS, I_MERGEB, I_WBR, I_WOUT, I_LN1G, I_LN1B, I_WQ, I_SUBK, I_PU, I_PV, I_LN2G, I_LN2B };

__global__ void __launch_bounds__(512, 2) mega_fwd(MegaArgs a) {
    extern __shared__ __attribute__((aligned(16))) unsigned char lds_raw[];
    LAS unsigned char* lds = (LAS unsigned char*)lds_raw;
    const int wave0 = __builtin_amdgcn_readfirstlane(threadIdx.x >> 6);
    volatile LAS unsigned* MISC = (volatile LAS unsigned*)(lds + MISC_OFF);
    { PHASE_IDS for (int u = tid; u < (LDS_BYTES - PHASE_LDS_BYTES) / 4; u += 512) ((LAS unsigned*)(lds + PHASE_LDS_BYTES))[u] = 0u; }
    __syncthreads();
    { XcdBarrier b0 = xcd_barrier_post((unsigned*)(WSP + WS_CTL) + CW_BAR, MISC + 8); (void)b0; }
#define GRID_BAR() do { XcdBarrier b_; b_.bar = (unsigned*)(WSP + WS_CTL) + CW_BAR; b_.x = xb_xcc_id(); b_.st = MISC + 8; xcd_barrier(b_); } while (0)

    { PHASE_IDS float2* rt = (float2*)(WSP + WS_ROPE);
      for (size_t i = gt; i < (size_t)SEQ * 32; i += NGT) { const int pos = (int)(i >> 5), fi = (int)(i & 31); const float ang = (float)pos * powf(10000.0f, -(float)fi / 32.0f); rt[i] = make_float2(cosf(ang), sinf(ang)); } }
    { PHASE_IDS const float* x = INF(I_X); bf16* xb = (bf16*)(WSP + WS_XB);
      unsigned* xq = (unsigned*)(WSP + WS_XQ);
      for (size_t i = gt; i < (size_t)T_TOK * DM / 4; i += NGT) { const float4 v = ((const float4*)x)[i]; ((uint2*)xb)[i] = make_uint2(pk2(v.x, v.y), pk2(v.z, v.w)); xq[i] = pk4_fp8(v.x, v.y, v.z, v.w); } }

#pragma nounroll
    for (int l = 0; l < DEPTH; ++l) {
        { PHASE_IDS
            unsigned char* ws = WSP; bf16* WinT = (bf16*)(ws + WS_WIN); bf16* WbT = (bf16*)(ws + WS_WB); bf16* WoT = (bf16*)(ws + WS_WO); bf16* WqT = (bf16*)(ws + WS_WQ); float* bias = (float*)(ws + WS_BIAS);
            const float* w_in = INF(I_WIN) + (size_t)l * DM * IN_COLS; const float* w_branch = INF(I_WBR) + (size_t)l * 3 * 1024 * DM; const float* w_out = INF(I_WOUT) + (size_t)l * DM * DM; const float* peer_wq = INF(I_WQ) + (size_t)l * DM * DM;
            const float* merge_gate_b = INF(I_MERGEB) + (size_t)l * 3 * DM;
            LAS float* scr = (LAS float*)(lds + wave * 16384);
            constexpr int I_IN = (DM / 64) * (NP / 32), I_B = (1024 / 64) * (DM / 32), I_O = (DM / 64) * (DM / 32);
            constexpr int NITEMS = I_IN + 3 * I_B + 2 * I_O;
            for (int it = gw; it < NITEMS; it += NGW) {
                int r = it;
                if (r < I_IN) { transpose_item<1>(w_in, DM, IN_COLS, NP, WinT, scr, r, lane, ws + WS_WG8); continue; } r -= I_IN;
                if (r < 3 * I_B) { const int k = r / I_B; transpose_item<2>(w_branch + (size_t)k * 1024 * DM, 1024, DM, DM, nullptr, scr, r - k * I_B, lane, ws + WS_WB8 + (size_t)k * DM * 1024); continue; } r -= 3 * I_B;
                if (r < I_O) { transpose_item<2>(w_out, DM, DM, DM, nullptr, scr, r, lane, ws + WS_WO8); continue; } r -= I_O;
                transpose_item<0>(peer_wq, DM, DM, DM, WqT, scr, r, lane);
            }
            for (size_t n = gt; n < NP; n += NGT) bias[n] = (n >= C_G && n < C_SMALL) ? merge_gate_b[n - C_G] : 0.f;
            { const float4* sk = (const float4*)(INF(I_SUBK) + (size_t)l * 8 * 2 * 128 * 128); uint2* skb = (uint2*)(ws + WS_SKB);
              for (size_t n = gt; n < 8 * 2 * 128 * 128 / 4; n += NGT) { const float4 v = sk[n]; skb[n] = make_uint2(pk2(v.x, v.y), pk2(v.z, v.w)); } }
        }
        GRID_BAR();
        { PHASE_IDS unsigned char* ws = WSP; pg8::Gemm g{(const bf16*)(ws + WS_XQ), (const bf16*)(ws + WS_WG8), T_TOK, C_SMALL - 256, DM / 2}; pg8::StaticOrder S; S.init(T_TOK, C_SMALL - 256, G, bx); S.rfrom = C_AV / 256; S.rto = SMALL_TILE - 1; S.wgm = 4;
          pg8::EpiProj E{(bf16*)(ws + WS_PROJ), (const float*)(ws + WS_BIAS), (float*)(ws + WS_SMALL), NP, GATE_TILE_LO, SMALL_TILE, 0, 1.0f / WG8_SCALE};
          pg8::gemm_phase<pg8::EpiProj, pg8::StaticOrder, true, true, true>(lds, g, S, E, tid); }
        __syncthreads();
        { PHASE_IDS unsigned char* ws = WSP; pg8::Gemm g{(const bf16*)(ws + WS_XB), (const bf16*)(ws + WS_WIN), T_TOK, 512, DM}; pg8::StaticOrder S; S.init(T_TOK, 512, G, bx); S.rfrom = 0; S.rto = C_AV / 256; S.rfrom2 = 1; S.rto2 = SMALL_TILE;
          pg8::EpiProj E{(bf16*)(ws + WS_PROJ), (const float*)(ws + WS_BIAS), (float*)(ws + WS_SMALL), NP, GATE_TILE_LO, SMALL_TILE, 0, 1.0f};
          pg8::gemm_phase<pg8::EpiProj, pg8::StaticOrder, true, true>(lds, g, S, E, tid); }
        GRID_BAR();
        { PHASE_IDS unsigned char* ws = WSP; const bf16* proj = (const bf16*)(ws + WS_PROJ); bf16* xcb = (bf16*)(ws + WS_R2);
          const float* cwg = INF(I_CONVW) + (size_t)l * 4 * 1536; const float* cbg = INF(I_CONVB) + l * 1536;
          LAS float* cw = (LAS float*)(lds + 16384); LAS float* cb = cw + 4 * 1536;
          for (int n = tid; n < 4 * 1536 / 4; n += 512) { const float4 v = ((const float4*)cwg)[n]; *(LAS f32x4e_t*)(cw + 4 * n) = (f32x4e_t){v.x, v.y, v.z, v.w}; }
          for (int n = tid; n < 1536 / 4; n += 512) { const float4 v = ((const float4*)cbg)[n]; *(LAS f32x4e_t*)(cb + 4 * n) = (f32x4e_t){v.x, v.y, v.z, v.w}; }
          asm volatile("s_waitcnt lgkmcnt(0)" ::: "memory"); __builtin_amdgcn_s_barrier(); asm volatile("" ::: "memory");
          for (int i = (int)gt; i < 192 * (T_TOK / 8); i += (int)NGT) ssd_conv_item(i, proj, cw, cb, xcb); }
        { PHASE_IDS unsigned char* ws = WSP; const float* small = (const float*)(ws + WS_SMALL); LAS float* wl = (LAS float*)(lds + wave * 1024);
          for (int i = gw; i < NBATCH * 4 * 64; i += NGW) mlstm_gate_item(i, lane, wl, small, INF(I_MGATEB) + l * 8, (float4*)(ws + WS_MG), (float*)(ws + WS_MEG));
          for (int i = gw; i < NBATCH * 16 * 32; i += NGW) ssd_gate_item(i, lane, wl, small, INF(I_DTB) + l * 16, INF(I_ALOG) + l * 16, (float4*)(ws + WS_SG), (float*)(ws + WS_SEA)); }
        GRID_BAR();
        { PHASE_IDS unsigned char* ws = WSP; mlstm_phase(lds, (const bf16*)(ws + WS_PROJ), (const float4*)(ws + WS_MG), (const float*)(ws + WS_MEG), (bf16*)(ws + WS_HM), tid, bx, G, G == 256 ? INF(I_PU) + (size_t)l * P_EXPERTS * DM : nullptr, ws + WS_TAB); }
        { PHASE_IDS unsigned char* ws = WSP; ssd_phase(lds, (const bf16*)(ws + WS_R2), (const float4*)(ws + WS_SG), (const float*)(ws + WS_SEA), INF(I_SSMD) + l * 16, (bf16*)(ws + WS_R1), tid, bx, G, G == 256 ? INF(I_PV) + (size_t)l * P_EXPERTS * DM : nullptr, ws + WS_TAB + 32 * MiB); }
        { PHASE_IDS unsigned char* ws = WSP; swa_phase(lds, (const bf16*)(ws + WS_PROJ), (const float*)(ws + WS_ROPE), INF(I_SINKS) + l * 16, ws + WS_YQ + 64 * MiB, tid, bx, G); }
        GRID_BAR();
        { PHASE_IDS unsigned char* ws = WSP; const bf16* proj = (const bf16*)(ws + WS_PROJ); const bf16* hm = (const bf16*)(ws + WS_HM); unsigned char* ym = ws + WS_YQ; const float* nwg = INF(I_MNORMW) + l * 1024; const float* nsg = INF(I_SNORMW) + l * 1024;
          LAS float* nw = (LAS float*)lds; LAS float* nsl = nw + 1024;
          if (tid < 256) { const float4 v = ((const float4*)nwg)[tid]; *(LAS f32x4e_t*)(nw + 4 * tid) = (f32x4e_t){v.x, v.y, v.z, v.w}; }
          else { const float4 v = ((const float4*)nsg)[tid - 256]; *(LAS f32x4e_t*)(nsl + 4 * (tid - 256)) = (f32x4e_t){v.x, v.y, v.z, v.w}; }
          asm volatile("s_waitcnt lgkmcnt(0)" ::: "memory"); __builtin_amdgcn_s_barrier(); asm volatile("" ::: "memory");
          for (int t = gw; t < T_TOK; t += NGW) mlstm_post_tok(t, lane, hm, proj, nw, ym); }
        { PHASE_IDS unsigned char* ws = WSP; const bf16* proj = (const bf16*)(ws + WS_PROJ); const bf16* yraw = (const bf16*)(ws + WS_R1); unsigned char* ys = ws + WS_YQ + 32 * MiB; const LAS float* nw = (const LAS float*)lds + 1024;
          for (int tp = gw; tp < T_TOK / 2; tp += NGW) ssd_post_tok2(tp, lane, yraw, proj, nw, ys); }
        GRID_BAR();
        { PHASE_IDS unsigned char* ws = WSP; pg8::Gemm g{(const bf16*)(ws + WS_YQ), (const bf16*)(ws + WS_WB8), T_TOK, DM, 512}; pg8::StaticOrder S; S.init(T_TOK, DM, G, bx); S.wgm = 4;
          pg8::EpiMix<1, 0, 8, 2> E{(bf16*)(ws + WS_R1), (const bf16*)(ws + WS_PROJ) + C_G, DM, NP, nullptr};
          pg8::gemm_phase<pg8::EpiMix<1, 0, 8, 2>, pg8::StaticOrder, true, true, true>(lds, g, S, E, tid); }
        __syncthreads();
        { PHASE_IDS unsigned char* ws = WSP; pg8::Gemm g{(const bf16*)(ws + WS_YQ + 32 * MiB), (const bf16*)(ws + WS_WB8 + (size_t)DM * 1024), T_TOK, DM, 512}; pg8::StaticOrder S; S.init(T_TOK, DM, G, bx); S.wgm = 4;
          pg8::EpiMix<0, 0, 8, 2> E{(bf16*)(ws + WS_R1), (const bf16*)(ws + WS_PROJ) + C_G + DM, DM, NP, nullptr};
          pg8::gemm_phase<pg8::EpiMix<0, 0, 8, 2>, pg8::StaticOrder, true, true, true>(lds, g, S, E, tid); }
        __syncthreads();
        { PHASE_IDS unsigned char* ws = WSP; pg8::Gemm g{(const bf16*)(ws + WS_YQ + 64 * MiB), (const bf16*)(ws + WS_WB8 + (size_t)2 * DM * 1024), T_TOK, DM, 512}; pg8::StaticOrder S; S.init(T_TOK, DM, G, bx); S.wgm = 4;
          pg8::EpiMix<0, 1, 8, 2> E{(bf16*)(ws + WS_R1), (const bf16*)(ws + WS_PROJ) + C_G + 2 * DM, DM, NP, ws + WS_R1Q};
          pg8::gemm_phase<pg8::EpiMix<0, 1, 8, 2>, pg8::StaticOrder, true, true, true>(lds, g, S, E, tid); }
        GRID_BAR();
        { PHASE_IDS unsigned char* ws = WSP;
          pg8::Gemm g{(const bf16*)(ws + WS_R1Q), (const bf16*)(ws + WS_WO8), T_TOK, DM, DM / 2}; pg8::StaticOrder S; S.init(T_TOK, DM, G, bx); S.wgm = 4; pg8::EpiResidB<8> E{(bf16*)(ws + WS_XB), DM, ALPHA, 0};
          pg8::gemm_phase<pg8::EpiResidB<8>, pg8::StaticOrder, true, true, true>(lds, g, S, E, tid); }
        GRID_BAR();
        { PHASE_IDS unsigned char* ws = WSP; bf16* xb = (bf16*)(ws + WS_XB); const float* g1g = INF(I_LN1G) + l * DM; const float* b1g = INF(I_LN1B) + l * DM;
          LAS float* g1 = (LAS float*)lds; LAS float* b1 = g1 + DM;
          { const float4 v = ((const float4*)g1g)[tid], w = ((const float4*)b1g)[tid]; *(LAS f32x4e_t*)(g1 + 4 * tid) = (f32x4e_t){v.x, v.y, v.z, v.w}; *(LAS f32x4e_t*)(b1 + 4 * tid) = (f32x4e_t){w.x, w.y, w.z, w.w}; }
          asm volatile("s_waitcnt lgkmcnt(0)" ::: "memory"); __builtin_amdgcn_s_barrier(); asm volatile("" ::: "memory");
          for (int tp = gw; tp < T_TOK / 2; tp += NGW) ln_body2b(tp, lane, xb, g1, b1); }
        { PHASE_IDS unsigned char* ws = WSP; constexpr size_t NGRP = (size_t)P_EXPERTS * DM / 32;
          const float* pu = INF(I_PU) + (size_t)l * P_EXPERTS * DM; const float* pv = INF(I_PV) + (size_t)l * P_EXPERTS * DM; unsigned char* U6 = ws + WS_TAB; unsigned char* V6 = ws + WS_TAB + 32 * MiB;
          if (G != 256) for (size_t i = gt; i < NGRP; i += NGT) { tab_to_fp4(i, pu, U6, U6_SCALE); tab_to_fp4(i, pv, V6, V4_SCALE); } }
        GRID_BAR();
        { PHASE_IDS unsigned char* ws = WSP; pg8::Gemm g{(const bf16*)(ws + WS_XB), (const bf16*)(ws + WS_WQ), T_TOK, DM, DM}; pg8::StaticOrder S; S.init(T_TOK, DM, G, bx); S.wgm = 4;
          pg8::EpiProj E{(bf16*)(ws + WS_QF), nullptr, nullptr, DM, 1 << 20, -1, 0, 1.0f};
          pg8::gemm_phase<pg8::EpiProj, pg8::StaticOrder, true, true>(lds, g, S, E, tid); }
        GRID_BAR();
        { PHASE_IDS unsigned char* ws = WSP; peer_select_phase(lds, (const bf16*)(ws + WS_QF), (const bf16*)(ws + WS_SKB), (int*)(ws + WS_IDS), (float*)(ws + WS_GATES), tid, bx, G); }
        GRID_BAR();
        { PHASE_IDS unsigned char* ws = WSP; const int* ids = (const int*)(ws + WS_IDS); const float* gates = (const float*)(ws + WS_GATES);
          const unsigned char* U8 = ws + WS_TAB; const unsigned char* V8 = ws + WS_TAB + 32 * MiB;     const float* g2 = INF(I_LN2G) + l * DM; const float* b2 = INF(I_LN2B) + l * DM; float* out = OUTP; bf16* xb = (bf16*)(ws + WS_XB);
          LAS unsigned* wl = (LAS unsigned*)(lds + wave * 2048);
          LAS float* gl = (LAS float*)(lds + 16384); LAS float* bl = gl + DM;
          for (int n = tid; n < DM / 4; n += 512) { const int ln_ = n >> 3, i_ = n & 7; const float4 gv = ((const float4*)g2)[n], bv = ((const float4*)b2)[n];
              *(LAS f32x4e_t*)(gl + (i_ * 64 + ln_) * 4) = (f32x4e_t){gv.x, gv.y, gv.z, gv.w}; *(LAS f32x4e_t*)(bl + (i_ * 64 + ln_) * 4) = (f32x4e_t){bv.x, bv.y, bv.z, bv.w}; }
          asm volatile("s_waitcnt lgkmcnt(0)" ::: "memory"); __builtin_amdgcn_s_barrier(); asm volatile("" ::: "memory");
          for (int t = gw; t < T_TOK; t += NGW) peer_expert_body(t, lane, l == DEPTH - 1, ids, gates, U8, V8, gl, bl, out, xb, ws + WS_XQ, wl); }
        GRID_BAR();
    }
#undef GRID_BAR
}

extern "C" void kernel_launch(void* const* d_in, const int* in_sizes, int n_in, void* d_out, int out_size, void* d_ws, size_t ws_size, hipStream_t stream) {
    static int grid = 0;
    if (grid == 0) {
        if (n_in != 22 || out_size != T_TOK * DM || ws_size < WS_END) { fprintf(stderr, "kernel_launch: unexpected shapes (n_in %d, out %d, ws %zu)\n", n_in, out_size, ws_size); grid = -1; return; }
        int dev = 0, cus = 0, per_cu = 0;
        if (hipGetDevice(&dev) != hipSuccess || hipDeviceGetAttribute(&cus, hipDeviceAttributeMultiprocessorCount, dev) != hipSuccess) { grid = -1; return; }
        if (hipFuncSetAttribute((const void*)mega_fwd, hipFuncAttributeMaxDynamicSharedMemorySize, LDS_BYTES) != hipSuccess) { fprintf(stderr, "kernel_launch: hipFuncSetAttribute failed\n"); grid = -1; return; }
        if (hipOccupancyMaxActiveBlocksPerMultiprocessor(&per_cu, (const void*)mega_fwd, 512, LDS_BYTES) != hipSuccess || per_cu < 1) { fprintf(stderr, "kernel_launch: occupancy query says %d blocks per CU\n", per_cu); (void)hipGetLastError(); grid = -1; return; }
        grid = cus;
    }
    if (grid < 0) return;
    (void)hipMemsetAsync((char*)d_ws + WS_CTL, 0, CTL_ZERO_BYTES, stream);
    MegaArgs a; memset(&a, 0, sizeof(a));
    for (int i = 0; i < 22; ++i) a.in[i] = (const float*)d_in[i];
    a.out = (float*)d_out; a.ws = (unsigned char*)d_ws;
    hipLaunchKernelGGL(mega_fwd, dim3(grid), dim3(512), LDS_BYTES, stream, a);
}
```

```cpp
#include <hip/hip_runtime.h>
#include <cstdio>
#include <cstdint>
#include <cstring>

namespace pg8 {
#define PG8_LAS __attribute__((address_space(3)))
typedef unsigned short bf16_t;
typedef short bf16x8 __attribute__((ext_vector_type(8)));
typedef float f32x4 __attribute__((ext_vector_type(4)));
typedef unsigned u32x4 __attribute__((ext_vector_type(4)));
typedef unsigned u32x2 __attribute__((ext_vector_type(2)));
constexpr int BM = 256, BK = 64, HALF = 128, HTB = HALF * BK * 2  , STAGE_BYTES = 8 * HTB, NXCD = 8, WGM = 8;

__host__ __device__ __forceinline__ int lds_byte(int r, int c) { const int st = (r >> 4) * 2 + (c >> 5), rr = r & 15, cc = c & 31, ob = rr * 64 + cc * 2; return st * 1024 + (ob ^ (((ob >> 9) & 1) << 5)); }
__host__ __device__ __forceinline__ void stage_rc(int b, int& R, int& C) { const int st = b / 1024, sb = b % 1024, swz = sb ^ (((sb >> 9) & 1) << 5); R = (st >> 1) * 16 + swz / 64; C = (st & 1) * 32 + (swz % 64) / 2; }
__host__ __device__ __forceinline__ int perm32(int rho) { const int n = rho >> 4, i = rho & 15; return 8 * (i >> 2) + 4 * n + (i & 3); }

struct Unit { int pm, pn; };
struct Gemm { const bf16_t* A; const bf16_t* Bt; int M, N, K; };

typedef int i32x4 __attribute__((ext_vector_type(4)));
typedef int i32x8 __attribute__((ext_vector_type(8)));
struct StaticOrder {
    int nM, nN, nwg, G, c, rfrom, rto, rfrom2, rto2, i0, i1, wgm;
    __host__ __device__ void init(int M, int N, int G_, int c_) { nM = M / BM; nN = N / BM; nwg = nM * nN; G = G_; c = c_; rfrom = -1; rto = -1; rfrom2 = -1; rto2 = -1; i0 = 0; i1 = 1 << 30; wgm = WGM; }
    __host__ __device__ bool next(int i, Unit& u) const {
        if (i + i0 >= i1) return false;
        const long L = (long)(i + i0) * G + c; if (L >= nwg) return false;
        int wgid = (int)L; { const int q = nwg / NXCD, r = nwg % NXCD, xcd = wgid % NXCD, off = wgid / NXCD; wgid = (xcd < r ? xcd * (q + 1) : r * (q + 1) + (xcd - r) * q) + off; }
        const int nig = wgm * nN, gid = wgid / nig, fm = gid * wgm, gsz = (nM - fm) < wgm ? (nM - fm) : wgm;
        u.pm = fm + ((wgid % nig) % gsz); u.pn = (wgid % nig) / gsz; if (u.pn == rfrom) u.pn = rto; else if (u.pn == rfrom2) u.pn = rto2; return true;
    }
    __device__ __forceinline__ void a_ready(const Unit&) const {}
    __device__ __forceinline__ void done(const Unit&) const {}
};

typedef float cvt2f_t __attribute__((ext_vector_type(2)));
typedef __bf16 cvt2b_t __attribute__((ext_vector_type(2)));
__device__ __forceinline__ unsigned cvt_pk_bf16(float lo, float hi) { const cvt2f_t f = {lo, hi}; return __builtin_bit_cast(unsigned, __builtin_convertvector(f, cvt2b_t)); }
typedef float f32x2 __attribute__((ext_vector_type(2)));
__device__ __forceinline__ float bf_lo(unsigned w) { return __uint_as_float(w << 16); }
__device__ __forceinline__ float bf_hi(unsigned w) { return __uint_as_float(w & 0xffff0000u); }
__device__ __forceinline__ unsigned cvt_pk4_fp8(float a, float b, float c, float d) { int p = __builtin_amdgcn_cvt_pk_fp8_f32(a, b, 0, false); p = __builtin_amdgcn_cvt_pk_fp8_f32(c, d, p, true); return (unsigned)p; }
__device__ __forceinline__ float sigmoidf_(float x) { return __builtin_amdgcn_rcpf(1.0f + __expf(-x)); }

struct EpiF32 {
    static constexpr bool PERM = false, AFTER_DRAIN = false;
    float* C; int ldc; int pad;
    __device__ __forceinline__ void operator()(const f32x4 (&acc)[2][2][4][2], const Unit& u, int wr, int wc, int fr, int fq) const {
        const int row0 = u.pm * BM + wr * 64 + fr, col0 = u.pn * BM + wc * 32 + 4 * fq;
#pragma unroll
        for (int ai = 0; ai < 2; ++ai)
#pragma unroll
            for (int m = 0; m < 4; ++m) { float* rowp = C + (size_t)(row0 + ai * HALF + m * 16) * ldc + col0;
#pragma unroll
                for (int bj = 0; bj < 2; ++bj)
#pragma unroll
                    for (int n = 0; n < 2; ++n) *(f32x4*)(rowp + bj * HALF + n * 16) = acc[ai][bj][m][n]; }
    }
};
struct EpiResid {
    static constexpr bool PERM = false, AFTER_DRAIN = false;
    float* C; const float* X; int ldc; float alpha;
    __device__ __forceinline__ void operator()(const f32x4 (&acc)[2][2][4][2], const Unit& u, int wr, int wc, int fr, int fq) const {
        const int row0 = u.pm * BM + wr * 64 + fr, col0 = u.pn * BM + wc * 32 + 4 * fq;
#pragma unroll
        for (int ai = 0; ai < 2; ++ai)
#pragma unroll
            for (int m = 0; m < 4; ++m) { const size_t off = (size_t)(row0 + ai * HALF + m * 16) * ldc + col0;
#pragma unroll
                for (int bj = 0; bj < 2; ++bj)
#pragma unroll
                    for (int n = 0; n < 2; ++n) { const f32x4 xv = *(const f32x4*)(X + off + bj * HALF + n * 16);
                        *(f32x4*)(C + off + bj * HALF + n * 16) = acc[ai][bj][m][n] + xv * alpha; } }
    }
};
template <int ASH = 0> struct EpiResidB {
    static constexpr bool PERM = true, AFTER_DRAIN = false;
    static constexpr float ascale = 1.0f / (float)(1 << ASH);
    bf16_t* O; int ldc; float alpha; int pad;
    __device__ __forceinline__ void operator()(const f32x4 (&acc)[2][2][4][2], const Unit& u, int wr, int wc, int fr, int fq) const {
        const int row0 = u.pm * BM + wr * 64 + fr, col0 = u.pn * BM + wc * 32 + 8 * fq;
#pragma unroll
        for (int ai = 0; ai < 2; ++ai) {
            u32x4 ow[4][2];
#pragma unroll
            for (int m = 0; m < 4; ++m)
#pragma unroll
                for (int bj = 0; bj < 2; ++bj) ow[m][bj] = *(const u32x4*)(O + (size_t)(row0 + ai * HALF + m * 16) * ldc + col0 + bj * HALF);
#pragma unroll
            for (int m = 0; m < 4; ++m) { bf16_t* rowp = O + (size_t)(row0 + ai * HALF + m * 16) * ldc + col0;
#pragma unroll
                for (int bj = 0; bj < 2; ++bj) { const u32x4 o = ow[m][bj];
                    const f32x4 a0 = acc[ai][bj][m][0], a1 = acc[ai][bj][m][1];
                    const float r0 = bf_lo(o.x) * alpha + a0[0] * ascale, r1 = bf_hi(o.x) * alpha + a0[1] * ascale, r2 = bf_lo(o.y) * alpha + a0[2] * ascale, r3 = bf_hi(o.y) * alpha + a0[3] * ascale;
                    const float r4 = bf_lo(o.z) * alpha + a1[0] * ascale, r5 = bf_hi(o.z) * alpha + a1[1] * ascale, r6 = bf_lo(o.w) * alpha + a1[2] * ascale, r7 = bf_hi(o.w) * alpha + a1[3] * ascale;
                    u32x4 w; w.x = cvt_pk_bf16(r0, r1); w.y = cvt_pk_bf16(r2, r3); w.z = cvt_pk_bf16(r4, r5); w.w = cvt_pk_bf16(r6, r7);
                    *(u32x4*)(rowp + bj * HALF) = w; } }
        }
    }
};
struct EpiProj {
    static constexpr bool PERM = true, AFTER_DRAIN = false;
    bf16_t* O; const float* bias; float* small; int ldc; int gate_lo; int small_tile; int pn_off; float ascale;
    __device__ __forceinline__ void operator()(const f32x4 (&acc)[2][2][4][2], const Unit& u, int wr, int wc, int fr, int fq) const {
        const int pn = u.pn + pn_off; const int row0 = u.pm * BM + wr * 64 + fr, col0 = pn * BM + wc * 32 + 8 * fq;
        if (pn == small_tile) {
            if (wc == 0) {
#pragma unroll
                for (int ai = 0; ai < 2; ++ai)
#pragma unroll
                    for (int m = 0; m < 4; ++m) { float* p = small + (size_t)(row0 + ai * HALF + m * 16) * 32 + 8 * fq;
                        *(f32x4*)p = acc[ai][0][m][0]; *(f32x4*)(p + 4) = acc[ai][0][m][1]; }
            }
            return;
        }
        const bool gate = pn >= gate_lo;
        f32x4 bv[2][2];
#pragma unroll
        for (int bj = 0; bj < 2; ++bj)
#pragma unroll
            for (int n = 0; n < 2; ++n) bv[bj][n] = gate ? *(const f32x4*)(bias + col0 + bj * HALF + 4 * n) : (f32x4){0.f, 0.f, 0.f, 0.f};
#pragma unroll
        for (int ai = 0; ai < 2; ++ai)
#pragma unroll
            for (int m = 0; m < 4; ++m) { bf16_t* rowp = O + (size_t)(row0 + ai * HALF + m * 16) * ldc + col0;
#pragma unroll
                for (int bj = 0; bj < 2; ++bj) { f32x4 v0 = acc[ai][bj][m][0] * ascale + bv[bj][0], v1 = acc[ai][bj][m][1] * ascale + bv[bj][1];
                    if (gate) {
#pragma unroll
                        for (int j = 0; j < 4; ++j) { v0[j] = sigmoidf_(v0[j]); v1[j] = sigmoidf_(v1[j]); } }
                    u32x4 w; w.x = cvt_pk_bf16(v0[0], v0[1]); w.y = cvt_pk_bf16(v0[2], v0[3]); w.z = cvt_pk_bf16(v1[0], v1[1]); w.w = cvt_pk_bf16(v1[2], v1[3]);
                    *(u32x4*)(rowp + bj * HALF) = w; } }
    }
};
template <int FIRST, int LASTQ = 0, int ASH = 0, int QSH = 0> struct EpiMix {
    static constexpr bool PERM = true, AFTER_DRAIN = false;
    static constexpr float ascale = 1.0f / (float)(1 << ASH), qscale = (float)(1 << QSH);
    bf16_t* O; const bf16_t* G; int ldc; int ldg; unsigned char* Q;
    __device__ __forceinline__ void operator()(const f32x4 (&acc)[2][2][4][2], const Unit& u, int wr, int wc, int fr, int fq) const {
        const int row0 = u.pm * BM + wr * 64 + fr, col0 = u.pn * BM + wc * 32 + 8 * fq;
#pragma unroll
        for (int ai = 0; ai < 2; ++ai) {
            u32x4 gwv[4][2], owv[4][2];
#pragma unroll
            for (int m = 0; m < 4; ++m)
#pragma unroll
                for (int bj = 0; bj < 2; ++bj) { const int row = row0 + ai * HALF + m * 16;
                    gwv[m][bj] = *(const u32x4*)(G + (size_t)row * ldg + col0 + bj * HALF);
                    owv[m][bj] = (u32x4){0u, 0u, 0u, 0u}; if (!FIRST) owv[m][bj] = *(const u32x4*)(O + (size_t)row * ldc + col0 + bj * HALF); }
#pragma unroll
            for (int m = 0; m < 4; ++m) { const int row = row0 + ai * HALF + m * 16; bf16_t* rowp = O + (size_t)row * ldc + col0;
#pragma unroll
                for (int bj = 0; bj < 2; ++bj) { const u32x4 gw = gwv[m][bj], ow = owv[m][bj];
                    const f32x4 a0 = acc[ai][bj][m][0] * ascale, a1 = acc[ai][bj][m][1] * ascale;
                    float r0 = bf_lo(ow.x) + bf_lo(gw.x) * a0[0], r1 = bf_hi(ow.x) + bf_hi(gw.x) * a0[1], r2 = bf_lo(ow.y) + bf_lo(gw.y) * a0[2], r3 = bf_hi(ow.y) + bf_hi(gw.y) * a0[3];
                    float r4 = bf_lo(ow.z) + bf_lo(gw.z) * a1[0], r5 = bf_hi(ow.z) + bf_hi(gw.z) * a1[1], r6 = bf_lo(ow.w) + bf_lo(gw.w) * a1[2], r7 = bf_hi(ow.w) + bf_hi(gw.w) * a1[3];
                    if constexpr (LASTQ) { *(u32x2*)(Q + (size_t)row * ldc + col0 + bj * HALF) = (u32x2){cvt_pk4_fp8(r0 * qscale, r1 * qscale, r2 * qscale, r3 * qscale), cvt_pk4_fp8(r4 * qscale, r5 * qscale, r6 * qscale, r7 * qscale)}; }
                    else { u32x4 w; w.x = cvt_pk_bf16(r0, r1); w.y = cvt_pk_bf16(r2, r3); w.z = cvt_pk_bf16(r4, r5); w.w = cvt_pk_bf16(r6, r7);
                        *(u32x4*)(rowp + bj * HALF) = w; } } }
        }
    }
};
template <class Epi, class Sched, bool ALIGN_EPI = false, bool SP2 = false, bool FP8 = false>
__device__ __forceinline__ void gemm_phase(PG8_LAS unsigned char* lds, const Gemm g, const Sched& S, const Epi& E, int tid_) {
    asm volatile("" : "+v"(tid_));
    const int tid = tid_, wid = __builtin_amdgcn_readfirstlane(tid >> 6), lane = tid & 63, wr = wid >> 2, wc = wid & 3, fr = lane & 15, fq = lane >> 4;
    const int K = g.K, nt = K / BK;
    unsigned voffA[2], voffB[2];
#pragma unroll
    for (int i = 0; i < 2; ++i) { int R, C; stage_rc(tid * 16 + i * 8192, R, C); const int Rb = Epi::PERM ? ((R & ~31) + perm32(R & 31)) : R;
        voffA[i] = (unsigned)(R * K + C) * 2u; voffB[i] = (unsigned)(Rb * K + C) * 2u; }
    const size_t kstep = (size_t)(BK * 2);
    const size_t hstep = (size_t)HALF * K * 2;
    const size_t tstep = 2 * hstep;
    const unsigned ldsw = (unsigned)wid * 1024u;
    const int aoff = lds_byte(wr * 64 + fr, fq * 8), boff = lds_byte(wc * 32 + fr, fq * 8);
#define PG8_SA(b, h) (((b) * 2 + (h)) * HTB)
#define PG8_SB(b, h) ((4 + (b) * 2 + (h)) * HTB)
#define PG8_STAGE(bufoff, gbase, voff) do { _Pragma("unroll") for (int _i = 0; _i < 2; ++_i) \
        __builtin_amdgcn_global_load_lds((const unsigned*)((const char*)(gbase) + (voff)[_i]), (PG8_LAS unsigned*)(lds + (bufoff) + ldsw + _i * 8192), 16, 0, 0); } while (0)
#define PG8_LDA(dst, b, h) do { _Pragma("unroll") for (int m = 0; m < 4; ++m) _Pragma("unroll") for (int k = 0; k < 2; ++k) dst[m][k] = *(const PG8_LAS bf16x8*)(lds + PG8_SA(b, h) + aoff + m * 2048 + k * 1024); } while (0)
#define PG8_LDB(dst, b, h) do { _Pragma("unroll") for (int n = 0; n < 2; ++n) _Pragma("unroll") for (int k = 0; k < 2; ++k) dst[n][k] = *(const PG8_LAS bf16x8*)(lds + PG8_SB(b, h) + boff + n * 2048 + k * 1024); } while (0)
#define PG8_CAT(lo, hi) ((i32x8){__builtin_bit_cast(i32x4, lo)[0], __builtin_bit_cast(i32x4, lo)[1], __builtin_bit_cast(i32x4, lo)[2], __builtin_bit_cast(i32x4, lo)[3], __builtin_bit_cast(i32x4, hi)[0], __builtin_bit_cast(i32x4, hi)[1], __builtin_bit_cast(i32x4, hi)[2], __builtin_bit_cast(i32x4, hi)[3]})
#define PG8_MMA(ai, bj, At, Bt) do { __builtin_amdgcn_s_setprio(1); _Pragma("unroll") for (int m = 0; m < 4; ++m) _Pragma("unroll") for (int n = 0; n < 2; ++n) { \
        if constexpr (FP8) { asm volatile("v_mfma_scale_f32_16x16x128_f8f6f4 %0, %1, %2, %0, %3, %3 op_sel_hi:[0,0,0]" : "+v"(acc[ai][bj][m][n]) : "v"(PG8_CAT(Bt[n][0], Bt[n][1])), "v"(PG8_CAT(At[m][0], At[m][1])), "v"(fp8_unit_scale)); } \
        else { _Pragma("unroll") for (int k = 0; k < 2; ++k) acc[ai][bj][m][n] = __builtin_amdgcn_mfma_f32_16x16x32_bf16(Bt[n][k], At[m][k], acc[ai][bj][m][n], 0, 0, 0); } } \
        __builtin_amdgcn_s_setprio(0); } while (0)
#define PG8_WAIT_V(n) asm volatile("s_waitcnt vmcnt(" #n ")" ::: "memory")
#define PG8_WAIT_L(n) asm volatile("s_waitcnt lgkmcnt(" #n ")" ::: "memory")
#define PG8_BAR __builtin_amdgcn_s_barrier()
#define PG8_SCHED __builtin_amdgcn_sched_barrier(0)
    Unit cur, nxt; int ui = 0;
    [[maybe_unused]] int fp8_unit_scale = 0x7F7F7F7F;
    if constexpr (FP8) asm volatile("" : "+v"(fp8_unit_scale));
    if (!S.next(0, cur)) return;
    f32x4 acc[2][2][4][2];
#pragma unroll
    for (int a = 0; a < 2; ++a)
#pragma unroll
        for (int b = 0; b < 2; ++b)
#pragma unroll
            for (int m = 0; m < 4; ++m)
#pragma unroll
                for (int n = 0; n < 2; ++n) acc[a][b][m][n] = (f32x4){0.f, 0.f, 0.f, 0.f};
    bf16x8 At[4][2], B0[2][2], B1[2][2];
    const char* cA = (const char*)g.A + (size_t)cur.pm * tstep; const char* cB = (const char*)g.Bt + (size_t)cur.pn * tstep;
    S.a_ready(cur);
    if constexpr (SP2) {
        PG8_STAGE(PG8_SB(0, 0), cB, voffB); PG8_STAGE(PG8_SB(0, 1), cB + hstep, voffB); PG8_STAGE(PG8_SA(0, 0), cA, voffA); PG8_STAGE(PG8_SA(0, 1), cA + hstep, voffA);
        if (wr == 1) PG8_BAR;
        PG8_WAIT_V(2); PG8_BAR;
        PG8_STAGE(PG8_SB(1, 0), cB + kstep, voffB); PG8_STAGE(PG8_SA(1, 0), cA + kstep, voffA); PG8_STAGE(PG8_SB(1, 1), cB + hstep + kstep, voffB);
        PG8_WAIT_V(6); PG8_BAR;
    } else {
        PG8_STAGE(PG8_SB(0, 0), cB, voffB); PG8_STAGE(PG8_SA(0, 0), cA, voffA); PG8_STAGE(PG8_SB(0, 1), cB + hstep, voffB); PG8_STAGE(PG8_SA(0, 1), cA + hstep, voffA);
        if (wr == 1) PG8_BAR;
        PG8_WAIT_V(4); PG8_BAR;
        PG8_STAGE(PG8_SB(1, 0), cB + kstep, voffB); PG8_STAGE(PG8_SA(1, 0), cA + kstep, voffA); PG8_STAGE(PG8_SB(1, 1), cB + hstep + kstep, voffB);
        PG8_WAIT_V(6); PG8_BAR;
    }
    for (;;) {
        const bool has_next = S.next(ui + 1, nxt);
        const char* nA = has_next ? (const char*)g.A + (size_t)nxt.pm * tstep : cA; const char* nB = has_next ? (const char*)g.Bt + (size_t)nxt.pn * tstep : cB;
        for (int t = 0; t < nt; t += 2) {
            const bool last = (t == nt - 2);
            const char* a1 = cA + (size_t)(t + 1) * kstep;
            const char* a2 = last ? nA : cA + (size_t)(t + 2) * kstep; const char* b2 = last ? nB : cB + (size_t)(t + 2) * kstep;
            const char* a3 = a2 + kstep; const char* b3 = b2 + kstep;
            if (last && has_next) S.a_ready(nxt);
            if constexpr (SP2) {
            PG8_LDB(B0, 0, 0); PG8_LDB(B1, 0, 1); PG8_SCHED; PG8_LDA(At, 0, 0); PG8_STAGE(PG8_SA(1, 1), a1 + hstep, voffA);
            PG8_WAIT_V(8); PG8_WAIT_L(0); PG8_BAR; PG8_MMA(0, 0, At, B0); PG8_MMA(0, 1, At, B1); PG8_BAR; PG8_SCHED;
            PG8_LDA(At, 0, 1); PG8_STAGE(PG8_SB(0, 0), b2, voffB); PG8_STAGE(PG8_SB(0, 1), b2 + hstep, voffB); PG8_STAGE(PG8_SA(0, 0), a2, voffA);
            PG8_WAIT_V(8); PG8_WAIT_L(0); PG8_BAR; PG8_MMA(1, 0, At, B0); PG8_MMA(1, 1, At, B1); PG8_BAR; PG8_SCHED;
            PG8_LDB(B0, 1, 0); PG8_LDB(B1, 1, 1); PG8_SCHED; PG8_LDA(At, 1, 0); PG8_STAGE(PG8_SA(0, 1), a2 + hstep, voffA);
            PG8_WAIT_V(8); PG8_WAIT_L(0); PG8_BAR; PG8_MMA(0, 0, At, B0); PG8_MMA(0, 1, At, B1); PG8_BAR; PG8_SCHED;
            PG8_LDA(At, 1, 1); PG8_STAGE(PG8_SB(1, 0), b3, voffB); PG8_STAGE(PG8_SB(1, 1), b3 + hstep, voffB); PG8_STAGE(PG8_SA(1, 0), a3, voffA);
            PG8_WAIT_V(8); PG8_WAIT_L(0); PG8_BAR; PG8_MMA(1, 0, At, B0); PG8_MMA(1, 1, At, B1); PG8_BAR; PG8_SCHED;
            } else {
            PG8_LDB(B0, 0, 0); PG8_SCHED; PG8_LDA(At, 0, 0); PG8_STAGE(PG8_SA(1, 1), a1 + hstep, voffA);
            PG8_WAIT_L(8); PG8_BAR; PG8_WAIT_L(0); PG8_MMA(0, 0, At, B0); PG8_BAR; PG8_SCHED;
            PG8_LDB(B1, 0, 1); PG8_STAGE(PG8_SB(0, 0), b2, voffB);
            PG8_BAR; PG8_WAIT_L(0); PG8_MMA(0, 1, At, B1); PG8_BAR;
            PG8_LDA(At, 0, 1); PG8_STAGE(PG8_SA(0, 0), a2, voffA);
            PG8_BAR; PG8_WAIT_L(0); PG8_MMA(1, 0, At, B0); PG8_BAR; PG8_SCHED;
            PG8_STAGE(PG8_SB(0, 1), b2 + hstep, voffB);
            PG8_WAIT_V(6); PG8_BAR; PG8_MMA(1, 1, At, B1); PG8_BAR;
            PG8_LDB(B0, 1, 0); PG8_SCHED; PG8_LDA(At, 1, 0); PG8_STAGE(PG8_SA(0, 1), a2 + hstep, voffA);
            PG8_WAIT_L(8); PG8_BAR; PG8_WAIT_L(0); PG8_MMA(0, 0, At, B0); PG8_BAR; PG8_SCHED;
            PG8_LDB(B1, 1, 1); PG8_STAGE(PG8_SB(1, 0), b3, voffB);
            PG8_BAR; PG8_WAIT_L(0); PG8_MMA(0, 1, At, B1); PG8_BAR;
            PG8_LDA(At, 1, 1); PG8_STAGE(PG8_SA(1, 0), a3, voffA);
            PG8_BAR; PG8_WAIT_L(0); PG8_MMA(1, 0, At, B0); PG8_BAR; PG8_SCHED;
            PG8_STAGE(PG8_SB(1, 1), b3 + hstep, voffB);
            PG8_WAIT_V(6); PG8_BAR; PG8_MMA(1, 1, At, B1); PG8_BAR;
            }
        }
        if constexpr (FP8) asm volatile("s_nop 15\n\ts_nop 15\n\ts_nop 15" ::: "memory");
        if constexpr (ALIGN_EPI) { if (wr == 0) PG8_BAR; }
        if constexpr (!Epi::AFTER_DRAIN) { E(acc, cur, wr, wc, fr, fq); S.done(cur); }
        if (!has_next) break;
#pragma unroll
        for (int a = 0; a < 2; ++a)
#pragma unroll
            for (int b = 0; b < 2; ++b)
#pragma unroll
                for (int m = 0; m < 4; ++m)
#pragma unroll
                    for (int n = 0; n < 2; ++n) acc[a][b][m][n] = (f32x4){0.f, 0.f, 0.f, 0.f};
        cur = nxt; cA = nA; cB = nB; ++ui;
        if constexpr (ALIGN_EPI) { if (wr == 1) PG8_BAR; }
    }
    PG8_WAIT_V(0);
    if constexpr (!ALIGN_EPI) { if (wr == 0) PG8_BAR; }
    PG8_BAR;
    if constexpr (Epi::AFTER_DRAIN) { E.fused(acc, cur, wr, wc, fr, fq, lds, wid, lane); S.done(cur); }
#undef PG8_SA
#undef PG8_SB
#undef PG8_STAGE
#undef PG8_LDA
#undef PG8_LDB
#undef PG8_MMA
#undef PG8_CAT
#undef PG8_WAIT_V
#undef PG8_WAIT_L
#undef PG8_BAR
#undef PG8_SCHED
}
}
typedef unsigned short bf16;
#define LAS __attribute__((address_space(3)))
constexpr int T_TOK = 32768, DM = 2048, SEQ = 4096, NBATCH = 8, DEPTH = 4;
constexpr int IN_COLS = 13336, NP = 13568;
constexpr int C_MQ = 0, C_MK = 512, C_MV = 1024, C_MO = 2048, C_SZ = 3072, C_SXBC = 4096, C_AQ = 5632, C_AK = 6656, C_AV = 6912, C_G = 7168, C_SMALL = 13312;
constexpr int GATE_TILE_LO = C_G / 256, SMALL_TILE = C_SMALL / 256;
constexpr float ALPHA = 1.681792830507429f;
constexpr int P_EXPERTS = 16384;

constexpr size_t MiB = 1u << 20;
constexpr size_t WS_CTL = 0, CTL_ZERO_BYTES = 64 * 1024, WS_WIN = 1 * MiB, WS_WB = 54 * MiB, WS_WO = 66 * MiB, WS_WQ = 74 * MiB, WS_BIAS = 82 * MiB, WS_SKB = 82 * MiB + 256 * 1024, WS_SMALL = 83 * MiB, WS_ROPE = 87 * MiB,
                 WS_TAB = 1480 * MiB  , WS_XB = 88 * MiB, WS_XQ = 216 * MiB  , WS_WG8 = 280 * MiB  , WS_WB8 = 306 * MiB  , WS_YQ = 312 * MiB  , WS_R1Q = 408 * MiB  , WS_WO8 = 54 * MiB  , WS_PROJ = 472 * MiB, WS_R1 = 1320 * MiB, WS_Y = 1480 * MiB, WS_R2 = 1672 * MiB, WS_HM = 1864 * MiB, WS_END = 1992 * MiB;
constexpr size_t WS_QF = WS_PROJ, WS_IDS = WS_PROJ + 256 * MiB, WS_GATES = WS_PROJ + 272 * MiB;
constexpr int CW_BAR = 4096;
constexpr int RING_BYTES = 131072, PHASE_LDS_BYTES = 155648, MISC_OFF = PHASE_LDS_BYTES + 320, LDS_BYTES = 163840;

__device__ __forceinline__ unsigned f2bf(float f) { unsigned u = __float_as_uint(f); return (u + 0x7fffu + ((u >> 16) & 1u)) >> 16; }
typedef float f32x4e_t __attribute__((ext_vector_type(4)));
typedef float pk2f_t __attribute__((ext_vector_type(2)));
typedef __bf16 pk2b_t __attribute__((ext_vector_type(2)));
__device__ __forceinline__ unsigned pk2(float lo, float hi) { const pk2f_t f = {lo, hi}; return __builtin_bit_cast(unsigned, __builtin_convertvector(f, pk2b_t)); }
__device__ __forceinline__ unsigned pk4_fp8(float a, float b, float c, float d) { int p = __builtin_amdgcn_cvt_pk_fp8_f32(a, b, 0, false); p = __builtin_amdgcn_cvt_pk_fp8_f32(c, d, p, true); return (unsigned)p; }
constexpr float ACT8_SCALE = 4.0f;
static_assert(ACT8_SCALE == 4.0f, "epilogue shifts");
constexpr float WG8_SCALE = 64.0f;
__device__ __forceinline__ float bf2f(bf16 b) { return __uint_as_float(((unsigned)b) << 16); }
__device__ __forceinline__ float sigm(float x) { return __builtin_amdgcn_rcpf(1.0f + __expf(-x)); }
__device__ __forceinline__ void halves32(float& lo, float& hi) { asm volatile("s_nop 1\n\tv_permlane32_swap_b32 %0, %1" : "+v"(lo), "+v"(hi)); }
template <int CTRL> __device__ __forceinline__ float dpp_f(float v) { return __builtin_bit_cast(float, __builtin_amdgcn_update_dpp(0, __builtin_bit_cast(int, v), CTRL, 0xF, 0xF, true)); }
__device__ __forceinline__ float quad_sum(float v) { v += dpp_f<0xB1>(v); v += dpp_f<0x4E>(v); return v; }
__device__ __forceinline__ float wave_sum(float v) {
    v = quad_sum(v); v += dpp_f<0x141>(v); v += dpp_f<0x140>(v);
    v += __builtin_bit_cast(float, __builtin_amdgcn_ds_swizzle(__builtin_bit_cast(int, v), 0x401F));
    return __builtin_bit_cast(float, __builtin_amdgcn_readlane(__builtin_bit_cast(int, v), 0)) + __builtin_bit_cast(float, __builtin_amdgcn_readlane(__builtin_bit_cast(int, v), 32));
}
__device__ __forceinline__ int src_col(int n) {
    if (n < 3072) return n;
    if (n < 5632) return n + 8;
    if (n < 13312) return n + 24;
    if (n < 13320) return 3072 + (n - 13312);
    if (n < 13336) return 5640 + (n - 13320);
    return -1;
}

#define XB_TMO      128
#define XB_XCNT(j)  (256  + 64 * (j))
#define XB_XSUB(j)  (1280 + 64 * (j))
#define XB_XGEN(j)  (2304 + 64 * (j))
#define XB_TOP      3328
#define XB_TOPGEN   3392
#define XCD_BAR_WORDS 3456
#define XB_SPIN_CAP (1u << 18)

__device__ __forceinline__ unsigned xb_ld(unsigned* p)              { return __hip_atomic_load(p, __ATOMIC_RELAXED, __HIP_MEMORY_SCOPE_AGENT); }
__device__ __forceinline__ unsigned xb_add(unsigned* p, unsigned v) { return __hip_atomic_fetch_add(p, v, __ATOMIC_RELAXED, __HIP_MEMORY_SCOPE_AGENT); }
__device__ __forceinline__ unsigned xb_xcc_id() { return (unsigned)__builtin_amdgcn_s_getreg((3 << 11) | 20) & 0xFu; }
#define XB_SPIN(cond, bar) do { unsigned _sp = 0; while (cond) { __builtin_amdgcn_s_sleep(1); \
    if ((++_sp & 255u) == 0u) { if (xb_ld(&(bar)[XB_TMO])) break; if (_sp > XB_SPIN_CAP) { atomicAdd(&(bar)[XB_TMO], 1u); break; } } } } while (0)

struct XcdBarrier {
    unsigned* bar; unsigned x;
    volatile LAS unsigned* st;
};

__device__ __forceinline__ XcdBarrier xcd_barrier_post(unsigned* bar, volatile LAS unsigned* st) {
    XcdBarrier b; b.bar = bar; b.x = xb_xcc_id(); b.st = st;
    if (threadIdx.x == 0) (void)xb_add(&bar[XB_XCNT(b.x)], 1u);
    return b;
}
__device__ __forceinline__ void xcd_barrier_complete(unsigned* bar, unsigned x, unsigned& nloc, unsigned& nx) {
    const unsigned G = gridDim.x * gridDim.y * gridDim.z;
    unsigned sum, cnt, mine, sp = 0u;
    for (;;) {
        sum = 0u; cnt = 0u; mine = 0u;
#pragma unroll
        for (unsigned j = 0; j < 16; ++j) { const unsigned c = xb_ld(&bar[XB_XCNT(j)]); sum += c; cnt += (c > 0u) ? 1u : 0u; mine = (j == x) ? c : mine; }
        if (sum == G) break;
        __builtin_amdgcn_s_sleep(1);
        if ((++sp & 255u) == 0u) { if (xb_ld(&bar[XB_TMO])) break; if (sp > XB_SPIN_CAP) { atomicAdd(&bar[XB_TMO], 1u); break; } }
    }
    nloc = mine > 0u ? mine : 1u; nx = cnt > 0u ? cnt : 1u;
}

__device__ __forceinline__ void xcd_barrier(const XcdBarrier& b) {
    asm volatile("s_waitcnt vmcnt(0)" ::: "memory");
    __syncthreads();
    if (threadIdx.x == 0) {
        unsigned* bar = b.bar;
        __builtin_amdgcn_s_waitcnt(0);
        unsigned nloc = b.st[0], nx = b.st[1];
        if (nloc == 0u) { xcd_barrier_complete(bar, b.x, nloc, nx); b.st[0] = nloc; b.st[1] = nx; }
        const unsigned old = xb_add(&bar[XB_XSUB(b.x)], 1u);
        const unsigned gen = old / nloc;
        if (old + 1u == (gen + 1u) * nloc) {
            __builtin_amdgcn_fence(__ATOMIC_RELEASE, "agent");
            asm volatile("s_waitcnt vmcnt(0)" ::: "memory");
            const unsigned og = xb_add(&bar[XB_TOP], 1u);
            const unsigned tg = og / nx;
            if (og + 1u == (tg + 1u) * nx) xb_add(&bar[XB_TOPGEN], 1u);
            else XB_SPIN(xb_ld(&bar[XB_TOPGEN]) == tg, bar);
            __builtin_amdgcn_fence(__ATOMIC_ACQUIRE, "agent");
            xb_add(&bar[XB_XGEN(b.x)], 1u);
            asm volatile("s_waitcnt vmcnt(0)" ::: "memory");
        } else {
            XB_SPIN(xb_ld(&bar[XB_XGEN(b.x)]) == gen, bar);
            __builtin_amdgcn_fence(__ATOMIC_ACQUIRE, "agent");
            asm volatile("s_waitcnt vmcnt(0)" ::: "memory");
        }
    }
    __syncthreads();
}

__device__ __forceinline__ int fresh_tid(int wave0) { int l; asm volatile("v_mbcnt_lo_u32_b32 %0, -1, 0\n\tv_mbcnt_hi_u32_b32 %0, -1, %0" : "=v"(l)); return wave0 * 64 + l; }
#define PHASE_IDS int G = gridDim.x, bx = blockIdx.x; asm volatile("" : "+s"(G), "+s"(bx)); const int tid = fresh_tid(wave0), lane = tid & 63, wave = wave0; const int gw = bx * 8 + wave, NGW = G * 8; \
    const size_t gt = (size_t)bx * 512 + tid, NGT = (size_t)G * 512; (void)lane; (void)gw; (void)gt; (void)NGW; (void)NGT; (void)wave;

template <int MODE> __device__ __forceinline__ void transpose_item(const float* __restrict__ W, int K, int ldw, int ndst, bf16* __restrict__ WT, LAS float* scr, int item, int lane, unsigned char* __restrict__ W8 = nullptr) {
    const int nblk = ndst / 32, kb = item / nblk, nb = item % nblk, k0 = 64 * kb, n0 = 32 * nb;
    const int n_l = n0 + (lane & 31); const int sc = MODE ? src_col(n_l) : n_l;
    float tv[32];
#pragma unroll
    for (int i = 0; i < 32; ++i) { const int kk = 2 * i + (lane >> 5); tv[i] = sc >= 0 ? W[(size_t)(k0 + kk) * ldw + sc] : 0.f; }
#pragma unroll
    for (int i = 0; i < 32; ++i) { const int kk = 2 * i + (lane >> 5); scr[kk * 33 + (lane & 31)] = tv[i]; }
    asm volatile("s_waitcnt lgkmcnt(0)" ::: "memory");
    const int c = lane & 7;
#pragma unroll
    for (int j = 0; j < 4; ++j) { const int n = (lane >> 3) + 8 * j; const LAS float* s = scr + (8 * c) * 33 + n;
        if (MODE == 2 || (MODE == 1 && n0 < C_SMALL))
            *(uint2*)(W8 + (size_t)(n0 + n) * K + k0 + 8 * c) = make_uint2(pk4_fp8(s[0 * 33] * WG8_SCALE, s[1 * 33] * WG8_SCALE, s[2 * 33] * WG8_SCALE, s[3 * 33] * WG8_SCALE), pk4_fp8(s[4 * 33] * WG8_SCALE, s[5 * 33] * WG8_SCALE, s[6 * 33] * WG8_SCALE, s[7 * 33] * WG8_SCALE));
        if (MODE == 2 || (MODE == 1 && n0 < C_SMALL && !(n0 >= C_AV && n0 < C_AV + 256))) continue;
        uint4 o; o.x = pk2(s[0 * 33], s[1 * 33]); o.y = pk2(s[2 * 33], s[3 * 33]); o.z = pk2(s[4 * 33], s[5 * 33]); o.w = pk2(s[6 * 33], s[7 * 33]);
        *(uint4*)(WT + (size_t)(n0 + n) * K + k0 + 8 * c) = o; }
    asm volatile("s_waitcnt lgkmcnt(0)" ::: "memory");
}

__device__ __forceinline__ void mlstm_post_tok(int t, int lane, const bf16* __restrict__ hm, const bf16* __restrict__ proj, const LAS float* norm_w  , unsigned char* __restrict__ ym  ) {
    float4 x[4], nw[4]; uint2 ov[4];
#pragma unroll
    for (int h = 0; h < 4; ++h) { const int c = h * 256 + lane * 4; { const uint2 xr = *(const uint2*)(hm + (size_t)t * 1024 + c); x[h] = make_float4(__uint_as_float(xr.x << 16), __uint_as_float(xr.x & 0xffff0000u), __uint_as_float(xr.y << 16), __uint_as_float(xr.y & 0xffff0000u)); } { const f32x4e_t q_ = *(const LAS f32x4e_t*)(norm_w + c); nw[h] = make_float4(q_[0], q_[1], q_[2], q_[3]); } ov[h] = *(const uint2*)(proj + (size_t)t * NP + C_MO + c); }
#pragma unroll
    for (int h = 0; h < 4; ++h) {
        const float mu = wave_sum((x[h].x + x[h].y) + (x[h].z + x[h].w)) * (1.0f / 256.0f);
        const float d0 = x[h].x - mu, d1 = x[h].y - mu, d2 = x[h].z - mu, d3 = x[h].w - mu;
        const float rs = rsqrtf(wave_sum((d0 * d0 + d1 * d1) + (d2 * d2 + d3 * d3)) * (1.0f / 256.0f) + 1e-6f);
        const float y0 = d0 * rs * nw[h].x * sigm(__uint_as_float(ov[h].x << 16)), y1 = d1 * rs * nw[h].y * sigm(__uint_as_float(ov[h].x & 0xffff0000u));
        const float y2 = d2 * rs * nw[h].z * sigm(__uint_as_float(ov[h].y << 16)), y3 = d3 * rs * nw[h].w * sigm(__uint_as_float(ov[h].y & 0xffff0000u));
        *(unsigned*)(ym + (size_t)t * 1024 + h * 256 + lane * 4) = pk4_fp8(y0 * ACT8_SCALE, y1 * ACT8_SCALE, y2 * ACT8_SCALE, y3 * ACT8_SCALE);
    }
}

__device__ __forceinline__ void ssd_conv_item(int item, const bf16* __restrict__ proj, const LAS float* cw  , const LAS float* cb  , bf16* __restrict__ xcb) {
    const int c8 = item % 192, tb = item / 192, t0 = tb * 4, pos0 = t0 % SEQ, c = c8 * 8;
    uint4 r[7];
#pragma unroll
    for (int j = 0; j < 7; ++j) { r[j] = make_uint4(0u, 0u, 0u, 0u); if (j >= 3 || pos0 > 0) r[j] = *(const uint4*)(proj + (size_t)(t0 - 3 + j) * NP + C_SXBC + c); }
    float w[4][8], bs[8];
#pragma unroll
    for (int j = 0; j < 4; ++j) { const f32x4e_t a = *(const LAS f32x4e_t*)(cw + j * 1536 + c), b = *(const LAS f32x4e_t*)(cw + j * 1536 + c + 4); w[j][0] = a.x; w[j][1] = a.y; w[j][2] = a.z; w[j][3] = a.w; w[j][4] = b.x; w[j][5] = b.y; w[j][6] = b.z; w[j][7] = b.w; }
    { const f32x4e_t a = *(const LAS f32x4e_t*)(cb + c), b = *(const LAS f32x4e_t*)(cb + c + 4); bs[0] = a.x; bs[1] = a.y; bs[2] = a.z; bs[3] = a.w; bs[4] = b.x; bs[5] = b.y; bs[6] = b.z; bs[7] = b.w; }
#pragma unroll
    for (int o = 0; o < 4; ++o) {
        float acc[8];
#pragma unroll
        for (int i = 0; i < 8; ++i) acc[i] = bs[i];
#pragma unroll
        for (int j = 0; j < 4; ++j) { const unsigned rw[4] = {r[o + j].x, r[o + j].y, r[o + j].z, r[o + j].w};
#pragma unroll
            for (int i = 0; i < 4; ++i) { acc[2 * i] += w[j][2 * i] * __uint_as_float(rw[i] << 16); acc[2 * i + 1] += w[j][2 * i + 1] * __uint_as_float(rw[i] & 0xffff0000u); } }
        uint4 ov; ov.x = pk2(acc[0] * sigm(acc[0]), acc[1] * sigm(acc[1])); ov.y = pk2(acc[2] * sigm(acc[2]), acc[3] * sigm(acc[3])); ov.z = pk2(acc[4] * sigm(acc[4]), acc[5] * sigm(acc[5])); ov.w = pk2(acc[6] * sigm(acc[6]), acc[7] * sigm(acc[7]));
        *(uint4*)(xcb + (size_t)(t0 + o) * 1536 + c) = ov;
    }
}
__device__ __forceinline__ void ssd_post_tok2(int tp, int lane, const bf16* __restrict__ yraw, const bf16* __restrict__ proj, const LAS float* norm_w  , unsigned char* __restrict__ ys  ) {
    uint4 yr[4]; uint4 zv[4];
#pragma unroll
    for (int i = 0; i < 4; ++i) { const int t = 2 * tp + (i >> 1), c = (i & 1) * 512 + lane * 8; yr[i] = *(const uint4*)(yraw + (size_t)t * 1024 + c); zv[i] = *(const uint4*)(proj + (size_t)t * NP + C_SZ + c); }
#pragma unroll
    for (int i = 0; i < 4; ++i) { const int t = 2 * tp + (i >> 1), c = (i & 1) * 512 + lane * 8;
        const float yv[8] = {__uint_as_float(yr[i].x << 16), __uint_as_float(yr[i].x & 0xffff0000u), __uint_as_float(yr[i].y << 16), __uint_as_float(yr[i].y & 0xffff0000u), __uint_as_float(yr[i].z << 16), __uint_as_float(yr[i].z & 0xffff0000u), __uint_as_float(yr[i].w << 16), __uint_as_float(yr[i].w & 0xffff0000u)}; const unsigned zw[4] = {zv[i].x, zv[i].y, zv[i].z, zv[i].w};
        float y[8], ss = 0.f;
#pragma unroll
        for (int k = 0; k < 4; ++k) { const float z0 = __uint_as_float(zw[k] << 16), z1 = __uint_as_float(zw[k] & 0xffff0000u); y[2 * k] = yv[2 * k] * (z0 * sigm(z0)); y[2 * k + 1] = yv[2 * k + 1] * (z1 * sigm(z1)); ss += y[2 * k] * y[2 * k] + y[2 * k + 1] * y[2 * k + 1]; }
        const float rs = rsqrtf(wave_sum(ss) * (1.0f / 512.0f) + 1e-6f);
        const f32x4e_t n0q = *(const LAS f32x4e_t*)(norm_w + c), n1q = *(const LAS f32x4e_t*)(norm_w + c + 4); const float4 n0 = make_float4(n0q[0], n0q[1], n0q[2], n0q[3]), n1 = make_float4(n1q[0], n1q[1], n1q[2], n1q[3]);
        { const float r4 = rs * ACT8_SCALE; *(uint2*)(ys + (size_t)t * 1024 + c) = make_uint2(pk4_fp8(y[0] * r4 * n0.x, y[1] * r4 * n0.y, y[2] * r4 * n0.z, y[3] * r4 * n0.w), pk4_fp8(y[4] * r4 * n1.x, y[5] * r4 * n1.y, y[6] * r4 * n1.z, y[7] * r4 * n1.w)); }
    }
}

__device__ __forceinline__ void ln_body2(int tp, int lane, const float* in, const float* __restrict__ g, const float* __restrict__ bta, float* outf, bf16* __restrict__ outb) {
    float4 v[2][8];
#pragma unroll
    for (int r = 0; r < 2; ++r)
#pragma unroll
        for (int j = 0; j < 8; ++j) v[r][j] = *(const float4*)(in + (size_t)(2 * tp + r) * DM + j * 256 + lane * 4);
    { int z_ = 0; asm volatile("" : "+s"(z_)); g += z_; bta += z_; }
#pragma unroll
    for (int r = 0; r < 2; ++r) {
        const int t = 2 * tp + r; float s = 0.f;
#pragma unroll
        for (int j = 0; j < 8; ++j) s += (v[r][j].x + v[r][j].y) + (v[r][j].z + v[r][j].w);
        const float mu = wave_sum(s) * (1.0f / DM); float q = 0.f;
#pragma unroll
        for (int j = 0; j < 8; ++j) { v[r][j].x -= mu; v[r][j].y -= mu; v[r][j].z -= mu; v[r][j].w -= mu; q += (v[r][j].x * v[r][j].x + v[r][j].y * v[r][j].y) + (v[r][j].z * v[r][j].z + v[r][j].w * v[r][j].w); }
        const float rs = rsqrtf(wave_sum(q) * (1.0f / DM) + 1e-5f);
#pragma unroll
        for (int j = 0; j < 8; ++j) { const int c = j * 256 + lane * 4; const float4 gg = *(const float4*)(g + c), bb = *(const float4*)(bta + c);
            float4 y; y.x = v[r][j].x * rs * gg.x + bb.x; y.y = v[r][j].y * rs * gg.y + bb.y; y.z = v[r][j].z * rs * gg.z + bb.z; y.w = v[r][j].w * rs * gg.w + bb.w;
            *(float4*)(outf + (size_t)t * DM + c) = y; *(uint2*)(outb + (size_t)t * DM + c) = make_uint2(pk2(y.x, y.y), pk2(y.z, y.w)); }
    }
}

__device__ __forceinline__ void ln_body2b(int tp, int lane, bf16* xb, const LAS float* g  , const LAS float* bta  ) {
    uint4 v[2][4];
#pragma unroll
    for (int r = 0; r < 2; ++r)
#pragma unroll
        for (int j = 0; j < 4; ++j) v[r][j] = *(const uint4*)(xb + (size_t)(2 * tp + r) * DM + j * 512 + lane * 8);
#pragma unroll
    for (int r = 0; r < 2; ++r) {
        const int t = 2 * tp + r; float f[32]; float s = 0.f;
#pragma unroll
        for (int j = 0; j < 4; ++j) { const unsigned w4[4] = {v[r][j].x, v[r][j].y, v[r][j].z, v[r][j].w};
#pragma unroll
            for (int k = 0; k < 4; ++k) { f[8 * j + 2 * k] = __uint_as_float(w4[k] << 16); f[8 * j + 2 * k + 1] = __uint_as_float(w4[k] & 0xffff0000u); } }
#pragma unroll
        for (int i = 0; i < 32; i += 4) s += (f[i] + f[i + 1]) + (f[i + 2] + f[i + 3]);
        const float mu = wave_sum(s) * (1.0f / DM); float q = 0.f;
#pragma unroll
        for (int i = 0; i < 32; ++i) { f[i] -= mu; q += f[i] * f[i]; }
        const float rs = rsqrtf(wave_sum(q) * (1.0f / DM) + 1e-5f);
#pragma unroll
        for (int j = 0; j < 4; ++j) { const int c = j * 512 + lane * 8; const f32x4e_t g0 = *(const LAS f32x4e_t*)(g + c), g1 = *(const LAS f32x4e_t*)(g + c + 4), b0 = *(const LAS f32x4e_t*)(bta + c), b1 = *(const LAS f32x4e_t*)(bta + c + 4);
            *(uint4*)(xb + (size_t)t * DM + c) = make_uint4(pk2(f[8 * j] * rs * g0.x + b0.x, f[8 * j + 1] * rs * g0.y + b0.y), pk2(f[8 * j + 2] * rs * g0.z + b0.z, f[8 * j + 3] * rs * g0.w + b0.w),
                                                            pk2(f[8 * j + 4] * rs * g1.x + b1.x, f[8 * j + 5] * rs * g1.y + b1.y), pk2(f[8 * j + 6] * rs * g1.z + b1.z, f[8 * j + 7] * rs * g1.w + b1.w)); }
    }
}

__device__ __forceinline__ float gelu_erf(float v) {
    const float av = fabsf(v), t = __builtin_amdgcn_rcpf(av * 0.2316418882f + 1.0f);
    float q = t * 0.5307027145f + (-0.7265760135f); q = q * t + 0.7107068705f; q = q * t + (-0.142248368f); q = q * t + 0.127414796f; q = q * t;
    const float e = __builtin_amdgcn_exp2f((v * v) * (-0.72134752044f));
    const float mm = v * (q * e), r = v - mm;
    return v < 0.f ? mm : r;
}
typedef unsigned u32x4e_t __attribute__((ext_vector_type(4)));
typedef float f32x4e_t __attribute__((ext_vector_type(4)));
typedef unsigned u32x2e_t __attribute__((ext_vector_type(2)));
constexpr float U6_SCALE = 80.0f, V4_SCALE = 16.0f;
constexpr int ROW4 = DM / 2;
constexpr int ROW6 = DM * 6 / 8;
typedef float v32f_t __attribute__((ext_vector_type(32)));
typedef float f32x2_t __attribute__((ext_vector_type(2)));
typedef __bf16 v32b_t __attribute__((ext_vector_type(32)));
typedef unsigned v6u_t __attribute__((ext_vector_type(6)));
typedef __bf16 v2b_t __attribute__((ext_vector_type(2)));
__device__ __forceinline__ void tab_to_fp6(size_t i, const float* __restrict__ src, unsigned char* __restrict__ dst, float sc) {
    const float4* s = (const float4*)src + i * 8; v32b_t b;
#pragma unroll
    for (int j = 0; j < 8; ++j) { const float4 v = s[j]; b[4 * j] = (__bf16)(v.x * sc); b[4 * j + 1] = (__bf16)(v.y * sc); b[4 * j + 2] = (__bf16)(v.z * sc); b[4 * j + 3] = (__bf16)(v.w * sc); }
    const v6u_t p = __builtin_amdgcn_cvt_scalef32_pk32_fp6_bf16(b, 1.0f);
    uint2* d = (uint2*)(dst + i * 24); d[0] = make_uint2(p[0], p[1]); d[1] = make_uint2(p[2], p[3]); d[2] = make_uint2(p[4], p[5]);
}
__device__ __forceinline__ void tab_to_fp4(size_t i, const float* __restrict__ src, unsigned char* __restrict__ dst, float sc) {
    const float4* s = (const float4*)src + i * 8; unsigned w[4];
#pragma unroll
    for (int j = 0; j < 4; ++j) { const float4 a = s[2 * j], b = s[2 * j + 1]; unsigned x = 0u;
        x = __builtin_amdgcn_cvt_scalef32_pk_fp4_f32(x, a.x * sc, a.y * sc, 1.0f, 0); x = __builtin_amdgcn_cvt_scalef32_pk_fp4_f32(x, a.z * sc, a.w * sc, 1.0f, 1);
        x = __builtin_amdgcn_cvt_scalef32_pk_fp4_f32(x, b.x * sc, b.y * sc, 1.0f, 2); x = __builtin_amdgcn_cvt_scalef32_pk_fp4_f32(x, b.z * sc, b.w * sc, 1.0f, 3); w[j] = x; }
    *(uint4*)(dst + i * 16) = make_uint4(w[0], w[1], w[2], w[3]);
}
__device__ __forceinline__ void tab_fp4_store(const float4 (&q)[4], unsigned char* __restrict__ dst8, float sc) {
    unsigned w[2];
#pragma unroll
    for (int j = 0; j < 2; ++j) { const float4 a = q[2 * j], b = q[2 * j + 1]; unsigned x = 0u;
        x = __builtin_amdgcn_cvt_scalef32_pk_fp4_f32(x, a.x * sc, a.y * sc, 1.0f, 0); x = __builtin_amdgcn_cvt_scalef32_pk_fp4_f32(x, a.z * sc, a.w * sc, 1.0f, 1);
        x = __builtin_amdgcn_cvt_scalef32_pk_fp4_f32(x, b.x * sc, b.y * sc, 1.0f, 2); x = __builtin_amdgcn_cvt_scalef32_pk_fp4_f32(x, b.z * sc, b.w * sc, 1.0f, 3); w[j] = x; }
    *(uint2*)dst8 = make_uint2(w[0], w[1]);
}
constexpr int TAB_PER_WG = (P_EXPERTS * (DM / 32)) / 128;
__device__ __forceinline__ void peer_expert_body(int t, int lane, bool last, const int* __restrict__ ids, const float* __restrict__ gates, const unsigned char* __restrict__ U6, const unsigned char* __restrict__ V6,
                                                 const LAS float* gl  , const LAS float* bl  , float* __restrict__ outf, bf16* outb  , unsigned char* __restrict__ outq  , LAS unsigned* wl  ) {
    asm volatile("" : "+v"(lane));
    int idA = ids[(size_t)t * 128 + lane], idB = ids[(size_t)t * 128 + 64 + lane]; float gA = gates[(size_t)t * 128 + lane], gB = gates[(size_t)t * 128 + 64 + lane];
    {
        const unsigned kA = ((unsigned)idA << 7) | (unsigned)lane, kB = ((unsigned)idB << 7) | (unsigned)(64 + lane);
        wl[lane] = kA; wl[64 + lane] = kB;
        asm volatile("s_waitcnt lgkmcnt(0)" ::: "memory");
        int rA = 0, rB = 0;
#pragma unroll 8
        for (int j = 0; j < 128; j += 4) { const u32x4e_t k4 = *(const LAS u32x4e_t*)(wl + j);
#pragma unroll
            for (int q = 0; q < 4; ++q) { rA += (k4[q] < kA) ? 1 : 0; rB += (k4[q] < kB) ? 1 : 0; } }
        asm volatile("s_waitcnt lgkmcnt(0)" ::: "memory");
        wl[128 + rA] = (unsigned)idA; wl[256 + rA] = __float_as_uint(gA); wl[128 + rB] = (unsigned)idB; wl[256 + rB] = __float_as_uint(gB);
        asm volatile("s_waitcnt lgkmcnt(0)" ::: "memory");
        idA = (int)wl[128 + lane]; idB = (int)wl[192 + lane]; gA = __uint_as_float(wl[256 + lane]); gB = __uint_as_float(wl[320 + lane]);
        asm volatile("s_waitcnt lgkmcnt(0)" ::: "memory");
    }
#define ID_OF(e_) __builtin_amdgcn_readlane((e_) < 64 ? idA : idB, (e_) & 63)
#define GATE_OF(e_) __builtin_bit_cast(float, __builtin_amdgcn_readlane(__builtin_bit_cast(int, (e_) < 64 ? gA : gB), (e_) & 63))
    uint4 ra[8], rb[8];
#define ROW_LOAD(R_, T_, e_) do { _Pragma("unroll") for (int k_ = 0; k_ < 8; ++k_) { const int id_ = ID_OF((e_) + k_); R_[k_] = *((const uint4*)((T_) + (size_t)id_ * ROW4) + lane); } } while (0)
#define V4_PAIR(D_, W_, j_, b_) do { const f32x2_t t_ = __builtin_amdgcn_cvt_scalef32_pk_f32_fp4(W_, 1.0f, b_); D_[8 * (j_) + 2 * (b_)] = t_.x; D_[8 * (j_) + 2 * (b_) + 1] = t_.y; } while (0)
#define V4_DWORD(D_, W_, j_) do { V4_PAIR(D_, W_, j_, 0); V4_PAIR(D_, W_, j_, 1); V4_PAIR(D_, W_, j_, 2); V4_PAIR(D_, W_, j_, 3); } while (0)
#define UDOT4(W_, j_) do { a_ = __builtin_amdgcn_fdot2_f32_bf16(__builtin_amdgcn_cvt_scalef32_pk_bf16_fp4(W_, 1.0f, 0), __builtin_bit_cast(v2b_t, xb[4 * (j_)]), a_, false); \
        b_ = __builtin_amdgcn_fdot2_f32_bf16(__builtin_amdgcn_cvt_scalef32_pk_bf16_fp4(W_, 1.0f, 1), __builtin_bit_cast(v2b_t, xb[4 * (j_) + 1]), b_, false); \
        a_ = __builtin_amdgcn_fdot2_f32_bf16(__builtin_amdgcn_cvt_scalef32_pk_bf16_fp4(W_, 1.0f, 2), __builtin_bit_cast(v2b_t, xb[4 * (j_) + 2]), a_, false); \
        b_ = __builtin_amdgcn_fdot2_f32_bf16(__builtin_amdgcn_cvt_scalef32_pk_bf16_fp4(W_, 1.0f, 3), __builtin_bit_cast(v2b_t, xb[4 * (j_) + 3]), b_, false); } while (0)
#define DEC4(D_, R_) do { V4_DWORD(D_, R_.x, 0); V4_DWORD(D_, R_.y, 1); V4_DWORD(D_, R_.z, 2); V4_DWORD(D_, R_.w, 3); } while (0)
#define PK6(W_) ((v6u_t){W_[0].x, W_[0].y, W_[1].x, W_[1].y, W_[2].x, W_[2].y})
#define SB_ __builtin_amdgcn_sched_barrier(0)
    float c0 = 0.f, c1 = 0.f;
    unsigned xb[16];
    {
#pragma unroll
        for (int i = 0; i < 4; ++i) { const uint4 v = *(const uint4*)(outb + (size_t)t * DM + lane * 32 + i * 8); xb[4 * i] = v.x; xb[4 * i + 1] = v.y; xb[4 * i + 2] = v.z; xb[4 * i + 3] = v.w; }
#define U_COMP(R_, e_) do { float p_[8]; _Pragma("unroll") for (int k_ = 0; k_ < 8; ++k_) { SB_; float a_ = 0.f, b_ = 0.f; UDOT4(R_[k_].x, 0); UDOT4(R_[k_].y, 1); UDOT4(R_[k_].z, 2); UDOT4(R_[k_].w, 3); p_[k_] = a_ + b_; } SB_; \
        { const bool o1_ = lane & 1, o2_ = lane & 2, o4_ = lane & 4; float w_[4], u_[2]; \
          _Pragma("unroll") for (int j_ = 0; j_ < 4; ++j_) { const float keep_ = o1_ ? p_[2 * j_ + 1] : p_[2 * j_], send_ = o1_ ? p_[2 * j_] : p_[2 * j_ + 1]; w_[j_] = keep_ + dpp_f<0xB1>(send_); } \
          _Pragma("unroll") for (int j_ = 0; j_ < 2; ++j_) { const float keep_ = o2_ ? w_[2 * j_ + 1] : w_[2 * j_], send_ = o2_ ? w_[2 * j_] : w_[2 * j_ + 1]; u_[j_] = keep_ + dpp_f<0x4E>(send_); } \
          float s_; { const float keep_ = o4_ ? u_[1] : u_[0], send_ = o4_ ? u_[0] : u_[1]; s_ = keep_ + __builtin_bit_cast(float, __builtin_amdgcn_ds_swizzle(__builtin_bit_cast(int, send_), 0x101F)); } \
          s_ += __builtin_bit_cast(float, __builtin_amdgcn_ds_swizzle(__builtin_bit_cast(int, s_), 0x201F)); s_ += __builtin_bit_cast(float, __builtin_amdgcn_ds_swizzle(__builtin_bit_cast(int, s_), 0x401F)); \
          { float lo_ = s_, hi_ = s_; halves32(lo_, hi_); s_ = lo_ + hi_; } \
          s_ *= (1.0f / U6_SCALE); const float ge_ = gelu_erf(s_) * (1.0f / V4_SCALE); \
          const bool in_ = ((lane ^ (e_)) & 56) == 0;              \
          if ((e_) < 64) c0 = in_ ? gA * ge_ : c0; else c1 = in_ ? gB * ge_ : c1; } } while (0)
        ROW_LOAD(ra, U6, 0);
#pragma nounroll
        for (int e = 0; e < 128; e += 16) {
            ROW_LOAD(rb, U6, e + 8);
            U_COMP(ra, e);
            if (e + 16 < 128) ROW_LOAD(ra, U6, e + 16);
            U_COMP(rb, e + 8);
        }
#undef U_COMP
    }
    v32f_t acc;
#pragma unroll
    for (int i = 0; i < 32; ++i) acc[i] = 0.f;
#define V_COMP(R_, e_) do { _Pragma("unroll") for (int k_ = 0; k_ < 8; ++k_) { SB_; const int ee_ = (e_) + k_; \
            const float cv_ = __builtin_bit_cast(float, __builtin_amdgcn_readlane(__builtin_bit_cast(int, ee_ < 64 ? c0 : c1), ee_ & 63)); \
            v32f_t d_; DEC4(d_, R_[k_]); acc += d_ * cv_; } SB_; } while (0)
    ROW_LOAD(ra, V6, 0);
#pragma nounroll
    for (int e = 0; e < 128; e += 16) {
        ROW_LOAD(rb, V6, e + 8);
        V_COMP(ra, e);
        if (e + 16 < 128) ROW_LOAD(ra, V6, e + 16);
        V_COMP(rb, e + 8);
    }
#undef V_COMP
#undef ID_OF
#undef GATE_OF
#undef ROW_LOAD
#undef PK6
#undef V4_PAIR
#undef V4_DWORD
#undef DEC4
#undef UDOT4
#undef SB_
    float s = 0.f;
#pragma unroll
    for (int i = 0; i < 16; ++i) { acc[2 * i] += ALPHA * __uint_as_float(xb[i] << 16); acc[2 * i + 1] += ALPHA * __uint_as_float(xb[i] & 0xffff0000u); }
#pragma unroll
    for (int i = 0; i < 32; ++i) s += acc[i];
    const float mu = wave_sum(s) * (1.0f / DM); float q = 0.f;
#pragma unroll
    for (int i = 0; i < 32; ++i) { acc[i] -= mu; q += acc[i] * acc[i]; }
    const float rs = rsqrtf(wave_sum(q) * (1.0f / DM) + 1e-5f);
#pragma unroll
    for (int i = 0; i < 8; ++i) { const int c = lane * 32 + i * 4; const f32x4e_t gq = *(const LAS f32x4e_t*)(gl + (i * 64 + lane) * 4), bq = *(const LAS f32x4e_t*)(bl + (i * 64 + lane) * 4);
        const float4 gg = make_float4(gq[0], gq[1], gq[2], gq[3]), bb = make_float4(bq[0], bq[1], bq[2], bq[3]);
        float4 y; y.x = acc[4 * i] * rs * gg.x + bb.x; y.y = acc[4 * i + 1] * rs * gg.y + bb.y; y.z = acc[4 * i + 2] * rs * gg.z + bb.z; y.w = acc[4 * i + 3] * rs * gg.w + bb.w;
        if (last) *(float4*)(outf + (size_t)t * DM + c) = y; else { *(uint2*)(outb + (size_t)t * DM + c) = make_uint2(pk2(y.x, y.y), pk2(y.z, y.w)); *(unsigned*)(outq + (size_t)t * DM + c) = pk4_fp8(y.x, y.y, y.z, y.w); } }
}

typedef short bf16x8_t __attribute__((ext_vector_type(8)));
typedef float f32x4_t __attribute__((ext_vector_type(4)));
typedef unsigned u32x2_t __attribute__((ext_vector_type(2)));
typedef unsigned u32x4_t __attribute__((ext_vector_type(4)));
constexpr int SWA_PITCH = 144;
constexpr int SWA_KS = 0, SWA_VS = 256 * SWA_PITCH, SWA_LDS = 2 * 256 * SWA_PITCH;
static_assert(SWA_LDS <= RING_BYTES, "SWA LDS");
__device__ __forceinline__ float grp4_max(float v) {
    v = fmaxf(v, __builtin_bit_cast(float, __builtin_amdgcn_ds_swizzle(__builtin_bit_cast(int, v), 0x401F)));
    float lo = v, hi = v; halves32(lo, hi);
    return fmaxf(lo, hi);
}
__device__ __forceinline__ float grp4_sum(float v) {
    v += __builtin_bit_cast(float, __builtin_amdgcn_ds_swizzle(__builtin_bit_cast(int, v), 0x401F));
    float lo = v, hi = v; halves32(lo, hi);
    return lo + hi;
}
__device__ __forceinline__ void tr_read2(unsigned a0, unsigned a1, u32x2_t& r0, u32x2_t& r1) {
    asm volatile("ds_read_b64_tr_b16 %0, %2\n\tds_read_b64_tr_b16 %1, %3\n\ts_waitcnt lgkmcnt(0)" : "=&v"(r0), "=&v"(r1) : "v"(a0), "v"(a1) : "memory");
}
__device__ __forceinline__ void rope8(uint4& lo, uint4& hi, const float4* cs, float scale) {
    unsigned* a = (unsigned*)&lo; unsigned* b = (unsigned*)&hi;
#pragma unroll
    for (int j = 0; j < 4; ++j) {
        const float x1a = __uint_as_float(a[j] << 16), x1b = __uint_as_float(a[j] & 0xffff0000u), x2a = __uint_as_float(b[j] << 16), x2b = __uint_as_float(b[j] & 0xffff0000u);
        const float4 c = cs[j];
        const float y1a = (x1a * c.x - x2a * c.y) * scale, y2a = (x2a * c.x + x1a * c.y) * scale, y1b = (x1b * c.z - x2b * c.w) * scale, y2b = (x2b * c.z + x1b * c.w) * scale;
        a[j] = pk2(y1a, y1b); b[j] = pk2(y2a, y2b);
    }
}
__device__ __forceinline__ void swa_phase(LAS unsigned char* lds, const bf16* __restrict__ proj, const float* __restrict__ rtab  , const float* __restrict__ sinks, unsigned char* __restrict__ ya  ,
                                          int tid, int bx, int G) {
    const int lane = tid & 63, w = __builtin_amdgcn_readfirstlane(tid >> 6), l15 = lane & 15, g4 = lane >> 4;
    const unsigned ldsb = (unsigned)(size_t)lds;
    constexpr int NSWA = NBATCH * 32 * 4, NSWA_LO = NSWA * 4 / 8;
    const int hb = G >> 1; int u0 = bx, u1 = NSWA, ust = G;
    if (hb > 0) { if (bx < hb) { u1 = NSWA_LO; ust = hb; } else { u0 = NSWA_LO + bx - hb; ust = G - hb; } }
    uint4 klo[2], khi[2], vv[4]; float4 kcs[2][4];
#define SWA_LOAD(u_) do { const int kvh_ = (u_) & 3, nb_ = ((u_) >> 2) & 31, b_ = (u_) >> 7, t0_ = b_ * SEQ + nb_ * 128; \
        _Pragma("unroll") for (int i_ = 0; i_ < 2; ++i_) { const int it_ = tid + 512 * i_, kk_ = it_ >> 2, c_ = it_ & 3; klo[i_] = make_uint4(0u, 0u, 0u, 0u); khi[i_] = klo[i_]; \
            _Pragma("unroll") for (int j_ = 0; j_ < 4; ++j_) kcs[i_][j_] = make_float4(0.f, 0.f, 0.f, 0.f); \
            if (nb_ > 0 || kk_ >= 128) { const bf16* src_ = proj + (size_t)(t0_ - 128 + kk_) * NP + C_AK + kvh_ * 64 + 8 * c_; klo[i_] = *(const uint4*)src_; khi[i_] = *(const uint4*)(src_ + 32); \
                const float4* cs_ = (const float4*)(rtab + ((size_t)(nb_ * 128 - 128 + kk_) * 32 + 8 * c_) * 2); kcs[i_][0] = cs_[0]; kcs[i_][1] = cs_[1]; kcs[i_][2] = cs_[2]; kcs[i_][3] = cs_[3]; } } \
        _Pragma("unroll") for (int i_ = 0; i_ < 4; ++i_) { const int it_ = tid + 512 * i_, kk_ = it_ >> 3, c_ = it_ & 7; vv[i_] = make_uint4(0u, 0u, 0u, 0u); \
            if (nb_ > 0 || kk_ >= 128) vv[i_] = *(const uint4*)(proj + (size_t)(t0_ - 128 + kk_) * NP + C_AV + kvh_ * 64 + 8 * c_); } } while (0)
#define SWA_STORE() do { \
        _Pragma("unroll") for (int i_ = 0; i_ < 2; ++i_) { const int it_ = tid + 512 * i_, kk_ = it_ >> 2, c_ = it_ & 3; uint4 lo_ = klo[i_], hi_ = khi[i_]; rope8(lo_, hi_, kcs[i_], 1.0f);     \
            *(LAS u32x4_t*)(lds + SWA_KS + kk_ * SWA_PITCH + 16 * c_) = __builtin_bit_cast(u32x4_t, lo_); *(LAS u32x4_t*)(lds + SWA_KS + kk_ * SWA_PITCH + 64 + 16 * c_) = __builtin_bit_cast(u32x4_t, hi_); } \
        _Pragma("unroll") for (int i_ = 0; i_ < 4; ++i_) { const int it_ = tid + 512 * i_, kk_ = it_ >> 3, c_ = it_ & 7; *(LAS u32x4_t*)(lds + SWA_VS + kk_ * SWA_PITCH + 16 * c_) = __builtin_bit_cast(u32x4_t, vv[i_]); } } while (0)
    if (u0 < u1) SWA_LOAD(u0);
    for (int u = u0; u < u1; u += ust) {
        const int kvh = u & 3, nb = (u >> 2) & 31, b = u >> 7;
        const int t0 = b * SEQ + nb * 128;
        const int r = w >> 1, hf = w & 1, hq = kvh * 4 + r;
        uint4 nqlo, nqhi; float4 nqcs[4];
#define SWA_QLOAD(qt_) do { const int iq_ = 64 * hf + 16 * (qt_) + l15; const bf16* src_ = proj + (size_t)(t0 + iq_) * NP + C_AQ + hq * 64 + 8 * g4; nqlo = *(const uint4*)src_; nqhi = *(const uint4*)(src_ + 32); \
            const float4* cs_ = (const float4*)(rtab + ((size_t)(nb * 128 + iq_) * 32 + 8 * g4) * 2); nqcs[0] = cs_[0]; nqcs[1] = cs_[1]; nqcs[2] = cs_[2]; nqcs[3] = cs_[3]; } while (0)
        SWA_QLOAD(0);
        __syncthreads();
        SWA_STORE();
        if (u + ust < u1) SWA_LOAD(u + ust);
        __syncthreads();
        const float sink = sinks[hq];
#pragma nounroll
        for (int qt = 0; qt < 4; ++qt) {
            const int i0 = 64 * hf + 16 * qt, iq = i0 + l15, tq = t0 + iq, ktb0 = 4 * hf + qt;
            bf16x8_t q0, q1;
            { uint4 lo = nqlo, hi = nqhi; rope8(lo, hi, nqcs, 0.125f); q0 = __builtin_bit_cast(bf16x8_t, lo); q1 = __builtin_bit_cast(bf16x8_t, hi); }
            if (qt + 1 < 4) SWA_QLOAD(qt + 1);
            f32x4_t s[9]; float m = sink; const int d0 = 4 * g4 - l15;
#pragma unroll
            for (int n = 0; n < 9; ++n) {
                const LAS unsigned char* kp = lds + SWA_KS + (16 * (ktb0 + n) + l15) * SWA_PITCH + 16 * g4;
                const bf16x8_t a0 = *(const LAS bf16x8_t*)kp, a1 = *(const LAS bf16x8_t*)(kp + 64);
                f32x4_t acc = (f32x4_t){0.f, 0.f, 0.f, 0.f};
                acc = __builtin_amdgcn_mfma_f32_16x16x32_bf16(a0, q0, acc, 0, 0, 0);
                acc = __builtin_amdgcn_mfma_f32_16x16x32_bf16(a1, q1, acc, 0, 0, 0);
                const bool tv = (nb > 0) || (ktb0 + n >= 8);
#pragma unroll
                for (int e = 0; e < 4; ++e) { const bool ok = tv && (n == 0 ? (d0 + e >= 1) : n == 8 ? (d0 + e <= 0) : true);
                    acc[e] = ok ? acc[e] : -1e30f; m = fmaxf(m, acc[e]); }
                s[n] = acc;
            }
            m = grp4_max(m);
            float lsum = 0.f;
#pragma unroll
            for (int n = 0; n < 9; ++n)
#pragma unroll
                for (int e = 0; e < 4; ++e) { const float p = __expf(s[n][e] - m); s[n][e] = p; lsum += p; }
            lsum = grp4_sum(lsum) + __expf(sink - m);
            const float inv = __builtin_amdgcn_rcpf(lsum);
            bf16x8_t pf[5];
#pragma unroll
            for (int pi = 0; pi < 4; ++pi) { uint4 w4; w4.x = pk2(s[2 * pi][0], s[2 * pi][1]); w4.y = pk2(s[2 * pi][2], s[2 * pi][3]); w4.z = pk2(s[2 * pi + 1][0], s[2 * pi + 1][1]); w4.w = pk2(s[2 * pi + 1][2], s[2 * pi + 1][3]);
                pf[pi] = __builtin_bit_cast(bf16x8_t, w4); }
            { uint4 w4; w4.x = pk2(s[8][0], s[8][1]); w4.y = pk2(s[8][2], s[8][3]); w4.z = 0u; w4.w = 0u; pf[4] = __builtin_bit_cast(bf16x8_t, w4); }
            const int qq = l15 >> 2, pp = lane & 3;
#pragma unroll
            for (int dt = 0; dt < 4; ++dt) {
                f32x4_t o = (f32x4_t){0.f, 0.f, 0.f, 0.f};
#pragma unroll
                for (int pi = 0; pi < 5; ++pi) {
                    const int ka = (ktb0 + 2 * pi) < 15 ? (ktb0 + 2 * pi) : 15, kb = (ktb0 + 2 * pi + 1) < 15 ? (ktb0 + 2 * pi + 1) : 15;
                    u32x2_t v0, v1;
                    tr_read2(ldsb + SWA_VS + (16 * ka + 4 * g4 + qq) * SWA_PITCH + (16 * dt + 4 * pp) * 2, ldsb + SWA_VS + (16 * kb + 4 * g4 + qq) * SWA_PITCH + (16 * dt + 4 * pp) * 2, v0, v1);
                    const uint4 av = make_uint4(v0.x, v0.y, v1.x, v1.y);
                    o = __builtin_amdgcn_mfma_f32_16x16x32_bf16(__builtin_bit_cast(bf16x8_t, av), pf[pi], o, 0, 0, 0);
                }
                { const float i4 = inv * ACT8_SCALE; *(unsigned*)(ya + (size_t)tq * 1024 + hq * 64 + 16 * dt + 4 * g4) = pk4_fp8(o[0] * i4, o[1] * i4, o[2] * i4, o[3] * i4); }
            }
        }
    }
#undef SWA_LOAD
#undef SWA_STORE
#undef SWA_QLOAD
}

constexpr size_t WS_MG = WS_R1 + 128 * MiB, WS_MEG = WS_MG + 2 * MiB, WS_SG = WS_MG + 3 * MiB, WS_SEA = WS_SG + 8 * MiB;
__device__ __forceinline__ void mlstm_gate_item(int item, int lane, LAS float* wl, const float* __restrict__ small, const float* __restrict__ gate_b, float4* __restrict__ mg, float* __restrict__ meg) {
    const int ch = item & 63, h = (item >> 6) & 3, b = item >> 8; const size_t t = (size_t)b * SEQ + ch * 64 + lane;
    const float ip = small[t * 32 + h] + gate_b[h], fp = small[t * 32 + 4 + h] + gate_b[4 + h];
    wl[lane] = fminf(fp, 0.f) - log1pf(__expf(-fabsf(fp)));
    asm volatile("s_waitcnt lgkmcnt(0)" ::: "memory");
    float bs = 0.f;
#pragma unroll
    for (int j = 0; j < 64; j += 4) { const f32x4_t v4 = *(const LAS f32x4_t*)(wl + j);
        bs += (j + 0 <= lane) ? v4[0] : 0.f; bs += (j + 1 <= lane) ? v4[1] : 0.f; bs += (j + 2 <= lane) ? v4[2] : 0.f; bs += (j + 3 <= lane) ? v4[3] : 0.f; }
    const float gt = __builtin_bit_cast(float, __builtin_amdgcn_readlane(__builtin_bit_cast(int, bs), 63));
    mg[t * 4 + h] = make_float4(bs, ip - bs, __expf(bs), __expf(gt - bs + ip) * 0.08838834764831845f);
    if (lane == 0) meg[(b * 4 + h) * 64 + ch] = __expf(gt);
    asm volatile("s_waitcnt lgkmcnt(0)" ::: "memory");
}
__device__ __forceinline__ void ssd_gate_item(int item, int lane, LAS float* wl, const float* __restrict__ small, const float* __restrict__ dt_bias, const float* __restrict__ a_log, float4* __restrict__ sg, float* __restrict__ sea) {
    const int ch = item & 31, hh = (item >> 5) & 15, b = item >> 9; const size_t t0 = (size_t)b * SEQ + ch * 128;
    const float a = -__expf(a_log[hh]), dtb = dt_bias[hh];
    float dt[2];
#pragma unroll
    for (int r = 0; r < 2; ++r) { const float dtr = small[(t0 + lane + 64 * r) * 32 + 8 + hh] + dtb; dt[r] = dtr > 20.f ? dtr : log1pf(__expf(dtr)); wl[lane + 64 * r] = dt[r] * a; }
    asm volatile("s_waitcnt lgkmcnt(0)" ::: "memory");
    float a0 = 0.f, a1 = 0.f;
#pragma unroll 8
    for (int j = 0; j < 128; j += 4) { const f32x4_t v4 = *(const LAS f32x4_t*)(wl + j);
#pragma unroll
        for (int q = 0; q < 4; ++q) { a0 += (j + q <= lane) ? v4[q] : 0.f; a1 += (j + q <= lane + 64) ? v4[q] : 0.f; } }
    const float atot = __builtin_bit_cast(float, __builtin_amdgcn_readlane(__builtin_bit_cast(int, a1), 63));
    sg[(t0 + lane) * 16 + hh] = make_float4(dt[0], a0, __expf(a0), __expf(atot - a0) * dt[0]);
    sg[(t0 + lane + 64) * 16 + hh] = make_float4(dt[1], a1, __expf(a1), __expf(atot - a1) * dt[1]);
    if (lane == 0) sea[(b * 16 + hh) * 32 + ch] = __expf(atot);
    asm volatile("s_waitcnt lgkmcnt(0)" ::: "memory");
}

constexpr int ML_QP = 272, ML_VP = 176, ML_PP = 144;
constexpr int ML_UNITS = NBATCH * 4 * 4;
constexpr int ML_Q = 0, ML_K = 2 * 64 * ML_QP, ML_V = ML_K + 2 * 64 * ML_QP, ML_VW = ML_V + 2 * 64 * ML_VP, ML_P = ML_VW + 64 * ML_VP, ML_CT = ML_P + 64 * ML_PP,
              ML_VEC = ML_CT + 80 * ML_QP, ML_END = ML_VEC + 4096;
static_assert(ML_END <= PHASE_LDS_BYTES, "mLSTM LDS");
__device__ __forceinline__ void tr_read2q(unsigned a0, unsigned a1, u32x2_t& r0, u32x2_t& r1) {
    asm volatile("ds_read_b64_tr_b16 %0, %2\n\tds_read_b64_tr_b16 %1, %3\n\ts_waitcnt lgkmcnt(0)" : "=&v"(r0), "=&v"(r1) : "v"(a0), "v"(a1) : "memory");
}
__device__ __forceinline__ bf16x8_t mk_frag(u32x2_t lo, u32x2_t hi) { const u32x4_t v = (u32x4_t){lo.x, lo.y, hi.x, hi.y}; return __builtin_bit_cast(bf16x8_t, v); }
#define LBAR() do { asm volatile("s_waitcnt lgkmcnt(0)" ::: "memory"); __builtin_amdgcn_s_barrier(); asm volatile("" ::: "memory"); } while (0)
__device__ __forceinline__ void mlstm_phase(LAS unsigned char* lds, const bf16* __restrict__ proj, const float4* __restrict__ mg, const float* __restrict__ meg, bf16* __restrict__ hm, int tid, int bx, int G, const float* __restrict__ tsrc  , unsigned char* __restrict__ tdst) {
    const int lane0 = tid & 63, w = __builtin_amdgcn_readfirstlane(tid >> 6);
    const unsigned ldsb = (unsigned)(size_t)lds;
    LAS float* vec = (LAS float*)(lds + ML_VEC);
    for (int u0_ = bx; u0_ < ML_UNITS; u0_ += G) {
        const int u = (G == 256) ? (u0_ & 7) * 16 + (u0_ >> 3) : u0_;
        const int vs = u & 3, h = (u >> 2) & 3, b = u >> 4;
        LBAR();
        for (int i = tid; i < 2 * 64; i += 512) { LAS unsigned* p = (LAS unsigned*)(lds + ML_V + i * ML_VP + 128); unsigned zz = 0u; asm volatile("" : "+v"(zz));     p[0] = 0x00003F80u | zz;
#pragma unroll
            for (int j = 1; j < 8; ++j) p[j] = zz; }
        for (int i = tid; i < 80 * ML_QP / 4; i += 512) ((LAS unsigned*)(lds + ML_CT))[i] = 0u;
        f32x4_t cacc[5];
#pragma unroll
        for (int i = 0; i < 5; ++i) cacc[i] = (f32x4_t){0.f, 0.f, 0.f, 0.f};
        struct MLRegs { uint4 pq[2], pk[2], pv; float4 pg; float peg; } rs[2];
#pragma unroll
        for (int i = 0; i < 2; ++i) { rs[i].pv = make_uint4(0u, 0u, 0u, 0u); rs[i].pg = make_float4(0.f, 0.f, 0.f, 0.f); rs[i].peg = 0.f; }
#define ML_LOAD(R_, c_) do { const size_t tb_ = (size_t)b * SEQ + (size_t)(c_) * 64; \
            _Pragma("unroll") for (int i_ = 0; i_ < 2; ++i_) { const int p_ = tid + 512 * i_, row_ = p_ >> 4, c16_ = p_ & 15; const bf16* s_ = proj + (tb_ + row_) * NP + h * 128 + c16_ * 8; R_.pq[i_] = *(const uint4*)(s_ + C_MQ); R_.pk[i_] = *(const uint4*)(s_ + C_MK); } \
            R_.pv = *(const uint4*)(proj + (tb_ + (tid >> 3)) * NP + C_MV + h * 256 + vs * 64 + (tid & 7) * 8); \
            if (tid >= 256 && tid < 320) { R_.pg = mg[(tb_ + (tid - 256)) * 4 + h]; R_.peg = meg[(b * 4 + h) * 64 + (c_)]; } } while (0)
#define ML_STORE(R_, bi_) do { _Pragma("unroll") for (int i_ = 0; i_ < 2; ++i_) { const int p_ = tid + 512 * i_, row_ = p_ >> 4, c16_ = p_ & 15; \
                *(LAS u32x4_t*)(lds + ML_Q + (bi_) * 64 * ML_QP + row_ * ML_QP + c16_ * 16) = __builtin_bit_cast(u32x4_t, R_.pq[i_]); *(LAS u32x4_t*)(lds + ML_K + (bi_) * 64 * ML_QP + row_ * ML_QP + c16_ * 16) = __builtin_bit_cast(u32x4_t, R_.pk[i_]); } \
            *(LAS u32x4_t*)(lds + ML_V + (bi_) * 64 * ML_VP + (tid >> 3) * ML_VP + (tid & 7) * 16) = __builtin_bit_cast(u32x4_t, R_.pv); \
            if (tid >= 256 && tid < 320) { LAS float* v_ = vec + (bi_) * 320 + (tid - 256); v_[0] = R_.pg.x; v_[64] = R_.pg.y; v_[128] = R_.pg.z; v_[192] = R_.pg.w; if (tid == 256) vec[(bi_) * 320 + 256] = R_.peg; } } while (0)
        ML_LOAD(rs[0], 0); ML_STORE(rs[0], 0); ML_LOAD(rs[1], 1);
        LBAR();
#pragma nounroll
        for (int c2 = 0; c2 < 64; c2 += 2) {
          int lane = lane0; asm volatile("" : "+v"(lane));
          const int l15 = lane & 15, g4 = lane >> 4, qq = l15 >> 2, pp = lane & 3;
#pragma unroll
          for (int par = 0; par < 2; ++par) {
            const int c = c2 + par, bi_cur = par;
            const LAS unsigned char* Qs = lds + ML_Q + bi_cur * 64 * ML_QP; const LAS unsigned char* Ks = lds + ML_K + bi_cur * 64 * ML_QP;
            const unsigned Ksb = ldsb + ML_K + bi_cur * 64 * ML_QP, Vsb = ldsb + ML_V + bi_cur * 64 * ML_VP, Vwb = ldsb + ML_VW;
            if (c + 2 < 64) ML_LOAD(rs[par], c + 2);
            float4 tq[4]; const size_t tgi = ((size_t)bx * TAB_PER_WG + (size_t)c * 128) * 2 + tid;
            if (tsrc && tid < 256) {
#pragma unroll
                for (int j = 0; j < 4; ++j) tq[j] = ((const float4*)tsrc)[tgi * 4 + j]; }
            const LAS float* vb = vec + bi_cur * 320;
            {
                const int ti = w >> 1;
#pragma unroll
                for (int sj = 0; sj < 2; ++sj) {
                    const int si = 2 * (w & 1) + sj;
                    f32x4_t acc = (f32x4_t){0.f, 0.f, 0.f, 0.f};
                    if (si <= ti) {
#pragma unroll
                        for (int ks = 0; ks < 4; ++ks) {
                            const bf16x8_t a = *(const LAS bf16x8_t*)(Ks + (16 * si + l15) * ML_QP + (32 * ks + 8 * g4) * 2);
                            const bf16x8_t bq = *(const LAS bf16x8_t*)(Qs + (16 * ti + l15) * ML_QP + (32 * ks + 8 * g4) * 2);
                            acc = __builtin_amdgcn_mfma_f32_16x16x32_bf16(a, bq, acc, 0, 0, 0);
                        }
                        const int t = 16 * ti + l15; const float btv = vb[t];
                        const f32x4_t csv = *(const LAS f32x4_t*)(vb + 64 + 16 * si + 4 * g4);
#pragma unroll
                        for (int e = 0; e < 4; ++e) { const int s = 16 * si + 4 * g4 + e; acc[e] = (s <= t) ? acc[e] * __expf(btv + csv[e]) * 0.08838834764831845f : 0.f; }
                    }
                    *(LAS u32x2_t*)(lds + ML_P + (16 * ti + l15) * ML_PP + (16 * si + 4 * g4) * 2) = (u32x2_t){pk2(acc[0], acc[1]), pk2(acc[2], acc[3])};
                }
            }
            for (int it = tid; it < 640; it += 512) { const int s = it / 10, pc = it % 10; const float wsv = vb[192 + s];
                const u32x4_t v = *(const LAS u32x4_t*)(lds + ML_V + bi_cur * 64 * ML_VP + s * ML_VP + pc * 16); u32x4_t o;
#pragma unroll
                for (int j = 0; j < 4; ++j) o[j] = pk2(__uint_as_float(v[j] << 16) * wsv, __uint_as_float(v[j] & 0xffff0000u) * wsv);
                *(LAS u32x4_t*)(lds + ML_VW + s * ML_VP + pc * 16) = o; }
            LBAR();
            f32x4_t numv[3]; const int ti5 = w >> 1;
            {
                const int nv = (w & 1) ? 2 : 3, v0 = (w & 1) ? 3 : 0;
                bf16x8_t pfr[2], qfr[4];
#pragma unroll
                for (int ks = 0; ks < 2; ++ks) pfr[ks] = *(const LAS bf16x8_t*)(lds + ML_P + (16 * ti5 + l15) * ML_PP + (32 * ks + 8 * g4) * 2);
#pragma unroll
                for (int ks = 0; ks < 4; ++ks) qfr[ks] = *(const LAS bf16x8_t*)(Qs + (16 * ti5 + l15) * ML_QP + (32 * ks + 8 * g4) * 2);
#pragma unroll
                for (int j = 0; j < 3; ++j) {
                    numv[j] = (f32x4_t){0.f, 0.f, 0.f, 0.f};
                    if (j < nv) {
                        const int vi = v0 + j;
                        f32x4_t ai = (f32x4_t){0.f, 0.f, 0.f, 0.f}, ax = ai;
#pragma unroll
                        for (int ks = 0; ks < 2; ++ks) {
                            u32x2_t r0, r1; tr_read2q(Vsb + (32 * ks + 8 * g4 + qq) * ML_VP + (16 * vi + 4 * pp) * 2, Vsb + (32 * ks + 8 * g4 + 4 + qq) * ML_VP + (16 * vi + 4 * pp) * 2, r0, r1);
                            ai = __builtin_amdgcn_mfma_f32_16x16x32_bf16(pfr[ks], mk_frag(r0, r1), ai, 0, 0, 0);
                        }
#pragma unroll
                        for (int ks = 0; ks < 4; ++ks) {
                            const bf16x8_t bc = *(const LAS bf16x8_t*)(lds + ML_CT + (16 * vi + l15) * ML_QP + (32 * ks + 8 * g4) * 2);
                            ax = __builtin_amdgcn_mfma_f32_16x16x32_bf16(qfr[ks], bc, ax, 0, 0, 0);
                        }
                        const f32x4_t eb = *(const LAS f32x4_t*)(vb + 128 + 16 * ti5 + 4 * g4);
                        numv[j] = ai + eb * ax;
                    }
                }
                if ((w & 1) && l15 == 0) *(LAS f32x4_t*)(vec + 640 + 16 * ti5 + 4 * g4) = numv[1];
            }
            LBAR();
            {
                const f32x4_t dn = *(const LAS f32x4_t*)(vec + 640 + 16 * ti5 + 4 * g4);
                const size_t tb = (size_t)b * SEQ + (size_t)c * 64;
                const int nw = (w & 1) ? 1 : 3, v0 = (w & 1) ? 3 : 0;
                f32x4_t rdn;
#pragma unroll
                for (int e = 0; e < 4; ++e) rdn[e] = __builtin_amdgcn_rcpf(fmaxf(fabsf(dn[e]), 1.0f));
#pragma unroll
                for (int j = 0; j < 3; ++j)
                    if (j < nw) {
#pragma unroll
                        for (int e = 0; e < 4; ++e) hm[(tb + 16 * ti5 + 4 * g4 + e) * 1024 + h * 256 + vs * 64 + 16 * (v0 + j) + l15] = (bf16)pk2(numv[j][e] * rdn[e], 0.f);
                    }
            }
            {
                const float eg = vb[256];
                bf16x8_t kf[2];
#pragma unroll
                for (int ks = 0; ks < 2; ++ks) { u32x2_t a0, a1; tr_read2q(Ksb + (32 * ks + 8 * g4 + qq) * ML_QP + (16 * w + 4 * pp) * 2, Ksb + (32 * ks + 8 * g4 + 4 + qq) * ML_QP + (16 * w + 4 * pp) * 2, a0, a1); kf[ks] = mk_frag(a0, a1); }
#pragma unroll
                for (int vi = 0; vi < 5; ++vi) {
                    f32x4_t acc = cacc[vi] * eg;
#pragma unroll
                    for (int ks = 0; ks < 2; ++ks) {
                        u32x2_t b0, b1;
                        tr_read2q(Vwb + (32 * ks + 8 * g4 + qq) * ML_VP + (16 * vi + 4 * pp) * 2, Vwb + (32 * ks + 8 * g4 + 4 + qq) * ML_VP + (16 * vi + 4 * pp) * 2, b0, b1);
                        acc = __builtin_amdgcn_mfma_f32_16x16x32_bf16(kf[ks], mk_frag(b0, b1), acc, 0, 0, 0);
                    }
                    cacc[vi] = acc;
                    *(LAS u32x2_t*)(lds + ML_CT + (16 * vi + l15) * ML_QP + (16 * w + 4 * g4) * 2) = (u32x2_t){pk2(acc[0], acc[1]), pk2(acc[2], acc[3])};
                }
            }
            if (tsrc && tid < 256) tab_fp4_store(tq, tdst + tgi * 8, U6_SCALE);
            if (c + 1 < 64) ML_STORE(rs[par ^ 1], bi_cur ^ 1);
            LBAR();
          }
        }
#undef ML_LOAD
#undef ML_STORE
    }
}

constexpr int SD_BP = 272, SD_XP = 144;
constexpr int SD_UNITS = NBATCH * 16;
constexpr int SD_B = 0, SD_C = 128 * SD_BP, SD_M = 2 * 128 * SD_BP, SD_H = 3 * 128 * SD_BP, SD_X = SD_H + 64 * SD_BP, SD_VEC = SD_X + 128 * SD_XP, SD_END = SD_VEC + 4096;
static_assert(SD_END <= PHASE_LDS_BYTES, "SSD LDS");
__device__ __forceinline__ void ssd_phase(LAS unsigned char* lds, const bf16* __restrict__ xcb  , const float4* __restrict__ sg, const float* __restrict__ sea,
                                          const float* __restrict__ dsk, bf16* __restrict__ yraw  , int tid, int bx, int G, const float* __restrict__ tsrc  , unsigned char* __restrict__ tdst) {
    const int lane0 = tid & 63, w = __builtin_amdgcn_readfirstlane(tid >> 6);
    const unsigned ldsb = (unsigned)(size_t)lds;
    LAS float* vec = (LAS float*)(lds + SD_VEC);
    const int hb = G >> 1;
    if (bx >= hb) for (int u0_ = bx - hb; u0_ < SD_UNITS; u0_ += G - hb) {
        const int u = (G == 256) ? (((u0_ & 7) * 2 + (u0_ >> 6)) * 8 + ((u0_ >> 3) & 7)) : u0_;
        const int hh = u & 15, b = u >> 4, g = hh >> 3;
        const float Dk = dsk[hh];
        LBAR();
        for (int i = tid; i < 64 * SD_BP / 4; i += 512) ((LAS unsigned*)(lds + SD_H))[i] = 0u;
        for (int i = tid; i < 128 * SD_BP / 4; i += 512) ((LAS unsigned*)(lds + SD_M))[i] = 0u;
        f32x4_t hacc[4];
#pragma unroll
        for (int i = 0; i < 4; ++i) hacc[i] = (f32x4_t){0.f, 0.f, 0.f, 0.f};
        uint4 pb[4], pc[4], px[2]; float4 pg = make_float4(0.f, 0.f, 0.f, 0.f); float pea = 0.f;
#define SD_LOAD(c_) do { const size_t tb_ = (size_t)b * SEQ + (size_t)(c_) * 128; \
            _Pragma("unroll") for (int i_ = 0; i_ < 4; ++i_) { const int p_ = tid + 512 * i_, row_ = p_ >> 4, c16_ = p_ & 15; const bf16* s_ = xcb + (tb_ + row_) * 1536 + 1024 + g * 128 + c16_ * 8; pb[i_] = *(const uint4*)s_; pc[i_] = *(const uint4*)(s_ + 256); } \
            _Pragma("unroll") for (int i_ = 0; i_ < 2; ++i_) { const int p_ = tid + 512 * i_; px[i_] = *(const uint4*)(xcb + (tb_ + (p_ >> 3)) * 1536 + hh * 64 + (p_ & 7) * 8); } \
            if (tid < 128) { pg = sg[(tb_ + tid) * 16 + hh]; pea = sea[(b * 16 + hh) * 32 + (c_)]; } } while (0)
#define SD_STORE() do { _Pragma("unroll") for (int i_ = 0; i_ < 4; ++i_) { const int p_ = tid + 512 * i_, row_ = p_ >> 4, c16_ = p_ & 15; \
                *(LAS u32x4_t*)(lds + SD_B + row_ * SD_BP + c16_ * 16) = __builtin_bit_cast(u32x4_t, pb[i_]); *(LAS u32x4_t*)(lds + SD_C + row_ * SD_BP + c16_ * 16) = __builtin_bit_cast(u32x4_t, pc[i_]); } \
            _Pragma("unroll") for (int i_ = 0; i_ < 2; ++i_) { const int p_ = tid + 512 * i_; *(LAS u32x4_t*)(lds + SD_X + (p_ >> 3) * SD_XP + (p_ & 7) * 16) = __builtin_bit_cast(u32x4_t, px[i_]); } \
            if (tid < 128) { vec[640 + tid] = pg.x; vec[256 + tid] = pg.y; vec[384 + tid] = pg.z; vec[512 + tid] = pg.w; if (tid == 0) vec[769] = pea; } } while (0)
        SD_LOAD(0); SD_STORE();
        LBAR();
#pragma nounroll
        for (int c = 0; c < 32; ++c) {
            int lane = lane0; asm volatile("" : "+v"(lane));
            const int l15 = lane & 15, g4 = lane >> 4, qq = l15 >> 2, pp = lane & 3;
            if (c + 1 < 32) SD_LOAD(c + 1);
            float4 tq[4]; const size_t tgi = ((size_t)(bx - hb) * TAB_PER_WG + (size_t)c * 256) * 2 + tid;
            if (tsrc) {
#pragma unroll
                for (int j = 0; j < 4; ++j) tq[j] = ((const float4*)tsrc)[tgi * 4 + j]; }
            {
#pragma unroll
                for (int k = 0; k < 5; ++k) {
                    int li, si;
                    if (w >= 4) { li = w; si = w - 4 + k; } else if (k <= w) { li = w; si = k; } else { li = 7 - w; si = k - w - 1; }
                    if (w >= 4 || k <= 3) {
                        const int l = 16 * li + l15; const float acl = vec[256 + l];
                        f32x4_t acc = (f32x4_t){0.f, 0.f, 0.f, 0.f};
#pragma unroll
                        for (int ks = 0; ks < 4; ++ks) {
                            const bf16x8_t av = *(const LAS bf16x8_t*)(lds + SD_B + (16 * si + l15) * SD_BP + (32 * ks + 8 * g4) * 2);
                            const bf16x8_t bv = *(const LAS bf16x8_t*)(lds + SD_C + (16 * li + l15) * SD_BP + (32 * ks + 8 * g4) * 2);
                            acc = __builtin_amdgcn_mfma_f32_16x16x32_bf16(av, bv, acc, 0, 0, 0);
                        }
                        const f32x4_t acs = *(const LAS f32x4_t*)(vec + 256 + 16 * si + 4 * g4), dts = *(const LAS f32x4_t*)(vec + 640 + 16 * si + 4 * g4);
#pragma unroll
                        for (int e = 0; e < 4; ++e) { const int s = 16 * si + 4 * g4 + e; acc[e] = (s <= l) ? acc[e] * __expf(acl - acs[e]) * dts[e] : 0.f; }
                        *(LAS u32x2_t*)(lds + SD_M + l * SD_BP + (16 * si + 4 * g4) * 2) = (u32x2_t){pk2(acc[0], acc[1]), pk2(acc[2], acc[3])};
                    }
                }
            }
            LBAR();
#pragma unroll
            for (int i_ = 0; i_ < 4; ++i_) { const int p_ = tid + 512 * i_, s = p_ >> 4, c16 = p_ & 15; const float wv = vec[512 + s];
                LAS u32x4_t* bp = (LAS u32x4_t*)(lds + SD_B + s * SD_BP + c16 * 16); const u32x4_t v = *bp; u32x4_t o;
#pragma unroll
                for (int j = 0; j < 4; ++j) o[j] = pk2(__uint_as_float(v[j] << 16) * wv, __uint_as_float(v[j] & 0xffff0000u) * wv);
                *bp = o; }
            {
                const int li = w; const size_t tb = (size_t)b * SEQ + (size_t)c * 128;
                const f32x4_t eac = *(const LAS f32x4_t*)(vec + 384 + 16 * li + 4 * g4);
                bf16x8_t mf[4], cf[4];
#pragma unroll
                for (int ks = 0; ks < 4; ++ks) {
                    mf[ks] = *(const LAS bf16x8_t*)(lds + SD_M + (16 * li + l15) * SD_BP + (32 * ks + 8 * g4) * 2);
                    cf[ks] = *(const LAS bf16x8_t*)(lds + SD_C + (16 * li + l15) * SD_BP + (32 * ks + 8 * g4) * 2);
                }
#pragma unroll
                for (int pi = 0; pi < 4; ++pi) {
                    f32x4_t yd = (f32x4_t){0.f, 0.f, 0.f, 0.f}, yo = yd;
#pragma unroll
                    for (int ks = 0; ks < 4; ++ks) {
                        if (32 * ks <= 16 * li + 15) {
                            u32x2_t r0, r1; tr_read2q(ldsb + SD_X + (32 * ks + 8 * g4 + qq) * SD_XP + (16 * pi + 4 * pp) * 2, ldsb + SD_X + (32 * ks + 8 * g4 + 4 + qq) * SD_XP + (16 * pi + 4 * pp) * 2, r0, r1);
                            yd = __builtin_amdgcn_mfma_f32_16x16x32_bf16(mf[ks], mk_frag(r0, r1), yd, 0, 0, 0);
                        }
                    }
#pragma unroll
                    for (int ks = 0; ks < 4; ++ks) {
                        const bf16x8_t bh = *(const LAS bf16x8_t*)(lds + SD_H + (16 * pi + l15) * SD_BP + (32 * ks + 8 * g4) * 2);
                        yo = __builtin_amdgcn_mfma_f32_16x16x32_bf16(cf[ks], bh, yo, 0, 0, 0);
                    }
#pragma unroll
                    for (int e = 0; e < 4; ++e) { const int l = 16 * li + 4 * g4 + e;
                        const float xv = __uint_as_float(((unsigned)*(const LAS unsigned short*)(lds + SD_X + l * SD_XP + (16 * pi + l15) * 2)) << 16);
                        yraw[(tb + l) * 1024 + hh * 64 + 16 * pi + l15] = (bf16)pk2(yd[e] + eac[e] * yo[e] + Dk * xv, 0.f); }
                }
            }
            LBAR();
            {
                const float ea = vec[769];
                bf16x8_t kf[4];
#pragma unroll
                for (int ks = 0; ks < 4; ++ks) { u32x2_t a0, a1; tr_read2q(ldsb + SD_B + (32 * ks + 8 * g4 + qq) * SD_BP + (16 * w + 4 * pp) * 2, ldsb + SD_B + (32 * ks + 8 * g4 + 4 + qq) * SD_BP + (16 * w + 4 * pp) * 2, a0, a1); kf[ks] = mk_frag(a0, a1); }
#pragma unroll
                for (int pi = 0; pi < 4; ++pi) {
                    f32x4_t acc = hacc[pi] * ea;
#pragma unroll
                    for (int ks = 0; ks < 4; ++ks) {
                        u32x2_t b0, b1;
                        tr_read2q(ldsb + SD_X + (32 * ks + 8 * g4 + qq) * SD_XP + (16 * pi + 4 * pp) * 2, ldsb + SD_X + (32 * ks + 8 * g4 + 4 + qq) * SD_XP + (16 * pi + 4 * pp) * 2, b0, b1);
                        acc = __builtin_amdgcn_mfma_f32_16x16x32_bf16(kf[ks], mk_frag(b0, b1), acc, 0, 0, 0);
                    }
                    hacc[pi] = acc;
                    *(LAS u32x2_t*)(lds + SD_H + (16 * pi + l15) * SD_BP + (16 * w + 4 * g4) * 2) = (u32x2_t){pk2(acc[0], acc[1]), pk2(acc[2], acc[3])};
                }
            }
            LBAR();
            if (tsrc) tab_fp4_store(tq, tdst + tgi * 8, V4_SCALE);
            if (c + 1 < 32) SD_STORE();
            LBAR();
        }
#undef SD_LOAD
#undef SD_STORE
    }
}

constexpr int PS_SKP = 272;
constexpr int PS_SK = 0, PS_END = 2 * 128 * PS_SKP;
static_assert(PS_END <= PHASE_LDS_BYTES, "PEER select LDS");
__device__ __forceinline__ unsigned fkey(float f) { const unsigned u = __float_as_uint(f); return u ^ ((unsigned)((int)u >> 31) | 0x80000000u); }
__device__ __forceinline__ float funkey(unsigned k) { return __uint_as_float((k & 0x80000000u) ? (k ^ 0x80000000u) : ~k); }
template <int CTRL> __device__ __forceinline__ unsigned dpp_u(unsigned v) { return (unsigned)__builtin_amdgcn_update_dpp(0, (int)v, CTRL, 0xF, 0xF, true); }
__device__ __forceinline__ unsigned umax(unsigned a, unsigned b) { return a > b ? a : b; }
__device__ __forceinline__ unsigned row_umax(unsigned v) { v = umax(v, dpp_u<0xB1>(v)); v = umax(v, dpp_u<0x4E>(v)); v = umax(v, dpp_u<0x141>(v)); v = umax(v, dpp_u<0x140>(v)); return v; }
__device__ __forceinline__ float row_sum(float v) { v += dpp_f<0xB1>(v); v += dpp_f<0x4E>(v); v += dpp_f<0x141>(v); v += dpp_f<0x140>(v); return v; }
template <int N> __device__ __forceinline__ unsigned row_top16(unsigned (&s)[N], int l15) {
    unsigned mine = 0u;
#pragma unroll
    for (int j = 0; j < 16; ++j) {
        unsigned m = s[0];
#pragma unroll
        for (int i = 1; i < N; ++i) m = umax(m, s[i]);
        m = row_umax(m);
        mine = (l15 == j) ? m : mine;
#pragma unroll
        for (int i = 0; i < N; ++i) s[i] = (s[i] == m) ? 0u : s[i];
    }
    return mine;
}
__device__ __forceinline__ void ce_desc(unsigned& a, unsigned& b) { const unsigned hi = umax(a, b), lo = a < b ? a : b; a = hi; b = lo; }
__device__ __forceinline__ void sort_desc(unsigned (&s)[8]) {
    ce_desc(s[0], s[1]); ce_desc(s[2], s[3]); ce_desc(s[4], s[5]); ce_desc(s[6], s[7]);
    ce_desc(s[0], s[2]); ce_desc(s[1], s[3]); ce_desc(s[4], s[6]); ce_desc(s[5], s[7]);
    ce_desc(s[1], s[2]); ce_desc(s[5], s[6]);
    ce_desc(s[0], s[4]); ce_desc(s[1], s[5]); ce_desc(s[2], s[6]); ce_desc(s[3], s[7]);
    ce_desc(s[2], s[4]); ce_desc(s[3], s[5]);
    ce_desc(s[1], s[2]); ce_desc(s[3], s[4]); ce_desc(s[5], s[6]);
}
__device__ __forceinline__ void sort_desc(unsigned (&s)[4]) { ce_desc(s[0], s[1]); ce_desc(s[2], s[3]); ce_desc(s[0], s[2]); ce_desc(s[1], s[3]); ce_desc(s[1], s[2]); }
template <int N> __device__ __forceinline__ void row_top16x4(unsigned (&s)[4][N], int l15, unsigned (&mine)[4]) {
#pragma unroll
    for (int e = 0; e < 4; ++e) { sort_desc(s[e]); mine[e] = 0u; }
#pragma unroll
    for (int j = 0; j < 16; ++j) {
        unsigned mx[4];
#pragma unroll
        for (int e = 0; e < 4; ++e) mx[e] = s[e][0];
#pragma unroll
        for (int e = 0; e < 4; ++e) mx[e] = umax(mx[e], dpp_u<0xB1>(mx[e]));
#pragma unroll
        for (int e = 0; e < 4; ++e) mx[e] = umax(mx[e], dpp_u<0x4E>(mx[e]));
#pragma unroll
        for (int e = 0; e < 4; ++e) mx[e] = umax(mx[e], dpp_u<0x141>(mx[e]));
#pragma unroll
        for (int e = 0; e < 4; ++e) mx[e] = umax(mx[e], dpp_u<0x140>(mx[e]));
#pragma unroll
        for (int e = 0; e < 4; ++e) {
            mine[e] = (l15 == j) ? mx[e] : mine[e];
            const bool win = s[e][0] == mx[e];
#pragma unroll
            for (int i = 0; i + 1 < N; ++i) s[e][i] = win ? s[e][i + 1] : s[e][i];
            s[e][N - 1] = win ? 0u : s[e][N - 1];
        }
    }
}
__device__ __forceinline__ void peer_select_phase(LAS unsigned char* lds, const bf16* __restrict__ qb  , const bf16* __restrict__ skb  , int* __restrict__ ids, float* __restrict__ gates,
                                                  int tid, int bx, int G) {
    const int lane = tid & 63, w = __builtin_amdgcn_readfirstlane(tid >> 6), l15 = lane & 15, g4 = lane >> 4;
    int ca[4], cb[4];
#pragma unroll
    for (int i = 0; i < 4; ++i) { const int sg = 4 * l15 + i; int a = 0, base = 0;
#pragma unroll
        for (int k = 0; k < 15; ++k) { const int cnt = 16 / (k + 1); const bool adv = (a == k) && (sg >= base + cnt); base += adv ? cnt : 0; a += adv ? 1 : 0; }
        ca[i] = a; cb[i] = sg - base; if (sg >= 50) { ca[i] = -1; cb[i] = 0; } }
    for (int u = bx; u < 8 * 32; u += G) {
        const int h = u >> 5, tr = u & 31;
        LBAR();
        for (int it = tid; it < 4096; it += 512) { const int row = it >> 4, c16 = it & 15;
            *(LAS u32x4_t*)(lds + PS_SK + row * PS_SKP + c16 * 16) = __builtin_bit_cast(u32x4_t, *(const uint4*)(skb + ((size_t)h * 256 + row) * 128 + c16 * 8)); }
        LBAR();
#pragma nounroll
        for (int tile = w; tile < 64; tile += 8) {
            const int t0 = tr * 1024 + tile * 16;
            unsigned top[2][4];
#pragma unroll
            for (int c = 0; c < 2; ++c) {
                bf16x8_t af[4];
#pragma unroll
                for (int ks = 0; ks < 4; ++ks) af[ks] = __builtin_bit_cast(bf16x8_t, *(const uint4*)(qb + (size_t)(t0 + l15) * DM + h * 256 + c * 128 + 32 * ks + 8 * g4));
                unsigned key[8][4];
#pragma unroll
                for (int kt = 0; kt < 8; ++kt) {
                    f32x4_t acc = (f32x4_t){0.f, 0.f, 0.f, 0.f};
#pragma unroll
                    for (int ks = 0; ks < 4; ++ks) {
                        const bf16x8_t bfr = *(const LAS bf16x8_t*)(lds + PS_SK + (c * 128 + 16 * kt + l15) * PS_SKP + (32 * ks + 8 * g4) * 2);
                        acc = __builtin_amdgcn_mfma_f32_16x16x32_bf16(af[ks], bfr, acc, 0, 0, 0);
                    }
#pragma unroll
                    for (int e = 0; e < 4; ++e) key[kt][e] = (fkey(acc[e]) & ~0x7Fu) | (unsigned)(127 - (16 * kt + l15));
                }
                { unsigned s8[4][8];
#pragma unroll
                  for (int e = 0; e < 4; ++e)
#pragma unroll
                      for (int kt = 0; kt < 8; ++kt) s8[e][kt] = key[kt][e];
                  __builtin_amdgcn_sched_barrier(0); row_top16x4<8>(s8, l15, top[c]); __builtin_amdgcn_sched_barrier(0); }
            }
            unsigned s4[4][4], win4[4];
#pragma unroll
            for (int e = 0; e < 4; ++e)
#pragma unroll
                for (int i = 0; i < 4; ++i) {
                    const int srcA = ((lane & 48) + (ca[i] < 0 ? 0 : ca[i])) * 4, srcB = ((lane & 48) + cb[i]) * 4;
                    const unsigned ka = (unsigned)__builtin_amdgcn_ds_bpermute(srcA, (int)top[0][e]), kb = (unsigned)__builtin_amdgcn_ds_bpermute(srcB, (int)top[1][e]);
                    const float cv = funkey(ka & ~0x7Fu) + funkey(kb & ~0x7Fu);
                    s4[e][i] = ca[i] < 0 ? 0u : ((fkey(cv) & ~0xFFu) | (unsigned)(255 - (ca[i] * 16 + cb[i])));
                }
            __builtin_amdgcn_sched_barrier(0); row_top16x4<4>(s4, l15, win4); __builtin_amdgcn_sched_barrier(0);
#pragma unroll
            for (int e = 0; e < 4; ++e) {
                const unsigned win = win4[e];
                const int jw = 255 - (int)(win & 0xFFu), wa = jw >> 4, wb = jw & 15;
                const unsigned ka = (unsigned)__builtin_amdgcn_ds_bpermute(((lane & 48) + wa) * 4, (int)top[0][e]), kb = (unsigned)__builtin_amdgcn_ds_bpermute(((lane & 48) + wb) * 4, (int)top[1][e]);
                const float bv = funkey(ka & ~0x7Fu) + funkey(kb & ~0x7Fu);
                const int id = (127 - (int)(ka & 0x7Fu)) * 128 + (127 - (int)(kb & 0x7Fu));
                const float mx = __builtin_bit_cast(float, __builtin_amdgcn_ds_bpermute((lane & 48) * 4, __builtin_bit_cast(int, bv)));
                const float ex = __expf(bv - mx), den = row_sum(ex);
                const size_t o = (size_t)(t0 + 4 * g4 + e) * 128 + h * 16 + l15;
                ids[o] = id; gates[o] = ex * __builtin_amdgcn_rcpf(den);
            }
        }
    }
}

struct MegaArgs { const float* in[22]; float* out; unsigned char* ws; };
template <int I> __device__ __forceinline__ unsigned long long ld_ptr() {
    unsigned long long v; const auto ka = __builtin_amdgcn_kernarg_segment_ptr();
    asm volatile("s_load_dwordx2 %0, %1, %2\n\ts_waitcnt lgkmcnt(0)" : "=s"(v) : "s"(ka), "n"(I * 8) : "memory");
    return v;
}
#define GAS_ __attribute__((address_space(1)))
#define INF(i) ((const float*)(const GAS_ float*)ld_ptr<(i)>())
#define OUTP ((float*)(GAS_ float*)ld_ptr<22>())
#define WSP ((unsigned char*)(GAS_ unsigned char*)ld_ptr<23>())
enum { I_X = 0, I_WIN, I_MGATEB, I_MNORMW, I_CONVW, I_CONVB, I_DTB, I_ALOG, I_SSMD, I_SNORMW, I_SINKS, I_MERGEB, I_WBR, I_WOUT, I_LN1G, I_LN1B, I_WQ, I_SUBK, I_PU, I_PV, I_LN2G, I_LN2B };

__global__ void __launch_bounds__(512, 2) mega_fwd(MegaArgs a) {
    extern __shared__ __attribute__((aligned(16))) unsigned char lds_raw[];
    LAS unsigned char* lds = (LAS unsigned char*)lds_raw;
    const int wave0 = __builtin_amdgcn_readfirstlane(threadIdx.x >> 6);
    volatile LAS unsigned* MISC = (volatile LAS unsigned*)(lds + MISC_OFF);
    { PHASE_IDS for (int u = tid; u < (LDS_BYTES - PHASE_LDS_BYTES) / 4; u += 512) ((LAS unsigned*)(lds + PHASE_LDS_BYTES))[u] = 0u; }
    __syncthreads();
    { XcdBarrier b0 = xcd_barrier_post((unsigned*)(WSP + WS_CTL) + CW_BAR, MISC + 8); (void)b0; }
#define GRID_BAR() do { XcdBarrier b_; b_.bar = (unsigned*)(WSP + WS_CTL) + CW_BAR; b_.x = xb_xcc_id(); b_.st = MISC + 8; xcd_barrier(b_); } while (0)

    { PHASE_IDS float2* rt = (float2*)(WSP + WS_ROPE);
      for (size_t i = gt; i < (size_t)SEQ * 32; i += NGT) { const int pos = (int)(i >> 5), fi = (int)(i & 31); const float ang = (float)pos * powf(10000.0f, -(float)fi / 32.0f); rt[i] = make_float2(cosf(ang), sinf(ang)); } }
    { PHASE_IDS const float* x = INF(I_X); bf16* xb = (bf16*)(WSP + WS_XB);
      unsigned* xq = (unsigned*)(WSP + WS_XQ);
      for (size_t i = gt; i < (size_t)T_TOK * DM / 4; i += NGT) { const float4 v = ((const float4*)x)[i]; ((uint2*)xb)[i] = make_uint2(pk2(v.x, v.y), pk2(v.z, v.w)); xq[i] = pk4_fp8(v.x, v.y, v.z, v.w); } }

#pragma nounroll
    for (int l = 0; l < DEPTH; ++l) {
        { PHASE_IDS
            unsigned char* ws = WSP; bf16* WinT = (bf16*)(ws + WS_WIN); bf16* WbT = (bf16*)(ws + WS_WB); bf16* WoT = (bf16*)(ws + WS_WO); bf16* WqT = (bf16*)(ws + WS_WQ); float* bias = (float*)(ws + WS_BIAS);
            const float* w_in = INF(I_WIN) + (size_t)l * DM * IN_COLS; const float* w_branch = INF(I_WBR) + (size_t)l * 3 * 1024 * DM; const float* w_out = INF(I_WOUT) + (size_t)l * DM * DM; const float* peer_wq = INF(I_WQ) + (size_t)l * DM * DM;
            const float* merge_gate_b = INF(I_MERGEB) + (size_t)l * 3 * DM;
            LAS float* scr = (LAS float*)(lds + wave * 16384);
            constexpr int I_IN = (DM / 64) * (NP / 32), I_B = (1024 / 64) * (DM / 32), I_O = (DM / 64) * (DM / 32);
            constexpr int NITEMS = I_IN + 3 * I_B + 2 * I_O;
            for (int it = gw; it < NITEMS; it += NGW) {
                int r = it;
                if (r < I_IN) { transpose_item<1>(w_in, DM, IN_COLS, NP, WinT, scr, r, lane, ws + WS_WG8); continue; } r -= I_IN;
                if (r < 3 * I_B) { const int k = r / I_B; transpose_item<2>(w_branch + (size_t)k * 1024 * DM, 1024, DM, DM, nullptr, scr, r - k * I_B, lane, ws + WS_WB8 + (size_t)k * DM * 1024); continue; } r -= 3 * I_B;
                if (r < I_O) { transpose_item<2>(w_out, DM, DM, DM, nullptr, scr, r, lane, ws + WS_WO8); continue; } r -= I_O;
                transpose_item<0>(peer_wq, DM, DM, DM, WqT, scr, r, lane);
            }
            for (size_t n = gt; n < NP; n += NGT) bias[n] = (n >= C_G && n < C_SMALL) ? merge_gate_b[n - C_G] : 0.f;
            { const float4* sk = (const float4*)(INF(I_SUBK) + (size_t)l * 8 * 2 * 128 * 128); uint2* skb = (uint2*)(ws + WS_SKB);
              for (size_t n = gt; n < 8 * 2 * 128 * 128 / 4; n += NGT) { const float4 v = sk[n]; skb[n] = make_uint2(pk2(v.x, v.y), pk2(v.z, v.w)); } }
        }
        GRID_BAR();
        { PHASE_IDS unsigned char* ws = WSP; pg8::Gemm g{(const bf16*)(ws + WS_XQ), (const bf16*)(ws + WS_WG8), T_TOK, C_SMALL - 256, DM / 2}; pg8::StaticOrder S; S.init(T_TOK, C_SMALL - 256, G, bx); S.rfrom = C_AV / 256; S.rto = SMALL_TILE - 1; S.wgm = 4;
          pg8::EpiProj E{(bf16*)(ws + WS_PROJ), (const float*)(ws + WS_BIAS), (float*)(ws + WS_SMALL), NP, GATE_TILE_LO, SMALL_TILE, 0, 1.0f / WG8_SCALE};
          pg8::gemm_phase<pg8::EpiProj, pg8::StaticOrder, true, true, true>(lds, g, S, E, tid); }
        __syncthreads();
        { PHASE_IDS unsigned char* ws = WSP; pg8::Gemm g{(const bf16*)(ws + WS_XB), (const bf16*)(ws + WS_WIN), T_TOK, 512, DM}; pg8::StaticOrder S; S.init(T_TOK, 512, G, bx); S.rfrom = 0; S.rto = C_AV / 256; S.rfrom2 = 1; S.rto2 = SMALL_TILE;
          pg8::EpiProj E{(bf16*)(ws + WS_PROJ), (const float*)(ws + WS_BIAS), (float*)(ws + WS_SMALL), NP, GATE_TILE_LO, SMALL_TILE, 0, 1.0f};
          pg8::gemm_phase<pg8::EpiProj, pg8::StaticOrder, true, true>(lds, g, S, E, tid); }
        GRID_BAR();
        { PHASE_IDS unsigned char* ws = WSP; const bf16* proj = (const bf16*)(ws + WS_PROJ); bf16* xcb = (bf16*)(ws + WS_R2);
          const float* cwg = INF(I_CONVW) + (size_t)l * 4 * 1536; const float* cbg = INF(I_CONVB) + l * 1536;
          LAS float* cw = (LAS float*)(lds + 16384); LAS float* cb = cw + 4 * 1536;
          for (int n = tid; n < 4 * 1536 / 4; n += 512) { const float4 v = ((const float4*)cwg)[n]; *(LAS f32x4e_t*)(cw + 4 * n) = (f32x4e_t){v.x, v.y, v.z, v.w}; }
          for (int n = tid; n < 1536 / 4; n += 512) { const float4 v = ((const float4*)cbg)[n]; *(LAS f32x4e_t*)(cb + 4 * n) = (f32x4e_t){v.x, v.y, v.z, v.w}; }
          asm volatile("s_waitcnt lgkmcnt(0)" ::: "memory"); __builtin_amdgcn_s_barrier(); asm volatile("" ::: "memory");
          for (int i = (int)gt; i < 192 * (T_TOK / 4); i += (int)NGT) ssd_conv_item(i, proj, cw, cb, xcb); }
        { PHASE_IDS unsigned char* ws = WSP; const float* small = (const float*)(ws + WS_SMALL); LAS float* wl = (LAS float*)(lds + wave * 1024);
          for (int i = gw; i < NBATCH * 4 * 64; i += NGW) mlstm_gate_item(i, lane, wl, small, INF(I_MGATEB) + l * 8, (float4*)(ws + WS_MG), (float*)(ws + WS_MEG));
          for (int i = gw; i < NBATCH * 16 * 32; i += NGW) ssd_gate_item(i, lane, wl, small, INF(I_DTB) + l * 16, INF(I_ALOG) + l * 16, (float4*)(ws + WS_SG), (float*)(ws + WS_SEA)); }
        GRID_BAR();
        { PHASE_IDS unsigned char* ws = WSP; mlstm_phase(lds, (const bf16*)(ws + WS_PROJ), (const float4*)(ws + WS_MG), (const float*)(ws + WS_MEG), (bf16*)(ws + WS_HM), tid, bx, G, G == 256 ? INF(I_PU) + (size_t)l * P_EXPERTS * DM : nullptr, ws + WS_TAB); }
        { PHASE_IDS unsigned char* ws = WSP; ssd_phase(lds, (const bf16*)(ws + WS_R2), (const float4*)(ws + WS_SG), (const float*)(ws + WS_SEA), INF(I_SSMD) + l * 16, (bf16*)(ws + WS_R1), tid, bx, G, G == 256 ? INF(I_PV) + (size_t)l * P_EXPERTS * DM : nullptr, ws + WS_TAB + 32 * MiB); }
        { PHASE_IDS unsigned char* ws = WSP; swa_phase(lds, (const bf16*)(ws + WS_PROJ), (const float*)(ws + WS_ROPE), INF(I_SINKS) + l * 16, ws + WS_YQ + 64 * MiB, tid, bx, G); }
        GRID_BAR();
        { PHASE_IDS unsigned char* ws = WSP; const bf16* proj = (const bf16*)(ws + WS_PROJ); const bf16* hm = (const bf16*)(ws + WS_HM); unsigned char* ym = ws + WS_YQ; const float* nwg = INF(I_MNORMW) + l * 1024; const float* nsg = INF(I_SNORMW) + l * 1024;
          LAS float* nw = (LAS float*)lds; LAS float* nsl = nw + 1024;
          if (tid < 256) { const float4 v = ((const float4*)nwg)[tid]; *(LAS f32x4e_t*)(nw + 4 * tid) = (f32x4e_t){v.x, v.y, v.z, v.w}; }
          else { const float4 v = ((const float4*)nsg)[tid - 256]; *(LAS f32x4e_t*)(nsl + 4 * (tid - 256)) = (f32x4e_t){v.x, v.y, v.z, v.w}; }
          asm volatile("s_waitcnt lgkmcnt(0)" ::: "memory"); __builtin_amdgcn_s_barrier(); asm volatile("" ::: "memory");
          for (int t = gw; t < T_TOK; t += NGW) mlstm_post_tok(t, lane, hm, proj, nw, ym); }
        { PHASE_IDS unsigned char* ws = WSP; const bf16* proj = (const bf16*)(ws + WS_PROJ); const bf16* yraw = (const bf16*)(ws + WS_R1); unsigned char* ys = ws + WS_YQ + 32 * MiB; const LAS float* nw = (const LAS float*)lds + 1024;
          for (int tp = gw; tp < T_TOK / 2; tp += NGW) ssd_post_tok2(tp, lane, yraw, proj, nw, ys); }
        GRID_BAR();
        { PHASE_IDS unsigned char* ws = WSP; pg8::Gemm g{(const bf16*)(ws + WS_YQ), (const bf16*)(ws + WS_WB8), T_TOK, DM, 512}; pg8::StaticOrder S; S.init(T_TOK, DM, G, bx); S.wgm = 4;
          pg8::EpiMix<1, 0, 8, 2> E{(bf16*)(ws + WS_R1), (const bf16*)(ws + WS_PROJ) + C_G, DM, NP, nullptr};
          pg8::gemm_phase<pg8::EpiMix<1, 0, 8, 2>, pg8::StaticOrder, true, true, true>(lds, g, S, E, tid); }
        __syncthreads();
        { PHASE_IDS unsigned char* ws = WSP; pg8::Gemm g{(const bf16*)(ws + WS_YQ + 32 * MiB), (const bf16*)(ws + WS_WB8 + (size_t)DM * 1024), T_TOK, DM, 512}; pg8::StaticOrder S; S.init(T_TOK, DM, G, bx); S.wgm = 4;
          pg8::EpiMix<0, 0, 8, 2> E{(bf16*)(ws + WS_R1), (const bf16*)(ws + WS_PROJ) + C_G + DM, DM, NP, nullptr};
          pg8::gemm_phase<pg8::EpiMix<0, 0, 8, 2>, pg8::StaticOrder, true, true, true>(lds, g, S, E, tid); }
        __syncthreads();
        { PHASE_IDS unsigned char* ws = WSP; pg8::Gemm g{(const bf16*)(ws + WS_YQ + 64 * MiB), (const bf16*)(ws + WS_WB8 + (size_t)2 * DM * 1024), T_TOK, DM, 512}; pg8::StaticOrder S; S.init(T_TOK, DM, G, bx); S.wgm = 4;
          pg8::EpiMix<0, 1, 8, 2> E{(bf16*)(ws + WS_R1), (const bf16*)(ws + WS_PROJ) + C_G + 2 * DM, DM, NP, ws + WS_R1Q};
          pg8::gemm_phase<pg8::EpiMix<0, 1, 8, 2>, pg8::StaticOrder, true, true, true>(lds, g, S, E, tid); }
        GRID_BAR();
        { PHASE_IDS unsigned char* ws = WSP;
          pg8::Gemm g{(const bf16*)(ws + WS_R1Q), (const bf16*)(ws + WS_WO8), T_TOK, DM, DM / 2}; pg8::StaticOrder S; S.init(T_TOK, DM, G, bx); S.wgm = 4; pg8::EpiResidB<8> E{(bf16*)(ws + WS_XB), DM, ALPHA, 0};
          pg8::gemm_phase<pg8::EpiResidB<8>, pg8::StaticOrder, true, true, true>(lds, g, S, E, tid); }
        GRID_BAR();
        { PHASE_IDS unsigned char* ws = WSP; bf16* xb = (bf16*)(ws + WS_XB); const float* g1g = INF(I_LN1G) + l * DM; const float* b1g = INF(I_LN1B) + l * DM;
          LAS float* g1 = (LAS float*)lds; LAS float* b1 = g1 + DM;
          { const float4 v = ((const float4*)g1g)[tid], w = ((const float4*)b1g)[tid]; *(LAS f32x4e_t*)(g1 + 4 * tid) = (f32x4e_t){v.x, v.y, v.z, v.w}; *(LAS f32x4e_t*)(b1 + 4 * tid) = (f32x4e_t){w.x, w.y, w.z, w.w}; }
          asm volatile("s_waitcnt lgkmcnt(0)" ::: "memory"); __builtin_amdgcn_s_barrier(); asm volatile("" ::: "memory");
          for (int tp = gw; tp < T_TOK / 2; tp += NGW) ln_body2b(tp, lane, xb, g1, b1); }
        { PHASE_IDS unsigned char* ws = WSP; constexpr size_t NGRP = (size_t)P_EXPERTS * DM / 32;
          const float* pu = INF(I_PU) + (size_t)l * P_EXPERTS * DM; const float* pv = INF(I_PV) + (size_t)l * P_EXPERTS * DM; unsigned char* U6 = ws + WS_TAB; unsigned char* V6 = ws + WS_TAB + 32 * MiB;
          if (G != 256) for (size_t i = gt; i < NGRP; i += NGT) { tab_to_fp4(i, pu, U6, U6_SCALE); tab_to_fp4(i, pv, V6, V4_SCALE); } }
        GRID_BAR();
        { PHASE_IDS unsigned char* ws = WSP; pg8::Gemm g{(const bf16*)(ws + WS_XB), (const bf16*)(ws + WS_WQ), T_TOK, DM, DM}; pg8::StaticOrder S; S.init(T_TOK, DM, G, bx); S.wgm = 4;
          pg8::EpiProj E{(bf16*)(ws + WS_QF), nullptr, nullptr, DM, 1 << 20, -1, 0, 1.0f};
          pg8::gemm_phase<pg8::EpiProj, pg8::StaticOrder, true, true>(lds, g, S, E, tid); }
        GRID_BAR();
        { PHASE_IDS unsigned char* ws = WSP; peer_select_phase(lds, (const bf16*)(ws + WS_QF), (const bf16*)(ws + WS_SKB), (int*)(ws + WS_IDS), (float*)(ws + WS_GATES), tid, bx, G); }
        GRID_BAR();
        { PHASE_IDS unsigned char* ws = WSP; const int* ids = (const int*)(ws + WS_IDS); const float* gates = (const float*)(ws + WS_GATES);
          const unsigned char* U8 = ws + WS_TAB; const unsigned char* V8 = ws + WS_TAB + 32 * MiB;     const float* g2 = INF(I_LN2G) + l * DM; const float* b2 = INF(I_LN2B) + l * DM; float* out = OUTP; bf16* xb = (bf16*)(ws + WS_XB);
          LAS unsigned* wl = (LAS unsigned*)(lds + wave * 2048);
          LAS float* gl = (LAS float*)(lds + 16384); LAS float* bl = gl + DM;
          for (int n = tid; n < DM / 4; n += 512) { const int ln_ = n >> 3, i_ = n & 7; const float4 gv = ((const float4*)g2)[n], bv = ((const float4*)b2)[n];
              *(LAS f32x4e_t*)(gl + (i_ * 64 + ln_) * 4) = (f32x4e_t){gv.x, gv.y, gv.z, gv.w}; *(LAS f32x4e_t*)(bl + (i_ * 64 + ln_) * 4) = (f32x4e_t){bv.x, bv.y, bv.z, bv.w}; }
          asm volatile("s_waitcnt lgkmcnt(0)" ::: "memory"); __builtin_amdgcn_s_barrier(); asm volatile("" ::: "memory");
          for (int t = gw; t < T_TOK; t += NGW) peer_expert_body(t, lane, l == DEPTH - 1, ids, gates, U8, V8, gl, bl, out, xb, ws + WS_XQ, wl); }
        GRID_BAR();
    }
#undef GRID_BAR
}

extern "C" void kernel_launch(void* const* d_in, const int* in_sizes, int n_in, void* d_out, int out_size, void* d_ws, size_t ws_size, hipStream_t stream) {
    static int grid = 0;
    if (grid == 0) {
        if (n_in != 22 || out_size != T_TOK * DM || ws_size < WS_END) { fprintf(stderr, "kernel_launch: unexpected shapes (n_in %d, out %d, ws %zu)\n", n_in, out_size, ws_size); grid = -1; return; }
        int dev = 0, cus = 0, per_cu = 0;
        if (hipGetDevice(&dev) != hipSuccess || hipDeviceGetAttribute(&cus, hipDeviceAttributeMultiprocessorCount, dev) != hipSuccess) { grid = -1; return; }
        if (hipFuncSetAttribute((const void*)mega_fwd, hipFuncAttributeMaxDynamicSharedMemorySize, LDS_BYTES) != hipSuccess) { fprintf(stderr, "kernel_launch: hipFuncSetAttribute failed\n"); grid = -1; return; }
        if (hipOccupancyMaxActiveBlocksPerMultiprocessor(&per_cu, (const void*)mega_fwd, 512, LDS_BYTES) != hipSuccess || per_cu < 1) { fprintf(stderr, "kernel_launch: occupancy query says %d blocks per CU\n", per_cu); (void)hipGetLastError(); grid = -1; return; }
        grid = cus;
    }
    if (grid < 0) return;
    (void)hipMemsetAsync((char*)d_ws + WS_CTL, 0, CTL_ZERO_BYTES, stream);
    MegaArgs a; memset(&a, 0, sizeof(a));
    for (int i = 0; i < 22; ++i) a.in[i] = (const float*)d_in[i];
    a.out = (float*)d_out; a.ws = (unsigned char*)d_ws;
    hipLaunchKernelGGL(mega_fwd, dim3(grid), dim3(512), LDS_BYTES, stream, a);
}
```

```cpp
#include <hip/hip_runtime.h>
#include <cstdio>
#include <cstdint>
#include <cstring>

namespace pg8 {
#define PG8_LAS __attribute__((address_space(3)))
typedef unsigned short bf16_t;
typedef short bf16x8 __attribute__((ext_vector_type(8)));
typedef float f32x4 __attribute__((ext_vector_type(4)));
typedef unsigned u32x4 __attribute__((ext_vector_type(4)));
typedef unsigned u32x2 __attribute__((ext_vector_type(2)));
constexpr int BM = 256, BK = 64, HALF = 128, HTB = HALF * BK * 2  , STAGE_BYTES = 8 * HTB, NXCD = 8, WGM = 8;

__host__ __device__ __forceinline__ int lds_byte(int r, int c) { const int st = (r >> 4) * 2 + (c >> 5), rr = r & 15, cc = c & 31, ob = rr * 64 + cc * 2; return st * 1024 + (ob ^ (((ob >> 9) & 1) << 5)); }
__host__ __device__ __forceinline__ void stage_rc(int b, int& R, int& C) { const int st = b / 1024, sb = b % 1024, swz = sb ^ (((sb >> 9) & 1) << 5); R = (st >> 1) * 16 + swz / 64; C = (st & 1) * 32 + (swz % 64) / 2; }
__host__ __device__ __forceinline__ int perm32(int rho) { const int n = rho >> 4, i = rho & 15; return 8 * (i >> 2) + 4 * n + (i & 3); }

struct Unit { int pm, pn; };
struct Gemm { const bf16_t* A; const bf16_t* Bt; int M, N, K; };

typedef int i32x4 __attribute__((ext_vector_type(4)));
typedef int i32x8 __attribute__((ext_vector_type(8)));
struct StaticOrder {
    int nM, nN, nwg, G, c, rfrom, rto, rfrom2, rto2, i0, i1, wgm;
    __host__ __device__ void init(int M, int N, int G_, int c_) { nM = M / BM; nN = N / BM; nwg = nM * nN; G = G_; c = c_; rfrom = -1; rto = -1; rfrom2 = -1; rto2 = -1; i0 = 0; i1 = 1 << 30; wgm = WGM; }
    __host__ __device__ bool next(int i, Unit& u) const {
        if (i + i0 >= i1) return false;
        const long L = (long)(i + i0) * G + c; if (L >= nwg) return false;
        int wgid = (int)L; { const int q = nwg / NXCD, r = nwg % NXCD, xcd = wgid % NXCD, off = wgid / NXCD; wgid = (xcd < r ? xcd * (q + 1) : r * (q + 1) + (xcd - r) * q) + off; }
        const int nig = wgm * nN, gid = wgid / nig, fm = gid * wgm, gsz = (nM - fm) < wgm ? (nM - fm) : wgm;
        u.pm = fm + ((wgid % nig) % gsz); u.pn = (wgid % nig) / gsz; if (u.pn == rfrom) u.pn = rto; else if (u.pn == rfrom2) u.pn = rto2; return true;
    }
    __device__ __forceinline__ void a_ready(const Unit&) const {}
    __device__ __forceinline__ void done(const Unit&) const {}
};

typedef float cvt2f_t __attribute__((ext_vector_type(2)));
typedef __bf16 cvt2b_t __attribute__((ext_vector_type(2)));
__device__ __forceinline__ unsigned cvt_pk_bf16(float lo, float hi) { const cvt2f_t f = {lo, hi}; return __builtin_bit_cast(unsigned, __builtin_convertvector(f, cvt2b_t)); }
typedef float f32x2 __attribute__((ext_vector_type(2)));
__device__ __forceinline__ float bf_lo(unsigned w) { return __uint_as_float(w << 16); }
__device__ __forceinline__ float bf_hi(unsigned w) { return __uint_as_float(w & 0xffff0000u); }
__device__ __forceinline__ unsigned cvt_pk4_fp8(float a, float b, float c, float d) { int p = __builtin_amdgcn_cvt_pk_fp8_f32(a, b, 0, false); p = __builtin_amdgcn_cvt_pk_fp8_f32(c, d, p, true); return (unsigned)p; }
__device__ __forceinline__ float sigmoidf_(float x) { return __builtin_amdgcn_rcpf(1.0f + __expf(-x)); }

struct EpiF32 {
    static constexpr bool PERM = false, AFTER_DRAIN = false;
    float* C; int ldc; int pad;
    __device__ __forceinline__ void operator()(const f32x4 (&acc)[2][2][4][2], const Unit& u, int wr, int wc, int fr, int fq) const {
        const int row0 = u.pm * BM + wr * 64 + fr, col0 = u.pn * BM + wc * 32 + 4 * fq;
#pragma unroll
        for (int ai = 0; ai < 2; ++ai)
#pragma unroll
            for (int m = 0; m < 4; ++m) { float* rowp = C + (size_t)(row0 + ai * HALF + m * 16) * ldc + col0;
#pragma unroll
                for (int bj = 0; bj < 2; ++bj)
#pragma unroll
                    for (int n = 0; n < 2; ++n) *(f32x4*)(rowp + bj * HALF + n * 16) = acc[ai][bj][m][n]; }
    }
};
struct EpiResid {
    static constexpr bool PERM = false, AFTER_DRAIN = false;
    float* C; const float* X; int ldc; float alpha;
    __device__ __forceinline__ void operator()(const f32x4 (&acc)[2][2][4][2], const Unit& u, int wr, int wc, int fr, int fq) const {
        const int row0 = u.pm * BM + wr * 64 + fr, col0 = u.pn * BM + wc * 32 + 4 * fq;
#pragma unroll
        for (int ai = 0; ai < 2; ++ai)
#pragma unroll
            for (int m = 0; m < 4; ++m) { const size_t off = (size_t)(row0 + ai * HALF + m * 16) * ldc + col0;
#pragma unroll
                for (int bj = 0; bj < 2; ++bj)
#pragma unroll
                    for (int n = 0; n < 2; ++n) { const f32x4 xv = *(const f32x4*)(X + off + bj * HALF + n * 16);
                        *(f32x4*)(C + off + bj * HALF + n * 16) = acc[ai][bj][m][n] + xv * alpha; } }
    }
};
template <int ASH = 0> struct EpiResidB {
    static constexpr bool PERM = true, AFTER_DRAIN = false;
    static constexpr float ascale = 1.0f / (float)(1 << ASH);
    bf16_t* O; int ldc; float alpha; int pad;
    __device__ __forceinline__ void operator()(const f32x4 (&acc)[2][2][4][2], const Unit& u, int wr, int wc, int fr, int fq) const {
        const int row0 = u.pm * BM + wr * 64 + fr, col0 = u.pn * BM + wc * 32 + 8 * fq;
#pragma unroll
        for (int ai = 0; ai < 2; ++ai) {
            u32x4 ow[4][2];
#pragma unroll
            for (int m = 0; m < 4; ++m)
#pragma unroll
                for (int bj = 0; bj < 2; ++bj) ow[m][bj] = *(const u32x4*)(O + (size_t)(row0 + ai * HALF + m * 16) * ldc + col0 + bj * HALF);
#pragma unroll
            for (int m = 0; m < 4; ++m) { bf16_t* rowp = O + (size_t)(row0 + ai * HALF + m * 16) * ldc + col0;
#pragma unroll
                for (int bj = 0; bj < 2; ++bj) { const u32x4 o = ow[m][bj];
                    const f32x4 a0 = acc[ai][bj][m][0], a1 = acc[ai][bj][m][1];
                    const float r0 = bf_lo(o.x) * alpha + a0[0] * ascale, r1 = bf_hi(o.x) * alpha + a0[1] * ascale, r2 = bf_lo(o.y) * alpha + a0[2] * ascale, r3 = bf_hi(o.y) * alpha + a0[3] * ascale;
                    const float r4 = bf_lo(o.z) * alpha + a1[0] * ascale, r5 = bf_hi(o.z) * alpha + a1[1] * ascale, r6 = bf_lo(o.w) * alpha + a1[2] * ascale, r7 = bf_hi(o.w) * alpha + a1[3] * ascale;
                    u32x4 w; w.x = cvt_pk_bf16(r0, r1); w.y = cvt_pk_bf16(r2, r3); w.z = cvt_pk_bf16(r4, r5); w.w = cvt_pk_bf16(r6, r7);
                    *(u32x4*)(rowp + bj * HALF) = w; } }
        }
    }
};
struct EpiProj {
    static constexpr bool PERM = true, AFTER_DRAIN = false;
    bf16_t* O; const float* bias; float* small; int ldc; int gate_lo; int small_tile; int pn_off; float ascale;
    __device__ __forceinline__ void operator()(const f32x4 (&acc)[2][2][4][2], const Unit& u, int wr, int wc, int fr, int fq) const {
        const int pn = u.pn + pn_off; const int row0 = u.pm * BM + wr * 64 + fr, col0 = pn * BM + wc * 32 + 8 * fq;
        if (pn == small_tile) {
            if (wc == 0) {
#pragma unroll
                for (int ai = 0; ai < 2; ++ai)
#pragma unroll
                    for (int m = 0; m < 4; ++m) { float* p = small + (size_t)(row0 + ai * HALF + m * 16) * 32 + 8 * fq;
                        *(f32x4*)p = acc[ai][0][m][0]; *(f32x4*)(p + 4) = acc[ai][0][m][1]; }
            }
            return;
        }
        const bool gate = pn >= gate_lo;
        f32x4 bv[2][2];
#pragma unroll
        for (int bj = 0; bj < 2; ++bj)
#pragma unroll
            for (int n = 0; n < 2; ++n) bv[bj][n] = gate ? *(const f32x4*)(bias + col0 + bj * HALF + 4 * n) : (f32x4){0.f, 0.f, 0.f, 0.f};
#pragma unroll
        for (int ai = 0; ai < 2; ++ai)
#pragma unroll
            for (int m = 0; m < 4; ++m) { bf16_t* rowp = O + (size_t)(row0 + ai * HALF + m * 16) * ldc + col0;
#pragma unroll
                for (int bj = 0; bj < 2; ++bj) { f32x4 v0 = acc[ai][bj][m][0] * ascale + bv[bj][0], v1 = acc[ai][bj][m][1] * ascale + bv[bj][1];
                    if (gate) {
#pragma unroll
                        for (int j = 0; j < 4; ++j) { v0[j] = sigmoidf_(v0[j]); v1[j] = sigmoidf_(v1[j]); } }
                    u32x4 w; w.x = cvt_pk_bf16(v0[0], v0[1]); w.y = cvt_pk_bf16(v0[2], v0[3]); w.z = cvt_pk_bf16(v1[0], v1[1]); w.w = cvt_pk_bf16(v1[2], v1[3]);
                    *(u32x4*)(rowp + bj * HALF) = w; } }
    }
};
template <int FIRST, int LASTQ = 0, int ASH = 0, int QSH = 0> struct EpiMix {
    static constexpr bool PERM = true, AFTER_DRAIN = false;
    static constexpr float ascale = 1.0f / (float)(1 << ASH), qscale = (float)(1 << QSH);
    bf16_t* O; const bf16_t* G; int ldc; int ldg; unsigned char* Q;
    __device__ __forceinline__ void operator()(const f32x4 (&acc)[2][2][4][2], const Unit& u, int wr, int wc, int fr, int fq) const {
        const int row0 = u.pm * BM + wr * 64 + fr, col0 = u.pn * BM + wc * 32 + 8 * fq;
#pragma unroll
        for (int ai = 0; ai < 2; ++ai) {
            u32x4 gwv[4][2], owv[4][2];
#pragma unroll
            for (int m = 0; m < 4; ++m)
#pragma unroll
                for (int bj = 0; bj < 2; ++bj) { const int row = row0 + ai * HALF + m * 16;
                    gwv[m][bj] = *(const u32x4*)(G + (size_t)row * ldg + col0 + bj * HALF);
                    owv[m][bj] = (u32x4){0u, 0u, 0u, 0u}; if (!FIRST) owv[m][bj] = *(const u32x4*)(O + (size_t)row * ldc + col0 + bj * HALF); }
#pragma unroll
            for (int m = 0; m < 4; ++m) { const int row = row0 + ai * HALF + m * 16; bf16_t* rowp = O + (size_t)row * ldc + col0;
#pragma unroll
                for (int bj = 0; bj < 2; ++bj) { const u32x4 gw = gwv[m][bj], ow = owv[m][bj];
                    const f32x4 a0 = acc[ai][bj][m][0] * ascale, a1 = acc[ai][bj][m][1] * ascale;
                    float r0 = bf_lo(ow.x) + bf_lo(gw.x) * a0[0], r1 = bf_hi(ow.x) + bf_hi(gw.x) * a0[1], r2 = bf_lo(ow.y) + bf_lo(gw.y) * a0[2], r3 = bf_hi(ow.y) + bf_hi(gw.y) * a0[3];
                    float r4 = bf_lo(ow.z) + bf_lo(gw.z) * a1[0], r5 = bf_hi(ow.z) + bf_hi(gw.z) * a1[1], r6 = bf_lo(ow.w) + bf_lo(gw.w) * a1[2], r7 = bf_hi(ow.w) + bf_hi(gw.w) * a1[3];
                    if constexpr (LASTQ) { *(u32x2*)(Q + (size_t)row * ldc + col0 + bj * HALF) = (u32x2){cvt_pk4_fp8(r0 * qscale, r1 * qscale, r2 * qscale, r3 * qscale), cvt_pk4_fp8(r4 * qscale, r5 * qscale, r6 * qscale, r7 * qscale)}; }
                    else { u32x4 w; w.x = cvt_pk_bf16(r0, r1); w.y = cvt_pk_bf16(r2, r3); w.z = cvt_pk_bf16(r4, r5); w.w = cvt_pk_bf16(r6, r7);
                        *(u32x4*)(rowp + bj * HALF) = w; } } }
        }
    }
};
template <class Epi, class Sched, bool ALIGN_EPI = false, bool SP2 = false, bool FP8 = false>
__device__ __forceinline__ void gemm_phase(PG8_LAS unsigned char* lds, const Gemm g, const Sched& S, const Epi& E, int tid_) {
    asm volatile("" : "+v"(tid_));
    const int tid = tid_, wid = __builtin_amdgcn_readfirstlane(tid >> 6), lane = tid & 63, wr = wid >> 2, wc = wid & 3, fr = lane & 15, fq = lane >> 4;
    const int K = g.K, nt = K / BK;
    unsigned voffA[2], voffB[2];
#pragma unroll
    for (int i = 0; i < 2; ++i) { int R, C; stage_rc(tid * 16 + i * 8192, R, C); const int Rb = Epi::PERM ? ((R & ~31) + perm32(R & 31)) : R;
        voffA[i] = (unsigned)(R * K + C) * 2u; voffB[i] = (unsigned)(Rb * K + C) * 2u; }
    const size_t kstep = (size_t)(BK * 2);
    const size_t hstep = (size_t)HALF * K * 2;
    const size_t tstep = 2 * hstep;
    const unsigned ldsw = (unsigned)wid * 1024u;
    const int aoff = lds_byte(wr * 64 + fr, fq * 8), boff = lds_byte(wc * 32 + fr, fq * 8);
#define PG8_SA(b, h) (((b) * 2 + (h)) * HTB)
#define PG8_SB(b, h) ((4 + (b) * 2 + (h)) * HTB)
#define PG8_STAGE(bufoff, gbase, voff) do { _Pragma("unroll") for (int _i = 0; _i < 2; ++_i) \
        __builtin_amdgcn_global_load_lds((const unsigned*)((const char*)(gbase) + (voff)[_i]), (PG8_LAS unsigned*)(lds + (bufoff) + ldsw + _i * 8192), 16, 0, 0); } while (0)
#define PG8_LDA(dst, b, h) do { _Pragma("unroll") for (int m = 0; m < 4; ++m) _Pragma("unroll") for (int k = 0; k < 2; ++k) dst[m][k] = *(const PG8_LAS bf16x8*)(lds + PG8_SA(b, h) + aoff + m * 2048 + k * 1024); } while (0)
#define PG8_LDB(dst, b, h) do { _Pragma("unroll") for (int n = 0; n < 2; ++n) _Pragma("unroll") for (int k = 0; k < 2; ++k) dst[n][k] = *(const PG8_LAS bf16x8*)(lds + PG8_SB(b, h) + boff + n * 2048 + k * 1024); } while (0)
#define PG8_CAT(lo, hi) ((i32x8){__builtin_bit_cast(i32x4, lo)[0], __builtin_bit_cast(i32x4, lo)[1], __builtin_bit_cast(i32x4, lo)[2], __builtin_bit_cast(i32x4, lo)[3], __builtin_bit_cast(i32x4, hi)[0], __builtin_bit_cast(i32x4, hi)[1], __builtin_bit_cast(i32x4, hi)[2], __builtin_bit_cast(i32x4, hi)[3]})
#define PG8_MMA(ai, bj, At, Bt) do { __builtin_amdgcn_s_setprio(1); _Pragma("unroll") for (int m = 0; m < 4; ++m) _Pragma("unroll") for (int n = 0; n < 2; ++n) { \
        if constexpr (FP8) { asm volatile("v_mfma_scale_f32_16x16x128_f8f6f4 %0, %1, %2, %0, %3, %3 op_sel_hi:[0,0,0]" : "+v"(acc[ai][bj][m][n]) : "v"(PG8_CAT(Bt[n][0], Bt[n][1])), "v"(PG8_CAT(At[m][0], At[m][1])), "v"(fp8_unit_scale)); } \
        else { _Pragma("unroll") for (int k = 0; k < 2; ++k) acc[ai][bj][m][n] = __builtin_amdgcn_mfma_f32_16x16x32_bf16(Bt[n][k], At[m][k], acc[ai][bj][m][n], 0, 0, 0); } } \
        __builtin_amdgcn_s_setprio(0); } while (0)
#define PG8_WAIT_V(n) asm volatile("s_waitcnt vmcnt(" #n ")" ::: "memory")
#define PG8_WAIT_L(n) asm volatile("s_waitcnt lgkmcnt(" #n ")" ::: "memory")
#define PG8_BAR __builtin_amdgcn_s_barrier()
#define PG8_SCHED __builtin_amdgcn_sched_barrier(0)
    Unit cur, nxt; int ui = 0;
    [[maybe_unused]] int fp8_unit_scale = 0x7F7F7F7F;
    if constexpr (FP8) asm volatile("" : "+v"(fp8_unit_scale));
    if (!S.next(0, cur)) return;
    f32x4 acc[2][2][4][2];
#pragma unroll
    for (int a = 0; a < 2; ++a)
#pragma unroll
        for (int b = 0; b < 2; ++b)
#pragma unroll
            for (int m = 0; m < 4; ++m)
#pragma unroll
                for (int n = 0; n < 2; ++n) acc[a][b][m][n] = (f32x4){0.f, 0.f, 0.f, 0.f};
    bf16x8 At[4][2], B0[2][2], B1[2][2];
    const char* cA = (const char*)g.A + (size_t)cur.pm * tstep; const char* cB = (const char*)g.Bt + (size_t)cur.pn * tstep;
    S.a_ready(cur);
    if constexpr (SP2) {
        PG8_STAGE(PG8_SB(0, 0), cB, voffB); PG8_STAGE(PG8_SB(0, 1), cB + hstep, voffB); PG8_STAGE(PG8_SA(0, 0), cA, voffA); PG8_STAGE(PG8_SA(0, 1), cA + hstep, voffA);
        if (wr == 1) PG8_BAR;
        PG8_WAIT_V(2); PG8_BAR;
        PG8_STAGE(PG8_SB(1, 0), cB + kstep, voffB); PG8_STAGE(PG8_SA(1, 0), cA + kstep, voffA); PG8_STAGE(PG8_SB(1, 1), cB + hstep + kstep, voffB);
        PG8_WAIT_V(6); PG8_BAR;
    } else {
        PG8_STAGE(PG8_SB(0, 0), cB, voffB); PG8_STAGE(PG8_SA(0, 0), cA, voffA); PG8_STAGE(PG8_SB(0, 1), cB + hstep, voffB); PG8_STAGE(PG8_SA(0, 1), cA + hstep, voffA);
        if (wr == 1) PG8_BAR;
        PG8_WAIT_V(4); PG8_BAR;
        PG8_STAGE(PG8_SB(1, 0), cB + kstep, voffB); PG8_STAGE(PG8_SA(1, 0), cA + kstep, voffA); PG8_STAGE(PG8_SB(1, 1), cB + hstep + kstep, voffB);
        PG8_WAIT_V(6); PG8_BAR;
    }
    for (;;) {
        const bool has_next = S.next(ui + 1, nxt);
        const char* nA = has_next ? (const char*)g.A + (size_t)nxt.pm * tstep : cA; const char* nB = has_next ? (const char*)g.Bt + (size_t)nxt.pn * tstep : cB;
        for (int t = 0; t < nt; t += 2) {
            const bool last = (t == nt - 2);
            const char* a1 = cA + (size_t)(t + 1) * kstep;
            const char* a2 = last ? nA : cA + (size_t)(t + 2) * kstep; const char* b2 = last ? nB : cB + (size_t)(t + 2) * kstep;
            const char* a3 = a2 + kstep; const char* b3 = b2 + kstep;
            if (last && has_next) S.a_ready(nxt);
            if constexpr (SP2) {
            PG8_LDB(B0, 0, 0); PG8_LDB(B1, 0, 1); PG8_SCHED; PG8_LDA(At, 0, 0); PG8_STAGE(PG8_SA(1, 1), a1 + hstep, voffA);
            PG8_WAIT_V(8); PG8_WAIT_L(0); PG8_BAR; PG8_MMA(0, 0, At, B0); PG8_MMA(0, 1, At, B1); PG8_BAR; PG8_SCHED;
            PG8_LDA(At, 0, 1); PG8_STAGE(PG8_SB(0, 0), b2, voffB); PG8_STAGE(PG8_SB(0, 1), b2 + hstep, voffB); PG8_STAGE(PG8_SA(0, 0), a2, voffA);
            PG8_WAIT_V(8); PG8_WAIT_L(0); PG8_BAR; PG8_MMA(1, 0, At, B0); PG8_MMA(1, 1, At, B1); PG8_BAR; PG8_SCHED;
            PG8_LDB(B0, 1, 0); PG8_LDB(B1, 1, 1); PG8_SCHED; PG8_LDA(At, 1, 0); PG8_STAGE(PG8_SA(0, 1), a2 + hstep, voffA);
            PG8_WAIT_V(8); PG8_WAIT_L(0); PG8_BAR; PG8_MMA(0, 0, At, B0); PG8_MMA(0, 1, At, B1); PG8_BAR; PG8_SCHED;
            PG8_LDA(At, 1, 1); PG8_STAGE(PG8_SB(1, 0), b3, voffB); PG8_STAGE(PG8_SB(1, 1), b3 + hstep, voffB); PG8_STAGE(PG8_SA(1, 0), a3, voffA);
            PG8_WAIT_V(8); PG8_WAIT_L(0); PG8_BAR; PG8_MMA(1, 0, At, B0); PG8_MMA(1, 1, At, B1); PG8_BAR; PG8_SCHED;
            } else {
            PG8_LDB(B0, 0, 0); PG8_SCHED; PG8_LDA(At, 0, 0); PG8_STAGE(PG8_SA(1, 1), a1 + hstep, voffA);
            PG8_WAIT_L(8); PG8_BAR; PG8_WAIT_L(0); PG8_MMA(0, 0, At, B0); PG8_BAR; PG8_SCHED;
            PG8_LDB(B1, 0, 1); PG8_STAGE(PG8_SB(0, 0), b2, voffB);
            PG8_BAR; PG8_WAIT_L(0); PG8_MMA(0, 1, At, B1); PG8_BAR;
            PG8_LDA(At, 0, 1); PG8_STAGE(PG8_SA(0, 0), a2, voffA);
            PG8_BAR; PG8_WAIT_L(0); PG8_MMA(1, 0, At, B0); PG8_BAR; PG8_SCHED;
            PG8_STAGE(PG8_SB(0, 1), b2 + hstep, voffB);
            PG8_WAIT_V(6); PG8_BAR; PG8_MMA(1, 1, At, B1); PG8_BAR;
            PG8_LDB(B0, 1, 0); PG8_SCHED; PG8_LDA(At, 1, 0); PG8_STAGE(PG8_SA(0, 1), a2 + hstep, voffA);
            PG8_WAIT_L(8); PG8_BAR; PG8_WAIT_L(0); PG8_MMA(0, 0, At, B0); PG8_BAR; PG8_SCHED;
            PG8_LDB(B1, 1, 1); PG8_STAGE(PG8_SB(1, 0), b3, voffB);
            PG8_BAR; PG8_WAIT_L(0); PG8_MMA(0, 1, At, B1); PG8_BAR;
            PG8_LDA(At, 1, 1); PG8_STAGE(PG8_SA(1, 0), a3, voffA);
            PG8_BAR; PG8_WAIT_L(0); PG8_MMA(1, 0, At, B0); PG8_BAR; PG8_SCHED;
            PG8_STAGE(PG8_SB(1, 1), b3 + hstep, voffB);
            PG8_WAIT_V(6); PG8_BAR; PG8_MMA(1, 1, At, B1); PG8_BAR;
            }
        }
        if constexpr (FP8) asm volatile("s_nop 15\n\ts_nop 15\n\ts_nop 15" ::: "memory");
        if constexpr (ALIGN_EPI) { if (wr == 0) PG8_BAR; }
        if constexpr (!Epi::AFTER_DRAIN) { E(acc, cur, wr, wc, fr, fq); S.done(cur); }
        if (!has_next) break;
#pragma unroll
        for (int a = 0; a < 2; ++a)
#pragma unroll
            for (int b = 0; b < 2; ++b)
#pragma unroll
                for (int m = 0; m < 4; ++m)
#pragma unroll
                    for (int n = 0; n < 2; ++n) acc[a][b][m][n] = (f32x4){0.f, 0.f, 0.f, 0.f};
        cur = nxt; cA = nA; cB = nB; ++ui;
        if constexpr (ALIGN_EPI) { if (wr == 1) PG8_BAR; }
    }
    PG8_WAIT_V(0);
    if constexpr (!ALIGN_EPI) { if (wr == 0) PG8_BAR; }
    PG8_BAR;
    if constexpr (Epi::AFTER_DRAIN) { E.fused(acc, cur, wr, wc, fr, fq, lds, wid, lane); S.done(cur); }
#undef PG8_SA
#undef PG8_SB
#undef PG8_STAGE
#undef PG8_LDA
#undef PG8_LDB
#undef PG8_MMA
#undef PG8_CAT
#undef PG8_WAIT_V
#undef PG8_WAIT_L
#undef PG8_BAR
#undef PG8_SCHED
}
}
typedef unsigned short bf16;
#define LAS __attribute__((address_space(3)))
constexpr int T_TOK = 32768, DM = 2048, SEQ = 4096, NBATCH = 8, DEPTH = 4;
constexpr int IN_COLS = 13336, NP = 13568;
constexpr int C_MQ = 0, C_MK = 512, C_MV = 1024, C_MO = 2048, C_SZ = 3072, C_SXBC = 4096, C_AQ = 5632, C_AK = 6656, C_AV = 6912, C_G = 7168, C_SMALL = 13312;
constexpr int GATE_TILE_LO = C_G / 256, SMALL_TILE = C_SMALL / 256;
constexpr float ALPHA = 1.681792830507429f;
constexpr int P_EXPERTS = 16384;

constexpr size_t MiB = 1u << 20;
constexpr size_t WS_CTL = 0, CTL_ZERO_BYTES = 64 * 1024, WS_WIN = 1 * MiB, WS_WB = 54 * MiB, WS_WO = 66 * MiB, WS_WQ = 74 * MiB, WS_BIAS = 82 * MiB, WS_SKB = 82 * MiB + 256 * 1024, WS_SMALL = 83 * MiB, WS_ROPE = 87 * MiB,
                 WS_TAB = 1480 * MiB  , WS_XB = 88 * MiB, WS_XQ = 216 * MiB  , WS_WG8 = 280 * MiB  , WS_WB8 = 306 * MiB  , WS_YQ = 312 * MiB  , WS_R1Q = 408 * MiB  , WS_WO8 = 54 * MiB  , WS_PROJ = 472 * MiB, WS_R1 = 1320 * MiB, WS_Y = 1480 * MiB, WS_R2 = 1672 * MiB, WS_HM = 1864 * MiB, WS_END = 1992 * MiB;
constexpr size_t WS_QF = WS_PROJ, WS_IDS = WS_PROJ + 256 * MiB, WS_GATES = WS_PROJ + 272 * MiB;
constexpr int CW_BAR = 4096;
constexpr int RING_BYTES = 131072, PHASE_LDS_BYTES = 155648, MISC_OFF = PHASE_LDS_BYTES + 320, LDS_BYTES = 163840;

__device__ __forceinline__ unsigned f2bf(float f) { unsigned u = __float_as_uint(f); return (u + 0x7fffu + ((u >> 16) & 1u)) >> 16; }
typedef float f32x4e_t __attribute__((ext_vector_type(4)));
typedef float pk2f_t __attribute__((ext_vector_type(2)));
typedef __bf16 pk2b_t __attribute__((ext_vector_type(2)));
__device__ __forceinline__ unsigned pk2(float lo, float hi) { const pk2f_t f = {lo, hi}; return __builtin_bit_cast(unsigned, __builtin_convertvector(f, pk2b_t)); }
__device__ __forceinline__ unsigned pk4_fp8(float a, float b, float c, float d) { int p = __builtin_amdgcn_cvt_pk_fp8_f32(a, b, 0, false); p = __builtin_amdgcn_cvt_pk_fp8_f32(c, d, p, true); return (unsigned)p; }
constexpr float ACT8_SCALE = 4.0f;
static_assert(ACT8_SCALE == 4.0f, "epilogue shifts");
constexpr float WG8_SCALE = 64.0f;
__device__ __forceinline__ float bf2f(bf16 b) { return __uint_as_float(((unsigned)b) << 16); }
__device__ __forceinline__ float sigm(float x) { return __builtin_amdgcn_rcpf(1.0f + __expf(-x)); }
__device__ __forceinline__ void halves32(float& lo, float& hi) { asm volatile("s_nop 1\n\tv_permlane32_swap_b32 %0, %1" : "+v"(lo), "+v"(hi)); }
template <int CTRL> __device__ __forceinline__ float dpp_f(float v) { return __builtin_bit_cast(float, __builtin_amdgcn_update_dpp(0, __builtin_bit_cast(int, v), CTRL, 0xF, 0xF, true)); }
__device__ __forceinline__ float quad_sum(float v) { v += dpp_f<0xB1>(v); v += dpp_f<0x4E>(v); return v; }
__device__ __forceinline__ float wave_sum(float v) {
    v = quad_sum(v); v += dpp_f<0x141>(v); v += dpp_f<0x140>(v);
    v += __builtin_bit_cast(float, __builtin_amdgcn_ds_swizzle(__builtin_bit_cast(int, v), 0x401F));
    return __builtin_bit_cast(float, __builtin_amdgcn_readlane(__builtin_bit_cast(int, v), 0)) + __builtin_bit_cast(float, __builtin_amdgcn_readlane(__builtin_bit_cast(int, v), 32));
}
__device__ __forceinline__ int src_col(int n) {
    if (n < 3072) return n;
    if (n < 5632) return n + 8;
    if (n < 13312) return n + 24;
    if (n < 13320) return 3072 + (n - 13312);
    if (n < 13336) return 5640 + (n - 13320);
    return -1;
}

#define XB_TMO      128
#define XB_XCNT(j)  (256  + 64 * (j))
#define XB_XSUB(j)  (1280 + 64 * (j))
#define XB_XGEN(j)  (2304 + 64 * (j))
#define XB_TOP      3328
#define XB_TOPGEN   3392
#define XCD_BAR_WORDS 3456
#define XB_SPIN_CAP (1u << 18)

__device__ __forceinline__ unsigned xb_ld(unsigned* p)              { return __hip_atomic_load(p, __ATOMIC_RELAXED, __HIP_MEMORY_SCOPE_AGENT); }
__device__ __forceinline__ unsigned xb_add(unsigned* p, unsigned v) { return __hip_atomic_fetch_add(p, v, __ATOMIC_RELAXED, __HIP_MEMORY_SCOPE_AGENT); }
__device__ __forceinline__ unsigned xb_xcc_id() { return (unsigned)__builtin_amdgcn_s_getreg((3 << 11) | 20) & 0xFu; }
#define XB_SPIN(cond, bar) do { unsigned _sp = 0; while (cond) { __builtin_amdgcn_s_sleep(1); \
    if ((++_sp & 255u) == 0u) { if (xb_ld(&(bar)[XB_TMO])) break; if (_sp > XB_SPIN_CAP) { atomicAdd(&(bar)[XB_TMO], 1u); break; } } } } while (0)

struct XcdBarrier {
    unsigned* bar; unsigned x;
    volatile LAS unsigned* st;
};

__device__ __forceinline__ XcdBarrier xcd_barrier_post(unsigned* bar, volatile LAS unsigned* st) {
    XcdBarrier b; b.bar = bar; b.x = xb_xcc_id(); b.st = st;
    if (threadIdx.x == 0) (void)xb_add(&bar[XB_XCNT(b.x)], 1u);
    return b;
}
__device__ __forceinline__ void xcd_barrier_complete(unsigned* bar, unsigned x, unsigned& nloc, unsigned& nx) {
    const unsigned G = gridDim.x * gridDim.y * gridDim.z;
    unsigned sum, cnt, mine, sp = 0u;
    for (;;) {
        sum = 0u; cnt = 0u; mine = 0u;
#pragma unroll
        for (unsigned j = 0; j < 16; ++j) { const unsigned c = xb_ld(&bar[XB_XCNT(j)]); sum += c; cnt += (c > 0u) ? 1u : 0u; mine = (j == x) ? c : mine; }
        if (sum == G) break;
        __builtin_amdgcn_s_sleep(1);
        if ((++sp & 255u) == 0u) { if (xb_ld(&bar[XB_TMO])) break; if (sp > XB_SPIN_CAP) { atomicAdd(&bar[XB_TMO], 1u); break; } }
    }
    nloc = mine > 0u ? mine : 1u; nx = cnt > 0u ? cnt : 1u;
}

__device__ __forceinline__ void xcd_barrier(const XcdBarrier& b) {
    asm volatile("s_waitcnt vmcnt(0)" ::: "memory");
    __syncthreads();
    if (threadIdx.x == 0) {
        unsigned* bar = b.bar;
        __builtin_amdgcn_s_waitcnt(0);
        unsigned nloc = b.st[0], nx = b.st[1];
        if (nloc == 0u) { xcd_barrier_complete(bar, b.x, nloc, nx); b.st[0] = nloc; b.st[1] = nx; }
        const unsigned old = xb_add(&bar[XB_XSUB(b.x)], 1u);
        const unsigned gen = old / nloc;
        if (old + 1u == (gen + 1u) * nloc) {
            __builtin_amdgcn_fence(__ATOMIC_RELEASE, "agent");
            asm volatile("s_waitcnt vmcnt(0)" ::: "memory");
            const unsigned og = xb_add(&bar[XB_TOP], 1u);
            const unsigned tg = og / nx;
            if (og + 1u == (tg + 1u) * nx) xb_add(&bar[XB_TOPGEN], 1u);
            else XB_SPIN(xb_ld(&bar[XB_TOPGEN]) == tg, bar);
            __builtin_amdgcn_fence(__ATOMIC_ACQUIRE, "agent");
            xb_add(&bar[XB_XGEN(b.x)], 1u);
            asm volatile("s_waitcnt vmcnt(0)" ::: "memory");
        } else {
            XB_SPIN(xb_ld(&bar[XB_XGEN(b.x)]) == gen, bar);
            __builtin_amdgcn_fence(__ATOMIC_ACQUIRE, "agent");
            asm volatile("s_waitcnt vmcnt(0)" ::: "memory");
        }
    }
    __syncthreads();
}

__device__ __forceinline__ int fresh_tid(int wave0) { int l; asm volatile("v_mbcnt_lo_u32_b32 %0, -1, 0\n\tv_mbcnt_hi_u32_b32 %0, -1, %0" : "=v"(l)); return wave0 * 64 + l; }
#define PHASE_IDS int G = gridDim.x, bx = blockIdx.x; asm volatile("" : "+s"(G), "+s"(bx)); const int tid = fresh_tid(wave0), lane = tid & 63, wave = wave0; const int gw = bx * 8 + wave, NGW = G * 8; \
    const size_t gt = (size_t)bx * 512 + tid, NGT = (size_t)G * 512; (void)lane; (void)gw; (void)gt; (void)NGW; (void)NGT; (void)wave;

template <int MODE> __device__ __forceinline__ void transpose_item(const float* __restrict__ W, int K, int ldw, int ndst, bf16* __restrict__ WT, LAS float* scr, int item, int lane, unsigned char* __restrict__ W8 = nullptr) {
    const int nblk = ndst / 32, kb = item / nblk, nb = item % nblk, k0 = 64 * kb, n0 = 32 * nb;
    const int n_l = n0 + (lane & 31); const int sc = MODE ? src_col(n_l) : n_l;
    float tv[32];
#pragma unroll
    for (int i = 0; i < 32; ++i) { const int kk = 2 * i + (lane >> 5); tv[i] = sc >= 0 ? W[(size_t)(k0 + kk) * ldw + sc] : 0.f; }
#pragma unroll
    for (int i = 0; i < 32; ++i) { const int kk = 2 * i + (lane >> 5); scr[kk * 33 + (lane & 31)] = tv[i]; }
    asm volatile("s_waitcnt lgkmcnt(0)" ::: "memory");
    const int c = lane & 7;
#pragma unroll
    for (int j = 0; j < 4; ++j) { const int n = (lane >> 3) + 8 * j; const LAS float* s = scr + (8 * c) * 33 + n;
        if (MODE == 2 || (MODE == 1 && n0 < C_SMALL))
            *(uint2*)(W8 + (size_t)(n0 + n) * K + k0 + 8 * c) = make_uint2(pk4_fp8(s[0 * 33] * WG8_SCALE, s[1 * 33] * WG8_SCALE, s[2 * 33] * WG8_SCALE, s[3 * 33] * WG8_SCALE), pk4_fp8(s[4 * 33] * WG8_SCALE, s[5 * 33] * WG8_SCALE, s[6 * 33] * WG8_SCALE, s[7 * 33] * WG8_SCALE));
        if (MODE == 2 || (MODE == 1 && n0 < C_SMALL && !(n0 >= C_AV && n0 < C_AV + 256))) continue;
        uint4 o; o.x = pk2(s[0 * 33], s[1 * 33]); o.y = pk2(s[2 * 33], s[3 * 33]); o.z = pk2(s[4 * 33], s[5 * 33]); o.w = pk2(s[6 * 33], s[7 * 33]);
        *(uint4*)(WT + (size_t)(n0 + n) * K + k0 + 8 * c) = o; }
    asm volatile("s_waitcnt lgkmcnt(0)" ::: "memory");
}

__device__ __forceinline__ void mlstm_post_tok(int t, int lane, const bf16* __restrict__ hm, const bf16* __restrict__ proj, const LAS float* norm_w  , unsigned char* __restrict__ ym  ) {
    float4 x[4], nw[4]; uint2 ov[4];
#pragma unroll
    for (int h = 0; h < 4; ++h) { const int c = h * 256 + lane * 4; { const uint2 xr = *(const uint2*)(hm + (size_t)t * 1024 + c); x[h] = make_float4(__uint_as_float(xr.x << 16), __uint_as_float(xr.x & 0xffff0000u), __uint_as_float(xr.y << 16), __uint_as_float(xr.y & 0xffff0000u)); } { const f32x4e_t q_ = *(const LAS f32x4e_t*)(norm_w + c); nw[h] = make_float4(q_[0], q_[1], q_[2], q_[3]); } ov[h] = *(const uint2*)(proj + (size_t)t * NP + C_MO + c); }
#pragma unroll
    for (int h = 0; h < 4; ++h) {
        const float mu = wave_sum((x[h].x + x[h].y) + (x[h].z + x[h].w)) * (1.0f / 256.0f);
        const float d0 = x[h].x - mu, d1 = x[h].y - mu, d2 = x[h].z - mu, d3 = x[h].w - mu;
        const float rs = rsqrtf(wave_sum((d0 * d0 + d1 * d1) + (d2 * d2 + d3 * d3)) * (1.0f / 256.0f) + 1e-6f);
        const float y0 = d0 * rs * nw[h].x * sigm(__uint_as_float(ov[h].x << 16)), y1 = d1 * rs * nw[h].y * sigm(__uint_as_float(ov[h].x & 0xffff0000u));
        const float y2 = d2 * rs * nw[h].z * sigm(__uint_as_float(ov[h].y << 16)), y3 = d3 * rs * nw[h].w * sigm(__uint_as_float(ov[h].y & 0xffff0000u));
        *(unsigned*)(ym + (size_t)t * 1024 + h * 256 + lane * 4) = pk4_fp8(y0 * ACT8_SCALE, y1 * ACT8_SCALE, y2 * ACT8_SCALE, y3 * ACT8_SCALE);
    }
}

__device__ __forceinline__ void ssd_conv_item(int item, const bf16* __restrict__ proj, const LAS float* cw  , const LAS float* cb  , bf16* __restrict__ xcb) {
    const int c8 = item % 192, tb = item / 192, t0 = tb * 8, pos0 = t0 % SEQ, c = c8 * 8;
    uint4 r[11];
#pragma unroll
    for (int j = 0; j < 11; ++j) { r[j] = make_uint4(0u, 0u, 0u, 0u); if (j >= 3 || pos0 > 0) r[j] = *(const uint4*)(proj + (size_t)(t0 - 3 + j) * NP + C_SXBC + c); }
    float w[4][8], bs[8];
#pragma unroll
    for (int j = 0; j < 4; ++j) { const f32x4e_t a = *(const LAS f32x4e_t*)(cw + j * 1536 + c), b = *(const LAS f32x4e_t*)(cw + j * 1536 + c + 4); w[j][0] = a.x; w[j][1] = a.y; w[j][2] = a.z; w[j][3] = a.w; w[j][4] = b.x; w[j][5] = b.y; w[j][6] = b.z; w[j][7] = b.w; }
    { const f32x4e_t a = *(const LAS f32x4e_t*)(cb + c), b = *(const LAS f32x4e_t*)(cb + c + 4); bs[0] = a.x; bs[1] = a.y; bs[2] = a.z; bs[3] = a.w; bs[4] = b.x; bs[5] = b.y; bs[6] = b.z; bs[7] = b.w; }
#pragma unroll
    for (int o = 0; o < 8; ++o) {
        float acc[8];
#pragma unroll
        for (int i = 0; i < 8; ++i) acc[i] = bs[i];
#pragma unroll
        for (int j = 0; j < 4; ++j) { const unsigned rw[4] = {r[o + j].x, r[o + j].y, r[o + j].z, r[o + j].w};
#pragma unroll
            for (int i = 0; i < 4; ++i) { acc[2 * i] += w[j][2 * i] * __uint_as_float(rw[i] << 16); acc[2 * i + 1] += w[j][2 * i + 1] * __uint_as_float(rw[i] & 0xffff0000u); } }
        uint4 ov; ov.x = pk2(acc[0] * sigm(acc[0]), acc[1] * sigm(acc[1])); ov.y = pk2(acc[2] * sigm(acc[2]), acc[3] * sigm(acc[3])); ov.z = pk2(acc[4] * sigm(acc[4]), acc[5] * sigm(acc[5])); ov.w = pk2(acc[6] * sigm(acc[6]), acc[7] * sigm(acc[7]));
        *(uint4*)(xcb + (size_t)(t0 + o) * 1536 + c) = ov;
    }
}
__device__ __forceinline__ void ssd_post_tok2(int tp, int lane, const bf16* __restrict__ yraw, const bf16* __restrict__ proj, const LAS float* norm_w  , unsigned char* __restrict__ ys  ) {
    uint4 yr[4]; uint4 zv[4];
#pragma unroll
    for (int i = 0; i < 4; ++i) { const int t = 2 * tp + (i >> 1), c = (i & 1) * 512 + lane * 8; yr[i] = *(const uint4*)(yraw + (size_t)t * 1024 + c); zv[i] = *(const uint4*)(proj + (size_t)t * NP + C_SZ + c); }
#pragma unroll
    for (int i = 0; i < 4; ++i) { const int t = 2 * tp + (i >> 1), c = (i & 1) * 512 + lane * 8;
        const float yv[8] = {__uint_as_float(yr[i].x << 16), __uint_as_float(yr[i].x & 0xffff0000u), __uint_as_float(yr[i].y << 16), __uint_as_float(yr[i].y & 0xffff0000u), __uint_as_float(yr[i].z << 16), __uint_as_float(yr[i].z & 0xffff0000u), __uint_as_float(yr[i].w << 16), __uint_as_float(yr[i].w & 0xffff0000u)}; const unsigned zw[4] = {zv[i].x, zv[i].y, zv[i].z, zv[i].w};
        float y[8], ss = 0.f;
#pragma unroll
        for (int k = 0; k < 4; ++k) { const float z0 = __uint_as_float(zw[k] << 16), z1 = __uint_as_float(zw[k] & 0xffff0000u); y[2 * k] = yv[2 * k] * (z0 * sigm(z0)); y[2 * k + 1] = yv[2 * k + 1] * (z1 * sigm(z1)); ss += y[2 * k] * y[2 * k] + y[2 * k + 1] * y[2 * k + 1]; }
        const float rs = rsqrtf(wave_sum(ss) * (1.0f / 512.0f) + 1e-6f);
        const f32x4e_t n0q = *(const LAS f32x4e_t*)(norm_w + c), n1q = *(const LAS f32x4e_t*)(norm_w + c + 4); const float4 n0 = make_float4(n0q[0], n0q[1], n0q[2], n0q[3]), n1 = make_float4(n1q[0], n1q[1], n1q[2], n1q[3]);
        { const float r4 = rs * ACT8_SCALE; *(uint2*)(ys + (size_t)t * 1024 + c) = make_uint2(pk4_fp8(y[0] * r4 * n0.x, y[1] * r4 * n0.y, y[2] * r4 * n0.z, y[3] * r4 * n0.w), pk4_fp8(y[4] * r4 * n1.x, y[5] * r4 * n1.y, y[6] * r4 * n1.z, y[7] * r4 * n1.w)); }
    }
}

__device__ __forceinline__ void ln_body2(int tp, int lane, const float* in, const float* __restrict__ g, const float* __restrict__ bta, float* outf, bf16* __restrict__ outb) {
    float4 v[2][8];
#pragma unroll
    for (int r = 0; r < 2; ++r)
#pragma unroll
        for (int j = 0; j < 8; ++j) v[r][j] = *(const float4*)(in + (size_t)(2 * tp + r) * DM + j * 256 + lane * 4);
    { int z_ = 0; asm volatile("" : "+s"(z_)); g += z_; bta += z_; }
#pragma unroll
    for (int r = 0; r < 2; ++r) {
        const int t = 2 * tp + r; float s = 0.f;
#pragma unroll
        for (int j = 0; j < 8; ++j) s += (v[r][j].x + v[r][j].y) + (v[r][j].z + v[r][j].w);
        const float mu = wave_sum(s) * (1.0f / DM); float q = 0.f;
#pragma unroll
        for (int j = 0; j < 8; ++j) { v[r][j].x -= mu; v[r][j].y -= mu; v[r][j].z -= mu; v[r][j].w -= mu; q += (v[r][j].x * v[r][j].x + v[r][j].y * v[r][j].y) + (v[r][j].z * v[r][j].z + v[r][j].w * v[r][j].w); }
        const float rs = rsqrtf(wave_sum(q) * (1.0f / DM) + 1e-5f);
#pragma unroll
        for (int j = 0; j < 8; ++j) { const int c = j * 256 + lane * 4; const float4 gg = *(const float4*)(g + c), bb = *(const float4*)(bta + c);
            float4 y; y.x = v[r][j].x * rs * gg.x + bb.x; y.y = v[r][j].y * rs * gg.y + bb.y; y.z = v[r][j].z * rs * gg.z + bb.z; y.w = v[r][j].w * rs * gg.w + bb.w;
            *(float4*)(outf + (size_t)t * DM + c) = y; *(uint2*)(outb + (size_t)t * DM + c) = make_uint2(pk2(y.x, y.y), pk2(y.z, y.w)); }
    }
}

__device__ __forceinline__ void ln_body2b(int tp, int lane, bf16* xb, const LAS float* g  , const LAS float* bta  ) {
    uint4 v[2][4];
#pragma unroll
    for (int r = 0; r < 2; ++r)
#pragma unroll
        for (int j = 0; j < 4; ++j) v[r][j] = *(const uint4*)(xb + (size_t)(2 * tp + r) * DM + j * 512 + lane * 8);
#pragma unroll
    for (int r = 0; r < 2; ++r) {
        const int t = 2 * tp + r; float f[32]; float s = 0.f;
#pragma unroll
        for (int j = 0; j < 4; ++j) { const unsigned w4[4] = {v[r][j].x, v[r][j].y, v[r][j].z, v[r][j].w};
#pragma unroll
            for (int k = 0; k < 4; ++k) { f[8 * j + 2 * k] = __uint_as_float(w4[k] << 16); f[8 * j + 2 * k + 1] = __uint_as_float(w4[k] & 0xffff0000u); } }
#pragma unroll
        for (int i = 0; i < 32; i += 4) s += (f[i] + f[i + 1]) + (f[i + 2] + f[i + 3]);
        const float mu = wave_sum(s) * (1.0f / DM); float q = 0.f;
#pragma unroll
        for (int i = 0; i < 32; ++i) { f[i] -= mu; q += f[i] * f[i]; }
        const float rs = rsqrtf(wave_sum(q) * (1.0f / DM) + 1e-5f);
#pragma unroll
        for (int j = 0; j < 4; ++j) { const int c = j * 512 + lane * 8; const f32x4e_t g0 = *(const LAS f32x4e_t*)(g + c), g1 = *(const LAS f32x4e_t*)(g + c + 4), b0 = *(const LAS f32x4e_t*)(bta + c), b1 = *(const LAS f32x4e_t*)(bta + c + 4);
            *(uint4*)(xb + (size_t)t * DM + c) = make_uint4(pk2(f[8 * j] * rs * g0.x + b0.x, f[8 * j + 1] * rs * g0.y + b0.y), pk2(f[8 * j + 2] * rs * g0.z + b0.z, f[8 * j + 3] * rs * g0.w + b0.w),
                                                            pk2(f[8 * j + 4] * rs * g1.x + b1.x, f[8 * j + 5] * rs * g1.y + b1.y), pk2(f[8 * j + 6] * rs * g1.z + b1.z, f[8 * j + 7] * rs * g1.w + b1.w)); }
    }
}

__device__ __forceinline__ float gelu_erf(float v) {
    const float av = fabsf(v), t = __builtin_amdgcn_rcpf(av * 0.2316418882f + 1.0f);
    float q = t * 0.5307027145f + (-0.7265760135f); q = q * t + 0.7107068705f; q = q * t + (-0.142248368f); q = q * t + 0.127414796f; q = q * t;
    const float e = __builtin_amdgcn_exp2f((v * v) * (-0.72134752044f));
    const float mm = v * (q * e), r = v - mm;
    return v < 0.f ? mm : r;
}
typedef unsigned u32x4e_t __attribute__((ext_vector_type(4)));
typedef float f32x4e_t __attribute__((ext_vector_type(4)));
typedef unsigned u32x2e_t __attribute__((ext_vector_type(2)));
constexpr float U6_SCALE = 80.0f, V4_SCALE = 16.0f;
constexpr int ROW4 = DM / 2;
constexpr int ROW6 = DM * 6 / 8;
typedef float v32f_t __attribute__((ext_vector_type(32)));
typedef float f32x2_t __attribute__((ext_vector_type(2)));
typedef __bf16 v32b_t __attribute__((ext_vector_type(32)));
typedef unsigned v6u_t __attribute__((ext_vector_type(6)));
typedef __bf16 v2b_t __attribute__((ext_vector_type(2)));
__device__ __forceinline__ void tab_to_fp6(size_t i, const float* __restrict__ src, unsigned char* __restrict__ dst, float sc) {
    const float4* s = (const float4*)src + i * 8; v32b_t b;
#pragma unroll
    for (int j = 0; j < 8; ++j) { const float4 v = s[j]; b[4 * j] = (__bf16)(v.x * sc); b[4 * j + 1] = (__bf16)(v.y * sc); b[4 * j + 2] = (__bf16)(v.z * sc); b[4 * j + 3] = (__bf16)(v.w * sc); }
    const v6u_t p = __builtin_amdgcn_cvt_scalef32_pk32_fp6_bf16(b, 1.0f);
    uint2* d = (uint2*)(dst + i * 24); d[0] = make_uint2(p[0], p[1]); d[1] = make_uint2(p[2], p[3]); d[2] = make_uint2(p[4], p[5]);
}
__device__ __forceinline__ void tab_to_fp4(size_t i, const float* __restrict__ src, unsigned char* __restrict__ dst, float sc) {
    const float4* s = (const float4*)src + i * 8; unsigned w[4];
#pragma unroll
    for (int j = 0; j < 4; ++j) { const float4 a = s[2 * j], b = s[2 * j + 1]; unsigned x = 0u;
        x = __builtin_amdgcn_cvt_scalef32_pk_fp4_f32(x, a.x * sc, a.y * sc, 1.0f, 0); x = __builtin_amdgcn_cvt_scalef32_pk_fp4_f32(x, a.z * sc, a.w * sc, 1.0f, 1);
        x = __builtin_amdgcn_cvt_scalef32_pk_fp4_f32(x, b.x * sc, b.y * sc, 1.0f, 2); x = __builtin_amdgcn_cvt_scalef32_pk_fp4_f32(x, b.z * sc, b.w * sc, 1.0f, 3); w[j] = x; }
    *(uint4*)(dst + i * 16) = make_uint4(w[0], w[1], w[2], w[3]);
}
__device__ __forceinline__ void tab_fp4_store(const float4 (&q)[4], unsigned char* __restrict__ dst8, float sc) {
    unsigned w[2];
#pragma unroll
    for (int j = 0; j < 2; ++j) { const float4 a = q[2 * j], b = q[2 * j + 1]; unsigned x = 0u;
        x = __builtin_amdgcn_cvt_scalef32_pk_fp4_f32(x, a.x * sc, a.y * sc, 1.0f, 0); x = __builtin_amdgcn_cvt_scalef32_pk_fp4_f32(x, a.z * sc, a.w * sc, 1.0f, 1);
        x = __builtin_amdgcn_cvt_scalef32_pk_fp4_f32(x, b.x * sc, b.y * sc, 1.0f, 2); x = __builtin_amdgcn_cvt_scalef32_pk_fp4_f32(x, b.z * sc, b.w * sc, 1.0f, 3); w[j] = x; }
    *(uint2*)dst8 = make_uint2(w[0], w[1]);
}
constexpr int TAB_PER_WG = (P_EXPERTS * (DM / 32)) / 128;
__device__ __forceinline__ void peer_expert_body(int t, int lane, bool last, const int* __restrict__ ids, const float* __restrict__ gates, const unsigned char* __restrict__ U6, const unsigned char* __restrict__ V6,
                                                 const LAS float* gl  , const LAS float* bl  , float* __restrict__ outf, bf16* outb  , unsigned char* __restrict__ outq  , LAS unsigned* wl  ) {
    asm volatile("" : "+v"(lane));
    int idA = ids[(size_t)t * 128 + lane], idB = ids[(size_t)t * 128 + 64 + lane]; float gA = gates[(size_t)t * 128 + lane], gB = gates[(size_t)t * 128 + 64 + lane];
    {
        const unsigned kA = ((unsigned)idA << 7) | (unsigned)lane, kB = ((unsigned)idB << 7) | (unsigned)(64 + lane);
        wl[lane] = kA; wl[64 + lane] = kB;
        asm volatile("s_waitcnt lgkmcnt(0)" ::: "memory");
        int rA = 0, rB = 0;
#pragma unroll 8
        for (int j = 0; j < 128; j += 4) { const u32x4e_t k4 = *(const LAS u32x4e_t*)(wl + j);
#pragma unroll
            for (int q = 0; q < 4; ++q) { rA += (k4[q] < kA) ? 1 : 0; rB += (k4[q] < kB) ? 1 : 0; } }
        asm volatile("s_waitcnt lgkmcnt(0)" ::: "memory");
        wl[128 + rA] = (unsigned)idA; wl[256 + rA] = __float_as_uint(gA); wl[128 + rB] = (unsigned)idB; wl[256 + rB] = __float_as_uint(gB);
        asm volatile("s_waitcnt lgkmcnt(0)" ::: "memory");
        idA = (int)wl[128 + lane]; idB = (int)wl[192 + lane]; gA = __uint_as_float(wl[256 + lane]); gB = __uint_as_float(wl[320 + lane]);
        asm volatile("s_waitcnt lgkmcnt(0)" ::: "memory");
    }
#define ID_OF(e_) __builtin_amdgcn_readlane((e_) < 64 ? idA : idB, (e_) & 63)
#define GATE_OF(e_) __builtin_bit_cast(float, __builtin_amdgcn_readlane(__builtin_bit_cast(int, (e_) < 64 ? gA : gB), (e_) & 63))
    uint4 ra[8], rb[8];
#define ROW_LOAD(R_, T_, e_) do { _Pragma("unroll") for (int k_ = 0; k_ < 8; ++k_) { const int id_ = ID_OF((e_) + k_); R_[k_] = *((const uint4*)((T_) + (size_t)id_ * ROW4) + lane); } } while (0)
#define V4_PAIR(D_, W_, j_, b_) do { const f32x2_t t_ = __builtin_amdgcn_cvt_scalef32_pk_f32_fp4(W_, 1.0f, b_); D_[8 * (j_) + 2 * (b_)] = t_.x; D_[8 * (j_) + 2 * (b_) + 1] = t_.y; } while (0)
#define V4_DWORD(D_, W_, j_) do { V4_PAIR(D_, W_, j_, 0); V4_PAIR(D_, W_, j_, 1); V4_PAIR(D_, W_, j_, 2); V4_PAIR(D_, W_, j_, 3); } while (0)
#define UDOT4(W_, j_) do { a_ = __builtin_amdgcn_fdot2_f32_bf16(__builtin_amdgcn_cvt_scalef32_pk_bf16_fp4(W_, 1.0f, 0), __builtin_bit_cast(v2b_t, xb[4 * (j_)]), a_, false); \
        b_ = __builtin_amdgcn_fdot2_f32_bf16(__builtin_amdgcn_cvt_scalef32_pk_bf16_fp4(W_, 1.0f, 1), __builtin_bit_cast(v2b_t, xb[4 * (j_) + 1]), b_, false); \
        a_ = __builtin_amdgcn_fdot2_f32_bf16(__builtin_amdgcn_cvt_scalef32_pk_bf16_fp4(W_, 1.0f, 2), __builtin_bit_cast(v2b_t, xb[4 * (j_) + 2]), a_, false); \
        b_ = __builtin_amdgcn_fdot2_f32_bf16(__builtin_amdgcn_cvt_scalef32_pk_bf16_fp4(W_, 1.0f, 3), __builtin_bit_cast(v2b_t, xb[4 * (j_) + 3]), b_, false); } while (0)
#define DEC4(D_, R_) do { V4_DWORD(D_, R_.x, 0); V4_DWORD(D_, R_.y, 1); V4_DWORD(D_, R_.z, 2); V4_DWORD(D_, R_.w, 3); } while (0)
#define PK6(W_) ((v6u_t){W_[0].x, W_[0].y, W_[1].x, W_[1].y, W_[2].x, W_[2].y})
#define SB_ __builtin_amdgcn_sched_barrier(0)
    float c0 = 0.f, c1 = 0.f;
    unsigned xb[16];
    {
#pragma unroll
        for (int i = 0; i < 4; ++i) { const uint4 v = *(const uint4*)(outb + (size_t)t * DM + lane * 32 + i * 8); xb[4 * i] = v.x; xb[4 * i + 1] = v.y; xb[4 * i + 2] = v.z; xb[4 * i + 3] = v.w; }
#define U_COMP(R_, e_) do { float p_[8]; _Pragma("unroll") for (int k_ = 0; k_ < 8; ++k_) { SB_; float a_ = 0.f, b_ = 0.f; UDOT4(R_[k_].x, 0); UDOT4(R_[k_].y, 1); UDOT4(R_[k_].z, 2); UDOT4(R_[k_].w, 3); p_[k_] = a_ + b_; } SB_; \
        { const bool o1_ = lane & 1, o2_ = lane & 2, o4_ = lane & 4; float w_[4], u_[2]; \
          _Pragma("unroll") for (int j_ = 0; j_ < 4; ++j_) { const float keep_ = o1_ ? p_[2 * j_ + 1] : p_[2 * j_], send_ = o1_ ? p_[2 * j_] : p_[2 * j_ + 1]; w_[j_] = keep_ + dpp_f<0xB1>(send_); } \
          _Pragma("unroll") for (int j_ = 0; j_ < 2; ++j_) { const float keep_ = o2_ ? w_[2 * j_ + 1] : w_[2 * j_], send_ = o2_ ? w_[2 * j_] : w_[2 * j_ + 1]; u_[j_] = keep_ + dpp_f<0x4E>(send_); } \
          float s_; { const float keep_ = o4_ ? u_[1] : u_[0], send_ = o4_ ? u_[0] : u_[1]; s_ = keep_ + __builtin_bit_cast(float, __builtin_amdgcn_ds_swizzle(__builtin_bit_cast(int, send_), 0x101F)); } \
          s_ += __builtin_bit_cast(float, __builtin_amdgcn_ds_swizzle(__builtin_bit_cast(int, s_), 0x201F)); s_ += __builtin_bit_cast(float, __builtin_amdgcn_ds_swizzle(__builtin_bit_cast(int, s_), 0x401F)); \
          { float lo_ = s_, hi_ = s_; halves32(lo_, hi_); s_ = lo_ + hi_; } \
          s_ *= (1.0f / U6_SCALE); const float ge_ = gelu_erf(s_) * (1.0f / V4_SCALE); \
          const bool in_ = ((lane ^ (e_)) & 56) == 0;              \
          if ((e_) < 64) c0 = in_ ? gA * ge_ : c0; else c1 = in_ ? gB * ge_ : c1; } } while (0)
        ROW_LOAD(ra, U6, 0);
#pragma nounroll
        for (int e = 0; e < 128; e += 16) {
            ROW_LOAD(rb, U6, e + 8);
            U_COMP(ra, e);
            if (e + 16 < 128) ROW_LOAD(ra, U6, e + 16);
            U_COMP(rb, e + 8);
        }
#undef U_COMP
    }
    v32f_t acc;
#pragma unroll
    for (int i = 0; i < 32; ++i) acc[i] = 0.f;
#define V_COMP(R_, e_) do { _Pragma("unroll") for (int k_ = 0; k_ < 8; ++k_) { SB_; const int ee_ = (e_) + k_; \
            const float cv_ = __builtin_bit_cast(float, __builtin_amdgcn_readlane(__builtin_bit_cast(int, ee_ < 64 ? c0 : c1), ee_ & 63)); \
            v32f_t d_; DEC4(d_, R_[k_]); acc += d_ * cv_; } SB_; } while (0)
    ROW_LOAD(ra, V6, 0);
#pragma nounroll
    for (int e = 0; e < 128; e += 16) {
        ROW_LOAD(rb, V6, e + 8);
        V_COMP(ra, e);
        if (e + 16 < 128) ROW_LOAD(ra, V6, e + 16);
        V_COMP(rb, e + 8);
    }
#undef V_COMP
#undef ID_OF
#undef GATE_OF
#undef ROW_LOAD
#undef PK6
#undef V4_PAIR
#undef V4_DWORD
#undef DEC4
#undef UDOT4
#undef SB_
    float s = 0.f;
#pragma unroll
    for (int i = 0; i < 16; ++i) { acc[2 * i] += ALPHA * __uint_as_float(xb[i] << 16); acc[2 * i + 1] += ALPHA * __uint_as_float(xb[i] & 0xffff0000u); }
#pragma unroll
    for (int i = 0; i < 32; ++i) s += acc[i];
    const float mu = wave_sum(s) * (1.0f / DM); float q = 0.f;
#pragma unroll
    for (int i = 0; i < 32; ++i) { acc[i] -= mu; q += acc[i] * acc[i]; }
    const float rs = rsqrtf(wave_sum(q) * (1.0f / DM) + 1e-5f);
#pragma unroll
    for (int i = 0; i < 8; i += 2) { const int c = lane * 32 + i * 4; float y[8];
#pragma unroll
        for (int h = 0; h < 2; ++h) { const f32x4e_t gq = *(const LAS f32x4e_t*)(gl + ((i + h) * 64 + lane) * 4), bq = *(const LAS f32x4e_t*)(bl + ((i + h) * 64 + lane) * 4);
#pragma unroll
            for (int k = 0; k < 4; ++k) y[4 * h + k] = acc[4 * (i + h) + k] * rs * gq[k] + bq[k]; }
        if (last) { *(float4*)(outf + (size_t)t * DM + c) = make_float4(y[0], y[1], y[2], y[3]); *(float4*)(outf + (size_t)t * DM + c + 4) = make_float4(y[4], y[5], y[6], y[7]); }
        else { *(uint4*)(outb + (size_t)t * DM + c) = make_uint4(pk2(y[0], y[1]), pk2(y[2], y[3]), pk2(y[4], y[5]), pk2(y[6], y[7])); *(uint2*)(outq + (size_t)t * DM + c) = make_uint2(pk4_fp8(y[0], y[1], y[2], y[3]), pk4_fp8(y[4], y[5], y[6], y[7])); } }
}

typedef short bf16x8_t __attribute__((ext_vector_type(8)));
typedef float f32x4_t __attribute__((ext_vector_type(4)));
typedef unsigned u32x2_t __attribute__((ext_vector_type(2)));
typedef unsigned u32x4_t __attribute__((ext_vector_type(4)));
constexpr int SWA_PITCH = 144;
constexpr int SWA_KS = 0, SWA_VS = 256 * SWA_PITCH, SWA_LDS = 2 * 256 * SWA_PITCH;
static_assert(SWA_LDS <= RING_BYTES, "SWA LDS");
__device__ __forceinline__ float grp4_max(float v) {
    v = fmaxf(v, __builtin_bit_cast(float, __builtin_amdgcn_ds_swizzle(__builtin_bit_cast(int, v), 0x401F)));
    float lo = v, hi = v; halves32(lo, hi);
    return fmaxf(lo, hi);
}
__device__ __forceinline__ float grp4_sum(float v) {
    v += __builtin_bit_cast(float, __builtin_amdgcn_ds_swizzle(__builtin_bit_cast(int, v), 0x401F));
    float lo = v, hi = v; halves32(lo, hi);
    return lo + hi;
}
__device__ __forceinline__ void tr_read2(unsigned a0, unsigned a1, u32x2_t& r0, u32x2_t& r1) {
    asm volatile("ds_read_b64_tr_b16 %0, %2\n\tds_read_b64_tr_b16 %1, %3\n\ts_waitcnt lgkmcnt(0)" : "=&v"(r0), "=&v"(r1) : "v"(a0), "v"(a1) : "memory");
}
__device__ __forceinline__ void rope8(uint4& lo, uint4& hi, const float4* cs, float scale) {
    unsigned* a = (unsigned*)&lo; unsigned* b = (unsigned*)&hi;
#pragma unroll
    for (int j = 0; j < 4; ++j) {
        const float x1a = __uint_as_float(a[j] << 16), x1b = __uint_as_float(a[j] & 0xffff0000u), x2a = __uint_as_float(b[j] << 16), x2b = __uint_as_float(b[j] & 0xffff0000u);
        const float4 c = cs[j];
        const float y1a = (x1a * c.x - x2a * c.y) * scale, y2a = (x2a * c.x + x1a * c.y) * scale, y1b = (x1b * c.z - x2b * c.w) * scale, y2b = (x2b * c.z + x1b * c.w) * scale;
        a[j] = pk2(y1a, y1b); b[j] = pk2(y2a, y2b);
    }
}
__device__ __forceinline__ void swa_phase(LAS unsigned char* lds, const bf16* __restrict__ proj, const float* __restrict__ rtab  , const float* __restrict__ sinks, unsigned char* __restrict__ ya  ,
                                          int tid, int bx, int G) {
    const int lane = tid & 63, w = __builtin_amdgcn_readfirstlane(tid >> 6), l15 = lane & 15, g4 = lane >> 4;
    const unsigned ldsb = (unsigned)(size_t)lds;
    constexpr int NSWA = NBATCH * 32 * 4, NSWA_LO = NSWA * 4 / 8;
    const int hb = G >> 1; int u0 = bx, u1 = NSWA, ust = G;
    if (hb > 0) { if (bx < hb) { u1 = NSWA_LO; ust = hb; } else { u0 = NSWA_LO + bx - hb; ust = G - hb; } }
    uint4 klo[2], khi[2], vv[4]; float4 kcs[2][4];
#define SWA_LOAD(u_) do { const int kvh_ = (u_) & 3, nb_ = ((u_) >> 2) & 31, b_ = (u_) >> 7, t0_ = b_ * SEQ + nb_ * 128; \
        _Pragma("unroll") for (int i_ = 0; i_ < 2; ++i_) { const int it_ = tid + 512 * i_, kk_ = it_ >> 2, c_ = it_ & 3; klo[i_] = make_uint4(0u, 0u, 0u, 0u); khi[i_] = klo[i_]; \
            _Pragma("unroll") for (int j_ = 0; j_ < 4; ++j_) kcs[i_][j_] = make_float4(0.f, 0.f, 0.f, 0.f); \
            if (nb_ > 0 || kk_ >= 128) { const bf16* src_ = proj + (size_t)(t0_ - 128 + kk_) * NP + C_AK + kvh_ * 64 + 8 * c_; klo[i_] = *(const uint4*)src_; khi[i_] = *(const uint4*)(src_ + 32); \
                const float4* cs_ = (const float4*)(rtab + ((size_t)(nb_ * 128 - 128 + kk_) * 32 + 8 * c_) * 2); kcs[i_][0] = cs_[0]; kcs[i_][1] = cs_[1]; kcs[i_][2] = cs_[2]; kcs[i_][3] = cs_[3]; } } \
        _Pragma("unroll") for (int i_ = 0; i_ < 4; ++i_) { const int it_ = tid + 512 * i_, kk_ = it_ >> 3, c_ = it_ & 7; vv[i_] = make_uint4(0u, 0u, 0u, 0u); \
            if (nb_ > 0 || kk_ >= 128) vv[i_] = *(const uint4*)(proj + (size_t)(t0_ - 128 + kk_) * NP + C_AV + kvh_ * 64 + 8 * c_); } } while (0)
#define SWA_STORE() do { \
        _Pragma("unroll") for (int i_ = 0; i_ < 2; ++i_) { const int it_ = tid + 512 * i_, kk_ = it_ >> 2, c_ = it_ & 3; uint4 lo_ = klo[i_], hi_ = khi[i_]; rope8(lo_, hi_, kcs[i_], 1.0f);     \
            *(LAS u32x4_t*)(lds + SWA_KS + kk_ * SWA_PITCH + 16 * c_) = __builtin_bit_cast(u32x4_t, lo_); *(LAS u32x4_t*)(lds + SWA_KS + kk_ * SWA_PITCH + 64 + 16 * c_) = __builtin_bit_cast(u32x4_t, hi_); } \
        _Pragma("unroll") for (int i_ = 0; i_ < 4; ++i_) { const int it_ = tid + 512 * i_, kk_ = it_ >> 3, c_ = it_ & 7; *(LAS u32x4_t*)(lds + SWA_VS + kk_ * SWA_PITCH + 16 * c_) = __builtin_bit_cast(u32x4_t, vv[i_]); } } while (0)
    if (u0 < u1) SWA_LOAD(u0);
    for (int u = u0; u < u1; u += ust) {
        const int kvh = u & 3, nb = (u >> 2) & 31, b = u >> 7;
        const int t0 = b * SEQ + nb * 128;
        const int r = w >> 1, hf = w & 1, hq = kvh * 4 + r;
        uint4 nqlo, nqhi; float4 nqcs[4];
#define SWA_QLOAD(qt_) do { const int iq_ = 64 * hf + 16 * (qt_) + l15; const bf16* src_ = proj + (size_t)(t0 + iq_) * NP + C_AQ + hq * 64 + 8 * g4; nqlo = *(const uint4*)src_; nqhi = *(const uint4*)(src_ + 32); \
            const float4* cs_ = (const float4*)(rtab + ((size_t)(nb * 128 + iq_) * 32 + 8 * g4) * 2); nqcs[0] = cs_[0]; nqcs[1] = cs_[1]; nqcs[2] = cs_[2]; nqcs[3] = cs_[3]; } while (0)
        SWA_QLOAD(0);
        __syncthreads();
        SWA_STORE();
        if (u + ust < u1) SWA_LOAD(u + ust);
        __syncthreads();
        const float sink = sinks[hq];
#pragma nounroll
        for (int qt = 0; qt < 4; ++qt) {
            const int i0 = 64 * hf + 16 * qt, iq = i0 + l15, tq = t0 + iq, ktb0 = 4 * hf + qt;
            bf16x8_t q0, q1;
            { uint4 lo = nqlo, hi = nqhi; rope8(lo, hi, nqcs, 0.125f); q0 = __builtin_bit_cast(bf16x8_t, lo); q1 = __builtin_bit_cast(bf16x8_t, hi); }
            if (qt + 1 < 4) SWA_QLOAD(qt + 1);
            f32x4_t s[9]; float m = sink; const int d0 = 4 * g4 - l15;
#pragma unroll
            for (int n = 0; n < 9; ++n) {
                const LAS unsigned char* kp = lds + SWA_KS + (16 * (ktb0 + n) + l15) * SWA_PITCH + 16 * g4;
                const bf16x8_t a0 = *(const LAS bf16x8_t*)kp, a1 = *(const LAS bf16x8_t*)(kp + 64);
                f32x4_t acc = (f32x4_t){0.f, 0.f, 0.f, 0.f};
                acc = __builtin_amdgcn_mfma_f32_16x16x32_bf16(a0, q0, acc, 0, 0, 0);
                acc = __builtin_amdgcn_mfma_f32_16x16x32_bf16(a1, q1, acc, 0, 0, 0);
                const bool tv = (nb > 0) || (ktb0 + n >= 8);
#pragma unroll
                for (int e = 0; e < 4; ++e) { const bool ok = tv && (n == 0 ? (d0 + e >= 1) : n == 8 ? (d0 + e <= 0) : true);
                    acc[e] = ok ? acc[e] : -1e30f; m = fmaxf(m, acc[e]); }
                s[n] = acc;
            }
            m = grp4_max(m);
            float lsum = 0.f;
#pragma unroll
            for (int n = 0; n < 9; ++n)
#pragma unroll
                for (int e = 0; e < 4; ++e) { const float p = __expf(s[n][e] - m); s[n][e] = p; lsum += p; }
            lsum = grp4_sum(lsum) + __expf(sink - m);
            const float inv = __builtin_amdgcn_rcpf(lsum);
            bf16x8_t pf[5];
#pragma unroll
            for (int pi = 0; pi < 4; ++pi) { uint4 w4; w4.x = pk2(s[2 * pi][0], s[2 * pi][1]); w4.y = pk2(s[2 * pi][2], s[2 * pi][3]); w4.z = pk2(s[2 * pi + 1][0], s[2 * pi + 1][1]); w4.w = pk2(s[2 * pi + 1][2], s[2 * pi + 1][3]);
                pf[pi] = __builtin_bit_cast(bf16x8_t, w4); }
            { uint4 w4; w4.x = pk2(s[8][0], s[8][1]); w4.y = pk2(s[8][2], s[8][3]); w4.z = 0u; w4.w = 0u; pf[4] = __builtin_bit_cast(bf16x8_t, w4); }
            const int qq = l15 >> 2, pp = lane & 3;
#pragma unroll
            for (int dt = 0; dt < 4; ++dt) {
                f32x4_t o = (f32x4_t){0.f, 0.f, 0.f, 0.f};
#pragma unroll
                for (int pi = 0; pi < 5; ++pi) {
                    const int ka = (ktb0 + 2 * pi) < 15 ? (ktb0 + 2 * pi) : 15, kb = (ktb0 + 2 * pi + 1) < 15 ? (ktb0 + 2 * pi + 1) : 15;
                    u32x2_t v0, v1;
                    tr_read2(ldsb + SWA_VS + (16 * ka + 4 * g4 + qq) * SWA_PITCH + (16 * dt + 4 * pp) * 2, ldsb + SWA_VS + (16 * kb + 4 * g4 + qq) * SWA_PITCH + (16 * dt + 4 * pp) * 2, v0, v1);
                    const uint4 av = make_uint4(v0.x, v0.y, v1.x, v1.y);
                    o = __builtin_amdgcn_mfma_f32_16x16x32_bf16(__builtin_bit_cast(bf16x8_t, av), pf[pi], o, 0, 0, 0);
                }
                { const float i4 = inv * ACT8_SCALE; *(unsigned*)(ya + (size_t)tq * 1024 + hq * 64 + 16 * dt + 4 * g4) = pk4_fp8(o[0] * i4, o[1] * i4, o[2] * i4, o[3] * i4); }
            }
        }
    }
#undef SWA_LOAD
#undef SWA_STORE
#undef SWA_QLOAD
}

constexpr size_t WS_MG = WS_R1 + 128 * MiB, WS_MEG = WS_MG + 2 * MiB, WS_SG = WS_MG + 3 * MiB, WS_SEA = WS_SG + 8 * MiB;
__device__ __forceinline__ void mlstm_gate_item(int item, int lane, LAS float* wl, const float* __restrict__ small, const float* __restrict__ gate_b, float4* __restrict__ mg, float* __restrict__ meg) {
    const int ch = item & 63, h = (item >> 6) & 3, b = item >> 8; const size_t t = (size_t)b * SEQ + ch * 64 + lane;
    const float ip = small[t * 32 + h] + gate_b[h], fp = small[t * 32 + 4 + h] + gate_b[4 + h];
    wl[lane] = fminf(fp, 0.f) - log1pf(__expf(-fabsf(fp)));
    asm volatile("s_waitcnt lgkmcnt(0)" ::: "memory");
    float bs = 0.f;
#pragma unroll
    for (int j = 0; j < 64; j += 4) { const f32x4_t v4 = *(const LAS f32x4_t*)(wl + j);
        bs += (j + 0 <= lane) ? v4[0] : 0.f; bs += (j + 1 <= lane) ? v4[1] : 0.f; bs += (j + 2 <= lane) ? v4[2] : 0.f; bs += (j + 3 <= lane) ? v4[3] : 0.f; }
    const float gt = __builtin_bit_cast(float, __builtin_amdgcn_readlane(__builtin_bit_cast(int, bs), 63));
    mg[t * 4 + h] = make_float4(bs, ip - bs, __expf(bs), __expf(gt - bs + ip) * 0.08838834764831845f);
    if (lane == 0) meg[(b * 4 + h) * 64 + ch] = __expf(gt);
    asm volatile("s_waitcnt lgkmcnt(0)" ::: "memory");
}
__device__ __forceinline__ void ssd_gate_item(int item, int lane, LAS float* wl, const float* __restrict__ small, const float* __restrict__ dt_bias, const float* __restrict__ a_log, float4* __restrict__ sg, float* __restrict__ sea) {
    const int ch = item & 31, hh = (item >> 5) & 15, b = item >> 9; const size_t t0 = (size_t)b * SEQ + ch * 128;
    const float a = -__expf(a_log[hh]), dtb = dt_bias[hh];
    float dt[2];
#pragma unroll
    for (int r = 0; r < 2; ++r) { const float dtr = small[(t0 + lane + 64 * r) * 32 + 8 + hh] + dtb; dt[r] = dtr > 20.f ? dtr : log1pf(__expf(dtr)); wl[lane + 64 * r] = dt[r] * a; }
    asm volatile("s_waitcnt lgkmcnt(0)" ::: "memory");
    float a0 = 0.f, a1 = 0.f;
#pragma unroll 8
    for (int j = 0; j < 128; j += 4) { const f32x4_t v4 = *(const LAS f32x4_t*)(wl + j);
#pragma unroll
        for (int q = 0; q < 4; ++q) { a0 += (j + q <= lane) ? v4[q] : 0.f; a1 += (j + q <= lane + 64) ? v4[q] : 0.f; } }
    const float atot = __builtin_bit_cast(float, __builtin_amdgcn_readlane(__builtin_bit_cast(int, a1), 63));
    sg[(t0 + lane) * 16 + hh] = make_float4(dt[0], a0, __expf(a0), __expf(atot - a0) * dt[0]);
    sg[(t0 + lane + 64) * 16 + hh] = make_float4(dt[1], a1, __expf(a1), __expf(atot - a1) * dt[1]);
    if (lane == 0) sea[(b * 16 + hh) * 32 + ch] = __expf(atot);
    asm volatile("s_waitcnt lgkmcnt(0)" ::: "memory");
}

constexpr int ML_QP = 272, ML_VP = 176, ML_PP = 144;
constexpr int ML_UNITS = NBATCH * 4 * 4;
constexpr int ML_Q = 0, ML_K = 2 * 64 * ML_QP, ML_V = ML_K + 2 * 64 * ML_QP, ML_VW = ML_V + 2 * 64 * ML_VP, ML_P = ML_VW + 64 * ML_VP, ML_CT = ML_P + 64 * ML_PP,
              ML_VEC = ML_CT + 80 * ML_QP, ML_END = ML_VEC + 4096;
static_assert(ML_END <= PHASE_LDS_BYTES, "mLSTM LDS");
__device__ __forceinline__ void tr_read2q(unsigned a0, unsigned a1, u32x2_t& r0, u32x2_t& r1) {
    asm volatile("ds_read_b64_tr_b16 %0, %2\n\tds_read_b64_tr_b16 %1, %3\n\ts_waitcnt lgkmcnt(0)" : "=&v"(r0), "=&v"(r1) : "v"(a0), "v"(a1) : "memory");
}
__device__ __forceinline__ bf16x8_t mk_frag(u32x2_t lo, u32x2_t hi) { const u32x4_t v = (u32x4_t){lo.x, lo.y, hi.x, hi.y}; return __builtin_bit_cast(bf16x8_t, v); }
#define LBAR() do { asm volatile("s_waitcnt lgkmcnt(0)" ::: "memory"); __builtin_amdgcn_s_barrier(); asm volatile("" ::: "memory"); } while (0)
__device__ __forceinline__ void mlstm_phase(LAS unsigned char* lds, const bf16* __restrict__ proj, const float4* __restrict__ mg, const float* __restrict__ meg, bf16* __restrict__ hm, int tid, int bx, int G, const float* __restrict__ tsrc  , unsigned char* __restrict__ tdst) {
    const int lane0 = tid & 63, w = __builtin_amdgcn_readfirstlane(tid >> 6);
    const unsigned ldsb = (unsigned)(size_t)lds;
    LAS float* vec = (LAS float*)(lds + ML_VEC);
    for (int u0_ = bx; u0_ < ML_UNITS; u0_ += G) {
        const int u = (G == 256) ? (u0_ & 7) * 16 + (u0_ >> 3) : u0_;
        const int vs = u & 3, h = (u >> 2) & 3, b = u >> 4;
        LBAR();
        for (int i = tid; i < 2 * 64; i += 512) { LAS unsigned* p = (LAS unsigned*)(lds + ML_V + i * ML_VP + 128); unsigned zz = 0u; asm volatile("" : "+v"(zz));     p[0] = 0x00003F80u | zz;
#pragma unroll
            for (int j = 1; j < 8; ++j) p[j] = zz; }
        for (int i = tid; i < 80 * ML_QP / 4; i += 512) ((LAS unsigned*)(lds + ML_CT))[i] = 0u;
        f32x4_t cacc[5];
#pragma unroll
        for (int i = 0; i < 5; ++i) cacc[i] = (f32x4_t){0.f, 0.f, 0.f, 0.f};
        struct MLRegs { uint4 pq[2], pk[2], pv; float4 pg; float peg; } rs[2];
#pragma unroll
        for (int i = 0; i < 2; ++i) { rs[i].pv = make_uint4(0u, 0u, 0u, 0u); rs[i].pg = make_float4(0.f, 0.f, 0.f, 0.f); rs[i].peg = 0.f; }
#define ML_LOAD(R_, c_) do { const size_t tb_ = (size_t)b * SEQ + (size_t)(c_) * 64; \
            _Pragma("unroll") for (int i_ = 0; i_ < 2; ++i_) { const int p_ = tid + 512 * i_, row_ = p_ >> 4, c16_ = p_ & 15; const bf16* s_ = proj + (tb_ + row_) * NP + h * 128 + c16_ * 8; R_.pq[i_] = *(const uint4*)(s_ + C_MQ); R_.pk[i_] = *(const uint4*)(s_ + C_MK); } \
            R_.pv = *(const uint4*)(proj + (tb_ + (tid >> 3)) * NP + C_MV + h * 256 + vs * 64 + (tid & 7) * 8); \
            if (tid >= 256 && tid < 320) { R_.pg = mg[(tb_ + (tid - 256)) * 4 + h]; R_.peg = meg[(b * 4 + h) * 64 + (c_)]; } } while (0)
#define ML_STORE(R_, bi_) do { _Pragma("unroll") for (int i_ = 0; i_ < 2; ++i_) { const int p_ = tid + 512 * i_, row_ = p_ >> 4, c16_ = p_ & 15; \
                *(LAS u32x4_t*)(lds + ML_Q + (bi_) * 64 * ML_QP + row_ * ML_QP + c16_ * 16) = __builtin_bit_cast(u32x4_t, R_.pq[i_]); *(LAS u32x4_t*)(lds + ML_K + (bi_) * 64 * ML_QP + row_ * ML_QP + c16_ * 16) = __builtin_bit_cast(u32x4_t, R_.pk[i_]); } \
            *(LAS u32x4_t*)(lds + ML_V + (bi_) * 64 * ML_VP + (tid >> 3) * ML_VP + (tid & 7) * 16) = __builtin_bit_cast(u32x4_t, R_.pv); \
            if (tid >= 256 && tid < 320) { LAS float* v_ = vec + (bi_) * 320 + (tid - 256); v_[0] = R_.pg.x; v_[64] = R_.pg.y; v_[128] = R_.pg.z; v_[192] = R_.pg.w; if (tid == 256) vec[(bi_) * 320 + 256] = R_.peg; } } while (0)
        ML_LOAD(rs[0], 0); ML_STORE(rs[0], 0); ML_LOAD(rs[1], 1);
        LBAR();
#pragma nounroll
        for (int c2 = 0; c2 < 64; c2 += 2) {
          int lane = lane0; asm volatile("" : "+v"(lane));
          const int l15 = lane & 15, g4 = lane >> 4, qq = l15 >> 2, pp = lane & 3;
#pragma unroll
          for (int par = 0; par < 2; ++par) {
            const int c = c2 + par, bi_cur = par;
            const LAS unsigned char* Qs = lds + ML_Q + bi_cur * 64 * ML_QP; const LAS unsigned char* Ks = lds + ML_K + bi_cur * 64 * ML_QP;
            const unsigned Ksb = ldsb + ML_K + bi_cur * 64 * ML_QP, Vsb = ldsb + ML_V + bi_cur * 64 * ML_VP, Vwb = ldsb + ML_VW;
            if (c + 2 < 64) ML_LOAD(rs[par], c + 2);
            float4 tq[4]; const size_t tgi = ((size_t)bx * TAB_PER_WG + (size_t)c * 128) * 2 + tid;
            if (tsrc && tid < 256) {
#pragma unroll
                for (int j = 0; j < 4; ++j) tq[j] = ((const float4*)tsrc)[tgi * 4 + j]; }
            const LAS float* vb = vec + bi_cur * 320;
            {
                const int ti = w >> 1;
#pragma unroll
                for (int sj = 0; sj < 2; ++sj) {
                    const int si = 2 * (w & 1) + sj;
                    f32x4_t acc = (f32x4_t){0.f, 0.f, 0.f, 0.f};
                    if (si <= ti) {
#pragma unroll
                        for (int ks = 0; ks < 4; ++ks) {
                            const bf16x8_t a = *(const LAS bf16x8_t*)(Ks + (16 * si + l15) * ML_QP + (32 * ks + 8 * g4) * 2);
                            const bf16x8_t bq = *(const LAS bf16x8_t*)(Qs + (16 * ti + l15) * ML_QP + (32 * ks + 8 * g4) * 2);
                            acc = __builtin_amdgcn_mfma_f32_16x16x32_bf16(a, bq, acc, 0, 0, 0);
                        }
                        const int t = 16 * ti + l15; const float btv = vb[t];
                        const f32x4_t csv = *(const LAS f32x4_t*)(vb + 64 + 16 * si + 4 * g4);
#pragma unroll
                        for (int e = 0; e < 4; ++e) { const int s = 16 * si + 4 * g4 + e; acc[e] = (s <= t) ? acc[e] * __expf(btv + csv[e]) * 0.08838834764831845f : 0.f; }
                    }
                    *(LAS u32x2_t*)(lds + ML_P + (16 * ti + l15) * ML_PP + (16 * si + 4 * g4) * 2) = (u32x2_t){pk2(acc[0], acc[1]), pk2(acc[2], acc[3])};
                }
            }
            for (int it = tid; it < 640; it += 512) { const int s = it / 10, pc = it % 10; const float wsv = vb[192 + s];
                const u32x4_t v = *(const LAS u32x4_t*)(lds + ML_V + bi_cur * 64 * ML_VP + s * ML_VP + pc * 16); u32x4_t o;
#pragma unroll
                for (int j = 0; j < 4; ++j) o[j] = pk2(__uint_as_float(v[j] << 16) * wsv, __uint_as_float(v[j] & 0xffff0000u) * wsv);
                *(LAS u32x4_t*)(lds + ML_VW + s * ML_VP + pc * 16) = o; }
            LBAR();
            f32x4_t numv[3]; const int ti5 = w >> 1;
            {
                const int nv = (w & 1) ? 2 : 3, v0 = (w & 1) ? 3 : 0;
                bf16x8_t pfr[2], qfr[4];
#pragma unroll
                for (int ks = 0; ks < 2; ++ks) pfr[ks] = *(const LAS bf16x8_t*)(lds + ML_P + (16 * ti5 + l15) * ML_PP + (32 * ks + 8 * g4) * 2);
#pragma unroll
                for (int ks = 0; ks < 4; ++ks) qfr[ks] = *(const LAS bf16x8_t*)(Qs + (16 * ti5 + l15) * ML_QP + (32 * ks + 8 * g4) * 2);
#pragma unroll
                for (int j = 0; j < 3; ++j) {
                    numv[j] = (f32x4_t){0.f, 0.f, 0.f, 0.f};
                    if (j < nv) {
                        const int vi = v0 + j;
                        f32x4_t ai = (f32x4_t){0.f, 0.f, 0.f, 0.f}, ax = ai;
#pragma unroll
                        for (int ks = 0; ks < 2; ++ks) {
                            u32x2_t r0, r1; tr_read2q(Vsb + (32 * ks + 8 * g4 + qq) * ML_VP + (16 * vi + 4 * pp) * 2, Vsb + (32 * ks + 8 * g4 + 4 + qq) * ML_VP + (16 * vi + 4 * pp) * 2, r0, r1);
                            ai = __builtin_amdgcn_mfma_f32_16x16x32_bf16(pfr[ks], mk_frag(r0, r1), ai, 0, 0, 0);
                        }
#pragma unroll
                        for (int ks = 0; ks < 4; ++ks) {
                            const bf16x8_t bc = *(const LAS bf16x8_t*)(lds + ML_CT + (16 * vi + l15) * ML_QP + (32 * ks + 8 * g4) * 2);
                            ax = __builtin_amdgcn_mfma_f32_16x16x32_bf16(qfr[ks], bc, ax, 0, 0, 0);
                        }
                        const f32x4_t eb = *(const LAS f32x4_t*)(vb + 128 + 16 * ti5 + 4 * g4);
                        numv[j] = ai + eb * ax;
                    }
                }
                if ((w & 1) && l15 == 0) *(LAS f32x4_t*)(vec + 640 + 16 * ti5 + 4 * g4) = numv[1];
            }
            LBAR();
            {
                const f32x4_t dn = *(const LAS f32x4_t*)(vec + 640 + 16 * ti5 + 4 * g4);
                const size_t tb = (size_t)b * SEQ + (size_t)c * 64;
                const int nw = (w & 1) ? 1 : 3, v0 = (w & 1) ? 3 : 0;
                f32x4_t rdn;
#pragma unroll
                for (int e = 0; e < 4; ++e) rdn[e] = __builtin_amdgcn_rcpf(fmaxf(fabsf(dn[e]), 1.0f));
#pragma unroll
                for (int j = 0; j < 3; ++j)
                    if (j < nw) {
#pragma unroll
                        for (int e = 0; e < 4; ++e) hm[(tb + 16 * ti5 + 4 * g4 + e) * 1024 + h * 256 + vs * 64 + 16 * (v0 + j) + l15] = (bf16)pk2(numv[j][e] * rdn[e], 0.f);
                    }
            }
            {
                const float eg = vb[256];
                bf16x8_t kf[2];
#pragma unroll
                for (int ks = 0; ks < 2; ++ks) { u32x2_t a0, a1; tr_read2q(Ksb + (32 * ks + 8 * g4 + qq) * ML_QP + (16 * w + 4 * pp) * 2, Ksb + (32 * ks + 8 * g4 + 4 + qq) * ML_QP + (16 * w + 4 * pp) * 2, a0, a1); kf[ks] = mk_frag(a0, a1); }
#pragma unroll
                for (int vi = 0; vi < 5; ++vi) {
                    f32x4_t acc = cacc[vi] * eg;
#pragma unroll
                    for (int ks = 0; ks < 2; ++ks) {
                        u32x2_t b0, b1;
                        tr_read2q(Vwb + (32 * ks + 8 * g4 + qq) * ML_VP + (16 * vi + 4 * pp) * 2, Vwb + (32 * ks + 8 * g4 + 4 + qq) * ML_VP + (16 * vi + 4 * pp) * 2, b0, b1);
                        acc = __builtin_amdgcn_mfma_f32_16x16x32_bf16(kf[ks], mk_frag(b0, b1), acc, 0, 0, 0);
                    }
                    cacc[vi] = acc;
                    *(LAS u32x2_t*)(lds + ML_CT + (16 * vi + l15) * ML_QP + (16 * w + 4 * g4) * 2) = (u32x2_t){pk2(acc[0], acc[1]), pk2(acc[2], acc[3])};
                }
            }
            if (tsrc && tid < 256) tab_fp4_store(tq, tdst + tgi * 8, U6_SCALE);
            if (c + 1 < 64) ML_STORE(rs[par ^ 1], bi_cur ^ 1);
            LBAR();
          }
        }
#undef ML_LOAD
#undef ML_STORE
    }
}

constexpr int SD_BP = 272, SD_XP = 144;
constexpr int SD_UNITS = NBATCH * 16;
constexpr int SD_B = 0, SD_C = 128 * SD_BP, SD_M = 2 * 128 * SD_BP, SD_H = 3 * 128 * SD_BP, SD_X = SD_H + 64 * SD_BP, SD_VEC = SD_X + 128 * SD_XP, SD_END = SD_VEC + 4096;
static_assert(SD_END <= PHASE_LDS_BYTES, "SSD LDS");
__device__ __forceinline__ void ssd_phase(LAS unsigned char* lds, const bf16* __restrict__ xcb  , const float4* __restrict__ sg, const float* __restrict__ sea,
                                          const float* __restrict__ dsk, bf16* __restrict__ yraw  , int tid, int bx, int G, const float* __restrict__ tsrc  , unsigned char* __restrict__ tdst) {
    const int lane0 = tid & 63, w = __builtin_amdgcn_readfirstlane(tid >> 6);
    const unsigned ldsb = (unsigned)(size_t)lds;
    LAS float* vec = (LAS float*)(lds + SD_VEC);
    const int hb = G >> 1;
    if (bx >= hb) for (int u0_ = bx - hb; u0_ < SD_UNITS; u0_ += G - hb) {
        const int u = (G == 256) ? (((u0_ & 7) * 2 + (u0_ >> 6)) * 8 + ((u0_ >> 3) & 7)) : u0_;
        const int hh = u & 15, b = u >> 4, g = hh >> 3;
        const float Dk = dsk[hh];
        LBAR();
        for (int i = tid; i < 64 * SD_BP / 4; i += 512) ((LAS unsigned*)(lds + SD_H))[i] = 0u;
        for (int i = tid; i < 128 * SD_BP / 4; i += 512) ((LAS unsigned*)(lds + SD_M))[i] = 0u;
        f32x4_t hacc[4];
#pragma unroll
        for (int i = 0; i < 4; ++i) hacc[i] = (f32x4_t){0.f, 0.f, 0.f, 0.f};
        uint4 pb[4], pc[4], px[2]; float4 pg = make_float4(0.f, 0.f, 0.f, 0.f); float pea = 0.f;
#define SD_LOAD(c_) do { const size_t tb_ = (size_t)b * SEQ + (size_t)(c_) * 128; \
            _Pragma("unroll") for (int i_ = 0; i_ < 4; ++i_) { const int p_ = tid + 512 * i_, row_ = p_ >> 4, c16_ = p_ & 15; const bf16* s_ = xcb + (tb_ + row_) * 1536 + 1024 + g * 128 + c16_ * 8; pb[i_] = *(const uint4*)s_; pc[i_] = *(const uint4*)(s_ + 256); } \
            _Pragma("unroll") for (int i_ = 0; i_ < 2; ++i_) { const int p_ = tid + 512 * i_; px[i_] = *(const uint4*)(xcb + (tb_ + (p_ >> 3)) * 1536 + hh * 64 + (p_ & 7) * 8); } \
            if (tid < 128) { pg = sg[(tb_ + tid) * 16 + hh]; pea = sea[(b * 16 + hh) * 32 + (c_)]; } } while (0)
#define SD_STORE() do { _Pragma("unroll") for (int i_ = 0; i_ < 4; ++i_) { const int p_ = tid + 512 * i_, row_ = p_ >> 4, c16_ = p_ & 15; \
                *(LAS u32x4_t*)(lds + SD_B + row_ * SD_BP + c16_ * 16) = __builtin_bit_cast(u32x4_t, pb[i_]); *(LAS u32x4_t*)(lds + SD_C + row_ * SD_BP + c16_ * 16) = __builtin_bit_cast(u32x4_t, pc[i_]); } \
            _Pragma("unroll") for (int i_ = 0; i_ < 2; ++i_) { const int p_ = tid + 512 * i_; *(LAS u32x4_t*)(lds + SD_X + (p_ >> 3) * SD_XP + (p_ & 7) * 16) = __builtin_bit_cast(u32x4_t, px[i_]); } \
            if (tid < 128) { vec[640 + tid] = pg.x; vec[256 + tid] = pg.y; vec[384 + tid] = pg.z; vec[512 + tid] = pg.w; if (tid == 0) vec[769] = pea; } } while (0)
        SD_LOAD(0); SD_STORE();
        LBAR();
#pragma nounroll
        for (int c = 0; c < 32; ++c) {
            int lane = lane0; asm volatile("" : "+v"(lane));
            const int l15 = lane & 15, g4 = lane >> 4, qq = l15 >> 2, pp = lane & 3;
            if (c + 1 < 32) SD_LOAD(c + 1);
            float4 tq[4]; const size_t tgi = ((size_t)(bx - hb) * TAB_PER_WG + (size_t)c * 256) * 2 + tid;
            if (tsrc) {
#pragma unroll
                for (int j = 0; j < 4; ++j) tq[j] = ((const float4*)tsrc)[tgi * 4 + j]; }
            {
#pragma unroll
                for (int k = 0; k < 5; ++k) {
                    int li, si;
                    if (w >= 4) { li = w; si = w - 4 + k; } else if (k <= w) { li = w; si = k; } else { li = 7 - w; si = k - w - 1; }
                    if (w >= 4 || k <= 3) {
                        const int l = 16 * li + l15; const float acl = vec[256 + l];
                        f32x4_t acc = (f32x4_t){0.f, 0.f, 0.f, 0.f};
#pragma unroll
                        for (int ks = 0; ks < 4; ++ks) {
                            const bf16x8_t av = *(const LAS bf16x8_t*)(lds + SD_B + (16 * si + l15) * SD_BP + (32 * ks + 8 * g4) * 2);
                            const bf16x8_t bv = *(const LAS bf16x8_t*)(lds + SD_C + (16 * li + l15) * SD_BP + (32 * ks + 8 * g4) * 2);
                            acc = __builtin_amdgcn_mfma_f32_16x16x32_bf16(av, bv, acc, 0, 0, 0);
                        }
                        const f32x4_t acs = *(const LAS f32x4_t*)(vec + 256 + 16 * si + 4 * g4), dts = *(const LAS f32x4_t*)(vec + 640 + 16 * si + 4 * g4);
#pragma unroll
                        for (int e = 0; e < 4; ++e) { const int s = 16 * si + 4 * g4 + e; acc[e] = (s <= l) ? acc[e] * __expf(acl - acs[e]) * dts[e] : 0.f; }
                        *(LAS u32x2_t*)(lds + SD_M + l * SD_BP + (16 * si + 4 * g4) * 2) = (u32x2_t){pk2(acc[0], acc[1]), pk2(acc[2], acc[3])};
                    }
                }
            }
            LBAR();
#pragma unroll
            for (int i_ = 0; i_ < 4; ++i_) { const int p_ = tid + 512 * i_, s = p_ >> 4, c16 = p_ & 15; const float wv = vec[512 + s];
                LAS u32x4_t* bp = (LAS u32x4_t*)(lds + SD_B + s * SD_BP + c16 * 16); const u32x4_t v = *bp; u32x4_t o;
#pragma unroll
                for (int j = 0; j < 4; ++j) o[j] = pk2(__uint_as_float(v[j] << 16) * wv, __uint_as_float(v[j] & 0xffff0000u) * wv);
                *bp = o; }
            {
                const int li = w; const size_t tb = (size_t)b * SEQ + (size_t)c * 128;
                const f32x4_t eac = *(const LAS f32x4_t*)(vec + 384 + 16 * li + 4 * g4);
                bf16x8_t mf[4], cf[4];
#pragma unroll
                for (int ks = 0; ks < 4; ++ks) {
                    mf[ks] = *(const LAS bf16x8_t*)(lds + SD_M + (16 * li + l15) * SD_BP + (32 * ks + 8 * g4) * 2);
                    cf[ks] = *(const LAS bf16x8_t*)(lds + SD_C + (16 * li + l15) * SD_BP + (32 * ks + 8 * g4) * 2);
                }
#pragma unroll
                for (int pi = 0; pi < 4; ++pi) {
                    f32x4_t yd = (f32x4_t){0.f, 0.f, 0.f, 0.f}, yo = yd;
#pragma unroll
                    for (int ks = 0; ks < 4; ++ks) {
                        if (32 * ks <= 16 * li + 15) {
                            u32x2_t r0, r1; tr_read2q(ldsb + SD_X + (32 * ks + 8 * g4 + qq) * SD_XP + (16 * pi + 4 * pp) * 2, ldsb + SD_X + (32 * ks + 8 * g4 + 4 + qq) * SD_XP + (16 * pi + 4 * pp) * 2, r0, r1);
                            yd = __builtin_amdgcn_mfma_f32_16x16x32_bf16(mf[ks], mk_frag(r0, r1), yd, 0, 0, 0);
                        }
                    }
#pragma unroll
                    for (int ks = 0; ks < 4; ++ks) {
                        const bf16x8_t bh = *(const LAS bf16x8_t*)(lds + SD_H + (16 * pi + l15) * SD_BP + (32 * ks + 8 * g4) * 2);
                        yo = __builtin_amdgcn_mfma_f32_16x16x32_bf16(cf[ks], bh, yo, 0, 0, 0);
                    }
#pragma unroll
                    for (int e = 0; e < 4; ++e) { const int l = 16 * li + 4 * g4 + e;
                        const float xv = __uint_as_float(((unsigned)*(const LAS unsigned short*)(lds + SD_X + l * SD_XP + (16 * pi + l15) * 2)) << 16);
                        yraw[(tb + l) * 1024 + hh * 64 + 16 * pi + l15] = (bf16)pk2(yd[e] + eac[e] * yo[e] + Dk * xv, 0.f); }
                }
            }
            LBAR();
            {
                const float ea = vec[769];
                bf16x8_t kf[4];
#pragma unroll
                for (int ks = 0; ks < 4; ++ks) { u32x2_t a0, a1; tr_read2q(ldsb + SD_B + (32 * ks + 8 * g4 + qq) * SD_BP + (16 * w + 4 * pp) * 2, ldsb + SD_B + (32 * ks + 8 * g4 + 4 + qq) * SD_BP + (16 * w + 4 * pp) * 2, a0, a1); kf[ks] = mk_frag(a0, a1); }
#pragma unroll
                for (int pi = 0; pi < 4; ++pi) {
                    f32x4_t acc = hacc[pi] * ea;
#pragma unroll
                    for (int ks = 0; ks < 4; ++ks) {
                        u32x2_t b0, b1;
                        tr_read2q(ldsb + SD_X + (32 * ks + 8 * g4 + qq) * SD_XP + (16 * pi + 4 * pp) * 2, ldsb + SD_X + (32 * ks + 8 * g4 + 4 + qq) * SD_XP + (16 * pi + 4 * pp) * 2, b0, b1);
                        acc = __builtin_amdgcn_mfma_f32_16x16x32_bf16(kf[ks], mk_frag(b0, b1), acc, 0, 0, 0);
                    }
                    hacc[pi] = acc;
                    *(LAS u32x2_t*)(lds + SD_H + (16 * pi + l15) * SD_BP + (16 * w + 4 * g4) * 2) = (u32x2_t){pk2(acc[0], acc[1]), pk2(acc[2], acc[3])};
                }
            }
            LBAR();
            if (tsrc) tab_fp4_store(tq, tdst + tgi * 8, V4_SCALE);
            if (c + 1 < 32) SD_STORE();
            LBAR();
        }
#undef SD_LOAD
#undef SD_STORE
    }
}

constexpr int PS_SKP = 272;
constexpr int PS_SK = 0, PS_END = 2 * 128 * PS_SKP;
static_assert(PS_END <= PHASE_LDS_BYTES, "PEER select LDS");
__device__ __forceinline__ unsigned fkey(float f) { const unsigned u = __float_as_uint(f); return u ^ ((unsigned)((int)u >> 31) | 0x80000000u); }
__device__ __forceinline__ float funkey(unsigned k) { return __uint_as_float((k & 0x80000000u) ? (k ^ 0x80000000u) : ~k); }
template <int CTRL> __device__ __forceinline__ unsigned dpp_u(unsigned v) { return (unsigned)__builtin_amdgcn_update_dpp(0, (int)v, CTRL, 0xF, 0xF, true); }
__device__ __forceinline__ unsigned umax(unsigned a, unsigned b) { return a > b ? a : b; }
__device__ __forceinline__ unsigned row_umax(unsigned v) { v = umax(v, dpp_u<0xB1>(v)); v = umax(v, dpp_u<0x4E>(v)); v = umax(v, dpp_u<0x141>(v)); v = umax(v, dpp_u<0x140>(v)); return v; }
__device__ __forceinline__ float row_sum(float v) { v += dpp_f<0xB1>(v); v += dpp_f<0x4E>(v); v += dpp_f<0x141>(v); v += dpp_f<0x140>(v); return v; }
template <int N> __device__ __forceinline__ unsigned row_top16(unsigned (&s)[N], int l15) {
    unsigned mine = 0u;
#pragma unroll
    for (int j = 0; j < 16; ++j) {
        unsigned m = s[0];
#pragma unroll
        for (int i = 1; i < N; ++i) m = umax(m, s[i]);
        m = row_umax(m);
        mine = (l15 == j) ? m : mine;
#pragma unroll
        for (int i = 0; i < N; ++i) s[i] = (s[i] == m) ? 0u : s[i];
    }
    return mine;
}
__device__ __forceinline__ void ce_desc(unsigned& a, unsigned& b) { const unsigned hi = umax(a, b), lo = a < b ? a : b; a = hi; b = lo; }
__device__ __forceinline__ void sort_desc(unsigned (&s)[8]) {
    ce_desc(s[0], s[1]); ce_desc(s[2], s[3]); ce_desc(s[4], s[5]); ce_desc(s[6], s[7]);
    ce_desc(s[0], s[2]); ce_desc(s[1], s[3]); ce_desc(s[4], s[6]); ce_desc(s[5], s[7]);
    ce_desc(s[1], s[2]); ce_desc(s[5], s[6]);
    ce_desc(s[0], s[4]); ce_desc(s[1], s[5]); ce_desc(s[2], s[6]); ce_desc(s[3], s[7]);
    ce_desc(s[2], s[4]); ce_desc(s[3], s[5]);
    ce_desc(s[1], s[2]); ce_desc(s[3], s[4]); ce_desc(s[5], s[6]);
}
__device__ __forceinline__ void sort_desc(unsigned (&s)[4]) { ce_desc(s[0], s[1]); ce_desc(s[2], s[3]); ce_desc(s[0], s[2]); ce_desc(s[1], s[3]); ce_desc(s[1], s[2]); }
template <int N> __device__ __forceinline__ void row_top16x4(unsigned (&s)[4][N], int l15, unsigned (&mine)[4]) {
#pragma unroll
    for (int e = 0; e < 4; ++e) { sort_desc(s[e]); mine[e] = 0u; }
#pragma unroll
    for (int j = 0; j < 16; ++j) {
        unsigned mx[4];
#pragma unroll
        for (int e = 0; e < 4; ++e) mx[e] = s[e][0];
#pragma unroll
        for (int e = 0; e < 4; ++e) mx[e] = umax(mx[e], dpp_u<0xB1>(mx[e]));
#pragma unroll
        for (int e = 0; e < 4; ++e) mx[e] = umax(mx[e], dpp_u<0x4E>(mx[e]));
#pragma unroll
        for (int e = 0; e < 4; ++e) mx[e] = umax(mx[e], dpp_u<0x141>(mx[e]));
#pragma unroll
        for (int e = 0; e < 4; ++e) mx[e] = umax(mx[e], dpp_u<0x140>(mx[e]));
#pragma unroll
        for (int e = 0; e < 4; ++e) {
            mine[e] = (l15 == j) ? mx[e] : mine[e];
            const bool win = s[e][0] == mx[e];
#pragma unroll
            for (int i = 0; i + 1 < N; ++i) s[e][i] = win ? s[e][i + 1] : s[e][i];
            s[e][N - 1] = win ? 0u : s[e][N - 1];
        }
    }
}
__device__ __forceinline__ void peer_select_phase(LAS unsigned char* lds, const bf16* __restrict__ qb  , const bf16* __restrict__ skb  , int* __restrict__ ids, float* __restrict__ gates,
                                                  int tid, int bx, int G) {
    const int lane = tid & 63, w = __builtin_amdgcn_readfirstlane(tid >> 6), l15 = lane & 15, g4 = lane >> 4;
    int ca[4], cb[4];
#pragma unroll
    for (int i = 0; i < 4; ++i) { const int sg = 4 * l15 + i; int a = 0, base = 0;
#pragma unroll
        for (int k = 0; k < 15; ++k) { const int cnt = 16 / (k + 1); const bool adv = (a == k) && (sg >= base + cnt); base += adv ? cnt : 0; a += adv ? 1 : 0; }
        ca[i] = a; cb[i] = sg - base; if (sg >= 50) { ca[i] = -1; cb[i] = 0; } }
    for (int u = bx; u < 8 * 32; u += G) {
        const int h = u >> 5, tr = u & 31;
        LBAR();
        for (int it = tid; it < 4096; it += 512) { const int row = it >> 4, c16 = it & 15;
            *(LAS u32x4_t*)(lds + PS_SK + row * PS_SKP + c16 * 16) = __builtin_bit_cast(u32x4_t, *(const uint4*)(skb + ((size_t)h * 256 + row) * 128 + c16 * 8)); }
        LBAR();
#pragma nounroll
        for (int tile = w; tile < 64; tile += 8) {
            const int t0 = tr * 1024 + tile * 16;
            unsigned top[2][4];
#pragma unroll
            for (int c = 0; c < 2; ++c) {
                bf16x8_t af[4];
#pragma unroll
                for (int ks = 0; ks < 4; ++ks) af[ks] = __builtin_bit_cast(bf16x8_t, *(const uint4*)(qb + (size_t)(t0 + l15) * DM + h * 256 + c * 128 + 32 * ks + 8 * g4));
                unsigned key[8][4];
#pragma unroll
                for (int kt = 0; kt < 8; ++kt) {
                    f32x4_t acc = (f32x4_t){0.f, 0.f, 0.f, 0.f};
#pragma unroll
                    for (int ks = 0; ks < 4; ++ks) {
                        const bf16x8_t bfr = *(const LAS bf16x8_t*)(lds + PS_SK + (c * 128 + 16 * kt + l15) * PS_SKP + (32 * ks + 8 * g4) * 2);
                        acc = __builtin_amdgcn_mfma_f32_16x16x32_bf16(af[ks], bfr, acc, 0, 0, 0);
                    }
#pragma unroll
                    for (int e = 0; e < 4; ++e) key[kt][e] = (fkey(acc[e]) & ~0x7Fu) | (unsigned)(127 - (16 * kt + l15));
                }
                { unsigned s8[4][8];
#pragma unroll
                  for (int e = 0; e < 4; ++e)
#pragma unroll
                      for (int kt = 0; kt < 8; ++kt) s8[e][kt] = key[kt][e];
                  __builtin_amdgcn_sched_barrier(0); row_top16x4<8>(s8, l15, top[c]); __builtin_amdgcn_sched_barrier(0); }
            }
            unsigned s4[4][4], win4[4];
#pragma unroll
            for (int e = 0; e < 4; ++e)
#pragma unroll
                for (int i = 0; i < 4; ++i) {
                    const int srcA = ((lane & 48) + (ca[i] < 0 ? 0 : ca[i])) * 4, srcB = ((lane & 48) + cb[i]) * 4;
                    const unsigned ka = (unsigned)__builtin_amdgcn_ds_bpermute(srcA, (int)top[0][e]), kb = (unsigned)__builtin_amdgcn_ds_bpermute(srcB, (int)top[1][e]);
                    const float cv = funkey(ka & ~0x7Fu) + funkey(kb & ~0x7Fu);
                    s4[e][i] = ca[i] < 0 ? 0u : ((fkey(cv) & ~0xFFu) | (unsigned)(255 - (ca[i] * 16 + cb[i])));
                }
            __builtin_amdgcn_sched_barrier(0); row_top16x4<4>(s4, l15, win4); __builtin_amdgcn_sched_barrier(0);
#pragma unroll
            for (int e = 0; e < 4; ++e) {
                const unsigned win = win4[e];
                const int jw = 255 - (int)(win & 0xFFu), wa = jw >> 4, wb = jw & 15;
                const unsigned ka = (unsigned)__builtin_amdgcn_ds_bpermute(((lane & 48) + wa) * 4, (int)top[0][e]), kb = (unsigned)__builtin_amdgcn_ds_bpermute(((lane & 48) + wb) * 4, (int)top[1][e]);
                const float bv = funkey(ka & ~0x7Fu) + funkey(kb & ~0x7Fu);
                const int id = (127 - (int)(ka & 0x7Fu)) * 128 + (127 - (int)(kb & 0x7Fu));
                const float mx = __builtin_bit_cast(float, __builtin_amdgcn_ds_bpermute((lane & 48) * 4, __builtin_bit_cast(int, bv)));
                const float ex = __expf(bv - mx), den = row_sum(ex);
                const size_t o = (size_t)(t0 + 4 * g4 + e) * 128 + h * 16 + l15;
                ids[o] = id; gates[o] = ex * __builtin_amdgcn_rcpf(den);
            }
        }
    }
}

struct MegaArgs { const float* in[22]; float* out; unsigned char* ws; };
template <int I> __device__ __forceinline__ unsigned long long ld_ptr() {
    unsigned long long v; const auto ka = __builtin_amdgcn_kernarg_segment_ptr();
    asm volatile("s_load_dwordx2 %0, %1, %2\n\ts_waitcnt lgkmcnt(0)" : "=s"(v) : "s"(ka), "n"(I * 8) : "memory");
    return v;
}
#define GAS_ __attribute__((address_space(1)))
#define INF(i) ((const float*)(const GAS_ float*)ld_ptr<(i)>())
#define OUTP ((float*)(GAS_ float*)ld_ptr<22>())
#define WSP ((unsigned char*)(GAS_ unsigned char*)ld_ptr<23>())
enum { I_X = 0, I_WIN, I_MGATEB, I_MNORMW, I_CONVW, I_CONVB, I_DTB, I_ALOG, I_SSMD, I_SNORMW, I_SINKS, I_MERGEB, I_WBR, I_WOUT, I_LN1G, I_LN1B, I_WQ, I_SUBK, I_PU, I_PV, I_LN2G, I_LN2B };

__global__ void __launch_bounds__(512, 2) mega_fwd(MegaArgs a) {
    extern __shared__ __attribute__((aligned(16))) unsigned char lds_raw[];
    LAS unsigned char* lds = (LAS unsigned char*)lds_raw;
    const int wave0 = __builtin_amdgcn_readfirstlane(threadIdx.x >> 6);
    volatile LAS unsigned* MISC = (volatile LAS unsigned*)(lds + MISC_OFF);
    { PHASE_IDS for (int u = tid; u < (LDS_BYTES - PHASE_LDS_BYTES) / 4; u += 512) ((LAS unsigned*)(lds + PHASE_LDS_BYTES))[u] = 0u; }
    __syncthreads();
    { XcdBarrier b0 = xcd_barrier_post((unsigned*)(WSP + WS_CTL) + CW_BAR, MISC + 8); (void)b0; }
#define GRID_BAR() do { XcdBarrier b_; b_.bar = (unsigned*)(WSP + WS_CTL) + CW_BAR; b_.x = xb_xcc_id(); b_.st = MISC + 8; xcd_barrier(b_); } while (0)

    { PHASE_IDS float2* rt = (float2*)(WSP + WS_ROPE);
      for (size_t i = gt; i < (size_t)SEQ * 32; i += NGT) { const int pos = (int)(i >> 5), fi = (int)(i & 31); const float ang = (float)pos * powf(10000.0f, -(float)fi / 32.0f); rt[i] = make_float2(cosf(ang), sinf(ang)); } }
    { PHASE_IDS const float* x = INF(I_X); bf16* xb = (bf16*)(WSP + WS_XB);
      unsigned* xq = (unsigned*)(WSP + WS_XQ);
      for (size_t i = gt; i < (size_t)T_TOK * DM / 4; i += NGT) { const float4 v = ((const float4*)x)[i]; ((uint2*)xb)[i] = make_uint2(pk2(v.x, v.y), pk2(v.z, v.w)); xq[i] = pk4_fp8(v.x, v.y, v.z, v.w); } }

#pragma nounroll
    for (int l = 0; l < DEPTH; ++l) {
        { PHASE_IDS
            unsigned char* ws = WSP; bf16* WinT = (bf16*)(ws + WS_WIN); bf16* WbT = (bf16*)(ws + WS_WB); bf16* WoT = (bf16*)(ws + WS_WO); bf16* WqT = (bf16*)(ws + WS_WQ); float* bias = (float*)(ws + WS_BIAS);
            const float* w_in = INF(I_WIN) + (size_t)l * DM * IN_COLS; const float* w_branch = INF(I_WBR) + (size_t)l * 3 * 1024 * DM; const float* w_out = INF(I_WOUT) + (size_t)l * DM * DM; const float* peer_wq = INF(I_WQ) + (size_t)l * DM * DM;
            const float* merge_gate_b = INF(I_MERGEB) + (size_t)l * 3 * DM;
            LAS float* scr = (LAS float*)(lds + wave * 16384);
            constexpr int I_IN = (DM / 64) * (NP / 32), I_B = (1024 / 64) * (DM / 32), I_O = (DM / 64) * (DM / 32);
            constexpr int NITEMS = I_IN + 3 * I_B + 2 * I_O;
            for (int it = gw; it < NITEMS; it += NGW) {
                int r = it;
                if (r < I_IN) { transpose_item<1>(w_in, DM, IN_COLS, NP, WinT, scr, r, lane, ws + WS_WG8); continue; } r -= I_IN;
                if (r < 3 * I_B) { const int k = r / I_B; transpose_item<2>(w_branch + (size_t)k * 1024 * DM, 1024, DM, DM, nullptr, scr, r - k * I_B, lane, ws + WS_WB8 + (size_t)k * DM * 1024); continue; } r -= 3 * I_B;
                if (r < I_O) { transpose_item<2>(w_out, DM, DM, DM, nullptr, scr, r, lane, ws + WS_WO8); continue; } r -= I_O;
                transpose_item<0>(peer_wq, DM, DM, DM, WqT, scr, r, lane);
            }
            for (size_t n = gt; n < NP; n += NGT) bias[n] = (n >= C_G && n < C_SMALL) ? merge_gate_b[n - C_G] : 0.f;
            { const float4* sk = (const float4*)(INF(I_SUBK) + (size_t)l * 8 * 2 * 128 * 128); uint2* skb = (uint2*)(ws + WS_SKB);
              for (size_t n = gt; n < 8 * 2 * 128 * 128 / 4; n += NGT) { const float4 v = sk[n]; skb[n] = make_uint2(pk2(v.x, v.y), pk2(v.z, v.w)); } }
        }
        GRID_BAR();
        { PHASE_IDS unsigned char* ws = WSP; pg8::Gemm g{(const bf16*)(ws + WS_XQ), (const bf16*)(ws + WS_WG8), T_TOK, C_SMALL - 256, DM / 2}; pg8::StaticOrder S; S.init(T_TOK, C_SMALL - 256, G, bx); S.rfrom = C_AV / 256; S.rto = SMALL_TILE - 1; S.wgm = 4;
          pg8::EpiProj E{(bf16*)(ws + WS_PROJ), (const float*)(ws + WS_BIAS), (float*)(ws + WS_SMALL), NP, GATE_TILE_LO, SMALL_TILE, 0, 1.0f / WG8_SCALE};
          pg8::gemm_phase<pg8::EpiProj, pg8::StaticOrder, true, true, true>(lds, g, S, E, tid); }
        __syncthreads();
        { PHASE_IDS unsigned char* ws = WSP; pg8::Gemm g{(const bf16*)(ws + WS_XB), (const bf16*)(ws + WS_WIN), T_TOK, 512, DM}; pg8::StaticOrder S; S.init(T_TOK, 512, G, bx); S.rfrom = 0; S.rto = C_AV / 256; S.rfrom2 = 1; S.rto2 = SMALL_TILE;
          pg8::EpiProj E{(bf16*)(ws + WS_PROJ), (const float*)(ws + WS_BIAS), (float*)(ws + WS_SMALL), NP, GATE_TILE_LO, SMALL_TILE, 0, 1.0f};
          pg8::gemm_phase<pg8::EpiProj, pg8::StaticOrder, true, true>(lds, g, S, E, tid); }
        GRID_BAR();
        { PHASE_IDS unsigned char* ws = WSP; const bf16* proj = (const bf16*)(ws + WS_PROJ); bf16* xcb = (bf16*)(ws + WS_R2);
          const float* cwg = INF(I_CONVW) + (size_t)l * 4 * 1536; const float* cbg = INF(I_CONVB) + l * 1536;
          LAS float* cw = (LAS float*)(lds + 16384); LAS float* cb = cw + 4 * 1536;
          for (int n = tid; n < 4 * 1536 / 4; n += 512) { const float4 v = ((const float4*)cwg)[n]; *(LAS f32x4e_t*)(cw + 4 * n) = (f32x4e_t){v.x, v.y, v.z, v.w}; }
          for (int n = tid; n < 1536 / 4; n += 512) { const float4 v = ((const float4*)cbg)[n]; *(LAS f32x4e_t*)(cb + 4 * n) = (f32x4e_t){v.x, v.y, v.z, v.w}; }
          asm volatile("s_waitcnt lgkmcnt(0)" ::: "memory"); __builtin_amdgcn_s_barrier(); asm volatile("" ::: "memory");
          for (int i = (int)gt; i < 192 * (T_TOK / 8); i += (int)NGT) ssd_conv_item(i, proj, cw, cb, xcb); }
        { PHASE_IDS unsigned char* ws = WSP; const float* small = (const float*)(ws + WS_SMALL); LAS float* wl = (LAS float*)(lds + wave * 1024);
          for (int i = gw; i < NBATCH * 4 * 64; i += NGW) mlstm_gate_item(i, lane, wl, small, INF(I_MGATEB) + l * 8, (float4*)(ws + WS_MG), (float*)(ws + WS_MEG));
          for (int i = gw; i < NBATCH * 16 * 32; i += NGW) ssd_gate_item(i, lane, wl, small, INF(I_DTB) + l * 16, INF(I_ALOG) + l * 16, (float4*)(ws + WS_SG), (float*)(ws + WS_SEA)); }
        GRID_BAR();
        { PHASE_IDS unsigned char* ws = WSP; mlstm_phase(lds, (const bf16*)(ws + WS_PROJ), (const float4*)(ws + WS_MG), (const float*)(ws + WS_MEG), (bf16*)(ws + WS_HM), tid, bx, G, G == 256 ? INF(I_PU) + (size_t)l * P_EXPERTS * DM : nullptr, ws + WS_TAB); }
        { PHASE_IDS unsigned char* ws = WSP; ssd_phase(lds, (const bf16*)(ws + WS_R2), (const float4*)(ws + WS_SG), (const float*)(ws + WS_SEA), INF(I_SSMD) + l * 16, (bf16*)(ws + WS_R1), tid, bx, G, G == 256 ? INF(I_PV) + (size_t)l * P_EXPERTS * DM : nullptr, ws + WS_TAB + 32 * MiB); }
        { PHASE_IDS unsigned char* ws = WSP; swa_phase(lds, (const bf16*)(ws + WS_PROJ), (const float*)(ws + WS_ROPE), INF(I_SINKS) + l * 16, ws + WS_YQ + 64 * MiB, tid, bx, G); }
        GRID_BAR();
        { PHASE_IDS unsigned char* ws = WSP; const bf16* proj = (const bf16*)(ws + WS_PROJ); const bf16* hm = (const bf16*)(ws + WS_HM); unsigned char* ym = ws + WS_YQ; const float* nwg = INF(I_MNORMW) + l * 1024; const float* nsg = INF(I_SNORMW) + l * 1024;
          LAS float* nw = (LAS float*)lds; LAS float* nsl = nw + 1024;
          if (tid < 256) { const float4 v = ((const float4*)nwg)[tid]; *(LAS f32x4e_t*)(nw + 4 * tid) = (f32x4e_t){v.x, v.y, v.z, v.w}; }
          else { const float4 v = ((const float4*)nsg)[tid - 256]; *(LAS f32x4e_t*)(nsl + 4 * (tid - 256)) = (f32x4e_t){v.x, v.y, v.z, v.w}; }
          asm volatile("s_waitcnt lgkmcnt(0)" ::: "memory"); __builtin_amdgcn_s_barrier(); asm volatile("" ::: "memory");
          for (int t = gw; t < T_TOK; t += NGW) mlstm_post_tok(t, lane, hm, proj, nw, ym); }
        { PHASE_IDS unsigned char* ws = WSP; const bf16* proj = (const bf16*)(ws + WS_PROJ); const bf16* yraw = (const bf16*)(ws + WS_R1); unsigned char* ys = ws + WS_YQ + 32 * MiB; const LAS float* nw = (const LAS float*)lds + 1024;
          for (int tp = gw; tp < T_TOK / 2; tp += NGW) ssd_post_tok2(tp, lane, yraw, proj, nw, ys); }
        GRID_BAR();
        { PHASE_IDS unsigned char* ws = WSP; pg8::Gemm g{(const bf16*)(ws + WS_YQ), (const bf16*)(ws + WS_WB8), T_TOK, DM, 512}; pg8::StaticOrder S; S.init(T_TOK, DM, G, bx); S.wgm = 4;
          pg8::EpiMix<1, 0, 8, 2> E{(bf16*)(ws + WS_R1), (const bf16*)(ws + WS_PROJ) + C_G, DM, NP, nullptr};
          pg8::gemm_phase<pg8::EpiMix<1, 0, 8, 2>, pg8::StaticOrder, true, true, true>(lds, g, S, E, tid); }
        __syncthreads();
        { PHASE_IDS unsigned char* ws = WSP; pg8::Gemm g{(const bf16*)(ws + WS_YQ + 32 * MiB), (const bf16*)(ws + WS_WB8 + (size_t)DM * 1024), T_TOK, DM, 512}; pg8::StaticOrder S; S.init(T_TOK, DM, G, bx); S.wgm = 4;
          pg8::EpiMix<0, 0, 8, 2> E{(bf16*)(ws + WS_R1), (const bf16*)(ws + WS_PROJ) + C_G + DM, DM, NP, nullptr};
          pg8::gemm_phase<pg8::EpiMix<0, 0, 8, 2>, pg8::StaticOrder, true, true, true>(lds, g, S, E, tid); }
        __syncthreads();
        { PHASE_IDS unsigned char* ws = WSP; pg8::Gemm g{(const bf16*)(ws + WS_YQ + 64 * MiB), (const bf16*)(ws + WS_WB8 + (size_t)2 * DM * 1024), T_TOK, DM, 512}; pg8::StaticOrder S; S.init(T_TOK, DM, G, bx); S.wgm = 4;
          pg8::EpiMix<0, 1, 8, 2> E{(bf16*)(ws + WS_R1), (const bf16*)(ws + WS_PROJ) + C_G + 2 * DM, DM, NP, ws + WS_R1Q};
          pg8::gemm_phase<pg8::EpiMix<0, 1, 8, 2>, pg8::StaticOrder, true, true, true>(lds, g, S, E, tid); }
        GRID_BAR();
        { PHASE_IDS unsigned char* ws = WSP;
          pg8::Gemm g{(const bf16*)(ws + WS_R1Q), (const bf16*)(ws + WS_WO8), T_TOK, DM, DM / 2}; pg8::StaticOrder S; S.init(T_TOK, DM, G, bx); S.wgm = 4; pg8::EpiResidB<8> E{(bf16*)(ws + WS_XB), DM, ALPHA, 0};
          pg8::gemm_phase<pg8::EpiResidB<8>, pg8::StaticOrder, true, true, true>(lds, g, S, E, tid); }
        GRID_BAR();
        { PHASE_IDS unsigned char* ws = WSP; bf16* xb = (bf16*)(ws + WS_XB); const float* g1g = INF(I_LN1G) + l * DM; const float* b1g = INF(I_LN1B) + l * DM;
          LAS float* g1 = (LAS float*)lds; LAS float* b1 = g1 + DM;
          { const float4 v = ((const float4*)g1g)[tid], w = ((const float4*)b1g)[tid]; *(LAS f32x4e_t*)(g1 + 4 * tid) = (f32x4e_t){v.x, v.y, v.z, v.w}; *(LAS f32x4e_t*)(b1 + 4 * tid) = (f32x4e_t){w.x, w.y, w.z, w.w}; }
          asm volatile("s_waitcnt lgkmcnt(0)" ::: "memory"); __builtin_amdgcn_s_barrier(); asm volatile("" ::: "memory");
          for (int tp = gw; tp < T_TOK / 2; tp += NGW) ln_body2b(tp, lane, xb, g1, b1); }
        { PHASE_IDS unsigned char* ws = WSP; constexpr size_t NGRP = (size_t)P_EXPERTS * DM / 32;
          const float* pu = INF(I_PU) + (size_t)l * P_EXPERTS * DM; const float* pv = INF(I_PV) + (size_t)l * P_EXPERTS * DM; unsigned char* U6 = ws + WS_TAB; unsigned char* V6 = ws + WS_TAB + 32 * MiB;
          if (G != 256) for (size_t i = gt; i < NGRP; i += NGT) { tab_to_fp4(i, pu, U6, U6_SCALE); tab_to_fp4(i, pv, V6, V4_SCALE); } }
        GRID_BAR();
        { PHASE_IDS unsigned char* ws = WSP; pg8::Gemm g{(const bf16*)(ws + WS_XB), (const bf16*)(ws + WS_WQ), T_TOK, DM, DM}; pg8::StaticOrder S; S.init(T_TOK, DM, G, bx); S.wgm = 4;
          pg8::EpiProj E{(bf16*)(ws + WS_QF), nullptr, nullptr, DM, 1 << 20, -1, 0, 1.0f};
          pg8::gemm_phase<pg8::EpiProj, pg8::StaticOrder, true, true>(lds, g, S, E, tid); }
        GRID_BAR();
        { PHASE_IDS unsigned char* ws = WSP; peer_select_phase(lds, (const bf16*)(ws + WS_QF), (const bf16*)(ws + WS_SKB), (int*)(ws + WS_IDS), (float*)(ws + WS_GATES), tid, bx, G); }
        GRID_BAR();
        { PHASE_IDS unsigned char* ws = WSP; const int* ids = (const int*)(ws + WS_IDS); const float* gates = (const float*)(ws + WS_GATES);
          const unsigned char* U8 = ws + WS_TAB; const unsigned char* V8 = ws + WS_TAB + 32 * MiB;     const float* g2 = INF(I_LN2G) + l * DM; const float* b2 = INF(I_LN2B) + l * DM; float* out = OUTP; bf16* xb = (bf16*)(ws + WS_XB);
          LAS unsigned* wl = (LAS unsigned*)(lds + wave * 2048);
          LAS float* gl = (LAS float*)(lds + 16384); LAS float* bl = gl + DM;
          for (int n = tid; n < DM / 4; n += 512) { const int ln_ = n >> 3, i_ = n & 7; const float4 gv = ((const float4*)g2)[n], bv = ((const float4*)b2)[n];
              *(LAS f32x4e_t*)(gl + (i_ * 64 + ln_) * 4) = (f32x4e_t){gv.x, gv.y, gv.z, gv.w}; *(LAS f32x4e_t*)(bl + (i_ * 64 + ln_) * 4) = (f32x4e_t){bv.x, bv.y, bv.z, bv.w}; }
          asm volatile("s_waitcnt lgkmcnt(0)" ::: "memory"); __builtin_amdgcn_s_barrier(); asm volatile("" ::: "memory");
          for (int t = gw; t < T_TOK; t += NGW) peer_expert_body(t, lane, l == DEPTH - 1, ids, gates, U8, V8, gl, bl, out, xb, ws + WS_XQ, wl); }
        GRID_BAR();
    }
#undef GRID_BAR
}

extern "C" void kernel_launch(void* const* d_in, const int* in_sizes, int n_in, void* d_out, int out_size, void* d_ws, size_t ws_size, hipStream_t stream) {
    static int grid = 0;
    if (grid == 0) {
        if (n_in != 22 || out_size != T_TOK * DM || ws_size < WS_END) { fprintf(stderr, "kernel_launch: unexpected shapes (n_in %d, out %d, ws %zu)\n", n_in, out_size, ws_size); grid = -1; return; }
        int dev = 0, cus = 0, per_cu = 0;
        if (hipGetDevice(&dev) != hipSuccess || hipDeviceGetAttribute(&cus, hipDeviceAttributeMultiprocessorCount, dev) != hipSuccess) { grid = -1; return; }
        if (hipFuncSetAttribute((const void*)mega_fwd, hipFuncAttributeMaxDynamicSharedMemorySize, LDS_BYTES) != hipSuccess) { fprintf(stderr, "kernel_launch: hipFuncSetAttribute failed\n"); grid = -1; return; }
        if (hipOccupancyMaxActiveBlocksPerMultiprocessor(&per_cu, (const void*)mega_fwd, 512, LDS_BYTES) != hipSuccess || per_cu < 1) { fprintf(stderr, "kernel_launch: occupancy query says %d blocks per CU\n", per_cu); (void)hipGetLastError(); grid = -1; return; }
        grid = cus;
    }
    if (grid < 0) return;
    (void)hipMemsetAsync((char*)d_ws + WS_CTL, 0, CTL_ZERO_BYTES, stream);
    MegaArgs a; memset(&a, 0, sizeof(a));
    for (int i = 0; i < 22; ++i) a.in[i] = (const float*)d_in[i];
    a.out = (float*)d_out; a.ws = (unsigned char*)d_ws;
    hipLaunchKernelGGL(mega_fwd, dim3(grid), dim3(512), LDS_BYTES, stream, a);
}
```

```cpp
#include <hip/hip_runtime.h>
#include <cstdio>
#include <cstdint>
#include <cstring>

namespace pg8 {
#define PG8_LAS __attribute__((address_space(3)))
typedef unsigned short bf16_t;
typedef short bf16x8 __attribute__((ext_vector_type(8)));
typedef float f32x4 __attribute__((ext_vector_type(4)));
typedef unsigned u32x4 __attribute__((ext_vector_type(4)));
typedef unsigned u32x2 __attribute__((ext_vector_type(2)));
constexpr int BM = 256, BK = 64, HALF = 128, HTB = HALF * BK * 2  , STAGE_BYTES = 8 * HTB, NXCD = 8, WGM = 8;

__host__ __device__ __forceinline__ int lds_byte(int r, int c) { const int st = (r >> 4) * 2 + (c >> 5), rr = r & 15, cc = c & 31, ob = rr * 64 + cc * 2; return st * 1024 + (ob ^ (((ob >> 9) & 1) << 5)); }
__host__ __device__ __forceinline__ void stage_rc(int b, int& R, int& C) { const int st = b / 1024, sb = b % 1024, swz = sb ^ (((sb >> 9) & 1) << 5); R = (st >> 1) * 16 + swz / 64; C = (st & 1) * 32 + (swz % 64) / 2; }
__host__ __device__ __forceinline__ int perm32(int rho) { const int n = rho >> 4, i = rho & 15; return 8 * (i >> 2) + 4 * n + (i & 3); }

struct Unit { int pm, pn; };
struct Gemm { const bf16_t* A; const bf16_t* Bt; int M, N, K; };

typedef int i32x4 __attribute__((ext_vector_type(4)));
typedef int i32x8 __attribute__((ext_vector_type(8)));
struct StaticOrder {
    int nM, nN, nwg, G, c, rfrom, rto, rfrom2, rto2, i0, i1, wgm;
    __host__ __device__ void init(int M, int N, int G_, int c_) { nM = M / BM; nN = N / BM; nwg = nM * nN; G = G_; c = c_; rfrom = -1; rto = -1; rfrom2 = -1; rto2 = -1; i0 = 0; i1 = 1 << 30; wgm = WGM; }
    __host__ __device__ bool next(int i, Unit& u) const {
        if (i + i0 >= i1) return false;
        const long L = (long)(i + i0) * G + c; if (L >= nwg) return false;
        int wgid = (int)L; { const int q = nwg / NXCD, r = nwg % NXCD, xcd = wgid % NXCD, off = wgid / NXCD; wgid = (xcd < r ? xcd * (q + 1) : r * (q + 1) + (xcd - r) * q) + off; }
        const int nig = wgm * nN, gid = wgid / nig, fm = gid * wgm, gsz = (nM - fm) < wgm ? (nM - fm) : wgm;
        u.pm = fm + ((wgid % nig) % gsz); u.pn = (wgid % nig) / gsz; if (u.pn == rfrom) u.pn = rto; else if (u.pn == rfrom2) u.pn = rto2; return true;
    }
    __device__ __forceinline__ void a_ready(const Unit&) const {}
    __device__ __forceinline__ void done(const Unit&) const {}
};

typedef float cvt2f_t __attribute__((ext_vector_type(2)));
typedef __bf16 cvt2b_t __attribute__((ext_vector_type(2)));
__device__ __forceinline__ unsigned cvt_pk_bf16(float lo, float hi) { const cvt2f_t f = {lo, hi}; return __builtin_bit_cast(unsigned, __builtin_convertvector(f, cvt2b_t)); }
typedef float f32x2 __attribute__((ext_vector_type(2)));
__device__ __forceinline__ float bf_lo(unsigned w) { return __uint_as_float(w << 16); }
__device__ __forceinline__ float bf_hi(unsigned w) { return __uint_as_float(w & 0xffff0000u); }
__device__ __forceinline__ unsigned cvt_pk4_fp8(float a, float b, float c, float d) { int p = __builtin_amdgcn_cvt_pk_fp8_f32(a, b, 0, false); p = __builtin_amdgcn_cvt_pk_fp8_f32(c, d, p, true); return (unsigned)p; }
__device__ __forceinline__ float sigmoidf_(float x) { return __builtin_amdgcn_rcpf(1.0f + __expf(-x)); }

struct EpiF32 {
    static constexpr bool PERM = false, AFTER_DRAIN = false;
    float* C; int ldc; int pad;
    __device__ __forceinline__ void operator()(const f32x4 (&acc)[2][2][4][2], const Unit& u, int wr, int wc, int fr, int fq) const {
        const int row0 = u.pm * BM + wr * 64 + fr, col0 = u.pn * BM + wc * 32 + 4 * fq;
#pragma unroll
        for (int ai = 0; ai < 2; ++ai)
#pragma unroll
            for (int m = 0; m < 4; ++m) { float* rowp = C + (size_t)(row0 + ai * HALF + m * 16) * ldc + col0;
#pragma unroll
                for (int bj = 0; bj < 2; ++bj)
#pragma unroll
                    for (int n = 0; n < 2; ++n) *(f32x4*)(rowp + bj * HALF + n * 16) = acc[ai][bj][m][n]; }
    }
};
struct EpiResid {
    static constexpr bool PERM = false, AFTER_DRAIN = false;
    float* C; const float* X; int ldc; float alpha;
    __device__ __forceinline__ void operator()(const f32x4 (&acc)[2][2][4][2], const Unit& u, int wr, int wc, int fr, int fq) const {
        const int row0 = u.pm * BM + wr * 64 + fr, col0 = u.pn * BM + wc * 32 + 4 * fq;
#pragma unroll
        for (int ai = 0; ai < 2; ++ai)
#pragma unroll
            for (int m = 0; m < 4; ++m) { const size_t off = (size_t)(row0 + ai * HALF + m * 16) * ldc + col0;
#pragma unroll
                for (int bj = 0; bj < 2; ++bj)
#pragma unroll
                    for (int n = 0; n < 2; ++n) { const f32x4 xv = *(const f32x4*)(X + off + bj * HALF + n * 16);
                        *(f32x4*)(C + off + bj * HALF + n * 16) = acc[ai][bj][m][n] + xv * alpha; } }
    }
};
template <int ASH = 0> struct EpiResidB {
    static constexpr bool PERM = true, AFTER_DRAIN = false;
    static constexpr float ascale = 1.0f / (float)(1 << ASH);
    bf16_t* O; int ldc; float alpha; int pad;
    __device__ __forceinline__ void operator()(const f32x4 (&acc)[2][2][4][2], const Unit& u, int wr, int wc, int fr, int fq) const {
        const int row0 = u.pm * BM + wr * 64 + fr, col0 = u.pn * BM + wc * 32 + 8 * fq;
#pragma unroll
        for (int ai = 0; ai < 2; ++ai) {
            u32x4 ow[4][2];
#pragma unroll
            for (int m = 0; m < 4; ++m)
#pragma unroll
                for (int bj = 0; bj < 2; ++bj) ow[m][bj] = *(const u32x4*)(O + (size_t)(row0 + ai * HALF + m * 16) * ldc + col0 + bj * HALF);
#pragma unroll
            for (int m = 0; m < 4; ++m) { bf16_t* rowp = O + (size_t)(row0 + ai * HALF + m * 16) * ldc + col0;
#pragma unroll
                for (int bj = 0; bj < 2; ++bj) { const u32x4 o = ow[m][bj];
                    const f32x4 a0 = acc[ai][bj][m][0], a1 = acc[ai][bj][m][1];
                    const float r0 = bf_lo(o.x) * alpha + a0[0] * ascale, r1 = bf_hi(o.x) * alpha + a0[1] * ascale, r2 = bf_lo(o.y) * alpha + a0[2] * ascale, r3 = bf_hi(o.y) * alpha + a0[3] * ascale;
                    const float r4 = bf_lo(o.z) * alpha + a1[0] * ascale, r5 = bf_hi(o.z) * alpha + a1[1] * ascale, r6 = bf_lo(o.w) * alpha + a1[2] * ascale, r7 = bf_hi(o.w) * alpha + a1[3] * ascale;
                    u32x4 w; w.x = cvt_pk_bf16(r0, r1); w.y = cvt_pk_bf16(r2, r3); w.z = cvt_pk_bf16(r4, r5); w.w = cvt_pk_bf16(r6, r7);
                    *(u32x4*)(rowp + bj * HALF) = w; } }
        }
    }
};
struct EpiProj {
    static constexpr bool PERM = true, AFTER_DRAIN = false;
    bf16_t* O; const float* bias; float* small; int ldc; int gate_lo; int small_tile; int pn_off; float ascale;
    __device__ __forceinline__ void operator()(const f32x4 (&acc)[2][2][4][2], const Unit& u, int wr, int wc, int fr, int fq) const {
        const int pn = u.pn + pn_off; const int row0 = u.pm * BM + wr * 64 + fr, col0 = pn * BM + wc * 32 + 8 * fq;
        if (pn == small_tile) {
            if (wc == 0) {
#pragma unroll
                for (int ai = 0; ai < 2; ++ai)
#pragma unroll
                    for (int m = 0; m < 4; ++m) { float* p = small + (size_t)(row0 + ai * HALF + m * 16) * 32 + 8 * fq;
                        *(f32x4*)p = acc[ai][0][m][0]; *(f32x4*)(p + 4) = acc[ai][0][m][1]; }
            }
            return;
        }
        const bool gate = pn >= gate_lo;
        f32x4 bv[2][2];
#pragma unroll
        for (int bj = 0; bj < 2; ++bj)
#pragma unroll
            for (int n = 0; n < 2; ++n) bv[bj][n] = gate ? *(const f32x4*)(bias + col0 + bj * HALF + 4 * n) : (f32x4){0.f, 0.f, 0.f, 0.f};
#pragma unroll
        for (int ai = 0; ai < 2; ++ai)
#pragma unroll
            for (int m = 0; m < 4; ++m) { bf16_t* rowp = O + (size_t)(row0 + ai * HALF + m * 16) * ldc + col0;
#pragma unroll
                for (int bj = 0; bj < 2; ++bj) { f32x4 v0 = acc[ai][bj][m][0] * ascale + bv[bj][0], v1 = acc[ai][bj][m][1] * ascale + bv[bj][1];
                    if (gate) {
#pragma unroll
                        for (int j = 0; j < 4; ++j) { v0[j] = sigmoidf_(v0[j]); v1[j] = sigmoidf_(v1[j]); } }
                    u32x4 w; w.x = cvt_pk_bf16(v0[0], v0[1]); w.y = cvt_pk_bf16(v0[2], v0[3]); w.z = cvt_pk_bf16(v1[0], v1[1]); w.w = cvt_pk_bf16(v1[2], v1[3]);
                    *(u32x4*)(rowp + bj * HALF) = w; } }
    }
};
template <int FIRST, int LASTQ = 0, int ASH = 0, int QSH = 0> struct EpiMix {
    static constexpr bool PERM = true, AFTER_DRAIN = false;
    static constexpr float ascale = 1.0f / (float)(1 << ASH), qscale = (float)(1 << QSH);
    bf16_t* O; const bf16_t* G; int ldc; int ldg; unsigned char* Q;
    __device__ __forceinline__ void operator()(const f32x4 (&acc)[2][2][4][2], const Unit& u, int wr, int wc, int fr, int fq) const {
        const int row0 = u.pm * BM + wr * 64 + fr, col0 = u.pn * BM + wc * 32 + 8 * fq;
#pragma unroll
        for (int ai = 0; ai < 2; ++ai) {
            u32x4 gwv[4][2], owv[4][2];
#pragma unroll
            for (int m = 0; m < 4; ++m)
#pragma unroll
                for (int bj = 0; bj < 2; ++bj) { const int row = row0 + ai * HALF + m * 16;
                    gwv[m][bj] = *(const u32x4*)(G + (size_t)row * ldg + col0 + bj * HALF);
                    owv[m][bj] = (u32x4){0u, 0u, 0u, 0u}; if (!FIRST) owv[m][bj] = *(const u32x4*)(O + (size_t)row * ldc + col0 + bj * HALF); }
#pragma unroll
            for (int m = 0; m < 4; ++m) { const int row = row0 + ai * HALF + m * 16; bf16_t* rowp = O + (size_t)row * ldc + col0;
#pragma unroll
                for (int bj = 0; bj < 2; ++bj) { const u32x4 gw = gwv[m][bj], ow = owv[m][bj];
                    const f32x4 a0 = acc[ai][bj][m][0] * ascale, a1 = acc[ai][bj][m][1] * ascale;
                    float r0 = bf_lo(ow.x) + bf_lo(gw.x) * a0[0], r1 = bf_hi(ow.x) + bf_hi(gw.x) * a0[1], r2 = bf_lo(ow.y) + bf_lo(gw.y) * a0[2], r3 = bf_hi(ow.y) + bf_hi(gw.y) * a0[3];
                    float r4 = bf_lo(ow.z) + bf_lo(gw.z) * a1[0], r5 = bf_hi(ow.z) + bf_hi(gw.z) * a1[1], r6 = bf_lo(ow.w) + bf_lo(gw.w) * a1[2], r7 = bf_hi(ow.w) + bf_hi(gw.w) * a1[3];
                    if constexpr (LASTQ) { *(u32x2*)(Q + (size_t)row * ldc + col0 + bj * HALF) = (u32x2){cvt_pk4_fp8(r0 * qscale, r1 * qscale, r2 * qscale, r3 * qscale), cvt_pk4_fp8(r4 * qscale, r5 * qscale, r6 * qscale, r7 * qscale)}; }
                    else { u32x4 w; w.x = cvt_pk_bf16(r0, r1); w.y = cvt_pk_bf16(r2, r3); w.z = cvt_pk_bf16(r4, r5); w.w = cvt_pk_bf16(r6, r7);
                        *(u32x4*)(rowp + bj * HALF) = w; } } }
        }
    }
};
template <class Epi, class Sched, bool ALIGN_EPI = false, bool SP2 = false, bool FP8 = false>
__device__ __forceinline__ void gemm_phase(PG8_LAS unsigned char* lds, const Gemm g, const Sched& S, const Epi& E, int tid_) {
    asm volatile("" : "+v"(tid_));
    const int tid = tid_, wid = __builtin_amdgcn_readfirstlane(tid >> 6), lane = tid & 63, wr = wid >> 2, wc = wid & 3, fr = lane & 15, fq = lane >> 4;
    const int K = g.K, nt = K / BK;
    unsigned voffA[2], voffB[2];
#pragma unroll
    for (int i = 0; i < 2; ++i) { int R, C; stage_rc(tid * 16 + i * 8192, R, C); const int Rb = Epi::PERM ? ((R & ~31) + perm32(R & 31)) : R;
        voffA[i] = (unsigned)(R * K + C) * 2u; voffB[i] = (unsigned)(Rb * K + C) * 2u; }
    const size_t kstep = (size_t)(BK * 2);
    const size_t hstep = (size_t)HALF * K * 2;
    const size_t tstep = 2 * hstep;
    const unsigned ldsw = (unsigned)wid * 1024u;
    const int aoff = lds_byte(wr * 64 + fr, fq * 8), boff = lds_byte(wc * 32 + fr, fq * 8);
#define PG8_SA(b, h) (((b) * 2 + (h)) * HTB)
#define PG8_SB(b, h) ((4 + (b) * 2 + (h)) * HTB)
#define PG8_STAGE(bufoff, gbase, voff) do { _Pragma("unroll") for (int _i = 0; _i < 2; ++_i) \
        __builtin_amdgcn_global_load_lds((const unsigned*)((const char*)(gbase) + (voff)[_i]), (PG8_LAS unsigned*)(lds + (bufoff) + ldsw + _i * 8192), 16, 0, 0); } while (0)
#define PG8_LDA(dst, b, h) do { _Pragma("unroll") for (int m = 0; m < 4; ++m) _Pragma("unroll") for (int k = 0; k < 2; ++k) dst[m][k] = *(const PG8_LAS bf16x8*)(lds + PG8_SA(b, h) + aoff + m * 2048 + k * 1024); } while (0)
#define PG8_LDB(dst, b, h) do { _Pragma("unroll") for (int n = 0; n < 2; ++n) _Pragma("unroll") for (int k = 0; k < 2; ++k) dst[n][k] = *(const PG8_LAS bf16x8*)(lds + PG8_SB(b, h) + boff + n * 2048 + k * 1024); } while (0)
#define PG8_CAT(lo, hi) ((i32x8){__builtin_bit_cast(i32x4, lo)[0], __builtin_bit_cast(i32x4, lo)[1], __builtin_bit_cast(i32x4, lo)[2], __builtin_bit_cast(i32x4, lo)[3], __builtin_bit_cast(i32x4, hi)[0], __builtin_bit_cast(i32x4, hi)[1], __builtin_bit_cast(i32x4, hi)[2], __builtin_bit_cast(i32x4, hi)[3]})
#define PG8_MMA(ai, bj, At, Bt) do { __builtin_amdgcn_s_setprio(1); _Pragma("unroll") for (int m = 0; m < 4; ++m) _Pragma("unroll") for (int n = 0; n < 2; ++n) { \
        if constexpr (FP8) { asm volatile("v_mfma_scale_f32_16x16x128_f8f6f4 %0, %1, %2, %0, %3, %3 op_sel_hi:[0,0,0]" : "+v"(acc[ai][bj][m][n]) : "v"(PG8_CAT(Bt[n][0], Bt[n][1])), "v"(PG8_CAT(At[m][0], At[m][1])), "v"(fp8_unit_scale)); } \
        else { _Pragma("unroll") for (int k = 0; k < 2; ++k) acc[ai][bj][m][n] = __builtin_amdgcn_mfma_f32_16x16x32_bf16(Bt[n][k], At[m][k], acc[ai][bj][m][n], 0, 0, 0); } } \
        __builtin_amdgcn_s_setprio(0); } while (0)
#define PG8_WAIT_V(n) asm volatile("s_waitcnt vmcnt(" #n ")" ::: "memory")
#define PG8_WAIT_L(n) asm volatile("s_waitcnt lgkmcnt(" #n ")" ::: "memory")
#define PG8_BAR __builtin_amdgcn_s_barrier()
#define PG8_SCHED __builtin_amdgcn_sched_barrier(0)
    Unit cur, nxt; int ui = 0;
    [[maybe_unused]] int fp8_unit_scale = 0x7F7F7F7F;
    if constexpr (FP8) asm volatile("" : "+v"(fp8_unit_scale));
    if (!S.next(0, cur)) return;
    f32x4 acc[2][2][4][2];
#pragma unroll
    for (int a = 0; a < 2; ++a)
#pragma unroll
        for (int b = 0; b < 2; ++b)
#pragma unroll
            for (int m = 0; m < 4; ++m)
#pragma unroll
                for (int n = 0; n < 2; ++n) acc[a][b][m][n] = (f32x4){0.f, 0.f, 0.f, 0.f};
    bf16x8 At[4][2], B0[2][2], B1[2][2];
    const char* cA = (const char*)g.A + (size_t)cur.pm * tstep; const char* cB = (const char*)g.Bt + (size_t)cur.pn * tstep;
    S.a_ready(cur);
    if constexpr (SP2) {
        PG8_STAGE(PG8_SB(0, 0), cB, voffB); PG8_STAGE(PG8_SB(0, 1), cB + hstep, voffB); PG8_STAGE(PG8_SA(0, 0), cA, voffA); PG8_STAGE(PG8_SA(0, 1), cA + hstep, voffA);
        if (wr == 1) PG8_BAR;
        PG8_WAIT_V(2); PG8_BAR;
        PG8_STAGE(PG8_SB(1, 0), cB + kstep, voffB); PG8_STAGE(PG8_SA(1, 0), cA + kstep, voffA); PG8_STAGE(PG8_SB(1, 1), cB + hstep + kstep, voffB);
        PG8_WAIT_V(6); PG8_BAR;
    } else {
        PG8_STAGE(PG8_SB(0, 0), cB, voffB); PG8_STAGE(PG8_SA(0, 0), cA, voffA); PG8_STAGE(PG8_SB(0, 1), cB + hstep, voffB); PG8_STAGE(PG8_SA(0, 1), cA + hstep, voffA);
        if (wr == 1) PG8_BAR;
        PG8_WAIT_V(4); PG8_BAR;
        PG8_STAGE(PG8_SB(1, 0), cB + kstep, voffB); PG8_STAGE(PG8_SA(1, 0), cA + kstep, voffA); PG8_STAGE(PG8_SB(1, 1), cB + hstep + kstep, voffB);
        PG8_WAIT_V(6); PG8_BAR;
    }
    for (;;) {
        const bool has_next = S.next(ui + 1, nxt);
        const char* nA = has_next ? (const char*)g.A + (size_t)nxt.pm * tstep : cA; const char* nB = has_next ? (const char*)g.Bt + (size_t)nxt.pn * tstep : cB;
        for (int t = 0; t < nt; t += 2) {
            const bool last = (t == nt - 2);
            const char* a1 = cA + (size_t)(t + 1) * kstep;
            const char* a2 = last ? nA : cA + (size_t)(t + 2) * kstep; const char* b2 = last ? nB : cB + (size_t)(t + 2) * kstep;
            const char* a3 = a2 + kstep; const char* b3 = b2 + kstep;
            if (last && has_next) S.a_ready(nxt);
            if constexpr (SP2) {
            PG8_LDB(B0, 0, 0); PG8_LDB(B1, 0, 1); PG8_SCHED; PG8_LDA(At, 0, 0); PG8_STAGE(PG8_SA(1, 1), a1 + hstep, voffA);
            PG8_WAIT_V(8); PG8_WAIT_L(0); PG8_BAR; PG8_MMA(0, 0, At, B0); PG8_MMA(0, 1, At, B1); PG8_BAR; PG8_SCHED;
            PG8_LDA(At, 0, 1); PG8_STAGE(PG8_SB(0, 0), b2, voffB); PG8_STAGE(PG8_SB(0, 1), b2 + hstep, voffB); PG8_STAGE(PG8_SA(0, 0), a2, voffA);
            PG8_WAIT_V(8); PG8_WAIT_L(0); PG8_BAR; PG8_MMA(1, 0, At, B0); PG8_MMA(1, 1, At, B1); PG8_BAR; PG8_SCHED;
            PG8_LDB(B0, 1, 0); PG8_LDB(B1, 1, 1); PG8_SCHED; PG8_LDA(At, 1, 0); PG8_STAGE(PG8_SA(0, 1), a2 + hstep, voffA);
            PG8_WAIT_V(8); PG8_WAIT_L(0); PG8_BAR; PG8_MMA(0, 0, At, B0); PG8_MMA(0, 1, At, B1); PG8_BAR; PG8_SCHED;
            PG8_LDA(At, 1, 1); PG8_STAGE(PG8_SB(1, 0), b3, voffB); PG8_STAGE(PG8_SB(1, 1), b3 + hstep, voffB); PG8_STAGE(PG8_SA(1, 0), a3, voffA);
            PG8_WAIT_V(8); PG8_WAIT_L(0); PG8_BAR; PG8_MMA(1, 0, At, B0); PG8_MMA(1, 1, At, B1); PG8_BAR; PG8_SCHED;
            } else {
            PG8_LDB(B0, 0, 0); PG8_SCHED; PG8_LDA(At, 0, 0); PG8_STAGE(PG8_SA(1, 1), a1 + hstep, voffA);
            PG8_WAIT_L(8); PG8_BAR; PG8_WAIT_L(0); PG8_MMA(0, 0, At, B0); PG8_BAR; PG8_SCHED;
            PG8_LDB(B1, 0, 1); PG8_STAGE(PG8_SB(0, 0), b2, voffB);
            PG8_BAR; PG8_WAIT_L(0); PG8_MMA(0, 1, At, B1); PG8_BAR;
            PG8_LDA(At, 0, 1); PG8_STAGE(PG8_SA(0, 0), a2, voffA);
            PG8_BAR; PG8_WAIT_L(0); PG8_MMA(1, 0, At, B0); PG8_BAR; PG8_SCHED;
            PG8_STAGE(PG8_SB(0, 1), b2 + hstep, voffB);
            PG8_WAIT_V(6); PG8_BAR; PG8_MMA(1, 1, At, B1); PG8_BAR;
            PG8_LDB(B0, 1, 0); PG8_SCHED; PG8_LDA(At, 1, 0); PG8_STAGE(PG8_SA(0, 1), a2 + hstep, voffA);
            PG8_WAIT_L(8); PG8_BAR; PG8_WAIT_L(0); PG8_MMA(0, 0, At, B0); PG8_BAR; PG8_SCHED;
            PG8_LDB(B1, 1, 1); PG8_STAGE(PG8_SB(1, 0), b3, voffB);
            PG8_BAR; PG8_WAIT_L(0); PG8_MMA(0, 1, At, B1); PG8_BAR;
            PG8_LDA(At, 1, 1); PG8_STAGE(PG8_SA(1, 0), a3, voffA);
            PG8_BAR; PG8_WAIT_L(0); PG8_MMA(1, 0, At, B0); PG8_BAR; PG8_SCHED;
            PG8_STAGE(PG8_SB(1, 1), b3 + hstep, voffB);
            PG8_WAIT_V(6); PG8_BAR; PG8_MMA(1, 1, At, B1); PG8_BAR;
            }
        }
        if constexpr (FP8) asm volatile("s_nop 15\n\ts_nop 15\n\ts_nop 15" ::: "memory");
        if constexpr (ALIGN_EPI) { if (wr == 0) PG8_BAR; }
        if constexpr (!Epi::AFTER_DRAIN) { E(acc, cur, wr, wc, fr, fq); S.done(cur); }
        if (!has_next) break;
#pragma unroll
        for (int a = 0; a < 2; ++a)
#pragma unroll
            for (int b = 0; b < 2; ++b)
#pragma unroll
                for (int m = 0; m < 4; ++m)
#pragma unroll
                    for (int n = 0; n < 2; ++n) acc[a][b][m][n] = (f32x4){0.f, 0.f, 0.f, 0.f};
        cur = nxt; cA = nA; cB = nB; ++ui;
        if constexpr (ALIGN_EPI) { if (wr == 1) PG8_BAR; }
    }
    PG8_WAIT_V(0);
    if constexpr (!ALIGN_EPI) { if (wr == 0) PG8_BAR; }
    PG8_BAR;
    if constexpr (Epi::AFTER_DRAIN) { E.fused(acc, cur, wr, wc, fr, fq, lds, wid, lane); S.done(cur); }
#undef PG8_SA
#undef PG8_SB
#undef PG8_STAGE
#undef PG8_LDA
#undef PG8_LDB
#undef PG8_MMA
#undef PG8_CAT
#undef PG8_WAIT_V
#undef PG8_WAIT_L
#undef PG8_BAR
#undef PG8_SCHED
}
}
typedef unsigned short bf16;
#define LAS __attribute__((address_space(3)))
constexpr int T_TOK = 32768, DM = 2048, SEQ = 4096, NBATCH = 8, DEPTH = 4;
constexpr int IN_COLS = 13336, NP = 13568;
constexpr int C_MQ = 0, C_MK = 512, C_MV = 1024, C_MO = 2048, C_SZ = 3072, C_SXBC = 4096, C_AQ = 5632, C_AK = 6656, C_AV = 6912, C_G = 7168, C_SMALL = 13312;
constexpr int GATE_TILE_LO = C_G / 256, SMALL_TILE = C_SMALL / 256;
constexpr float ALPHA = 1.681792830507429f;
constexpr int P_EXPERTS = 16384;

constexpr size_t MiB = 1u << 20;
constexpr size_t WS_CTL = 0, CTL_ZERO_BYTES = 64 * 1024, WS_WIN = 1 * MiB, WS_WB = 54 * MiB, WS_WO = 66 * MiB, WS_WQ = 74 * MiB, WS_BIAS = 82 * MiB, WS_SKB = 82 * MiB + 256 * 1024, WS_SMALL = 83 * MiB, WS_ROPE = 87 * MiB,
                 WS_TAB = 1480 * MiB  , WS_XB = 88 * MiB, WS_XQ = 216 * MiB  , WS_WG8 = 280 * MiB  , WS_WB8 = 306 * MiB  , WS_YQ = 312 * MiB  , WS_R1Q = 408 * MiB  , WS_WO8 = 54 * MiB  , WS_PROJ = 472 * MiB, WS_R1 = 1320 * MiB, WS_Y = 1480 * MiB, WS_R2 = 1672 * MiB, WS_HM = 1864 * MiB, WS_END = 1992 * MiB;
constexpr size_t WS_QF = WS_PROJ, WS_IDS = WS_PROJ + 256 * MiB, WS_GATES = WS_PROJ + 272 * MiB;
constexpr int CW_BAR = 4096;
constexpr int RING_BYTES = 131072, PHASE_LDS_BYTES = 155648, MISC_OFF = PHASE_LDS_BYTES + 320, LDS_BYTES = 163840;

__device__ __forceinline__ unsigned f2bf(float f) { unsigned u = __float_as_uint(f); return (u + 0x7fffu + ((u >> 16) & 1u)) >> 16; }
typedef float f32x4e_t __attribute__((ext_vector_type(4)));
typedef float pk2f_t __attribute__((ext_vector_type(2)));
typedef __bf16 pk2b_t __attribute__((ext_vector_type(2)));
__device__ __forceinline__ unsigned pk2(float lo, float hi) { const pk2f_t f = {lo, hi}; return __builtin_bit_cast(unsigned, __builtin_convertvector(f, pk2b_t)); }
__device__ __forceinline__ unsigned pk4_fp8(float a, float b, float c, float d) { int p = __builtin_amdgcn_cvt_pk_fp8_f32(a, b, 0, false); p = __builtin_amdgcn_cvt_pk_fp8_f32(c, d, p, true); return (unsigned)p; }
constexpr float ACT8_SCALE = 4.0f;
static_assert(ACT8_SCALE == 4.0f, "epilogue shifts");
constexpr float WG8_SCALE = 64.0f;
__device__ __forceinline__ float bf2f(bf16 b) { return __uint_as_float(((unsigned)b) << 16); }
__device__ __forceinline__ float sigm(float x) { return __builtin_amdgcn_rcpf(1.0f + __expf(-x)); }
__device__ __forceinline__ void halves32(float& lo, float& hi) { asm volatile("s_nop 1\n\tv_permlane32_swap_b32 %0, %1" : "+v"(lo), "+v"(hi)); }
template <int CTRL> __device__ __forceinline__ float dpp_f(float v) { return __builtin_bit_cast(float, __builtin_amdgcn_update_dpp(0, __builtin_bit_cast(int, v), CTRL, 0xF, 0xF, true)); }
__device__ __forceinline__ float quad_sum(float v) { v += dpp_f<0xB1>(v); v += dpp_f<0x4E>(v); return v; }
__device__ __forceinline__ float wave_sum(float v) {
    v = quad_sum(v); v += dpp_f<0x141>(v); v += dpp_f<0x140>(v);
    v += __builtin_bit_cast(float, __builtin_amdgcn_ds_swizzle(__builtin_bit_cast(int, v), 0x401F));
    return __builtin_bit_cast(float, __builtin_amdgcn_readlane(__builtin_bit_cast(int, v), 0)) + __builtin_bit_cast(float, __builtin_amdgcn_readlane(__builtin_bit_cast(int, v), 32));
}
__device__ __forceinline__ int src_col(int n) {
    if (n < 3072) return n;
    if (n < 5632) return n + 8;
    if (n < 13312) return n + 24;
    if (n < 13320) return 3072 + (n - 13312);
    if (n < 13336) return 5640 + (n - 13320);
    return -1;
}

#define XB_TMO      128
#define XB_XCNT(j)  (256  + 64 * (j))
#define XB_XSUB(j)  (1280 + 64 * (j))
#define XB_XGEN(j)  (2304 + 64 * (j))
#define XB_TOP      3328
#define XB_TOPGEN   3392
#define XCD_BAR_WORDS 3456
#define XB_SPIN_CAP (1u << 18)

__device__ __forceinline__ unsigned xb_ld(unsigned* p)              { return __hip_atomic_load(p, __ATOMIC_RELAXED, __HIP_MEMORY_SCOPE_AGENT); }
__device__ __forceinline__ unsigned xb_add(unsigned* p, unsigned v) { return __hip_atomic_fetch_add(p, v, __ATOMIC_RELAXED, __HIP_MEMORY_SCOPE_AGENT); }
__device__ __forceinline__ unsigned xb_xcc_id() { return (unsigned)__builtin_amdgcn_s_getreg((3 << 11) | 20) & 0xFu; }
#define XB_SPIN(cond, bar) do { unsigned _sp = 0; while (cond) { __builtin_amdgcn_s_sleep(1); \
    if ((++_sp & 255u) == 0u) { if (xb_ld(&(bar)[XB_TMO])) break; if (_sp > XB_SPIN_CAP) { atomicAdd(&(bar)[XB_TMO], 1u); break; } } } } while (0)

struct XcdBarrier {
    unsigned* bar; unsigned x;
    volatile LAS unsigned* st;
};

__device__ __forceinline__ XcdBarrier xcd_barrier_post(unsigned* bar, volatile LAS unsigned* st) {
    XcdBarrier b; b.bar = bar; b.x = xb_xcc_id(); b.st = st;
    if (threadIdx.x == 0) (void)xb_add(&bar[XB_XCNT(b.x)], 1u);
    return b;
}
__device__ __forceinline__ void xcd_barrier_complete(unsigned* bar, unsigned x, unsigned& nloc, unsigned& nx) {
    const unsigned G = gridDim.x * gridDim.y * gridDim.z;
    unsigned sum, cnt, mine, sp = 0u;
    for (;;) {
        sum = 0u; cnt = 0u; mine = 0u;
#pragma unroll
        for (unsigned j = 0; j < 16; ++j) { const unsigned c = xb_ld(&bar[XB_XCNT(j)]); sum += c; cnt += (c > 0u) ? 1u : 0u; mine = (j == x) ? c : mine; }
        if (sum == G) break;
        __builtin_amdgcn_s_sleep(1);
        if ((++sp & 255u) == 0u) { if (xb_ld(&bar[XB_TMO])) break; if (sp > XB_SPIN_CAP) { atomicAdd(&bar[XB_TMO], 1u); break; } }
    }
    nloc = mine > 0u ? mine : 1u; nx = cnt > 0u ? cnt : 1u;
}

__device__ __forceinline__ void xcd_barrier(const XcdBarrier& b) {
    asm volatile("s_waitcnt vmcnt(0)" ::: "memory");
    __syncthreads();
    if (threadIdx.x == 0) {
        unsigned* bar = b.bar;
        __builtin_amdgcn_s_waitcnt(0);
        unsigned nloc = b.st[0], nx = b.st[1];
        if (nloc == 0u) { xcd_barrier_complete(bar, b.x, nloc, nx); b.st[0] = nloc; b.st[1] = nx; }
        const unsigned old = xb_add(&bar[XB_XSUB(b.x)], 1u);
        const unsigned gen = old / nloc;
        if (old + 1u == (gen + 1u) * nloc) {
            __builtin_amdgcn_fence(__ATOMIC_RELEASE, "agent");
            asm volatile("s_waitcnt vmcnt(0)" ::: "memory");
            const unsigned og = xb_add(&bar[XB_TOP], 1u);
            const unsigned tg = og / nx;
            if (og + 1u == (tg + 1u) * nx) xb_add(&bar[XB_TOPGEN], 1u);
            else XB_SPIN(xb_ld(&bar[XB_TOPGEN]) == tg, bar);
            __builtin_amdgcn_fence(__ATOMIC_ACQUIRE, "agent");
            xb_add(&bar[XB_XGEN(b.x)], 1u);
            asm volatile("s_waitcnt vmcnt(0)" ::: "memory");
        } else {
            XB_SPIN(xb_ld(&bar[XB_XGEN(b.x)]) == gen, bar);
            __builtin_amdgcn_fence(__ATOMIC_ACQUIRE, "agent");
            asm volatile("s_waitcnt vmcnt(0)" ::: "memory");
        }
    }
    __syncthreads();
}

__device__ __forceinline__ int fresh_tid(int wave0) { int l; asm volatile("v_mbcnt_lo_u32_b32 %0, -1, 0\n\tv_mbcnt_hi_u32_b32 %0, -1, %0" : "=v"(l)); return wave0 * 64 + l; }
#define PHASE_IDS int G = gridDim.x, bx = blockIdx.x; asm volatile("" : "+s"(G), "+s"(bx)); const int tid = fresh_tid(wave0), lane = tid & 63, wave = wave0; const int gw = bx * 8 + wave, NGW = G * 8; \
    const size_t gt = (size_t)bx * 512 + tid, NGT = (size_t)G * 512; (void)lane; (void)gw; (void)gt; (void)NGW; (void)NGT; (void)wave;

template <int MODE> __device__ __forceinline__ void transpose_item(const float* __restrict__ W, int K, int ldw, int ndst, bf16* __restrict__ WT, LAS float* scr, int item, int lane, unsigned char* __restrict__ W8 = nullptr) {
    const int nblk = ndst / 32, kb = item / nblk, nb = item % nblk, k0 = 64 * kb, n0 = 32 * nb;
    const int n_l = n0 + (lane & 31); const int sc = MODE ? src_col(n_l) : n_l;
    float tv[32];
#pragma unroll
    for (int i = 0; i < 32; ++i) { const int kk = 2 * i + (lane >> 5); tv[i] = sc >= 0 ? W[(size_t)(k0 + kk) * ldw + sc] : 0.f; }
#pragma unroll
    for (int i = 0; i < 32; ++i) { const int kk = 2 * i + (lane >> 5); scr[kk * 33 + (lane & 31)] = tv[i]; }
    asm volatile("s_waitcnt lgkmcnt(0)" ::: "memory");
    const int c = lane & 7;
#pragma unroll
    for (int j = 0; j < 4; ++j) { const int n = (lane >> 3) + 8 * j; const LAS float* s = scr + (8 * c) * 33 + n;
        if (MODE == 2 || (MODE == 1 && n0 < C_SMALL))
            *(uint2*)(W8 + (size_t)(n0 + n) * K + k0 + 8 * c) = make_uint2(pk4_fp8(s[0 * 33] * WG8_SCALE, s[1 * 33] * WG8_SCALE, s[2 * 33] * WG8_SCALE, s[3 * 33] * WG8_SCALE), pk4_fp8(s[4 * 33] * WG8_SCALE, s[5 * 33] * WG8_SCALE, s[6 * 33] * WG8_SCALE, s[7 * 33] * WG8_SCALE));
        if (MODE == 2 || (MODE == 1 && n0 < C_SMALL && !(n0 >= C_AV && n0 < C_AV + 256))) continue;
        uint4 o; o.x = pk2(s[0 * 33], s[1 * 33]); o.y = pk2(s[2 * 33], s[3 * 33]); o.z = pk2(s[4 * 33], s[5 * 33]); o.w = pk2(s[6 * 33], s[7 * 33]);
        *(uint4*)(WT + (size_t)(n0 + n) * K + k0 + 8 * c) = o; }
    asm volatile("s_waitcnt lgkmcnt(0)" ::: "memory");
}

__device__ __forceinline__ void mlstm_post_tok(int t, int lane, const bf16* __restrict__ hm, const bf16* __restrict__ proj, const LAS float* norm_w  , unsigned char* __restrict__ ym  ) {
    float4 x[4], nw[4]; uint2 ov[4];
#pragma unroll
    for (int h = 0; h < 4; ++h) { const int c = h * 256 + lane * 4; { const uint2 xr = *(const uint2*)(hm + (size_t)t * 1024 + c); x[h] = make_float4(__uint_as_float(xr.x << 16), __uint_as_float(xr.x & 0xffff0000u), __uint_as_float(xr.y << 16), __uint_as_float(xr.y & 0xffff0000u)); } { const f32x4e_t q_ = *(const LAS f32x4e_t*)(norm_w + c); nw[h] = make_float4(q_[0], q_[1], q_[2], q_[3]); } ov[h] = *(const uint2*)(proj + (size_t)t * NP + C_MO + c); }
#pragma unroll
    for (int h = 0; h < 4; ++h) {
        const float mu = wave_sum((x[h].x + x[h].y) + (x[h].z + x[h].w)) * (1.0f / 256.0f);
        const float d0 = x[h].x - mu, d1 = x[h].y - mu, d2 = x[h].z - mu, d3 = x[h].w - mu;
        const float rs = rsqrtf(wave_sum((d0 * d0 + d1 * d1) + (d2 * d2 + d3 * d3)) * (1.0f / 256.0f) + 1e-6f);
        const float y0 = d0 * rs * nw[h].x * sigm(__uint_as_float(ov[h].x << 16)), y1 = d1 * rs * nw[h].y * sigm(__uint_as_float(ov[h].x & 0xffff0000u));
        const float y2 = d2 * rs * nw[h].z * sigm(__uint_as_float(ov[h].y << 16)), y3 = d3 * rs * nw[h].w * sigm(__uint_as_float(ov[h].y & 0xffff0000u));
        *(unsigned*)(ym + (size_t)t * 1024 + h * 256 + lane * 4) = pk4_fp8(y0 * ACT8_SCALE, y1 * ACT8_SCALE, y2 * ACT8_SCALE, y3 * ACT8_SCALE);
    }
}

__device__ __forceinline__ void ssd_conv_item(int item, const bf16* __restrict__ proj, const LAS float* cw  , const LAS float* cb  , bf16* __restrict__ xcb) {
    const int c8 = item % 192, tb = item / 192, t0 = tb * 8, pos0 = t0 % SEQ, c = c8 * 8;
    uint4 r[11];
#pragma unroll
    for (int j = 0; j < 11; ++j) { r[j] = make_uint4(0u, 0u, 0u, 0u); if (j >= 3 || pos0 > 0) r[j] = *(const uint4*)(proj + (size_t)(t0 - 3 + j) * NP + C_SXBC + c); }
    float w[4][8], bs[8];
#pragma unroll
    for (int j = 0; j < 4; ++j) { const f32x4e_t a = *(const LAS f32x4e_t*)(cw + j * 1536 + c), b = *(const LAS f32x4e_t*)(cw + j * 1536 + c + 4); w[j][0] = a.x; w[j][1] = a.y; w[j][2] = a.z; w[j][3] = a.w; w[j][4] = b.x; w[j][5] = b.y; w[j][6] = b.z; w[j][7] = b.w; }
    { const f32x4e_t a = *(const LAS f32x4e_t*)(cb + c), b = *(const LAS f32x4e_t*)(cb + c + 4); bs[0] = a.x; bs[1] = a.y; bs[2] = a.z; bs[3] = a.w; bs[4] = b.x; bs[5] = b.y; bs[6] = b.z; bs[7] = b.w; }
#pragma unroll
    for (int o = 0; o < 8; ++o) {
        float acc[8];
#pragma unroll
        for (int i = 0; i < 8; ++i) acc[i] = bs[i];
#pragma unroll
        for (int j = 0; j < 4; ++j) { const unsigned rw[4] = {r[o + j].x, r[o + j].y, r[o + j].z, r[o + j].w};
#pragma unroll
            for (int i = 0; i < 4; ++i) { acc[2 * i] += w[j][2 * i] * __uint_as_float(rw[i] << 16); acc[2 * i + 1] += w[j][2 * i + 1] * __uint_as_float(rw[i] & 0xffff0000u); } }
        uint4 ov; ov.x = pk2(acc[0] * sigm(acc[0]), acc[1] * sigm(acc[1])); ov.y = pk2(acc[2] * sigm(acc[2]), acc[3] * sigm(acc[3])); ov.z = pk2(acc[4] * sigm(acc[4]), acc[5] * sigm(acc[5])); ov.w = pk2(acc[6] * sigm(acc[6]), acc[7] * sigm(acc[7]));
        *(uint4*)(xcb + (size_t)(t0 + o) * 1536 + c) = ov;
    }
}
__device__ __forceinline__ void ssd_post_tok2(int tp, int lane, const bf16* __restrict__ yraw, const bf16* __restrict__ proj, const LAS float* norm_w  , unsigned char* __restrict__ ys  ) {
    uint4 yr[4]; uint4 zv[4];
#pragma unroll
    for (int i = 0; i < 4; ++i) { const int t = 2 * tp + (i >> 1), c = (i & 1) * 512 + lane * 8; yr[i] = *(const uint4*)(yraw + (size_t)t * 1024 + c); zv[i] = *(const uint4*)(proj + (size_t)t * NP + C_SZ + c); }
#pragma unroll
    for (int i = 0; i < 4; ++i) { const int t = 2 * tp + (i >> 1), c = (i & 1) * 512 + lane * 8;
        const float yv[8] = {__uint_as_float(yr[i].x << 16), __uint_as_float(yr[i].x & 0xffff0000u), __uint_as_float(yr[i].y << 16), __uint_as_float(yr[i].y & 0xffff0000u), __uint_as_float(yr[i].z << 16), __uint_as_float(yr[i].z & 0xffff0000u), __uint_as_float(yr[i].w << 16), __uint_as_float(yr[i].w & 0xffff0000u)}; const unsigned zw[4] = {zv[i].x, zv[i].y, zv[i].z, zv[i].w};
        float y[8], ss = 0.f;
#pragma unroll
        for (int k = 0; k < 4; ++k) { const float z0 = __uint_as_float(zw[k] << 16), z1 = __uint_as_float(zw[k] & 0xffff0000u); y[2 * k] = yv[2 * k] * (z0 * sigm(z0)); y[2 * k + 1] = yv[2 * k + 1] * (z1 * sigm(z1)); ss += y[2 * k] * y[2 * k] + y[2 * k + 1] * y[2 * k + 1]; }
        const float rs = rsqrtf(wave_sum(ss) * (1.0f / 512.0f) + 1e-6f);
        const f32x4e_t n0q = *(const LAS f32x4e_t*)(norm_w + c), n1q = *(const LAS f32x4e_t*)(norm_w + c + 4); const float4 n0 = make_float4(n0q[0], n0q[1], n0q[2], n0q[3]), n1 = make_float4(n1q[0], n1q[1], n1q[2], n1q[3]);
        { const float r4 = rs * ACT8_SCALE; *(uint2*)(ys + (size_t)t * 1024 + c) = make_uint2(pk4_fp8(y[0] * r4 * n0.x, y[1] * r4 * n0.y, y[2] * r4 * n0.z, y[3] * r4 * n0.w), pk4_fp8(y[4] * r4 * n1.x, y[5] * r4 * n1.y, y[6] * r4 * n1.z, y[7] * r4 * n1.w)); }
    }
}

__device__ __forceinline__ void ln_body2(int tp, int lane, const float* in, const float* __restrict__ g, const float* __restrict__ bta, float* outf, bf16* __restrict__ outb) {
    float4 v[2][8];
#pragma unroll
    for (int r = 0; r < 2; ++r)
#pragma unroll
        for (int j = 0; j < 8; ++j) v[r][j] = *(const float4*)(in + (size_t)(2 * tp + r) * DM + j * 256 + lane * 4);
    { int z_ = 0; asm volatile("" : "+s"(z_)); g += z_; bta += z_; }
#pragma unroll
    for (int r = 0; r < 2; ++r) {
        const int t = 2 * tp + r; float s = 0.f;
#pragma unroll
        for (int j = 0; j < 8; ++j) s += (v[r][j].x + v[r][j].y) + (v[r][j].z + v[r][j].w);
        const float mu = wave_sum(s) * (1.0f / DM); float q = 0.f;
#pragma unroll
        for (int j = 0; j < 8; ++j) { v[r][j].x -= mu; v[r][j].y -= mu; v[r][j].z -= mu; v[r][j].w -= mu; q += (v[r][j].x * v[r][j].x + v[r][j].y * v[r][j].y) + (v[r][j].z * v[r][j].z + v[r][j].w * v[r][j].w); }
        const float rs = rsqrtf(wave_sum(q) * (1.0f / DM) + 1e-5f);
#pragma unroll
        for (int j = 0; j < 8; ++j) { const int c = j * 256 + lane * 4; const float4 gg = *(const float4*)(g + c), bb = *(const float4*)(bta + c);
            float4 y; y.x = v[r][j].x * rs * gg.x + bb.x; y.y = v[r][j].y * rs * gg.y + bb.y; y.z = v[r][j].z * rs * gg.z + bb.z; y.w = v[r][j].w * rs * gg.w + bb.w;
            *(float4*)(outf + (size_t)t * DM + c) = y; *(uint2*)(outb + (size_t)t * DM + c) = make_uint2(pk2(y.x, y.y), pk2(y.z, y.w)); }
    }
}

__device__ __forceinline__ void ln_body2b(int tp, int lane, bf16* xb, const LAS float* g  , const LAS float* bta  ) {
    uint4 v[2][4];
#pragma unroll
    for (int r = 0; r < 2; ++r)
#pragma unroll
        for (int j = 0; j < 4; ++j) v[r][j] = *(const uint4*)(xb + (size_t)(2 * tp + r) * DM + j * 512 + lane * 8);
#pragma unroll
    for (int r = 0; r < 2; ++r) {
        const int t = 2 * tp + r; float f[32]; float s = 0.f;
#pragma unroll
        for (int j = 0; j < 4; ++j) { const unsigned w4[4] = {v[r][j].x, v[r][j].y, v[r][j].z, v[r][j].w};
#pragma unroll
            for (int k = 0; k < 4; ++k) { f[8 * j + 2 * k] = __uint_as_float(w4[k] << 16); f[8 * j + 2 * k + 1] = __uint_as_float(w4[k] & 0xffff0000u); } }
#pragma unroll
        for (int i = 0; i < 32; i += 4) s += (f[i] + f[i + 1]) + (f[i + 2] + f[i + 3]);
        const float mu = wave_sum(s) * (1.0f / DM); float q = 0.f;
#pragma unroll
        for (int i = 0; i < 32; ++i) { f[i] -= mu; q += f[i] * f[i]; }
        const float rs = rsqrtf(wave_sum(q) * (1.0f / DM) + 1e-5f);
#pragma unroll
        for (int j = 0; j < 4; ++j) { const int c = j * 512 + lane * 8; const f32x4e_t g0 = *(const LAS f32x4e_t*)(g + c), g1 = *(const LAS f32x4e_t*)(g + c + 4), b0 = *(const LAS f32x4e_t*)(bta + c), b1 = *(const LAS f32x4e_t*)(bta + c + 4);
            *(uint4*)(xb + (size_t)t * DM + c) = make_uint4(pk2(f[8 * j] * rs * g0.x + b0.x, f[8 * j + 1] * rs * g0.y + b0.y), pk2(f[8 * j + 2] * rs * g0.z + b0.z, f[8 * j + 3] * rs * g0.w + b0.w),
                                                            pk2(f[8 * j + 4] * rs * g1.x + b1.x, f[8 * j + 5] * rs * g1.y + b1.y), pk2(f[8 * j + 6] * rs * g1.z + b1.z, f[8 * j + 7] * rs * g1.w + b1.w)); }
    }
}

__device__ __forceinline__ float gelu_erf(float v) {
    const float av = fabsf(v), t = __builtin_amdgcn_rcpf(av * 0.2316418882f + 1.0f);
    float q = t * 0.5307027145f + (-0.7265760135f); q = q * t + 0.7107068705f; q = q * t + (-0.142248368f); q = q * t + 0.127414796f; q = q * t;
    const float e = __builtin_amdgcn_exp2f((v * v) * (-0.72134752044f));
    const float mm = v * (q * e), r = v - mm;
    return v < 0.f ? mm : r;
}
typedef unsigned u32x4e_t __attribute__((ext_vector_type(4)));
typedef float f32x4e_t __attribute__((ext_vector_type(4)));
typedef unsigned u32x2e_t __attribute__((ext_vector_type(2)));
constexpr float U6_SCALE = 80.0f, V4_SCALE = 16.0f;
constexpr int ROW4 = DM / 2;
constexpr int ROW6 = DM * 6 / 8;
typedef float v32f_t __attribute__((ext_vector_type(32)));
typedef float f32x2_t __attribute__((ext_vector_type(2)));
typedef __bf16 v32b_t __attribute__((ext_vector_type(32)));
typedef unsigned v6u_t __attribute__((ext_vector_type(6)));
typedef __bf16 v2b_t __attribute__((ext_vector_type(2)));
__device__ __forceinline__ void tab_to_fp6(size_t i, const float* __restrict__ src, unsigned char* __restrict__ dst, float sc) {
    const float4* s = (const float4*)src + i * 8; v32b_t b;
#pragma unroll
    for (int j = 0; j < 8; ++j) { const float4 v = s[j]; b[4 * j] = (__bf16)(v.x * sc); b[4 * j + 1] = (__bf16)(v.y * sc); b[4 * j + 2] = (__bf16)(v.z * sc); b[4 * j + 3] = (__bf16)(v.w * sc); }
    const v6u_t p = __builtin_amdgcn_cvt_scalef32_pk32_fp6_bf16(b, 1.0f);
    uint2* d = (uint2*)(dst + i * 24); d[0] = make_uint2(p[0], p[1]); d[1] = make_uint2(p[2], p[3]); d[2] = make_uint2(p[4], p[5]);
}
__device__ __forceinline__ void tab_to_fp4(size_t i, const float* __restrict__ src, unsigned char* __restrict__ dst, float sc) {
    const float4* s = (const float4*)src + i * 8; unsigned w[4];
#pragma unroll
    for (int j = 0; j < 4; ++j) { const float4 a = s[2 * j], b = s[2 * j + 1]; unsigned x = 0u;
        x = __builtin_amdgcn_cvt_scalef32_pk_fp4_f32(x, a.x * sc, a.y * sc, 1.0f, 0); x = __builtin_amdgcn_cvt_scalef32_pk_fp4_f32(x, a.z * sc, a.w * sc, 1.0f, 1);
        x = __builtin_amdgcn_cvt_scalef32_pk_fp4_f32(x, b.x * sc, b.y * sc, 1.0f, 2); x = __builtin_amdgcn_cvt_scalef32_pk_fp4_f32(x, b.z * sc, b.w * sc, 1.0f, 3); w[j] = x; }
    *(uint4*)(dst + i * 16) = make_uint4(w[0], w[1], w[2], w[3]);
}
__device__ __forceinline__ void tab_fp4_store(const float4 (&q)[4], unsigned char* __restrict__ dst8, float sc) {
    unsigned w[2];
#pragma unroll
    for (int j = 0; j < 2; ++j) { const float4 a = q[2 * j], b = q[2 * j + 1]; unsigned x = 0u;
        x = __builtin_amdgcn_cvt_scalef32_pk_fp4_f32(x, a.x * sc, a.y * sc, 1.0f, 0); x = __builtin_amdgcn_cvt_scalef32_pk_fp4_f32(x, a.z * sc, a.w * sc, 1.0f, 1);
        x = __builtin_amdgcn_cvt_scalef32_pk_fp4_f32(x, b.x * sc, b.y * sc, 1.0f, 2); x = __builtin_amdgcn_cvt_scalef32_pk_fp4_f32(x, b.z * sc, b.w * sc, 1.0f, 3); w[j] = x; }
    *(uint2*)dst8 = make_uint2(w[0], w[1]);
}
constexpr int TAB_PER_WG = (P_EXPERTS * (DM / 32)) / 128;
__device__ __forceinline__ void peer_expert_body(int t, int lane, bool last, const int* __restrict__ ids, const float* __restrict__ gates, const unsigned char* __restrict__ U6, const unsigned char* __restrict__ V6,
                                                 const LAS float* gl  , const LAS float* bl  , float* __restrict__ outf, bf16* outb  , unsigned char* __restrict__ outq  , LAS unsigned* wl  ) {
    asm volatile("" : "+v"(lane));
    int idA = ids[(size_t)t * 128 + lane], idB = ids[(size_t)t * 128 + 64 + lane]; float gA = gates[(size_t)t * 128 + lane], gB = gates[(size_t)t * 128 + 64 + lane];
    {
        const unsigned kA = ((unsigned)idA << 7) | (unsigned)lane, kB = ((unsigned)idB << 7) | (unsigned)(64 + lane);
        wl[lane] = kA; wl[64 + lane] = kB;
        asm volatile("s_waitcnt lgkmcnt(0)" ::: "memory");
        int rA = 0, rB = 0;
#pragma unroll 8
        for (int j = 0; j < 128; j += 4) { const u32x4e_t k4 = *(const LAS u32x4e_t*)(wl + j);
#pragma unroll
            for (int q = 0; q < 4; ++q) { rA += (k4[q] < kA) ? 1 : 0; rB += (k4[q] < kB) ? 1 : 0; } }
        asm volatile("s_waitcnt lgkmcnt(0)" ::: "memory");
        wl[128 + rA] = (unsigned)idA; wl[256 + rA] = __float_as_uint(gA); wl[128 + rB] = (unsigned)idB; wl[256 + rB] = __float_as_uint(gB);
        asm volatile("s_waitcnt lgkmcnt(0)" ::: "memory");
        idA = (int)wl[128 + lane]; idB = (int)wl[192 + lane]; gA = __uint_as_float(wl[256 + lane]); gB = __uint_as_float(wl[320 + lane]);
        asm volatile("s_waitcnt lgkmcnt(0)" ::: "memory");
    }
#define ID_OF(e_) __builtin_amdgcn_readlane((e_) < 64 ? idA : idB, (e_) & 63)
#define GATE_OF(e_) __builtin_bit_cast(float, __builtin_amdgcn_readlane(__builtin_bit_cast(int, (e_) < 64 ? gA : gB), (e_) & 63))
    uint4 ra[8], rb[8];
#define ROW_LOAD(R_, T_, e_) do { _Pragma("unroll") for (int k_ = 0; k_ < 8; ++k_) { const int id_ = ID_OF((e_) + k_); R_[k_] = *((const uint4*)((T_) + (size_t)id_ * ROW4) + lane); } } while (0)
#define V4_PAIR(D_, W_, j_, b_) do { const f32x2_t t_ = __builtin_amdgcn_cvt_scalef32_pk_f32_fp4(W_, 1.0f, b_); D_[8 * (j_) + 2 * (b_)] = t_.x; D_[8 * (j_) + 2 * (b_) + 1] = t_.y; } while (0)
#define V4_DWORD(D_, W_, j_) do { V4_PAIR(D_, W_, j_, 0); V4_PAIR(D_, W_, j_, 1); V4_PAIR(D_, W_, j_, 2); V4_PAIR(D_, W_, j_, 3); } while (0)
#define UDOT4(W_, j_) do { a_ = __builtin_amdgcn_fdot2_f32_bf16(__builtin_amdgcn_cvt_scalef32_pk_bf16_fp4(W_, 1.0f, 0), __builtin_bit_cast(v2b_t, xb[4 * (j_)]), a_, false); \
        b_ = __builtin_amdgcn_fdot2_f32_bf16(__builtin_amdgcn_cvt_scalef32_pk_bf16_fp4(W_, 1.0f, 1), __builtin_bit_cast(v2b_t, xb[4 * (j_) + 1]), b_, false); \
        a_ = __builtin_amdgcn_fdot2_f32_bf16(__builtin_amdgcn_cvt_scalef32_pk_bf16_fp4(W_, 1.0f, 2), __builtin_bit_cast(v2b_t, xb[4 * (j_) + 2]), a_, false); \
        b_ = __builtin_amdgcn_fdot2_f32_bf16(__builtin_amdgcn_cvt_scalef32_pk_bf16_fp4(W_, 1.0f, 3), __builtin_bit_cast(v2b_t, xb[4 * (j_) + 3]), b_, false); } while (0)
#define DEC4(D_, R_) do { V4_DWORD(D_, R_.x, 0); V4_DWORD(D_, R_.y, 1); V4_DWORD(D_, R_.z, 2); V4_DWORD(D_, R_.w, 3); } while (0)
#define PK6(W_) ((v6u_t){W_[0].x, W_[0].y, W_[1].x, W_[1].y, W_[2].x, W_[2].y})
#define SB_ __builtin_amdgcn_sched_barrier(0)
    float c0 = 0.f, c1 = 0.f;
    unsigned xb[16];
    {
#pragma unroll
        for (int i = 0; i < 4; ++i) { const uint4 v = *(const uint4*)(outb + (size_t)t * DM + lane * 32 + i * 8); xb[4 * i] = v.x; xb[4 * i + 1] = v.y; xb[4 * i + 2] = v.z; xb[4 * i + 3] = v.w; }
#define U_COMP(R_, e_) do { float p_[8]; _Pragma("unroll") for (int k_ = 0; k_ < 8; ++k_) { SB_; float a_ = 0.f, b_ = 0.f; UDOT4(R_[k_].x, 0); UDOT4(R_[k_].y, 1); UDOT4(R_[k_].z, 2); UDOT4(R_[k_].w, 3); p_[k_] = a_ + b_; } SB_; \
        { const bool o1_ = lane & 1, o2_ = lane & 2, o4_ = lane & 4; float w_[4], u_[2]; \
          _Pragma("unroll") for (int j_ = 0; j_ < 4; ++j_) { const float keep_ = o1_ ? p_[2 * j_ + 1] : p_[2 * j_], send_ = o1_ ? p_[2 * j_] : p_[2 * j_ + 1]; w_[j_] = keep_ + dpp_f<0xB1>(send_); } \
          _Pragma("unroll") for (int j_ = 0; j_ < 2; ++j_) { const float keep_ = o2_ ? w_[2 * j_ + 1] : w_[2 * j_], send_ = o2_ ? w_[2 * j_] : w_[2 * j_ + 1]; u_[j_] = keep_ + dpp_f<0x4E>(send_); } \
          float s_; { const float keep_ = o4_ ? u_[1] : u_[0], send_ = o4_ ? u_[0] : u_[1]; s_ = keep_ + __builtin_bit_cast(float, __builtin_amdgcn_ds_swizzle(__builtin_bit_cast(int, send_), 0x101F)); } \
          s_ += __builtin_bit_cast(float, __builtin_amdgcn_ds_swizzle(__builtin_bit_cast(int, s_), 0x201F)); s_ += __builtin_bit_cast(float, __builtin_amdgcn_ds_swizzle(__builtin_bit_cast(int, s_), 0x401F)); \
          { float lo_ = s_, hi_ = s_; halves32(lo_, hi_); s_ = lo_ + hi_; } \
          s_ *= (1.0f / U6_SCALE); const float ge_ = gelu_erf(s_) * (1.0f / V4_SCALE); \
          const bool in_ = ((lane ^ (e_)) & 56) == 0;              \
          if ((e_) < 64) c0 = in_ ? gA * ge_ : c0; else c1 = in_ ? gB * ge_ : c1; } } while (0)
        ROW_LOAD(ra, U6, 0);
#pragma nounroll
        for (int e = 0; e < 128; e += 16) {
            ROW_LOAD(rb, U6, e + 8);
            U_COMP(ra, e);
            if (e + 16 < 128) ROW_LOAD(ra, U6, e + 16);
            U_COMP(rb, e + 8);
        }
#undef U_COMP
    }
    v32f_t acc;
#pragma unroll
    for (int i = 0; i < 32; ++i) acc[i] = 0.f;
#define V_COMP(R_, e_) do { _Pragma("unroll") for (int k_ = 0; k_ < 8; ++k_) { SB_; const int ee_ = (e_) + k_; \
            const float cv_ = __builtin_bit_cast(float, __builtin_amdgcn_readlane(__builtin_bit_cast(int, ee_ < 64 ? c0 : c1), ee_ & 63)); \
            v32f_t d_; DEC4(d_, R_[k_]); acc += d_ * cv_; } SB_; } while (0)
    ROW_LOAD(ra, V6, 0);
#pragma nounroll
    for (int e = 0; e < 128; e += 16) {
        ROW_LOAD(rb, V6, e + 8);
        V_COMP(ra, e);
        if (e + 16 < 128) ROW_LOAD(ra, V6, e + 16);
        V_COMP(rb, e + 8);
    }
#undef V_COMP
#undef ID_OF
#undef GATE_OF
#undef ROW_LOAD
#undef PK6
#undef V4_PAIR
#undef V4_DWORD
#undef DEC4
#undef UDOT4
#undef SB_
    float s = 0.f;
#pragma unroll
    for (int i = 0; i < 16; ++i) { acc[2 * i] += ALPHA * __uint_as_float(xb[i] << 16); acc[2 * i + 1] += ALPHA * __uint_as_float(xb[i] & 0xffff0000u); }
#pragma unroll
    for (int i = 0; i < 32; ++i) s += acc[i];
    const float mu = wave_sum(s) * (1.0f / DM); float q = 0.f;
#pragma unroll
    for (int i = 0; i < 32; ++i) { acc[i] -= mu; q += acc[i] * acc[i]; }
    const float rs = rsqrtf(wave_sum(q) * (1.0f / DM) + 1e-5f);
#pragma unroll
    for (int i = 0; i < 8; i += 2) { const int c = lane * 32 + i * 4; float y[8];
#pragma unroll
        for (int h = 0; h < 2; ++h) { const f32x4e_t gq = *(const LAS f32x4e_t*)(gl + ((i + h) * 64 + lane) * 4), bq = *(const LAS f32x4e_t*)(bl + ((i + h) * 64 + lane) * 4);
#pragma unroll
            for (int k = 0; k < 4; ++k) y[4 * h + k] = acc[4 * (i + h) + k] * rs * gq[k] + bq[k]; }
        if (last) { *(float4*)(outf + (size_t)t * DM + c) = make_float4(y[0], y[1], y[2], y[3]); *(float4*)(outf + (size_t)t * DM + c + 4) = make_float4(y[4], y[5], y[6], y[7]); }
        else { *(uint4*)(outb + (size_t)t * DM + c) = make_uint4(pk2(y[0], y[1]), pk2(y[2], y[3]), pk2(y[4], y[5]), pk2(y[6], y[7])); *(uint2*)(outq + (size_t)t * DM + c) = make_uint2(pk4_fp8(y[0], y[1], y[2], y[3]), pk4_fp8(y[4], y[5], y[6], y[7])); } }
}

typedef short bf16x8_t __attribute__((ext_vector_type(8)));
typedef float f32x4_t __attribute__((ext_vector_type(4)));
typedef unsigned u32x2_t __attribute__((ext_vector_type(2)));
typedef unsigned u32x4_t __attribute__((ext_vector_type(4)));
constexpr int SWA_PITCH = 144;
constexpr int SWA_KS = 0, SWA_VS = 256 * SWA_PITCH, SWA_LDS = 2 * 256 * SWA_PITCH;
static_assert(SWA_LDS <= RING_BYTES, "SWA LDS");
__device__ __forceinline__ float grp4_max(float v) {
    v = fmaxf(v, __builtin_bit_cast(float, __builtin_amdgcn_ds_swizzle(__builtin_bit_cast(int, v), 0x401F)));
    float lo = v, hi = v; halves32(lo, hi);
    return fmaxf(lo, hi);
}
__device__ __forceinline__ float grp4_sum(float v) {
    v += __builtin_bit_cast(float, __builtin_amdgcn_ds_swizzle(__builtin_bit_cast(int, v), 0x401F));
    float lo = v, hi = v; halves32(lo, hi);
    return lo + hi;
}
__device__ __forceinline__ void tr_read2(unsigned a0, unsigned a1, u32x2_t& r0, u32x2_t& r1) {
    asm volatile("ds_read_b64_tr_b16 %0, %2\n\tds_read_b64_tr_b16 %1, %3\n\ts_waitcnt lgkmcnt(0)" : "=&v"(r0), "=&v"(r1) : "v"(a0), "v"(a1) : "memory");
}
__device__ __forceinline__ void rope8(uint4& lo, uint4& hi, const float4* cs, float scale) {
    unsigned* a = (unsigned*)&lo; unsigned* b = (unsigned*)&hi;
#pragma unroll
    for (int j = 0; j < 4; ++j) {
        const float x1a = __uint_as_float(a[j] << 16), x1b = __uint_as_float(a[j] & 0xffff0000u), x2a = __uint_as_float(b[j] << 16), x2b = __uint_as_float(b[j] & 0xffff0000u);
        const float4 c = cs[j];
        const float y1a = (x1a * c.x - x2a * c.y) * scale, y2a = (x2a * c.x + x1a * c.y) * scale, y1b = (x1b * c.z - x2b * c.w) * scale, y2b = (x2b * c.z + x1b * c.w) * scale;
        a[j] = pk2(y1a, y1b); b[j] = pk2(y2a, y2b);
    }
}
__device__ __forceinline__ void swa_phase(LAS unsigned char* lds, const bf16* __restrict__ proj, const float* __restrict__ rtab  , const float* __restrict__ sinks, unsigned char* __restrict__ ya  ,
                                          int tid, int bx, int G) {
    const int lane = tid & 63, w = __builtin_amdgcn_readfirstlane(tid >> 6), l15 = lane & 15, g4 = lane >> 4;
    const unsigned ldsb = (unsigned)(size_t)lds;
    constexpr int NSWA = NBATCH * 32 * 4, NSWA_LO = NSWA * 4 / 8;
    const int hb = G >> 1; int u0 = bx, u1 = NSWA, ust = G;
    if (hb > 0) { if (bx < hb) { u1 = NSWA_LO; ust = hb; } else { u0 = NSWA_LO + bx - hb; ust = G - hb; } }
    uint4 klo[2], khi[2], vv[4]; float4 kcs[2][4];
#define SWA_LOAD(u_) do { const int kvh_ = (u_) & 3, nb_ = ((u_) >> 2) & 31, b_ = (u_) >> 7, t0_ = b_ * SEQ + nb_ * 128; \
        _Pragma("unroll") for (int i_ = 0; i_ < 2; ++i_) { const int it_ = tid + 512 * i_, kk_ = it_ >> 2, c_ = it_ & 3; klo[i_] = make_uint4(0u, 0u, 0u, 0u); khi[i_] = klo[i_]; \
            _Pragma("unroll") for (int j_ = 0; j_ < 4; ++j_) kcs[i_][j_] = make_float4(0.f, 0.f, 0.f, 0.f); \
            if (nb_ > 0 || kk_ >= 128) { const bf16* src_ = proj + (size_t)(t0_ - 128 + kk_) * NP + C_AK + kvh_ * 64 + 8 * c_; klo[i_] = *(const uint4*)src_; khi[i_] = *(const uint4*)(src_ + 32); \
                const float4* cs_ = (const float4*)(rtab + ((size_t)(nb_ * 128 - 128 + kk_) * 32 + 8 * c_) * 2); kcs[i_][0] = cs_[0]; kcs[i_][1] = cs_[1]; kcs[i_][2] = cs_[2]; kcs[i_][3] = cs_[3]; } } \
        _Pragma("unroll") for (int i_ = 0; i_ < 4; ++i_) { const int it_ = tid + 512 * i_, kk_ = it_ >> 3, c_ = it_ & 7; vv[i_] = make_uint4(0u, 0u, 0u, 0u); \
            if (nb_ > 0 || kk_ >= 128) vv[i_] = *(const uint4*)(proj + (size_t)(t0_ - 128 + kk_) * NP + C_AV + kvh_ * 64 + 8 * c_); } } while (0)
#define SWA_STORE() do { \
        _Pragma("unroll") for (int i_ = 0; i_ < 2; ++i_) { const int it_ = tid + 512 * i_, kk_ = it_ >> 2, c_ = it_ & 3; uint4 lo_ = klo[i_], hi_ = khi[i_]; rope8(lo_, hi_, kcs[i_], 1.0f);     \
            *(LAS u32x4_t*)(lds + SWA_KS + kk_ * SWA_PITCH + 16 * c_) = __builtin_bit_cast(u32x4_t, lo_); *(LAS u32x4_t*)(lds + SWA_KS + kk_ * SWA_PITCH + 64 + 16 * c_) = __builtin_bit_cast(u32x4_t, hi_); } \
        _Pragma("unroll") for (int i_ = 0; i_ < 4; ++i_) { const int it_ = tid + 512 * i_, kk_ = it_ >> 3, c_ = it_ & 7; *(LAS u32x4_t*)(lds + SWA_VS + kk_ * SWA_PITCH + 16 * c_) = __builtin_bit_cast(u32x4_t, vv[i_]); } } while (0)
    if (u0 < u1) SWA_LOAD(u0);
    for (int u = u0; u < u1; u += ust) {
        const int kvh = u & 3, nb = (u >> 2) & 31, b = u >> 7;
        const int t0 = b * SEQ + nb * 128;
        const int r = w >> 1, hf = w & 1, hq = kvh * 4 + r;
        uint4 nqlo, nqhi; float4 nqcs[4];
#define SWA_QLOAD(qt_) do { const int iq_ = 64 * hf + 16 * (qt_) + l15; const bf16* src_ = proj + (size_t)(t0 + iq_) * NP + C_AQ + hq * 64 + 8 * g4; nqlo = *(const uint4*)src_; nqhi = *(const uint4*)(src_ + 32); \
            const float4* cs_ = (const float4*)(rtab + ((size_t)(nb * 128 + iq_) * 32 + 8 * g4) * 2); nqcs[0] = cs_[0]; nqcs[1] = cs_[1]; nqcs[2] = cs_[2]; nqcs[3] = cs_[3]; } while (0)
        SWA_QLOAD(0);
        __syncthreads();
        SWA_STORE();
        if (u + ust < u1) SWA_LOAD(u + ust);
        __syncthreads();
        const float sink = sinks[hq];
#pragma nounroll
        for (int qt = 0; qt < 4; ++qt) {
            const int i0 = 64 * hf + 16 * qt, iq = i0 + l15, tq = t0 + iq, ktb0 = 4 * hf + qt;
            bf16x8_t q0, q1;
            { uint4 lo = nqlo, hi = nqhi; rope8(lo, hi, nqcs, 0.125f); q0 = __builtin_bit_cast(bf16x8_t, lo); q1 = __builtin_bit_cast(bf16x8_t, hi); }
            if (qt + 1 < 4) SWA_QLOAD(qt + 1);
            f32x4_t s[9]; float m = sink; const int d0 = 4 * g4 - l15;
#pragma unroll
            for (int n = 0; n < 9; ++n) {
                const LAS unsigned char* kp = lds + SWA_KS + (16 * (ktb0 + n) + l15) * SWA_PITCH + 16 * g4;
                const bf16x8_t a0 = *(const LAS bf16x8_t*)kp, a1 = *(const LAS bf16x8_t*)(kp + 64);
                f32x4_t acc = (f32x4_t){0.f, 0.f, 0.f, 0.f};
                acc = __builtin_amdgcn_mfma_f32_16x16x32_bf16(a0, q0, acc, 0, 0, 0);
                acc = __builtin_amdgcn_mfma_f32_16x16x32_bf16(a1, q1, acc, 0, 0, 0);
                const bool tv = (nb > 0) || (ktb0 + n >= 8);
#pragma unroll
                for (int e = 0; e < 4; ++e) { const bool ok = tv && (n == 0 ? (d0 + e >= 1) : n == 8 ? (d0 + e <= 0) : true);
                    acc[e] = ok ? acc[e] : -1e30f; m = fmaxf(m, acc[e]); }
                s[n] = acc;
            }
            m = grp4_max(m);
            float lsum = 0.f;
#pragma unroll
            for (int n = 0; n < 9; ++n)
#pragma unroll
                for (int e = 0; e < 4; ++e) { const float p = __expf(s[n][e] - m); s[n][e] = p; lsum += p; }
            lsum = grp4_sum(lsum) + __expf(sink - m);
            const float inv = __builtin_amdgcn_rcpf(lsum);
            bf16x8_t pf[5];
#pragma unroll
            for (int pi = 0; pi < 4; ++pi) { uint4 w4; w4.x = pk2(s[2 * pi][0], s[2 * pi][1]); w4.y = pk2(s[2 * pi][2], s[2 * pi][3]); w4.z = pk2(s[2 * pi + 1][0], s[2 * pi + 1][1]); w4.w = pk2(s[2 * pi + 1][2], s[2 * pi + 1][3]);
                pf[pi] = __builtin_bit_cast(bf16x8_t, w4); }
            { uint4 w4; w4.x = pk2(s[8][0], s[8][1]); w4.y = pk2(s[8][2], s[8][3]); w4.z = 0u; w4.w = 0u; pf[4] = __builtin_bit_cast(bf16x8_t, w4); }
            const int qq = l15 >> 2, pp = lane & 3;
#pragma unroll
            for (int dt = 0; dt < 4; ++dt) {
                f32x4_t o = (f32x4_t){0.f, 0.f, 0.f, 0.f};
#pragma unroll
                for (int pi = 0; pi < 5; ++pi) {
                    const int ka = (ktb0 + 2 * pi) < 15 ? (ktb0 + 2 * pi) : 15, kb = (ktb0 + 2 * pi + 1) < 15 ? (ktb0 + 2 * pi + 1) : 15;
                    u32x2_t v0, v1;
                    tr_read2(ldsb + SWA_VS + (16 * ka + 4 * g4 + qq) * SWA_PITCH + (16 * dt + 4 * pp) * 2, ldsb + SWA_VS + (16 * kb + 4 * g4 + qq) * SWA_PITCH + (16 * dt + 4 * pp) * 2, v0, v1);
                    const uint4 av = make_uint4(v0.x, v0.y, v1.x, v1.y);
                    o = __builtin_amdgcn_mfma_f32_16x16x32_bf16(__builtin_bit_cast(bf16x8_t, av), pf[pi], o, 0, 0, 0);
                }
                { const float i4 = inv * ACT8_SCALE; *(unsigned*)(ya + (size_t)tq * 1024 + hq * 64 + 16 * dt + 4 * g4) = pk4_fp8(o[0] * i4, o[1] * i4, o[2] * i4, o[3] * i4); }
            }
        }
    }
#undef SWA_LOAD
#undef SWA_STORE
#undef SWA_QLOAD
}

constexpr size_t WS_MG = WS_R1 + 128 * MiB, WS_MEG = WS_MG + 2 * MiB, WS_SG = WS_MG + 3 * MiB, WS_SEA = WS_SG + 8 * MiB;
__device__ __forceinline__ void mlstm_gate_item(int item, int lane, LAS float* wl, const float* __restrict__ small, const float* __restrict__ gate_b, float4* __restrict__ mg, float* __restrict__ meg) {
    const int ch = item & 63, h = (item >> 6) & 3, b = item >> 8; const size_t t = (size_t)b * SEQ + ch * 64 + lane;
    const float ip = small[t * 32 + h] + gate_b[h], fp = small[t * 32 + 4 + h] + gate_b[4 + h];
    wl[lane] = fminf(fp, 0.f) - log1pf(__expf(-fabsf(fp)));
    asm volatile("s_waitcnt lgkmcnt(0)" ::: "memory");
    float bs = 0.f;
#pragma unroll
    for (int j = 0; j < 64; j += 4) { const f32x4_t v4 = *(const LAS f32x4_t*)(wl + j);
        bs += (j + 0 <= lane) ? v4[0] : 0.f; bs += (j + 1 <= lane) ? v4[1] : 0.f; bs += (j + 2 <= lane) ? v4[2] : 0.f; bs += (j + 3 <= lane) ? v4[3] : 0.f; }
    const float gt = __builtin_bit_cast(float, __builtin_amdgcn_readlane(__builtin_bit_cast(int, bs), 63));
    mg[t * 4 + h] = make_float4(bs, ip - bs, __expf(bs), __expf(gt - bs + ip) * 0.08838834764831845f);
    if (lane == 0) meg[(b * 4 + h) * 64 + ch] = __expf(gt);
    asm volatile("s_waitcnt lgkmcnt(0)" ::: "memory");
}
__device__ __forceinline__ void ssd_gate_item(int item, int lane, LAS float* wl, const float* __restrict__ small, const float* __restrict__ dt_bias, const float* __restrict__ a_log, float4* __restrict__ sg, float* __restrict__ sea) {
    const int ch = item & 31, hh = (item >> 5) & 15, b = item >> 9; const size_t t0 = (size_t)b * SEQ + ch * 128;
    const float a = -__expf(a_log[hh]), dtb = dt_bias[hh];
    float dt[2];
#pragma unroll
    for (int r = 0; r < 2; ++r) { const float dtr = small[(t0 + lane + 64 * r) * 32 + 8 + hh] + dtb; dt[r] = dtr > 20.f ? dtr : log1pf(__expf(dtr)); wl[lane + 64 * r] = dt[r] * a; }
    asm volatile("s_waitcnt lgkmcnt(0)" ::: "memory");
    float a0 = 0.f, a1 = 0.f;
#pragma unroll 8
    for (int j = 0; j < 128; j += 4) { const f32x4_t v4 = *(const LAS f32x4_t*)(wl + j);
#pragma unroll
        for (int q = 0; q < 4; ++q) { a0 += (j + q <= lane) ? v4[q] : 0.f; a1 += (j + q <= lane + 64) ? v4[q] : 0.f; } }
    const float atot = __builtin_bit_cast(float, __builtin_amdgcn_readlane(__builtin_bit_cast(int, a1), 63));
    sg[(t0 + lane) * 16 + hh] = make_float4(dt[0], a0, __expf(a0), __expf(atot - a0) * dt[0]);
    sg[(t0 + lane + 64) * 16 + hh] = make_float4(dt[1], a1, __expf(a1), __expf(atot - a1) * dt[1]);
    if (lane == 0) sea[(b * 16 + hh) * 32 + ch] = __expf(atot);
    asm volatile("s_waitcnt lgkmcnt(0)" ::: "memory");
}

constexpr int ML_QP = 272, ML_VP = 176, ML_PP = 144;
constexpr int ML_UNITS = NBATCH * 4 * 4;
constexpr int ML_Q = 0, ML_K = 2 * 64 * ML_QP, ML_V = ML_K + 2 * 64 * ML_QP, ML_VW = ML_V + 2 * 64 * ML_VP, ML_P = ML_VW + 64 * ML_VP, ML_CT = ML_P + 64 * ML_PP,
              ML_VEC = ML_CT + 80 * ML_QP, ML_END = ML_VEC + 4096;
static_assert(ML_END <= PHASE_LDS_BYTES, "mLSTM LDS");
__device__ __forceinline__ void tr_read2q(unsigned a0, unsigned a1, u32x2_t& r0, u32x2_t& r1) {
    asm volatile("ds_read_b64_tr_b16 %0, %2\n\tds_read_b64_tr_b16 %1, %3\n\ts_waitcnt lgkmcnt(0)" : "=&v"(r0), "=&v"(r1) : "v"(a0), "v"(a1) : "memory");
}
__device__ __forceinline__ bf16x8_t mk_frag(u32x2_t lo, u32x2_t hi) { const u32x4_t v = (u32x4_t){lo.x, lo.y, hi.x, hi.y}; return __builtin_bit_cast(bf16x8_t, v); }
#define LBAR() do { asm volatile("s_waitcnt lgkmcnt(0)" ::: "memory"); __builtin_amdgcn_s_barrier(); asm volatile("" ::: "memory"); } while (0)
__device__ __forceinline__ void mlstm_phase(LAS unsigned char* lds, const bf16* __restrict__ proj, const float4* __restrict__ mg, const float* __restrict__ meg, bf16* __restrict__ hm, int tid, int bx, int G, const float* __restrict__ tsrc  , unsigned char* __restrict__ tdst) {
    const int lane0 = tid & 63, w = __builtin_amdgcn_readfirstlane(tid >> 6);
    const unsigned ldsb = (unsigned)(size_t)lds;
    LAS float* vec = (LAS float*)(lds + ML_VEC);
    for (int u0_ = bx; u0_ < ML_UNITS; u0_ += G) {
        const int u = (G == 256) ? (u0_ & 7) * 16 + (u0_ >> 3) : u0_;
        const int vs = u & 3, h = (u >> 2) & 3, b = u >> 4;
        LBAR();
        for (int i = tid; i < 2 * 64; i += 512) { LAS unsigned* p = (LAS unsigned*)(lds + ML_V + i * ML_VP + 128); unsigned zz = 0u; asm volatile("" : "+v"(zz));     p[0] = 0x00003F80u | zz;
#pragma unroll
            for (int j = 1; j < 8; ++j) p[j] = zz; }
        for (int i = tid; i < 80 * ML_QP / 4; i += 512) ((LAS unsigned*)(lds + ML_CT))[i] = 0u;
        f32x4_t cacc[5];
#pragma unroll
        for (int i = 0; i < 5; ++i) cacc[i] = (f32x4_t){0.f, 0.f, 0.f, 0.f};
        struct MLRegs { uint4 pq[2], pk[2], pv; float4 pg; float peg; } rs[2];
#pragma unroll
        for (int i = 0; i < 2; ++i) { rs[i].pv = make_uint4(0u, 0u, 0u, 0u); rs[i].pg = make_float4(0.f, 0.f, 0.f, 0.f); rs[i].peg = 0.f; }
#define ML_LOAD(R_, c_) do { const size_t tb_ = (size_t)b * SEQ + (size_t)(c_) * 64; \
            _Pragma("unroll") for (int i_ = 0; i_ < 2; ++i_) { const int p_ = tid + 512 * i_, row_ = p_ >> 4, c16_ = p_ & 15; const bf16* s_ = proj + (tb_ + row_) * NP + h * 128 + c16_ * 8; R_.pq[i_] = *(const uint4*)(s_ + C_MQ); R_.pk[i_] = *(const uint4*)(s_ + C_MK); } \
            R_.pv = *(const uint4*)(proj + (tb_ + (tid >> 3)) * NP + C_MV + h * 256 + vs * 64 + (tid & 7) * 8); \
            if (tid >= 256 && tid < 320) { R_.pg = mg[(tb_ + (tid - 256)) * 4 + h]; R_.peg = meg[(b * 4 + h) * 64 + (c_)]; } } while (0)
#define ML_STORE(R_, bi_) do { _Pragma("unroll") for (int i_ = 0; i_ < 2; ++i_) { const int p_ = tid + 512 * i_, row_ = p_ >> 4, c16_ = p_ & 15; \
                *(LAS u32x4_t*)(lds + ML_Q + (bi_) * 64 * ML_QP + row_ * ML_QP + c16_ * 16) = __builtin_bit_cast(u32x4_t, R_.pq[i_]); *(LAS u32x4_t*)(lds + ML_K + (bi_) * 64 * ML_QP + row_ * ML_QP + c16_ * 16) = __builtin_bit_cast(u32x4_t, R_.pk[i_]); } \
            *(LAS u32x4_t*)(lds + ML_V + (bi_) * 64 * ML_VP + (tid >> 3) * ML_VP + (tid & 7) * 16) = __builtin_bit_cast(u32x4_t, R_.pv); \
            if (tid >= 256 && tid < 320) { LAS float* v_ = vec + (bi_) * 320 + (tid - 256); v_[0] = R_.pg.x; v_[64] = R_.pg.y; v_[128] = R_.pg.z; v_[192] = R_.pg.w; if (tid == 256) vec[(bi_) * 320 + 256] = R_.peg; } } while (0)
        ML_LOAD(rs[0], 0); ML_STORE(rs[0], 0); ML_LOAD(rs[1], 1);
        LBAR();
#pragma nounroll
        for (int c2 = 0; c2 < 64; c2 += 2) {
          int lane = lane0; asm volatile("" : "+v"(lane));
          const int l15 = lane & 15, g4 = lane >> 4, qq = l15 >> 2, pp = lane & 3;
#pragma unroll
          for (int par = 0; par < 2; ++par) {
            const int c = c2 + par, bi_cur = par;
            const LAS unsigned char* Qs = lds + ML_Q + bi_cur * 64 * ML_QP; const LAS unsigned char* Ks = lds + ML_K + bi_cur * 64 * ML_QP;
            const unsigned Ksb = ldsb + ML_K + bi_cur * 64 * ML_QP, Vsb = ldsb + ML_V + bi_cur * 64 * ML_VP, Vwb = ldsb + ML_VW;
            if (c + 2 < 64) ML_LOAD(rs[par], c + 2);
            float4 tq[4]; const size_t tgi = ((size_t)bx * TAB_PER_WG + (size_t)c * 128) * 2 + tid;
            if (tsrc && tid < 256) {
#pragma unroll
                for (int j = 0; j < 4; ++j) tq[j] = ((const float4*)tsrc)[tgi * 4 + j]; }
            const LAS float* vb = vec + bi_cur * 320;
            {
                const int ti = w >> 1;
#pragma unroll
                for (int sj = 0; sj < 2; ++sj) {
                    const int si = 2 * (w & 1) + sj;
                    f32x4_t acc = (f32x4_t){0.f, 0.f, 0.f, 0.f};
                    if (si <= ti) {
#pragma unroll
                        for (int ks = 0; ks < 4; ++ks) {
                            const bf16x8_t a = *(const LAS bf16x8_t*)(Ks + (16 * si + l15) * ML_QP + (32 * ks + 8 * g4) * 2);
                            const bf16x8_t bq = *(const LAS bf16x8_t*)(Qs + (16 * ti + l15) * ML_QP + (32 * ks + 8 * g4) * 2);
                            acc = __builtin_amdgcn_mfma_f32_16x16x32_bf16(a, bq, acc, 0, 0, 0);
                        }
                        const int t = 16 * ti + l15; const float btv = vb[t];
                        const f32x4_t csv = *(const LAS f32x4_t*)(vb + 64 + 16 * si + 4 * g4);
#pragma unroll
                        for (int e = 0; e < 4; ++e) { const int s = 16 * si + 4 * g4 + e; acc[e] = (s <= t) ? acc[e] * __expf(btv + csv[e]) * 0.08838834764831845f : 0.f; }
                    }
                    *(LAS u32x2_t*)(lds + ML_P + (16 * ti + l15) * ML_PP + (16 * si + 4 * g4) * 2) = (u32x2_t){pk2(acc[0], acc[1]), pk2(acc[2], acc[3])};
                }
            }
            for (int it = tid; it < 640; it += 512) { const int s = it / 10, pc = it % 10; const float wsv = vb[192 + s];
                const u32x4_t v = *(const LAS u32x4_t*)(lds + ML_V + bi_cur * 64 * ML_VP + s * ML_VP + pc * 16); u32x4_t o;
#pragma unroll
                for (int j = 0; j < 4; ++j) o[j] = pk2(__uint_as_float(v[j] << 16) * wsv, __uint_as_float(v[j] & 0xffff0000u) * wsv);
                *(LAS u32x4_t*)(lds + ML_VW + s * ML_VP + pc * 16) = o; }
            LBAR();
            f32x4_t numv[3]; const int ti5 = w >> 1;
            {
                const int nv = (w & 1) ? 2 : 3, v0 = (w & 1) ? 3 : 0;
                bf16x8_t pfr[2], qfr[4];
#pragma unroll
                for (int ks = 0; ks < 2; ++ks) pfr[ks] = *(const LAS bf16x8_t*)(lds + ML_P + (16 * ti5 + l15) * ML_PP + (32 * ks + 8 * g4) * 2);
#pragma unroll
                for (int ks = 0; ks < 4; ++ks) qfr[ks] = *(const LAS bf16x8_t*)(Qs + (16 * ti5 + l15) * ML_QP + (32 * ks + 8 * g4) * 2);
#pragma unroll
                for (int j = 0; j < 3; ++j) {
                    numv[j] = (f32x4_t){0.f, 0.f, 0.f, 0.f};
                    if (j < nv) {
                        const int vi = v0 + j;
                        f32x4_t ai = (f32x4_t){0.f, 0.f, 0.f, 0.f}, ax = ai;
#pragma unroll
                        for (int ks = 0; ks < 2; ++ks) {
                            u32x2_t r0, r1; tr_read2q(Vsb + (32 * ks + 8 * g4 + qq) * ML_VP + (16 * vi + 4 * pp) * 2, Vsb + (32 * ks + 8 * g4 + 4 + qq) * ML_VP + (16 * vi + 4 * pp) * 2, r0, r1);
                            ai = __builtin_amdgcn_mfma_f32_16x16x32_bf16(pfr[ks], mk_frag(r0, r1), ai, 0, 0, 0);
                        }
#pragma unroll
                        for (int ks = 0; ks < 4; ++ks) {
                            const bf16x8_t bc = *(const LAS bf16x8_t*)(lds + ML_CT + (16 * vi + l15) * ML_QP + (32 * ks + 8 * g4) * 2);
                            ax = __builtin_amdgcn_mfma_f32_16x16x32_bf16(qfr[ks], bc, ax, 0, 0, 0);
                        }
                        const f32x4_t eb = *(const LAS f32x4_t*)(vb + 128 + 16 * ti5 + 4 * g4);
                        numv[j] = ai + eb * ax;
                    }
                }
                if ((w & 1) && l15 == 0) *(LAS f32x4_t*)(vec + 640 + 16 * ti5 + 4 * g4) = numv[1];
            }
            LBAR();
            {
                const f32x4_t dn = *(const LAS f32x4_t*)(vec + 640 + 16 * ti5 + 4 * g4);
                const size_t tb = (size_t)b * SEQ + (size_t)c * 64;
                const int nw = (w & 1) ? 1 : 3, v0 = (w & 1) ? 3 : 0;
                f32x4_t rdn;
#pragma unroll
                for (int e = 0; e < 4; ++e) rdn[e] = __builtin_amdgcn_rcpf(fmaxf(fabsf(dn[e]), 1.0f));
#pragma unroll
                for (int j = 0; j < 3; ++j)
                    if (j < nw) {
#pragma unroll
                        for (int e = 0; e < 4; ++e) hm[(tb + 16 * ti5 + 4 * g4 + e) * 1024 + h * 256 + vs * 64 + 16 * (v0 + j) + l15] = (bf16)pk2(numv[j][e] * rdn[e], 0.f);
                    }
            }
            {
                const float eg = vb[256];
                bf16x8_t kf[2];
#pragma unroll
                for (int ks = 0; ks < 2; ++ks) { u32x2_t a0, a1; tr_read2q(Ksb + (32 * ks + 8 * g4 + qq) * ML_QP + (16 * w + 4 * pp) * 2, Ksb + (32 * ks + 8 * g4 + 4 + qq) * ML_QP + (16 * w + 4 * pp) * 2, a0, a1); kf[ks] = mk_frag(a0, a1); }
#pragma unroll
                for (int vi = 0; vi < 5; ++vi) {
                    f32x4_t acc = cacc[vi] * eg;
#pragma unroll
                    for (int ks = 0; ks < 2; ++ks) {
                        u32x2_t b0, b1;
                        tr_read2q(Vwb + (32 * ks + 8 * g4 + qq) * ML_VP + (16 * vi + 4 * pp) * 2, Vwb + (32 * ks + 8 * g4 + 4 + qq) * ML_VP + (16 * vi + 4 * pp) * 2, b0, b1);
                        acc = __builtin_amdgcn_mfma_f32_16x16x32_bf16(kf[ks], mk_frag(b0, b1), acc, 0, 0, 0);
                    }
                    cacc[vi] = acc;
                    *(LAS u32x2_t*)(lds + ML_CT + (16 * vi + l15) * ML_QP + (16 * w + 4 * g4) * 2) = (u32x2_t){pk2(acc[0], acc[1]), pk2(acc[2], acc[3])};
                }
            }
            if (tsrc && tid < 256) tab_fp4_store(tq, tdst + tgi * 8, U6_SCALE);
            if (c + 1 < 64) ML_STORE(rs[par ^ 1], bi_cur ^ 1);
            LBAR();
          }
        }
#undef ML_LOAD
#undef ML_STORE
    }
}

constexpr int SD_BP = 272, SD_XP = 144;
constexpr int SD_UNITS = NBATCH * 16;
constexpr int SD_B = 0, SD_C = 128 * SD_BP, SD_M = 2 * 128 * SD_BP, SD_H = 3 * 128 * SD_BP, SD_X = SD_H + 64 * SD_BP, SD_VEC = SD_X + 128 * SD_XP, SD_END = SD_VEC + 4096;
static_assert(SD_END <= PHASE_LDS_BYTES, "SSD LDS");
__device__ __forceinline__ void ssd_phase(LAS unsigned char* lds, const bf16* __restrict__ xcb  , const float4* __restrict__ sg, const float* __restrict__ sea,
                                          const float* __restrict__ dsk, bf16* __restrict__ yraw  , int tid, int bx, int G, const float* __restrict__ tsrc  , unsigned char* __restrict__ tdst) {
    const int lane0 = tid & 63, w = __builtin_amdgcn_readfirstlane(tid >> 6);
    const unsigned ldsb = (unsigned)(size_t)lds;
    LAS float* vec = (LAS float*)(lds + SD_VEC);
    const int hb = G >> 1;
    if (bx >= hb) for (int u0_ = bx - hb; u0_ < SD_UNITS; u0_ += G - hb) {
        const int u = (G == 256) ? (((u0_ & 7) * 2 + (u0_ >> 6)) * 8 + ((u0_ >> 3) & 7)) : u0_;
        const int hh = u & 15, b = u >> 4, g = hh >> 3;
        const float Dk = dsk[hh];
        LBAR();
        for (int i = tid; i < 64 * SD_BP / 4; i += 512) ((LAS unsigned*)(lds + SD_H))[i] = 0u;
        for (int i = tid; i < 128 * SD_BP / 4; i += 512) ((LAS unsigned*)(lds + SD_M))[i] = 0u;
        f32x4_t hacc[4];
#pragma unroll
        for (int i = 0; i < 4; ++i) hacc[i] = (f32x4_t){0.f, 0.f, 0.f, 0.f};
        uint4 pb[4], pc[4], px[2]; float4 pg = make_float4(0.f, 0.f, 0.f, 0.f); float pea = 0.f;
#define SD_LOAD(c_) do { const size_t tb_ = (size_t)b * SEQ + (size_t)(c_) * 128; \
            _Pragma("unroll") for (int i_ = 0; i_ < 4; ++i_) { const int p_ = tid + 512 * i_, row_ = p_ >> 4, c16_ = p_ & 15; const bf16* s_ = xcb + (tb_ + row_) * 1536 + 1024 + g * 128 + c16_ * 8; pb[i_] = *(const uint4*)s_; pc[i_] = *(const uint4*)(s_ + 256); } \
            _Pragma("unroll") for (int i_ = 0; i_ < 2; ++i_) { const int p_ = tid + 512 * i_; px[i_] = *(const uint4*)(xcb + (tb_ + (p_ >> 3)) * 1536 + hh * 64 + (p_ & 7) * 8); } \
            if (tid < 128) { pg = sg[(tb_ + tid) * 16 + hh]; pea = sea[(b * 16 + hh) * 32 + (c_)]; } } while (0)
#define SD_STORE() do { _Pragma("unroll") for (int i_ = 0; i_ < 4; ++i_) { const int p_ = tid + 512 * i_, row_ = p_ >> 4, c16_ = p_ & 15; \
                *(LAS u32x4_t*)(lds + SD_B + row_ * SD_BP + c16_ * 16) = __builtin_bit_cast(u32x4_t, pb[i_]); *(LAS u32x4_t*)(lds + SD_C + row_ * SD_BP + c16_ * 16) = __builtin_bit_cast(u32x4_t, pc[i_]); } \
            _Pragma("unroll") for (int i_ = 0; i_ < 2; ++i_) { const int p_ = tid + 512 * i_; *(LAS u32x4_t*)(lds + SD_X + (p_ >> 3) * SD_XP + (p_ & 7) * 16) = __builtin_bit_cast(u32x4_t, px[i_]); } \
            if (tid < 128) { vec[640 + tid] = pg.x; vec[256 + tid] = pg.y; vec[384 + tid] = pg.z; vec[512 + tid] = pg.w; if (tid == 0) vec[769] = pea; } } while (0)
        SD_LOAD(0); SD_STORE();
        LBAR();
#pragma nounroll
        for (int c = 0; c < 32; ++c) {
            int lane = lane0; asm volatile("" : "+v"(lane));
            const int l15 = lane & 15, g4 = lane >> 4, qq = l15 >> 2, pp = lane & 3;
            if (c + 1 < 32) SD_LOAD(c + 1);
            float4 tq[4]; const size_t tgi = ((size_t)(bx - hb) * TAB_PER_WG + (size_t)c * 256) * 2 + tid;
            if (tsrc) {
#pragma unroll
                for (int j = 0; j < 4; ++j) tq[j] = ((const float4*)tsrc)[tgi * 4 + j]; }
            {
#pragma unroll
                for (int k = 0; k < 5; ++k) {
                    int li, si;
                    if (w >= 4) { li = w; si = w - 4 + k; } else if (k <= w) { li = w; si = k; } else { li = 7 - w; si = k - w - 1; }
                    if (w >= 4 || k <= 3) {
                        const int l = 16 * li + l15; const float acl = vec[256 + l];
                        f32x4_t acc = (f32x4_t){0.f, 0.f, 0.f, 0.f};
#pragma unroll
                        for (int ks = 0; ks < 4; ++ks) {
                            const bf16x8_t av = *(const LAS bf16x8_t*)(lds + SD_B + (16 * si + l15) * SD_BP + (32 * ks + 8 * g4) * 2);
                            const bf16x8_t bv = *(const LAS bf16x8_t*)(lds + SD_C + (16 * li + l15) * SD_BP + (32 * ks + 8 * g4) * 2);
                            acc = __builtin_amdgcn_mfma_f32_16x16x32_bf16(av, bv, acc, 0, 0, 0);
                        }
                        const f32x4_t acs = *(const LAS f32x4_t*)(vec + 256 + 16 * si + 4 * g4), dts = *(const LAS f32x4_t*)(vec + 640 + 16 * si + 4 * g4);
#pragma unroll
                        for (int e = 0; e < 4; ++e) { const int s = 16 * si + 4 * g4 + e; acc[e] = (s <= l) ? acc[e] * __expf(acl - acs[e]) * dts[e] : 0.f; }
                        *(LAS u32x2_t*)(lds + SD_M + l * SD_BP + (16 * si + 4 * g4) * 2) = (u32x2_t){pk2(acc[0], acc[1]), pk2(acc[2], acc[3])};
                    }
                }
            }
            LBAR();
#pragma unroll
            for (int i_ = 0; i_ < 4; ++i_) { const int p_ = tid + 512 * i_, s = p_ >> 4, c16 = p_ & 15; const float wv = vec[512 + s];
                LAS u32x4_t* bp = (LAS u32x4_t*)(lds + SD_B + s * SD_BP + c16 * 16); const u32x4_t v = *bp; u32x4_t o;
#pragma unroll
                for (int j = 0; j < 4; ++j) o[j] = pk2(__uint_as_float(v[j] << 16) * wv, __uint_as_float(v[j] & 0xffff0000u) * wv);
                *bp = o; }
            {
                const int li = w; const size_t tb = (size_t)b * SEQ + (size_t)c * 128;
                const f32x4_t eac = *(const LAS f32x4_t*)(vec + 384 + 16 * li + 4 * g4);
                bf16x8_t mf[4], cf[4];
#pragma unroll
                for (int ks = 0; ks < 4; ++ks) {
                    mf[ks] = *(const LAS bf16x8_t*)(lds + SD_M + (16 * li + l15) * SD_BP + (32 * ks + 8 * g4) * 2);
                    cf[ks] = *(const LAS bf16x8_t*)(lds + SD_C + (16 * li + l15) * SD_BP + (32 * ks + 8 * g4) * 2);
                }
#pragma unroll
                for (int pi = 0; pi < 4; ++pi) {
                    f32x4_t yd = (f32x4_t){0.f, 0.f, 0.f, 0.f}, yo = yd;
#pragma unroll
                    for (int ks = 0; ks < 4; ++ks) {
                        if (32 * ks <= 16 * li + 15) {
                            u32x2_t r0, r1; tr_read2q(ldsb + SD_X + (32 * ks + 8 * g4 + qq) * SD_XP + (16 * pi + 4 * pp) * 2, ldsb + SD_X + (32 * ks + 8 * g4 + 4 + qq) * SD_XP + (16 * pi + 4 * pp) * 2, r0, r1);
                            yd = __builtin_amdgcn_mfma_f32_16x16x32_bf16(mf[ks], mk_frag(r0, r1), yd, 0, 0, 0);
                        }
                    }
#pragma unroll
                    for (int ks = 0; ks < 4; ++ks) {
                        const bf16x8_t bh = *(const LAS bf16x8_t*)(lds + SD_H + (16 * pi + l15) * SD_BP + (32 * ks + 8 * g4) * 2);
                        yo = __builtin_amdgcn_mfma_f32_16x16x32_bf16(cf[ks], bh, yo, 0, 0, 0);
                    }
#pragma unroll
                    for (int e = 0; e < 4; ++e) { const int l = 16 * li + 4 * g4 + e;
                        const float xv = __uint_as_float(((unsigned)*(const LAS unsigned short*)(lds + SD_X + l * SD_XP + (16 * pi + l15) * 2)) << 16);
                        yraw[(tb + l) * 1024 + hh * 64 + 16 * pi + l15] = (bf16)pk2(yd[e] + eac[e] * yo[e] + Dk * xv, 0.f); }
                }
            }
            LBAR();
            {
                const float ea = vec[769];
                bf16x8_t kf[4];
#pragma unroll
                for (int ks = 0; ks < 4; ++ks) { u32x2_t a0, a1; tr_read2q(ldsb + SD_B + (32 * ks + 8 * g4 + qq) * SD_BP + (16 * w + 4 * pp) * 2, ldsb + SD_B + (32 * ks + 8 * g4 + 4 + qq) * SD_BP + (16 * w + 4 * pp) * 2, a0, a1); kf[ks] = mk_frag(a0, a1); }
#pragma unroll
                for (int pi = 0; pi < 4; ++pi) {
                    f32x4_t acc = hacc[pi] * ea;
#pragma unroll
                    for (int ks = 0; ks < 4; ++ks) {
                        u32x2_t b0, b1;
                        tr_read2q(ldsb + SD_X + (32 * ks + 8 * g4 + qq) * SD_XP + (16 * pi + 4 * pp) * 2, ldsb + SD_X + (32 * ks + 8 * g4 + 4 + qq) * SD_XP + (16 * pi + 4 * pp) * 2, b0, b1);
                        acc = __builtin_amdgcn_mfma_f32_16x16x32_bf16(kf[ks], mk_frag(b0, b1), acc, 0, 0, 0);
                    }
                    hacc[pi] = acc;
                    *(LAS u32x2_t*)(lds + SD_H + (16 * pi + l15) * SD_BP + (16 * w + 4 * g4) * 2) = (u32x2_t){pk2(acc[0], acc[1]), pk2(acc[2], acc[3])};
                }
            }
            LBAR();
            if (tsrc) tab_fp4_store(tq, tdst + tgi * 8, V4_SCALE);
            if (c + 1 < 32) SD_STORE();
            LBAR();
        }
#undef SD_LOAD
#undef SD_STORE
    }
}

constexpr int PS_SKP = 272;
constexpr int PS_SK = 0, PS_END = 2 * 128 * PS_SKP;
static_assert(PS_END <= PHASE_LDS_BYTES, "PEER select LDS");
__device__ __forceinline__ unsigned fkey(float f) { const unsigned u = __float_as_uint(f); return u ^ ((unsigned)((int)u >> 31) | 0x80000000u); }
__device__ __forceinline__ float funkey(unsigned k) { return __uint_as_float((k & 0x80000000u) ? (k ^ 0x80000000u) : ~k); }
template <int CTRL> __device__ __forceinline__ unsigned dpp_u(unsigned v) { return (unsigned)__builtin_amdgcn_update_dpp(0, (int)v, CTRL, 0xF, 0xF, true); }
__device__ __forceinline__ unsigned umax(unsigned a, unsigned b) { return a > b ? a : b; }
__device__ __forceinline__ unsigned row_umax(unsigned v) { v = umax(v, dpp_u<0xB1>(v)); v = umax(v, dpp_u<0x4E>(v)); v = umax(v, dpp_u<0x141>(v)); v = umax(v, dpp_u<0x140>(v)); return v; }
__device__ __forceinline__ float row_sum(float v) { v += dpp_f<0xB1>(v); v += dpp_f<0x4E>(v); v += dpp_f<0x141>(v); v += dpp_f<0x140>(v); return v; }
template <int N> __device__ __forceinline__ unsigned row_top16(unsigned (&s)[N], int l15) {
    unsigned mine = 0u;
#pragma unroll
    for (int j = 0; j < 16; ++j) {
        unsigned m = s[0];
#pragma unroll
        for (int i = 1; i < N; ++i) m = umax(m, s[i]);
        m = row_umax(m);
        mine = (l15 == j) ? m : mine;
#pragma unroll
        for (int i = 0; i < N; ++i) s[i] = (s[i] == m) ? 0u : s[i];
    }
    return mine;
}
__device__ __forceinline__ void ce_desc(unsigned& a, unsigned& b) { const unsigned hi = umax(a, b), lo = a < b ? a : b; a = hi; b = lo; }
__device__ __forceinline__ void sort_desc(unsigned (&s)[8]) {
    ce_desc(s[0], s[1]); ce_desc(s[2], s[3]); ce_desc(s[4], s[5]); ce_desc(s[6], s[7]);
    ce_desc(s[0], s[2]); ce_desc(s[1], s[3]); ce_desc(s[4], s[6]); ce_desc(s[5], s[7]);
    ce_desc(s[1], s[2]); ce_desc(s[5], s[6]);
    ce_desc(s[0], s[4]); ce_desc(s[1], s[5]); ce_desc(s[2], s[6]); ce_desc(s[3], s[7]);
    ce_desc(s[2], s[4]); ce_desc(s[3], s[5]);
    ce_desc(s[1], s[2]); ce_desc(s[3], s[4]); ce_desc(s[5], s[6]);
}
__device__ __forceinline__ void sort_desc(unsigned (&s)[4]) { ce_desc(s[0], s[1]); ce_desc(s[2], s[3]); ce_desc(s[0], s[2]); ce_desc(s[1], s[3]); ce_desc(s[1], s[2]); }
template <int N> __device__ __forceinline__ void row_top16x4(unsigned (&s)[4][N], int l15, unsigned (&mine)[4]) {
#pragma unroll
    for (int e = 0; e < 4; ++e) { sort_desc(s[e]); mine[e] = 0u; }
#pragma unroll
    for (int j = 0; j < 16; ++j) {
        unsigned mx[4];
#pragma unroll
        for (int e = 0; e < 4; ++e) mx[e] = s[e][0];
#pragma unroll
        for (int e = 0; e < 4; ++e) mx[e] = umax(mx[e], dpp_u<0xB1>(mx[e]));
#pragma unroll
        for (int e = 0; e < 4; ++e) mx[e] = umax(mx[e], dpp_u<0x4E>(mx[e]));
#pragma unroll
        for (int e = 0; e < 4; ++e) mx[e] = umax(mx[e], dpp_u<0x141>(mx[e]));
#pragma unroll
        for (int e = 0; e < 4; ++e) mx[e] = umax(mx[e], dpp_u<0x140>(mx[e]));
#pragma unroll
        for (int e = 0; e < 4; ++e) {
            mine[e] = (l15 == j) ? mx[e] : mine[e];
            const bool win = s[e][0] == mx[e];
#pragma unroll
            for (int i = 0; i + 1 < N; ++i) s[e][i] = win ? s[e][i + 1] : s[e][i];
            s[e][N - 1] = win ? 0u : s[e][N - 1];
        }
    }
}
__device__ __forceinline__ void peer_select_phase(LAS unsigned char* lds, const bf16* __restrict__ qb  , const bf16* __restrict__ skb  , int* __restrict__ ids, float* __restrict__ gates,
                                                  int tid, int bx, int G) {
    const int lane = tid & 63, w = __builtin_amdgcn_readfirstlane(tid >> 6), l15 = lane & 15, g4 = lane >> 4;
    int ca[4], cb[4];
#pragma unroll
    for (int i = 0; i < 4; ++i) { const int sg = 4 * l15 + i; int a = 0, base = 0;
#pragma unroll
        for (int k = 0; k < 15; ++k) { const int cnt = 16 / (k + 1); const bool adv = (a == k) && (sg >= base + cnt); base += adv ? cnt : 0; a += adv ? 1 : 0; }
        ca[i] = a; cb[i] = sg - base; if (sg >= 50) { ca[i] = -1; cb[i] = 0; } }
    for (int u = bx; u < 8 * 32; u += G) {
        const int h = u >> 5, tr = u & 31;
        LBAR();
        for (int it = tid; it < 4096; it += 512) { const int row = it >> 4, c16 = it & 15;
            *(LAS u32x4_t*)(lds + PS_SK + row * PS_SKP + c16 * 16) = __builtin_bit_cast(u32x4_t, *(const uint4*)(skb + ((size_t)h * 256 + row) * 128 + c16 * 8)); }
        LBAR();
#pragma nounroll
        for (int tile = w; tile < 64; tile += 8) {
            const int t0 = tr * 1024 + tile * 16;
            unsigned top[2][4];
#pragma unroll
            for (int c = 0; c < 2; ++c) {
                bf16x8_t af[4];
#pragma unroll
                for (int ks = 0; ks < 4; ++ks) af[ks] = __builtin_bit_cast(bf16x8_t, *(const uint4*)(qb + (size_t)(t0 + l15) * DM + h * 256 + c * 128 + 32 * ks + 8 * g4));
                unsigned key[8][4];
#pragma unroll
                for (int kt = 0; kt < 8; ++kt) {
                    f32x4_t acc = (f32x4_t){0.f, 0.f, 0.f, 0.f};
#pragma unroll
                    for (int ks = 0; ks < 4; ++ks) {
                        const bf16x8_t bfr = *(const LAS bf16x8_t*)(lds + PS_SK + (c * 128 + 16 * kt + l15) * PS_SKP + (32 * ks + 8 * g4) * 2);
                        acc = __builtin_amdgcn_mfma_f32_16x16x32_bf16(af[ks], bfr, acc, 0, 0, 0);
                    }
#pragma unroll
                    for (int e = 0; e < 4; ++e) key[kt][e] = (fkey(acc[e]) & ~0x7Fu) | (unsigned)(127 - (16 * kt + l15));
                }
                { unsigned s8[4][8];
#pragma unroll
                  for (int e = 0; e < 4; ++e)
#pragma unroll
                      for (int kt = 0; kt < 8; ++kt) s8[e][kt] = key[kt][e];
                  __builtin_amdgcn_sched_barrier(0); row_top16x4<8>(s8, l15, top[c]); __builtin_amdgcn_sched_barrier(0); }
            }
            unsigned s4[4][4], win4[4];
#pragma unroll
            for (int e = 0; e < 4; ++e)
#pragma unroll
                for (int i = 0; i < 4; ++i) {
                    const int srcA = ((lane & 48) + (ca[i] < 0 ? 0 : ca[i])) * 4, srcB = ((lane & 48) + cb[i]) * 4;
                    const unsigned ka = (unsigned)__builtin_amdgcn_ds_bpermute(srcA, (int)top[0][e]), kb = (unsigned)__builtin_amdgcn_ds_bpermute(srcB, (int)top[1][e]);
                    const float cv = funkey(ka & ~0x7Fu) + funkey(kb & ~0x7Fu);
                    s4[e][i] = ca[i] < 0 ? 0u : ((fkey(cv) & ~0xFFu) | (unsigned)(255 - (ca[i] * 16 + cb[i])));
                }
            __builtin_amdgcn_sched_barrier(0); row_top16x4<4>(s4, l15, win4); __builtin_amdgcn_sched_barrier(0);
#pragma unroll
            for (int e = 0; e < 4; ++e) {
                const unsigned win = win4[e];
                const int jw = 255 - (int)(win & 0xFFu), wa = jw >> 4, wb = jw & 15;
                const unsigned ka = (unsigned)__builtin_amdgcn_ds_bpermute(((lane & 48) + wa) * 4, (int)top[0][e]), kb = (unsigned)__builtin_amdgcn_ds_bpermute(((lane & 48) + wb) * 4, (int)top[1][e]);
                const float bv = funkey(ka & ~0x7Fu) + funkey(kb & ~0x7Fu);
                const int id = (127 - (int)(ka & 0x7Fu)) * 128 + (127 - (int)(kb & 0x7Fu));
                const float mx = __builtin_bit_cast(float, __builtin_amdgcn_ds_bpermute((lane & 48) * 4, __builtin_bit_cast(int, bv)));
                const float ex = __expf(bv - mx), den = row_sum(ex);
                const size_t o = (size_t)(t0 + 4 * g4 + e) * 128 + h * 16 + l15;
                ids[o] = id; gates[o] = ex * __builtin_amdgcn_rcpf(den);
            }
        }
    }
}

struct MegaArgs { const float* in[22]; float* out; unsigned char* ws; };
template <int I> __device__ __forceinline__ unsigned long long ld_ptr() {
    unsigned long long v; const auto ka = __builtin_amdgcn_kernarg_segment_ptr();
    asm volatile("s_load_dwordx2 %0, %1, %2\n\ts_waitcnt lgkmcnt(0)" : "=s"(v) : "s"(ka), "n"(I * 8) : "memory");
    return v;
}
#define GAS_ __attribute__((address_space(1)))
#define INF(i) ((const float*)(const GAS_ float*)ld_ptr<(i)>())
#define OUTP ((float*)(GAS_ float*)ld_ptr<22>())
#define WSP ((unsigned char*)(GAS_ unsigned char*)ld_ptr<23>())
enum { I_X = 0, I_WIN, I_MGATEB, I_MNORMW, I_CONVW, I_CONVB, I_DTB, I_ALOG, I_SSMD, I_SNORMW, I_SINKS, I_MERGEB, I_WBR, I_WOUT, I_LN1G, I_LN1B, I_WQ, I_SUBK, I_PU, I_PV, I_LN2G, I_LN2B };

__global__ void __launch_bounds__(512, 2) mega_fwd(MegaArgs a) {
    extern __shared__ __attribute__((aligned(16))) unsigned char lds_raw[];
    LAS unsigned char* lds = (LAS unsigned char*)lds_raw;
    const int wave0 = __builtin_amdgcn_readfirstlane(threadIdx.x >> 6);
    volatile LAS unsigned* MISC = (volatile LAS unsigned*)(lds + MISC_OFF);
    { PHASE_IDS for (int u = tid; u < (LDS_BYTES - PHASE_LDS_BYTES) / 4; u += 512) ((LAS unsigned*)(lds + PHASE_LDS_BYTES))[u] = 0u; }
    __syncthreads();
    { XcdBarrier b0 = xcd_barrier_post((unsigned*)(WSP + WS_CTL) + CW_BAR, MISC + 8); (void)b0; }
#define GRID_BAR() do { XcdBarrier b_; b_.bar = (unsigned*)(WSP + WS_CTL) + CW_BAR; b_.x = xb_xcc_id(); b_.st = MISC + 8; xcd_barrier(b_); } while (0)

    { PHASE_IDS float2* rt = (float2*)(WSP + WS_ROPE);
      for (size_t i = gt; i < (size_t)SEQ * 32; i += NGT) { const int pos = (int)(i >> 5), fi = (int)(i & 31); const float ang = (float)pos * powf(10000.0f, -(float)fi / 32.0f); rt[i] = make_float2(cosf(ang), sinf(ang)); } }
    { PHASE_IDS const float* x = INF(I_X); bf16* xb = (bf16*)(WSP + WS_XB);
      unsigned* xq = (unsigned*)(WSP + WS_XQ);
      for (size_t i = gt; i < (size_t)T_TOK * DM / 4; i += NGT) { const float4 v = ((const float4*)x)[i]; ((uint2*)xb)[i] = make_uint2(pk2(v.x, v.y), pk2(v.z, v.w)); xq[i] = pk4_fp8(v.x, v.y, v.z, v.w); } }

#pragma nounroll
    for (int l = 0; l < DEPTH; ++l) {
        { PHASE_IDS
            unsigned char* ws = WSP; bf16* WinT = (bf16*)(ws + WS_WIN); bf16* WbT = (bf16*)(ws + WS_WB); bf16* WoT = (bf16*)(ws + WS_WO); bf16* WqT = (bf16*)(ws + WS_WQ); float* bias = (float*)(ws + WS_BIAS);
            const float* w_in = INF(I_WIN) + (size_t)l * DM * IN_COLS; const float* w_branch = INF(I_WBR) + (size_t)l * 3 * 1024 * DM; const float* w_out = INF(I_WOUT) + (size_t)l * DM * DM; const float* peer_wq = INF(I_WQ) + (size_t)l * DM * DM;
            const float* merge_gate_b = INF(I_MERGEB) + (size_t)l * 3 * DM;
            LAS float* scr = (LAS float*)(lds + wave * 16384);
            constexpr int I_IN = (DM / 64) * (NP / 32), I_B = (1024 / 64) * (DM / 32), I_O = (DM / 64) * (DM / 32);
            constexpr int NITEMS = I_IN + 3 * I_B + 2 * I_O;
            for (int it = gw; it < NITEMS; it += NGW) {
                int r = it;
                if (r < I_IN) { transpose_item<1>(w_in, DM, IN_COLS, NP, WinT, scr, r, lane, ws + WS_WG8); continue; } r -= I_IN;
                if (r < 3 * I_B) { const int k = r / I_B; transpose_item<2>(w_branch + (size_t)k * 1024 * DM, 1024, DM, DM, nullptr, scr, r - k * I_B, lane, ws + WS_WB8 + (size_t)k * DM * 1024); continue; } r -= 3 * I_B;
                if (r < I_O) { transpose_item<2>(w_out, DM, DM, DM, nullptr, scr, r, lane, ws + WS_WO8); continue; } r -= I_O;
                transpose_item<0>(peer_wq, DM, DM, DM, WqT, scr, r, lane);
            }
            for (size_t n = gt; n < NP; n += NGT) bias[n] = (n >= C_G && n < C_SMALL) ? merge_gate_b[n - C_G] : 0.f;
            { const float4* sk = (const float4*)(INF(I_SUBK) + (size_t)l * 8 * 2 * 128 * 128); uint2* skb = (uint2*)(ws + WS_SKB);
              for (size_t n = gt; n < 8 * 2 * 128 * 128 / 4; n += NGT) { const float4 v = sk[n]; skb[n] = make_uint2(pk2(v.x, v.y), pk2(v.z, v.w)); } }
        }
        GRID_BAR();
        { PHASE_IDS unsigned char* ws = WSP; pg8::Gemm g{(const bf16*)(ws + WS_XQ), (const bf16*)(ws + WS_WG8), T_TOK, C_SMALL - 256, DM / 2}; pg8::StaticOrder S; S.init(T_TOK, C_SMALL - 256, G, bx); S.rfrom = C_AV / 256; S.rto = SMALL_TILE - 1; S.wgm = 4;
          pg8::EpiProj E{(bf16*)(ws + WS_PROJ), (const float*)(ws + WS_BIAS), (float*)(ws + WS_SMALL), NP, GATE_TILE_LO, SMALL_TILE, 0, 1.0f / WG8_SCALE};
          pg8::gemm_phase<pg8::EpiProj, pg8::StaticOrder, true, true, true>(lds, g, S, E, tid); }
        __syncthreads();
        { PHASE_IDS unsigned char* ws = WSP; pg8::Gemm g{(const bf16*)(ws + WS_XB), (const bf16*)(ws + WS_WIN), T_TOK, 512, DM}; pg8::StaticOrder S; S.init(T_TOK, 512, G, bx); S.rfrom = 0; S.rto = C_AV / 256; S.rfrom2 = 1; S.rto2 = SMALL_TILE;
          pg8::EpiProj E{(bf16*)(ws + WS_PROJ), (const float*)(ws + WS_BIAS), (float*)(ws + WS_SMALL), NP, GATE_TILE_LO, SMALL_TILE, 0, 1.0f};
          pg8::gemm_phase<pg8::EpiProj, pg8::StaticOrder, true, true>(lds, g, S, E, tid); }
        GRID_BAR();
        { PHASE_IDS unsigned char* ws = WSP; const bf16* proj = (const bf16*)(ws + WS_PROJ); bf16* xcb = (bf16*)(ws + WS_R2);
          const float* cwg = INF(I_CONVW) + (size_t)l * 4 * 1536; const float* cbg = INF(I_CONVB) + l * 1536;
          LAS float* cw = (LAS float*)(lds + 16384); LAS float* cb = cw + 4 * 1536;
          for (int n = tid; n < 4 * 1536 / 4; n += 512) { const float4 v = ((const float4*)cwg)[n]; *(LAS f32x4e_t*)(cw + 4 * n) = (f32x4e_t){v.x, v.y, v.z, v.w}; }
          for (int n = tid; n < 1536 / 4; n += 512) { const float4 v = ((const float4*)cbg)[n]; *(LAS f32x4e_t*)(cb + 4 * n) = (f32x4e_t){v.x, v.y, v.z, v.w}; }
          asm volatile("s_waitcnt lgkmcnt(0)" ::: "memory"); __builtin_amdgcn_s_barrier(); asm volatile("" ::: "memory");
          for (int i = (int)gt; i < 192 * (T_TOK / 8); i += (int)NGT) ssd_conv_item(i, proj, cw, cb, xcb); }
        { PHASE_IDS unsigned char* ws = WSP; const float* small = (const float*)(ws + WS_SMALL); LAS float* wl = (LAS float*)(lds + wave * 1024);
          for (int i = gw; i < NBATCH * 4 * 64; i += NGW) mlstm_gate_item(i, lane, wl, small, INF(I_MGATEB) + l * 8, (float4*)(ws + WS_MG), (float*)(ws + WS_MEG));
          for (int i = gw; i < NBATCH * 16 * 32; i += NGW) ssd_gate_item(i, lane, wl, small, INF(I_DTB) + l * 16, INF(I_ALOG) + l * 16, (float4*)(ws + WS_SG), (float*)(ws + WS_SEA)); }
        GRID_BAR();
        { PHASE_IDS unsigned char* ws = WSP; mlstm_phase(lds, (const bf16*)(ws + WS_PROJ), (const float4*)(ws + WS_MG), (const float*)(ws + WS_MEG), (bf16*)(ws + WS_HM), tid, bx, G, G == 256 ? INF(I_PU) + (size_t)l * P_EXPERTS * DM : nullptr, ws + WS_TAB); }
        { PHASE_IDS unsigned char* ws = WSP; ssd_phase(lds, (const bf16*)(ws + WS_R2), (const float4*)(ws + WS_SG), (const float*)(ws + WS_SEA), INF(I_SSMD) + l * 16, (bf16*)(ws + WS_R1), tid, bx, G, G == 256 ? INF(I_PV) + (size_t)l * P_EXPERTS * DM : nullptr, ws + WS_TAB + 32 * MiB); }
        { PHASE_IDS unsigned char* ws = WSP; swa_phase(lds, (const bf16*)(ws + WS_PROJ), (const float*)(ws + WS_ROPE), INF(I_SINKS) + l * 16, ws + WS_YQ + 64 * MiB, tid, bx, G); }
        GRID_BAR();
        { PHASE_IDS unsigned char* ws = WSP; const bf16* proj = (const bf16*)(ws + WS_PROJ); const bf16* hm = (const bf16*)(ws + WS_HM); unsigned char* ym = ws + WS_YQ; const float* nwg = INF(I_MNORMW) + l * 1024; const float* nsg = INF(I_SNORMW) + l * 1024;
          LAS float* nw = (LAS float*)lds; LAS float* nsl = nw + 1024;
          if (tid < 256) { const float4 v = ((const float4*)nwg)[tid]; *(LAS f32x4e_t*)(nw + 4 * tid) = (f32x4e_t){v.x, v.y, v.z, v.w}; }
          else { const float4 v = ((const float4*)nsg)[tid - 256]; *(LAS f32x4e_t*)(nsl + 4 * (tid - 256)) = (f32x4e_t){v.x, v.y, v.z, v.w}; }
          asm volatile("s_waitcnt lgkmcnt(0)" ::: "memory"); __builtin_amdgcn_s_barrier(); asm volatile("" ::: "memory");
          for (int t = gw; t < T_TOK; t += NGW) mlstm_post_tok(t, lane, hm, proj, nw, ym); }
        { PHASE_IDS unsigned char* ws = WSP; const bf16* proj = (const bf16*)(ws + WS_PROJ); const bf16* yraw = (const bf16*)(ws + WS_R1); unsigned char* ys = ws + WS_YQ + 32 * MiB; const LAS float* nw = (const LAS float*)lds + 1024;
          for (int tp = gw; tp < T_TOK / 2; tp += NGW) ssd_post_tok2(tp, lane, yraw, proj, nw, ys); }
        GRID_BAR();
        { PHASE_IDS unsigned char* ws = WSP; pg8::Gemm g{(const bf16*)(ws + WS_YQ), (const bf16*)(ws + WS_WB8), T_TOK, DM, 512}; pg8::StaticOrder S; S.init(T_TOK, DM, G, bx); S.wgm = 8;
          pg8::EpiMix<1, 0, 8, 2> E{(bf16*)(ws + WS_R1), (const bf16*)(ws + WS_PROJ) + C_G, DM, NP, nullptr};
          pg8::gemm_phase<pg8::EpiMix<1, 0, 8, 2>, pg8::StaticOrder, true, true, true>(lds, g, S, E, tid); }
        __syncthreads();
        { PHASE_IDS unsigned char* ws = WSP; pg8::Gemm g{(const bf16*)(ws + WS_YQ + 32 * MiB), (const bf16*)(ws + WS_WB8 + (size_t)DM * 1024), T_TOK, DM, 512}; pg8::StaticOrder S; S.init(T_TOK, DM, G, bx); S.wgm = 8;
          pg8::EpiMix<0, 0, 8, 2> E{(bf16*)(ws + WS_R1), (const bf16*)(ws + WS_PROJ) + C_G + DM, DM, NP, nullptr};
          pg8::gemm_phase<pg8::EpiMix<0, 0, 8, 2>, pg8::StaticOrder, true, true, true>(lds, g, S, E, tid); }
        __syncthreads();
        { PHASE_IDS unsigned char* ws = WSP; pg8::Gemm g{(const bf16*)(ws + WS_YQ + 64 * MiB), (const bf16*)(ws + WS_WB8 + (size_t)2 * DM * 1024), T_TOK, DM, 512}; pg8::StaticOrder S; S.init(T_TOK, DM, G, bx); S.wgm = 8;
          pg8::EpiMix<0, 1, 8, 2> E{(bf16*)(ws + WS_R1), (const bf16*)(ws + WS_PROJ) + C_G + 2 * DM, DM, NP, ws + WS_R1Q};
          pg8::gemm_phase<pg8::EpiMix<0, 1, 8, 2>, pg8::StaticOrder, true, true, true>(lds, g, S, E, tid); }
        GRID_BAR();
        { PHASE_IDS unsigned char* ws = WSP;
          pg8::Gemm g{(const bf16*)(ws + WS_R1Q), (const bf16*)(ws + WS_WO8), T_TOK, DM, DM / 2}; pg8::StaticOrder S; S.init(T_TOK, DM, G, bx); S.wgm = 4; pg8::EpiResidB<8> E{(bf16*)(ws + WS_XB), DM, ALPHA, 0};
          pg8::gemm_phase<pg8::EpiResidB<8>, pg8::StaticOrder, true, true, true>(lds, g, S, E, tid); }
        GRID_BAR();
        { PHASE_IDS unsigned char* ws = WSP; bf16* xb = (bf16*)(ws + WS_XB); const float* g1g = INF(I_LN1G) + l * DM; const float* b1g = INF(I_LN1B) + l * DM;
          LAS float* g1 = (LAS float*)lds; LAS float* b1 = g1 + DM;
          { const float4 v = ((const float4*)g1g)[tid], w = ((const float4*)b1g)[tid]; *(LAS f32x4e_t*)(g1 + 4 * tid) = (f32x4e_t){v.x, v.y, v.z, v.w}; *(LAS f32x4e_t*)(b1 + 4 * tid) = (f32x4e_t){w.x, w.y, w.z, w.w}; }
          asm volatile("s_waitcnt lgkmcnt(0)" ::: "memory"); __builtin_amdgcn_s_barrier(); asm volatile("" ::: "memory");
          for (int tp = gw; tp < T_TOK / 2; tp += NGW) ln_body2b(tp, lane, xb, g1, b1); }
        { PHASE_IDS unsigned char* ws = WSP; constexpr size_t NGRP = (size_t)P_EXPERTS * DM / 32;
          const float* pu = INF(I_PU) + (size_t)l * P_EXPERTS * DM; const float* pv = INF(I_PV) + (size_t)l * P_EXPERTS * DM; unsigned char* U6 = ws + WS_TAB; unsigned char* V6 = ws + WS_TAB + 32 * MiB;
          if (G != 256) for (size_t i = gt; i < NGRP; i += NGT) { tab_to_fp4(i, pu, U6, U6_SCALE); tab_to_fp4(i, pv, V6, V4_SCALE); } }
        GRID_BAR();
        { PHASE_IDS unsigned char* ws = WSP; pg8::Gemm g{(const bf16*)(ws + WS_XB), (const bf16*)(ws + WS_WQ), T_TOK, DM, DM}; pg8::StaticOrder S; S.init(T_TOK, DM, G, bx); S.wgm = 4;
          pg8::EpiProj E{(bf16*)(ws + WS_QF), nullptr, nullptr, DM, 1 << 20, -1, 0, 1.0f};
          pg8::gemm_phase<pg8::EpiProj, pg8::StaticOrder, true, true>(lds, g, S, E, tid); }
        GRID_BAR();
        { PHASE_IDS unsigned char* ws = WSP; peer_select_phase(lds, (const bf16*)(ws + WS_QF), (const bf16*)(ws + WS_SKB), (int*)(ws + WS_IDS), (float*)(ws + WS_GATES), tid, bx, G); }
        GRID_BAR();
        { PHASE_IDS unsigned char* ws = WSP; const int* ids = (const int*)(ws + WS_IDS); const float* gates = (const float*)(ws + WS_GATES);
          const unsigned char* U8 = ws + WS_TAB; const unsigned char* V8 = ws + WS_TAB + 32 * MiB;     const float* g2 = INF(I_LN2G) + l * DM; const float* b2 = INF(I_LN2B) + l * DM; float* out = OUTP; bf16* xb = (bf16*)(ws + WS_XB);
          LAS unsigned* wl = (LAS unsigned*)(lds + wave * 2048);
          LAS float* gl = (LAS float*)(lds + 16384); LAS float* bl = gl + DM;
          for (int n = tid; n < DM / 4; n += 512) { const int ln_ = n >> 3, i_ = n & 7; const float4 gv = ((const float4*)g2)[n], bv = ((const float4*)b2)[n];
              *(LAS f32x4e_t*)(gl + (i_ * 64 + ln_) * 4) = (f32x4e_t){gv.x, gv.y, gv.z, gv.w}; *(LAS f32x4e_t*)(bl + (i_ * 64 + ln_) * 4) = (f32x4e_t){bv.x, bv.y, bv.z, bv.w}; }
          asm volatile("s_waitcnt lgkmcnt(0)" ::: "memory"); __builtin_amdgcn_s_barrier(); asm volatile("" ::: "memory");
          for (int t = gw; t < T_TOK; t += NGW) peer_expert_body(t, lane, l == DEPTH - 1, ids, gates, U8, V8, gl, bl, out, xb, ws + WS_XQ, wl); }
        GRID_BAR();
    }
#undef GRID_BAR
}

extern "C" void kernel_launch(void* const* d_in, const int* in_sizes, int n_in, void* d_out, int out_size, void* d_ws, size_t ws_size, hipStream_t stream) {
    static int grid = 0;
    if (grid == 0) {
        if (n_in != 22 || out_size != T_TOK * DM || ws_size < WS_END) { fprintf(stderr, "kernel_launch: unexpected shapes (n_in %d, out %d, ws %zu)\n", n_in, out_size, ws_size); grid = -1; return; }
        int dev = 0, cus = 0, per_cu = 0;
        if (hipGetDevice(&dev) != hipSuccess || hipDeviceGetAttribute(&cus, hipDeviceAttributeMultiprocessorCount, dev) != hipSuccess) { grid = -1; return; }
        if (hipFuncSetAttribute((const void*)mega_fwd, hipFuncAttributeMaxDynamicSharedMemorySize, LDS_BYTES) != hipSuccess) { fprintf(stderr, "kernel_launch: hipFuncSetAttribute failed\n"); grid = -1; return; }
        if (hipOccupancyMaxActiveBlocksPerMultiprocessor(&per_cu, (const void*)mega_fwd, 512, LDS_BYTES) != hipSuccess || per_cu < 1) { fprintf(stderr, "kernel_launch: occupancy query says %d blocks per CU\n", per_cu); (void)hipGetLastError(); grid = -1; return; }
        grid = cus;
    }
    if (grid < 0) return;
    (void)hipMemsetAsync((char*)d_ws + WS_CTL, 0, CTL_ZERO_BYTES, stream);
    MegaArgs a; memset(&a, 0, sizeof(a));
    for (int i = 0; i < 22; ++i) a.in[i] = (const float*)d_in[i];
    a.out = (float*)d_out; a.ws = (unsigned char*)d_ws;
    hipLaunchKernelGGL(mega_fwd, dim3(grid), dim3(512), LDS_BYTES, stream, a);
}
```
